# Optimizing an MI355X kernel written in HIP

```python
import math
import jax, jax.numpy as jnp
from jax import lax
import numpy as np

D_MODEL = 1024
BATCH = 8
SEQ = 2048
DEPTH = 2

D_MIX = D_MODEL
DN_HEADS = 4
DN_HEAD_DIM = 128
DN_WIDTH = DN_HEADS * DN_HEAD_DIM
DN_CONV = 4
DN_CHUNK = 64
NSA_HEADS = 4
NSA_HEAD_DIM = 64
NSA_WIDTH = NSA_HEADS * NSA_HEAD_DIM
CMP_LEN = 32
CMP_STRIDE = 16
CMP_HIDDEN = 2 * NSA_HEAD_DIM
SLC_BLOCK = 64
SLC_TOP_N = 16
WINDOW = 512
Q_BLOCK = 128
CONV_WIDTH = D_MIX - DN_WIDTH - NSA_WIDTH
CONV_KERNEL = 31
REL_BUCKETS = 32
REL_MAX_DIST = 128
N_EXPERTS = 32
TOP_K = 4
D_FF = D_MODEL
SWIGLU_LIMIT = 7.0
SWIGLU_ALPHA = 1.702
MOE_BLOCK = 128

EPS = 1e-6
NEG_INF = -1e30
FORCE = 1e4

IN_SPLITS = (
    DN_WIDTH,
    DN_WIDTH,
    DN_WIDTH,
    DN_WIDTH,
    DN_HEADS,
    DN_HEADS,
    NSA_WIDTH,
    6 * NSA_HEAD_DIM,
    3 * NSA_HEADS,
    2 * CONV_WIDTH,
)
D_IN = sum(IN_SPLITS)

kernel_name = 'hybrid_deltanet_nsa_conformer_moe'

f32 = jnp.float32


def rms_norm(x, w):
    xf = x.astype(f32)
    y = xf * lax.rsqrt(jnp.mean(xf * xf, axis=-1, keepdims=True) + EPS)
    return (y * w.astype(f32)).astype(x.dtype)


def layer_norm(x, w, b):
    xf = x.astype(f32)
    mu = jnp.mean(xf, axis=-1, keepdims=True)
    var = jnp.mean(jnp.square(xf - mu), axis=-1, keepdims=True)
    return ((xf - mu) * lax.rsqrt(var + EPS) * w.astype(f32) + b.astype(f32)).astype(x.dtype)


def l2_normalize(x):
    return x * lax.rsqrt(jnp.sum(x * x, axis=-1, keepdims=True) + EPS)


def masked_softmax(s, mask):
    s = jnp.where(mask, s, NEG_INF)
    return jax.nn.softmax(s, axis=-1) * mask


def causal_depthwise_conv(x, w):
    k = w.shape[0]
    return lax.conv_general_dilated(
        x, w[:, None, :].astype(x.dtype), window_strides=(1,), padding=[(k - 1, 0)],
        dimension_numbers=('NHC', 'HIO', 'NHC'), feature_group_count=x.shape[-1])


def t5_bucket(dist):
    n = jnp.maximum(dist, 0)
    max_exact = REL_BUCKETS // 2
    nf = jnp.maximum(n, 1).astype(f32)
    large = max_exact + (jnp.log(nf / max_exact) / math.log(REL_MAX_DIST / max_exact)
                         * (REL_BUCKETS - max_exact)).astype(jnp.int32)
    large = jnp.minimum(large, REL_BUCKETS - 1)
    return jnp.where(n < max_exact, n, large)


def chunk_gated_delta_rule(q, k, v, g, beta):
    B, T, H, Dk = q.shape
    Dv = v.shape[-1]
    C = DN_CHUNK
    N = T // C
    to_chunks = lambda t: t.reshape(B, N, C, H, -1).transpose(1, 0, 3, 2, 4)
    q, k, v = to_chunks(q), to_chunks(k), to_chunks(v)
    g = jnp.cumsum(g.reshape(B, N, C, H).transpose(1, 0, 3, 2), axis=-1)
    beta = beta.reshape(B, N, C, H).transpose(1, 0, 3, 2)
    k_beta = k * beta[..., None]
    v_beta = v * beta[..., None]
    tril = jnp.tril(jnp.ones((C, C), bool))
    strict = jnp.tril(jnp.ones((C, C), bool), -1)
    gdiff = jnp.where(tril, g[..., :, None] - g[..., None, :], 0.0)
    decay = jnp.where(tril, jnp.exp(gdiff), 0.0)
    lower = jnp.where(strict, jnp.einsum('nbhid,nbhjd->nbhij', k_beta, k) * decay, 0.0)
    rhs = jnp.concatenate([v_beta, k_beta * jnp.exp(g)[..., None]], axis=-1)
    sol = lax.linalg.triangular_solve(lower, rhs, left_side=True, lower=True, unit_diagonal=True)
    u, w = sol[..., :Dv], sol[..., Dv:]
    attn_intra = jnp.where(tril, jnp.einsum('nbhid,nbhjd->nbhij', q, k) * decay, 0.0)

    def step(S, inp):
        q_c, k_c, u_c, w_c, g_c, a_c = inp
        v_new = u_c - jnp.einsum('bhck,bhkv->bhcv', w_c, S)
        o = (jnp.einsum('bhck,bhkv->bhcv', q_c * jnp.exp(g_c)[..., None], S)
             + jnp.einsum('bhij,bhjv->bhiv', a_c, v_new))
        g_last = g_c[..., -1:]
        S = (S * jnp.exp(g_last)[..., None]
             + jnp.einsum('bhck,bhcv->bhkv', k_c * jnp.exp(g_last - g_c)[..., None], v_new))
        return S, o

    S0 = jnp.zeros((B, H, Dk, Dv), f32)
    _, o = lax.scan(step, S0, (q, k, u, w, g, attn_intra))
    return o.transpose(1, 0, 3, 2, 4).reshape(B, T, H, Dv)


def gated_deltanet(q, k, v, z, a, b, conv_w, a_log, dt_bias, norm_w):
    B, T, _ = q.shape
    qkv = jax.nn.silu(causal_depthwise_conv(jnp.concatenate([q, k, v], axis=-1), conv_w))
    q, k, v = jnp.split(qkv, 3, axis=-1)
    heads = lambda t: t.reshape(B, T, DN_HEADS, DN_HEAD_DIM).astype(f32)
    q = l2_normalize(heads(q)) * DN_HEAD_DIM ** -0.5
    k = l2_normalize(heads(k))
    v = heads(v)
    beta = jax.nn.sigmoid(b.astype(f32))
    g = -jnp.exp(a_log.astype(f32)) * jax.nn.softplus(a.astype(f32) + dt_bias.astype(f32))
    o = chunk_gated_delta_rule(q, k, v, g, beta)
    o = rms_norm(o, norm_w) * jax.nn.silu(heads(z))
    return o.reshape(B, T, DN_WIDTH).astype(z.dtype)


def nsa_attention(q, kv, gate_logits, q_norm_w, k_norm_w, cmp_pos, cmp_w1, cmp_w2, rel_bias):
    B, T, _ = q.shape
    H, Dh = NSA_HEADS, NSA_HEAD_DIM
    dt = q.dtype
    scale = Dh ** -0.5
    rel_bias = rel_bias.astype(f32)
    q = rms_norm(q.reshape(B, T, H, Dh), q_norm_w)
    k_cmp_raw, v_cmp_raw, k_slc, v_slc, k_win, v_win = jnp.split(kv, 6, axis=-1)
    t_pos = jnp.arange(T)

    n_cmp = (T - CMP_LEN) // CMP_STRIDE + 1
    blk_idx = np.arange(n_cmp)[:, None] * CMP_STRIDE + np.arange(CMP_LEN)[None, :]

    def compress(t, pos, w1, w2):
        blocks = t[:, blk_idx] + pos.astype(t.dtype)
        return jax.nn.silu(blocks.reshape(B, n_cmp, CMP_LEN * Dh) @ w1) @ w2

    k_cmp = rms_norm(compress(k_cmp_raw, cmp_pos[0], cmp_w1[0], cmp_w2[0]), k_norm_w[0])
    v_cmp = compress(v_cmp_raw, cmp_pos[1], cmp_w1[1], cmp_w2[1])
    cmp_end = jnp.arange(n_cmp) * CMP_STRIDE + CMP_LEN - 1
    dist_cmp = t_pos[:, None] - cmp_end[None, :]
    bias_cmp = rel_bias[t5_bucket(dist_cmp)].transpose(2, 0, 1)
    s_cmp = jnp.einsum('bthd,bjd->bhtj', q, k_cmp).astype(f32) * scale + bias_cmp
    p_cmp = masked_softmax(s_cmp, dist_cmp >= 0)
    o_cmp = jnp.einsum('bhtj,bjd->bthd', p_cmp.astype(dt), v_cmp)

    n_slc = T // SLC_BLOCK
    cmp_start = np.arange(n_cmp) * CMP_STRIDE
    slc_start = np.arange(n_slc) * SLC_BLOCK
    overlap = ((cmp_start[:, None] < slc_start[None, :] + SLC_BLOCK)
               & (cmp_start[:, None] + CMP_LEN > slc_start[None, :])).astype(np.float32)
    imp = jnp.einsum('bhtj,js->bts', p_cmp, jnp.asarray(overlap))
    cur = (t_pos // SLC_BLOCK)[:, None]
    s_idx = jnp.arange(n_slc)[None, :]
    causal_blk = s_idx <= cur
    forced = (s_idx == 0) | (s_idx == cur) | (s_idx == cur - 1)
    imp = jnp.where(causal_blk & forced, FORCE, jnp.where(causal_blk, imp, -1.0))
    top_n = min(SLC_TOP_N, n_slc)
    _, sel = lax.top_k(imp, top_n)

    k_slc = rms_norm(k_slc, k_norm_w[1]).reshape(B, n_slc, SLC_BLOCK, Dh)
    v_slc = v_slc.reshape(B, n_slc, SLC_BLOCK, Dh)
    k_win_p = jnp.pad(rms_norm(k_win, k_norm_w[2]), ((0, 0), (WINDOW, 0), (0, 0)))
    v_win_p = jnp.pad(v_win, ((0, 0), (WINDOW, 0), (0, 0)))
    n_qb = T // Q_BLOCK
    q_blocks = q.reshape(B, n_qb, Q_BLOCK, H, Dh).transpose(1, 0, 2, 3, 4)
    sel_blocks = sel.reshape(B, n_qb, Q_BLOCK, top_n).transpose(1, 0, 2, 3)
    b_idx = jnp.arange(B)[:, None, None]
    n_keys = top_n * SLC_BLOCK

    def query_block(args):
        i, q_i, sel_i = args
        tq = i * Q_BLOCK + jnp.arange(Q_BLOCK)
        kg = k_slc[b_idx, sel_i]
        vg = v_slc[b_idx, sel_i].reshape(B, Q_BLOCK, n_keys, Dh)
        key_pos = sel_i[..., None] * SLC_BLOCK + jnp.arange(SLC_BLOCK)
        dist = tq[None, :, None, None] - key_pos
        bias = rel_bias[t5_bucket(dist)].transpose(0, 4, 1, 2, 3)
        s = jnp.einsum('bqhd,bqnkd->bhqnk', q_i, kg).astype(f32) * scale + bias
        p = masked_softmax(s.reshape(B, H, Q_BLOCK, n_keys),
                           (dist >= 0).reshape(B, 1, Q_BLOCK, n_keys))
        o_s = jnp.einsum('bhqm,bqmd->bqhd', p.astype(dt), vg)
        kw = lax.dynamic_slice_in_dim(k_win_p, i * Q_BLOCK, WINDOW + Q_BLOCK, axis=1)
        vw = lax.dynamic_slice_in_dim(v_win_p, i * Q_BLOCK, WINDOW + Q_BLOCK, axis=1)
        kpos = i * Q_BLOCK - WINDOW + jnp.arange(WINDOW + Q_BLOCK)
        dist_w = tq[:, None] - kpos[None, :]
        mask_w = (dist_w >= 0) & (dist_w < WINDOW) & (kpos[None, :] >= 0)
        bias_w = rel_bias[t5_bucket(dist_w)].transpose(2, 0, 1)
        s_w = jnp.einsum('bqhd,bkd->bhqk', q_i, kw).astype(f32) * scale + bias_w
        p_w = masked_softmax(s_w, mask_w)
        o_w = jnp.einsum('bhqk,bkd->bqhd', p_w.astype(dt), vw)
        return o_s, o_w

    o_slc, o_win = lax.map(query_block, (jnp.arange(n_qb), q_blocks, sel_blocks))
    o_slc = o_slc.transpose(1, 0, 2, 3, 4).reshape(B, T, H, Dh)
    o_win = o_win.transpose(1, 0, 2, 3, 4).reshape(B, T, H, Dh)
    gates = jax.nn.sigmoid(gate_logits.astype(f32)).reshape(B, T, H, 3)
    o = (gates[..., 0, None] * o_cmp.astype(f32) + gates[..., 1, None] * o_slc.astype(f32)
         + gates[..., 2, None] * o_win.astype(f32))
    return o.reshape(B, T, NSA_WIDTH).astype(dt)


def conformer_conv(u, dw_w, dw_b, ln_w, ln_b):
    a, gate = jnp.split(u, 2, axis=-1)
    h = a * jax.nn.sigmoid(gate)
    h = causal_depthwise_conv(h, dw_w) + dw_b
    h = layer_norm(h, ln_w, ln_b)
    return jax.nn.silu(h)


def moe_ffn(h, router_w, router_b, w_gate_up, b_gate_up, w_down, b_down):
    B, T, D = h.shape
    x = h.reshape(-1, D)
    n_tok = x.shape[0]
    n_assign = n_tok * TOP_K
    logits = (x @ router_w + router_b).astype(f32)
    top_logits, top_idx = lax.top_k(logits, TOP_K)
    weights = jax.nn.softmax(top_logits, axis=-1)
    flat_e = top_idx.reshape(-1)
    order = jnp.argsort(flat_e)
    sorted_e = flat_e[order]
    sorted_tok = order // TOP_K
    counts = jnp.bincount(flat_e, length=N_EXPERTS)
    padded = (counts + MOE_BLOCK - 1) // MOE_BLOCK * MOE_BLOCK
    pad_end = jnp.cumsum(padded)
    pad_start = pad_end - padded
    start = jnp.cumsum(counts) - counts
    slot = pad_start[sorted_e] + jnp.arange(n_assign) - start[sorted_e]
    n_slots = n_assign + N_EXPERTS * MOE_BLOCK
    n_blocks = n_slots // MOE_BLOCK
    tok_of_slot = jnp.zeros((n_slots,), jnp.int32).at[slot].set(sorted_tok)
    w_of_slot = jnp.zeros((n_slots,), f32).at[slot].set(weights.reshape(-1)[order])
    block_expert = jnp.minimum(
        jnp.searchsorted(pad_end, jnp.arange(n_blocks) * MOE_BLOCK, side='right'), N_EXPERTS - 1)
    xs = x[tok_of_slot].reshape(n_blocks, MOE_BLOCK, D)

    def expert_block(args):
        e, xb = args
        gu = xb @ w_gate_up[e] + b_gate_up[e]
        gate, up = jnp.split(gu, 2, axis=-1)
        gate = jnp.minimum(gate, SWIGLU_LIMIT)
        up = jnp.clip(up, -SWIGLU_LIMIT, SWIGLU_LIMIT)
        act = (up + 1.0) * gate * jax.nn.sigmoid(SWIGLU_ALPHA * gate)
        return act @ w_down[e] + b_down[e]

    ys = lax.map(expert_block, (block_expert, xs)).reshape(n_slots, D)
    out = jnp.zeros_like(x).at[tok_of_slot].add(ys * w_of_slot[:, None].astype(ys.dtype))
    return out.reshape(B, T, D)


def split_columns(p):
    offsets = [int(o) for o in np.cumsum(IN_SPLITS)[:-1]]
    return jnp.split(p, offsets, axis=-1)


def setup_inputs(seed: int = 0) -> dict:
    key = jax.random.key(seed)
    ks = iter(jax.random.split(key, 32))
    L = DEPTH

    def nrm(shape, scale):
        return scale * jax.random.normal(next(ks), shape, f32)

    dt = jnp.exp(jax.random.uniform(next(ks), (L, DN_HEADS), f32, math.log(1e-3), math.log(1e-1)))
    a_init = jax.random.uniform(next(ks), (L, DN_HEADS), f32, 1.0, 16.0)
    return {
        'x': nrm((BATCH, SEQ, D_MODEL), 1.0),
        'attn_norm_w': 1.0 + nrm((L, D_MODEL), 0.01),
        'w_in': nrm((L, D_MODEL, D_IN), D_MODEL ** -0.5),
        'dn_conv_w': nrm((L, DN_CONV, 3 * DN_WIDTH), DN_CONV ** -0.5),
        'dn_a_log': jnp.log(a_init),
        'dn_dt_bias': dt + jnp.log(-jnp.expm1(-dt)),
        'dn_norm_w': 1.0 + nrm((L, DN_HEAD_DIM), 0.01),
        'nsa_q_norm_w': 1.0 + nrm((L, NSA_HEAD_DIM), 0.01),
        'nsa_k_norm_w': 1.0 + nrm((L, 3, NSA_HEAD_DIM), 0.01),
        'nsa_cmp_pos': nrm((L, 2, CMP_LEN, NSA_HEAD_DIM), 0.1),
        'nsa_cmp_w1': nrm((L, 2, CMP_LEN * NSA_HEAD_DIM, CMP_HIDDEN), (CMP_LEN * NSA_HEAD_DIM) ** -0.5),
        'nsa_cmp_w2': nrm((L, 2, CMP_HIDDEN, NSA_HEAD_DIM), CMP_HIDDEN ** -0.5),
        'conv_dw_w': nrm((L, CONV_KERNEL, CONV_WIDTH), CONV_KERNEL ** -0.5),
        'conv_dw_b': nrm((L, CONV_WIDTH), 0.01),
        'conv_ln_w': 1.0 + nrm((L, CONV_WIDTH), 0.01),
        'conv_ln_b': nrm((L, CONV_WIDTH), 0.01),
        'w_out': nrm((L, D_MIX, D_MODEL), 0.5 * D_MIX ** -0.5),
        'ffn_norm_w': 1.0 + nrm((L, D_MODEL), 0.01),
        'router_w': nrm((L, D_MODEL, N_EXPERTS), D_MODEL ** -0.5),
        'router_b': nrm((L, N_EXPERTS), 0.01),
        'w_gate_up': nrm((L, N_EXPERTS, D_MODEL, 2 * D_FF), D_MODEL ** -0.5),
        'b_gate_up': nrm((L, N_EXPERTS, 2 * D_FF), 0.01),
        'w_down': nrm((L, N_EXPERTS, D_FF, D_MODEL), 0.5 * D_FF ** -0.5),
        'b_down': nrm((L, N_EXPERTS, D_MODEL), 0.01),
        'rel_bias': nrm((REL_BUCKETS, NSA_HEADS), 0.5),
    }


def reference(x, attn_norm_w, w_in, dn_conv_w, dn_a_log, dn_dt_bias, dn_norm_w,
              nsa_q_norm_w, nsa_k_norm_w, nsa_cmp_pos, nsa_cmp_w1, nsa_cmp_w2,
              conv_dw_w, conv_dw_b, conv_ln_w, conv_ln_b, w_out, ffn_norm_w,
              router_w, router_b, w_gate_up, b_gate_up, w_down, b_down, rel_bias):
    for l in range(DEPTH):
        h = rms_norm(x, attn_norm_w[l])
        (dn_q, dn_k, dn_v, dn_z, dn_a, dn_b,
         nsa_q, nsa_kv, nsa_g, conv_u) = split_columns(h @ w_in[l])
        y_a = gated_deltanet(dn_q, dn_k, dn_v, dn_z, dn_a, dn_b,
                             dn_conv_w[l], dn_a_log[l], dn_dt_bias[l], dn_norm_w[l])
        y_b = nsa_attention(nsa_q, nsa_kv, nsa_g, nsa_q_norm_w[l], nsa_k_norm_w[l],
                            nsa_cmp_pos[l], nsa_cmp_w1[l], nsa_cmp_w2[l], rel_bias)
        y_c = conformer_conv(conv_u, conv_dw_w[l], conv_dw_b[l], conv_ln_w[l], conv_ln_b[l])
        x = x + jnp.concatenate([y_a, y_b, y_c], axis=-1) @ w_out[l]
        x = x + moe_ffn(rms_norm(x, ffn_norm_w[l]), router_w[l], router_b[l],
                        w_gate_up[l], b_gate_up[l], w_down[l], b_down[l])
    return x
```

```cpp
#include <hip/hip_runtime.h>
#include <cstdio>
#include <cstdint>
#include <cstddef>
namespace pg8 {
#define PG8_LAS __attribute__((address_space(3)))
typedef unsigned short bf16_t;
typedef short bf16x8 __attribute__((ext_vector_type(8)));
typedef float f32x4 __attribute__((ext_vector_type(4)));
typedef unsigned u32x4 __attribute__((ext_vector_type(4)));
constexpr int BM = 256, BK = 64, HALF = 128, HTB = HALF * BK * 2  , STAGE_BYTES = 8 * HTB, NXCD = 8, WGM = 8;

__host__ __device__ __forceinline__ int lds_byte(int r, int c) { const int st = (r >> 4) * 2 + (c >> 5), rr = r & 15, cc = c & 31, ob = rr * 64 + cc * 2; return st * 1024 + (ob ^ (((ob >> 9) & 1) << 5)); }
__host__ __device__ __forceinline__ void stage_rc(int b, int& R, int& C) { const int st = b / 1024, sb = b % 1024, swz = sb ^ (((sb >> 9) & 1) << 5); R = (st >> 1) * 16 + swz / 64; C = (st & 1) * 32 + (swz % 64) / 2; }
__host__ __device__ __forceinline__ int perm32(int rho) { const int n = rho >> 4, i = rho & 15; return 8 * (i >> 2) + 4 * n + (i & 3); }

struct Unit { int pm, pn; };
struct Gemm { const bf16_t* A; const bf16_t* Bt; int M, N, K; };

struct StaticOrder {
    int nM, nN, nwg, G, c;
    __host__ __device__ void init(int M, int N, int G_, int c_) { nM = M / BM; nN = N / BM; nwg = nM * nN; G = G_; c = c_; }
    __host__ __device__ bool next(int i, Unit& u) const {
        const long L = (long)i * G + c; if (L >= nwg) return false;
        int wgid = (int)L; { const int q = nwg / NXCD, r = nwg % NXCD, xcd = wgid % NXCD, off = wgid / NXCD; wgid = (xcd < r ? xcd * (q + 1) : r * (q + 1) + (xcd - r) * q) + off; }
        const int nig = WGM * nN, gid = wgid / nig, fm = gid * WGM, gsz = (nM - fm) < WGM ? (nM - fm) : WGM;
        u.pm = fm + ((wgid % nig) % gsz); u.pn = (wgid % nig) / gsz; return true;
    }
    __device__ __forceinline__ void a_ready(const Unit&) const {}
    __device__ __forceinline__ void done(const Unit&) const {}
};

__device__ __forceinline__ unsigned cvt_pk_bf16(float lo, float hi) { unsigned r; asm volatile("v_cvt_pk_bf16_f32 %0, %1, %2" : "=v"(r) : "v"(lo), "v"(hi)); return r; }

struct EpiBf16Plain {
    static constexpr bool PERM = true, AFTER_DRAIN = false;
    bf16_t* O; int ldc;
    __device__ __forceinline__ void operator()(const f32x4 (&acc)[2][2][4][2], const Unit& u, int wr, int wc, int fr, int fq) const {
        const int row0 = u.pm * BM + wr * 64 + fr, col0 = u.pn * BM + wc * 32 + 8 * fq;
#pragma unroll
        for (int ai = 0; ai < 2; ++ai)
#pragma unroll
            for (int m = 0; m < 4; ++m) { bf16_t* rowp = O + (size_t)(row0 + ai * HALF + m * 16) * ldc + col0;
#pragma unroll
                for (int bj = 0; bj < 2; ++bj) { const f32x4 v0 = acc[ai][bj][m][0], v1 = acc[ai][bj][m][1];
                    u32x4 w; w.x = cvt_pk_bf16(v0[0], v0[1]); w.y = cvt_pk_bf16(v0[2], v0[3]); w.z = cvt_pk_bf16(v1[0], v1[1]); w.w = cvt_pk_bf16(v1[2], v1[3]);
                    *(u32x4*)(rowp + bj * HALF) = w; } }
    }
};
struct EpiResF32 {
    static constexpr bool PERM = false, AFTER_DRAIN = false;
    const float* base; float* out; int ldc;
    __device__ __forceinline__ void operator()(const f32x4 (&acc)[2][2][4][2], const Unit& u, int wr, int wc, int fr, int fq) const {
        const int row0 = u.pm * BM + wr * 64 + fr, col0 = u.pn * BM + wc * 32 + 4 * fq;
#pragma unroll
        for (int ai = 0; ai < 2; ++ai)
#pragma unroll
            for (int m = 0; m < 4; ++m) { const size_t off = (size_t)(row0 + ai * HALF + m * 16) * ldc + col0;
#pragma unroll
                for (int bj = 0; bj < 2; ++bj)
#pragma unroll
                    for (int n = 0; n < 2; ++n) { const f32x4 b = *(const f32x4*)(base + off + bj * HALF + n * 16); *(f32x4*)(out + off + bj * HALF + n * 16) = b + acc[ai][bj][m][n]; } }
    }
};
struct EpiSwiglu {
    static constexpr bool PERM = true, AFTER_DRAIN = false;
    bf16_t* O; const float* bgu;
    __device__ __forceinline__ void operator()(const f32x4 (&acc)[2][2][4][2], const Unit& u, int wr, int wc, int fr, int fq) const {
        const int e = u.pn >> 3, pnl = u.pn & 7;
        const int row0 = u.pm * BM + wr * 64 + fr, gcol = pnl * 128 + wc * 32 + 8 * fq;
        const float* bg = bgu + (size_t)e * 2048 + gcol;
        f32x4 bgv[2], buv[2];
#pragma unroll
        for (int n = 0; n < 2; ++n) { bgv[n] = *(const f32x4*)(bg + 4 * n); buv[n] = *(const f32x4*)(bg + 1024 + 4 * n); }
#pragma unroll
        for (int ai = 0; ai < 2; ++ai)
#pragma unroll
            for (int m = 0; m < 4; ++m) { bf16_t* rowp = O + (size_t)(row0 + ai * HALF + m * 16) * 1024 + gcol;
                float r[8];
#pragma unroll
                for (int n = 0; n < 2; ++n) { const f32x4 gv = acc[ai][0][m][n] + bgv[n], uv = acc[ai][1][m][n] + buv[n];
#pragma unroll
                    for (int j = 0; j < 4; ++j) { const float g = fminf(gv[j], 7.0f), up = fminf(fmaxf(uv[j], -7.0f), 7.0f);
                        const float sg = __builtin_amdgcn_rcpf(1.0f + __expf(-1.702f * g)); r[n * 4 + j] = (up + 1.0f) * g * sg; } }
                u32x4 w; w.x = cvt_pk_bf16(r[0], r[1]); w.y = cvt_pk_bf16(r[2], r[3]); w.z = cvt_pk_bf16(r[4], r[5]); w.w = cvt_pk_bf16(r[6], r[7]);
                *(u32x4*)rowp = w; }
    }
};
struct EpiDown {
    static constexpr bool PERM = true, AFTER_DRAIN = false;
    bf16_t* O; const float* bd;
    __device__ __forceinline__ void operator()(const f32x4 (&acc)[2][2][4][2], const Unit& u, int wr, int wc, int fr, int fq) const {
        const int e = u.pn >> 2, pnl = u.pn & 3;
        const int row0 = u.pm * BM + wr * 64 + fr, col0 = pnl * BM + wc * 32 + 8 * fq;
        const float* bp = bd + (size_t)e * 1024 + col0;
        f32x4 bv[2][2];
#pragma unroll
        for (int bj = 0; bj < 2; ++bj)
#pragma unroll
            for (int n = 0; n < 2; ++n) bv[bj][n] = *(const f32x4*)(bp + bj * HALF + 4 * n);
#pragma unroll
        for (int ai = 0; ai < 2; ++ai)
#pragma unroll
            for (int m = 0; m < 4; ++m) { bf16_t* rowp = O + (size_t)(row0 + ai * HALF + m * 16) * 1024 + col0;
#pragma unroll
                for (int bj = 0; bj < 2; ++bj) { const f32x4 v0 = acc[ai][bj][m][0] + bv[bj][0], v1 = acc[ai][bj][m][1] + bv[bj][1];
                    u32x4 w; w.x = cvt_pk_bf16(v0[0], v0[1]); w.y = cvt_pk_bf16(v0[2], v0[3]); w.z = cvt_pk_bf16(v1[0], v1[1]); w.w = cvt_pk_bf16(v1[2], v1[3]);
                    *(u32x4*)(rowp + bj * HALF) = w; } }
    }
};
template <int NPN> struct MoeOrder {
    int nunits, G, c; const PG8_LAS int* texp;
    __device__ __forceinline__ bool next(int i, Unit& u) const {
        const int L = __builtin_amdgcn_readfirstlane(i * G + c); if (L >= nunits) return false;
        const int mt = L / NPN, pn = L % NPN;
        const int e = __builtin_amdgcn_readfirstlane(texp[mt]);
        u.pm = mt; u.pn = e * NPN + pn; return true;
    }
    __device__ __forceinline__ void a_ready(const Unit&) const {}
    __device__ __forceinline__ void done(const Unit&) const {}
};

template <class Epi, class Sched, bool ALIGN_EPI = false, bool SP2 = false>
__device__ __forceinline__ void gemm_phase(PG8_LAS unsigned char* lds, const Gemm g, const Sched& S, const Epi& E) {
    int tid_ = threadIdx.x; asm volatile("" : "+v"(tid_));
    const int tid = tid_, wid = __builtin_amdgcn_readfirstlane(tid >> 6), lane = tid & 63, wr = wid >> 2, wc = wid & 3, fr = lane & 15, fq = lane >> 4;
    const int K = g.K, nt = K / BK;
    unsigned voffA[2], voffB[2];
#pragma unroll
    for (int i = 0; i < 2; ++i) { int R, C; stage_rc(tid * 16 + i * 8192, R, C); const int Rb = Epi::PERM ? ((R & ~31) + perm32(R & 31)) : R;
        voffA[i] = (unsigned)(R * K + C) * 2u; voffB[i] = (unsigned)(Rb * K + C) * 2u; }
    const size_t kstep = (size_t)(BK * 2);
    const size_t hstep = (size_t)HALF * K * 2;
    const size_t tstep = 2 * hstep;
    const unsigned ldsw = (unsigned)wid * 1024u;
    const int aoff = lds_byte(wr * 64 + fr, fq * 8), boff = lds_byte(wc * 32 + fr, fq * 8);
#define PG8_SA(b, h) (((b) * 2 + (h)) * HTB)
#define PG8_SB(b, h) ((4 + (b) * 2 + (h)) * HTB)
#define PG8_STAGE(bufoff, gbase, voff) do { _Pragma("unroll") for (int _i = 0; _i < 2; ++_i) \
        __builtin_amdgcn_global_load_lds((const unsigned*)((const char*)(gbase) + (voff)[_i]), (PG8_LAS unsigned*)(lds + (bufoff) + ldsw + _i * 8192), 16, 0, 0); } while (0)
#define PG8_LDA(dst, b, h) do { _Pragma("unroll") for (int m = 0; m < 4; ++m) _Pragma("unroll") for (int k = 0; k < 2; ++k) dst[m][k] = *(const PG8_LAS bf16x8*)(lds + PG8_SA(b, h) + aoff + m * 2048 + k * 1024); } while (0)
#define PG8_LDB(dst, b, h) do { _Pragma("unroll") for (int n = 0; n < 2; ++n) _Pragma("unroll") for (int k = 0; k < 2; ++k) dst[n][k] = *(const PG8_LAS bf16x8*)(lds + PG8_SB(b, h) + boff + n * 2048 + k * 1024); } while (0)
#define PG8_MMA(ai, bj, At, Bt) do { __builtin_amdgcn_s_setprio(1); _Pragma("unroll") for (int m = 0; m < 4; ++m) _Pragma("unroll") for (int n = 0; n < 2; ++n) _Pragma("unroll") for (int k = 0; k < 2; ++k) \
        acc[ai][bj][m][n] = __builtin_amdgcn_mfma_f32_16x16x32_bf16(Bt[n][k], At[m][k], acc[ai][bj][m][n], 0, 0, 0); __builtin_amdgcn_s_setprio(0); } while (0)
#define PG8_WAIT_V(n) asm volatile("s_waitcnt vmcnt(" #n ")" ::: "memory")
#define PG8_WAIT_L(n) asm volatile("s_waitcnt lgkmcnt(" #n ")" ::: "memory")
#define PG8_BAR __builtin_amdgcn_s_barrier()
#define PG8_SCHED __builtin_amdgcn_sched_barrier(0)
    Unit cur, nxt; int ui = 0;
    if (!S.next(0, cur)) return;
    f32x4 acc[2][2][4][2];
#pragma unroll
    for (int a = 0; a < 2; ++a)
#pragma unroll
        for (int b = 0; b < 2; ++b)
#pragma unroll
            for (int m = 0; m < 4; ++m)
#pragma unroll
                for (int n = 0; n < 2; ++n) acc[a][b][m][n] = (f32x4){0.f, 0.f, 0.f, 0.f};
    bf16x8 At[4][2], B0[2][2], B1[2][2];
    const char* cA = (const char*)g.A + (size_t)cur.pm * tstep; const char* cB = (const char*)g.Bt + (size_t)cur.pn * tstep;
    S.a_ready(cur);
    if constexpr (SP2) {
        PG8_STAGE(PG8_SB(0, 0), cB, voffB); PG8_STAGE(PG8_SB(0, 1), cB + hstep, voffB); PG8_STAGE(PG8_SA(0, 0), cA, voffA); PG8_STAGE(PG8_SA(0, 1), cA + hstep, voffA);
        if (wr == 1) PG8_BAR;
        PG8_WAIT_V(2); PG8_BAR;
        PG8_STAGE(PG8_SB(1, 0), cB + kstep, voffB); PG8_STAGE(PG8_SA(1, 0), cA + kstep, voffA); PG8_STAGE(PG8_SB(1, 1), cB + hstep + kstep, voffB);
        PG8_WAIT_V(6); PG8_BAR;
    } else {
        PG8_STAGE(PG8_SB(0, 0), cB, voffB); PG8_STAGE(PG8_SA(0, 0), cA, voffA); PG8_STAGE(PG8_SB(0, 1), cB + hstep, voffB); PG8_STAGE(PG8_SA(0, 1), cA + hstep, voffA);
        if (wr == 1) PG8_BAR;
        PG8_WAIT_V(4); PG8_BAR;
        PG8_STAGE(PG8_SB(1, 0), cB + kstep, voffB); PG8_STAGE(PG8_SA(1, 0), cA + kstep, voffA); PG8_STAGE(PG8_SB(1, 1), cB + hstep + kstep, voffB);
        PG8_WAIT_V(6); PG8_BAR;
    }
    for (;;) {
        const bool has_next = S.next(ui + 1, nxt);
        const char* nA = has_next ? (const char*)g.A + (size_t)nxt.pm * tstep : cA; const char* nB = has_next ? (const char*)g.Bt + (size_t)nxt.pn * tstep : cB;
        for (int t = 0; t < nt; t += 2) {
            const bool last = (t == nt - 2);
            const char* a1 = cA + (size_t)(t + 1) * kstep;
            const char* a2 = last ? nA : cA + (size_t)(t + 2) * kstep; const char* b2 = last ? nB : cB + (size_t)(t + 2) * kstep;
            const char* a3 = a2 + kstep; const char* b3 = b2 + kstep;
            if (last && has_next) S.a_ready(nxt);
            if constexpr (SP2) {
            PG8_LDB(B0, 0, 0); PG8_LDB(B1, 0, 1); PG8_SCHED; PG8_LDA(At, 0, 0); PG8_STAGE(PG8_SA(1, 1), a1 + hstep, voffA);
            PG8_WAIT_V(8); PG8_WAIT_L(0); PG8_BAR; PG8_MMA(0, 0, At, B0); PG8_MMA(0, 1, At, B1); PG8_BAR; PG8_SCHED;
            PG8_LDA(At, 0, 1); PG8_STAGE(PG8_SB(0, 0), b2, voffB); PG8_STAGE(PG8_SB(0, 1), b2 + hstep, voffB); PG8_STAGE(PG8_SA(0, 0), a2, voffA);
            PG8_WAIT_V(8); PG8_WAIT_L(0); PG8_BAR; PG8_MMA(1, 0, At, B0); PG8_MMA(1, 1, At, B1); PG8_BAR; PG8_SCHED;
            PG8_LDB(B0, 1, 0); PG8_LDB(B1, 1, 1); PG8_SCHED; PG8_LDA(At, 1, 0); PG8_STAGE(PG8_SA(0, 1), a2 + hstep, voffA);
            PG8_WAIT_V(8); PG8_WAIT_L(0); PG8_BAR; PG8_MMA(0, 0, At, B0); PG8_MMA(0, 1, At, B1); PG8_BAR; PG8_SCHED;
            PG8_LDA(At, 1, 1); PG8_STAGE(PG8_SB(1, 0), b3, voffB); PG8_STAGE(PG8_SB(1, 1), b3 + hstep, voffB); PG8_STAGE(PG8_SA(1, 0), a3, voffA);
            PG8_WAIT_V(8); PG8_WAIT_L(0); PG8_BAR; PG8_MMA(1, 0, At, B0); PG8_MMA(1, 1, At, B1); PG8_BAR; PG8_SCHED;
            } else {
            PG8_LDB(B0, 0, 0); PG8_SCHED; PG8_LDA(At, 0, 0); PG8_STAGE(PG8_SA(1, 1), a1 + hstep, voffA);
            PG8_WAIT_L(8); PG8_BAR; PG8_WAIT_L(0); PG8_MMA(0, 0, At, B0); PG8_BAR; PG8_SCHED;
            PG8_LDB(B1, 0, 1); PG8_STAGE(PG8_SB(0, 0), b2, voffB);
            PG8_BAR; PG8_WAIT_L(0); PG8_MMA(0, 1, At, B1); PG8_BAR;
            PG8_LDA(At, 0, 1); PG8_STAGE(PG8_SA(0, 0), a2, voffA);
            PG8_BAR; PG8_WAIT_L(0); PG8_MMA(1, 0, At, B0); PG8_BAR; PG8_SCHED;
            PG8_STAGE(PG8_SB(0, 1), b2 + hstep, voffB);
            PG8_WAIT_V(6); PG8_BAR; PG8_MMA(1, 1, At, B1); PG8_BAR;
            PG8_LDB(B0, 1, 0); PG8_SCHED; PG8_LDA(At, 1, 0); PG8_STAGE(PG8_SA(0, 1), a2 + hstep, voffA);
            PG8_WAIT_L(8); PG8_BAR; PG8_WAIT_L(0); PG8_MMA(0, 0, At, B0); PG8_BAR; PG8_SCHED;
            PG8_LDB(B1, 1, 1); PG8_STAGE(PG8_SB(1, 0), b3, voffB);
            PG8_BAR; PG8_WAIT_L(0); PG8_MMA(0, 1, At, B1); PG8_BAR;
            PG8_LDA(At, 1, 1); PG8_STAGE(PG8_SA(1, 0), a3, voffA);
            PG8_BAR; PG8_WAIT_L(0); PG8_MMA(1, 0, At, B0); PG8_BAR; PG8_SCHED;
            PG8_STAGE(PG8_SB(1, 1), b3 + hstep, voffB);
            PG8_WAIT_V(6); PG8_BAR; PG8_MMA(1, 1, At, B1); PG8_BAR;
            }
        }
        if constexpr (ALIGN_EPI) { if (wr == 0) PG8_BAR; }
        if constexpr (!Epi::AFTER_DRAIN) { E(acc, cur, wr, wc, fr, fq); S.done(cur); }
        if (!has_next) break;
#pragma unroll
        for (int a = 0; a < 2; ++a)
#pragma unroll
            for (int b = 0; b < 2; ++b)
#pragma unroll
                for (int m = 0; m < 4; ++m)
#pragma unroll
                    for (int n = 0; n < 2; ++n) acc[a][b][m][n] = (f32x4){0.f, 0.f, 0.f, 0.f};
        cur = nxt; cA = nA; cB = nB; ++ui;
        if constexpr (ALIGN_EPI) { if (wr == 1) PG8_BAR; }
    }
    PG8_WAIT_V(0);
    if constexpr (!ALIGN_EPI) { if (wr == 0) PG8_BAR; }
    PG8_BAR;
    if constexpr (Epi::AFTER_DRAIN) { E.fused(acc, cur, wr, wc, fr, fq, lds, wid, lane); S.done(cur); }
#undef PG8_SA
#undef PG8_SB
#undef PG8_STAGE
#undef PG8_LDA
#undef PG8_LDB
#undef PG8_MMA
#undef PG8_WAIT_V
#undef PG8_WAIT_L
#undef PG8_BAR
#undef PG8_SCHED
}
}


#define GAS __attribute__((address_space(1)))
typedef unsigned short bf16;
typedef float f32x4 __attribute__((ext_vector_type(4)));
typedef unsigned u32x4 __attribute__((ext_vector_type(4)));
typedef unsigned u32x2 __attribute__((ext_vector_type(2)));

#ifndef SINGLE_LAUNCH
#define SINGLE_LAUNCH 1
#endif

constexpr int NB = 8, SEQ = 2048, DM = 1024, NT = NB * SEQ, NLAYER = 2;
constexpr int DIN = 3220, NP = 3328;
constexpr int C_Q = 0, C_K = 512, C_V = 1024, C_Z = 1536, C_NQ = 2048, C_KV = 2304, C_CU = 2688, C_A = 3200, C_B = 3204, C_G = 3208;
constexpr int NE = 32, MAXT = 288;
constexpr int NWAVES = 8, NTHR = 512;
constexpr float EPS = 1e-6f;

constexpr size_t MiB = 1u << 20;
constexpr size_t WS_CTL = 0, CTL_ZERO_BYTES = 1 * MiB;
constexpr size_t WS_BT = 1 * MiB;
constexpr size_t WS_KCMP = 1 * MiB + 256 * 1024, WS_VCMP = 1 * MiB + 512 * 1024;
constexpr size_t WS_G = 2 * MiB, WS_BETA = 2 * MiB + 256 * 1024, WS_GC = 2 * MiB + 512 * 1024;
constexpr size_t WS_EIDX = 3 * MiB, WS_EPOS = 3 * MiB + 256 * 1024, WS_EW = 3 * MiB + 512 * 1024, WS_SLOT = 3 * MiB + 768 * 1024;
constexpr size_t WS_WIN = 4 * MiB;
constexpr size_t WS_WOUT = 17 * MiB;
constexpr size_t WS_WGU = 22 * MiB;
constexpr size_t WS_WD = 278 * MiB;
constexpr size_t WS_XA = 406 * MiB, WS_XB = 470 * MiB;
constexpr size_t WS_XN = 534 * MiB;
constexpr size_t WS_P = 566 * MiB;
constexpr size_t WS_QN = 670 * MiB, WS_KN = 686 * MiB, WS_VC = 702 * MiB;
constexpr size_t WS_U = 718 * MiB, WS_W = 750 * MiB;
constexpr size_t WS_ATT = 782 * MiB;
constexpr size_t WS_O = 798 * MiB;
constexpr size_t WS_NQ = 830 * MiB;
constexpr size_t WS_KS = 846 * MiB, WS_KW = 848 * MiB;
constexpr size_t WS_Y = 850 * MiB;
constexpr size_t WS_XS = 882 * MiB, WS_ACT = 1026 * MiB, WS_YS = 1170 * MiB;
constexpr size_t WS_END = 1314 * MiB;

constexpr int CW_TMO = 0, CW_BAR = 4096, CW_CNT = 16384;

constexpr int RING_BYTES = 131072;
constexpr int LDSCTL_OFF = RING_BYTES, MISC_OFF = LDSCTL_OFF, TS_OFF = LDSCTL_OFF + 128, TE_OFF = LDSCTL_OFF + 320;
constexpr int LDS_BYTES = 147456;
static_assert(TE_OFF + MAXT * 4 + 64 <= LDS_BYTES, "LDS map");

#define XB_TMO      128
#define XB_XCNT(j)  (256  + 64 * (j))
#define XB_XSUB(j)  (1280 + 64 * (j))
#define XB_XGEN(j)  (2304 + 64 * (j))
#define XB_TOP      3328
#define XB_TOPGEN   3392
#define XCD_BAR_WORDS 3456
#define XB_SPIN_CAP (1u << 22)
#define LAS __attribute__((address_space(3)))

__device__ __forceinline__ unsigned xb_ld(unsigned* p)              { return __hip_atomic_load(p, __ATOMIC_RELAXED, __HIP_MEMORY_SCOPE_AGENT); }
__device__ __forceinline__ unsigned xb_add(unsigned* p, unsigned v) { return __hip_atomic_fetch_add(p, v, __ATOMIC_RELAXED, __HIP_MEMORY_SCOPE_AGENT); }
__device__ __forceinline__ unsigned xb_xcc_id() { return (unsigned)__builtin_amdgcn_s_getreg((3 << 11) | 20) & 0xFu; }
#define XB_SPIN(cond, bar) do { unsigned _sp = 0; while (cond) { __builtin_amdgcn_s_sleep(1); \
    if ((++_sp & 255u) == 0u) { if (xb_ld(&(bar)[XB_TMO])) break; if (_sp > XB_SPIN_CAP) { atomicAdd(&(bar)[XB_TMO], 1u); break; } } } } while (0)

struct XcdBarrier {
    unsigned* bar; unsigned x;
    volatile LAS unsigned* st;
};

__device__ __forceinline__ XcdBarrier xcd_barrier_post(unsigned* bar, volatile LAS unsigned* st) {
    XcdBarrier b; b.bar = bar; b.x = xb_xcc_id(); b.st = st;
    if (threadIdx.x == 0) (void)xb_add(&bar[XB_XCNT(b.x)], 1u);
    return b;
}
__device__ __forceinline__ void xcd_barrier_complete(unsigned* bar, unsigned x, unsigned& nloc, unsigned& nx) {
    const unsigned G = gridDim.x * gridDim.y * gridDim.z;
    unsigned sum, cnt, mine, sp = 0u;
    for (;;) {
        sum = 0u; cnt = 0u; mine = 0u;
#pragma unroll
        for (unsigned j = 0; j < 16; ++j) { const unsigned c = xb_ld(&bar[XB_XCNT(j)]); sum += c; cnt += (c > 0u) ? 1u : 0u; mine = (j == x) ? c : mine; }
        if (sum == G) break;
        __builtin_amdgcn_s_sleep(1);
        if ((++sp & 255u) == 0u) { if (xb_ld(&bar[XB_TMO])) break; if (sp > XB_SPIN_CAP) { atomicAdd(&bar[XB_TMO], 1u); break; } }
    }
    nloc = mine > 0u ? mine : 1u; nx = cnt > 0u ? cnt : 1u;
}

__device__ __forceinline__ void xcd_barrier(const XcdBarrier& b) {
    asm volatile("s_waitcnt vmcnt(0)" ::: "memory");
    __syncthreads();
    if (threadIdx.x == 0) {
        unsigned* bar = b.bar;
        __builtin_amdgcn_s_waitcnt(0);
        unsigned nloc = b.st[0], nx = b.st[1];
        if (nloc == 0u) { xcd_barrier_complete(bar, b.x, nloc, nx); b.st[0] = nloc; b.st[1] = nx; }
        const unsigned old = xb_add(&bar[XB_XSUB(b.x)], 1u);
        const unsigned gen = old / nloc;
        if (old + 1u == (gen + 1u) * nloc) {
            __builtin_amdgcn_fence(__ATOMIC_RELEASE, "agent");
            asm volatile("s_waitcnt vmcnt(0)" ::: "memory");
            const unsigned og = xb_add(&bar[XB_TOP], 1u);
            const unsigned tg = og / nx;
            if (og + 1u == (tg + 1u) * nx) xb_add(&bar[XB_TOPGEN], 1u);
            else XB_SPIN(xb_ld(&bar[XB_TOPGEN]) == tg, bar);
            __builtin_amdgcn_fence(__ATOMIC_ACQUIRE, "agent");
            xb_add(&bar[XB_XGEN(b.x)], 1u);
            asm volatile("s_waitcnt vmcnt(0)" ::: "memory");
        } else {
            XB_SPIN(xb_ld(&bar[XB_XGEN(b.x)]) == gen, bar);
            __builtin_amdgcn_fence(__ATOMIC_ACQUIRE, "agent");
            asm volatile("s_waitcnt vmcnt(0)" ::: "memory");
        }
    }
    __syncthreads();
}


__device__ __forceinline__ float bf_lo(unsigned w) { return __uint_as_float(w << 16); }
__device__ __forceinline__ float bf_hi(unsigned w) { return __uint_as_float(w & 0xffff0000u); }
__device__ __forceinline__ float bf2f(bf16 v) { return __uint_as_float(((unsigned)v) << 16); }
__device__ __forceinline__ unsigned f2bf(float f) { unsigned u = __float_as_uint(f); return (u + 0x7fffu + ((u >> 16) & 1u)) >> 16; }
__device__ __forceinline__ unsigned pk2(float lo, float hi) { return f2bf(lo) | (f2bf(hi) << 16); }
__device__ __forceinline__ float wave_sum(float v) {
#pragma unroll
    for (int o = 1; o < 64; o <<= 1) v += __shfl_xor(v, o);
    return v;
}
__device__ __forceinline__ float wave_max(float v) {
#pragma unroll
    for (int o = 1; o < 64; o <<= 1) v = fmaxf(v, __shfl_xor(v, o));
    return v;
}
__device__ __forceinline__ float sigmoidf_(float x) { return 1.0f / (1.0f + __expf(-x)); }
__device__ __forceinline__ float siluf_(float x) { return x / (1.0f + __expf(-x)); }
#define LDS_WAIT() asm volatile("s_waitcnt lgkmcnt(0)" ::: "memory")

struct Args { const float* in[25]; float* out; unsigned char* ws; int ph_lo, ph_hi; };

__device__ __forceinline__ int map_win(int n);
__device__ __forceinline__ int map_gu(int n);
template <int MAP>
__device__ __forceinline__ void transpose_item(const float* W, int K, int N, bf16* WT, LAS float* scr, int item, int nblk, int lane) {
    const int kb = item / nblk, nb = item % nblk, k0 = 64 * kb, n0 = 32 * nb;
    const int nd = n0 + (lane & 31); const int src = MAP == 1 ? map_win(nd) : (MAP == 2 ? map_gu(nd) : nd);
#pragma unroll 8
    for (int i = 0; i < 32; ++i) { const int kk = 2 * i + (lane >> 5); scr[kk * 33 + (lane & 31)] = src >= 0 ? W[(size_t)(k0 + kk) * N + src] : 0.0f; }
    LDS_WAIT();
    const int c = lane & 7;
#pragma unroll
    for (int j = 0; j < 4; ++j) { const int n = (lane >> 3) + 8 * j; const LAS float* s = scr + (8 * c) * 33 + n;
        u32x4 o; o.x = pk2(s[0 * 33], s[1 * 33]); o.y = pk2(s[2 * 33], s[3 * 33]); o.z = pk2(s[4 * 33], s[5 * 33]); o.w = pk2(s[6 * 33], s[7 * 33]);
        *(u32x4*)(WT + (size_t)(n0 + n) * K + k0 + 8 * c) = o; }
    LDS_WAIT();
}
__device__ __forceinline__ int map_win(int n) {
    if (n < 2048) return n;
    if (n < C_KV) return 2056 + (n - C_NQ);
    if (n < C_CU) return 2312 + (n - C_KV);
    if (n < C_A) return 2708 + (n - C_CU);
    if (n < C_B) return 2048 + (n - C_A);
    if (n < C_G) return 2052 + (n - C_B);
    if (n < C_G + 12) return 2696 + (n - C_G);
    return -1;
}
__device__ __forceinline__ int map_gu(int n) { const int pn = n >> 8, r = n & 255; return (r < 128 ? 0 : 1024) + 128 * pn + (r & 127); }

__device__ __forceinline__ void ph_prologue(const Args& a, LAS unsigned char* lds, int gw, int NGW, int wave, int lane) {
    LAS float* scr = (LAS float*)(lds + wave * 16384);
    bf16* WinT = (bf16*)(a.ws + WS_WIN); bf16* WoutT = (bf16*)(a.ws + WS_WOUT); bf16* WguT = (bf16*)(a.ws + WS_WGU); bf16* WdT = (bf16*)(a.ws + WS_WD);
    constexpr int I_IN = 16 * (NP / 32), I_OUT = 16 * 32, I_GU = 16 * 64, I_D = 16 * 32;
    constexpr int N_IN = NLAYER * I_IN, N_OUT = NLAYER * I_OUT, N_GU = NLAYER * NE * I_GU, N_D = NLAYER * NE * I_D;
    for (int it = gw; it < N_IN + N_OUT + N_GU + N_D; it += NGW) {
        int r = it;
        if (r < N_IN) { const int l = r / I_IN; transpose_item<1>(a.in[2] + (size_t)l * DM * DIN, DM, DIN, WinT + (size_t)l * NP * DM, scr, r % I_IN, NP / 32, lane); continue; } r -= N_IN;
        if (r < N_OUT) { const int l = r / I_OUT; transpose_item<0>(a.in[16] + (size_t)l * DM * DM, DM, DM, WoutT + (size_t)l * DM * DM, scr, r % I_OUT, 32, lane); continue; } r -= N_OUT;
        if (r < N_GU) { const int le = r / I_GU; transpose_item<2>(a.in[20] + (size_t)le * DM * 2048, DM, 2048, WguT + (size_t)le * 2048 * DM, scr, r % I_GU, 64, lane); continue; } r -= N_GU;
        { const int le = r / I_D; transpose_item<0>(a.in[22] + (size_t)le * DM * DM, DM, DM, WdT + (size_t)le * DM * DM, scr, r % I_D, 32, lane); }
    }
    float* BT = (float*)(a.ws + WS_BT);
    for (int i = gw * 64 + lane; i < 4 * 2048; i += NGW * 64) {
        const int h = i >> 11, n = i & 2047; int bk;
        if (n < 16) bk = n; else { const float v = logf((float)n / 16.0f) / 2.0794415416798357f * 16.0f; bk = 16 + (int)v; bk = bk < 31 ? bk : 31; }
        BT[i] = a.in[24][bk * 4 + h];
    }
}

__device__ __forceinline__ void rms_row_to_bf16(const f32x4 (&v)[4], const float* w, bf16* orow, int lane) {
    float s = 0.f;
#pragma unroll
    for (int j = 0; j < 4; ++j) s += (v[j].x * v[j].x + v[j].y * v[j].y) + (v[j].z * v[j].z + v[j].w * v[j].w);
    const float r = rsqrtf(wave_sum(s) * (1.0f / DM) + EPS);
#pragma unroll
    for (int j = 0; j < 4; ++j) { const f32x4 wv = *(const f32x4*)(w + 4 * (64 * j + lane)); const f32x4 y = v[j] * r * wv;
        u32x2 o; o.x = pk2(y.x, y.y); o.y = pk2(y.z, y.w); *(u32x2*)(orow + 4 * (64 * j + lane)) = o; }
}

__device__ __forceinline__ void ph_norm0(const Args& a, int gw, int NGW, int lane) {
    bf16* XN = (bf16*)(a.ws + WS_XN);
    for (int tok = gw; tok < NT; tok += NGW) {
        f32x4 v[4];
#pragma unroll
        for (int j = 0; j < 4; ++j) v[j] = *(const f32x4*)(a.in[0] + (size_t)tok * DM + 4 * (64 * j + lane));
        rms_row_to_bf16(v, a.in[1], XN + (size_t)tok * DM, lane);
    }
}

__device__ __forceinline__ void ph_m1(const Args& a, int l, LAS unsigned char* lds, int bid, int G, int tid, int wave, int lane) {
    const bf16* P = (const bf16*)(a.ws + WS_P);
    {
        LAS float* xin = (LAS float*)lds; LAS float* posl = (LAS float*)(lds + 36864); LAS float* hid = (LAS float*)(lds + 45056);
        bf16* KCMP = (bf16*)(a.ws + WS_KCMP); bf16* VCMP = (bf16*)(a.ws + WS_VCMP);
        for (int u = bid; u < 256; u += G) {
            const int b = u >> 5, kv = (u >> 4) & 1, jg = u & 15;
            for (int idx = tid; idx < 144 * 64; idx += NTHR) { const int tk = idx >> 6, d = idx & 63; int tkk = 128 * jg + tk; tkk = tkk < SEQ ? tkk : SEQ - 1;
                xin[idx] = bf2f(P[(size_t)(b * SEQ + tkk) * NP + C_KV + kv * 64 + d]); }
            for (int idx = tid; idx < 2048; idx += NTHR) posl[idx] = a.in[9][(size_t)(l * 2 + kv) * 2048 + idx];
            __syncthreads();
            const int n = tid & 127, rg = tid >> 7, j0 = 2 * rg;
            const float* w1 = a.in[10] + (size_t)(l * 2 + kv) * 2048 * 128;
            float acc0 = 0.f, acc1 = 0.f;
            for (int kidx = 0; kidx < 2048; ++kidx) { const int lq = kidx >> 6, d = kidx & 63; const float wv = w1[(size_t)kidx * 128 + n], pz = posl[kidx];
                acc0 += (xin[(16 * j0 + lq) * 64 + d] + pz) * wv; acc1 += (xin[(16 * (j0 + 1) + lq) * 64 + d] + pz) * wv; }
            hid[j0 * 128 + n] = siluf_(acc0); hid[(j0 + 1) * 128 + n] = siluf_(acc1);
            __syncthreads();
            const float* w2 = a.in[11] + (size_t)(l * 2 + kv) * 128 * 64;
            float o = 0.f;
            for (int nn = 0; nn < 128; ++nn) o += hid[wave * 128 + nn] * w2[nn * 64 + lane];
            if (kv == 0) { const float ss = wave_sum(o * o); o = o * rsqrtf(ss * (1.0f / 64.0f) + EPS) * a.in[8][l * 192 + lane]; }
            const int j = 8 * jg + wave;
            if (j < 127) (kv ? VCMP : KCMP)[(size_t)(b * 128 + j) * 64 + lane] = (bf16)f2bf(o);
            __syncthreads();
        }
    }
    const int gw = bid * NWAVES + wave, NGW = G * NWAVES;
    bf16* QN = (bf16*)(a.ws + WS_QN); bf16* KN = (bf16*)(a.ws + WS_KN); bf16* VC = (bf16*)(a.ws + WS_VC);
    float* Gb = (float*)(a.ws + WS_G); float* BETA = (float*)(a.ws + WS_BETA);
    float* NQ = (float*)(a.ws + WS_NQ); bf16* KS = (bf16*)(a.ws + WS_KS); bf16* KW = (bf16*)(a.ws + WS_KW); bf16* Y = (bf16*)(a.ws + WS_Y);
    const float* convw = a.in[3] + (size_t)l * 4 * 1536; const float* a_log = a.in[4] + l * 4; const float* dt_bias = a.in[5] + l * 4;
    const float* qnw = a.in[7] + l * 64; const float* knw = a.in[8] + l * 192;
    const float* dww = a.in[12] + (size_t)l * 31 * 256; const float* dwb = a.in[13] + l * 256; const float* lnw = a.in[14] + l * 256; const float* lnb = a.in[15] + l * 256;
    for (int tok = gw; tok < NT; tok += NGW) {
        const int t = tok & (SEQ - 1); const bf16* prow = P + (size_t)tok * NP;
#pragma unroll
        for (int ten = 0; ten < 3; ++ten)
#pragma unroll
            for (int h = 0; h < 4; ++h) { const int cb = ten * 512 + h * 128 + 2 * lane; float a0 = 0.f, a1 = 0.f;
#pragma unroll
                for (int j = 0; j < 4; ++j) if (t - 3 + j >= 0) { const unsigned w = *(const unsigned*)(prow + (ptrdiff_t)(j - 3) * NP + cb);
                    a0 += convw[j * 1536 + cb] * bf_lo(w); a1 += convw[j * 1536 + cb + 1] * bf_hi(w); }
                float y0 = siluf_(a0), y1 = siluf_(a1);
                if (ten < 2) { const float ss = wave_sum(y0 * y0 + y1 * y1); const float sc = rsqrtf(ss + EPS) * (ten == 0 ? 0.08838834764831845f : 1.0f); y0 *= sc; y1 *= sc; }
                bf16* dst = ten == 0 ? QN : (ten == 1 ? KN : VC);
                *(unsigned*)(dst + (size_t)tok * 512 + h * 128 + 2 * lane) = pk2(y0, y1); }
        if (lane < 4) { const float av = bf2f(prow[C_A + lane]), bv = bf2f(prow[C_B + lane]);
            BETA[(size_t)tok * 4 + lane] = sigmoidf_(bv);
            const float x = av + dt_bias[lane]; const float sp = x > 20.0f ? x : log1pf(expf(x));
            Gb[(size_t)tok * 4 + lane] = -expf(a_log[lane]) * sp; }
#pragma unroll
        for (int h = 0; h < 4; ++h) { const float x = bf2f(prow[C_NQ + h * 64 + lane]); const float ss = wave_sum(x * x);
            NQ[(size_t)tok * 256 + h * 64 + lane] = x * rsqrtf(ss * (1.0f / 64.0f) + EPS) * qnw[lane] * 0.125f; }
        { const float x = bf2f(prow[C_KV + 128 + lane]); const float ss = wave_sum(x * x); KS[(size_t)tok * 64 + lane] = (bf16)f2bf(x * rsqrtf(ss * (1.0f / 64.0f) + EPS) * knw[64 + lane]); }
        { const float x = bf2f(prow[C_KV + 256 + lane]); const float ss = wave_sum(x * x); KW[(size_t)tok * 64 + lane] = (bf16)f2bf(x * rsqrtf(ss * (1.0f / 64.0f) + EPS) * knw[128 + lane]); }
        { const int c = 4 * lane; f32x4 acc = *(const f32x4*)(dwb + c);
            for (int j = 0; j < 31; ++j) if (t - 30 + j >= 0) { const bf16* pr = prow + (ptrdiff_t)(j - 30) * NP + C_CU + c;
                const u32x2 av = *(const u32x2*)pr, gv = *(const u32x2*)(pr + 256); const f32x4 w = *(const f32x4*)(dww + j * 256 + c);
                acc.x += w.x * bf_lo(av.x) * sigmoidf_(bf_lo(gv.x)); acc.y += w.y * bf_hi(av.x) * sigmoidf_(bf_hi(gv.x));
                acc.z += w.z * bf_lo(av.y) * sigmoidf_(bf_lo(gv.y)); acc.w += w.w * bf_hi(av.y) * sigmoidf_(bf_hi(gv.y)); }
            const float mean = wave_sum((acc.x + acc.y) + (acc.z + acc.w)) * (1.0f / 256.0f);
            const f32x4 d = acc - mean; const float var = wave_sum((d.x * d.x + d.y * d.y) + (d.z * d.z + d.w * d.w)) * (1.0f / 256.0f);
            const float r = rsqrtf(var + EPS); const f32x4 lw = *(const f32x4*)(lnw + c), lb = *(const f32x4*)(lnb + c);
            const f32x4 y = d * r * lw + lb;
            u32x2 o; o.x = pk2(siluf_(y.x), siluf_(y.y)); o.y = pk2(siluf_(y.z), siluf_(y.w));
            *(u32x2*)(Y + (size_t)tok * DM + 768 + c) = o; }
    }
}

__device__ __forceinline__ void ph_dn_chunk(const Args& a, LAS unsigned char* lds, int bid, int G, int tid, int wave, int lane) {
    LAS float* Kf = (LAS float*)lds;
    LAS float* QV = Kf + 64 * 129;
    LAS float* Lm = QV + 64 * 129;
    LAS float* Tm = Lm + 64 * 65;
    LAS float* gcl = Tm + 64 * 65; LAS float* betal = gcl + 64; LAS float* bkl = betal + 64;
    const bf16* QN = (const bf16*)(a.ws + WS_QN); const bf16* KN = (const bf16*)(a.ws + WS_KN); const bf16* VC = (const bf16*)(a.ws + WS_VC);
    const float* Gb = (const float*)(a.ws + WS_G); const float* BETA = (const float*)(a.ws + WS_BETA); float* GC = (float*)(a.ws + WS_GC);
    float* U = (float*)(a.ws + WS_U); float* W = (float*)(a.ws + WS_W); float* ATT = (float*)(a.ws + WS_ATT);
    for (int ci = bid; ci < 1024; ci += G) {
        const int n = ci & 31, h = (ci >> 5) & 3, b = ci >> 7; const int r0 = b * SEQ + n * 64;
        { const int row = tid >> 3, seg = tid & 7; const size_t go = (size_t)(r0 + row) * 512 + h * 128 + seg * 16;
            const u32x4 k0 = *(const u32x4*)(KN + go), k1 = *(const u32x4*)(KN + go + 8), q0 = *(const u32x4*)(QN + go), q1 = *(const u32x4*)(QN + go + 8);
            LAS float* kd = Kf + row * 129 + seg * 16; LAS float* qd = QV + row * 129 + seg * 16;
#pragma unroll
            for (int e = 0; e < 4; ++e) { kd[2 * e] = bf_lo(k0[e]); kd[2 * e + 1] = bf_hi(k0[e]); kd[8 + 2 * e] = bf_lo(k1[e]); kd[8 + 2 * e + 1] = bf_hi(k1[e]);
                qd[2 * e] = bf_lo(q0[e]); qd[2 * e + 1] = bf_hi(q0[e]); qd[8 + 2 * e] = bf_lo(q1[e]); qd[8 + 2 * e + 1] = bf_hi(q1[e]); } }
        if (wave == 0) { float g = Gb[(size_t)(r0 + lane) * 4 + h];
#pragma unroll
            for (int off = 1; off < 64; off <<= 1) { const float v = __shfl_up(g, off); if (lane >= off) g += v; }
            const float be = BETA[(size_t)(r0 + lane) * 4 + h];
            gcl[lane] = g; GC[(size_t)(r0 + lane) * 4 + h] = g; betal[lane] = be; bkl[lane] = be * __expf(g); }
        __syncthreads();
        { const int i = tid >> 3, jg = tid & 7; float kk[8], qk[8];
#pragma unroll
            for (int m = 0; m < 8; ++m) { kk[m] = 0.f; qk[m] = 0.f; }
            for (int c = 0; c < 128; ++c) { const float ak = Kf[i * 129 + c], aq = QV[i * 129 + c];
#pragma unroll
                for (int m = 0; m < 8; ++m) { const float kj = Kf[(jg + 8 * m) * 129 + c]; kk[m] += ak * kj; qk[m] += aq * kj; } }
            const float gi = gcl[i], bi = betal[i];
#pragma unroll
            for (int m = 0; m < 8; ++m) { const int j = jg + 8 * m; const float dec = (j <= i) ? __expf(gi - gcl[j]) : 0.f;
                Lm[i * 65 + j] = (j < i) ? bi * kk[m] * dec : 0.f;
                ATT[(size_t)ci * 4096 + i * 64 + j] = (j <= i) ? qk[m] * dec : 0.f; } }
        __syncthreads();
        if (wave == 0) {
            for (int i = 0; i < 64; ++i) { float acc = (i == lane) ? 1.f : 0.f;
                for (int j = 0; j < i; ++j) acc -= Lm[i * 65 + j] * Tm[j * 65 + lane];
                Tm[i * 65 + lane] = acc; }
        } else {
            for (int e = tid - 64; e < 512; e += 448) { const int row = e >> 3, seg = e & 7; const size_t go = (size_t)(r0 + row) * 512 + h * 128 + seg * 16;
                const u32x4 v0 = *(const u32x4*)(VC + go), v1 = *(const u32x4*)(VC + go + 8); LAS float* vd = QV + row * 129 + seg * 16;
#pragma unroll
                for (int q = 0; q < 4; ++q) { vd[2 * q] = bf_lo(v0[q]); vd[2 * q + 1] = bf_hi(v0[q]); vd[8 + 2 * q] = bf_lo(v1[q]); vd[8 + 2 * q + 1] = bf_hi(v1[q]); } }
        }
        __syncthreads();
        { const int c = tid & 127, part = (tid >> 7) & 1, rg = tid >> 8; float acc[32];
#pragma unroll
            for (int ii = 0; ii < 32; ++ii) acc[ii] = 0.f;
            for (int j = 0; j < 64; ++j) { const float x = part ? Kf[j * 129 + c] * bkl[j] : QV[j * 129 + c] * betal[j];
#pragma unroll
                for (int ii = 0; ii < 32; ++ii) acc[ii] += Tm[(rg * 32 + ii) * 65 + j] * x; }
            float* dst = part ? W : U;
#pragma unroll
            for (int ii = 0; ii < 32; ++ii) dst[(size_t)(r0 + rg * 32 + ii) * 512 + h * 128 + c] = acc[ii]; }
        __syncthreads();
    }
}

__device__ __forceinline__ void ph_dn_scan(const Args& a, LAS unsigned char* lds, int bid, int G, int tid) {
    LAS float* Sl = (LAS float*)lds;
    LAS float* Wl = Sl + 128 * 16;
    LAS unsigned* Ql = (LAS unsigned*)(Wl + 64 * 129);
    LAS unsigned* Kl = Ql + 64 * 65;
    LAS float* Al = (LAS float*)(Kl + 64 * 65);
    LAS float* UL = Al + 64 * 65;
    LAS float* VN = UL + 64 * 16;
    LAS float* gcl = VN + 64 * 17; LAS float* dkl = gcl + 64; LAS float* egl = dkl + 64;
    const bf16* QN = (const bf16*)(a.ws + WS_QN); const bf16* KN = (const bf16*)(a.ws + WS_KN);
    const float* GC = (const float*)(a.ws + WS_GC); const float* U = (const float*)(a.ws + WS_U); const float* W = (const float*)(a.ws + WS_W);
    const float* ATT = (const float*)(a.ws + WS_ATT); float* O = (float*)(a.ws + WS_O);
    for (int u = bid; u < 256; u += G) {
        const int s = u & 7, h = (u >> 3) & 3, b = u >> 5;
        for (int i = tid; i < 128 * 16; i += NTHR) Sl[i] = 0.f;
        __syncthreads();
        const int c = tid & 15, i0 = tid >> 4;
        for (int n = 0; n < 32; ++n) {
            const int r0 = b * SEQ + n * 64, ci = (b * 4 + h) * 32 + n;
            { const int row = tid >> 3, seg = tid & 7; const size_t go = (size_t)(r0 + row) * 512 + h * 128 + seg * 16;
#pragma unroll
                for (int q = 0; q < 4; ++q) { const f32x4 wv = *(const f32x4*)(W + go + 4 * q); LAS float* wd = Wl + row * 129 + seg * 16 + 4 * q; wd[0] = wv.x; wd[1] = wv.y; wd[2] = wv.z; wd[3] = wv.w; }
                const u32x4 q0 = *(const u32x4*)(QN + go), q1 = *(const u32x4*)(QN + go + 8), k0 = *(const u32x4*)(KN + go), k1 = *(const u32x4*)(KN + go + 8);
                LAS unsigned* qd = Ql + row * 65 + seg * 8; LAS unsigned* kd = Kl + row * 65 + seg * 8;
#pragma unroll
                for (int q = 0; q < 4; ++q) { qd[q] = q0[q]; qd[4 + q] = q1[q]; kd[q] = k0[q]; kd[4 + q] = k1[q]; }
                const int idx = tid * 8, ar = idx >> 6, ac = idx & 63;
                const f32x4 a0 = *(const f32x4*)(ATT + (size_t)ci * 4096 + idx), a1 = *(const f32x4*)(ATT + (size_t)ci * 4096 + idx + 4);
                LAS float* ad = Al + ar * 65 + ac; ad[0] = a0.x; ad[1] = a0.y; ad[2] = a0.z; ad[3] = a0.w; ad[4] = a1.x; ad[5] = a1.y; ad[6] = a1.z; ad[7] = a1.w;
#pragma unroll
                for (int rr = 0; rr < 2; ++rr) { const int i = i0 + 32 * rr; UL[i * 16 + c] = U[(size_t)(r0 + i) * 512 + h * 128 + s * 16 + c]; }
                if (tid < 64) gcl[tid] = GC[(size_t)(r0 + tid) * 4 + h]; }
            __syncthreads();
            if (tid < 64) { const float gl = gcl[63], gi = gcl[tid]; dkl[tid] = __expf(gl - gi); egl[tid] = __expf(gi); }
#pragma unroll
            for (int rr = 0; rr < 2; ++rr) { const int i = i0 + 32 * rr; float acc = UL[i * 16 + c];
                for (int k = 0; k < 128; ++k) acc -= Wl[i * 129 + k] * Sl[k * 16 + c];
                VN[i * 17 + c] = acc; }
            __syncthreads();
#pragma unroll
            for (int rr = 0; rr < 2; ++rr) { const int i = i0 + 32 * rr; float acc = 0.f;
                for (int k2 = 0; k2 < 64; ++k2) { const unsigned qw = Ql[i * 65 + k2]; acc += bf_lo(qw) * Sl[(2 * k2) * 16 + c] + bf_hi(qw) * Sl[(2 * k2 + 1) * 16 + c]; }
                acc *= egl[i];
                for (int j = 0; j <= i; ++j) acc += Al[i * 65 + j] * VN[j * 17 + c];
                O[(size_t)(r0 + i) * 512 + h * 128 + s * 16 + c] = acc; }
            __syncthreads();
            { const float eg = __expf(gcl[63]);
#pragma unroll
                for (int m = 0; m < 4; ++m) { const int kk = i0 + 32 * m; float acc = Sl[kk * 16 + c] * eg;
                    for (int j = 0; j < 64; ++j) { const unsigned kw = Kl[j * 65 + (kk >> 1)]; const float kv = (kk & 1) ? bf_hi(kw) : bf_lo(kw); acc += kv * dkl[j] * VN[j * 17 + c]; }
                    Sl[kk * 16 + c] = acc; } }
            __syncthreads();
        }
    }
}

__device__ __forceinline__ void ph_dn_out(const Args& a, int l, int gw, int NGW, int lane) {
    const float* O = (const float*)(a.ws + WS_O); const bf16* P = (const bf16*)(a.ws + WS_P); bf16* Y = (bf16*)(a.ws + WS_Y);
    const float* nw = a.in[6] + l * 128;
    for (int tok = gw; tok < NT; tok += NGW) {
#pragma unroll
        for (int h = 0; h < 4; ++h) { const float o0 = O[(size_t)tok * 512 + h * 128 + 2 * lane], o1 = O[(size_t)tok * 512 + h * 128 + 2 * lane + 1];
            const float ss = wave_sum(o0 * o0 + o1 * o1); const float r = rsqrtf(ss * (1.0f / 128.0f) + EPS);
            const unsigned zw = *(const unsigned*)(P + (size_t)tok * NP + C_Z + h * 128 + 2 * lane);
            const float y0 = o0 * r * nw[2 * lane] * siluf_(bf_lo(zw)), y1 = o1 * r * nw[2 * lane + 1] * siluf_(bf_hi(zw));
            *(unsigned*)(Y + (size_t)tok * DM + h * 128 + 2 * lane) = pk2(y0, y1); }
    }
}

__device__ __forceinline__ void nsa_qk(const bf16* krow, const LAS float* qs, float (&s)[4]) {
#pragma unroll
    for (int h = 0; h < 4; ++h) s[h] = 0.f;
#pragma unroll 1
    for (int i = 0; i < 8; ++i) { const u32x4 kr = *(const u32x4*)(krow + 8 * i);
#pragma unroll
        for (int hf = 0; hf < 2; ++hf) { const float k0 = bf_lo(kr[2 * hf]), k1 = bf_hi(kr[2 * hf]), k2 = bf_lo(kr[2 * hf + 1]), k3 = bf_hi(kr[2 * hf + 1]);
#pragma unroll
            for (int h = 0; h < 4; ++h) { const f32x4 qv = *(const LAS f32x4*)(qs + h * 64 + i * 8 + hf * 4); s[h] += (qv.x * k0 + qv.y * k1) + (qv.z * k2 + qv.w * k3); } } }
}
__device__ __forceinline__ void nsa_pv(const float (&p)[4], LAS float* pw, const bf16* vbase, int vpitch, int kmax, int lane, float (&o)[4][2]) {
    *(LAS f32x4*)(pw + lane * 4) = (f32x4){p[0], p[1], p[2], p[3]};
    LDS_WAIT();
    const int dp = lane & 31, par = lane >> 5;
#pragma unroll 8
    for (int kk = 0; kk < 32; ++kk) { const int key = 2 * kk + par; const f32x4 pv = *(const LAS f32x4*)(pw + key * 4);
        const int row = key < kmax ? key : kmax; const unsigned vv = *(const unsigned*)(vbase + (size_t)row * vpitch + 2 * dp);
        const float v0 = bf_lo(vv), v1 = bf_hi(vv);
#pragma unroll
        for (int h = 0; h < 4; ++h) { o[h][0] += pv[h] * v0; o[h][1] += pv[h] * v1; } }
    LDS_WAIT();
}
__device__ __forceinline__ void nsa_tile(const bf16* krow, bool valid, int dist, const LAS float* qs, const LAS float* btl, LAS float* pw, const bf16* vbase, int vpitch, int lane,
                                         float (&m)[4], float (&lsum)[4], float (&o)[4][2]) {
    float s[4], p[4]; nsa_qk(krow, qs, s);
    const int dd = dist < 0 ? 0 : (dist > 2047 ? 2047 : dist);
#pragma unroll
    for (int h = 0; h < 4; ++h) { const float sv = valid ? s[h] + btl[h * 2048 + dd] : -1e30f; const float mn = fmaxf(m[h], wave_max(sv));
        const float corr = __expf(m[h] - mn); p[h] = valid ? __expf(sv - mn) : 0.f; lsum[h] = lsum[h] * corr + wave_sum(p[h]); o[h][0] *= corr; o[h][1] *= corr; m[h] = mn; }
    nsa_pv(p, pw, vbase, vpitch, 63, lane, o);
}

__device__ __forceinline__ void ph_nsa(const Args& a, LAS unsigned char* lds, int bid, int G, int tid, int wave, int lane) {
    LAS float* btl = (LAS float*)lds;
    LAS float* qs = (LAS float*)(lds + 32768 + wave * 4096);
    LAS float* pw = qs + 256;
    LAS float* ps = pw + 256;
    const float* BT = (const float*)(a.ws + WS_BT);
    for (int i = tid; i < 4 * 2048; i += NTHR) btl[i] = BT[i];
    __syncthreads();
    const bf16* P = (const bf16*)(a.ws + WS_P); const float* NQ = (const float*)(a.ws + WS_NQ);
    const bf16* KS = (const bf16*)(a.ws + WS_KS); const bf16* KW = (const bf16*)(a.ws + WS_KW);
    const bf16* KCMP = (const bf16*)(a.ws + WS_KCMP); const bf16* VCMP = (const bf16*)(a.ws + WS_VCMP); bf16* Y = (bf16*)(a.ws + WS_Y);
    const int gw = bid * NWAVES + wave, NGW = G * NWAVES;
    for (int it = gw; it < NT; it += NGW) {
        const int b = it / SEQ, t = ((it % SEQ) + 293 * b) & (SEQ - 1);
        const int tok = b * SEQ + t;
#pragma unroll
        for (int i = 0; i < 4; ++i) qs[lane + 64 * i] = NQ[(size_t)tok * 256 + lane + 64 * i];
        LDS_WAIT();
        float ocmp[4][2], oslc[4][2], owin[4][2];
        {
            float sA[4], sB[4], pA[4], pB[4];
            const int jA = lane, jB = 64 + lane; const bool vA = (16 * jA + 31 <= t), vB = (jB < 127) && (16 * jB + 31 <= t);
            nsa_qk(KCMP + (size_t)(b * 128 + jA) * 64, qs, sA);
            nsa_qk(KCMP + (size_t)(b * 128 + (jB < 127 ? jB : 126)) * 64, qs, sB);
            int dA = t - 16 * jA - 31, dB = t - 16 * jB - 31; dA = dA < 0 ? 0 : dA; dB = dB < 0 ? 0 : dB;
#pragma unroll
            for (int h = 0; h < 4; ++h) { const float a_ = vA ? sA[h] + btl[h * 2048 + dA] : -1e30f, b_ = vB ? sB[h] + btl[h * 2048 + dB] : -1e30f;
                const float mx = wave_max(fmaxf(a_, b_)); pA[h] = vA ? __expf(a_ - mx) : 0.f; pB[h] = vB ? __expf(b_ - mx) : 0.f;
                const float ls = wave_sum(pA[h] + pB[h]); const float inv = ls > 0.f ? 1.0f / ls : 0.f; pA[h] *= inv; pB[h] *= inv; }
            ps[lane] = (pA[0] + pA[1]) + (pA[2] + pA[3]); ps[64 + lane] = (pB[0] + pB[1]) + (pB[2] + pB[3]);
#pragma unroll
            for (int h = 0; h < 4; ++h) { ocmp[h][0] = 0.f; ocmp[h][1] = 0.f; }
            nsa_pv(pA, pw, VCMP + (size_t)(b * 128) * 64, 64, 63, lane, ocmp);
            nsa_pv(pB, pw, VCMP + (size_t)(b * 128 + 64) * 64, 64, 62, lane, ocmp);
#pragma unroll
            for (int h = 0; h < 4; ++h) { ocmp[h][0] += __shfl_xor(ocmp[h][0], 32); ocmp[h][1] += __shfl_xor(ocmp[h][1], 32); }
        }
        unsigned selmask;
        {
            const int sb = lane & 31, cur = t >> 6; float imp = 0.f;
#pragma unroll
            for (int dj = -1; dj <= 3; ++dj) { const int j = 4 * sb + dj; if (j >= 0 && j <= 126) imp += ps[j]; }
            if (sb > cur) imp = -1.0f; else if (sb == 0 || sb == cur || sb == cur - 1) imp = 1e4f;
            int rank = 0;
            for (int s2 = 0; s2 < 32; ++s2) { const float v2 = __shfl(imp, s2); rank += (v2 > imp || (v2 == imp && s2 < sb)) ? 1 : 0; }
            const bool sel = (lane < 32) && (rank < 16) && (sb <= cur);
            selmask = (unsigned)__ballot(sel);
        }
        {
            float m[4], ls[4];
#pragma unroll
            for (int h = 0; h < 4; ++h) { m[h] = -1e30f; ls[h] = 0.f; oslc[h][0] = 0.f; oslc[h][1] = 0.f; }
            unsigned mk = selmask;
            while (mk) { const int sblk = __builtin_ctz(mk); mk &= mk - 1u; const int key = 64 * sblk + lane;
                nsa_tile(KS + (size_t)(b * SEQ + key) * 64, key <= t, t - key, qs, btl, pw, P + (size_t)(b * SEQ + 64 * sblk) * NP + C_KV + 192, NP, lane, m, ls, oslc); }
#pragma unroll
            for (int h = 0; h < 4; ++h) { const float inv = ls[h] > 0.f ? 1.0f / ls[h] : 0.f; oslc[h][0] = (oslc[h][0] + __shfl_xor(oslc[h][0], 32)) * inv; oslc[h][1] = (oslc[h][1] + __shfl_xor(oslc[h][1], 32)) * inv; }
        }
        {
            float m[4], ls[4];
#pragma unroll
            for (int h = 0; h < 4; ++h) { m[h] = -1e30f; ls[h] = 0.f; owin[h][0] = 0.f; owin[h][1] = 0.f; }
            const int lo = t - 511 > 0 ? t - 511 : 0;
            for (int kt = lo >> 6; kt <= (t >> 6); ++kt) { const int key = 64 * kt + lane;
                nsa_tile(KW + (size_t)(b * SEQ + key) * 64, key <= t && key >= lo, t - key, qs, btl, pw, P + (size_t)(b * SEQ + 64 * kt) * NP + C_KV + 320, NP, lane, m, ls, owin); }
#pragma unroll
            for (int h = 0; h < 4; ++h) { const float inv = ls[h] > 0.f ? 1.0f / ls[h] : 0.f; owin[h][0] = (owin[h][0] + __shfl_xor(owin[h][0], 32)) * inv; owin[h][1] = (owin[h][1] + __shfl_xor(owin[h][1], 32)) * inv; }
        }
        if (lane < 32) {
#pragma unroll
            for (int h = 0; h < 4; ++h) { const bf16* gp = P + (size_t)tok * NP + C_G + h * 3;
                const float g0 = sigmoidf_(bf2f(gp[0])), g1 = sigmoidf_(bf2f(gp[1])), g2 = sigmoidf_(bf2f(gp[2]));
                const float y0 = g0 * ocmp[h][0] + g1 * oslc[h][0] + g2 * owin[h][0], y1 = g0 * ocmp[h][1] + g1 * oslc[h][1] + g2 * owin[h][1];
                *(unsigned*)(Y + (size_t)tok * DM + 512 + h * 64 + 2 * lane) = pk2(y0, y1); }
        }
    }
}

__device__ __forceinline__ void ph_router(const Args& a, int l, const float* X1, LAS unsigned char* lds, int bid, int G, int tid, int wave, int lane) {
    LAS float* hrow = (LAS float*)lds + wave * 1024;
    LAS int* lcnt = (LAS int*)(lds + 32768); LAS int* asg_e = lcnt + 32; LAS int* asg_p = asg_e + 256; LAS float* asg_w = (LAS float*)(asg_p + 256); LAS int* gbase = (LAS int*)(asg_w + 256);
    bf16* H2 = (bf16*)(a.ws + WS_XN); unsigned* cnt = (unsigned*)(a.ws + WS_CTL) + CW_CNT + 64 * l;
    int* EIDX = (int*)(a.ws + WS_EIDX); int* EPOS = (int*)(a.ws + WS_EPOS); float* EW = (float*)(a.ws + WS_EW);
    const float* fw = a.in[17] + (size_t)l * DM; const float* rw = a.in[18] + (size_t)l * DM * NE; const float* rb = a.in[19] + l * NE;
    for (int u = bid; u < NT / 64; u += G) {
        const int tok0 = u * 64;
        if (tid < 32) lcnt[tid] = 0;
        __syncthreads();
        for (int i = 0; i < 8; ++i) {
            const int tl = wave * 8 + i, tok = tok0 + tl;
            f32x4 v[4]; float ss = 0.f;
#pragma unroll
            for (int j = 0; j < 4; ++j) { v[j] = *(const f32x4*)(X1 + (size_t)tok * DM + 4 * (64 * j + lane)); ss += (v[j].x * v[j].x + v[j].y * v[j].y) + (v[j].z * v[j].z + v[j].w * v[j].w); }
            const float r = rsqrtf(wave_sum(ss) * (1.0f / DM) + EPS);
#pragma unroll
            for (int j = 0; j < 4; ++j) { const f32x4 y = v[j] * r * *(const f32x4*)(fw + 4 * (64 * j + lane));
                u32x2 o; o.x = pk2(y.x, y.y); o.y = pk2(y.z, y.w); *(u32x2*)(H2 + (size_t)tok * DM + 4 * (64 * j + lane)) = o;
                *(LAS f32x4*)(hrow + 4 * (64 * j + lane)) = y; }
            LDS_WAIT();
            const int e = lane & 31, half = lane >> 5; float acc = 0.f;
            for (int d = 0; d < 512; ++d) { const int dd = half * 512 + d; acc += hrow[dd] * rw[(size_t)dd * NE + e]; }
            acc += __shfl_xor(acc, 32); acc += rb[e];
            float val = acc, tv[4]; int ti[4];
#pragma unroll
            for (int q = 0; q < 4; ++q) { const float mx = wave_max(val); const unsigned bal = (unsigned)__ballot(val == mx); const int idx = __builtin_ctz(bal);
                tv[q] = mx; ti[q] = idx; if (e == idx) val = -3.0e38f; }
            float ew[4], es = 0.f;
#pragma unroll
            for (int q = 0; q < 4; ++q) { ew[q] = __expf(tv[q] - tv[0]); es += ew[q]; }
            if (lane == 0) {
#pragma unroll
                for (int q = 0; q < 4; ++q) { const int p = __hip_atomic_fetch_add(&lcnt[ti[q]], 1, __ATOMIC_RELAXED, __HIP_MEMORY_SCOPE_WORKGROUP); asg_e[tl * 4 + q] = ti[q]; asg_p[tl * 4 + q] = p; asg_w[tl * 4 + q] = ew[q] / es; } }
            LDS_WAIT();
        }
        __syncthreads();
        if (tid < 32) gbase[tid] = (int)atomicAdd(&cnt[tid], (unsigned)lcnt[tid]);
        __syncthreads();
        if (tid < 256) { const int tok = tok0 + (tid >> 2), k = tid & 3, e = asg_e[tid];
            EIDX[(size_t)tok * 4 + k] = e; EPOS[(size_t)tok * 4 + k] = gbase[e] + asg_p[tid]; EW[(size_t)tok * 4 + k] = asg_w[tid]; }
        __syncthreads();
    }
}

__device__ __forceinline__ void build_tiles(const unsigned* cnt, LAS int* TS, LAS int* TE, int tid) {
    if (tid == 0) { int acc = 0;
        for (int e = 0; e < NE; ++e) { TS[e] = acc; const int nt = (int)((cnt[e] + 255u) >> 8); for (int i = 0; i < nt; ++i) TE[acc + i] = e; acc += nt; }
        TS[NE] = acc; }
    __syncthreads();
}

__device__ __forceinline__ void ph_gather(const Args& a, int l, LAS unsigned char* lds, int gw, int NGW, int tid, int lane) {
    LAS int* TS = (LAS int*)(lds + TS_OFF); LAS int* TE = (LAS int*)(lds + TE_OFF);
    build_tiles((const unsigned*)(a.ws + WS_CTL) + CW_CNT + 64 * l, TS, TE, tid);
    const bf16* H2 = (const bf16*)(a.ws + WS_XN); bf16* XS = (bf16*)(a.ws + WS_XS);
    const int* EIDX = (const int*)(a.ws + WS_EIDX); const int* EPOS = (const int*)(a.ws + WS_EPOS); int* SLOT = (int*)(a.ws + WS_SLOT);
    for (int tok = gw; tok < NT; tok += NGW) {
        int slot = 0;
        if (lane < 4) { const int e = EIDX[(size_t)tok * 4 + lane]; slot = TS[e] * 256 + EPOS[(size_t)tok * 4 + lane]; SLOT[(size_t)tok * 4 + lane] = slot; }
        const u32x4 r0 = *(const u32x4*)(H2 + (size_t)tok * DM + 8 * lane), r1 = *(const u32x4*)(H2 + (size_t)tok * DM + 512 + 8 * lane);
#pragma unroll
        for (int k = 0; k < 4; ++k) { const int sk = __shfl(slot, k); *(u32x4*)(XS + (size_t)sk * DM + 8 * lane) = r0; *(u32x4*)(XS + (size_t)sk * DM + 512 + 8 * lane) = r1; }
    }
}

__device__ __forceinline__ void ph_combine(const Args& a, const float* X1, float* Xo, const float* next_norm_w, int gw, int NGW, int lane) {
    const bf16* YS = (const bf16*)(a.ws + WS_YS); const int* SLOT = (const int*)(a.ws + WS_SLOT); const float* EW = (const float*)(a.ws + WS_EW); bf16* XN = (bf16*)(a.ws + WS_XN);
    for (int tok = gw; tok < NT; tok += NGW) {
        int slot = 0; float wgt = 0.f;
        if (lane < 4) { slot = SLOT[(size_t)tok * 4 + lane]; wgt = EW[(size_t)tok * 4 + lane]; }
        f32x4 v[4];
#pragma unroll
        for (int j = 0; j < 4; ++j) v[j] = *(const f32x4*)(X1 + (size_t)tok * DM + 4 * (64 * j + lane));
#pragma unroll
        for (int k = 0; k < 4; ++k) { const int sk = __shfl(slot, k); const float wk = __shfl(wgt, k);
#pragma unroll
            for (int j = 0; j < 4; ++j) { const u32x2 y = *(const u32x2*)(YS + (size_t)sk * DM + 4 * (64 * j + lane));
                v[j].x += wk * bf_lo(y.x); v[j].y += wk * bf_hi(y.x); v[j].z += wk * bf_lo(y.y); v[j].w += wk * bf_hi(y.y); } }
#pragma unroll
        for (int j = 0; j < 4; ++j) *(f32x4*)(Xo + (size_t)tok * DM + 4 * (64 * j + lane)) = v[j];
        if (next_norm_w) rms_row_to_bf16(v, next_norm_w, XN + (size_t)tok * DM, lane);
    }
}

struct Tid { int tid, lane, wave; };
__device__ __forceinline__ Tid fresh_tid() { int t = threadIdx.x; asm volatile("" : "+v"(t)); Tid r; r.tid = t; r.lane = t & 63; r.wave = __builtin_amdgcn_readfirstlane(t >> 6); return r; }
#define FT() Args A_ = args_k; { unsigned char* w_ = args_k.ws; asm volatile("" : "+s"(w_)); A_.ws = w_; } const Args& args = A_; const Tid T_ = fresh_tid(); const int tid = T_.tid, lane = T_.lane, wave = T_.wave, gw = bid * NWAVES + wave; (void)tid; (void)lane; (void)wave; (void)gw
constexpr int PH_PER_LAYER = 11, NPH = 2 + NLAYER * PH_PER_LAYER;

#if SINGLE_LAUNCH
#define BARPARM , const XcdBarrier& bar
#define BARARG , bar
#define GRID_BAR() xcd_barrier(bar)
#else
#define BARPARM
#define BARARG
#define GRID_BAR() do {} while (0)
#endif
#define IN(k) (lo <= (k) && (k) < hi)
#define SEAM(k) do { if (IN(k) && IN((k) + 1)) GRID_BAR(); } while (0)
template <int l>
__device__ __forceinline__ void run_layer(const Args& args_k, LAS unsigned char* lds, int lo, int hi, int G, int bid, int NGW BARPARM) {
        const int pb = 2 + l * PH_PER_LAYER;
#define Xin ((l == 0) ? args.in[0] : (const float*)(args.ws + WS_XB))
#define X1 ((float*)(args.ws + WS_XA))
#define Xout ((l == NLAYER - 1) ? args.out : (float*)(args.ws + WS_XB))
        if (IN(pb + 0)) {
            FT(); pg8::Gemm g{(const pg8::bf16_t*)(args.ws + WS_XN), (const pg8::bf16_t*)(args.ws + WS_WIN) + (size_t)l * NP * DM, NT, NP, DM};
            pg8::StaticOrder S; S.init(NT, NP, G, bid);
            pg8::EpiBf16Plain E{(pg8::bf16_t*)(args.ws + WS_P), NP};
            pg8::gemm_phase<pg8::EpiBf16Plain, pg8::StaticOrder, true, true>(lds, g, S, E);
        } SEAM(pb + 0);
        if (IN(pb + 1)) { FT(); ph_m1(args, l, lds, bid, G, tid, wave, lane); } SEAM(pb + 1);
        if (IN(pb + 2)) { { FT(); ph_dn_chunk(args, lds, bid, G, tid, wave, lane); } __syncthreads(); { FT(); ph_nsa(args, lds, bid, G, tid, wave, lane); } } SEAM(pb + 2);
        if (IN(pb + 3)) { FT(); ph_dn_scan(args, lds, bid, G, tid); } SEAM(pb + 3);
        if (IN(pb + 4)) { FT(); ph_dn_out(args, l, gw, NGW, lane); } SEAM(pb + 4);
        if (IN(pb + 5)) {
            FT(); pg8::Gemm g{(const pg8::bf16_t*)(args.ws + WS_Y), (const pg8::bf16_t*)(args.ws + WS_WOUT) + (size_t)l * DM * DM, NT, DM, DM};
            pg8::StaticOrder S; S.init(NT, DM, G, bid);
            pg8::EpiResF32 E{Xin, X1, DM};
            pg8::gemm_phase<pg8::EpiResF32, pg8::StaticOrder, true, true>(lds, g, S, E);
        } SEAM(pb + 5);
        if (IN(pb + 6)) { FT(); ph_router(args, l, X1, lds, bid, G, tid, wave, lane); } SEAM(pb + 6);
        if (IN(pb + 7)) { FT(); ph_gather(args, l, lds, gw, NGW, tid, lane); } SEAM(pb + 7);
        if (IN(pb + 8)) {
            FT(); LAS int* TS = (LAS int*)(lds + TS_OFF); LAS int* TE = (LAS int*)(lds + TE_OFF);
            build_tiles((const unsigned*)(args.ws + WS_CTL) + CW_CNT + 64 * l, TS, TE, tid);
            const int ntiles = __builtin_amdgcn_readfirstlane(TS[NE]);
            pg8::Gemm g{(const pg8::bf16_t*)(args.ws + WS_XS), (const pg8::bf16_t*)(args.ws + WS_WGU) + (size_t)l * NE * 2048 * DM, ntiles * 256, NE * 2048, DM};
            pg8::MoeOrder<8> S{ntiles * 8, G, bid, (const LAS int*)TE};
            pg8::EpiSwiglu E{(pg8::bf16_t*)(args.ws + WS_ACT), args.in[21] + (size_t)l * NE * 2048};
            pg8::gemm_phase<pg8::EpiSwiglu, pg8::MoeOrder<8>, true, true>(lds, g, S, E);
        } SEAM(pb + 8);
        if (IN(pb + 9)) {
            FT(); LAS int* TS = (LAS int*)(lds + TS_OFF); LAS int* TE = (LAS int*)(lds + TE_OFF);
            build_tiles((const unsigned*)(args.ws + WS_CTL) + CW_CNT + 64 * l, TS, TE, tid);
            const int ntiles = __builtin_amdgcn_readfirstlane(TS[NE]);
            pg8::Gemm g{(const pg8::bf16_t*)(args.ws + WS_ACT), (const pg8::bf16_t*)(args.ws + WS_WD) + (size_t)l * NE * DM * DM, ntiles * 256, NE * DM, DM};
            pg8::MoeOrder<4> S{ntiles * 4, G, bid, (const LAS int*)TE};
            pg8::EpiDown E{(pg8::bf16_t*)(args.ws + WS_YS), args.in[23] + (size_t)l * NE * DM};
            pg8::gemm_phase<pg8::EpiDown, pg8::MoeOrder<4>, true, true>(lds, g, S, E);
        } SEAM(pb + 9);
        if (IN(pb + 10)) { FT(); ph_combine(args, X1, Xout, (l + 1 < NLAYER) ? args.in[1] + (size_t)(l + 1) * DM : nullptr, gw, NGW, lane); }
        if (l + 1 < NLAYER) SEAM(pb + 10);
    }

__global__ void __launch_bounds__(NTHR, 2) fwd_kernel(Args args_k) {
    extern __shared__ __attribute__((aligned(16))) unsigned char lds_raw[];
    LAS unsigned char* lds = (LAS unsigned char*)lds_raw;
    const int G = gridDim.x, bid = blockIdx.x, NGW = G * NWAVES;
    for (int u = threadIdx.x; u < (LDS_BYTES - LDSCTL_OFF) / 4; u += NTHR) ((LAS unsigned*)(lds + LDSCTL_OFF))[u] = 0u;
    __syncthreads();
#if SINGLE_LAUNCH
    XcdBarrier bar = xcd_barrier_post((unsigned*)(args_k.ws + WS_CTL) + CW_BAR, (volatile LAS unsigned*)(lds + MISC_OFF) + 8);
#endif
    const int lo = args_k.ph_lo, hi = args_k.ph_hi;

    if (IN(0)) { FT(); ph_prologue(args, lds, gw, NGW, wave, lane); } SEAM(0);
    if (IN(1)) { FT(); ph_norm0(args, gw, NGW, lane); } SEAM(1);

    run_layer<0>(args_k, lds, lo, hi, G, bid, NGW BARARG);
    run_layer<1>(args_k, lds, lo, hi, G, bid, NGW BARARG);
#undef IN
#undef SEAM
}

extern "C" void kernel_launch(void* const* d_in, const int* in_sizes, int n_in, void* d_out, int out_size, void* d_ws, size_t ws_size, hipStream_t stream) {
    static int grid = 0;
    if (grid == 0) {
        if (n_in != 25 || in_sizes[0] != NT * DM || out_size != NT * DM || ws_size < WS_END) {
            fprintf(stderr, "kernel_launch: unexpected problem (n_in %d, in0 %d, out %d, ws %zu < %zu); nothing launched\n", n_in, n_in > 0 ? in_sizes[0] : -1, out_size, ws_size, (size_t)WS_END); grid = -1; return; }
        int dev = 0, cus = 0, per_cu = 0;
        if (hipGetDevice(&dev) != hipSuccess || hipDeviceGetAttribute(&cus, hipDeviceAttributeMultiprocessorCount, dev) != hipSuccess) { grid = -1; return; }
        if (hipFuncSetAttribute((const void*)fwd_kernel, hipFuncAttributeMaxDynamicSharedMemorySize, LDS_BYTES) != hipSuccess) { fprintf(stderr, "kernel_launch: hipFuncSetAttribute failed\n"); grid = -1; return; }
        if (hipOccupancyMaxActiveBlocksPerMultiprocessor(&per_cu, (const void*)fwd_kernel, NTHR, LDS_BYTES) != hipSuccess || per_cu < 1)
            fprintf(stderr, "kernel_launch: note: occupancy query reports %d workgroups per CU\n", per_cu);
        (void)hipGetLastError();
        grid = cus;
    }
    if (grid < 0) return;
    if (hipMemsetAsync((char*)d_ws + WS_CTL, 0, CTL_ZERO_BYTES, stream) != hipSuccess) { fprintf(stderr, "kernel_launch: memset failed\n"); return; }
    Args a{};
    for (int i = 0; i < 25; ++i) a.in[i] = (const float*)d_in[i];
    a.out = (float*)d_out; a.ws = (unsigned char*)d_ws;
#if SINGLE_LAUNCH
    a.ph_lo = 0; a.ph_hi = NPH;
    hipLaunchKernelGGL(fwd_kernel, dim3(grid), dim3(NTHR), LDS_BYTES, stream, a);
#else
    for (int ph = 0; ph < NPH; ++ph) { a.ph_lo = ph; a.ph_hi = ph + 1; hipLaunchKernelGGL(fwd_kernel, dim3(grid), dim3(NTHR), LDS_BYTES, stream, a); }
#endif
}
```

```cpp
#include <hip/hip_runtime.h>
#include <cstdio>
#include <cstdint>
#include <cstddef>
namespace pg8 {
#define PG8_LAS __attribute__((address_space(3)))
typedef unsigned short bf16_t;
typedef short bf16x8 __attribute__((ext_vector_type(8)));
typedef float f32x4 __attribute__((ext_vector_type(4)));
typedef unsigned u32x4 __attribute__((ext_vector_type(4)));
constexpr int BM = 256, BK = 64, HALF = 128, HTB = HALF * BK * 2  , STAGE_BYTES = 8 * HTB, NXCD = 8, WGM = 8;

__host__ __device__ __forceinline__ int lds_byte(int r, int c) { const int st = (r >> 4) * 2 + (c >> 5), rr = r & 15, cc = c & 31, ob = rr * 64 + cc * 2; return st * 1024 + (ob ^ (((ob >> 9) & 1) << 5)); }
__host__ __device__ __forceinline__ void stage_rc(int b, int& R, int& C) { const int st = b / 1024, sb = b % 1024, swz = sb ^ (((sb >> 9) & 1) << 5); R = (st >> 1) * 16 + swz / 64; C = (st & 1) * 32 + (swz % 64) / 2; }
__host__ __device__ __forceinline__ int perm32(int rho) { const int n = rho >> 4, i = rho & 15; return 8 * (i >> 2) + 4 * n + (i & 3); }

struct Unit { int pm, pn; };
struct Gemm { const bf16_t* A; const bf16_t* Bt; int M, N, K; };

struct StaticOrder {
    int nM, nN, nwg, G, c;
    __host__ __device__ void init(int M, int N, int G_, int c_) { nM = M / BM; nN = N / BM; nwg = nM * nN; G = G_; c = c_; }
    __host__ __device__ bool next(int i, Unit& u) const {
        const long L = (long)i * G + c; if (L >= nwg) return false;
        int wgid = (int)L; { const int q = nwg / NXCD, r = nwg % NXCD, xcd = wgid % NXCD, off = wgid / NXCD; wgid = (xcd < r ? xcd * (q + 1) : r * (q + 1) + (xcd - r) * q) + off; }
        const int nig = WGM * nN, gid = wgid / nig, fm = gid * WGM, gsz = (nM - fm) < WGM ? (nM - fm) : WGM;
        u.pm = fm + ((wgid % nig) % gsz); u.pn = (wgid % nig) / gsz; return true;
    }
    __device__ __forceinline__ void a_ready(const Unit&) const {}
    __device__ __forceinline__ void done(const Unit&) const {}
};

__device__ __forceinline__ unsigned cvt_pk_bf16(float lo, float hi) { unsigned r; asm volatile("v_cvt_pk_bf16_f32 %0, %1, %2" : "=v"(r) : "v"(lo), "v"(hi)); return r; }

struct EpiBf16Plain {
    static constexpr bool PERM = true, AFTER_DRAIN = false;
    bf16_t* O; int ldc;
    __device__ __forceinline__ void operator()(const f32x4 (&acc)[2][2][4][2], const Unit& u, int wr, int wc, int fr, int fq) const {
        const int row0 = u.pm * BM + wr * 64 + fr, col0 = u.pn * BM + wc * 32 + 8 * fq;
#pragma unroll
        for (int ai = 0; ai < 2; ++ai)
#pragma unroll
            for (int m = 0; m < 4; ++m) { bf16_t* rowp = O + (size_t)(row0 + ai * HALF + m * 16) * ldc + col0;
#pragma unroll
                for (int bj = 0; bj < 2; ++bj) { const f32x4 v0 = acc[ai][bj][m][0], v1 = acc[ai][bj][m][1];
                    u32x4 w; w.x = cvt_pk_bf16(v0[0], v0[1]); w.y = cvt_pk_bf16(v0[2], v0[3]); w.z = cvt_pk_bf16(v1[0], v1[1]); w.w = cvt_pk_bf16(v1[2], v1[3]);
                    *(u32x4*)(rowp + bj * HALF) = w; } }
    }
};
struct EpiResF32 {
    static constexpr bool PERM = false, AFTER_DRAIN = false;
    const float* base; float* out; int ldc;
    __device__ __forceinline__ void operator()(const f32x4 (&acc)[2][2][4][2], const Unit& u, int wr, int wc, int fr, int fq) const {
        const int row0 = u.pm * BM + wr * 64 + fr, col0 = u.pn * BM + wc * 32 + 4 * fq;
#pragma unroll
        for (int ai = 0; ai < 2; ++ai)
#pragma unroll
            for (int m = 0; m < 4; ++m) { const size_t off = (size_t)(row0 + ai * HALF + m * 16) * ldc + col0;
#pragma unroll
                for (int bj = 0; bj < 2; ++bj)
#pragma unroll
                    for (int n = 0; n < 2; ++n) { const f32x4 b = *(const f32x4*)(base + off + bj * HALF + n * 16); *(f32x4*)(out + off + bj * HALF + n * 16) = b + acc[ai][bj][m][n]; } }
    }
};
struct EpiSwiglu {
    static constexpr bool PERM = true, AFTER_DRAIN = false;
    bf16_t* O; const float* bgu;
    __device__ __forceinline__ void operator()(const f32x4 (&acc)[2][2][4][2], const Unit& u, int wr, int wc, int fr, int fq) const {
        const int e = u.pn >> 3, pnl = u.pn & 7;
        const int row0 = u.pm * BM + wr * 64 + fr, gcol = pnl * 128 + wc * 32 + 8 * fq;
        const float* bg = bgu + (size_t)e * 2048 + gcol;
        f32x4 bgv[2], buv[2];
#pragma unroll
        for (int n = 0; n < 2; ++n) { bgv[n] = *(const f32x4*)(bg + 4 * n); buv[n] = *(const f32x4*)(bg + 1024 + 4 * n); }
#pragma unroll
        for (int ai = 0; ai < 2; ++ai)
#pragma unroll
            for (int m = 0; m < 4; ++m) { bf16_t* rowp = O + (size_t)(row0 + ai * HALF + m * 16) * 1024 + gcol;
                float r[8];
#pragma unroll
                for (int n = 0; n < 2; ++n) { const f32x4 gv = acc[ai][0][m][n] + bgv[n], uv = acc[ai][1][m][n] + buv[n];
#pragma unroll
                    for (int j = 0; j < 4; ++j) { const float g = fminf(gv[j], 7.0f), up = fminf(fmaxf(uv[j], -7.0f), 7.0f);
                        const float sg = __builtin_amdgcn_rcpf(1.0f + __expf(-1.702f * g)); r[n * 4 + j] = (up + 1.0f) * g * sg; } }
                u32x4 w; w.x = cvt_pk_bf16(r[0], r[1]); w.y = cvt_pk_bf16(r[2], r[3]); w.z = cvt_pk_bf16(r[4], r[5]); w.w = cvt_pk_bf16(r[6], r[7]);
                *(u32x4*)rowp = w; }
    }
};
struct EpiDown {
    static constexpr bool PERM = true, AFTER_DRAIN = false;
    bf16_t* O; const float* bd;
    __device__ __forceinline__ void operator()(const f32x4 (&acc)[2][2][4][2], const Unit& u, int wr, int wc, int fr, int fq) const {
        const int e = u.pn >> 2, pnl = u.pn & 3;
        const int row0 = u.pm * BM + wr * 64 + fr, col0 = pnl * BM + wc * 32 + 8 * fq;
        const float* bp = bd + (size_t)e * 1024 + col0;
        f32x4 bv[2][2];
#pragma unroll
        for (int bj = 0; bj < 2; ++bj)
#pragma unroll
            for (int n = 0; n < 2; ++n) bv[bj][n] = *(const f32x4*)(bp + bj * HALF + 4 * n);
#pragma unroll
        for (int ai = 0; ai < 2; ++ai)
#pragma unroll
            for (int m = 0; m < 4; ++m) { bf16_t* rowp = O + (size_t)(row0 + ai * HALF + m * 16) * 1024 + col0;
#pragma unroll
                for (int bj = 0; bj < 2; ++bj) { const f32x4 v0 = acc[ai][bj][m][0] + bv[bj][0], v1 = acc[ai][bj][m][1] + bv[bj][1];
                    u32x4 w; w.x = cvt_pk_bf16(v0[0], v0[1]); w.y = cvt_pk_bf16(v0[2], v0[3]); w.z = cvt_pk_bf16(v1[0], v1[1]); w.w = cvt_pk_bf16(v1[2], v1[3]);
                    *(u32x4*)(rowp + bj * HALF) = w; } }
    }
};
template <int NPN> struct MoeOrder {
    int nunits, G, c; const PG8_LAS int* texp;
    __device__ __forceinline__ bool next(int i, Unit& u) const {
        const int L = __builtin_amdgcn_readfirstlane(i * G + c); if (L >= nunits) return false;
        const int mt = L / NPN, pn = L % NPN;
        const int e = __builtin_amdgcn_readfirstlane(texp[mt]);
        u.pm = mt; u.pn = e * NPN + pn; return true;
    }
    __device__ __forceinline__ void a_ready(const Unit&) const {}
    __device__ __forceinline__ void done(const Unit&) const {}
};

template <class Epi, class Sched, bool ALIGN_EPI = false, bool SP2 = false>
__device__ __forceinline__ void gemm_phase(PG8_LAS unsigned char* lds, const Gemm g, const Sched& S, const Epi& E) {
    int tid_ = threadIdx.x; asm volatile("" : "+v"(tid_));
    const int tid = tid_, wid = __builtin_amdgcn_readfirstlane(tid >> 6), lane = tid & 63, wr = wid >> 2, wc = wid & 3, fr = lane & 15, fq = lane >> 4;
    const int K = g.K, nt = K / BK;
    unsigned voffA[2], voffB[2];
#pragma unroll
    for (int i = 0; i < 2; ++i) { int R, C; stage_rc(tid * 16 + i * 8192, R, C); const int Rb = Epi::PERM ? ((R & ~31) + perm32(R & 31)) : R;
        voffA[i] = (unsigned)(R * K + C) * 2u; voffB[i] = (unsigned)(Rb * K + C) * 2u; }
    const size_t kstep = (size_t)(BK * 2);
    const size_t hstep = (size_t)HALF * K * 2;
    const size_t tstep = 2 * hstep;
    const unsigned ldsw = (unsigned)wid * 1024u;
    const int aoff = lds_byte(wr * 64 + fr, fq * 8), boff = lds_byte(wc * 32 + fr, fq * 8);
#define PG8_SA(b, h) (((b) * 2 + (h)) * HTB)
#define PG8_SB(b, h) ((4 + (b) * 2 + (h)) * HTB)
#define PG8_STAGE(bufoff, gbase, voff) do { _Pragma("unroll") for (int _i = 0; _i < 2; ++_i) \
        __builtin_amdgcn_global_load_lds((const unsigned*)((const char*)(gbase) + (voff)[_i]), (PG8_LAS unsigned*)(lds + (bufoff) + ldsw + _i * 8192), 16, 0, 0); } while (0)
#define PG8_LDA(dst, b, h) do { _Pragma("unroll") for (int m = 0; m < 4; ++m) _Pragma("unroll") for (int k = 0; k < 2; ++k) dst[m][k] = *(const PG8_LAS bf16x8*)(lds + PG8_SA(b, h) + aoff + m * 2048 + k * 1024); } while (0)
#define PG8_LDB(dst, b, h) do { _Pragma("unroll") for (int n = 0; n < 2; ++n) _Pragma("unroll") for (int k = 0; k < 2; ++k) dst[n][k] = *(const PG8_LAS bf16x8*)(lds + PG8_SB(b, h) + boff + n * 2048 + k * 1024); } while (0)
#define PG8_MMA(ai, bj, At, Bt) do { __builtin_amdgcn_s_setprio(1); _Pragma("unroll") for (int m = 0; m < 4; ++m) _Pragma("unroll") for (int n = 0; n < 2; ++n) _Pragma("unroll") for (int k = 0; k < 2; ++k) \
        acc[ai][bj][m][n] = __builtin_amdgcn_mfma_f32_16x16x32_bf16(Bt[n][k], At[m][k], acc[ai][bj][m][n], 0, 0, 0); __builtin_amdgcn_s_setprio(0); } while (0)
#define PG8_WAIT_V(n) asm volatile("s_waitcnt vmcnt(" #n ")" ::: "memory")
#define PG8_WAIT_L(n) asm volatile("s_waitcnt lgkmcnt(" #n ")" ::: "memory")
#define PG8_BAR __builtin_amdgcn_s_barrier()
#define PG8_SCHED __builtin_amdgcn_sched_barrier(0)
    Unit cur, nxt; int ui = 0;
    if (!S.next(0, cur)) return;
    f32x4 acc[2][2][4][2];
#pragma unroll
    for (int a = 0; a < 2; ++a)
#pragma unroll
        for (int b = 0; b < 2; ++b)
#pragma unroll
            for (int m = 0; m < 4; ++m)
#pragma unroll
                for (int n = 0; n < 2; ++n) acc[a][b][m][n] = (f32x4){0.f, 0.f, 0.f, 0.f};
    bf16x8 At[4][2], B0[2][2], B1[2][2];
    const char* cA = (const char*)g.A + (size_t)cur.pm * tstep; const char* cB = (const char*)g.Bt + (size_t)cur.pn * tstep;
    S.a_ready(cur);
    if constexpr (SP2) {
        PG8_STAGE(PG8_SB(0, 0), cB, voffB); PG8_STAGE(PG8_SB(0, 1), cB + hstep, voffB); PG8_STAGE(PG8_SA(0, 0), cA, voffA); PG8_STAGE(PG8_SA(0, 1), cA + hstep, voffA);
        if (wr == 1) PG8_BAR;
        PG8_WAIT_V(2); PG8_BAR;
        PG8_STAGE(PG8_SB(1, 0), cB + kstep, voffB); PG8_STAGE(PG8_SA(1, 0), cA + kstep, voffA); PG8_STAGE(PG8_SB(1, 1), cB + hstep + kstep, voffB);
        PG8_WAIT_V(6); PG8_BAR;
    } else {
        PG8_STAGE(PG8_SB(0, 0), cB, voffB); PG8_STAGE(PG8_SA(0, 0), cA, voffA); PG8_STAGE(PG8_SB(0, 1), cB + hstep, voffB); PG8_STAGE(PG8_SA(0, 1), cA + hstep, voffA);
        if (wr == 1) PG8_BAR;
        PG8_WAIT_V(4); PG8_BAR;
        PG8_STAGE(PG8_SB(1, 0), cB + kstep, voffB); PG8_STAGE(PG8_SA(1, 0), cA + kstep, voffA); PG8_STAGE(PG8_SB(1, 1), cB + hstep + kstep, voffB);
        PG8_WAIT_V(6); PG8_BAR;
    }
    for (;;) {
        const bool has_next = S.next(ui + 1, nxt);
        const char* nA = has_next ? (const char*)g.A + (size_t)nxt.pm * tstep : cA; const char* nB = has_next ? (const char*)g.Bt + (size_t)nxt.pn * tstep : cB;
        for (int t = 0; t < nt; t += 2) {
            const bool last = (t == nt - 2);
            const char* a1 = cA + (size_t)(t + 1) * kstep;
            const char* a2 = last ? nA : cA + (size_t)(t + 2) * kstep; const char* b2 = last ? nB : cB + (size_t)(t + 2) * kstep;
            const char* a3 = a2 + kstep; const char* b3 = b2 + kstep;
            if (last && has_next) S.a_ready(nxt);
            if constexpr (SP2) {
            PG8_LDB(B0, 0, 0); PG8_LDB(B1, 0, 1); PG8_SCHED; PG8_LDA(At, 0, 0); PG8_STAGE(PG8_SA(1, 1), a1 + hstep, voffA);
            PG8_WAIT_V(8); PG8_WAIT_L(0); PG8_BAR; PG8_MMA(0, 0, At, B0); PG8_MMA(0, 1, At, B1); PG8_BAR; PG8_SCHED;
            PG8_LDA(At, 0, 1); PG8_STAGE(PG8_SB(0, 0), b2, voffB); PG8_STAGE(PG8_SB(0, 1), b2 + hstep, voffB); PG8_STAGE(PG8_SA(0, 0), a2, voffA);
            PG8_WAIT_V(8); PG8_WAIT_L(0); PG8_BAR; PG8_MMA(1, 0, At, B0); PG8_MMA(1, 1, At, B1); PG8_BAR; PG8_SCHED;
            PG8_LDB(B0, 1, 0); PG8_LDB(B1, 1, 1); PG8_SCHED; PG8_LDA(At, 1, 0); PG8_STAGE(PG8_SA(0, 1), a2 + hstep, voffA);
            PG8_WAIT_V(8); PG8_WAIT_L(0); PG8_BAR; PG8_MMA(0, 0, At, B0); PG8_MMA(0, 1, At, B1); PG8_BAR; PG8_SCHED;
            PG8_LDA(At, 1, 1); PG8_STAGE(PG8_SB(1, 0), b3, voffB); PG8_STAGE(PG8_SB(1, 1), b3 + hstep, voffB); PG8_STAGE(PG8_SA(1, 0), a3, voffA);
            PG8_WAIT_V(8); PG8_WAIT_L(0); PG8_BAR; PG8_MMA(1, 0, At, B0); PG8_MMA(1, 1, At, B1); PG8_BAR; PG8_SCHED;
            } else {
            PG8_LDB(B0, 0, 0); PG8_SCHED; PG8_LDA(At, 0, 0); PG8_STAGE(PG8_SA(1, 1), a1 + hstep, voffA);
            PG8_WAIT_L(8); PG8_BAR; PG8_WAIT_L(0); PG8_MMA(0, 0, At, B0); PG8_BAR; PG8_SCHED;
            PG8_LDB(B1, 0, 1); PG8_STAGE(PG8_SB(0, 0), b2, voffB);
            PG8_BAR; PG8_WAIT_L(0); PG8_MMA(0, 1, At, B1); PG8_BAR;
            PG8_LDA(At, 0, 1); PG8_STAGE(PG8_SA(0, 0), a2, voffA);
            PG8_BAR; PG8_WAIT_L(0); PG8_MMA(1, 0, At, B0); PG8_BAR; PG8_SCHED;
            PG8_STAGE(PG8_SB(0, 1), b2 + hstep, voffB);
            PG8_WAIT_V(6); PG8_BAR; PG8_MMA(1, 1, At, B1); PG8_BAR;
            PG8_LDB(B0, 1, 0); PG8_SCHED; PG8_LDA(At, 1, 0); PG8_STAGE(PG8_SA(0, 1), a2 + hstep, voffA);
            PG8_WAIT_L(8); PG8_BAR; PG8_WAIT_L(0); PG8_MMA(0, 0, At, B0); PG8_BAR; PG8_SCHED;
            PG8_LDB(B1, 1, 1); PG8_STAGE(PG8_SB(1, 0), b3, voffB);
            PG8_BAR; PG8_WAIT_L(0); PG8_MMA(0, 1, At, B1); PG8_BAR;
            PG8_LDA(At, 1, 1); PG8_STAGE(PG8_SA(1, 0), a3, voffA);
            PG8_BAR; PG8_WAIT_L(0); PG8_MMA(1, 0, At, B0); PG8_BAR; PG8_SCHED;
            PG8_STAGE(PG8_SB(1, 1), b3 + hstep, voffB);
            PG8_WAIT_V(6); PG8_BAR; PG8_MMA(1, 1, At, B1); PG8_BAR;
            }
        }
        if constexpr (ALIGN_EPI) { if (wr == 0) PG8_BAR; }
        if constexpr (!Epi::AFTER_DRAIN) { E(acc, cur, wr, wc, fr, fq); S.done(cur); }
        if (!has_next) break;
#pragma unroll
        for (int a = 0; a < 2; ++a)
#pragma unroll
            for (int b = 0; b < 2; ++b)
#pragma unroll
                for (int m = 0; m < 4; ++m)
#pragma unroll
                    for (int n = 0; n < 2; ++n) acc[a][b][m][n] = (f32x4){0.f, 0.f, 0.f, 0.f};
        cur = nxt; cA = nA; cB = nB; ++ui;
        if constexpr (ALIGN_EPI) { if (wr == 1) PG8_BAR; }
    }
    PG8_WAIT_V(0);
    if constexpr (!ALIGN_EPI) { if (wr == 0) PG8_BAR; }
    PG8_BAR;
    if constexpr (Epi::AFTER_DRAIN) { E.fused(acc, cur, wr, wc, fr, fq, lds, wid, lane); S.done(cur); }
#undef PG8_SA
#undef PG8_SB
#undef PG8_STAGE
#undef PG8_LDA
#undef PG8_LDB
#undef PG8_MMA
#undef PG8_WAIT_V
#undef PG8_WAIT_L
#undef PG8_BAR
#undef PG8_SCHED
}
}


#define GAS __attribute__((address_space(1)))
typedef unsigned short bf16;
typedef float f32x4 __attribute__((ext_vector_type(4)));
typedef unsigned u32x4 __attribute__((ext_vector_type(4)));
typedef unsigned u32x2 __attribute__((ext_vector_type(2)));

#ifndef SINGLE_LAUNCH
#define SINGLE_LAUNCH 1
#endif

constexpr int NB = 8, SEQ = 2048, DM = 1024, NT = NB * SEQ, NLAYER = 2;
constexpr int DIN = 3220, NP = 3328;
constexpr int C_Q = 0, C_K = 512, C_V = 1024, C_Z = 1536, C_NQ = 2048, C_KV = 2304, C_CU = 2688, C_A = 3200, C_B = 3204, C_G = 3208;
constexpr int NE = 32, MAXT = 288;
constexpr int NWAVES = 8, NTHR = 512;
constexpr float EPS = 1e-6f;

constexpr size_t MiB = 1u << 20;
constexpr size_t WS_CTL = 0, CTL_ZERO_BYTES = 1 * MiB;
constexpr size_t WS_BT = 1 * MiB;
constexpr size_t WS_KCMP = 1 * MiB + 256 * 1024, WS_VCMP = 1 * MiB + 512 * 1024;
constexpr size_t WS_G = 2 * MiB, WS_BETA = 2 * MiB + 256 * 1024, WS_GC = 2 * MiB + 512 * 1024;
constexpr size_t WS_EIDX = 3 * MiB, WS_EPOS = 3 * MiB + 256 * 1024, WS_EW = 3 * MiB + 512 * 1024, WS_SLOT = 3 * MiB + 768 * 1024;
constexpr size_t WS_WIN = 4 * MiB;
constexpr size_t WS_WOUT = 17 * MiB;
constexpr size_t WS_WGU = 22 * MiB;
constexpr size_t WS_WD = 278 * MiB;
constexpr size_t WS_XA = 406 * MiB, WS_XB = 470 * MiB;
constexpr size_t WS_XN = 534 * MiB;
constexpr size_t WS_P = 566 * MiB;
constexpr size_t WS_QN = 670 * MiB, WS_KN = 686 * MiB, WS_VC = 702 * MiB;
constexpr size_t WS_U = 718 * MiB, WS_W = 750 * MiB;
constexpr size_t WS_ATT = 782 * MiB;
constexpr size_t WS_O = 798 * MiB;
constexpr size_t WS_NQ = 830 * MiB;
constexpr size_t WS_KS = 846 * MiB, WS_KW = 848 * MiB;
constexpr size_t WS_Y = 850 * MiB;
constexpr size_t WS_XS = 882 * MiB, WS_ACT = 1026 * MiB, WS_YS = 1170 * MiB;
constexpr size_t WS_END = 1314 * MiB;

constexpr int CW_TMO = 0, CW_BAR = 4096, CW_CNT = 16384;

constexpr int RING_BYTES = 131072;
constexpr int LDSCTL_OFF = RING_BYTES, MISC_OFF = LDSCTL_OFF, TS_OFF = LDSCTL_OFF + 128, TE_OFF = LDSCTL_OFF + 320;
constexpr int LDS_BYTES = 147456;
static_assert(TE_OFF + MAXT * 4 + 64 <= LDS_BYTES, "LDS map");

#define XB_TMO      128
#define XB_XCNT(j)  (256  + 64 * (j))
#define XB_XSUB(j)  (1280 + 64 * (j))
#define XB_XGEN(j)  (2304 + 64 * (j))
#define XB_TOP      3328
#define XB_TOPGEN   3392
#define XCD_BAR_WORDS 3456
#define XB_SPIN_CAP (1u << 22)
#define LAS __attribute__((address_space(3)))

__device__ __forceinline__ unsigned xb_ld(unsigned* p)              { return __hip_atomic_load(p, __ATOMIC_RELAXED, __HIP_MEMORY_SCOPE_AGENT); }
__device__ __forceinline__ unsigned xb_add(unsigned* p, unsigned v) { return __hip_atomic_fetch_add(p, v, __ATOMIC_RELAXED, __HIP_MEMORY_SCOPE_AGENT); }
__device__ __forceinline__ unsigned xb_xcc_id() { return (unsigned)__builtin_amdgcn_s_getreg((3 << 11) | 20) & 0xFu; }
#define XB_SPIN(cond, bar) do { unsigned _sp = 0; while (cond) { __builtin_amdgcn_s_sleep(1); \
    if ((++_sp & 255u) == 0u) { if (xb_ld(&(bar)[XB_TMO])) break; if (_sp > XB_SPIN_CAP) { atomicAdd(&(bar)[XB_TMO], 1u); break; } } } } while (0)

struct XcdBarrier {
    unsigned* bar; unsigned x;
    volatile LAS unsigned* st;
};

__device__ __forceinline__ XcdBarrier xcd_barrier_post(unsigned* bar, volatile LAS unsigned* st) {
    XcdBarrier b; b.bar = bar; b.x = xb_xcc_id(); b.st = st;
    if (threadIdx.x == 0) (void)xb_add(&bar[XB_XCNT(b.x)], 1u);
    return b;
}
__device__ __forceinline__ void xcd_barrier_complete(unsigned* bar, unsigned x, unsigned& nloc, unsigned& nx) {
    const unsigned G = gridDim.x * gridDim.y * gridDim.z;
    unsigned sum, cnt, mine, sp = 0u;
    for (;;) {
        sum = 0u; cnt = 0u; mine = 0u;
#pragma unroll
        for (unsigned j = 0; j < 16; ++j) { const unsigned c = xb_ld(&bar[XB_XCNT(j)]); sum += c; cnt += (c > 0u) ? 1u : 0u; mine = (j == x) ? c : mine; }
        if (sum == G) break;
        __builtin_amdgcn_s_sleep(1);
        if ((++sp & 255u) == 0u) { if (xb_ld(&bar[XB_TMO])) break; if (sp > XB_SPIN_CAP) { atomicAdd(&bar[XB_TMO], 1u); break; } }
    }
    nloc = mine > 0u ? mine : 1u; nx = cnt > 0u ? cnt : 1u;
}

__device__ __forceinline__ void xcd_barrier(const XcdBarrier& b) {
    asm volatile("s_waitcnt vmcnt(0)" ::: "memory");
    __syncthreads();
    if (threadIdx.x == 0) {
        unsigned* bar = b.bar;
        __builtin_amdgcn_s_waitcnt(0);
        unsigned nloc = b.st[0], nx = b.st[1];
        if (nloc == 0u) { xcd_barrier_complete(bar, b.x, nloc, nx); b.st[0] = nloc; b.st[1] = nx; }
        const unsigned old = xb_add(&bar[XB_XSUB(b.x)], 1u);
        const unsigned gen = old / nloc;
        if (old + 1u == (gen + 1u) * nloc) {
            __builtin_amdgcn_fence(__ATOMIC_RELEASE, "agent");
            asm volatile("s_waitcnt vmcnt(0)" ::: "memory");
            const unsigned og = xb_add(&bar[XB_TOP], 1u);
            const unsigned tg = og / nx;
            if (og + 1u == (tg + 1u) * nx) xb_add(&bar[XB_TOPGEN], 1u);
            else XB_SPIN(xb_ld(&bar[XB_TOPGEN]) == tg, bar);
            __builtin_amdgcn_fence(__ATOMIC_ACQUIRE, "agent");
            xb_add(&bar[XB_XGEN(b.x)], 1u);
            asm volatile("s_waitcnt vmcnt(0)" ::: "memory");
        } else {
            XB_SPIN(xb_ld(&bar[XB_XGEN(b.x)]) == gen, bar);
            __builtin_amdgcn_fence(__ATOMIC_ACQUIRE, "agent");
            asm volatile("s_waitcnt vmcnt(0)" ::: "memory");
        }
    }
    __syncthreads();
}


__device__ __forceinline__ float bf_lo(unsigned w) { return __uint_as_float(w << 16); }
__device__ __forceinline__ float bf_hi(unsigned w) { return __uint_as_float(w & 0xffff0000u); }
__device__ __forceinline__ float bf2f(bf16 v) { return __uint_as_float(((unsigned)v) << 16); }
__device__ __forceinline__ unsigned f2bf(float f) { unsigned u = __float_as_uint(f); return (u + 0x7fffu + ((u >> 16) & 1u)) >> 16; }
__device__ __forceinline__ unsigned pk2(float lo, float hi) { return f2bf(lo) | (f2bf(hi) << 16); }
__device__ __forceinline__ float wave_sum(float v) {
#pragma unroll
    for (int o = 1; o < 64; o <<= 1) v += __shfl_xor(v, o);
    return v;
}
__device__ __forceinline__ float wave_max(float v) {
#pragma unroll
    for (int o = 1; o < 64; o <<= 1) v = fmaxf(v, __shfl_xor(v, o));
    return v;
}
__device__ __forceinline__ float sigmoidf_(float x) { return 1.0f / (1.0f + __expf(-x)); }
__device__ __forceinline__ float siluf_(float x) { return x / (1.0f + __expf(-x)); }
#define LDS_WAIT() asm volatile("s_waitcnt lgkmcnt(0)" ::: "memory")

struct Args { const float* in[25]; float* out; unsigned char* ws; int ph_lo, ph_hi; };

__device__ __forceinline__ int map_win(int n);
__device__ __forceinline__ int map_gu(int n);
template <int MAP>
__device__ __forceinline__ void transpose_item(const float* W, int K, int N, bf16* WT, LAS float* scr, int item, int nblk, int lane) {
    const int kb = item / nblk, nb = item % nblk, k0 = 64 * kb, n0 = 32 * nb;
    const int nd = n0 + (lane & 31); const int src = MAP == 1 ? map_win(nd) : (MAP == 2 ? map_gu(nd) : nd);
#pragma unroll 8
    for (int i = 0; i < 32; ++i) { const int kk = 2 * i + (lane >> 5); scr[kk * 33 + (lane & 31)] = src >= 0 ? W[(size_t)(k0 + kk) * N + src] : 0.0f; }
    LDS_WAIT();
    const int c = lane & 7;
#pragma unroll
    for (int j = 0; j < 4; ++j) { const int n = (lane >> 3) + 8 * j; const LAS float* s = scr + (8 * c) * 33 + n;
        u32x4 o; o.x = pk2(s[0 * 33], s[1 * 33]); o.y = pk2(s[2 * 33], s[3 * 33]); o.z = pk2(s[4 * 33], s[5 * 33]); o.w = pk2(s[6 * 33], s[7 * 33]);
        *(u32x4*)(WT + (size_t)(n0 + n) * K + k0 + 8 * c) = o; }
    LDS_WAIT();
}
__device__ __forceinline__ int map_win(int n) {
    if (n < 2048) return n;
    if (n < C_KV) return 2056 + (n - C_NQ);
    if (n < C_CU) return 2312 + (n - C_KV);
    if (n < C_A) return 2708 + (n - C_CU);
    if (n < C_B) return 2048 + (n - C_A);
    if (n < C_G) return 2052 + (n - C_B);
    if (n < C_G + 12) return 2696 + (n - C_G);
    return -1;
}
__device__ __forceinline__ int map_gu(int n) { const int pn = n >> 8, r = n & 255; return (r < 128 ? 0 : 1024) + 128 * pn + (r & 127); }

__device__ __forceinline__ void ph_prologue(const Args& a, LAS unsigned char* lds, int gw, int NGW, int wave, int lane) {
    LAS float* scr = (LAS float*)(lds + wave * 16384);
    bf16* WinT = (bf16*)(a.ws + WS_WIN); bf16* WoutT = (bf16*)(a.ws + WS_WOUT); bf16* WguT = (bf16*)(a.ws + WS_WGU); bf16* WdT = (bf16*)(a.ws + WS_WD);
    constexpr int I_IN = 16 * (NP / 32), I_OUT = 16 * 32, I_GU = 16 * 64, I_D = 16 * 32;
    constexpr int N_IN = NLAYER * I_IN, N_OUT = NLAYER * I_OUT, N_GU = NLAYER * NE * I_GU, N_D = NLAYER * NE * I_D;
    for (int it = gw; it < N_IN + N_OUT + N_GU + N_D; it += NGW) {
        int r = it;
        if (r < N_IN) { const int l = r / I_IN; transpose_item<1>(a.in[2] + (size_t)l * DM * DIN, DM, DIN, WinT + (size_t)l * NP * DM, scr, r % I_IN, NP / 32, lane); continue; } r -= N_IN;
        if (r < N_OUT) { const int l = r / I_OUT; transpose_item<0>(a.in[16] + (size_t)l * DM * DM, DM, DM, WoutT + (size_t)l * DM * DM, scr, r % I_OUT, 32, lane); continue; } r -= N_OUT;
        if (r < N_GU) { const int le = r / I_GU; transpose_item<2>(a.in[20] + (size_t)le * DM * 2048, DM, 2048, WguT + (size_t)le * 2048 * DM, scr, r % I_GU, 64, lane); continue; } r -= N_GU;
        { const int le = r / I_D; transpose_item<0>(a.in[22] + (size_t)le * DM * DM, DM, DM, WdT + (size_t)le * DM * DM, scr, r % I_D, 32, lane); }
    }
    float* BT = (float*)(a.ws + WS_BT);
    for (int i = gw * 64 + lane; i < 4 * 2048; i += NGW * 64) {
        const int h = i >> 11, n = i & 2047; int bk;
        if (n < 16) bk = n; else { const float v = logf((float)n / 16.0f) / 2.0794415416798357f * 16.0f; bk = 16 + (int)v; bk = bk < 31 ? bk : 31; }
        BT[i] = a.in[24][bk * 4 + h];
    }
}

__device__ __forceinline__ void rms_row_to_bf16(const f32x4 (&v)[4], const float* w, bf16* orow, int lane) {
    float s = 0.f;
#pragma unroll
    for (int j = 0; j < 4; ++j) s += (v[j].x * v[j].x + v[j].y * v[j].y) + (v[j].z * v[j].z + v[j].w * v[j].w);
    const float r = rsqrtf(wave_sum(s) * (1.0f / DM) + EPS);
#pragma unroll
    for (int j = 0; j < 4; ++j) { const f32x4 wv = *(const f32x4*)(w + 4 * (64 * j + lane)); const f32x4 y = v[j] * r * wv;
        u32x2 o; o.x = pk2(y.x, y.y); o.y = pk2(y.z, y.w); *(u32x2*)(orow + 4 * (64 * j + lane)) = o; }
}

__device__ __forceinline__ void ph_norm0(const Args& a, int gw, int NGW, int lane) {
    bf16* XN = (bf16*)(a.ws + WS_XN);
    for (int tok = gw; tok < NT; tok += NGW) {
        f32x4 v[4];
#pragma unroll
        for (int j = 0; j < 4; ++j) v[j] = *(const f32x4*)(a.in[0] + (size_t)tok * DM + 4 * (64 * j + lane));
        rms_row_to_bf16(v, a.in[1], XN + (size_t)tok * DM, lane);
    }
}

__device__ __forceinline__ void ph_m1(const Args& a, int l, LAS unsigned char* lds, int bid, int G, int tid, int wave, int lane) {
    const bf16* P = (const bf16*)(a.ws + WS_P);
    {
        LAS float* xin = (LAS float*)lds; LAS float* posl = (LAS float*)(lds + 36864); LAS float* hid = (LAS float*)(lds + 45056);
        bf16* KCMP = (bf16*)(a.ws + WS_KCMP); bf16* VCMP = (bf16*)(a.ws + WS_VCMP);
        for (int u = bid; u < 256; u += G) {
            const int b = u >> 5, kv = (u >> 4) & 1, jg = u & 15;
            for (int idx = tid; idx < 144 * 64; idx += NTHR) { const int tk = idx >> 6, d = idx & 63; int tkk = 128 * jg + tk; tkk = tkk < SEQ ? tkk : SEQ - 1;
                xin[idx] = bf2f(P[(size_t)(b * SEQ + tkk) * NP + C_KV + kv * 64 + d]); }
            for (int idx = tid; idx < 2048; idx += NTHR) posl[idx] = a.in[9][(size_t)(l * 2 + kv) * 2048 + idx];
            __syncthreads();
            const int n = tid & 127, rg = tid >> 7, j0 = 2 * rg;
            const float* w1 = a.in[10] + (size_t)(l * 2 + kv) * 2048 * 128;
            float acc0 = 0.f, acc1 = 0.f;
            for (int kidx = 0; kidx < 2048; ++kidx) { const int lq = kidx >> 6, d = kidx & 63; const float wv = w1[(size_t)kidx * 128 + n], pz = posl[kidx];
                acc0 += (xin[(16 * j0 + lq) * 64 + d] + pz) * wv; acc1 += (xin[(16 * (j0 + 1) + lq) * 64 + d] + pz) * wv; }
            hid[j0 * 128 + n] = siluf_(acc0); hid[(j0 + 1) * 128 + n] = siluf_(acc1);
            __syncthreads();
            const float* w2 = a.in[11] + (size_t)(l * 2 + kv) * 128 * 64;
            float o = 0.f;
            for (int nn = 0; nn < 128; ++nn) o += hid[wave * 128 + nn] * w2[nn * 64 + lane];
            if (kv == 0) { const float ss = wave_sum(o * o); o = o * rsqrtf(ss * (1.0f / 64.0f) + EPS) * a.in[8][l * 192 + lane]; }
            const int j = 8 * jg + wave;
            (kv ? VCMP : KCMP)[(size_t)(b * 128 + j) * 64 + lane] = (j < 127) ? (bf16)f2bf(o) : (bf16)0;
            __syncthreads();
        }
    }
    const int gw = bid * NWAVES + wave, NGW = G * NWAVES;
    bf16* QN = (bf16*)(a.ws + WS_QN); bf16* KN = (bf16*)(a.ws + WS_KN); bf16* VC = (bf16*)(a.ws + WS_VC);
    float* Gb = (float*)(a.ws + WS_G); float* BETA = (float*)(a.ws + WS_BETA);
    bf16* NQ = (bf16*)(a.ws + WS_NQ); bf16* KS = (bf16*)(a.ws + WS_KS); bf16* KW = (bf16*)(a.ws + WS_KW); bf16* Y = (bf16*)(a.ws + WS_Y);
    const float* convw = a.in[3] + (size_t)l * 4 * 1536; const float* a_log = a.in[4] + l * 4; const float* dt_bias = a.in[5] + l * 4;
    const float* qnw = a.in[7] + l * 64; const float* knw = a.in[8] + l * 192;
    const float* dww = a.in[12] + (size_t)l * 31 * 256; const float* dwb = a.in[13] + l * 256; const float* lnw = a.in[14] + l * 256; const float* lnb = a.in[15] + l * 256;
    for (int tok = gw; tok < NT; tok += NGW) {
        const int t = tok & (SEQ - 1); const bf16* prow = P + (size_t)tok * NP;
#pragma unroll
        for (int ten = 0; ten < 3; ++ten)
#pragma unroll
            for (int h = 0; h < 4; ++h) { const int cb = ten * 512 + h * 128 + 2 * lane; float a0 = 0.f, a1 = 0.f;
#pragma unroll
                for (int j = 0; j < 4; ++j) if (t - 3 + j >= 0) { const unsigned w = *(const unsigned*)(prow + (ptrdiff_t)(j - 3) * NP + cb);
                    a0 += convw[j * 1536 + cb] * bf_lo(w); a1 += convw[j * 1536 + cb + 1] * bf_hi(w); }
                float y0 = siluf_(a0), y1 = siluf_(a1);
                if (ten < 2) { const float ss = wave_sum(y0 * y0 + y1 * y1); const float sc = rsqrtf(ss + EPS) * (ten == 0 ? 0.08838834764831845f : 1.0f); y0 *= sc; y1 *= sc; }
                bf16* dst = ten == 0 ? QN : (ten == 1 ? KN : VC);
                *(unsigned*)(dst + (size_t)tok * 512 + h * 128 + 2 * lane) = pk2(y0, y1); }
        if (lane < 4) { const float av = bf2f(prow[C_A + lane]), bv = bf2f(prow[C_B + lane]);
            BETA[(size_t)tok * 4 + lane] = sigmoidf_(bv);
            const float x = av + dt_bias[lane]; const float sp = x > 20.0f ? x : log1pf(expf(x));
            Gb[(size_t)tok * 4 + lane] = -expf(a_log[lane]) * sp; }
#pragma unroll
        for (int h = 0; h < 4; ++h) { const float x = bf2f(prow[C_NQ + h * 64 + lane]); const float ss = wave_sum(x * x);
            NQ[(size_t)tok * 256 + h * 64 + lane] = (bf16)f2bf(x * rsqrtf(ss * (1.0f / 64.0f) + EPS) * qnw[lane] * 0.125f); }
        { const float x = bf2f(prow[C_KV + 128 + lane]); const float ss = wave_sum(x * x); KS[(size_t)tok * 64 + lane] = (bf16)f2bf(x * rsqrtf(ss * (1.0f / 64.0f) + EPS) * knw[64 + lane]); }
        { const float x = bf2f(prow[C_KV + 256 + lane]); const float ss = wave_sum(x * x); KW[(size_t)tok * 64 + lane] = (bf16)f2bf(x * rsqrtf(ss * (1.0f / 64.0f) + EPS) * knw[128 + lane]); }
        { const int c = 4 * lane; f32x4 acc = *(const f32x4*)(dwb + c);
            for (int j = 0; j < 31; ++j) if (t - 30 + j >= 0) { const bf16* pr = prow + (ptrdiff_t)(j - 30) * NP + C_CU + c;
                const u32x2 av = *(const u32x2*)pr, gv = *(const u32x2*)(pr + 256); const f32x4 w = *(const f32x4*)(dww + j * 256 + c);
                acc.x += w.x * bf_lo(av.x) * sigmoidf_(bf_lo(gv.x)); acc.y += w.y * bf_hi(av.x) * sigmoidf_(bf_hi(gv.x));
                acc.z += w.z * bf_lo(av.y) * sigmoidf_(bf_lo(gv.y)); acc.w += w.w * bf_hi(av.y) * sigmoidf_(bf_hi(gv.y)); }
            const float mean = wave_sum((acc.x + acc.y) + (acc.z + acc.w)) * (1.0f / 256.0f);
            const f32x4 d = acc - mean; const float var = wave_sum((d.x * d.x + d.y * d.y) + (d.z * d.z + d.w * d.w)) * (1.0f / 256.0f);
            const float r = rsqrtf(var + EPS); const f32x4 lw = *(const f32x4*)(lnw + c), lb = *(const f32x4*)(lnb + c);
            const f32x4 y = d * r * lw + lb;
            u32x2 o; o.x = pk2(siluf_(y.x), siluf_(y.y)); o.y = pk2(siluf_(y.z), siluf_(y.w));
            *(u32x2*)(Y + (size_t)tok * DM + 768 + c) = o; }
    }
}

__device__ __forceinline__ void ph_dn_chunk(const Args& a, LAS unsigned char* lds, int bid, int G, int tid, int wave, int lane) {
    LAS float* Kf = (LAS float*)lds;
    LAS float* QV = Kf + 64 * 129;
    LAS float* Lm = QV + 64 * 129;
    LAS float* Tm = Lm + 64 * 65;
    LAS float* gcl = Tm + 64 * 65; LAS float* betal = gcl + 64; LAS float* bkl = betal + 64;
    const bf16* QN = (const bf16*)(a.ws + WS_QN); const bf16* KN = (const bf16*)(a.ws + WS_KN); const bf16* VC = (const bf16*)(a.ws + WS_VC);
    const float* Gb = (const float*)(a.ws + WS_G); const float* BETA = (const float*)(a.ws + WS_BETA); float* GC = (float*)(a.ws + WS_GC);
    float* U = (float*)(a.ws + WS_U); float* W = (float*)(a.ws + WS_W); float* ATT = (float*)(a.ws + WS_ATT);
    for (int ci = bid; ci < 1024; ci += G) {
        const int n = ci & 31, h = (ci >> 5) & 3, b = ci >> 7; const int r0 = b * SEQ + n * 64;
        { const int row = tid >> 3, seg = tid & 7; const size_t go = (size_t)(r0 + row) * 512 + h * 128 + seg * 16;
            const u32x4 k0 = *(const u32x4*)(KN + go), k1 = *(const u32x4*)(KN + go + 8), q0 = *(const u32x4*)(QN + go), q1 = *(const u32x4*)(QN + go + 8);
            LAS float* kd = Kf + row * 129 + seg * 16; LAS float* qd = QV + row * 129 + seg * 16;
#pragma unroll
            for (int e = 0; e < 4; ++e) { kd[2 * e] = bf_lo(k0[e]); kd[2 * e + 1] = bf_hi(k0[e]); kd[8 + 2 * e] = bf_lo(k1[e]); kd[8 + 2 * e + 1] = bf_hi(k1[e]);
                qd[2 * e] = bf_lo(q0[e]); qd[2 * e + 1] = bf_hi(q0[e]); qd[8 + 2 * e] = bf_lo(q1[e]); qd[8 + 2 * e + 1] = bf_hi(q1[e]); } }
        if (wave == 0) { float g = Gb[(size_t)(r0 + lane) * 4 + h];
#pragma unroll
            for (int off = 1; off < 64; off <<= 1) { const float v = __shfl_up(g, off); if (lane >= off) g += v; }
            const float be = BETA[(size_t)(r0 + lane) * 4 + h];
            gcl[lane] = g; GC[(size_t)(r0 + lane) * 4 + h] = g; betal[lane] = be; bkl[lane] = be * __expf(g); }
        __syncthreads();
        { const int i = tid >> 3, jg = tid & 7; float kk[8], qk[8];
#pragma unroll
            for (int m = 0; m < 8; ++m) { kk[m] = 0.f; qk[m] = 0.f; }
            for (int c = 0; c < 128; ++c) { const float ak = Kf[i * 129 + c], aq = QV[i * 129 + c];
#pragma unroll
                for (int m = 0; m < 8; ++m) { const float kj = Kf[(jg + 8 * m) * 129 + c]; kk[m] += ak * kj; qk[m] += aq * kj; } }
            const float gi = gcl[i], bi = betal[i];
#pragma unroll
            for (int m = 0; m < 8; ++m) { const int j = jg + 8 * m; const float dec = (j <= i) ? __expf(gi - gcl[j]) : 0.f;
                Lm[i * 65 + j] = (j < i) ? bi * kk[m] * dec : 0.f;
                ATT[(size_t)ci * 4096 + i * 64 + j] = (j <= i) ? qk[m] * dec : 0.f; } }
        __syncthreads();
        if (wave == 0) {
            for (int i = 0; i < 64; ++i) { float acc = (i == lane) ? 1.f : 0.f;
                for (int j = 0; j < i; ++j) acc -= Lm[i * 65 + j] * Tm[j * 65 + lane];
                Tm[i * 65 + lane] = acc; }
        } else {
            for (int e = tid - 64; e < 512; e += 448) { const int row = e >> 3, seg = e & 7; const size_t go = (size_t)(r0 + row) * 512 + h * 128 + seg * 16;
                const u32x4 v0 = *(const u32x4*)(VC + go), v1 = *(const u32x4*)(VC + go + 8); LAS float* vd = QV + row * 129 + seg * 16;
#pragma unroll
                for (int q = 0; q < 4; ++q) { vd[2 * q] = bf_lo(v0[q]); vd[2 * q + 1] = bf_hi(v0[q]); vd[8 + 2 * q] = bf_lo(v1[q]); vd[8 + 2 * q + 1] = bf_hi(v1[q]); } }
        }
        __syncthreads();
        { const int c = tid & 127, part = (tid >> 7) & 1, rg = tid >> 8; float acc[32];
#pragma unroll
            for (int ii = 0; ii < 32; ++ii) acc[ii] = 0.f;
            for (int j = 0; j < 64; ++j) { const float x = part ? Kf[j * 129 + c] * bkl[j] : QV[j * 129 + c] * betal[j];
#pragma unroll
                for (int ii = 0; ii < 32; ++ii) acc[ii] += Tm[(rg * 32 + ii) * 65 + j] * x; }
            float* dst = part ? W : U;
#pragma unroll
            for (int ii = 0; ii < 32; ++ii) dst[(size_t)(r0 + rg * 32 + ii) * 512 + h * 128 + c] = acc[ii]; }
        __syncthreads();
    }
}

__device__ __forceinline__ void ph_dn_scan(const Args& a, LAS unsigned char* lds, int bid, int G, int tid) {
    LAS float* Sl = (LAS float*)lds;
    LAS float* Wl = Sl + 128 * 16;
    LAS unsigned* Ql = (LAS unsigned*)(Wl + 64 * 129);
    LAS unsigned* Kl = Ql + 64 * 65;
    LAS float* Al = (LAS float*)(Kl + 64 * 65);
    LAS float* UL = Al + 64 * 65;
    LAS float* VN = UL + 64 * 16;
    LAS float* gcl = VN + 64 * 17; LAS float* dkl = gcl + 64; LAS float* egl = dkl + 64;
    const bf16* QN = (const bf16*)(a.ws + WS_QN); const bf16* KN = (const bf16*)(a.ws + WS_KN);
    const float* GC = (const float*)(a.ws + WS_GC); const float* U = (const float*)(a.ws + WS_U); const float* W = (const float*)(a.ws + WS_W);
    const float* ATT = (const float*)(a.ws + WS_ATT); float* O = (float*)(a.ws + WS_O);
    for (int u = bid; u < 256; u += G) {
        const int s = u & 7, h = (u >> 3) & 3, b = u >> 5;
        for (int i = tid; i < 128 * 16; i += NTHR) Sl[i] = 0.f;
        __syncthreads();
        const int c = tid & 15, i0 = tid >> 4;
        for (int n = 0; n < 32; ++n) {
            const int r0 = b * SEQ + n * 64, ci = (b * 4 + h) * 32 + n;
            { const int row = tid >> 3, seg = tid & 7; const size_t go = (size_t)(r0 + row) * 512 + h * 128 + seg * 16;
#pragma unroll
                for (int q = 0; q < 4; ++q) { const f32x4 wv = *(const f32x4*)(W + go + 4 * q); LAS float* wd = Wl + row * 129 + seg * 16 + 4 * q; wd[0] = wv.x; wd[1] = wv.y; wd[2] = wv.z; wd[3] = wv.w; }
                const u32x4 q0 = *(const u32x4*)(QN + go), q1 = *(const u32x4*)(QN + go + 8), k0 = *(const u32x4*)(KN + go), k1 = *(const u32x4*)(KN + go + 8);
                LAS unsigned* qd = Ql + row * 65 + seg * 8; LAS unsigned* kd = Kl + row * 65 + seg * 8;
#pragma unroll
                for (int q = 0; q < 4; ++q) { qd[q] = q0[q]; qd[4 + q] = q1[q]; kd[q] = k0[q]; kd[4 + q] = k1[q]; }
                const int idx = tid * 8, ar = idx >> 6, ac = idx & 63;
                const f32x4 a0 = *(const f32x4*)(ATT + (size_t)ci * 4096 + idx), a1 = *(const f32x4*)(ATT + (size_t)ci * 4096 + idx + 4);
                LAS float* ad = Al + ar * 65 + ac; ad[0] = a0.x; ad[1] = a0.y; ad[2] = a0.z; ad[3] = a0.w; ad[4] = a1.x; ad[5] = a1.y; ad[6] = a1.z; ad[7] = a1.w;
#pragma unroll
                for (int rr = 0; rr < 2; ++rr) { const int i = i0 + 32 * rr; UL[i * 16 + c] = U[(size_t)(r0 + i) * 512 + h * 128 + s * 16 + c]; }
                if (tid < 64) gcl[tid] = GC[(size_t)(r0 + tid) * 4 + h]; }
            __syncthreads();
            if (tid < 64) { const float gl = gcl[63], gi = gcl[tid]; dkl[tid] = __expf(gl - gi); egl[tid] = __expf(gi); }
#pragma unroll
            for (int rr = 0; rr < 2; ++rr) { const int i = i0 + 32 * rr; float acc = UL[i * 16 + c];
                for (int k = 0; k < 128; ++k) acc -= Wl[i * 129 + k] * Sl[k * 16 + c];
                VN[i * 17 + c] = acc; }
            __syncthreads();
#pragma unroll
            for (int rr = 0; rr < 2; ++rr) { const int i = i0 + 32 * rr; float acc = 0.f;
                for (int k2 = 0; k2 < 64; ++k2) { const unsigned qw = Ql[i * 65 + k2]; acc += bf_lo(qw) * Sl[(2 * k2) * 16 + c] + bf_hi(qw) * Sl[(2 * k2 + 1) * 16 + c]; }
                acc *= egl[i];
                for (int j = 0; j <= i; ++j) acc += Al[i * 65 + j] * VN[j * 17 + c];
                O[(size_t)(r0 + i) * 512 + h * 128 + s * 16 + c] = acc; }
            __syncthreads();
            { const float eg = __expf(gcl[63]);
#pragma unroll
                for (int m = 0; m < 4; ++m) { const int kk = i0 + 32 * m; float acc = Sl[kk * 16 + c] * eg;
                    for (int j = 0; j < 64; ++j) { const unsigned kw = Kl[j * 65 + (kk >> 1)]; const float kv = (kk & 1) ? bf_hi(kw) : bf_lo(kw); acc += kv * dkl[j] * VN[j * 17 + c]; }
                    Sl[kk * 16 + c] = acc; } }
            __syncthreads();
        }
    }
}

__device__ __forceinline__ void ph_dn_out(const Args& a, int l, int gw, int NGW, int lane) {
    const float* O = (const float*)(a.ws + WS_O); const bf16* P = (const bf16*)(a.ws + WS_P); bf16* Y = (bf16*)(a.ws + WS_Y);
    const float* nw = a.in[6] + l * 128;
    for (int tok = gw; tok < NT; tok += NGW) {
#pragma unroll
        for (int h = 0; h < 4; ++h) { const float o0 = O[(size_t)tok * 512 + h * 128 + 2 * lane], o1 = O[(size_t)tok * 512 + h * 128 + 2 * lane + 1];
            const float ss = wave_sum(o0 * o0 + o1 * o1); const float r = rsqrtf(ss * (1.0f / 128.0f) + EPS);
            const unsigned zw = *(const unsigned*)(P + (size_t)tok * NP + C_Z + h * 128 + 2 * lane);
            const float y0 = o0 * r * nw[2 * lane] * siluf_(bf_lo(zw)), y1 = o1 * r * nw[2 * lane + 1] * siluf_(bf_hi(zw));
            *(unsigned*)(Y + (size_t)tok * DM + h * 128 + 2 * lane) = pk2(y0, y1); }
    }
}

__device__ __forceinline__ void nsa_qk(const bf16* krow, const LAS float* qs, float (&s)[4]) {
#pragma unroll
    for (int h = 0; h < 4; ++h) s[h] = 0.f;
#pragma unroll 1
    for (int i = 0; i < 8; ++i) { const u32x4 kr = *(const u32x4*)(krow + 8 * i);
#pragma unroll
        for (int hf = 0; hf < 2; ++hf) { const float k0 = bf_lo(kr[2 * hf]), k1 = bf_hi(kr[2 * hf]), k2 = bf_lo(kr[2 * hf + 1]), k3 = bf_hi(kr[2 * hf + 1]);
#pragma unroll
            for (int h = 0; h < 4; ++h) { const f32x4 qv = *(const LAS f32x4*)(qs + h * 64 + i * 8 + hf * 4); s[h] += (qv.x * k0 + qv.y * k1) + (qv.z * k2 + qv.w * k3); } } }
}
__device__ __forceinline__ void nsa_pv(const float (&p)[4], LAS float* pw, const bf16* vbase, int vpitch, int kmax, int lane, float (&o)[4][2]) {
    *(LAS f32x4*)(pw + lane * 4) = (f32x4){p[0], p[1], p[2], p[3]};
    LDS_WAIT();
    const int dp = lane & 31, par = lane >> 5;
#pragma unroll 8
    for (int kk = 0; kk < 32; ++kk) { const int key = 2 * kk + par; const f32x4 pv = *(const LAS f32x4*)(pw + key * 4);
        const int row = key < kmax ? key : kmax; const unsigned vv = *(const unsigned*)(vbase + (size_t)row * vpitch + 2 * dp);
        const float v0 = bf_lo(vv), v1 = bf_hi(vv);
#pragma unroll
        for (int h = 0; h < 4; ++h) { o[h][0] += pv[h] * v0; o[h][1] += pv[h] * v1; } }
    LDS_WAIT();
}
__device__ __forceinline__ void nsa_tile(const bf16* krow, bool valid, int dist, const LAS float* qs, const LAS float* btl, LAS float* pw, const bf16* vbase, int vpitch, int lane,
                                         float (&m)[4], float (&lsum)[4], float (&o)[4][2]) {
    float s[4], p[4]; nsa_qk(krow, qs, s);
    const int dd = dist < 0 ? 0 : (dist > 2047 ? 2047 : dist);
#pragma unroll
    for (int h = 0; h < 4; ++h) { const float sv = valid ? s[h] + btl[h * 2048 + dd] : -1e30f; const float mn = fmaxf(m[h], wave_max(sv));
        const float corr = __expf(m[h] - mn); p[h] = valid ? __expf(sv - mn) : 0.f; lsum[h] = lsum[h] * corr + wave_sum(p[h]); o[h][0] *= corr; o[h][1] *= corr; m[h] = mn; }
    nsa_pv(p, pw, vbase, vpitch, 63, lane, o);
}

__device__ __forceinline__ void ph_nsa(const Args& a, LAS unsigned char* lds, int bid, int G, int tid, int wave, int lane) {
    LAS float* btl = (LAS float*)lds;
    LAS float* qs = (LAS float*)(lds + 32768 + wave * 4096);
    LAS float* pw = qs + 256;
    LAS float* ps = pw + 256;
    const float* BT = (const float*)(a.ws + WS_BT);
    for (int i = tid; i < 4 * 2048; i += NTHR) btl[i] = BT[i];
    __syncthreads();
    const bf16* P = (const bf16*)(a.ws + WS_P); const bf16* NQ = (const bf16*)(a.ws + WS_NQ);
    const bf16* KS = (const bf16*)(a.ws + WS_KS); const bf16* KW = (const bf16*)(a.ws + WS_KW);
    const bf16* KCMP = (const bf16*)(a.ws + WS_KCMP); const bf16* VCMP = (const bf16*)(a.ws + WS_VCMP); bf16* Y = (bf16*)(a.ws + WS_Y);
    const int gw = bid * NWAVES + wave, NGW = G * NWAVES;
    for (int it = gw; it < NT; it += NGW) {
        const int b = it / SEQ, t = ((it % SEQ) + 293 * b) & (SEQ - 1);
        const int tok = b * SEQ + t;
#pragma unroll
        for (int i = 0; i < 4; ++i) qs[lane + 64 * i] = bf2f(NQ[(size_t)tok * 256 + lane + 64 * i]);
        LDS_WAIT();
        float ocmp[4][2], oslc[4][2], owin[4][2];
        {
            float sA[4], sB[4], pA[4], pB[4];
            const int jA = lane, jB = 64 + lane; const bool vA = (16 * jA + 31 <= t), vB = (jB < 127) && (16 * jB + 31 <= t);
            nsa_qk(KCMP + (size_t)(b * 128 + jA) * 64, qs, sA);
            nsa_qk(KCMP + (size_t)(b * 128 + (jB < 127 ? jB : 126)) * 64, qs, sB);
            int dA = t - 16 * jA - 31, dB = t - 16 * jB - 31; dA = dA < 0 ? 0 : dA; dB = dB < 0 ? 0 : dB;
#pragma unroll
            for (int h = 0; h < 4; ++h) { const float a_ = vA ? sA[h] + btl[h * 2048 + dA] : -1e30f, b_ = vB ? sB[h] + btl[h * 2048 + dB] : -1e30f;
                const float mx = wave_max(fmaxf(a_, b_)); pA[h] = vA ? __expf(a_ - mx) : 0.f; pB[h] = vB ? __expf(b_ - mx) : 0.f;
                const float ls = wave_sum(pA[h] + pB[h]); const float inv = ls > 0.f ? 1.0f / ls : 0.f; pA[h] *= inv; pB[h] *= inv; }
            ps[lane] = (pA[0] + pA[1]) + (pA[2] + pA[3]); ps[64 + lane] = (pB[0] + pB[1]) + (pB[2] + pB[3]);
#pragma unroll
            for (int h = 0; h < 4; ++h) { ocmp[h][0] = 0.f; ocmp[h][1] = 0.f; }
            nsa_pv(pA, pw, VCMP + (size_t)(b * 128) * 64, 64, 63, lane, ocmp);
            nsa_pv(pB, pw, VCMP + (size_t)(b * 128 + 64) * 64, 64, 62, lane, ocmp);
#pragma unroll
            for (int h = 0; h < 4; ++h) { ocmp[h][0] += __shfl_xor(ocmp[h][0], 32); ocmp[h][1] += __shfl_xor(ocmp[h][1], 32); }
        }
        unsigned selmask;
        {
            const int sb = lane & 31, cur = t >> 6; float imp = 0.f;
#pragma unroll
            for (int dj = -1; dj <= 3; ++dj) { const int j = 4 * sb + dj; if (j >= 0 && j <= 126) imp += ps[j]; }
            if (sb > cur) imp = -1.0f; else if (sb == 0 || sb == cur || sb == cur - 1) imp = 1e4f;
            int rank = 0;
            for (int s2 = 0; s2 < 32; ++s2) { const float v2 = __shfl(imp, s2); rank += (v2 > imp || (v2 == imp && s2 < sb)) ? 1 : 0; }
            const bool sel = (lane < 32) && (rank < 16) && (sb <= cur);
            selmask = (unsigned)__ballot(sel);
        }
        {
            float m[4], ls[4];
#pragma unroll
            for (int h = 0; h < 4; ++h) { m[h] = -1e30f; ls[h] = 0.f; oslc[h][0] = 0.f; oslc[h][1] = 0.f; }
            unsigned mk = selmask;
            while (mk) { const int sblk = __builtin_ctz(mk); mk &= mk - 1u; const int key = 64 * sblk + lane;
                nsa_tile(KS + (size_t)(b * SEQ + key) * 64, key <= t, t - key, qs, btl, pw, P + (size_t)(b * SEQ + 64 * sblk) * NP + C_KV + 192, NP, lane, m, ls, oslc); }
#pragma unroll
            for (int h = 0; h < 4; ++h) { const float inv = ls[h] > 0.f ? 1.0f / ls[h] : 0.f; oslc[h][0] = (oslc[h][0] + __shfl_xor(oslc[h][0], 32)) * inv; oslc[h][1] = (oslc[h][1] + __shfl_xor(oslc[h][1], 32)) * inv; }
        }
        {
            float m[4], ls[4];
#pragma unroll
            for (int h = 0; h < 4; ++h) { m[h] = -1e30f; ls[h] = 0.f; owin[h][0] = 0.f; owin[h][1] = 0.f; }
            const int lo = t - 511 > 0 ? t - 511 : 0;
            for (int kt = lo >> 6; kt <= (t >> 6); ++kt) { const int key = 64 * kt + lane;
                nsa_tile(KW + (size_t)(b * SEQ + key) * 64, key <= t && key >= lo, t - key, qs, btl, pw, P + (size_t)(b * SEQ + 64 * kt) * NP + C_KV + 320, NP, lane, m, ls, owin); }
#pragma unroll
            for (int h = 0; h < 4; ++h) { const float inv = ls[h] > 0.f ? 1.0f / ls[h] : 0.f; owin[h][0] = (owin[h][0] + __shfl_xor(owin[h][0], 32)) * inv; owin[h][1] = (owin[h][1] + __shfl_xor(owin[h][1], 32)) * inv; }
        }
        if (lane < 32) {
#pragma unroll
            for (int h = 0; h < 4; ++h) { const bf16* gp = P + (size_t)tok * NP + C_G + h * 3;
                const float g0 = sigmoidf_(bf2f(gp[0])), g1 = sigmoidf_(bf2f(gp[1])), g2 = sigmoidf_(bf2f(gp[2]));
                const float y0 = g0 * ocmp[h][0] + g1 * oslc[h][0] + g2 * owin[h][0], y1 = g0 * ocmp[h][1] + g1 * oslc[h][1] + g2 * owin[h][1];
                *(unsigned*)(Y + (size_t)tok * DM + 512 + h * 64 + 2 * lane) = pk2(y0, y1); }
        }
    }
}

typedef short bf16x8 __attribute__((ext_vector_type(8)));
typedef float f32x16 __attribute__((ext_vector_type(16)));
constexpr int NSA_KT_PITCH = 144, NSA_VT_PITCH = 136;
struct NsaStage { u32x4 kv, vv; };
__device__ __forceinline__ NsaStage nsa_load(const bf16* Kbase, int kpitch, const bf16* Vbase, int vpitch, int tid) {
    const int key = tid >> 3, seg = tid & 7; NsaStage s;
    s.kv = *(const u32x4*)(Kbase + (size_t)key * kpitch + seg * 8); s.vv = *(const u32x4*)(Vbase + (size_t)key * vpitch + seg * 8); return s;
}
__device__ __forceinline__ void nsa_store(const NsaStage& s, LAS unsigned char* Kt, LAS unsigned char* Vt, int tid) {
    const int key = tid >> 3, seg = tid & 7;
    *(LAS u32x4*)(Kt + key * NSA_KT_PITCH + seg * 16) = s.kv;
#pragma unroll
    for (int i = 0; i < 4; ++i) { const unsigned w = s.vv[i];
        *(LAS unsigned short*)(Vt + (seg * 8 + 2 * i) * NSA_VT_PITCH + key * 2) = (unsigned short)(w & 0xffffu);
        *(LAS unsigned short*)(Vt + (seg * 8 + 2 * i + 1) * NSA_VT_PITCH + key * 2) = (unsigned short)(w >> 16); }
}
__device__ __forceinline__ void nsa_st(const LAS unsigned char* Kt, const bf16x8 (&qf)[4], int n, int hh, f32x16 (&s)[2]) {
#pragma unroll
    for (int kb = 0; kb < 2; ++kb) {
#pragma unroll
        for (int r = 0; r < 16; ++r) s[kb][r] = 0.f;
#pragma unroll
        for (int ks = 0; ks < 4; ++ks) { const bf16x8 af = *(const LAS bf16x8*)(Kt + (kb * 32 + n) * NSA_KT_PITCH + (16 * ks + 8 * hh) * 2);
            s[kb] = __builtin_amdgcn_mfma_f32_32x32x16_bf16(af, qf[ks], s[kb], 0, 0, 0); } }
}
__device__ __forceinline__ void nsa_pvm(const LAS unsigned char* Vt, const bf16x8 (&pf)[2][2], int n, int hh, f32x16 (&o)[2]) {
#pragma unroll
    for (int db = 0; db < 2; ++db)
#pragma unroll
        for (int kb = 0; kb < 2; ++kb)
#pragma unroll
            for (int s2 = 0; s2 < 2; ++s2) { const LAS unsigned char* p = Vt + (db * 32 + n) * NSA_VT_PITCH + (kb * 32 + 16 * s2 + 4 * hh) * 2;
                const u32x2 lo = *(const LAS u32x2*)p, hi = *(const LAS u32x2*)(p + 16);
                const u32x4 av = {lo.x, lo.y, hi.x, hi.y};
                o[db] = __builtin_amdgcn_mfma_f32_32x32x16_bf16(__builtin_bit_cast(bf16x8, av), pf[kb][s2], o[db], 0, 0, 0); }
}
__device__ __forceinline__ void nsa_pack(const f32x16 (&p)[2], bf16x8 (&pf)[2][2]) {
#pragma unroll
    for (int kb = 0; kb < 2; ++kb)
#pragma unroll
        for (int s2 = 0; s2 < 2; ++s2) { u32x4 w;
            w.x = pg8::cvt_pk_bf16(p[kb][8 * s2 + 0], p[kb][8 * s2 + 1]); w.y = pg8::cvt_pk_bf16(p[kb][8 * s2 + 2], p[kb][8 * s2 + 3]);
            w.z = pg8::cvt_pk_bf16(p[kb][8 * s2 + 4], p[kb][8 * s2 + 5]); w.w = pg8::cvt_pk_bf16(p[kb][8 * s2 + 6], p[kb][8 * s2 + 7]);
            pf[kb][s2] = __builtin_bit_cast(bf16x8, w); }
}
__device__ __forceinline__ void nsa_tile_mfma(const LAS unsigned char* Kt, const LAS unsigned char* Vt, const LAS float* btlh, const bf16x8 (&qf)[4], int n, int hh,
                                              int key0, int tq, bool colsel, int lowk, float& m, float& l, f32x16 (&o)[2]) {
    f32x16 s[2]; nsa_st(Kt, qf, n, hh, s);
    float tmax = -1e30f;
#pragma unroll
    for (int kb = 0; kb < 2; ++kb)
#pragma unroll
        for (int r = 0; r < 16; ++r) { const int key = key0 + kb * 32 + (r & 3) + 8 * (r >> 2) + 4 * hh; const int dist = tq - key;
            const bool valid = colsel && dist >= 0 && key >= lowk; const float x = s[kb][r] + btlh[dist < 0 ? 0 : dist];
            s[kb][r] = valid ? x : -1e30f; tmax = fmaxf(tmax, s[kb][r]); }
    tmax = fmaxf(tmax, __shfl_xor(tmax, 32));
    const float mn = fmaxf(m, tmax), corr = __expf(m - mn); float rs = 0.f;
#pragma unroll
    for (int kb = 0; kb < 2; ++kb)
#pragma unroll
        for (int r = 0; r < 16; ++r) { const float x = s[kb][r]; const float p = x > -1e29f ? __expf(x - mn) : 0.f; s[kb][r] = p; rs += p; }
    rs += __shfl_xor(rs, 32);
    l = l * corr + rs; m = mn;
#pragma unroll
    for (int db = 0; db < 2; ++db)
#pragma unroll
        for (int r = 0; r < 16; ++r) o[db][r] *= corr;
    bf16x8 pf[2][2]; nsa_pack(s, pf);
    nsa_pvm(Vt, pf, n, hh, o);
}

__device__ __forceinline__ void ph_nsa_mfma(const Args& a, LAS unsigned char* lds, int bid, int G, int tid, int wave, int lane) {
    LAS float* btl = (LAS float*)lds;
    LAS unsigned char* Kt = lds + 32768;
    LAS unsigned char* Vt = lds + 32768 + 9216;
    LAS float* PS = (LAS float*)(lds + 51200);
    LAS unsigned* MK = (LAS unsigned*)(lds + 84480);
    const float* BT = (const float*)(a.ws + WS_BT);
    for (int i = tid; i < 4 * 2048; i += NTHR) btl[i] = BT[i];
    const bf16* P = (const bf16*)(a.ws + WS_P); const bf16* NQ = (const bf16*)(a.ws + WS_NQ);
    const bf16* KS = (const bf16*)(a.ws + WS_KS); const bf16* KW = (const bf16*)(a.ws + WS_KW);
    const bf16* KCMP = (const bf16*)(a.ws + WS_KCMP); const bf16* VCMP = (const bf16*)(a.ws + WS_VCMP); bf16* Y = (bf16*)(a.ws + WS_Y);
    const int n = lane & 31, hh = lane >> 5, tl = n >> 2, h = n & 3;
    const LAS float* btlh = btl + h * 2048;
    for (int u = bid; u < 256; u += G) {
        const int b = u >> 5, qt = 31 - (u & 31), t0 = 64 * qt, tq = t0 + 8 * wave + tl, tok = b * SEQ + tq;
        bf16x8 qf[4];
#pragma unroll
        for (int ks = 0; ks < 4; ++ks) qf[ks] = *(const bf16x8*)(NQ + (size_t)tok * 256 + h * 64 + 16 * ks + 8 * hh);
        float gate[3];
#pragma unroll
        for (int br = 0; br < 3; ++br) gate[br] = sigmoidf_(bf2f(P[(size_t)tok * NP + C_G + h * 3 + br]));
        f32x16 yacc[2];
#pragma unroll
        for (int db = 0; db < 2; ++db)
#pragma unroll
            for (int r = 0; r < 16; ++r) yacc[db][r] = 0.f;
        {
            f32x16 sc[2][2];
#pragma unroll
            for (int ct = 0; ct < 2; ++ct) {
                __syncthreads();
                { const NsaStage st = nsa_load(KCMP + (size_t)(b * 128 + ct * 64) * 64, 64, VCMP + (size_t)(b * 128 + ct * 64) * 64, 64, tid); nsa_store(st, Kt, Vt + ct * 0, tid); }
                __syncthreads();
                nsa_st(Kt, qf, n, hh, sc[ct]);
            }
            float mx = -1e30f;
#pragma unroll
            for (int ct = 0; ct < 2; ++ct)
#pragma unroll
                for (int kb = 0; kb < 2; ++kb)
#pragma unroll
                    for (int r = 0; r < 16; ++r) { const int j = ct * 64 + kb * 32 + (r & 3) + 8 * (r >> 2) + 4 * hh; const int dist = tq - 16 * j - 31;
                        const float x = sc[ct][kb][r] + btlh[dist < 0 ? 0 : dist]; sc[ct][kb][r] = dist >= 0 ? x : -1e30f; mx = fmaxf(mx, sc[ct][kb][r]); }
            mx = fmaxf(mx, __shfl_xor(mx, 32));
            float rs = 0.f;
#pragma unroll
            for (int ct = 0; ct < 2; ++ct)
#pragma unroll
                for (int kb = 0; kb < 2; ++kb)
#pragma unroll
                    for (int r = 0; r < 16; ++r) { const float x = sc[ct][kb][r]; const float p = x > -1e29f ? __expf(x - mx) : 0.f; sc[ct][kb][r] = p; rs += p; }
            rs += __shfl_xor(rs, 32);
            const float inv = rs > 0.f ? 1.0f / rs : 0.f;
#pragma unroll
            for (int ct = 0; ct < 2; ++ct)
#pragma unroll
                for (int kb = 0; kb < 2; ++kb)
#pragma unroll
                    for (int r = 0; r < 16; ++r) { const float p = sc[ct][kb][r] * inv; sc[ct][kb][r] = p;
                        float v = p; v += __shfl_xor(v, 1); v += __shfl_xor(v, 2);
                        if (h == 0) PS[(8 * wave + tl) * 129 + ct * 64 + kb * 32 + (r & 3) + 8 * (r >> 2) + 4 * hh] = v; }
            f32x16 o[2];
#pragma unroll
            for (int db = 0; db < 2; ++db)
#pragma unroll
                for (int r = 0; r < 16; ++r) o[db][r] = 0.f;
            { bf16x8 pf[2][2]; nsa_pack(sc[1], pf); nsa_pvm(Vt, pf, n, hh, o); }
            __syncthreads();
            { const NsaStage st = nsa_load(KCMP + (size_t)(b * 128) * 64, 64, VCMP + (size_t)(b * 128) * 64, 64, tid); nsa_store(st, Kt, Vt, tid); }
            __syncthreads();
            { bf16x8 pf[2][2]; nsa_pack(sc[0], pf); nsa_pvm(Vt, pf, n, hh, o); }
#pragma unroll
            for (int db = 0; db < 2; ++db)
#pragma unroll
                for (int r = 0; r < 16; ++r) yacc[db][r] += gate[0] * o[db][r];
        }
        LDS_WAIT();
        for (int t2 = 0; t2 < 8; ++t2) {
            const int tqq = t0 + 8 * wave + t2, sb = lane & 31, cur = tqq >> 6; const LAS float* row = PS + (8 * wave + t2) * 129; float imp = 0.f;
#pragma unroll
            for (int dj = -1; dj <= 3; ++dj) { const int j = 4 * sb + dj; if (j >= 0 && j <= 126) imp += row[j]; }
            if (sb > cur) imp = -1.0f; else if (sb == 0 || sb == cur || sb == cur - 1) imp = 1e4f;
            int rank = 0;
            for (int s2 = 0; s2 < 32; ++s2) { const float v2 = __shfl(imp, s2); rank += (v2 > imp || (v2 == imp && s2 < sb)) ? 1 : 0; }
            const unsigned msk = (unsigned)__ballot((lane < 32) && (rank < 16) && (sb <= cur));
            if (lane == 0) MK[8 * wave + t2] = msk;
        }
        __syncthreads();
        unsigned anymask, wmask; const unsigned mymask = MK[8 * wave + tl];
        { unsigned v = MK[lane];
#pragma unroll
            for (int o_ = 1; o_ < 64; o_ <<= 1) v |= (unsigned)__shfl_xor((int)v, o_);
            anymask = (unsigned)__builtin_amdgcn_readfirstlane((int)v);
            unsigned w = MK[8 * wave + (lane & 7)]; w |= (unsigned)__shfl_xor((int)w, 1); w |= (unsigned)__shfl_xor((int)w, 2); w |= (unsigned)__shfl_xor((int)w, 4);
            wmask = (unsigned)__builtin_amdgcn_readfirstlane((int)w); }
        {
            float m = -1e30f, l = 0.f; f32x16 o[2];
#pragma unroll
            for (int db = 0; db < 2; ++db)
#pragma unroll
                for (int r = 0; r < 16; ++r) o[db][r] = 0.f;
            unsigned mk = anymask;
            NsaStage st; { const int s0 = __builtin_ctz(mk); st = nsa_load(KS + (size_t)(b * SEQ + 64 * s0) * 64, 64, P + (size_t)(b * SEQ + 64 * s0) * NP + C_KV + 192, NP, tid); }
            while (mk) {
                const int sblk = __builtin_ctz(mk); mk &= mk - 1u;
                __syncthreads();
                nsa_store(st, Kt, Vt, tid);
                __syncthreads();
                if (mk) { const int s1 = __builtin_ctz(mk); st = nsa_load(KS + (size_t)(b * SEQ + 64 * s1) * 64, 64, P + (size_t)(b * SEQ + 64 * s1) * NP + C_KV + 192, NP, tid); }
                if ((wmask >> sblk) & 1u) nsa_tile_mfma(Kt, Vt, btlh, qf, n, hh, 64 * sblk, tq, ((mymask >> sblk) & 1u) != 0u, 0, m, l, o);
            }
            const float inv = l > 0.f ? gate[1] / l : 0.f;
#pragma unroll
            for (int db = 0; db < 2; ++db)
#pragma unroll
                for (int r = 0; r < 16; ++r) yacc[db][r] += inv * o[db][r];
        }
        {
            float m = -1e30f, l = 0.f; f32x16 o[2];
#pragma unroll
            for (int db = 0; db < 2; ++db)
#pragma unroll
                for (int r = 0; r < 16; ++r) o[db][r] = 0.f;
            const int kt0 = (t0 - 511 > 0 ? t0 - 511 : 0) >> 6;
            NsaStage st = nsa_load(KW + (size_t)(b * SEQ + 64 * kt0) * 64, 64, P + (size_t)(b * SEQ + 64 * kt0) * NP + C_KV + 320, NP, tid);
            for (int kt = kt0; kt <= qt; ++kt) {
                __syncthreads();
                nsa_store(st, Kt, Vt, tid);
                __syncthreads();
                if (kt < qt) st = nsa_load(KW + (size_t)(b * SEQ + 64 * (kt + 1)) * 64, 64, P + (size_t)(b * SEQ + 64 * (kt + 1)) * NP + C_KV + 320, NP, tid);
                nsa_tile_mfma(Kt, Vt, btlh, qf, n, hh, 64 * kt, tq, true, tq - 511, m, l, o);
            }
            const float inv = l > 0.f ? gate[2] / l : 0.f;
#pragma unroll
            for (int db = 0; db < 2; ++db)
#pragma unroll
                for (int r = 0; r < 16; ++r) yacc[db][r] += inv * o[db][r];
        }
#pragma unroll
        for (int db = 0; db < 2; ++db)
#pragma unroll
            for (int rq = 0; rq < 4; ++rq) { u32x2 w; w.x = pk2(yacc[db][4 * rq], yacc[db][4 * rq + 1]); w.y = pk2(yacc[db][4 * rq + 2], yacc[db][4 * rq + 3]);
                *(u32x2*)(Y + (size_t)tok * DM + 512 + h * 64 + db * 32 + 8 * rq + 4 * hh) = w; }
        __syncthreads();
    }
}

__device__ __forceinline__ void ph_router(const Args& a, int l, const float* X1, LAS unsigned char* lds, int bid, int G, int tid, int wave, int lane) {
    LAS float* hrow = (LAS float*)lds + wave * 1024;
    LAS int* lcnt = (LAS int*)(lds + 32768); LAS int* asg_e = lcnt + 32; LAS int* asg_p = asg_e + 256; LAS float* asg_w = (LAS float*)(asg_p + 256); LAS int* gbase = (LAS int*)(asg_w + 256);
    bf16* H2 = (bf16*)(a.ws + WS_XN); unsigned* cnt = (unsigned*)(a.ws + WS_CTL) + CW_CNT + 64 * l;
    int* EIDX = (int*)(a.ws + WS_EIDX); int* EPOS = (int*)(a.ws + WS_EPOS); float* EW = (float*)(a.ws + WS_EW);
    const float* fw = a.in[17] + (size_t)l * DM; const float* rw = a.in[18] + (size_t)l * DM * NE; const float* rb = a.in[19] + l * NE;
    for (int u = bid; u < NT / 64; u += G) {
        const int tok0 = u * 64;
        if (tid < 32) lcnt[tid] = 0;
        __syncthreads();
        for (int i = 0; i < 8; ++i) {
            const int tl = wave * 8 + i, tok = tok0 + tl;
            f32x4 v[4]; float ss = 0.f;
#pragma unroll
            for (int j = 0; j < 4; ++j) { v[j] = *(const f32x4*)(X1 + (size_t)tok * DM + 4 * (64 * j + lane)); ss += (v[j].x * v[j].x + v[j].y * v[j].y) + (v[j].z * v[j].z + v[j].w * v[j].w); }
            const float r = rsqrtf(wave_sum(ss) * (1.0f / DM) + EPS);
#pragma unroll
            for (int j = 0; j < 4; ++j) { const f32x4 y = v[j] * r * *(const f32x4*)(fw + 4 * (64 * j + lane));
                u32x2 o; o.x = pk2(y.x, y.y); o.y = pk2(y.z, y.w); *(u32x2*)(H2 + (size_t)tok * DM + 4 * (64 * j + lane)) = o;
                *(LAS f32x4*)(hrow + 4 * (64 * j + lane)) = y; }
            LDS_WAIT();
            const int e = lane & 31, half = lane >> 5; float acc = 0.f;
            for (int d = 0; d < 512; ++d) { const int dd = half * 512 + d; acc += hrow[dd] * rw[(size_t)dd * NE + e]; }
            acc += __shfl_xor(acc, 32); acc += rb[e];
            float val = acc, tv[4]; int ti[4];
#pragma unroll
            for (int q = 0; q < 4; ++q) { const float mx = wave_max(val); const unsigned bal = (unsigned)__ballot(val == mx); const int idx = __builtin_ctz(bal);
                tv[q] = mx; ti[q] = idx; if (e == idx) val = -3.0e38f; }
            float ew[4], es = 0.f;
#pragma unroll
            for (int q = 0; q < 4; ++q) { ew[q] = __expf(tv[q] - tv[0]); es += ew[q]; }
            if (lane == 0) {
#pragma unroll
                for (int q = 0; q < 4; ++q) { const int p = __hip_atomic_fetch_add(&lcnt[ti[q]], 1, __ATOMIC_RELAXED, __HIP_MEMORY_SCOPE_WORKGROUP); asg_e[tl * 4 + q] = ti[q]; asg_p[tl * 4 + q] = p; asg_w[tl * 4 + q] = ew[q] / es; } }
            LDS_WAIT();
        }
        __syncthreads();
        if (tid < 32) gbase[tid] = (int)atomicAdd(&cnt[tid], (unsigned)lcnt[tid]);
        __syncthreads();
        if (tid < 256) { const int tok = tok0 + (tid >> 2), k = tid & 3, e = asg_e[tid];
            EIDX[(size_t)tok * 4 + k] = e; EPOS[(size_t)tok * 4 + k] = gbase[e] + asg_p[tid]; EW[(size_t)tok * 4 + k] = asg_w[tid]; }
        __syncthreads();
    }
}

__device__ __forceinline__ void build_tiles(const unsigned* cnt, LAS int* TS, LAS int* TE, int tid) {
    if (tid == 0) { int acc = 0;
        for (int e = 0; e < NE; ++e) { TS[e] = acc; const int nt = (int)((cnt[e] + 255u) >> 8); for (int i = 0; i < nt; ++i) TE[acc + i] = e; acc += nt; }
        TS[NE] = acc; }
    __syncthreads();
}

__device__ __forceinline__ void ph_gather(const Args& a, int l, LAS unsigned char* lds, int gw, int NGW, int tid, int lane) {
    LAS int* TS = (LAS int*)(lds + TS_OFF); LAS int* TE = (LAS int*)(lds + TE_OFF);
    build_tiles((const unsigned*)(a.ws + WS_CTL) + CW_CNT + 64 * l, TS, TE, tid);
    const bf16* H2 = (const bf16*)(a.ws + WS_XN); bf16* XS = (bf16*)(a.ws + WS_XS);
    const int* EIDX = (const int*)(a.ws + WS_EIDX); const int* EPOS = (const int*)(a.ws + WS_EPOS); int* SLOT = (int*)(a.ws + WS_SLOT);
    for (int tok = gw; tok < NT; tok += NGW) {
        int slot = 0;
        if (lane < 4) { const int e = EIDX[(size_t)tok * 4 + lane]; slot = TS[e] * 256 + EPOS[(size_t)tok * 4 + lane]; SLOT[(size_t)tok * 4 + lane] = slot; }
        const u32x4 r0 = *(const u32x4*)(H2 + (size_t)tok * DM + 8 * lane), r1 = *(const u32x4*)(H2 + (size_t)tok * DM + 512 + 8 * lane);
#pragma unroll
        for (int k = 0; k < 4; ++k) { const int sk = __shfl(slot, k); *(u32x4*)(XS + (size_t)sk * DM + 8 * lane) = r0; *(u32x4*)(XS + (size_t)sk * DM + 512 + 8 * lane) = r1; }
    }
}

__device__ __forceinline__ void ph_combine(const Args& a, const float* X1, float* Xo, const float* next_norm_w, int gw, int NGW, int lane) {
    const bf16* YS = (const bf16*)(a.ws + WS_YS); const int* SLOT = (const int*)(a.ws + WS_SLOT); const float* EW = (const float*)(a.ws + WS_EW); bf16* XN = (bf16*)(a.ws + WS_XN);
    for (int tok = gw; tok < NT; tok += NGW) {
        int slot = 0; float wgt = 0.f;
        if (lane < 4) { slot = SLOT[(size_t)tok * 4 + lane]; wgt = EW[(size_t)tok * 4 + lane]; }
        f32x4 v[4];
#pragma unroll
        for (int j = 0; j < 4; ++j) v[j] = *(const f32x4*)(X1 + (size_t)tok * DM + 4 * (64 * j + lane));
#pragma unroll
        for (int k = 0; k < 4; ++k) { const int sk = __shfl(slot, k); const float wk = __shfl(wgt, k);
#pragma unroll
            for (int j = 0; j < 4; ++j) { const u32x2 y = *(const u32x2*)(YS + (size_t)sk * DM + 4 * (64 * j + lane));
                v[j].x += wk * bf_lo(y.x); v[j].y += wk * bf_hi(y.x); v[j].z += wk * bf_lo(y.y); v[j].w += wk * bf_hi(y.y); } }
#pragma unroll
        for (int j = 0; j < 4; ++j) *(f32x4*)(Xo + (size_t)tok * DM + 4 * (64 * j + lane)) = v[j];
        if (next_norm_w) rms_row_to_bf16(v, next_norm_w, XN + (size_t)tok * DM, lane);
    }
}

struct Tid { int tid, lane, wave; };
__device__ __forceinline__ Tid fresh_tid() { int t = threadIdx.x; asm volatile("" : "+v"(t)); Tid r; r.tid = t; r.lane = t & 63; r.wave = __builtin_amdgcn_readfirstlane(t >> 6); return r; }
#define FT() Args A_ = args_k; { unsigned char* w_ = args_k.ws; asm volatile("" : "+s"(w_)); A_.ws = w_; } const Args& args = A_; const Tid T_ = fresh_tid(); const int tid = T_.tid, lane = T_.lane, wave = T_.wave, gw = bid * NWAVES + wave; (void)tid; (void)lane; (void)wave; (void)gw
constexpr int PH_PER_LAYER = 11, NPH = 2 + NLAYER * PH_PER_LAYER;

#if SINGLE_LAUNCH
#define BARPARM , const XcdBarrier& bar
#define BARARG , bar
#define GRID_BAR() xcd_barrier(bar)
#else
#define BARPARM
#define BARARG
#define GRID_BAR() do {} while (0)
#endif
#define IN(k) (lo <= (k) && (k) < hi)
#define SEAM(k) do { if (IN(k) && IN((k) + 1)) GRID_BAR(); } while (0)
template <int l>
__device__ __forceinline__ void run_layer(const Args& args_k, LAS unsigned char* lds, int lo, int hi, int G, int bid, int NGW BARPARM) {
        const int pb = 2 + l * PH_PER_LAYER;
#define Xin ((l == 0) ? args.in[0] : (const float*)(args.ws + WS_XB))
#define X1 ((float*)(args.ws + WS_XA))
#define Xout ((l == NLAYER - 1) ? args.out : (float*)(args.ws + WS_XB))
        if (IN(pb + 0)) {
            FT(); pg8::Gemm g{(const pg8::bf16_t*)(args.ws + WS_XN), (const pg8::bf16_t*)(args.ws + WS_WIN) + (size_t)l * NP * DM, NT, NP, DM};
            pg8::StaticOrder S; S.init(NT, NP, G, bid);
            pg8::EpiBf16Plain E{(pg8::bf16_t*)(args.ws + WS_P), NP};
            pg8::gemm_phase<pg8::EpiBf16Plain, pg8::StaticOrder, true, true>(lds, g, S, E);
        } SEAM(pb + 0);
        if (IN(pb + 1)) { FT(); ph_m1(args, l, lds, bid, G, tid, wave, lane); } SEAM(pb + 1);
        if (IN(pb + 2)) { { FT(); ph_dn_chunk(args, lds, bid, G, tid, wave, lane); } __syncthreads(); { FT(); ph_nsa_mfma(args, lds, bid, G, tid, wave, lane); } } SEAM(pb + 2);
        if (IN(pb + 3)) { FT(); ph_dn_scan(args, lds, bid, G, tid); } SEAM(pb + 3);
        if (IN(pb + 4)) { FT(); ph_dn_out(args, l, gw, NGW, lane); } SEAM(pb + 4);
        if (IN(pb + 5)) {
            FT(); pg8::Gemm g{(const pg8::bf16_t*)(args.ws + WS_Y), (const pg8::bf16_t*)(args.ws + WS_WOUT) + (size_t)l * DM * DM, NT, DM, DM};
            pg8::StaticOrder S; S.init(NT, DM, G, bid);
            pg8::EpiResF32 E{Xin, X1, DM};
            pg8::gemm_phase<pg8::EpiResF32, pg8::StaticOrder, true, true>(lds, g, S, E);
        } SEAM(pb + 5);
        if (IN(pb + 6)) { FT(); ph_router(args, l, X1, lds, bid, G, tid, wave, lane); } SEAM(pb + 6);
        if (IN(pb + 7)) { FT(); ph_gather(args, l, lds, gw, NGW, tid, lane); } SEAM(pb + 7);
        if (IN(pb + 8)) {
            FT(); LAS int* TS = (LAS int*)(lds + TS_OFF); LAS int* TE = (LAS int*)(lds + TE_OFF);
            build_tiles((const unsigned*)(args.ws + WS_CTL) + CW_CNT + 64 * l, TS, TE, tid);
            const int ntiles = __builtin_amdgcn_readfirstlane(TS[NE]);
            pg8::Gemm g{(const pg8::bf16_t*)(args.ws + WS_XS), (const pg8::bf16_t*)(args.ws + WS_WGU) + (size_t)l * NE * 2048 * DM, ntiles * 256, NE * 2048, DM};
            pg8::MoeOrder<8> S{ntiles * 8, G, bid, (const LAS int*)TE};
            pg8::EpiSwiglu E{(pg8::bf16_t*)(args.ws + WS_ACT), args.in[21] + (size_t)l * NE * 2048};
            pg8::gemm_phase<pg8::EpiSwiglu, pg8::MoeOrder<8>, true, true>(lds, g, S, E);
        } SEAM(pb + 8);
        if (IN(pb + 9)) {
            FT(); LAS int* TS = (LAS int*)(lds + TS_OFF); LAS int* TE = (LAS int*)(lds + TE_OFF);
            build_tiles((const unsigned*)(args.ws + WS_CTL) + CW_CNT + 64 * l, TS, TE, tid);
            const int ntiles = __builtin_amdgcn_readfirstlane(TS[NE]);
            pg8::Gemm g{(const pg8::bf16_t*)(args.ws + WS_ACT), (const pg8::bf16_t*)(args.ws + WS_WD) + (size_t)l * NE * DM * DM, ntiles * 256, NE * DM, DM};
            pg8::MoeOrder<4> S{ntiles * 4, G, bid, (const LAS int*)TE};
            pg8::EpiDown E{(pg8::bf16_t*)(args.ws + WS_YS), args.in[23] + (size_t)l * NE * DM};
            pg8::gemm_phase<pg8::EpiDown, pg8::MoeOrder<4>, true, true>(lds, g, S, E);
        } SEAM(pb + 9);
        if (IN(pb + 10)) { FT(); ph_combine(args, X1, Xout, (l + 1 < NLAYER) ? args.in[1] + (size_t)(l + 1) * DM : nullptr, gw, NGW, lane); }
        if (l + 1 < NLAYER) SEAM(pb + 10);
    }

__global__ void __launch_bounds__(NTHR, 2) fwd_kernel(Args args_k) {
    extern __shared__ __attribute__((aligned(16))) unsigned char lds_raw[];
    LAS unsigned char* lds = (LAS unsigned char*)lds_raw;
    const int G = gridDim.x, bid = blockIdx.x, NGW = G * NWAVES;
    for (int u = threadIdx.x; u < (LDS_BYTES - LDSCTL_OFF) / 4; u += NTHR) ((LAS unsigned*)(lds + LDSCTL_OFF))[u] = 0u;
    __syncthreads();
#if SINGLE_LAUNCH
    XcdBarrier bar = xcd_barrier_post((unsigned*)(args_k.ws + WS_CTL) + CW_BAR, (volatile LAS unsigned*)(lds + MISC_OFF) + 8);
#endif
    const int lo = args_k.ph_lo, hi = args_k.ph_hi;

    if (IN(0)) { FT(); ph_prologue(args, lds, gw, NGW, wave, lane); } SEAM(0);
    if (IN(1)) { FT(); ph_norm0(args, gw, NGW, lane); } SEAM(1);

    run_layer<0>(args_k, lds, lo, hi, G, bid, NGW BARARG);
    run_layer<1>(args_k, lds, lo, hi, G, bid, NGW BARARG);
#undef IN
#undef SEAM
}

extern "C" void kernel_launch(void* const* d_in, const int* in_sizes, int n_in, void* d_out, int out_size, void* d_ws, size_t ws_size, hipStream_t stream) {
    static int grid = 0;
    if (grid == 0) {
        if (n_in != 25 || in_sizes[0] != NT * DM || out_size != NT * DM || ws_size < WS_END) {
            fprintf(stderr, "kernel_launch: unexpected problem (n_in %d, in0 %d, out %d, ws %zu < %zu); nothing launched\n", n_in, n_in > 0 ? in_sizes[0] : -1, out_size, ws_size, (size_t)WS_END); grid = -1; return; }
        int dev = 0, cus = 0, per_cu = 0;
        if (hipGetDevice(&dev) != hipSuccess || hipDeviceGetAttribute(&cus, hipDeviceAttributeMultiprocessorCount, dev) != hipSuccess) { grid = -1; return; }
        if (hipFuncSetAttribute((const void*)fwd_kernel, hipFuncAttributeMaxDynamicSharedMemorySize, LDS_BYTES) != hipSuccess) { fprintf(stderr, "kernel_launch: hipFuncSetAttribute failed\n"); grid = -1; return; }
        if (hipOccupancyMaxActiveBlocksPerMultiprocessor(&per_cu, (const void*)fwd_kernel, NTHR, LDS_BYTES) != hipSuccess || per_cu < 1)
            fprintf(stderr, "kernel_launch: note: occupancy query reports %d workgroups per CU\n", per_cu);
        (void)hipGetLastError();
        grid = cus;
    }
    if (grid < 0) return;
    if (hipMemsetAsync((char*)d_ws + WS_CTL, 0, CTL_ZERO_BYTES, stream) != hipSuccess) { fprintf(stderr, "kernel_launch: memset failed\n"); return; }
    Args a{};
    for (int i = 0; i < 25; ++i) a.in[i] = (const float*)d_in[i];
    a.out = (float*)d_out; a.ws = (unsigned char*)d_ws;
#if SINGLE_LAUNCH
    a.ph_lo = 0; a.ph_hi = NPH;
    hipLaunchKernelGGL(fwd_kernel, dim3(grid), dim3(NTHR), LDS_BYTES, stream, a);
#else
    for (int ph = 0; ph < NPH; ++ph) { a.ph_lo = ph; a.ph_hi = ph + 1; hipLaunchKernelGGL(fwd_kernel, dim3(grid), dim3(NTHR), LDS_BYTES, stream, a); }
#endif
}
```

```cpp
#include <hip/hip_runtime.h>
#include <cstdio>
#include <cstdint>
#include <cstddef>
namespace pg8 {
#define PG8_LAS __attribute__((address_space(3)))
typedef unsigned short bf16_t;
typedef short bf16x8 __attribute__((ext_vector_type(8)));
typedef float f32x4 __attribute__((ext_vector_type(4)));
typedef unsigned u32x4 __attribute__((ext_vector_type(4)));
constexpr int BM = 256, BK = 64, HALF = 128, HTB = HALF * BK * 2  , STAGE_BYTES = 8 * HTB, NXCD = 8, WGM = 8;

__host__ __device__ __forceinline__ int lds_byte(int r, int c) { const int st = (r >> 4) * 2 + (c >> 5), rr = r & 15, cc = c & 31, ob = rr * 64 + cc * 2; return st * 1024 + (ob ^ (((ob >> 9) & 1) << 5)); }
__host__ __device__ __forceinline__ void stage_rc(int b, int& R, int& C) { const int st = b / 1024, sb = b % 1024, swz = sb ^ (((sb >> 9) & 1) << 5); R = (st >> 1) * 16 + swz / 64; C = (st & 1) * 32 + (swz % 64) / 2; }
__host__ __device__ __forceinline__ int perm32(int rho) { const int n = rho >> 4, i = rho & 15; return 8 * (i >> 2) + 4 * n + (i & 3); }

struct Unit { int pm, pn; };
struct Gemm { const bf16_t* A; const bf16_t* Bt; int M, N, K; };

struct StaticOrder {
    int nM, nN, nwg, G, c;
    __host__ __device__ void init(int M, int N, int G_, int c_) { nM = M / BM; nN = N / BM; nwg = nM * nN; G = G_; c = c_; }
    __host__ __device__ bool next(int i, Unit& u) const {
        const long L = (long)i * G + c; if (L >= nwg) return false;
        int wgid = (int)L; { const int q = nwg / NXCD, r = nwg % NXCD, xcd = wgid % NXCD, off = wgid / NXCD; wgid = (xcd < r ? xcd * (q + 1) : r * (q + 1) + (xcd - r) * q) + off; }
        const int nig = WGM * nN, gid = wgid / nig, fm = gid * WGM, gsz = (nM - fm) < WGM ? (nM - fm) : WGM;
        u.pm = fm + ((wgid % nig) % gsz); u.pn = (wgid % nig) / gsz; return true;
    }
    __device__ __forceinline__ void a_ready(const Unit&) const {}
    __device__ __forceinline__ void done(const Unit&) const {}
};

__device__ __forceinline__ unsigned cvt_pk_bf16(float lo, float hi) { unsigned r; asm volatile("v_cvt_pk_bf16_f32 %0, %1, %2" : "=v"(r) : "v"(lo), "v"(hi)); return r; }

struct EpiBf16Plain {
    static constexpr bool PERM = true, AFTER_DRAIN = false;
    bf16_t* O; int ldc;
    __device__ __forceinline__ void operator()(const f32x4 (&acc)[2][2][4][2], const Unit& u, int wr, int wc, int fr, int fq) const {
        const int row0 = u.pm * BM + wr * 64 + fr, col0 = u.pn * BM + wc * 32 + 8 * fq;
#pragma unroll
        for (int ai = 0; ai < 2; ++ai)
#pragma unroll
            for (int m = 0; m < 4; ++m) { bf16_t* rowp = O + (size_t)(row0 + ai * HALF + m * 16) * ldc + col0;
#pragma unroll
                for (int bj = 0; bj < 2; ++bj) { const f32x4 v0 = acc[ai][bj][m][0], v1 = acc[ai][bj][m][1];
                    u32x4 w; w.x = cvt_pk_bf16(v0[0], v0[1]); w.y = cvt_pk_bf16(v0[2], v0[3]); w.z = cvt_pk_bf16(v1[0], v1[1]); w.w = cvt_pk_bf16(v1[2], v1[3]);
                    *(u32x4*)(rowp + bj * HALF) = w; } }
    }
};
struct EpiResF32 {
    static constexpr bool PERM = false, AFTER_DRAIN = false;
    const float* base; float* out; int ldc;
    __device__ __forceinline__ void operator()(const f32x4 (&acc)[2][2][4][2], const Unit& u, int wr, int wc, int fr, int fq) const {
        const int row0 = u.pm * BM + wr * 64 + fr, col0 = u.pn * BM + wc * 32 + 4 * fq;
#pragma unroll
        for (int ai = 0; ai < 2; ++ai)
#pragma unroll
            for (int m = 0; m < 4; ++m) { const size_t off = (size_t)(row0 + ai * HALF + m * 16) * ldc + col0;
#pragma unroll
                for (int bj = 0; bj < 2; ++bj)
#pragma unroll
                    for (int n = 0; n < 2; ++n) { const f32x4 b = *(const f32x4*)(base + off + bj * HALF + n * 16); *(f32x4*)(out + off + bj * HALF + n * 16) = b + acc[ai][bj][m][n]; } }
    }
};
struct EpiSwiglu {
    static constexpr bool PERM = true, AFTER_DRAIN = false;
    bf16_t* O; const float* bgu;
    __device__ __forceinline__ void operator()(const f32x4 (&acc)[2][2][4][2], const Unit& u, int wr, int wc, int fr, int fq) const {
        const int e = u.pn >> 3, pnl = u.pn & 7;
        const int row0 = u.pm * BM + wr * 64 + fr, gcol = pnl * 128 + wc * 32 + 8 * fq;
        const float* bg = bgu + (size_t)e * 2048 + gcol;
        f32x4 bgv[2], buv[2];
#pragma unroll
        for (int n = 0; n < 2; ++n) { bgv[n] = *(const f32x4*)(bg + 4 * n); buv[n] = *(const f32x4*)(bg + 1024 + 4 * n); }
#pragma unroll
        for (int ai = 0; ai < 2; ++ai)
#pragma unroll
            for (int m = 0; m < 4; ++m) { bf16_t* rowp = O + (size_t)(row0 + ai * HALF + m * 16) * 1024 + gcol;
                float r[8];
#pragma unroll
                for (int n = 0; n < 2; ++n) { const f32x4 gv = acc[ai][0][m][n] + bgv[n], uv = acc[ai][1][m][n] + buv[n];
#pragma unroll
                    for (int j = 0; j < 4; ++j) { const float g = fminf(gv[j], 7.0f), up = fminf(fmaxf(uv[j], -7.0f), 7.0f);
                        const float sg = __builtin_amdgcn_rcpf(1.0f + __expf(-1.702f * g)); r[n * 4 + j] = (up + 1.0f) * g * sg; } }
                u32x4 w; w.x = cvt_pk_bf16(r[0], r[1]); w.y = cvt_pk_bf16(r[2], r[3]); w.z = cvt_pk_bf16(r[4], r[5]); w.w = cvt_pk_bf16(r[6], r[7]);
                *(u32x4*)rowp = w; }
    }
};
struct EpiDown {
    static constexpr bool PERM = true, AFTER_DRAIN = false;
    bf16_t* O; const float* bd;
    __device__ __forceinline__ void operator()(const f32x4 (&acc)[2][2][4][2], const Unit& u, int wr, int wc, int fr, int fq) const {
        const int e = u.pn >> 2, pnl = u.pn & 3;
        const int row0 = u.pm * BM + wr * 64 + fr, col0 = pnl * BM + wc * 32 + 8 * fq;
        const float* bp = bd + (size_t)e * 1024 + col0;
        f32x4 bv[2][2];
#pragma unroll
        for (int bj = 0; bj < 2; ++bj)
#pragma unroll
            for (int n = 0; n < 2; ++n) bv[bj][n] = *(const f32x4*)(bp + bj * HALF + 4 * n);
#pragma unroll
        for (int ai = 0; ai < 2; ++ai)
#pragma unroll
            for (int m = 0; m < 4; ++m) { bf16_t* rowp = O + (size_t)(row0 + ai * HALF + m * 16) * 1024 + col0;
#pragma unroll
                for (int bj = 0; bj < 2; ++bj) { const f32x4 v0 = acc[ai][bj][m][0] + bv[bj][0], v1 = acc[ai][bj][m][1] + bv[bj][1];
                    u32x4 w; w.x = cvt_pk_bf16(v0[0], v0[1]); w.y = cvt_pk_bf16(v0[2], v0[3]); w.z = cvt_pk_bf16(v1[0], v1[1]); w.w = cvt_pk_bf16(v1[2], v1[3]);
                    *(u32x4*)(rowp + bj * HALF) = w; } }
    }
};
template <int NPN> struct MoeOrder {
    int nunits, G, c; const PG8_LAS int* texp;
    __device__ __forceinline__ bool next(int i, Unit& u) const {
        const int L = __builtin_amdgcn_readfirstlane(i * G + c); if (L >= nunits) return false;
        const int mt = L / NPN, pn = L % NPN;
        const int e = __builtin_amdgcn_readfirstlane(texp[mt]);
        u.pm = mt; u.pn = e * NPN + pn; return true;
    }
    __device__ __forceinline__ void a_ready(const Unit&) const {}
    __device__ __forceinline__ void done(const Unit&) const {}
};

template <class Epi, class Sched, bool ALIGN_EPI = false, bool SP2 = false>
__device__ __forceinline__ void gemm_phase(PG8_LAS unsigned char* lds, const Gemm g, const Sched& S, const Epi& E) {
    int tid_ = threadIdx.x; asm volatile("" : "+v"(tid_));
    const int tid = tid_, wid = __builtin_amdgcn_readfirstlane(tid >> 6), lane = tid & 63, wr = wid >> 2, wc = wid & 3, fr = lane & 15, fq = lane >> 4;
    const int K = g.K, nt = K / BK;
    unsigned voffA[2], voffB[2];
#pragma unroll
    for (int i = 0; i < 2; ++i) { int R, C; stage_rc(tid * 16 + i * 8192, R, C); const int Rb = Epi::PERM ? ((R & ~31) + perm32(R & 31)) : R;
        voffA[i] = (unsigned)(R * K + C) * 2u; voffB[i] = (unsigned)(Rb * K + C) * 2u; }
    const size_t kstep = (size_t)(BK * 2);
    const size_t hstep = (size_t)HALF * K * 2;
    const size_t tstep = 2 * hstep;
    const unsigned ldsw = (unsigned)wid * 1024u;
    const int aoff = lds_byte(wr * 64 + fr, fq * 8), boff = lds_byte(wc * 32 + fr, fq * 8);
#define PG8_SA(b, h) (((b) * 2 + (h)) * HTB)
#define PG8_SB(b, h) ((4 + (b) * 2 + (h)) * HTB)
#define PG8_STAGE(bufoff, gbase, voff) do { _Pragma("unroll") for (int _i = 0; _i < 2; ++_i) \
        __builtin_amdgcn_global_load_lds((const unsigned*)((const char*)(gbase) + (voff)[_i]), (PG8_LAS unsigned*)(lds + (bufoff) + ldsw + _i * 8192), 16, 0, 0); } while (0)
#define PG8_LDA(dst, b, h) do { _Pragma("unroll") for (int m = 0; m < 4; ++m) _Pragma("unroll") for (int k = 0; k < 2; ++k) dst[m][k] = *(const PG8_LAS bf16x8*)(lds + PG8_SA(b, h) + aoff + m * 2048 + k * 1024); } while (0)
#define PG8_LDB(dst, b, h) do { _Pragma("unroll") for (int n = 0; n < 2; ++n) _Pragma("unroll") for (int k = 0; k < 2; ++k) dst[n][k] = *(const PG8_LAS bf16x8*)(lds + PG8_SB(b, h) + boff + n * 2048 + k * 1024); } while (0)
#define PG8_MMA(ai, bj, At, Bt) do { __builtin_amdgcn_s_setprio(1); _Pragma("unroll") for (int m = 0; m < 4; ++m) _Pragma("unroll") for (int n = 0; n < 2; ++n) _Pragma("unroll") for (int k = 0; k < 2; ++k) \
        acc[ai][bj][m][n] = __builtin_amdgcn_mfma_f32_16x16x32_bf16(Bt[n][k], At[m][k], acc[ai][bj][m][n], 0, 0, 0); __builtin_amdgcn_s_setprio(0); } while (0)
#define PG8_WAIT_V(n) asm volatile("s_waitcnt vmcnt(" #n ")" ::: "memory")
#define PG8_WAIT_L(n) asm volatile("s_waitcnt lgkmcnt(" #n ")" ::: "memory")
#define PG8_BAR __builtin_amdgcn_s_barrier()
#define PG8_SCHED __builtin_amdgcn_sched_barrier(0)
    Unit cur, nxt; int ui = 0;
    if (!S.next(0, cur)) return;
    f32x4 acc[2][2][4][2];
#pragma unroll
    for (int a = 0; a < 2; ++a)
#pragma unroll
        for (int b = 0; b < 2; ++b)
#pragma unroll
            for (int m = 0; m < 4; ++m)
#pragma unroll
                for (int n = 0; n < 2; ++n) acc[a][b][m][n] = (f32x4){0.f, 0.f, 0.f, 0.f};
    bf16x8 At[4][2], B0[2][2], B1[2][2];
    const char* cA = (const char*)g.A + (size_t)cur.pm * tstep; const char* cB = (const char*)g.Bt + (size_t)cur.pn * tstep;
    S.a_ready(cur);
    if constexpr (SP2) {
        PG8_STAGE(PG8_SB(0, 0), cB, voffB); PG8_STAGE(PG8_SB(0, 1), cB + hstep, voffB); PG8_STAGE(PG8_SA(0, 0), cA, voffA); PG8_STAGE(PG8_SA(0, 1), cA + hstep, voffA);
        if (wr == 1) PG8_BAR;
        PG8_WAIT_V(2); PG8_BAR;
        PG8_STAGE(PG8_SB(1, 0), cB + kstep, voffB); PG8_STAGE(PG8_SA(1, 0), cA + kstep, voffA); PG8_STAGE(PG8_SB(1, 1), cB + hstep + kstep, voffB);
        PG8_WAIT_V(6); PG8_BAR;
    } else {
        PG8_STAGE(PG8_SB(0, 0), cB, voffB); PG8_STAGE(PG8_SA(0, 0), cA, voffA); PG8_STAGE(PG8_SB(0, 1), cB + hstep, voffB); PG8_STAGE(PG8_SA(0, 1), cA + hstep, voffA);
        if (wr == 1) PG8_BAR;
        PG8_WAIT_V(4); PG8_BAR;
        PG8_STAGE(PG8_SB(1, 0), cB + kstep, voffB); PG8_STAGE(PG8_SA(1, 0), cA + kstep, voffA); PG8_STAGE(PG8_SB(1, 1), cB + hstep + kstep, voffB);
        PG8_WAIT_V(6); PG8_BAR;
    }
    for (;;) {
        const bool has_next = S.next(ui + 1, nxt);
        const char* nA = has_next ? (const char*)g.A + (size_t)nxt.pm * tstep : cA; const char* nB = has_next ? (const char*)g.Bt + (size_t)nxt.pn * tstep : cB;
        for (int t = 0; t < nt; t += 2) {
            const bool last = (t == nt - 2);
            const char* a1 = cA + (size_t)(t + 1) * kstep;
            const char* a2 = last ? nA : cA + (size_t)(t + 2) * kstep; const char* b2 = last ? nB : cB + (size_t)(t + 2) * kstep;
            const char* a3 = a2 + kstep; const char* b3 = b2 + kstep;
            if (last && has_next) S.a_ready(nxt);
            if constexpr (SP2) {
            PG8_LDB(B0, 0, 0); PG8_LDB(B1, 0, 1); PG8_SCHED; PG8_LDA(At, 0, 0); PG8_STAGE(PG8_SA(1, 1), a1 + hstep, voffA);
            PG8_WAIT_V(8); PG8_WAIT_L(0); PG8_BAR; PG8_MMA(0, 0, At, B0); PG8_MMA(0, 1, At, B1); PG8_BAR; PG8_SCHED;
            PG8_LDA(At, 0, 1); PG8_STAGE(PG8_SB(0, 0), b2, voffB); PG8_STAGE(PG8_SB(0, 1), b2 + hstep, voffB); PG8_STAGE(PG8_SA(0, 0), a2, voffA);
            PG8_WAIT_V(8); PG8_WAIT_L(0); PG8_BAR; PG8_MMA(1, 0, At, B0); PG8_MMA(1, 1, At, B1); PG8_BAR; PG8_SCHED;
            PG8_LDB(B0, 1, 0); PG8_LDB(B1, 1, 1); PG8_SCHED; PG8_LDA(At, 1, 0); PG8_STAGE(PG8_SA(0, 1), a2 + hstep, voffA);
            PG8_WAIT_V(8); PG8_WAIT_L(0); PG8_BAR; PG8_MMA(0, 0, At, B0); PG8_MMA(0, 1, At, B1); PG8_BAR; PG8_SCHED;
            PG8_LDA(At, 1, 1); PG8_STAGE(PG8_SB(1, 0), b3, voffB); PG8_STAGE(PG8_SB(1, 1), b3 + hstep, voffB); PG8_STAGE(PG8_SA(1, 0), a3, voffA);
            PG8_WAIT_V(8); PG8_WAIT_L(0); PG8_BAR; PG8_MMA(1, 0, At, B0); PG8_MMA(1, 1, At, B1); PG8_BAR; PG8_SCHED;
            } else {
            PG8_LDB(B0, 0, 0); PG8_SCHED; PG8_LDA(At, 0, 0); PG8_STAGE(PG8_SA(1, 1), a1 + hstep, voffA);
            PG8_WAIT_L(8); PG8_BAR; PG8_WAIT_L(0); PG8_MMA(0, 0, At, B0); PG8_BAR; PG8_SCHED;
            PG8_LDB(B1, 0, 1); PG8_STAGE(PG8_SB(0, 0), b2, voffB);
            PG8_BAR; PG8_WAIT_L(0); PG8_MMA(0, 1, At, B1); PG8_BAR;
            PG8_LDA(At, 0, 1); PG8_STAGE(PG8_SA(0, 0), a2, voffA);
            PG8_BAR; PG8_WAIT_L(0); PG8_MMA(1, 0, At, B0); PG8_BAR; PG8_SCHED;
            PG8_STAGE(PG8_SB(0, 1), b2 + hstep, voffB);
            PG8_WAIT_V(6); PG8_BAR; PG8_MMA(1, 1, At, B1); PG8_BAR;
            PG8_LDB(B0, 1, 0); PG8_SCHED; PG8_LDA(At, 1, 0); PG8_STAGE(PG8_SA(0, 1), a2 + hstep, voffA);
            PG8_WAIT_L(8); PG8_BAR; PG8_WAIT_L(0); PG8_MMA(0, 0, At, B0); PG8_BAR; PG8_SCHED;
            PG8_LDB(B1, 1, 1); PG8_STAGE(PG8_SB(1, 0), b3, voffB);
            PG8_BAR; PG8_WAIT_L(0); PG8_MMA(0, 1, At, B1); PG8_BAR;
            PG8_LDA(At, 1, 1); PG8_STAGE(PG8_SA(1, 0), a3, voffA);
            PG8_BAR; PG8_WAIT_L(0); PG8_MMA(1, 0, At, B0); PG8_BAR; PG8_SCHED;
            PG8_STAGE(PG8_SB(1, 1), b3 + hstep, voffB);
            PG8_WAIT_V(6); PG8_BAR; PG8_MMA(1, 1, At, B1); PG8_BAR;
            }
        }
        if constexpr (ALIGN_EPI) { if (wr == 0) PG8_BAR; }
        if constexpr (!Epi::AFTER_DRAIN) { E(acc, cur, wr, wc, fr, fq); S.done(cur); }
        if (!has_next) break;
#pragma unroll
        for (int a = 0; a < 2; ++a)
#pragma unroll
            for (int b = 0; b < 2; ++b)
#pragma unroll
                for (int m = 0; m < 4; ++m)
#pragma unroll
                    for (int n = 0; n < 2; ++n) acc[a][b][m][n] = (f32x4){0.f, 0.f, 0.f, 0.f};
        cur = nxt; cA = nA; cB = nB; ++ui;
        if constexpr (ALIGN_EPI) { if (wr == 1) PG8_BAR; }
    }
    PG8_WAIT_V(0);
    if constexpr (!ALIGN_EPI) { if (wr == 0) PG8_BAR; }
    PG8_BAR;
    if constexpr (Epi::AFTER_DRAIN) { E.fused(acc, cur, wr, wc, fr, fq, lds, wid, lane); S.done(cur); }
#undef PG8_SA
#undef PG8_SB
#undef PG8_STAGE
#undef PG8_LDA
#undef PG8_LDB
#undef PG8_MMA
#undef PG8_WAIT_V
#undef PG8_WAIT_L
#undef PG8_BAR
#undef PG8_SCHED
}
}


#define GAS __attribute__((address_space(1)))
typedef unsigned short bf16;
typedef float f32x4 __attribute__((ext_vector_type(4)));
typedef unsigned u32x4 __attribute__((ext_vector_type(4)));
typedef unsigned u32x2 __attribute__((ext_vector_type(2)));
typedef short bf16x8 __attribute__((ext_vector_type(8)));
typedef float f32x16 __attribute__((ext_vector_type(16)));

#ifndef SINGLE_LAUNCH
#define SINGLE_LAUNCH 1
#endif

constexpr int NB = 8, SEQ = 2048, DM = 1024, NT = NB * SEQ, NLAYER = 2;
constexpr int DIN = 3220, NP = 3328;
constexpr int C_Q = 0, C_K = 512, C_V = 1024, C_Z = 1536, C_NQ = 2048, C_KV = 2304, C_CU = 2688, C_A = 3200, C_B = 3204, C_G = 3208;
constexpr int NE = 32, MAXT = 288;
constexpr int NWAVES = 8, NTHR = 512;
constexpr float EPS = 1e-6f;

constexpr size_t MiB = 1u << 20;
constexpr size_t WS_CTL = 0, CTL_ZERO_BYTES = 1 * MiB;
constexpr size_t WS_BT = 1 * MiB;
constexpr size_t WS_KCMP = 1 * MiB + 256 * 1024, WS_VCMP = 1 * MiB + 512 * 1024;
constexpr size_t WS_G = 2 * MiB, WS_BETA = 2 * MiB + 256 * 1024, WS_GC = 2 * MiB + 512 * 1024;
constexpr size_t WS_EIDX = 3 * MiB, WS_EPOS = 3 * MiB + 256 * 1024, WS_EW = 3 * MiB + 512 * 1024, WS_SLOT = 3 * MiB + 768 * 1024;
constexpr size_t WS_WIN = 4 * MiB;
constexpr size_t WS_WOUT = 17 * MiB;
constexpr size_t WS_WGU = 22 * MiB;
constexpr size_t WS_WD = 278 * MiB;
constexpr size_t WS_XA = 406 * MiB, WS_XB = 470 * MiB;
constexpr size_t WS_XN = 534 * MiB;
constexpr size_t WS_P = 566 * MiB;
constexpr size_t WS_QN = 670 * MiB, WS_KN = 686 * MiB, WS_VC = 702 * MiB;
constexpr size_t WS_U = 718 * MiB, WS_W = 750 * MiB;
constexpr size_t WS_ATT = 782 * MiB;
constexpr size_t WS_O = 798 * MiB;
constexpr size_t WS_NQ = 830 * MiB;
constexpr size_t WS_KS = 846 * MiB, WS_KW = 848 * MiB;
constexpr size_t WS_Y = 850 * MiB;
constexpr size_t WS_XS = 882 * MiB, WS_ACT = 1026 * MiB, WS_YS = 1170 * MiB;
constexpr size_t WS_KT = 1314 * MiB, WS_VT = 1330 * MiB;
constexpr size_t WS_W1T = 1346 * MiB;
constexpr size_t WS_POSW = 1349 * MiB;
constexpr size_t WS_END = 1350 * MiB;

constexpr int CW_TMO = 0, CW_BAR = 4096, CW_CNT = 16384;

constexpr int RING_BYTES = 131072;
constexpr int LDSCTL_OFF = RING_BYTES, MISC_OFF = LDSCTL_OFF, TS_OFF = LDSCTL_OFF + 128, TE_OFF = LDSCTL_OFF + 320;
constexpr int LDS_BYTES = 147456;
static_assert(TE_OFF + MAXT * 4 + 64 <= LDS_BYTES, "LDS map");

#define XB_TMO      128
#define XB_XCNT(j)  (256  + 64 * (j))
#define XB_XSUB(j)  (1280 + 64 * (j))
#define XB_XGEN(j)  (2304 + 64 * (j))
#define XB_TOP      3328
#define XB_TOPGEN   3392
#define XCD_BAR_WORDS 3456
#define XB_SPIN_CAP (1u << 22)
#define LAS __attribute__((address_space(3)))

__device__ __forceinline__ unsigned xb_ld(unsigned* p)              { return __hip_atomic_load(p, __ATOMIC_RELAXED, __HIP_MEMORY_SCOPE_AGENT); }
__device__ __forceinline__ unsigned xb_add(unsigned* p, unsigned v) { return __hip_atomic_fetch_add(p, v, __ATOMIC_RELAXED, __HIP_MEMORY_SCOPE_AGENT); }
__device__ __forceinline__ unsigned xb_xcc_id() { return (unsigned)__builtin_amdgcn_s_getreg((3 << 11) | 20) & 0xFu; }
#define XB_SPIN(cond, bar) do { unsigned _sp = 0; while (cond) { __builtin_amdgcn_s_sleep(1); \
    if ((++_sp & 255u) == 0u) { if (xb_ld(&(bar)[XB_TMO])) break; if (_sp > XB_SPIN_CAP) { atomicAdd(&(bar)[XB_TMO], 1u); break; } } } } while (0)

struct XcdBarrier {
    unsigned* bar; unsigned x;
    volatile LAS unsigned* st;
};

__device__ __forceinline__ XcdBarrier xcd_barrier_post(unsigned* bar, volatile LAS unsigned* st) {
    XcdBarrier b; b.bar = bar; b.x = xb_xcc_id(); b.st = st;
    if (threadIdx.x == 0) (void)xb_add(&bar[XB_XCNT(b.x)], 1u);
    return b;
}
__device__ __forceinline__ void xcd_barrier_complete(unsigned* bar, unsigned x, unsigned& nloc, unsigned& nx) {
    const unsigned G = gridDim.x * gridDim.y * gridDim.z;
    unsigned sum, cnt, mine, sp = 0u;
    for (;;) {
        sum = 0u; cnt = 0u; mine = 0u;
#pragma unroll
        for (unsigned j = 0; j < 16; ++j) { const unsigned c = xb_ld(&bar[XB_XCNT(j)]); sum += c; cnt += (c > 0u) ? 1u : 0u; mine = (j == x) ? c : mine; }
        if (sum == G) break;
        __builtin_amdgcn_s_sleep(1);
        if ((++sp & 255u) == 0u) { if (xb_ld(&bar[XB_TMO])) break; if (sp > XB_SPIN_CAP) { atomicAdd(&bar[XB_TMO], 1u); break; } }
    }
    nloc = mine > 0u ? mine : 1u; nx = cnt > 0u ? cnt : 1u;
}

__device__ __forceinline__ void xcd_barrier(const XcdBarrier& b) {
    asm volatile("s_waitcnt vmcnt(0)" ::: "memory");
    __syncthreads();
    if (threadIdx.x == 0) {
        unsigned* bar = b.bar;
        __builtin_amdgcn_s_waitcnt(0);
        unsigned nloc = b.st[0], nx = b.st[1];
        if (nloc == 0u) { xcd_barrier_complete(bar, b.x, nloc, nx); b.st[0] = nloc; b.st[1] = nx; }
        const unsigned old = xb_add(&bar[XB_XSUB(b.x)], 1u);
        const unsigned gen = old / nloc;
        if (old + 1u == (gen + 1u) * nloc) {
            __builtin_amdgcn_fence(__ATOMIC_RELEASE, "agent");
            asm volatile("s_waitcnt vmcnt(0)" ::: "memory");
            const unsigned og = xb_add(&bar[XB_TOP], 1u);
            const unsigned tg = og / nx;
            if (og + 1u == (tg + 1u) * nx) xb_add(&bar[XB_TOPGEN], 1u);
            else XB_SPIN(xb_ld(&bar[XB_TOPGEN]) == tg, bar);
            __builtin_amdgcn_fence(__ATOMIC_ACQUIRE, "agent");
            xb_add(&bar[XB_XGEN(b.x)], 1u);
            asm volatile("s_waitcnt vmcnt(0)" ::: "memory");
        } else {
            XB_SPIN(xb_ld(&bar[XB_XGEN(b.x)]) == gen, bar);
            __builtin_amdgcn_fence(__ATOMIC_ACQUIRE, "agent");
            asm volatile("s_waitcnt vmcnt(0)" ::: "memory");
        }
    }
    __syncthreads();
}


__device__ __forceinline__ float bf_lo(unsigned w) { return __uint_as_float(w << 16); }
__device__ __forceinline__ float bf_hi(unsigned w) { return __uint_as_float(w & 0xffff0000u); }
__device__ __forceinline__ float bf2f(bf16 v) { return __uint_as_float(((unsigned)v) << 16); }
__device__ __forceinline__ unsigned f2bf(float f) { unsigned u = __float_as_uint(f); return (u + 0x7fffu + ((u >> 16) & 1u)) >> 16; }
__device__ __forceinline__ unsigned pk2(float lo, float hi) { return f2bf(lo) | (f2bf(hi) << 16); }
__device__ __forceinline__ float wave_sum(float v) {
#pragma unroll
    for (int o = 1; o < 64; o <<= 1) v += __shfl_xor(v, o);
    return v;
}
__device__ __forceinline__ float wave_max(float v) {
#pragma unroll
    for (int o = 1; o < 64; o <<= 1) v = fmaxf(v, __shfl_xor(v, o));
    return v;
}
__device__ __forceinline__ float sigmoidf_(float x) { return 1.0f / (1.0f + __expf(-x)); }
__device__ __forceinline__ float siluf_(float x) { return x / (1.0f + __expf(-x)); }
#define LDS_WAIT() asm volatile("s_waitcnt lgkmcnt(0)" ::: "memory")

struct Args { const float* in[25]; float* out; unsigned char* ws; int ph_lo, ph_hi; };

__device__ __forceinline__ int map_win(int n);
__device__ __forceinline__ int map_gu(int n);
template <int MAP>
__device__ __forceinline__ void transpose_item(const float* W, int K, int N, bf16* WT, LAS float* scr, int item, int nblk, int lane) {
    const int kb = item / nblk, nb = item % nblk, k0 = 64 * kb, n0 = 32 * nb;
    const int nd = n0 + (lane & 31); const int src = MAP == 1 ? map_win(nd) : (MAP == 2 ? map_gu(nd) : nd);
#pragma unroll 8
    for (int i = 0; i < 32; ++i) { const int kk = 2 * i + (lane >> 5); scr[kk * 33 + (lane & 31)] = src >= 0 ? W[(size_t)(k0 + kk) * N + src] : 0.0f; }
    LDS_WAIT();
    const int c = lane & 7;
#pragma unroll
    for (int j = 0; j < 4; ++j) { const int n = (lane >> 3) + 8 * j; const LAS float* s = scr + (8 * c) * 33 + n;
        u32x4 o; o.x = pk2(s[0 * 33], s[1 * 33]); o.y = pk2(s[2 * 33], s[3 * 33]); o.z = pk2(s[4 * 33], s[5 * 33]); o.w = pk2(s[6 * 33], s[7 * 33]);
        *(u32x4*)(WT + (size_t)(n0 + n) * K + k0 + 8 * c) = o; }
    LDS_WAIT();
}
__device__ __forceinline__ int map_win(int n) {
    if (n < 2048) return n;
    if (n < C_KV) return 2056 + (n - C_NQ);
    if (n < C_CU) return 2312 + (n - C_KV);
    if (n < C_A) return 2708 + (n - C_CU);
    if (n < C_B) return 2048 + (n - C_A);
    if (n < C_G) return 2052 + (n - C_B);
    if (n < C_G + 12) return 2696 + (n - C_G);
    return -1;
}
__device__ __forceinline__ int map_gu(int n) { const int pn = n >> 8, r = n & 255; return (r < 128 ? 0 : 1024) + 128 * pn + (r & 127); }

__device__ __forceinline__ void ph_prologue(const Args& a, LAS unsigned char* lds, int gw, int NGW, int wave, int lane) {
    LAS float* scr = (LAS float*)(lds + wave * 16384);
    bf16* WinT = (bf16*)(a.ws + WS_WIN); bf16* WoutT = (bf16*)(a.ws + WS_WOUT); bf16* WguT = (bf16*)(a.ws + WS_WGU); bf16* WdT = (bf16*)(a.ws + WS_WD);
    constexpr int I_IN = 16 * (NP / 32), I_OUT = 16 * 32, I_GU = 16 * 64, I_D = 16 * 32;
    constexpr int N_IN = NLAYER * I_IN, N_OUT = NLAYER * I_OUT, N_GU = NLAYER * NE * I_GU, N_D = NLAYER * NE * I_D;
    for (int it = gw; it < N_IN + N_OUT + N_GU + N_D; it += NGW) {
        int r = it;
        if (r < N_IN) { const int l = r / I_IN; transpose_item<1>(a.in[2] + (size_t)l * DM * DIN, DM, DIN, WinT + (size_t)l * NP * DM, scr, r % I_IN, NP / 32, lane); continue; } r -= N_IN;
        if (r < N_OUT) { const int l = r / I_OUT; transpose_item<0>(a.in[16] + (size_t)l * DM * DM, DM, DM, WoutT + (size_t)l * DM * DM, scr, r % I_OUT, 32, lane); continue; } r -= N_OUT;
        if (r < N_GU) { const int le = r / I_GU; transpose_item<2>(a.in[20] + (size_t)le * DM * 2048, DM, 2048, WguT + (size_t)le * 2048 * DM, scr, r % I_GU, 64, lane); continue; } r -= N_GU;
        { const int le = r / I_D; transpose_item<0>(a.in[22] + (size_t)le * DM * DM, DM, DM, WdT + (size_t)le * DM * DM, scr, r % I_D, 32, lane); }
    }
    { bf16* W1T = (bf16*)(a.ws + WS_W1T);
        for (int it = gw; it < 4 * 128; it += NGW) { const int mtx = it >> 7; transpose_item<0>(a.in[10] + (size_t)mtx * 2048 * 128, 2048, 128, W1T + (size_t)mtx * 128 * 2048, scr, it & 127, 4, lane); }
        float* POSW = (float*)(a.ws + WS_POSW);
        const int id = gw * 64 + lane;
        if (id < 512) { const int mtx = id >> 7, n = id & 127; const float* w1 = a.in[10] + (size_t)mtx * 2048 * 128; const float* pos = a.in[9] + (size_t)mtx * 2048; float acc = 0.f;
            for (int k = 0; k < 2048; ++k) acc += pos[k] * w1[(size_t)k * 128 + n];
            POSW[id] = acc; } }
    float* BT = (float*)(a.ws + WS_BT);
    for (int i = gw * 64 + lane; i < 4 * 2048; i += NGW * 64) {
        const int h = i >> 11, n = i & 2047; int bk;
        if (n < 16) bk = n; else { const float v = logf((float)n / 16.0f) / 2.0794415416798357f * 16.0f; bk = 16 + (int)v; bk = bk < 31 ? bk : 31; }
        BT[i] = a.in[24][bk * 4 + h];
    }
}

__device__ __forceinline__ void rms_row_to_bf16(const f32x4 (&v)[4], const float* w, bf16* orow, int lane) {
    float s = 0.f;
#pragma unroll
    for (int j = 0; j < 4; ++j) s += (v[j].x * v[j].x + v[j].y * v[j].y) + (v[j].z * v[j].z + v[j].w * v[j].w);
    const float r = rsqrtf(wave_sum(s) * (1.0f / DM) + EPS);
#pragma unroll
    for (int j = 0; j < 4; ++j) { const f32x4 wv = *(const f32x4*)(w + 4 * (64 * j + lane)); const f32x4 y = v[j] * r * wv;
        u32x2 o; o.x = pk2(y.x, y.y); o.y = pk2(y.z, y.w); *(u32x2*)(orow + 4 * (64 * j + lane)) = o; }
}

__device__ __forceinline__ void ph_norm0(const Args& a, int gw, int NGW, int lane) {
    bf16* XN = (bf16*)(a.ws + WS_XN);
    for (int tok = gw; tok < NT; tok += NGW) {
        f32x4 v[4];
#pragma unroll
        for (int j = 0; j < 4; ++j) v[j] = *(const f32x4*)(a.in[0] + (size_t)tok * DM + 4 * (64 * j + lane));
        rms_row_to_bf16(v, a.in[1], XN + (size_t)tok * DM, lane);
    }
}

__device__ __forceinline__ void ph_compress_mfma(const Args& a, int l, LAS unsigned char* lds, int bid, int G, int tid, int wave, int lane) {
    LAS float* hid = (LAS float*)lds;
    const bf16* P = (const bf16*)(a.ws + WS_P); bf16* KCMP = (bf16*)(a.ws + WS_KCMP); bf16* VCMP = (bf16*)(a.ws + WS_VCMP);
    const int r = lane & 15, q = lane >> 4;
    for (int u = bid; u < 128; u += G) {
        const int b = u >> 4, kv = (u >> 3) & 1, j0 = 16 * (u & 7);
        const bf16* arow = P + (size_t)(b * SEQ) * NP + C_KV + kv * 64;
        const bf16* brow = (const bf16*)(a.ws + WS_W1T) + ((size_t)(l * 2 + kv) * 128 + 16 * wave + r) * 2048 + 8 * q;
        const float pw = ((const float*)(a.ws + WS_POSW))[(l * 2 + kv) * 128 + 16 * wave + r];
        f32x4 acc = {0.f, 0.f, 0.f, 0.f};
#pragma unroll 8
        for (int ks = 0; ks < 64; ++ks) { int tk = 16 * (j0 + r) + (ks >> 1); tk = tk < SEQ ? tk : SEQ - 1;
            const bf16x8 af = *(const bf16x8*)(arow + (size_t)tk * NP + (ks & 1) * 32 + 8 * q); const bf16x8 bfr = *(const bf16x8*)(brow + 32 * ks);
            acc = __builtin_amdgcn_mfma_f32_16x16x32_bf16(af, bfr, acc, 0, 0, 0); }
#pragma unroll
        for (int i = 0; i < 4; ++i) hid[(4 * q + i) * 132 + 16 * wave + r] = siluf_(acc[i] + pw);
        __syncthreads();
        { const int row = tid >> 5, c2 = tid & 31; const float* w2 = a.in[11] + (size_t)(l * 2 + kv) * 128 * 64; float o0 = 0.f, o1 = 0.f;
            for (int nn = 0; nn < 128; ++nn) { const float hv = hid[row * 132 + nn]; o0 += hv * w2[nn * 64 + 2 * c2]; o1 += hv * w2[nn * 64 + 2 * c2 + 1]; }
            if (kv == 0) { float ss = o0 * o0 + o1 * o1;
#pragma unroll
                for (int o_ = 1; o_ < 32; o_ <<= 1) ss += __shfl_xor(ss, o_);
                const float sc = rsqrtf(ss * (1.0f / 64.0f) + EPS); o0 *= sc * a.in[8][l * 192 + 2 * c2]; o1 *= sc * a.in[8][l * 192 + 2 * c2 + 1]; }
            const int j = j0 + row;
            *(unsigned*)((kv ? VCMP : KCMP) + (size_t)(b * 128 + j) * 64 + 2 * c2) = (j < 127) ? pk2(o0, o1) : 0u; }
        __syncthreads();
    }
}

__device__ __forceinline__ void ph_m1(const Args& a, int l, LAS unsigned char* lds, int bid, int G, int tid, int wave, int lane) {
    const bf16* P = (const bf16*)(a.ws + WS_P);
    bf16* QN = (bf16*)(a.ws + WS_QN); bf16* KN = (bf16*)(a.ws + WS_KN); bf16* VC = (bf16*)(a.ws + WS_VC);
    bf16* KT = (bf16*)(a.ws + WS_KT); bf16* VT = (bf16*)(a.ws + WS_VT);
    float* Gb = (float*)(a.ws + WS_G); float* BETA = (float*)(a.ws + WS_BETA);
    bf16* NQ = (bf16*)(a.ws + WS_NQ); bf16* KS = (bf16*)(a.ws + WS_KS); bf16* KW = (bf16*)(a.ws + WS_KW); bf16* Y = (bf16*)(a.ws + WS_Y);
    const float* convw = a.in[3] + (size_t)l * 4 * 1536; const float* a_log = a.in[4] + l * 4; const float* dt_bias = a.in[5] + l * 4;
    const float* qnw = a.in[7] + l * 64; const float* knw = a.in[8] + l * 192;
    const float* dww = a.in[12] + (size_t)l * 31 * 256; const float* dwb = a.in[13] + l * 256; const float* lnw = a.in[14] + l * 256; const float* lnb = a.in[15] + l * 256;
    LAS float* dwl = (LAS float*)(lds + 65536);
    for (int i = tid; i < 31 * 256; i += NTHR) dwl[i] = dww[i];
    __syncthreads();
    for (int u = bid; u < NT / 64; u += G) {
        const int b = u >> 5, nchunk = u & 31, tw = nchunk * 64 + 8 * wave;
        const bf16* pw0 = P + (size_t)(b * SEQ + tw) * NP;
#pragma unroll
        for (int ten = 0; ten < 3; ++ten)
#pragma unroll 1
            for (int h = 0; h < 4; ++h) { const int cb = ten * 512 + h * 128 + 2 * lane;
                float w0[4], w1[4];
#pragma unroll
                for (int j = 0; j < 4; ++j) { w0[j] = convw[j * 1536 + cb]; w1[j] = convw[j * 1536 + cb + 1]; }
                float xa[3], xb[3];
#pragma unroll
                for (int j = 0; j < 3; ++j) { unsigned w = 0u; if (tw - 3 + j >= 0) w = *(const unsigned*)(pw0 + (ptrdiff_t)(j - 3) * NP + cb); xa[j] = bf_lo(w); xb[j] = bf_hi(w); }
                unsigned pk[8];
#pragma unroll
                for (int i = 0; i < 8; ++i) { const unsigned w = *(const unsigned*)(pw0 + (size_t)i * NP + cb); const float ca = bf_lo(w), cbv = bf_hi(w);
                    float y0 = siluf_(w0[0] * xa[0] + w0[1] * xa[1] + w0[2] * xa[2] + w0[3] * ca), y1 = siluf_(w1[0] * xb[0] + w1[1] * xb[1] + w1[2] * xb[2] + w1[3] * cbv);
                    xa[0] = xa[1]; xa[1] = xa[2]; xa[2] = ca; xb[0] = xb[1]; xb[1] = xb[2]; xb[2] = cbv;
                    if (ten < 2) { const float ss = wave_sum(y0 * y0 + y1 * y1); const float sc = rsqrtf(ss + EPS) * (ten == 0 ? 0.08838834764831845f : 1.0f); y0 *= sc; y1 *= sc; }
                    pk[i] = pk2(y0, y1);
                    bf16* dst = ten == 0 ? QN : (ten == 1 ? KN : VC);
                    *(unsigned*)(dst + (size_t)(b * SEQ + tw + i) * 512 + h * 128 + 2 * lane) = pk[i]; }
                if (ten >= 1) {
                    bf16* tb = (ten == 1 ? KT : VT) + ((size_t)((b * 4 + h) * 32 + nchunk) * 128 + 2 * lane) * 64 + 8 * wave;
                    u32x4 lo, hi;
                    lo.x = (pk[0] & 0xffffu) | (pk[1] << 16); lo.y = (pk[2] & 0xffffu) | (pk[3] << 16); lo.z = (pk[4] & 0xffffu) | (pk[5] << 16); lo.w = (pk[6] & 0xffffu) | (pk[7] << 16);
                    hi.x = (pk[0] >> 16) | (pk[1] & 0xffff0000u); hi.y = (pk[2] >> 16) | (pk[3] & 0xffff0000u); hi.z = (pk[4] >> 16) | (pk[5] & 0xffff0000u); hi.w = (pk[6] >> 16) | (pk[7] & 0xffff0000u);
                    *(u32x4*)tb = lo; *(u32x4*)(tb + 64) = hi; } }
        if (lane < 32) { const int i = lane >> 2, hd = lane & 3; const size_t tok = (size_t)(b * SEQ + tw + i); const bf16* prow = P + tok * NP;
            const float av = bf2f(prow[C_A + hd]), bv = bf2f(prow[C_B + hd]);
            BETA[tok * 4 + hd] = sigmoidf_(bv);
            const float x = av + dt_bias[hd]; const float sp = x > 20.0f ? x : log1pf(expf(x));
            Gb[tok * 4 + hd] = -expf(a_log[hd]) * sp; }
        for (int i = 0; i < 8; ++i) { const size_t tok = (size_t)(b * SEQ + tw + i); const bf16* prow = P + tok * NP;
#pragma unroll
            for (int h = 0; h < 4; ++h) { const float x = bf2f(prow[C_NQ + h * 64 + lane]); const float ss = wave_sum(x * x);
                NQ[tok * 256 + h * 64 + lane] = (bf16)f2bf(x * rsqrtf(ss * (1.0f / 64.0f) + EPS) * qnw[lane] * 0.125f); }
            { const float x = bf2f(prow[C_KV + 128 + lane]); const float ss = wave_sum(x * x); KS[tok * 64 + lane] = (bf16)f2bf(x * rsqrtf(ss * (1.0f / 64.0f) + EPS) * knw[64 + lane]); }
            { const float x = bf2f(prow[C_KV + 256 + lane]); const float ss = wave_sum(x * x); KW[tok * 64 + lane] = (bf16)f2bf(x * rsqrtf(ss * (1.0f / 64.0f) + EPS) * knw[128 + lane]); } }
        { const int c = 4 * lane; f32x4 acc[8]; const f32x4 bias = *(const f32x4*)(dwb + c);
#pragma unroll
            for (int i = 0; i < 8; ++i) acc[i] = bias;
            for (int r = 0; r < 38; ++r) { const int tin = tw - 30 + r; if (tin < 0) continue;
                const bf16* pr = pw0 + (ptrdiff_t)(r - 30) * NP + C_CU + c; const u32x2 av = *(const u32x2*)pr, gv = *(const u32x2*)(pr + 256);
                f32x4 gl; gl.x = bf_lo(av.x) * sigmoidf_(bf_lo(gv.x)); gl.y = bf_hi(av.x) * sigmoidf_(bf_hi(gv.x)); gl.z = bf_lo(av.y) * sigmoidf_(bf_lo(gv.y)); gl.w = bf_hi(av.y) * sigmoidf_(bf_hi(gv.y));
#pragma unroll
                for (int i = 0; i < 8; ++i) { const int j = r - i; if (j >= 0 && j <= 30) { const f32x4 w = *(const LAS f32x4*)(dwl + j * 256 + c); acc[i] += w * gl; } } }
            const f32x4 lw = *(const f32x4*)(lnw + c), lb = *(const f32x4*)(lnb + c);
#pragma unroll
            for (int i = 0; i < 8; ++i) { const f32x4 x = acc[i]; const float mean = wave_sum((x.x + x.y) + (x.z + x.w)) * (1.0f / 256.0f);
                const f32x4 d = x - mean; const float var = wave_sum((d.x * d.x + d.y * d.y) + (d.z * d.z + d.w * d.w)) * (1.0f / 256.0f);
                const float rr = rsqrtf(var + EPS); const f32x4 y = d * rr * lw + lb;
                u32x2 o; o.x = pk2(siluf_(y.x), siluf_(y.y)); o.y = pk2(siluf_(y.z), siluf_(y.w));
                *(u32x2*)(Y + (size_t)(b * SEQ + tw + i) * DM + 768 + c) = o; } }
    }
}

__device__ __forceinline__ void ph_dn_chunk(const Args& a, LAS unsigned char* lds, int bid, int G, int tid, int wave, int lane) {
    LAS float* Kf = (LAS float*)lds;
    LAS float* QV = Kf + 64 * 129;
    LAS float* Lm = QV + 64 * 129;
    LAS float* Tm = Lm + 64 * 65;
    LAS float* gcl = Tm + 64 * 65; LAS float* betal = gcl + 64; LAS float* bkl = betal + 64;
    const bf16* QN = (const bf16*)(a.ws + WS_QN); const bf16* KN = (const bf16*)(a.ws + WS_KN); const bf16* VC = (const bf16*)(a.ws + WS_VC);
    const float* Gb = (const float*)(a.ws + WS_G); const float* BETA = (const float*)(a.ws + WS_BETA); float* GC = (float*)(a.ws + WS_GC);
    float* U = (float*)(a.ws + WS_U); float* W = (float*)(a.ws + WS_W); float* ATT = (float*)(a.ws + WS_ATT);
    for (int ci = bid; ci < 1024; ci += G) {
        const int n = ci & 31, h = (ci >> 5) & 3, b = ci >> 7; const int r0 = b * SEQ + n * 64;
        { const int row = tid >> 3, seg = tid & 7; const size_t go = (size_t)(r0 + row) * 512 + h * 128 + seg * 16;
            const u32x4 k0 = *(const u32x4*)(KN + go), k1 = *(const u32x4*)(KN + go + 8), q0 = *(const u32x4*)(QN + go), q1 = *(const u32x4*)(QN + go + 8);
            LAS float* kd = Kf + row * 129 + seg * 16; LAS float* qd = QV + row * 129 + seg * 16;
#pragma unroll
            for (int e = 0; e < 4; ++e) { kd[2 * e] = bf_lo(k0[e]); kd[2 * e + 1] = bf_hi(k0[e]); kd[8 + 2 * e] = bf_lo(k1[e]); kd[8 + 2 * e + 1] = bf_hi(k1[e]);
                qd[2 * e] = bf_lo(q0[e]); qd[2 * e + 1] = bf_hi(q0[e]); qd[8 + 2 * e] = bf_lo(q1[e]); qd[8 + 2 * e + 1] = bf_hi(q1[e]); } }
        if (wave == 0) { float g = Gb[(size_t)(r0 + lane) * 4 + h];
#pragma unroll
            for (int off = 1; off < 64; off <<= 1) { const float v = __shfl_up(g, off); if (lane >= off) g += v; }
            const float be = BETA[(size_t)(r0 + lane) * 4 + h];
            gcl[lane] = g; GC[(size_t)(r0 + lane) * 4 + h] = g; betal[lane] = be; bkl[lane] = be * __expf(g); }
        __syncthreads();
        { const int i = tid >> 3, jg = tid & 7; float kk[8], qk[8];
#pragma unroll
            for (int m = 0; m < 8; ++m) { kk[m] = 0.f; qk[m] = 0.f; }
            for (int c = 0; c < 128; ++c) { const float ak = Kf[i * 129 + c], aq = QV[i * 129 + c];
#pragma unroll
                for (int m = 0; m < 8; ++m) { const float kj = Kf[(jg + 8 * m) * 129 + c]; kk[m] += ak * kj; qk[m] += aq * kj; } }
            const float gi = gcl[i], bi = betal[i];
#pragma unroll
            for (int m = 0; m < 8; ++m) { const int j = jg + 8 * m; const float dec = (j <= i) ? __expf(gi - gcl[j]) : 0.f;
                Lm[i * 65 + j] = (j < i) ? bi * kk[m] * dec : 0.f;
                ATT[(size_t)ci * 4096 + i * 64 + j] = (j <= i) ? qk[m] * dec : 0.f; } }
        __syncthreads();
        if (wave == 0) {
            for (int i = 0; i < 64; ++i) { float acc = (i == lane) ? 1.f : 0.f;
                for (int j = 0; j < i; ++j) acc -= Lm[i * 65 + j] * Tm[j * 65 + lane];
                Tm[i * 65 + lane] = acc; }
        } else {
            for (int e = tid - 64; e < 512; e += 448) { const int row = e >> 3, seg = e & 7; const size_t go = (size_t)(r0 + row) * 512 + h * 128 + seg * 16;
                const u32x4 v0 = *(const u32x4*)(VC + go), v1 = *(const u32x4*)(VC + go + 8); LAS float* vd = QV + row * 129 + seg * 16;
#pragma unroll
                for (int q = 0; q < 4; ++q) { vd[2 * q] = bf_lo(v0[q]); vd[2 * q + 1] = bf_hi(v0[q]); vd[8 + 2 * q] = bf_lo(v1[q]); vd[8 + 2 * q + 1] = bf_hi(v1[q]); } }
        }
        __syncthreads();
        { const int c = tid & 127, part = (tid >> 7) & 1, rg = tid >> 8; float acc[32];
#pragma unroll
            for (int ii = 0; ii < 32; ++ii) acc[ii] = 0.f;
            for (int j = 0; j < 64; ++j) { const float x = part ? Kf[j * 129 + c] * bkl[j] : QV[j * 129 + c] * betal[j];
#pragma unroll
                for (int ii = 0; ii < 32; ++ii) acc[ii] += Tm[(rg * 32 + ii) * 65 + j] * x; }
            float* dst = part ? W : U;
#pragma unroll
            for (int ii = 0; ii < 32; ++ii) dst[(size_t)(r0 + rg * 32 + ii) * 512 + h * 128 + c] = acc[ii]; }
        __syncthreads();
    }
}

__device__ __forceinline__ void ph_dn_scan(const Args& a, LAS unsigned char* lds, int bid, int G, int tid) {
    LAS float* Sl = (LAS float*)lds;
    LAS float* Wl = Sl + 128 * 16;
    LAS unsigned* Ql = (LAS unsigned*)(Wl + 64 * 129);
    LAS unsigned* Kl = Ql + 64 * 65;
    LAS float* Al = (LAS float*)(Kl + 64 * 65);
    LAS float* UL = Al + 64 * 65;
    LAS float* VN = UL + 64 * 16;
    LAS float* gcl = VN + 64 * 17; LAS float* dkl = gcl + 64; LAS float* egl = dkl + 64;
    const bf16* QN = (const bf16*)(a.ws + WS_QN); const bf16* KN = (const bf16*)(a.ws + WS_KN);
    const float* GC = (const float*)(a.ws + WS_GC); const float* U = (const float*)(a.ws + WS_U); const float* W = (const float*)(a.ws + WS_W);
    const float* ATT = (const float*)(a.ws + WS_ATT); float* O = (float*)(a.ws + WS_O);
    for (int u = bid; u < 256; u += G) {
        const int s = u & 7, h = (u >> 3) & 3, b = u >> 5;
        for (int i = tid; i < 128 * 16; i += NTHR) Sl[i] = 0.f;
        __syncthreads();
        const int c = tid & 15, i0 = tid >> 4;
        for (int n = 0; n < 32; ++n) {
            const int r0 = b * SEQ + n * 64, ci = (b * 4 + h) * 32 + n;
            { const int row = tid >> 3, seg = tid & 7; const size_t go = (size_t)(r0 + row) * 512 + h * 128 + seg * 16;
#pragma unroll
                for (int q = 0; q < 4; ++q) { const f32x4 wv = *(const f32x4*)(W + go + 4 * q); LAS float* wd = Wl + row * 129 + seg * 16 + 4 * q; wd[0] = wv.x; wd[1] = wv.y; wd[2] = wv.z; wd[3] = wv.w; }
                const u32x4 q0 = *(const u32x4*)(QN + go), q1 = *(const u32x4*)(QN + go + 8), k0 = *(const u32x4*)(KN + go), k1 = *(const u32x4*)(KN + go + 8);
                LAS unsigned* qd = Ql + row * 65 + seg * 8; LAS unsigned* kd = Kl + row * 65 + seg * 8;
#pragma unroll
                for (int q = 0; q < 4; ++q) { qd[q] = q0[q]; qd[4 + q] = q1[q]; kd[q] = k0[q]; kd[4 + q] = k1[q]; }
                const int idx = tid * 8, ar = idx >> 6, ac = idx & 63;
                const f32x4 a0 = *(const f32x4*)(ATT + (size_t)ci * 4096 + idx), a1 = *(const f32x4*)(ATT + (size_t)ci * 4096 + idx + 4);
                LAS float* ad = Al + ar * 65 + ac; ad[0] = a0.x; ad[1] = a0.y; ad[2] = a0.z; ad[3] = a0.w; ad[4] = a1.x; ad[5] = a1.y; ad[6] = a1.z; ad[7] = a1.w;
#pragma unroll
                for (int rr = 0; rr < 2; ++rr) { const int i = i0 + 32 * rr; UL[i * 16 + c] = U[(size_t)(r0 + i) * 512 + h * 128 + s * 16 + c]; }
                if (tid < 64) gcl[tid] = GC[(size_t)(r0 + tid) * 4 + h]; }
            __syncthreads();
            if (tid < 64) { const float gl = gcl[63], gi = gcl[tid]; dkl[tid] = __expf(gl - gi); egl[tid] = __expf(gi); }
#pragma unroll
            for (int rr = 0; rr < 2; ++rr) { const int i = i0 + 32 * rr; float acc = UL[i * 16 + c];
                for (int k = 0; k < 128; ++k) acc -= Wl[i * 129 + k] * Sl[k * 16 + c];
                VN[i * 17 + c] = acc; }
            __syncthreads();
#pragma unroll
            for (int rr = 0; rr < 2; ++rr) { const int i = i0 + 32 * rr; float acc = 0.f;
                for (int k2 = 0; k2 < 64; ++k2) { const unsigned qw = Ql[i * 65 + k2]; acc += bf_lo(qw) * Sl[(2 * k2) * 16 + c] + bf_hi(qw) * Sl[(2 * k2 + 1) * 16 + c]; }
                acc *= egl[i];
                for (int j = 0; j <= i; ++j) acc += Al[i * 65 + j] * VN[j * 17 + c];
                O[(size_t)(r0 + i) * 512 + h * 128 + s * 16 + c] = acc; }
            __syncthreads();
            { const float eg = __expf(gcl[63]);
#pragma unroll
                for (int m = 0; m < 4; ++m) { const int kk = i0 + 32 * m; float acc = Sl[kk * 16 + c] * eg;
                    for (int j = 0; j < 64; ++j) { const unsigned kw = Kl[j * 65 + (kk >> 1)]; const float kv = (kk & 1) ? bf_hi(kw) : bf_lo(kw); acc += kv * dkl[j] * VN[j * 17 + c]; }
                    Sl[kk * 16 + c] = acc; } }
            __syncthreads();
        }
    }
}

__device__ __forceinline__ void ph_dn_out(const Args& a, int l, int gw, int NGW, int lane) {
    const float* O = (const float*)(a.ws + WS_O); const bf16* P = (const bf16*)(a.ws + WS_P); bf16* Y = (bf16*)(a.ws + WS_Y);
    const float* nw = a.in[6] + l * 128;
    for (int tok = gw; tok < NT; tok += NGW) {
#pragma unroll
        for (int h = 0; h < 4; ++h) { const float o0 = O[(size_t)tok * 512 + h * 128 + 2 * lane], o1 = O[(size_t)tok * 512 + h * 128 + 2 * lane + 1];
            const float ss = wave_sum(o0 * o0 + o1 * o1); const float r = rsqrtf(ss * (1.0f / 128.0f) + EPS);
            const unsigned zw = *(const unsigned*)(P + (size_t)tok * NP + C_Z + h * 128 + 2 * lane);
            const float y0 = o0 * r * nw[2 * lane] * siluf_(bf_lo(zw)), y1 = o1 * r * nw[2 * lane + 1] * siluf_(bf_hi(zw));
            *(unsigned*)(Y + (size_t)tok * DM + h * 128 + 2 * lane) = pk2(y0, y1); }
    }
}

__device__ __forceinline__ void nsa_qk(const bf16* krow, const LAS float* qs, float (&s)[4]) {
#pragma unroll
    for (int h = 0; h < 4; ++h) s[h] = 0.f;
#pragma unroll 1
    for (int i = 0; i < 8; ++i) { const u32x4 kr = *(const u32x4*)(krow + 8 * i);
#pragma unroll
        for (int hf = 0; hf < 2; ++hf) { const float k0 = bf_lo(kr[2 * hf]), k1 = bf_hi(kr[2 * hf]), k2 = bf_lo(kr[2 * hf + 1]), k3 = bf_hi(kr[2 * hf + 1]);
#pragma unroll
            for (int h = 0; h < 4; ++h) { const f32x4 qv = *(const LAS f32x4*)(qs + h * 64 + i * 8 + hf * 4); s[h] += (qv.x * k0 + qv.y * k1) + (qv.z * k2 + qv.w * k3); } } }
}
__device__ __forceinline__ void nsa_pv(const float (&p)[4], LAS float* pw, const bf16* vbase, int vpitch, int kmax, int lane, float (&o)[4][2]) {
    *(LAS f32x4*)(pw + lane * 4) = (f32x4){p[0], p[1], p[2], p[3]};
    LDS_WAIT();
    const int dp = lane & 31, par = lane >> 5;
#pragma unroll 8
    for (int kk = 0; kk < 32; ++kk) { const int key = 2 * kk + par; const f32x4 pv = *(const LAS f32x4*)(pw + key * 4);
        const int row = key < kmax ? key : kmax; const unsigned vv = *(const unsigned*)(vbase + (size_t)row * vpitch + 2 * dp);
        const float v0 = bf_lo(vv), v1 = bf_hi(vv);
#pragma unroll
        for (int h = 0; h < 4; ++h) { o[h][0] += pv[h] * v0; o[h][1] += pv[h] * v1; } }
    LDS_WAIT();
}
__device__ __forceinline__ void nsa_tile(const bf16* krow, bool valid, int dist, const LAS float* qs, const LAS float* btl, LAS float* pw, const bf16* vbase, int vpitch, int lane,
                                         float (&m)[4], float (&lsum)[4], float (&o)[4][2]) {
    float s[4], p[4]; nsa_qk(krow, qs, s);
    const int dd = dist < 0 ? 0 : (dist > 2047 ? 2047 : dist);
#pragma unroll
    for (int h = 0; h < 4; ++h) { const float sv = valid ? s[h] + btl[h * 2048 + dd] : -1e30f; const float mn = fmaxf(m[h], wave_max(sv));
        const float corr = __expf(m[h] - mn); p[h] = valid ? __expf(sv - mn) : 0.f; lsum[h] = lsum[h] * corr + wave_sum(p[h]); o[h][0] *= corr; o[h][1] *= corr; m[h] = mn; }
    nsa_pv(p, pw, vbase, vpitch, 63, lane, o);
}

__device__ __forceinline__ void ph_nsa(const Args& a, LAS unsigned char* lds, int bid, int G, int tid, int wave, int lane) {
    LAS float* btl = (LAS float*)lds;
    LAS float* qs = (LAS float*)(lds + 32768 + wave * 4096);
    LAS float* pw = qs + 256;
    LAS float* ps = pw + 256;
    const float* BT = (const float*)(a.ws + WS_BT);
    for (int i = tid; i < 4 * 2048; i += NTHR) btl[i] = BT[i];
    __syncthreads();
    const bf16* P = (const bf16*)(a.ws + WS_P); const bf16* NQ = (const bf16*)(a.ws + WS_NQ);
    const bf16* KS = (const bf16*)(a.ws + WS_KS); const bf16* KW = (const bf16*)(a.ws + WS_KW);
    const bf16* KCMP = (const bf16*)(a.ws + WS_KCMP); const bf16* VCMP = (const bf16*)(a.ws + WS_VCMP); bf16* Y = (bf16*)(a.ws + WS_Y);
    const int gw = bid * NWAVES + wave, NGW = G * NWAVES;
    for (int it = gw; it < NT; it += NGW) {
        const int b = it / SEQ, t = ((it % SEQ) + 293 * b) & (SEQ - 1);
        const int tok = b * SEQ + t;
#pragma unroll
        for (int i = 0; i < 4; ++i) qs[lane + 64 * i] = bf2f(NQ[(size_t)tok * 256 + lane + 64 * i]);
        LDS_WAIT();
        float ocmp[4][2], oslc[4][2], owin[4][2];
        {
            float sA[4], sB[4], pA[4], pB[4];
            const int jA = lane, jB = 64 + lane; const bool vA = (16 * jA + 31 <= t), vB = (jB < 127) && (16 * jB + 31 <= t);
            nsa_qk(KCMP + (size_t)(b * 128 + jA) * 64, qs, sA);
            nsa_qk(KCMP + (size_t)(b * 128 + (jB < 127 ? jB : 126)) * 64, qs, sB);
            int dA = t - 16 * jA - 31, dB = t - 16 * jB - 31; dA = dA < 0 ? 0 : dA; dB = dB < 0 ? 0 : dB;
#pragma unroll
            for (int h = 0; h < 4; ++h) { const float a_ = vA ? sA[h] + btl[h * 2048 + dA] : -1e30f, b_ = vB ? sB[h] + btl[h * 2048 + dB] : -1e30f;
                const float mx = wave_max(fmaxf(a_, b_)); pA[h] = vA ? __expf(a_ - mx) : 0.f; pB[h] = vB ? __expf(b_ - mx) : 0.f;
                const float ls = wave_sum(pA[h] + pB[h]); const float inv = ls > 0.f ? 1.0f / ls : 0.f; pA[h] *= inv; pB[h] *= inv; }
            ps[lane] = (pA[0] + pA[1]) + (pA[2] + pA[3]); ps[64 + lane] = (pB[0] + pB[1]) + (pB[2] + pB[3]);
#pragma unroll
            for (int h = 0; h < 4; ++h) { ocmp[h][0] = 0.f; ocmp[h][1] = 0.f; }
            nsa_pv(pA, pw, VCMP + (size_t)(b * 128) * 64, 64, 63, lane, ocmp);
            nsa_pv(pB, pw, VCMP + (size_t)(b * 128 + 64) * 64, 64, 62, lane, ocmp);
#pragma unroll
            for (int h = 0; h < 4; ++h) { ocmp[h][0] += __shfl_xor(ocmp[h][0], 32); ocmp[h][1] += __shfl_xor(ocmp[h][1], 32); }
        }
        unsigned selmask;
        {
            const int sb = lane & 31, cur = t >> 6; float imp = 0.f;
#pragma unroll
            for (int dj = -1; dj <= 3; ++dj) { const int j = 4 * sb + dj; if (j >= 0 && j <= 126) imp += ps[j]; }
            if (sb > cur) imp = -1.0f; else if (sb == 0 || sb == cur || sb == cur - 1) imp = 1e4f;
            int rank = 0;
            for (int s2 = 0; s2 < 32; ++s2) { const float v2 = __shfl(imp, s2); rank += (v2 > imp || (v2 == imp && s2 < sb)) ? 1 : 0; }
            const bool sel = (lane < 32) && (rank < 16) && (sb <= cur);
            selmask = (unsigned)__ballot(sel);
        }
        {
            float m[4], ls[4];
#pragma unroll
            for (int h = 0; h < 4; ++h) { m[h] = -1e30f; ls[h] = 0.f; oslc[h][0] = 0.f; oslc[h][1] = 0.f; }
            unsigned mk = selmask;
            while (mk) { const int sblk = __builtin_ctz(mk); mk &= mk - 1u; const int key = 64 * sblk + lane;
                nsa_tile(KS + (size_t)(b * SEQ + key) * 64, key <= t, t - key, qs, btl, pw, P + (size_t)(b * SEQ + 64 * sblk) * NP + C_KV + 192, NP, lane, m, ls, oslc); }
#pragma unroll
            for (int h = 0; h < 4; ++h) { const float inv = ls[h] > 0.f ? 1.0f / ls[h] : 0.f; oslc[h][0] = (oslc[h][0] + __shfl_xor(oslc[h][0], 32)) * inv; oslc[h][1] = (oslc[h][1] + __shfl_xor(oslc[h][1], 32)) * inv; }
        }
        {
            float m[4], ls[4];
#pragma unroll
            for (int h = 0; h < 4; ++h) { m[h] = -1e30f; ls[h] = 0.f; owin[h][0] = 0.f; owin[h][1] = 0.f; }
            const int lo = t - 511 > 0 ? t - 511 : 0;
            for (int kt = lo >> 6; kt <= (t >> 6); ++kt) { const int key = 64 * kt + lane;
                nsa_tile(KW + (size_t)(b * SEQ + key) * 64, key <= t && key >= lo, t - key, qs, btl, pw, P + (size_t)(b * SEQ + 64 * kt) * NP + C_KV + 320, NP, lane, m, ls, owin); }
#pragma unroll
            for (int h = 0; h < 4; ++h) { const float inv = ls[h] > 0.f ? 1.0f / ls[h] : 0.f; owin[h][0] = (owin[h][0] + __shfl_xor(owin[h][0], 32)) * inv; owin[h][1] = (owin[h][1] + __shfl_xor(owin[h][1], 32)) * inv; }
        }
        if (lane < 32) {
#pragma unroll
            for (int h = 0; h < 4; ++h) { const bf16* gp = P + (size_t)tok * NP + C_G + h * 3;
                const float g0 = sigmoidf_(bf2f(gp[0])), g1 = sigmoidf_(bf2f(gp[1])), g2 = sigmoidf_(bf2f(gp[2]));
                const float y0 = g0 * ocmp[h][0] + g1 * oslc[h][0] + g2 * owin[h][0], y1 = g0 * ocmp[h][1] + g1 * oslc[h][1] + g2 * owin[h][1];
                *(unsigned*)(Y + (size_t)tok * DM + 512 + h * 64 + 2 * lane) = pk2(y0, y1); }
        }
    }
}

constexpr int NSA_KT_PITCH = 144, NSA_VT_PITCH = 136;
struct NsaStage { u32x4 kv, vv; };
__device__ __forceinline__ NsaStage nsa_load(const bf16* Kbase, int kpitch, const bf16* Vbase, int vpitch, int tid) {
    const int key = tid >> 3, seg = tid & 7; NsaStage s;
    s.kv = *(const u32x4*)(Kbase + (size_t)key * kpitch + seg * 8); s.vv = *(const u32x4*)(Vbase + (size_t)key * vpitch + seg * 8); return s;
}
__device__ __forceinline__ void nsa_store(const NsaStage& s, LAS unsigned char* Kt, LAS unsigned char* Vt, int tid) {
    const int key = tid >> 3, seg = tid & 7;
    *(LAS u32x4*)(Kt + key * NSA_KT_PITCH + seg * 16) = s.kv;
#pragma unroll
    for (int i = 0; i < 4; ++i) { const unsigned w = s.vv[i];
        *(LAS unsigned short*)(Vt + (seg * 8 + 2 * i) * NSA_VT_PITCH + key * 2) = (unsigned short)(w & 0xffffu);
        *(LAS unsigned short*)(Vt + (seg * 8 + 2 * i + 1) * NSA_VT_PITCH + key * 2) = (unsigned short)(w >> 16); }
}
__device__ __forceinline__ void nsa_st(const LAS unsigned char* Kt, const bf16x8 (&qf)[4], int n, int hh, f32x16 (&s)[2]) {
#pragma unroll
    for (int kb = 0; kb < 2; ++kb) {
#pragma unroll
        for (int r = 0; r < 16; ++r) s[kb][r] = 0.f;
#pragma unroll
        for (int ks = 0; ks < 4; ++ks) { const bf16x8 af = *(const LAS bf16x8*)(Kt + (kb * 32 + n) * NSA_KT_PITCH + (16 * ks + 8 * hh) * 2);
            s[kb] = __builtin_amdgcn_mfma_f32_32x32x16_bf16(af, qf[ks], s[kb], 0, 0, 0); } }
}
__device__ __forceinline__ void nsa_pvm(const LAS unsigned char* Vt, const bf16x8 (&pf)[2][2], int n, int hh, f32x16 (&o)[2]) {
#pragma unroll
    for (int db = 0; db < 2; ++db)
#pragma unroll
        for (int kb = 0; kb < 2; ++kb)
#pragma unroll
            for (int s2 = 0; s2 < 2; ++s2) { const LAS unsigned char* p = Vt + (db * 32 + n) * NSA_VT_PITCH + (kb * 32 + 16 * s2 + 4 * hh) * 2;
                const u32x2 lo = *(const LAS u32x2*)p, hi = *(const LAS u32x2*)(p + 16);
                const u32x4 av = {lo.x, lo.y, hi.x, hi.y};
                o[db] = __builtin_amdgcn_mfma_f32_32x32x16_bf16(__builtin_bit_cast(bf16x8, av), pf[kb][s2], o[db], 0, 0, 0); }
}
__device__ __forceinline__ void nsa_pack(const f32x16 (&p)[2], bf16x8 (&pf)[2][2]) {
#pragma unroll
    for (int kb = 0; kb < 2; ++kb)
#pragma unroll
        for (int s2 = 0; s2 < 2; ++s2) { u32x4 w;
            w.x = pg8::cvt_pk_bf16(p[kb][8 * s2 + 0], p[kb][8 * s2 + 1]); w.y = pg8::cvt_pk_bf16(p[kb][8 * s2 + 2], p[kb][8 * s2 + 3]);
            w.z = pg8::cvt_pk_bf16(p[kb][8 * s2 + 4], p[kb][8 * s2 + 5]); w.w = pg8::cvt_pk_bf16(p[kb][8 * s2 + 6], p[kb][8 * s2 + 7]);
            pf[kb][s2] = __builtin_bit_cast(bf16x8, w); }
}
__device__ __forceinline__ void nsa_tile_mfma(const LAS unsigned char* Kt, const LAS unsigned char* Vt, const LAS float* btlh, const bf16x8 (&qf)[4], int n, int hh,
                                              int key0, int tq, bool colsel, int lowk, float& m, float& l, f32x16 (&o)[2]) {
    f32x16 s[2]; nsa_st(Kt, qf, n, hh, s);
    float tmax = -1e30f;
#pragma unroll
    for (int kb = 0; kb < 2; ++kb)
#pragma unroll
        for (int r = 0; r < 16; ++r) { const int key = key0 + kb * 32 + (r & 3) + 8 * (r >> 2) + 4 * hh; const int dist = tq - key;
            const bool valid = colsel && dist >= 0 && key >= lowk; const float x = s[kb][r] + btlh[dist < 0 ? 0 : dist];
            s[kb][r] = valid ? x : -1e30f; tmax = fmaxf(tmax, s[kb][r]); }
    tmax = fmaxf(tmax, __shfl_xor(tmax, 32));
    const float mn = fmaxf(m, tmax), corr = __expf(m - mn); float rs = 0.f;
#pragma unroll
    for (int kb = 0; kb < 2; ++kb)
#pragma unroll
        for (int r = 0; r < 16; ++r) { const float x = s[kb][r]; const float p = x > -1e29f ? __expf(x - mn) : 0.f; s[kb][r] = p; rs += p; }
    rs += __shfl_xor(rs, 32);
    l = l * corr + rs; m = mn;
#pragma unroll
    for (int db = 0; db < 2; ++db)
#pragma unroll
        for (int r = 0; r < 16; ++r) o[db][r] *= corr;
    bf16x8 pf[2][2]; nsa_pack(s, pf);
    nsa_pvm(Vt, pf, n, hh, o);
}

__device__ __forceinline__ void ph_nsa_mfma(const Args& a, LAS unsigned char* lds, int bid, int G, int tid, int wave, int lane) {
    LAS float* btl = (LAS float*)lds;
    LAS unsigned char* Kt = lds + 32768;
    LAS unsigned char* Vt = lds + 32768 + 9216;
    LAS float* PS = (LAS float*)(lds + 51200);
    LAS unsigned* MK = (LAS unsigned*)(lds + 84480);
    const float* BT = (const float*)(a.ws + WS_BT);
    for (int i = tid; i < 4 * 2048; i += NTHR) btl[i] = BT[i];
    const bf16* P = (const bf16*)(a.ws + WS_P); const bf16* NQ = (const bf16*)(a.ws + WS_NQ);
    const bf16* KS = (const bf16*)(a.ws + WS_KS); const bf16* KW = (const bf16*)(a.ws + WS_KW);
    const bf16* KCMP = (const bf16*)(a.ws + WS_KCMP); const bf16* VCMP = (const bf16*)(a.ws + WS_VCMP); bf16* Y = (bf16*)(a.ws + WS_Y);
    const int n = lane & 31, hh = lane >> 5, tl = n >> 2, h = n & 3;
    const LAS float* btlh = btl + h * 2048;
    for (int u = bid; u < 256; u += G) {
        const int b = u >> 5, qt = 31 - (u & 31), t0 = 64 * qt, tq = t0 + 8 * wave + tl, tok = b * SEQ + tq;
        bf16x8 qf[4];
#pragma unroll
        for (int ks = 0; ks < 4; ++ks) qf[ks] = *(const bf16x8*)(NQ + (size_t)tok * 256 + h * 64 + 16 * ks + 8 * hh);
        float gate[3];
#pragma unroll
        for (int br = 0; br < 3; ++br) gate[br] = sigmoidf_(bf2f(P[(size_t)tok * NP + C_G + h * 3 + br]));
        f32x16 yacc[2];
#pragma unroll
        for (int db = 0; db < 2; ++db)
#pragma unroll
            for (int r = 0; r < 16; ++r) yacc[db][r] = 0.f;
        {
            f32x16 sc[2][2];
#pragma unroll
            for (int ct = 0; ct < 2; ++ct) {
                __syncthreads();
                { const NsaStage st = nsa_load(KCMP + (size_t)(b * 128 + ct * 64) * 64, 64, VCMP + (size_t)(b * 128 + ct * 64) * 64, 64, tid); nsa_store(st, Kt, Vt + ct * 0, tid); }
                __syncthreads();
                nsa_st(Kt, qf, n, hh, sc[ct]);
            }
            float mx = -1e30f;
#pragma unroll
            for (int ct = 0; ct < 2; ++ct)
#pragma unroll
                for (int kb = 0; kb < 2; ++kb)
#pragma unroll
                    for (int r = 0; r < 16; ++r) { const int j = ct * 64 + kb * 32 + (r & 3) + 8 * (r >> 2) + 4 * hh; const int dist = tq - 16 * j - 31;
                        const float x = sc[ct][kb][r] + btlh[dist < 0 ? 0 : dist]; sc[ct][kb][r] = dist >= 0 ? x : -1e30f; mx = fmaxf(mx, sc[ct][kb][r]); }
            mx = fmaxf(mx, __shfl_xor(mx, 32));
            float rs = 0.f;
#pragma unroll
            for (int ct = 0; ct < 2; ++ct)
#pragma unroll
                for (int kb = 0; kb < 2; ++kb)
#pragma unroll
                    for (int r = 0; r < 16; ++r) { const float x = sc[ct][kb][r]; const float p = x > -1e29f ? __expf(x - mx) : 0.f; sc[ct][kb][r] = p; rs += p; }
            rs += __shfl_xor(rs, 32);
            const float inv = rs > 0.f ? 1.0f / rs : 0.f;
#pragma unroll
            for (int ct = 0; ct < 2; ++ct)
#pragma unroll
                for (int kb = 0; kb < 2; ++kb)
#pragma unroll
                    for (int r = 0; r < 16; ++r) { const float p = sc[ct][kb][r] * inv; sc[ct][kb][r] = p;
                        float v = p; v += __shfl_xor(v, 1); v += __shfl_xor(v, 2);
                        if (h == 0) PS[(8 * wave + tl) * 129 + ct * 64 + kb * 32 + (r & 3) + 8 * (r >> 2) + 4 * hh] = v; }
            f32x16 o[2];
#pragma unroll
            for (int db = 0; db < 2; ++db)
#pragma unroll
                for (int r = 0; r < 16; ++r) o[db][r] = 0.f;
            { bf16x8 pf[2][2]; nsa_pack(sc[1], pf); nsa_pvm(Vt, pf, n, hh, o); }
            __syncthreads();
            { const NsaStage st = nsa_load(KCMP + (size_t)(b * 128) * 64, 64, VCMP + (size_t)(b * 128) * 64, 64, tid); nsa_store(st, Kt, Vt, tid); }
            __syncthreads();
            { bf16x8 pf[2][2]; nsa_pack(sc[0], pf); nsa_pvm(Vt, pf, n, hh, o); }
#pragma unroll
            for (int db = 0; db < 2; ++db)
#pragma unroll
                for (int r = 0; r < 16; ++r) yacc[db][r] += gate[0] * o[db][r];
        }
        LDS_WAIT();
        for (int t2 = 0; t2 < 8; ++t2) {
            const int tqq = t0 + 8 * wave + t2, sb = lane & 31, cur = tqq >> 6; const LAS float* row = PS + (8 * wave + t2) * 129; float imp = 0.f;
#pragma unroll
            for (int dj = -1; dj <= 3; ++dj) { const int j = 4 * sb + dj; if (j >= 0 && j <= 126) imp += row[j]; }
            if (sb > cur) imp = -1.0f; else if (sb == 0 || sb == cur || sb == cur - 1) imp = 1e4f;
            int rank = 0;
            for (int s2 = 0; s2 < 32; ++s2) { const float v2 = __shfl(imp, s2); rank += (v2 > imp || (v2 == imp && s2 < sb)) ? 1 : 0; }
            const unsigned msk = (unsigned)__ballot((lane < 32) && (rank < 16) && (sb <= cur));
            if (lane == 0) MK[8 * wave + t2] = msk;
        }
        __syncthreads();
        unsigned anymask, wmask; const unsigned mymask = MK[8 * wave + tl];
        { unsigned v = MK[lane];
#pragma unroll
            for (int o_ = 1; o_ < 64; o_ <<= 1) v |= (unsigned)__shfl_xor((int)v, o_);
            anymask = (unsigned)__builtin_amdgcn_readfirstlane((int)v);
            unsigned w = MK[8 * wave + (lane & 7)]; w |= (unsigned)__shfl_xor((int)w, 1); w |= (unsigned)__shfl_xor((int)w, 2); w |= (unsigned)__shfl_xor((int)w, 4);
            wmask = (unsigned)__builtin_amdgcn_readfirstlane((int)w); }
        {
            float m = -1e30f, l = 0.f; f32x16 o[2];
#pragma unroll
            for (int db = 0; db < 2; ++db)
#pragma unroll
                for (int r = 0; r < 16; ++r) o[db][r] = 0.f;
            unsigned mk = anymask;
            NsaStage st; { const int s0 = __builtin_ctz(mk); st = nsa_load(KS + (size_t)(b * SEQ + 64 * s0) * 64, 64, P + (size_t)(b * SEQ + 64 * s0) * NP + C_KV + 192, NP, tid); }
            while (mk) {
                const int sblk = __builtin_ctz(mk); mk &= mk - 1u;
                __syncthreads();
                nsa_store(st, Kt, Vt, tid);
                __syncthreads();
                if (mk) { const int s1 = __builtin_ctz(mk); st = nsa_load(KS + (size_t)(b * SEQ + 64 * s1) * 64, 64, P + (size_t)(b * SEQ + 64 * s1) * NP + C_KV + 192, NP, tid); }
                if ((wmask >> sblk) & 1u) nsa_tile_mfma(Kt, Vt, btlh, qf, n, hh, 64 * sblk, tq, ((mymask >> sblk) & 1u) != 0u, 0, m, l, o);
            }
            const float inv = l > 0.f ? gate[1] / l : 0.f;
#pragma unroll
            for (int db = 0; db < 2; ++db)
#pragma unroll
                for (int r = 0; r < 16; ++r) yacc[db][r] += inv * o[db][r];
        }
        {
            float m = -1e30f, l = 0.f; f32x16 o[2];
#pragma unroll
            for (int db = 0; db < 2; ++db)
#pragma unroll
                for (int r = 0; r < 16; ++r) o[db][r] = 0.f;
            const int kt0 = (t0 - 511 > 0 ? t0 - 511 : 0) >> 6;
            NsaStage st = nsa_load(KW + (size_t)(b * SEQ + 64 * kt0) * 64, 64, P + (size_t)(b * SEQ + 64 * kt0) * NP + C_KV + 320, NP, tid);
            for (int kt = kt0; kt <= qt; ++kt) {
                __syncthreads();
                nsa_store(st, Kt, Vt, tid);
                __syncthreads();
                if (kt < qt) st = nsa_load(KW + (size_t)(b * SEQ + 64 * (kt + 1)) * 64, 64, P + (size_t)(b * SEQ + 64 * (kt + 1)) * NP + C_KV + 320, NP, tid);
                nsa_tile_mfma(Kt, Vt, btlh, qf, n, hh, 64 * kt, tq, true, tq - 511, m, l, o);
            }
            const float inv = l > 0.f ? gate[2] / l : 0.f;
#pragma unroll
            for (int db = 0; db < 2; ++db)
#pragma unroll
                for (int r = 0; r < 16; ++r) yacc[db][r] += inv * o[db][r];
        }
#pragma unroll
        for (int db = 0; db < 2; ++db)
#pragma unroll
            for (int rq = 0; rq < 4; ++rq) { u32x2 w; w.x = pk2(yacc[db][4 * rq], yacc[db][4 * rq + 1]); w.y = pk2(yacc[db][4 * rq + 2], yacc[db][4 * rq + 3]);
                *(u32x2*)(Y + (size_t)tok * DM + 512 + h * 64 + db * 32 + 8 * rq + 4 * hh) = w; }
        __syncthreads();
    }
}

__device__ __forceinline__ void ph_router(const Args& a, int l, const float* X1, LAS unsigned char* lds, int bid, int G, int tid, int wave, int lane) {
    LAS float* hrow = (LAS float*)lds + wave * 1024;
    LAS int* lcnt = (LAS int*)(lds + 32768); LAS int* asg_e = lcnt + 32; LAS int* asg_p = asg_e + 256; LAS float* asg_w = (LAS float*)(asg_p + 256); LAS int* gbase = (LAS int*)(asg_w + 256);
    bf16* H2 = (bf16*)(a.ws + WS_XN); unsigned* cnt = (unsigned*)(a.ws + WS_CTL) + CW_CNT + 64 * l;
    int* EIDX = (int*)(a.ws + WS_EIDX); int* EPOS = (int*)(a.ws + WS_EPOS); float* EW = (float*)(a.ws + WS_EW);
    const float* fw = a.in[17] + (size_t)l * DM; const float* rw = a.in[18] + (size_t)l * DM * NE; const float* rb = a.in[19] + l * NE;
    for (int u = bid; u < NT / 64; u += G) {
        const int tok0 = u * 64;
        if (tid < 32) lcnt[tid] = 0;
        __syncthreads();
        for (int i = 0; i < 8; ++i) {
            const int tl = wave * 8 + i, tok = tok0 + tl;
            f32x4 v[4]; float ss = 0.f;
#pragma unroll
            for (int j = 0; j < 4; ++j) { v[j] = *(const f32x4*)(X1 + (size_t)tok * DM + 4 * (64 * j + lane)); ss += (v[j].x * v[j].x + v[j].y * v[j].y) + (v[j].z * v[j].z + v[j].w * v[j].w); }
            const float r = rsqrtf(wave_sum(ss) * (1.0f / DM) + EPS);
#pragma unroll
            for (int j = 0; j < 4; ++j) { const f32x4 y = v[j] * r * *(const f32x4*)(fw + 4 * (64 * j + lane));
                u32x2 o; o.x = pk2(y.x, y.y); o.y = pk2(y.z, y.w); *(u32x2*)(H2 + (size_t)tok * DM + 4 * (64 * j + lane)) = o;
                *(LAS f32x4*)(hrow + 4 * (64 * j + lane)) = y; }
            LDS_WAIT();
            const int e = lane & 31, half = lane >> 5; float acc = 0.f;
            for (int d = 0; d < 512; ++d) { const int dd = half * 512 + d; acc += hrow[dd] * rw[(size_t)dd * NE + e]; }
            acc += __shfl_xor(acc, 32); acc += rb[e];
            float val = acc, tv[4]; int ti[4];
#pragma unroll
            for (int q = 0; q < 4; ++q) { const float mx = wave_max(val); const unsigned bal = (unsigned)__ballot(val == mx); const int idx = __builtin_ctz(bal);
                tv[q] = mx; ti[q] = idx; if (e == idx) val = -3.0e38f; }
            float ew[4], es = 0.f;
#pragma unroll
            for (int q = 0; q < 4; ++q) { ew[q] = __expf(tv[q] - tv[0]); es += ew[q]; }
            if (lane == 0) {
#pragma unroll
                for (int q = 0; q < 4; ++q) { const int p = __hip_atomic_fetch_add(&lcnt[ti[q]], 1, __ATOMIC_RELAXED, __HIP_MEMORY_SCOPE_WORKGROUP); asg_e[tl * 4 + q] = ti[q]; asg_p[tl * 4 + q] = p; asg_w[tl * 4 + q] = ew[q] / es; } }
            LDS_WAIT();
        }
        __syncthreads();
        if (tid < 32) gbase[tid] = (int)atomicAdd(&cnt[tid], (unsigned)lcnt[tid]);
        __syncthreads();
        if (tid < 256) { const int tok = tok0 + (tid >> 2), k = tid & 3, e = asg_e[tid];
            EIDX[(size_t)tok * 4 + k] = e; EPOS[(size_t)tok * 4 + k] = gbase[e] + asg_p[tid]; EW[(size_t)tok * 4 + k] = asg_w[tid]; }
        __syncthreads();
    }
}

__device__ __forceinline__ void build_tiles(const unsigned* cnt, LAS int* TS, LAS int* TE, int tid) {
    if (tid == 0) { int acc = 0;
        for (int e = 0; e < NE; ++e) { TS[e] = acc; const int nt = (int)((cnt[e] + 255u) >> 8); for (int i = 0; i < nt; ++i) TE[acc + i] = e; acc += nt; }
        TS[NE] = acc; }
    __syncthreads();
}

__device__ __forceinline__ void ph_gather(const Args& a, int l, LAS unsigned char* lds, int gw, int NGW, int tid, int lane) {
    LAS int* TS = (LAS int*)(lds + TS_OFF); LAS int* TE = (LAS int*)(lds + TE_OFF);
    build_tiles((const unsigned*)(a.ws + WS_CTL) + CW_CNT + 64 * l, TS, TE, tid);
    const bf16* H2 = (const bf16*)(a.ws + WS_XN); bf16* XS = (bf16*)(a.ws + WS_XS);
    const int* EIDX = (const int*)(a.ws + WS_EIDX); const int* EPOS = (const int*)(a.ws + WS_EPOS); int* SLOT = (int*)(a.ws + WS_SLOT);
    for (int tok = gw; tok < NT; tok += NGW) {
        int slot = 0;
        if (lane < 4) { const int e = EIDX[(size_t)tok * 4 + lane]; slot = TS[e] * 256 + EPOS[(size_t)tok * 4 + lane]; SLOT[(size_t)tok * 4 + lane] = slot; }
        const u32x4 r0 = *(const u32x4*)(H2 + (size_t)tok * DM + 8 * lane), r1 = *(const u32x4*)(H2 + (size_t)tok * DM + 512 + 8 * lane);
#pragma unroll
        for (int k = 0; k < 4; ++k) { const int sk = __shfl(slot, k); *(u32x4*)(XS + (size_t)sk * DM + 8 * lane) = r0; *(u32x4*)(XS + (size_t)sk * DM + 512 + 8 * lane) = r1; }
    }
}

__device__ __forceinline__ void ph_combine(const Args& a, const float* X1, float* Xo, const float* next_norm_w, int gw, int NGW, int lane) {
    const bf16* YS = (const bf16*)(a.ws + WS_YS); const int* SLOT = (const int*)(a.ws + WS_SLOT); const float* EW = (const float*)(a.ws + WS_EW); bf16* XN = (bf16*)(a.ws + WS_XN);
    for (int tok = gw; tok < NT; tok += NGW) {
        int slot = 0; float wgt = 0.f;
        if (lane < 4) { slot = SLOT[(size_t)tok * 4 + lane]; wgt = EW[(size_t)tok * 4 + lane]; }
        f32x4 v[4];
#pragma unroll
        for (int j = 0; j < 4; ++j) v[j] = *(const f32x4*)(X1 + (size_t)tok * DM + 4 * (64 * j + lane));
#pragma unroll
        for (int k = 0; k < 4; ++k) { const int sk = __shfl(slot, k); const float wk = __shfl(wgt, k);
#pragma unroll
            for (int j = 0; j < 4; ++j) { const u32x2 y = *(const u32x2*)(YS + (size_t)sk * DM + 4 * (64 * j + lane));
                v[j].x += wk * bf_lo(y.x); v[j].y += wk * bf_hi(y.x); v[j].z += wk * bf_lo(y.y); v[j].w += wk * bf_hi(y.y); } }
#pragma unroll
        for (int j = 0; j < 4; ++j) *(f32x4*)(Xo + (size_t)tok * DM + 4 * (64 * j + lane)) = v[j];
        if (next_norm_w) rms_row_to_bf16(v, next_norm_w, XN + (size_t)tok * DM, lane);
    }
}

struct Tid { int tid, lane, wave; };
__device__ __forceinline__ Tid fresh_tid() { int t = threadIdx.x; asm volatile("" : "+v"(t)); Tid r; r.tid = t; r.lane = t & 63; r.wave = __builtin_amdgcn_readfirstlane(t >> 6); return r; }
#define FT() Args A_ = args_k; { unsigned char* w_ = args_k.ws; asm volatile("" : "+s"(w_)); A_.ws = w_; } const Args& args = A_; const Tid T_ = fresh_tid(); const int tid = T_.tid, lane = T_.lane, wave = T_.wave, gw = bid * NWAVES + wave; (void)tid; (void)lane; (void)wave; (void)gw
constexpr int PH_PER_LAYER = 11, NPH = 2 + NLAYER * PH_PER_LAYER;

#if SINGLE_LAUNCH
#define BARPARM , const XcdBarrier& bar
#define BARARG , bar
#define GRID_BAR() xcd_barrier(bar)
#else
#define BARPARM
#define BARARG
#define GRID_BAR() do {} while (0)
#endif
#define IN(k) (lo <= (k) && (k) < hi)
#define SEAM(k) do { if (IN(k) && IN((k) + 1)) GRID_BAR(); } while (0)
template <int l>
__device__ __forceinline__ void run_layer(const Args& args_k, LAS unsigned char* lds, int lo, int hi, int G, int bid, int NGW BARPARM) {
        const int pb = 2 + l * PH_PER_LAYER;
#define Xin ((l == 0) ? args.in[0] : (const float*)(args.ws + WS_XB))
#define X1 ((float*)(args.ws + WS_XA))
#define Xout ((l == NLAYER - 1) ? args.out : (float*)(args.ws + WS_XB))
        if (IN(pb + 0)) {
            FT(); pg8::Gemm g{(const pg8::bf16_t*)(args.ws + WS_XN), (const pg8::bf16_t*)(args.ws + WS_WIN) + (size_t)l * NP * DM, NT, NP, DM};
            pg8::StaticOrder S; S.init(NT, NP, G, bid);
            pg8::EpiBf16Plain E{(pg8::bf16_t*)(args.ws + WS_P), NP};
            pg8::gemm_phase<pg8::EpiBf16Plain, pg8::StaticOrder, true, true>(lds, g, S, E);
        } SEAM(pb + 0);
        if (IN(pb + 1)) { { FT(); ph_compress_mfma(args, l, lds, bid, G, tid, wave, lane); } { FT(); ph_m1(args, l, lds, bid, G, tid, wave, lane); } } SEAM(pb + 1);
        if (IN(pb + 2)) { { FT(); ph_dn_chunk(args, lds, bid, G, tid, wave, lane); } __syncthreads(); { FT(); ph_nsa_mfma(args, lds, bid, G, tid, wave, lane); } } SEAM(pb + 2);
        if (IN(pb + 3)) { FT(); ph_dn_scan(args, lds, bid, G, tid); } SEAM(pb + 3);
        if (IN(pb + 4)) { FT(); ph_dn_out(args, l, gw, NGW, lane); } SEAM(pb + 4);
        if (IN(pb + 5)) {
            FT(); pg8::Gemm g{(const pg8::bf16_t*)(args.ws + WS_Y), (const pg8::bf16_t*)(args.ws + WS_WOUT) + (size_t)l * DM * DM, NT, DM, DM};
            pg8::StaticOrder S; S.init(NT, DM, G, bid);
            pg8::EpiResF32 E{Xin, X1, DM};
            pg8::gemm_phase<pg8::EpiResF32, pg8::StaticOrder, true, true>(lds, g, S, E);
        } SEAM(pb + 5);
        if (IN(pb + 6)) { FT(); ph_router(args, l, X1, lds, bid, G, tid, wave, lane); } SEAM(pb + 6);
        if (IN(pb + 7)) { FT(); ph_gather(args, l, lds, gw, NGW, tid, lane); } SEAM(pb + 7);
        if (IN(pb + 8)) {
            FT(); LAS int* TS = (LAS int*)(lds + TS_OFF); LAS int* TE = (LAS int*)(lds + TE_OFF);
            build_tiles((const unsigned*)(args.ws + WS_CTL) + CW_CNT + 64 * l, TS, TE, tid);
            const int ntiles = __builtin_amdgcn_readfirstlane(TS[NE]);
            pg8::Gemm g{(const pg8::bf16_t*)(args.ws + WS_XS), (const pg8::bf16_t*)(args.ws + WS_WGU) + (size_t)l * NE * 2048 * DM, ntiles * 256, NE * 2048, DM};
            pg8::MoeOrder<8> S{ntiles * 8, G, bid, (const LAS int*)TE};
            pg8::EpiSwiglu E{(pg8::bf16_t*)(args.ws + WS_ACT), args.in[21] + (size_t)l * NE * 2048};
            pg8::gemm_phase<pg8::EpiSwiglu, pg8::MoeOrder<8>, true, true>(lds, g, S, E);
        } SEAM(pb + 8);
        if (IN(pb + 9)) {
            FT(); LAS int* TS = (LAS int*)(lds + TS_OFF); LAS int* TE = (LAS int*)(lds + TE_OFF);
            build_tiles((const unsigned*)(args.ws + WS_CTL) + CW_CNT + 64 * l, TS, TE, tid);
            const int ntiles = __builtin_amdgcn_readfirstlane(TS[NE]);
            pg8::Gemm g{(const pg8::bf16_t*)(args.ws + WS_ACT), (const pg8::bf16_t*)(args.ws + WS_WD) + (size_t)l * NE * DM * DM, ntiles * 256, NE * DM, DM};
            pg8::MoeOrder<4> S{ntiles * 4, G, bid, (const LAS int*)TE};
            pg8::EpiDown E{(pg8::bf16_t*)(args.ws + WS_YS), args.in[23] + (size_t)l * NE * DM};
            pg8::gemm_phase<pg8::EpiDown, pg8::MoeOrder<4>, true, true>(lds, g, S, E);
        } SEAM(pb + 9);
        if (IN(pb + 10)) { FT(); ph_combine(args, X1, Xout, (l + 1 < NLAYER) ? args.in[1] + (size_t)(l + 1) * DM : nullptr, gw, NGW, lane); }
        if (l + 1 < NLAYER) SEAM(pb + 10);
    }

__global__ void __launch_bounds__(NTHR, 2) fwd_kernel(Args args_k) {
    extern __shared__ __attribute__((aligned(16))) unsigned char lds_raw[];
    LAS unsigned char* lds = (LAS unsigned char*)lds_raw;
    const int G = gridDim.x, bid = blockIdx.x, NGW = G * NWAVES;
    for (int u = threadIdx.x; u < (LDS_BYTES - LDSCTL_OFF) / 4; u += NTHR) ((LAS unsigned*)(lds + LDSCTL_OFF))[u] = 0u;
    __syncthreads();
#if SINGLE_LAUNCH
    XcdBarrier bar = xcd_barrier_post((unsigned*)(args_k.ws + WS_CTL) + CW_BAR, (volatile LAS unsigned*)(lds + MISC_OFF) + 8);
#endif
    const int lo = args_k.ph_lo, hi = args_k.ph_hi;

    if (IN(0)) { FT(); ph_prologue(args, lds, gw, NGW, wave, lane); } SEAM(0);
    if (IN(1)) { FT(); ph_norm0(args, gw, NGW, lane); } SEAM(1);

    run_layer<0>(args_k, lds, lo, hi, G, bid, NGW BARARG);
    run_layer<1>(args_k, lds, lo, hi, G, bid, NGW BARARG);
#undef IN
#undef SEAM
}

extern "C" void kernel_launch(void* const* d_in, const int* in_sizes, int n_in, void* d_out, int out_size, void* d_ws, size_t ws_size, hipStream_t stream) {
    static int grid = 0;
    if (grid == 0) {
        if (n_in != 25 || in_sizes[0] != NT * DM || out_size != NT * DM || ws_size < WS_END) {
            fprintf(stderr, "kernel_launch: unexpected problem (n_in %d, in0 %d, out %d, ws %zu < %zu); nothing launched\n", n_in, n_in > 0 ? in_sizes[0] : -1, out_size, ws_size, (size_t)WS_END); grid = -1; return; }
        int dev = 0, cus = 0, per_cu = 0;
        if (hipGetDevice(&dev) != hipSuccess || hipDeviceGetAttribute(&cus, hipDeviceAttributeMultiprocessorCount, dev) != hipSuccess) { grid = -1; return; }
        if (hipFuncSetAttribute((const void*)fwd_kernel, hipFuncAttributeMaxDynamicSharedMemorySize, LDS_BYTES) != hipSuccess) { fprintf(stderr, "kernel_launch: hipFuncSetAttribute failed\n"); grid = -1; return; }
        if (hipOccupancyMaxActiveBlocksPerMultiprocessor(&per_cu, (const void*)fwd_kernel, NTHR, LDS_BYTES) != hipSuccess || per_cu < 1)
            fprintf(stderr, "kernel_launch: note: occupancy query reports %d workgroups per CU\n", per_cu);
        (void)hipGetLastError();
        grid = cus;
    }
    if (grid < 0) return;
    if (hipMemsetAsync((char*)d_ws + WS_CTL, 0, CTL_ZERO_BYTES, stream) != hipSuccess) { fprintf(stderr, "kernel_launch: memset failed\n"); return; }
    Args a{};
    for (int i = 0; i < 25; ++i) a.in[i] = (const float*)d_in[i];
    a.out = (float*)d_out; a.ws = (unsigned char*)d_ws;
#if SINGLE_LAUNCH
    a.ph_lo = 0; a.ph_hi = NPH;
    hipLaunchKernelGGL(fwd_kernel, dim3(grid), dim3(NTHR), LDS_BYTES, stream, a);
#else
    for (int ph = 0; ph < NPH; ++ph) { a.ph_lo = ph; a.ph_hi = ph + 1; hipLaunchKernelGGL(fwd_kernel, dim3(grid), dim3(NTHR), LDS_BYTES, stream, a); }
#endif
}
```

```cpp
#include <hip/hip_runtime.h>
#include <cstdio>
#include <cstdint>
#include <cstddef>
namespace pg8 {
#define PG8_LAS __attribute__((address_space(3)))
typedef unsigned short bf16_t;
typedef short bf16x8 __attribute__((ext_vector_type(8)));
typedef float f32x4 __attribute__((ext_vector_type(4)));
typedef unsigned u32x4 __attribute__((ext_vector_type(4)));
constexpr int BM = 256, BK = 64, HALF = 128, HTB = HALF * BK * 2  , STAGE_BYTES = 8 * HTB, NXCD = 8, WGM = 8;

__host__ __device__ __forceinline__ int lds_byte(int r, int c) { const int st = (r >> 4) * 2 + (c >> 5), rr = r & 15, cc = c & 31, ob = rr * 64 + cc * 2; return st * 1024 + (ob ^ (((ob >> 9) & 1) << 5)); }
__host__ __device__ __forceinline__ void stage_rc(int b, int& R, int& C) { const int st = b / 1024, sb = b % 1024, swz = sb ^ (((sb >> 9) & 1) << 5); R = (st >> 1) * 16 + swz / 64; C = (st & 1) * 32 + (swz % 64) / 2; }
__host__ __device__ __forceinline__ int perm32(int rho) { const int n = rho >> 4, i = rho & 15; return 8 * (i >> 2) + 4 * n + (i & 3); }

struct Unit { int pm, pn; };
struct Gemm { const bf16_t* A; const bf16_t* Bt; int M, N, K; };

struct StaticOrder {
    int nM, nN, nwg, G, c;
    __host__ __device__ void init(int M, int N, int G_, int c_) { nM = M / BM; nN = N / BM; nwg = nM * nN; G = G_; c = c_; }
    __host__ __device__ bool next(int i, Unit& u) const {
        const long L = (long)i * G + c; if (L >= nwg) return false;
        int wgid = (int)L; { const int q = nwg / NXCD, r = nwg % NXCD, xcd = wgid % NXCD, off = wgid / NXCD; wgid = (xcd < r ? xcd * (q + 1) : r * (q + 1) + (xcd - r) * q) + off; }
        const int nig = WGM * nN, gid = wgid / nig, fm = gid * WGM, gsz = (nM - fm) < WGM ? (nM - fm) : WGM;
        u.pm = fm + ((wgid % nig) % gsz); u.pn = (wgid % nig) / gsz; return true;
    }
    __device__ __forceinline__ void a_ready(const Unit&) const {}
    __device__ __forceinline__ void done(const Unit&) const {}
};

__device__ __forceinline__ unsigned cvt_pk_bf16(float lo, float hi) { unsigned r; asm volatile("v_cvt_pk_bf16_f32 %0, %1, %2" : "=v"(r) : "v"(lo), "v"(hi)); return r; }

struct EpiBf16Plain {
    static constexpr bool PERM = true, AFTER_DRAIN = false;
    bf16_t* O; int ldc;
    __device__ __forceinline__ void operator()(const f32x4 (&acc)[2][2][4][2], const Unit& u, int wr, int wc, int fr, int fq) const {
        const int row0 = u.pm * BM + wr * 64 + fr, col0 = u.pn * BM + wc * 32 + 8 * fq;
#pragma unroll
        for (int ai = 0; ai < 2; ++ai)
#pragma unroll
            for (int m = 0; m < 4; ++m) { bf16_t* rowp = O + (size_t)(row0 + ai * HALF + m * 16) * ldc + col0;
#pragma unroll
                for (int bj = 0; bj < 2; ++bj) { const f32x4 v0 = acc[ai][bj][m][0], v1 = acc[ai][bj][m][1];
                    u32x4 w; w.x = cvt_pk_bf16(v0[0], v0[1]); w.y = cvt_pk_bf16(v0[2], v0[3]); w.z = cvt_pk_bf16(v1[0], v1[1]); w.w = cvt_pk_bf16(v1[2], v1[3]);
                    *(u32x4*)(rowp + bj * HALF) = w; } }
    }
};
struct EpiResF32 {
    static constexpr bool PERM = false, AFTER_DRAIN = false;
    const float* base; float* out; int ldc;
    __device__ __forceinline__ void operator()(const f32x4 (&acc)[2][2][4][2], const Unit& u, int wr, int wc, int fr, int fq) const {
        const int row0 = u.pm * BM + wr * 64 + fr, col0 = u.pn * BM + wc * 32 + 4 * fq;
#pragma unroll
        for (int ai = 0; ai < 2; ++ai)
#pragma unroll
            for (int m = 0; m < 4; ++m) { const size_t off = (size_t)(row0 + ai * HALF + m * 16) * ldc + col0;
#pragma unroll
                for (int bj = 0; bj < 2; ++bj)
#pragma unroll
                    for (int n = 0; n < 2; ++n) { const f32x4 b = *(const f32x4*)(base + off + bj * HALF + n * 16); *(f32x4*)(out + off + bj * HALF + n * 16) = b + acc[ai][bj][m][n]; } }
    }
};
struct EpiSwiglu {
    static constexpr bool PERM = true, AFTER_DRAIN = false;
    bf16_t* O; const float* bgu;
    __device__ __forceinline__ void operator()(const f32x4 (&acc)[2][2][4][2], const Unit& u, int wr, int wc, int fr, int fq) const {
        const int e = u.pn >> 3, pnl = u.pn & 7;
        const int row0 = u.pm * BM + wr * 64 + fr, gcol = pnl * 128 + wc * 32 + 8 * fq;
        const float* bg = bgu + (size_t)e * 2048 + gcol;
        f32x4 bgv[2], buv[2];
#pragma unroll
        for (int n = 0; n < 2; ++n) { bgv[n] = *(const f32x4*)(bg + 4 * n); buv[n] = *(const f32x4*)(bg + 1024 + 4 * n); }
#pragma unroll
        for (int ai = 0; ai < 2; ++ai)
#pragma unroll
            for (int m = 0; m < 4; ++m) { bf16_t* rowp = O + (size_t)(row0 + ai * HALF + m * 16) * 1024 + gcol;
                float r[8];
#pragma unroll
                for (int n = 0; n < 2; ++n) { const f32x4 gv = acc[ai][0][m][n] + bgv[n], uv = acc[ai][1][m][n] + buv[n];
#pragma unroll
                    for (int j = 0; j < 4; ++j) { const float g = fminf(gv[j], 7.0f), up = fminf(fmaxf(uv[j], -7.0f), 7.0f);
                        const float sg = __builtin_amdgcn_rcpf(1.0f + __expf(-1.702f * g)); r[n * 4 + j] = (up + 1.0f) * g * sg; } }
                u32x4 w; w.x = cvt_pk_bf16(r[0], r[1]); w.y = cvt_pk_bf16(r[2], r[3]); w.z = cvt_pk_bf16(r[4], r[5]); w.w = cvt_pk_bf16(r[6], r[7]);
                *(u32x4*)rowp = w; }
    }
};
struct EpiDown {
    static constexpr bool PERM = true, AFTER_DRAIN = false;
    bf16_t* O; const float* bd;
    __device__ __forceinline__ void operator()(const f32x4 (&acc)[2][2][4][2], const Unit& u, int wr, int wc, int fr, int fq) const {
        const int e = u.pn >> 2, pnl = u.pn & 3;
        const int row0 = u.pm * BM + wr * 64 + fr, col0 = pnl * BM + wc * 32 + 8 * fq;
        const float* bp = bd + (size_t)e * 1024 + col0;
        f32x4 bv[2][2];
#pragma unroll
        for (int bj = 0; bj < 2; ++bj)
#pragma unroll
            for (int n = 0; n < 2; ++n) bv[bj][n] = *(const f32x4*)(bp + bj * HALF + 4 * n);
#pragma unroll
        for (int ai = 0; ai < 2; ++ai)
#pragma unroll
            for (int m = 0; m < 4; ++m) { bf16_t* rowp = O + (size_t)(row0 + ai * HALF + m * 16) * 1024 + col0;
#pragma unroll
                for (int bj = 0; bj < 2; ++bj) { const f32x4 v0 = acc[ai][bj][m][0] + bv[bj][0], v1 = acc[ai][bj][m][1] + bv[bj][1];
                    u32x4 w; w.x = cvt_pk_bf16(v0[0], v0[1]); w.y = cvt_pk_bf16(v0[2], v0[3]); w.z = cvt_pk_bf16(v1[0], v1[1]); w.w = cvt_pk_bf16(v1[2], v1[3]);
                    *(u32x4*)(rowp + bj * HALF) = w; } }
    }
};
template <int NPN> struct MoeOrder {
    int nunits, G, c; const PG8_LAS int* texp;
    __device__ __forceinline__ bool next(int i, Unit& u) const {
        const int L = __builtin_amdgcn_readfirstlane(i * G + c); if (L >= nunits) return false;
        const int mt = L / NPN, pn = L % NPN;
        const int e = __builtin_amdgcn_readfirstlane(texp[mt]);
        u.pm = mt; u.pn = e * NPN + pn; return true;
    }
    __device__ __forceinline__ void a_ready(const Unit&) const {}
    __device__ __forceinline__ void done(const Unit&) const {}
};

template <class Epi, class Sched, bool ALIGN_EPI = false, bool SP2 = false>
__device__ __forceinline__ void gemm_phase(PG8_LAS unsigned char* lds, const Gemm g, const Sched& S, const Epi& E) {
    int tid_ = threadIdx.x; asm volatile("" : "+v"(tid_));
    const int tid = tid_, wid = __builtin_amdgcn_readfirstlane(tid >> 6), lane = tid & 63, wr = wid >> 2, wc = wid & 3, fr = lane & 15, fq = lane >> 4;
    const int K = g.K, nt = K / BK;
    unsigned voffA[2], voffB[2];
#pragma unroll
    for (int i = 0; i < 2; ++i) { int R, C; stage_rc(tid * 16 + i * 8192, R, C); const int Rb = Epi::PERM ? ((R & ~31) + perm32(R & 31)) : R;
        voffA[i] = (unsigned)(R * K + C) * 2u; voffB[i] = (unsigned)(Rb * K + C) * 2u; }
    const size_t kstep = (size_t)(BK * 2);
    const size_t hstep = (size_t)HALF * K * 2;
    const size_t tstep = 2 * hstep;
    const unsigned ldsw = (unsigned)wid * 1024u;
    const int aoff = lds_byte(wr * 64 + fr, fq * 8), boff = lds_byte(wc * 32 + fr, fq * 8);
#define PG8_SA(b, h) (((b) * 2 + (h)) * HTB)
#define PG8_SB(b, h) ((4 + (b) * 2 + (h)) * HTB)
#define PG8_STAGE(bufoff, gbase, voff) do { _Pragma("unroll") for (int _i = 0; _i < 2; ++_i) \
        __builtin_amdgcn_global_load_lds((const unsigned*)((const char*)(gbase) + (voff)[_i]), (PG8_LAS unsigned*)(lds + (bufoff) + ldsw + _i * 8192), 16, 0, 0); } while (0)
#define PG8_LDA(dst, b, h) do { _Pragma("unroll") for (int m = 0; m < 4; ++m) _Pragma("unroll") for (int k = 0; k < 2; ++k) dst[m][k] = *(const PG8_LAS bf16x8*)(lds + PG8_SA(b, h) + aoff + m * 2048 + k * 1024); } while (0)
#define PG8_LDB(dst, b, h) do { _Pragma("unroll") for (int n = 0; n < 2; ++n) _Pragma("unroll") for (int k = 0; k < 2; ++k) dst[n][k] = *(const PG8_LAS bf16x8*)(lds + PG8_SB(b, h) + boff + n * 2048 + k * 1024); } while (0)
#define PG8_MMA(ai, bj, At, Bt) do { __builtin_amdgcn_s_setprio(1); _Pragma("unroll") for (int m = 0; m < 4; ++m) _Pragma("unroll") for (int n = 0; n < 2; ++n) _Pragma("unroll") for (int k = 0; k < 2; ++k) \
        acc[ai][bj][m][n] = __builtin_amdgcn_mfma_f32_16x16x32_bf16(Bt[n][k], At[m][k], acc[ai][bj][m][n], 0, 0, 0); __builtin_amdgcn_s_setprio(0); } while (0)
#define PG8_WAIT_V(n) asm volatile("s_waitcnt vmcnt(" #n ")" ::: "memory")
#define PG8_WAIT_L(n) asm volatile("s_waitcnt lgkmcnt(" #n ")" ::: "memory")
#define PG8_BAR __builtin_amdgcn_s_barrier()
#define PG8_SCHED __builtin_amdgcn_sched_barrier(0)
    Unit cur, nxt; int ui = 0;
    if (!S.next(0, cur)) return;
    f32x4 acc[2][2][4][2];
#pragma unroll
    for (int a = 0; a < 2; ++a)
#pragma unroll
        for (int b = 0; b < 2; ++b)
#pragma unroll
            for (int m = 0; m < 4; ++m)
#pragma unroll
                for (int n = 0; n < 2; ++n) acc[a][b][m][n] = (f32x4){0.f, 0.f, 0.f, 0.f};
    bf16x8 At[4][2], B0[2][2], B1[2][2];
    const char* cA = (const char*)g.A + (size_t)cur.pm * tstep; const char* cB = (const char*)g.Bt + (size_t)cur.pn * tstep;
    S.a_ready(cur);
    if constexpr (SP2) {
        PG8_STAGE(PG8_SB(0, 0), cB, voffB); PG8_STAGE(PG8_SB(0, 1), cB + hstep, voffB); PG8_STAGE(PG8_SA(0, 0), cA, voffA); PG8_STAGE(PG8_SA(0, 1), cA + hstep, voffA);
        if (wr == 1) PG8_BAR;
        PG8_WAIT_V(2); PG8_BAR;
        PG8_STAGE(PG8_SB(1, 0), cB + kstep, voffB); PG8_STAGE(PG8_SA(1, 0), cA + kstep, voffA); PG8_STAGE(PG8_SB(1, 1), cB + hstep + kstep, voffB);
        PG8_WAIT_V(6); PG8_BAR;
    } else {
        PG8_STAGE(PG8_SB(0, 0), cB, voffB); PG8_STAGE(PG8_SA(0, 0), cA, voffA); PG8_STAGE(PG8_SB(0, 1), cB + hstep, voffB); PG8_STAGE(PG8_SA(0, 1), cA + hstep, voffA);
        if (wr == 1) PG8_BAR;
        PG8_WAIT_V(4); PG8_BAR;
        PG8_STAGE(PG8_SB(1, 0), cB + kstep, voffB); PG8_STAGE(PG8_SA(1, 0), cA + kstep, voffA); PG8_STAGE(PG8_SB(1, 1), cB + hstep + kstep, voffB);
        PG8_WAIT_V(6); PG8_BAR;
    }
    for (;;) {
        const bool has_next = S.next(ui + 1, nxt);
        const char* nA = has_next ? (const char*)g.A + (size_t)nxt.pm * tstep : cA; const char* nB = has_next ? (const char*)g.Bt + (size_t)nxt.pn * tstep : cB;
        for (int t = 0; t < nt; t += 2) {
            const bool last = (t == nt - 2);
            const char* a1 = cA + (size_t)(t + 1) * kstep;
            const char* a2 = last ? nA : cA + (size_t)(t + 2) * kstep; const char* b2 = last ? nB : cB + (size_t)(t + 2) * kstep;
            const char* a3 = a2 + kstep; const char* b3 = b2 + kstep;
            if (last && has_next) S.a_ready(nxt);
            if constexpr (SP2) {
            PG8_LDB(B0, 0, 0); PG8_LDB(B1, 0, 1); PG8_SCHED; PG8_LDA(At, 0, 0); PG8_STAGE(PG8_SA(1, 1), a1 + hstep, voffA);
            PG8_WAIT_V(8); PG8_WAIT_L(0); PG8_BAR; PG8_MMA(0, 0, At, B0); PG8_MMA(0, 1, At, B1); PG8_BAR; PG8_SCHED;
            PG8_LDA(At, 0, 1); PG8_STAGE(PG8_SB(0, 0), b2, voffB); PG8_STAGE(PG8_SB(0, 1), b2 + hstep, voffB); PG8_STAGE(PG8_SA(0, 0), a2, voffA);
            PG8_WAIT_V(8); PG8_WAIT_L(0); PG8_BAR; PG8_MMA(1, 0, At, B0); PG8_MMA(1, 1, At, B1); PG8_BAR; PG8_SCHED;
            PG8_LDB(B0, 1, 0); PG8_LDB(B1, 1, 1); PG8_SCHED; PG8_LDA(At, 1, 0); PG8_STAGE(PG8_SA(0, 1), a2 + hstep, voffA);
            PG8_WAIT_V(8); PG8_WAIT_L(0); PG8_BAR; PG8_MMA(0, 0, At, B0); PG8_MMA(0, 1, At, B1); PG8_BAR; PG8_SCHED;
            PG8_LDA(At, 1, 1); PG8_STAGE(PG8_SB(1, 0), b3, voffB); PG8_STAGE(PG8_SB(1, 1), b3 + hstep, voffB); PG8_STAGE(PG8_SA(1, 0), a3, voffA);
            PG8_WAIT_V(8); PG8_WAIT_L(0); PG8_BAR; PG8_MMA(1, 0, At, B0); PG8_MMA(1, 1, At, B1); PG8_BAR; PG8_SCHED;
            } else {
            PG8_LDB(B0, 0, 0); PG8_SCHED; PG8_LDA(At, 0, 0); PG8_STAGE(PG8_SA(1, 1), a1 + hstep, voffA);
            PG8_WAIT_L(8); PG8_BAR; PG8_WAIT_L(0); PG8_MMA(0, 0, At, B0); PG8_BAR; PG8_SCHED;
            PG8_LDB(B1, 0, 1); PG8_STAGE(PG8_SB(0, 0), b2, voffB);
            PG8_BAR; PG8_WAIT_L(0); PG8_MMA(0, 1, At, B1); PG8_BAR;
            PG8_LDA(At, 0, 1); PG8_STAGE(PG8_SA(0, 0), a2, voffA);
            PG8_BAR; PG8_WAIT_L(0); PG8_MMA(1, 0, At, B0); PG8_BAR; PG8_SCHED;
            PG8_STAGE(PG8_SB(0, 1), b2 + hstep, voffB);
            PG8_WAIT_V(6); PG8_BAR; PG8_MMA(1, 1, At, B1); PG8_BAR;
            PG8_LDB(B0, 1, 0); PG8_SCHED; PG8_LDA(At, 1, 0); PG8_STAGE(PG8_SA(0, 1), a2 + hstep, voffA);
            PG8_WAIT_L(8); PG8_BAR; PG8_WAIT_L(0); PG8_MMA(0, 0, At, B0); PG8_BAR; PG8_SCHED;
            PG8_LDB(B1, 1, 1); PG8_STAGE(PG8_SB(1, 0), b3, voffB);
            PG8_BAR; PG8_WAIT_L(0); PG8_MMA(0, 1, At, B1); PG8_BAR;
            PG8_LDA(At, 1, 1); PG8_STAGE(PG8_SA(1, 0), a3, voffA);
            PG8_BAR; PG8_WAIT_L(0); PG8_MMA(1, 0, At, B0); PG8_BAR; PG8_SCHED;
            PG8_STAGE(PG8_SB(1, 1), b3 + hstep, voffB);
            PG8_WAIT_V(6); PG8_BAR; PG8_MMA(1, 1, At, B1); PG8_BAR;
            }
        }
        if constexpr (ALIGN_EPI) { if (wr == 0) PG8_BAR; }
        if constexpr (!Epi::AFTER_DRAIN) { E(acc, cur, wr, wc, fr, fq); S.done(cur); }
        if (!has_next) break;
#pragma unroll
        for (int a = 0; a < 2; ++a)
#pragma unroll
            for (int b = 0; b < 2; ++b)
#pragma unroll
                for (int m = 0; m < 4; ++m)
#pragma unroll
                    for (int n = 0; n < 2; ++n) acc[a][b][m][n] = (f32x4){0.f, 0.f, 0.f, 0.f};
        cur = nxt; cA = nA; cB = nB; ++ui;
        if constexpr (ALIGN_EPI) { if (wr == 1) PG8_BAR; }
    }
    PG8_WAIT_V(0);
    if constexpr (!ALIGN_EPI) { if (wr == 0) PG8_BAR; }
    PG8_BAR;
    if constexpr (Epi::AFTER_DRAIN) { E.fused(acc, cur, wr, wc, fr, fq, lds, wid, lane); S.done(cur); }
#undef PG8_SA
#undef PG8_SB
#undef PG8_STAGE
#undef PG8_LDA
#undef PG8_LDB
#undef PG8_MMA
#undef PG8_WAIT_V
#undef PG8_WAIT_L
#undef PG8_BAR
#undef PG8_SCHED
}
}


#define GAS __attribute__((address_space(1)))
typedef unsigned short bf16;
typedef float f32x4 __attribute__((ext_vector_type(4)));
typedef unsigned u32x4 __attribute__((ext_vector_type(4)));
typedef unsigned u32x2 __attribute__((ext_vector_type(2)));
typedef short bf16x8 __attribute__((ext_vector_type(8)));
typedef float f32x16 __attribute__((ext_vector_type(16)));

#ifndef SINGLE_LAUNCH
#define SINGLE_LAUNCH 1
#endif

constexpr int NB = 8, SEQ = 2048, DM = 1024, NT = NB * SEQ, NLAYER = 2;
constexpr int DIN = 3220, NP = 3328;
constexpr int C_Q = 0, C_K = 512, C_V = 1024, C_Z = 1536, C_NQ = 2048, C_KV = 2304, C_CU = 2688, C_A = 3200, C_B = 3204, C_G = 3208;
constexpr int NE = 32, MAXT = 288;
constexpr int NWAVES = 8, NTHR = 512;
constexpr float EPS = 1e-6f;

constexpr size_t MiB = 1u << 20;
constexpr size_t WS_CTL = 0, CTL_ZERO_BYTES = 1 * MiB;
constexpr size_t WS_BT = 1 * MiB;
constexpr size_t WS_KCMP = 1 * MiB + 256 * 1024, WS_VCMP = 1 * MiB + 512 * 1024;
constexpr size_t WS_G = 2 * MiB, WS_BETA = 2 * MiB + 256 * 1024, WS_GC = 2 * MiB + 512 * 1024;
constexpr size_t WS_EIDX = 3 * MiB, WS_EPOS = 3 * MiB + 256 * 1024, WS_EW = 3 * MiB + 512 * 1024, WS_SLOT = 3 * MiB + 768 * 1024;
constexpr size_t WS_WIN = 4 * MiB;
constexpr size_t WS_WOUT = 17 * MiB;
constexpr size_t WS_WGU = 22 * MiB;
constexpr size_t WS_WD = 278 * MiB;
constexpr size_t WS_XA = 406 * MiB, WS_XB = 470 * MiB;
constexpr size_t WS_XN = 534 * MiB;
constexpr size_t WS_P = 566 * MiB;
constexpr size_t WS_QN = 670 * MiB, WS_KN = 686 * MiB, WS_VC = 702 * MiB;
constexpr size_t WS_U = 718 * MiB, WS_W = 750 * MiB;
constexpr size_t WS_ATT = 782 * MiB;
constexpr size_t WS_O = 798 * MiB;
constexpr size_t WS_NQ = 830 * MiB;
constexpr size_t WS_KS = 846 * MiB, WS_KW = 848 * MiB;
constexpr size_t WS_Y = 850 * MiB;
constexpr size_t WS_XS = 882 * MiB, WS_ACT = 1026 * MiB, WS_YS = 1170 * MiB;
constexpr size_t WS_KT = 1314 * MiB, WS_VT = 1330 * MiB;
constexpr size_t WS_W1T = 1346 * MiB;
constexpr size_t WS_POSW = 1349 * MiB;
constexpr size_t WS_END = 1350 * MiB;

constexpr int CW_TMO = 0, CW_BAR = 4096, CW_CNT = 16384;

constexpr int RING_BYTES = 131072;
constexpr int LDSCTL_OFF = RING_BYTES, MISC_OFF = LDSCTL_OFF, TS_OFF = LDSCTL_OFF + 128, TE_OFF = LDSCTL_OFF + 320;
constexpr int LDS_BYTES = 147456;
static_assert(TE_OFF + MAXT * 4 + 64 <= LDS_BYTES, "LDS map");

#define XB_TMO      128
#define XB_XCNT(j)  (256  + 64 * (j))
#define XB_XSUB(j)  (1280 + 64 * (j))
#define XB_XGEN(j)  (2304 + 64 * (j))
#define XB_TOP      3328
#define XB_TOPGEN   3392
#define XCD_BAR_WORDS 3456
#define XB_SPIN_CAP (1u << 22)
#define LAS __attribute__((address_space(3)))

__device__ __forceinline__ unsigned xb_ld(unsigned* p)              { return __hip_atomic_load(p, __ATOMIC_RELAXED, __HIP_MEMORY_SCOPE_AGENT); }
__device__ __forceinline__ unsigned xb_add(unsigned* p, unsigned v) { return __hip_atomic_fetch_add(p, v, __ATOMIC_RELAXED, __HIP_MEMORY_SCOPE_AGENT); }
__device__ __forceinline__ unsigned xb_xcc_id() { return (unsigned)__builtin_amdgcn_s_getreg((3 << 11) | 20) & 0xFu; }
#define XB_SPIN(cond, bar) do { unsigned _sp = 0; while (cond) { __builtin_amdgcn_s_sleep(1); \
    if ((++_sp & 255u) == 0u) { if (xb_ld(&(bar)[XB_TMO])) break; if (_sp > XB_SPIN_CAP) { atomicAdd(&(bar)[XB_TMO], 1u); break; } } } } while (0)

struct XcdBarrier {
    unsigned* bar; unsigned x;
    volatile LAS unsigned* st;
};

__device__ __forceinline__ XcdBarrier xcd_barrier_post(unsigned* bar, volatile LAS unsigned* st) {
    XcdBarrier b; b.bar = bar; b.x = xb_xcc_id(); b.st = st;
    if (threadIdx.x == 0) (void)xb_add(&bar[XB_XCNT(b.x)], 1u);
    return b;
}
__device__ __forceinline__ void xcd_barrier_complete(unsigned* bar, unsigned x, unsigned& nloc, unsigned& nx) {
    const unsigned G = gridDim.x * gridDim.y * gridDim.z;
    unsigned sum, cnt, mine, sp = 0u;
    for (;;) {
        sum = 0u; cnt = 0u; mine = 0u;
#pragma unroll
        for (unsigned j = 0; j < 16; ++j) { const unsigned c = xb_ld(&bar[XB_XCNT(j)]); sum += c; cnt += (c > 0u) ? 1u : 0u; mine = (j == x) ? c : mine; }
        if (sum == G) break;
        __builtin_amdgcn_s_sleep(1);
        if ((++sp & 255u) == 0u) { if (xb_ld(&bar[XB_TMO])) break; if (sp > XB_SPIN_CAP) { atomicAdd(&bar[XB_TMO], 1u); break; } }
    }
    nloc = mine > 0u ? mine : 1u; nx = cnt > 0u ? cnt : 1u;
}

__device__ __forceinline__ void xcd_barrier(const XcdBarrier& b) {
    asm volatile("s_waitcnt vmcnt(0)" ::: "memory");
    __syncthreads();
    if (threadIdx.x == 0) {
        unsigned* bar = b.bar;
        __builtin_amdgcn_s_waitcnt(0);
        unsigned nloc = b.st[0], nx = b.st[1];
        if (nloc == 0u) { xcd_barrier_complete(bar, b.x, nloc, nx); b.st[0] = nloc; b.st[1] = nx; }
        const unsigned old = xb_add(&bar[XB_XSUB(b.x)], 1u);
        const unsigned gen = old / nloc;
        if (old + 1u == (gen + 1u) * nloc) {
            __builtin_amdgcn_fence(__ATOMIC_RELEASE, "agent");
            asm volatile("s_waitcnt vmcnt(0)" ::: "memory");
            const unsigned og = xb_add(&bar[XB_TOP], 1u);
            const unsigned tg = og / nx;
            if (og + 1u == (tg + 1u) * nx) xb_add(&bar[XB_TOPGEN], 1u);
            else XB_SPIN(xb_ld(&bar[XB_TOPGEN]) == tg, bar);
            __builtin_amdgcn_fence(__ATOMIC_ACQUIRE, "agent");
            xb_add(&bar[XB_XGEN(b.x)], 1u);
            asm volatile("s_waitcnt vmcnt(0)" ::: "memory");
        } else {
            XB_SPIN(xb_ld(&bar[XB_XGEN(b.x)]) == gen, bar);
            __builtin_amdgcn_fence(__ATOMIC_ACQUIRE, "agent");
            asm volatile("s_waitcnt vmcnt(0)" ::: "memory");
        }
    }
    __syncthreads();
}


__device__ __forceinline__ float bf_lo(unsigned w) { return __uint_as_float(w << 16); }
__device__ __forceinline__ float bf_hi(unsigned w) { return __uint_as_float(w & 0xffff0000u); }
__device__ __forceinline__ float bf2f(bf16 v) { return __uint_as_float(((unsigned)v) << 16); }
__device__ __forceinline__ unsigned f2bf(float f) { unsigned u = __float_as_uint(f); return (u + 0x7fffu + ((u >> 16) & 1u)) >> 16; }
__device__ __forceinline__ unsigned pk2(float lo, float hi) { return f2bf(lo) | (f2bf(hi) << 16); }
__device__ __forceinline__ float wave_sum(float v) {
#pragma unroll
    for (int o = 1; o < 64; o <<= 1) v += __shfl_xor(v, o);
    return v;
}
__device__ __forceinline__ float wave_max(float v) {
#pragma unroll
    for (int o = 1; o < 64; o <<= 1) v = fmaxf(v, __shfl_xor(v, o));
    return v;
}
__device__ __forceinline__ float sigmoidf_(float x) { return 1.0f / (1.0f + __expf(-x)); }
__device__ __forceinline__ float siluf_(float x) { return x / (1.0f + __expf(-x)); }
#define LDS_WAIT() asm volatile("s_waitcnt lgkmcnt(0)" ::: "memory")

struct Args { const float* in[25]; float* out; unsigned char* ws; int ph_lo, ph_hi; };

__device__ __forceinline__ int map_win(int n);
__device__ __forceinline__ int map_gu(int n);
template <int MAP>
__device__ __forceinline__ void transpose_item(const float* W, int K, int N, bf16* WT, LAS float* scr, int item, int nblk, int lane) {
    const int kb = item / nblk, nb = item % nblk, k0 = 64 * kb, n0 = 32 * nb;
    const int nd = n0 + (lane & 31); const int src = MAP == 1 ? map_win(nd) : (MAP == 2 ? map_gu(nd) : nd);
#pragma unroll 8
    for (int i = 0; i < 32; ++i) { const int kk = 2 * i + (lane >> 5); scr[kk * 33 + (lane & 31)] = src >= 0 ? W[(size_t)(k0 + kk) * N + src] : 0.0f; }
    LDS_WAIT();
    const int c = lane & 7;
#pragma unroll
    for (int j = 0; j < 4; ++j) { const int n = (lane >> 3) + 8 * j; const LAS float* s = scr + (8 * c) * 33 + n;
        u32x4 o; o.x = pk2(s[0 * 33], s[1 * 33]); o.y = pk2(s[2 * 33], s[3 * 33]); o.z = pk2(s[4 * 33], s[5 * 33]); o.w = pk2(s[6 * 33], s[7 * 33]);
        *(u32x4*)(WT + (size_t)(n0 + n) * K + k0 + 8 * c) = o; }
    LDS_WAIT();
}
__device__ __forceinline__ int map_win(int n) {
    if (n < 2048) return n;
    if (n < C_KV) return 2056 + (n - C_NQ);
    if (n < C_CU) return 2312 + (n - C_KV);
    if (n < C_A) return 2708 + (n - C_CU);
    if (n < C_B) return 2048 + (n - C_A);
    if (n < C_G) return 2052 + (n - C_B);
    if (n < C_G + 12) return 2696 + (n - C_G);
    return -1;
}
__device__ __forceinline__ int map_gu(int n) { const int pn = n >> 8, r = n & 255; return (r < 128 ? 0 : 1024) + 128 * pn + (r & 127); }

__device__ __forceinline__ void ph_prologue(const Args& a, LAS unsigned char* lds, int gw, int NGW, int wave, int lane) {
    LAS float* scr = (LAS float*)(lds + wave * 16384);
    bf16* WinT = (bf16*)(a.ws + WS_WIN); bf16* WoutT = (bf16*)(a.ws + WS_WOUT); bf16* WguT = (bf16*)(a.ws + WS_WGU); bf16* WdT = (bf16*)(a.ws + WS_WD);
    constexpr int I_IN = 16 * (NP / 32), I_OUT = 16 * 32, I_GU = 16 * 64, I_D = 16 * 32;
    constexpr int N_IN = NLAYER * I_IN, N_OUT = NLAYER * I_OUT, N_GU = NLAYER * NE * I_GU, N_D = NLAYER * NE * I_D;
    for (int it = gw; it < N_IN + N_OUT + N_GU + N_D; it += NGW) {
        int r = it;
        if (r < N_IN) { const int l = r / I_IN; transpose_item<1>(a.in[2] + (size_t)l * DM * DIN, DM, DIN, WinT + (size_t)l * NP * DM, scr, r % I_IN, NP / 32, lane); continue; } r -= N_IN;
        if (r < N_OUT) { const int l = r / I_OUT; transpose_item<0>(a.in[16] + (size_t)l * DM * DM, DM, DM, WoutT + (size_t)l * DM * DM, scr, r % I_OUT, 32, lane); continue; } r -= N_OUT;
        if (r < N_GU) { const int le = r / I_GU; transpose_item<2>(a.in[20] + (size_t)le * DM * 2048, DM, 2048, WguT + (size_t)le * 2048 * DM, scr, r % I_GU, 64, lane); continue; } r -= N_GU;
        { const int le = r / I_D; transpose_item<0>(a.in[22] + (size_t)le * DM * DM, DM, DM, WdT + (size_t)le * DM * DM, scr, r % I_D, 32, lane); }
    }
    { bf16* W1T = (bf16*)(a.ws + WS_W1T);
        for (int it = gw; it < 4 * 128; it += NGW) { const int mtx = it >> 7; transpose_item<0>(a.in[10] + (size_t)mtx * 2048 * 128, 2048, 128, W1T + (size_t)mtx * 128 * 2048, scr, it & 127, 4, lane); }
        float* POSW = (float*)(a.ws + WS_POSW);
        const int id = gw * 64 + lane;
        if (id < 512) { const int mtx = id >> 7, n = id & 127; const float* w1 = a.in[10] + (size_t)mtx * 2048 * 128; const float* pos = a.in[9] + (size_t)mtx * 2048; float acc = 0.f;
            for (int k = 0; k < 2048; ++k) acc += pos[k] * w1[(size_t)k * 128 + n];
            POSW[id] = acc; } }
    float* BT = (float*)(a.ws + WS_BT);
    for (int i = gw * 64 + lane; i < 4 * 2048; i += NGW * 64) {
        const int h = i >> 11, n = i & 2047; int bk;
        if (n < 16) bk = n; else { const float v = logf((float)n / 16.0f) / 2.0794415416798357f * 16.0f; bk = 16 + (int)v; bk = bk < 31 ? bk : 31; }
        BT[i] = a.in[24][bk * 4 + h];
    }
}

__device__ __forceinline__ void rms_row_to_bf16(const f32x4 (&v)[4], const float* w, bf16* orow, int lane) {
    float s = 0.f;
#pragma unroll
    for (int j = 0; j < 4; ++j) s += (v[j].x * v[j].x + v[j].y * v[j].y) + (v[j].z * v[j].z + v[j].w * v[j].w);
    const float r = rsqrtf(wave_sum(s) * (1.0f / DM) + EPS);
#pragma unroll
    for (int j = 0; j < 4; ++j) { const f32x4 wv = *(const f32x4*)(w + 4 * (64 * j + lane)); const f32x4 y = v[j] * r * wv;
        u32x2 o; o.x = pk2(y.x, y.y); o.y = pk2(y.z, y.w); *(u32x2*)(orow + 4 * (64 * j + lane)) = o; }
}

__device__ __forceinline__ void ph_norm0(const Args& a, int gw, int NGW, int lane) {
    bf16* XN = (bf16*)(a.ws + WS_XN);
    for (int tok = gw; tok < NT; tok += NGW) {
        f32x4 v[4];
#pragma unroll
        for (int j = 0; j < 4; ++j) v[j] = *(const f32x4*)(a.in[0] + (size_t)tok * DM + 4 * (64 * j + lane));
        rms_row_to_bf16(v, a.in[1], XN + (size_t)tok * DM, lane);
    }
}

__device__ __forceinline__ void ph_compress_mfma(const Args& a, int l, LAS unsigned char* lds, int bid, int G, int tid, int wave, int lane) {
    LAS float* hid = (LAS float*)lds;
    const bf16* P = (const bf16*)(a.ws + WS_P); bf16* KCMP = (bf16*)(a.ws + WS_KCMP); bf16* VCMP = (bf16*)(a.ws + WS_VCMP);
    const int r = lane & 15, q = lane >> 4;
    for (int u = bid; u < 128; u += G) {
        const int b = u >> 4, kv = (u >> 3) & 1, j0 = 16 * (u & 7);
        const bf16* arow = P + (size_t)(b * SEQ) * NP + C_KV + kv * 64;
        const bf16* brow = (const bf16*)(a.ws + WS_W1T) + ((size_t)(l * 2 + kv) * 128 + 16 * wave + r) * 2048 + 8 * q;
        const float pw = ((const float*)(a.ws + WS_POSW))[(l * 2 + kv) * 128 + 16 * wave + r];
        f32x4 acc = {0.f, 0.f, 0.f, 0.f};
#pragma unroll 8
        for (int ks = 0; ks < 64; ++ks) { int tk = 16 * (j0 + r) + (ks >> 1); tk = tk < SEQ ? tk : SEQ - 1;
            const bf16x8 af = *(const bf16x8*)(arow + (size_t)tk * NP + (ks & 1) * 32 + 8 * q); const bf16x8 bfr = *(const bf16x8*)(brow + 32 * ks);
            acc = __builtin_amdgcn_mfma_f32_16x16x32_bf16(af, bfr, acc, 0, 0, 0); }
#pragma unroll
        for (int i = 0; i < 4; ++i) hid[(4 * q + i) * 132 + 16 * wave + r] = siluf_(acc[i] + pw);
        __syncthreads();
        { const int row = tid >> 5, c2 = tid & 31; const float* w2 = a.in[11] + (size_t)(l * 2 + kv) * 128 * 64; float o0 = 0.f, o1 = 0.f;
            for (int nn = 0; nn < 128; ++nn) { const float hv = hid[row * 132 + nn]; o0 += hv * w2[nn * 64 + 2 * c2]; o1 += hv * w2[nn * 64 + 2 * c2 + 1]; }
            if (kv == 0) { float ss = o0 * o0 + o1 * o1;
#pragma unroll
                for (int o_ = 1; o_ < 32; o_ <<= 1) ss += __shfl_xor(ss, o_);
                const float sc = rsqrtf(ss * (1.0f / 64.0f) + EPS); o0 *= sc * a.in[8][l * 192 + 2 * c2]; o1 *= sc * a.in[8][l * 192 + 2 * c2 + 1]; }
            const int j = j0 + row;
            *(unsigned*)((kv ? VCMP : KCMP) + (size_t)(b * 128 + j) * 64 + 2 * c2) = (j < 127) ? pk2(o0, o1) : 0u; }
        __syncthreads();
    }
}

__device__ __forceinline__ void ph_m1(const Args& a, int l, LAS unsigned char* lds, int bid, int G, int tid, int wave, int lane) {
    const bf16* P = (const bf16*)(a.ws + WS_P);
    bf16* QN = (bf16*)(a.ws + WS_QN); bf16* KN = (bf16*)(a.ws + WS_KN); bf16* VC = (bf16*)(a.ws + WS_VC);
    bf16* KT = (bf16*)(a.ws + WS_KT); bf16* VT = (bf16*)(a.ws + WS_VT);
    float* Gb = (float*)(a.ws + WS_G); float* BETA = (float*)(a.ws + WS_BETA);
    bf16* NQ = (bf16*)(a.ws + WS_NQ); bf16* KS = (bf16*)(a.ws + WS_KS); bf16* KW = (bf16*)(a.ws + WS_KW); bf16* Y = (bf16*)(a.ws + WS_Y);
    const float* convw = a.in[3] + (size_t)l * 4 * 1536; const float* a_log = a.in[4] + l * 4; const float* dt_bias = a.in[5] + l * 4;
    const float* qnw = a.in[7] + l * 64; const float* knw = a.in[8] + l * 192;
    const float* dww = a.in[12] + (size_t)l * 31 * 256; const float* dwb = a.in[13] + l * 256; const float* lnw = a.in[14] + l * 256; const float* lnb = a.in[15] + l * 256;
    LAS float* dwl = (LAS float*)(lds + 65536);
    for (int i = tid; i < 31 * 256; i += NTHR) dwl[i] = dww[i];
    __syncthreads();
    for (int u = bid; u < NT / 64; u += G) {
        const int b = u >> 5, nchunk = u & 31, tw = nchunk * 64 + 8 * wave;
        const bf16* pw0 = P + (size_t)(b * SEQ + tw) * NP;
#pragma unroll
        for (int ten = 0; ten < 3; ++ten)
#pragma unroll 1
            for (int h = 0; h < 4; ++h) { const int cb = ten * 512 + h * 128 + 2 * lane;
                float w0[4], w1[4];
#pragma unroll
                for (int j = 0; j < 4; ++j) { w0[j] = convw[j * 1536 + cb]; w1[j] = convw[j * 1536 + cb + 1]; }
                float xa[3], xb[3];
#pragma unroll
                for (int j = 0; j < 3; ++j) { unsigned w = 0u; if (tw - 3 + j >= 0) w = *(const unsigned*)(pw0 + (ptrdiff_t)(j - 3) * NP + cb); xa[j] = bf_lo(w); xb[j] = bf_hi(w); }
                unsigned pk[8];
#pragma unroll
                for (int i = 0; i < 8; ++i) { const unsigned w = *(const unsigned*)(pw0 + (size_t)i * NP + cb); const float ca = bf_lo(w), cbv = bf_hi(w);
                    float y0 = siluf_(w0[0] * xa[0] + w0[1] * xa[1] + w0[2] * xa[2] + w0[3] * ca), y1 = siluf_(w1[0] * xb[0] + w1[1] * xb[1] + w1[2] * xb[2] + w1[3] * cbv);
                    xa[0] = xa[1]; xa[1] = xa[2]; xa[2] = ca; xb[0] = xb[1]; xb[1] = xb[2]; xb[2] = cbv;
                    if (ten < 2) { const float ss = wave_sum(y0 * y0 + y1 * y1); const float sc = rsqrtf(ss + EPS) * (ten == 0 ? 0.08838834764831845f : 1.0f); y0 *= sc; y1 *= sc; }
                    pk[i] = pk2(y0, y1);
                    bf16* dst = ten == 0 ? QN : (ten == 1 ? KN : VC);
                    *(unsigned*)(dst + (size_t)(b * SEQ + tw + i) * 512 + h * 128 + 2 * lane) = pk[i]; }
                if (ten >= 1) {
                    bf16* tb = (ten == 1 ? KT : VT) + ((size_t)((b * 4 + h) * 32 + nchunk) * 128 + 2 * lane) * 64 + 8 * wave;
                    u32x4 lo, hi;
                    lo.x = (pk[0] & 0xffffu) | (pk[1] << 16); lo.y = (pk[2] & 0xffffu) | (pk[3] << 16); lo.z = (pk[4] & 0xffffu) | (pk[5] << 16); lo.w = (pk[6] & 0xffffu) | (pk[7] << 16);
                    hi.x = (pk[0] >> 16) | (pk[1] & 0xffff0000u); hi.y = (pk[2] >> 16) | (pk[3] & 0xffff0000u); hi.z = (pk[4] >> 16) | (pk[5] & 0xffff0000u); hi.w = (pk[6] >> 16) | (pk[7] & 0xffff0000u);
                    *(u32x4*)tb = lo; *(u32x4*)(tb + 64) = hi; } }
        if (lane < 32) { const int i = lane >> 2, hd = lane & 3; const size_t tok = (size_t)(b * SEQ + tw + i); const bf16* prow = P + tok * NP;
            const float av = bf2f(prow[C_A + hd]), bv = bf2f(prow[C_B + hd]);
            BETA[tok * 4 + hd] = sigmoidf_(bv);
            const float x = av + dt_bias[hd]; const float sp = x > 20.0f ? x : log1pf(expf(x));
            Gb[tok * 4 + hd] = -expf(a_log[hd]) * sp; }
        for (int i = 0; i < 8; ++i) { const size_t tok = (size_t)(b * SEQ + tw + i); const bf16* prow = P + tok * NP;
#pragma unroll
            for (int h = 0; h < 4; ++h) { const float x = bf2f(prow[C_NQ + h * 64 + lane]); const float ss = wave_sum(x * x);
                NQ[tok * 256 + h * 64 + lane] = (bf16)f2bf(x * rsqrtf(ss * (1.0f / 64.0f) + EPS) * qnw[lane] * 0.125f); }
            { const float x = bf2f(prow[C_KV + 128 + lane]); const float ss = wave_sum(x * x); KS[tok * 64 + lane] = (bf16)f2bf(x * rsqrtf(ss * (1.0f / 64.0f) + EPS) * knw[64 + lane]); }
            { const float x = bf2f(prow[C_KV + 256 + lane]); const float ss = wave_sum(x * x); KW[tok * 64 + lane] = (bf16)f2bf(x * rsqrtf(ss * (1.0f / 64.0f) + EPS) * knw[128 + lane]); } }
        { const int c = 4 * lane; f32x4 acc[8]; const f32x4 bias = *(const f32x4*)(dwb + c);
#pragma unroll
            for (int i = 0; i < 8; ++i) acc[i] = bias;
            for (int r = 0; r < 38; ++r) { const int tin = tw - 30 + r; if (tin < 0) continue;
                const bf16* pr = pw0 + (ptrdiff_t)(r - 30) * NP + C_CU + c; const u32x2 av = *(const u32x2*)pr, gv = *(const u32x2*)(pr + 256);
                f32x4 gl; gl.x = bf_lo(av.x) * sigmoidf_(bf_lo(gv.x)); gl.y = bf_hi(av.x) * sigmoidf_(bf_hi(gv.x)); gl.z = bf_lo(av.y) * sigmoidf_(bf_lo(gv.y)); gl.w = bf_hi(av.y) * sigmoidf_(bf_hi(gv.y));
#pragma unroll
                for (int i = 0; i < 8; ++i) { const int j = r - i; if (j >= 0 && j <= 30) { const f32x4 w = *(const LAS f32x4*)(dwl + j * 256 + c); acc[i] += w * gl; } } }
            const f32x4 lw = *(const f32x4*)(lnw + c), lb = *(const f32x4*)(lnb + c);
#pragma unroll
            for (int i = 0; i < 8; ++i) { const f32x4 x = acc[i]; const float mean = wave_sum((x.x + x.y) + (x.z + x.w)) * (1.0f / 256.0f);
                const f32x4 d = x - mean; const float var = wave_sum((d.x * d.x + d.y * d.y) + (d.z * d.z + d.w * d.w)) * (1.0f / 256.0f);
                const float rr = rsqrtf(var + EPS); const f32x4 y = d * rr * lw + lb;
                u32x2 o; o.x = pk2(siluf_(y.x), siluf_(y.y)); o.y = pk2(siluf_(y.z), siluf_(y.w));
                *(u32x2*)(Y + (size_t)(b * SEQ + tw + i) * DM + 768 + c) = o; } }
    }
}

__device__ __forceinline__ void ph_dn_chunk(const Args& a, LAS unsigned char* lds, int bid, int G, int tid, int wave, int lane) {
    LAS float* Kf = (LAS float*)lds;
    LAS float* QV = Kf + 64 * 129;
    LAS float* Lm = QV + 64 * 129;
    LAS float* Tm = Lm + 64 * 65;
    LAS float* gcl = Tm + 64 * 65; LAS float* betal = gcl + 64; LAS float* bkl = betal + 64;
    const bf16* QN = (const bf16*)(a.ws + WS_QN); const bf16* KN = (const bf16*)(a.ws + WS_KN); const bf16* VC = (const bf16*)(a.ws + WS_VC);
    const float* Gb = (const float*)(a.ws + WS_G); const float* BETA = (const float*)(a.ws + WS_BETA); float* GC = (float*)(a.ws + WS_GC);
    float* U = (float*)(a.ws + WS_U); float* W = (float*)(a.ws + WS_W); float* ATT = (float*)(a.ws + WS_ATT);
    for (int ci = bid; ci < 1024; ci += G) {
        const int n = ci & 31, h = (ci >> 5) & 3, b = ci >> 7; const int r0 = b * SEQ + n * 64;
        { const int row = tid >> 3, seg = tid & 7; const size_t go = (size_t)(r0 + row) * 512 + h * 128 + seg * 16;
            const u32x4 k0 = *(const u32x4*)(KN + go), k1 = *(const u32x4*)(KN + go + 8), q0 = *(const u32x4*)(QN + go), q1 = *(const u32x4*)(QN + go + 8);
            LAS float* kd = Kf + row * 129 + seg * 16; LAS float* qd = QV + row * 129 + seg * 16;
#pragma unroll
            for (int e = 0; e < 4; ++e) { kd[2 * e] = bf_lo(k0[e]); kd[2 * e + 1] = bf_hi(k0[e]); kd[8 + 2 * e] = bf_lo(k1[e]); kd[8 + 2 * e + 1] = bf_hi(k1[e]);
                qd[2 * e] = bf_lo(q0[e]); qd[2 * e + 1] = bf_hi(q0[e]); qd[8 + 2 * e] = bf_lo(q1[e]); qd[8 + 2 * e + 1] = bf_hi(q1[e]); } }
        if (wave == 0) { float g = Gb[(size_t)(r0 + lane) * 4 + h];
#pragma unroll
            for (int off = 1; off < 64; off <<= 1) { const float v = __shfl_up(g, off); if (lane >= off) g += v; }
            const float be = BETA[(size_t)(r0 + lane) * 4 + h];
            gcl[lane] = g; GC[(size_t)(r0 + lane) * 4 + h] = g; betal[lane] = be; bkl[lane] = be * __expf(g); }
        __syncthreads();
        { const int i = tid >> 3, jg = tid & 7; float kk[8], qk[8];
#pragma unroll
            for (int m = 0; m < 8; ++m) { kk[m] = 0.f; qk[m] = 0.f; }
            for (int c = 0; c < 128; ++c) { const float ak = Kf[i * 129 + c], aq = QV[i * 129 + c];
#pragma unroll
                for (int m = 0; m < 8; ++m) { const float kj = Kf[(jg + 8 * m) * 129 + c]; kk[m] += ak * kj; qk[m] += aq * kj; } }
            const float gi = gcl[i], bi = betal[i];
#pragma unroll
            for (int m = 0; m < 8; ++m) { const int j = jg + 8 * m; const float dec = (j <= i) ? __expf(gi - gcl[j]) : 0.f;
                Lm[i * 65 + j] = (j < i) ? bi * kk[m] * dec : 0.f;
                ATT[(size_t)ci * 4096 + i * 64 + j] = (j <= i) ? qk[m] * dec : 0.f; } }
        __syncthreads();
        if (wave == 0) {
            for (int i = 0; i < 64; ++i) { float acc = (i == lane) ? 1.f : 0.f;
                for (int j = 0; j < i; ++j) acc -= Lm[i * 65 + j] * Tm[j * 65 + lane];
                Tm[i * 65 + lane] = acc; }
        } else {
            for (int e = tid - 64; e < 512; e += 448) { const int row = e >> 3, seg = e & 7; const size_t go = (size_t)(r0 + row) * 512 + h * 128 + seg * 16;
                const u32x4 v0 = *(const u32x4*)(VC + go), v1 = *(const u32x4*)(VC + go + 8); LAS float* vd = QV + row * 129 + seg * 16;
#pragma unroll
                for (int q = 0; q < 4; ++q) { vd[2 * q] = bf_lo(v0[q]); vd[2 * q + 1] = bf_hi(v0[q]); vd[8 + 2 * q] = bf_lo(v1[q]); vd[8 + 2 * q + 1] = bf_hi(v1[q]); } }
        }
        __syncthreads();
        { const int c = tid & 127, part = (tid >> 7) & 1, rg = tid >> 8; float acc[32];
#pragma unroll
            for (int ii = 0; ii < 32; ++ii) acc[ii] = 0.f;
            for (int j = 0; j < 64; ++j) { const float x = part ? Kf[j * 129 + c] * bkl[j] : QV[j * 129 + c] * betal[j];
#pragma unroll
                for (int ii = 0; ii < 32; ++ii) acc[ii] += Tm[(rg * 32 + ii) * 65 + j] * x; }
            float* dst = part ? W : U;
#pragma unroll
            for (int ii = 0; ii < 32; ++ii) dst[(size_t)(r0 + rg * 32 + ii) * 512 + h * 128 + c] = acc[ii]; }
        __syncthreads();
    }
}

constexpr int LM_PITCH = 68;
__device__ __forceinline__ void ph_dn_chunk_mfma(const Args& a, LAS unsigned char* lds, int bid, int G, int tid, int wave, int lane) {
    LAS float* Lm = (LAS float*)lds;
    LAS float* gcl = (LAS float*)(lds + 4 * 64 * LM_PITCH * 4);
    LAS float* betal = gcl + 256; LAS float* bkl = betal + 256;
    const bf16* QN = (const bf16*)(a.ws + WS_QN); const bf16* KN = (const bf16*)(a.ws + WS_KN);
    const bf16* KT = (const bf16*)(a.ws + WS_KT); const bf16* VT = (const bf16*)(a.ws + WS_VT);
    const float* Gb = (const float*)(a.ws + WS_G); const float* BETA = (const float*)(a.ws + WS_BETA); float* GC = (float*)(a.ws + WS_GC);
    float* U = (float*)(a.ws + WS_U); bf16* W = (bf16*)(a.ws + WS_W); bf16* ATT = (bf16*)(a.ws + WS_ATT);
    const int n = lane & 31, hh = lane >> 5;
    for (int cb = bid * 4; cb < 1024; cb += G * 4) {
        if (wave < 4) { const int ci = cb + wave, nn = ci & 31, h = (ci >> 5) & 3, b = ci >> 7, r0 = b * SEQ + nn * 64;
            float g = Gb[(size_t)(r0 + lane) * 4 + h];
#pragma unroll
            for (int off = 1; off < 64; off <<= 1) { const float v = __shfl_up(g, off); if (lane >= off) g += v; }
            const float be = BETA[(size_t)(r0 + lane) * 4 + h];
            gcl[wave * 64 + lane] = g; GC[(size_t)(r0 + lane) * 4 + h] = g; betal[wave * 64 + lane] = be; bkl[wave * 64 + lane] = be * __expf(g); }
        __syncthreads();
#pragma unroll 1
        for (int q = 0; q < 3; ++q) { const int id = 3 * wave + q, c = id / 6, wq = id % 6, isq = wq >= 3 ? 1 : 0, blk = wq % 3, ib = blk >= 1 ? 1 : 0, jb = blk == 2 ? 1 : 0;
            const int ci = cb + c, nn = ci & 31, h = (ci >> 5) & 3, b = ci >> 7, r0 = b * SEQ + nn * 64;
            const bf16* ap = (isq ? QN : KN) + (size_t)(r0 + 32 * ib + n) * 512 + h * 128 + 8 * hh;
            const bf16* bp = KN + (size_t)(r0 + 32 * jb + n) * 512 + h * 128 + 8 * hh;
            f32x16 acc;
#pragma unroll
            for (int r = 0; r < 16; ++r) acc[r] = 0.f;
#pragma unroll
            for (int ks = 0; ks < 8; ++ks) acc = __builtin_amdgcn_mfma_f32_32x32x16_bf16(*(const bf16x8*)(ap + 16 * ks), *(const bf16x8*)(bp + 16 * ks), acc, 0, 0, 0);
            const int j = 32 * jb + n; const float gj = gcl[c * 64 + j];
#pragma unroll
            for (int r = 0; r < 16; ++r) { const int i = 32 * ib + (r & 3) + 8 * (r >> 2) + 4 * hh; const float dec = __expf(fminf(gcl[c * 64 + i] - gj, 0.f));
                if (isq) ATT[(size_t)ci * 4096 + i * 64 + j] = (bf16)((j <= i) ? f2bf(acc[r] * dec) : 0u);
                else Lm[c * 64 * LM_PITCH + i * LM_PITCH + j] = (j < i) ? betal[c * 64 + i] * acc[r] * dec : 0.f; } }
        __syncthreads();
        if (wave < 4) { LAS float* L = Lm + wave * 64 * LM_PITCH;
            for (int i = 0; i < 64; ++i) { float a0 = (i == lane) ? 1.f : 0.f, a1 = 0.f, a2 = 0.f, a3 = 0.f; int j = 0;
                for (; j + 3 < i; j += 4) { a0 -= L[i * LM_PITCH + j] * L[j * LM_PITCH + lane]; a1 -= L[i * LM_PITCH + j + 1] * L[(j + 1) * LM_PITCH + lane];
                    a2 -= L[i * LM_PITCH + j + 2] * L[(j + 2) * LM_PITCH + lane]; a3 -= L[i * LM_PITCH + j + 3] * L[(j + 3) * LM_PITCH + lane]; }
                for (; j < i; ++j) a0 -= L[i * LM_PITCH + j] * L[j * LM_PITCH + lane];
                L[i * LM_PITCH + lane] = (a0 + a1) + (a2 + a3); } }
        __syncthreads();
#pragma unroll 1
        for (int q = 0; q < 4; ++q) { const int id = wave * 4 + q, c = id >> 3, ten = (id >> 2) & 1, db = id & 3;
            const int ci = cb + c, nn = ci & 31, h = (ci >> 5) & 3, b = ci >> 7, r0 = b * SEQ + nn * 64;
            const bf16* arow = (ten ? KT : VT) + ((size_t)ci * 128 + 32 * db + n) * 64 + 8 * hh;
            const LAS float* scl = (ten ? bkl : betal) + c * 64;
            const LAS float* L = Lm + c * 64 * LM_PITCH;
#pragma unroll
            for (int ib = 0; ib < 2; ++ib) { f32x16 acc;
#pragma unroll
                for (int r = 0; r < 16; ++r) acc[r] = 0.f;
#pragma unroll
                for (int ks = 0; ks < 4; ++ks) { if (ib == 0 && ks >= 2) continue;
                    const LAS float* tp = L + (32 * ib + n) * LM_PITCH + 16 * ks + 8 * hh;
                    const f32x4 t0 = *(const LAS f32x4*)tp, t1 = *(const LAS f32x4*)(tp + 4), s0 = *(const LAS f32x4*)(scl + 16 * ks + 8 * hh), s1 = *(const LAS f32x4*)(scl + 16 * ks + 8 * hh + 4);
                    u32x4 bw; bw.x = pg8::cvt_pk_bf16(t0.x * s0.x, t0.y * s0.y); bw.y = pg8::cvt_pk_bf16(t0.z * s0.z, t0.w * s0.w); bw.z = pg8::cvt_pk_bf16(t1.x * s1.x, t1.y * s1.y); bw.w = pg8::cvt_pk_bf16(t1.z * s1.z, t1.w * s1.w);
                    acc = __builtin_amdgcn_mfma_f32_32x32x16_bf16(*(const bf16x8*)(arow + 16 * ks), __builtin_bit_cast(bf16x8, bw), acc, 0, 0, 0); }
                const size_t ob = (size_t)(r0 + 32 * ib + n) * 512 + h * 128 + 32 * db + 4 * hh;
#pragma unroll
                for (int rq = 0; rq < 4; ++rq) {
                    if (ten) { u32x2 w2; w2.x = pk2(acc[4 * rq], acc[4 * rq + 1]); w2.y = pk2(acc[4 * rq + 2], acc[4 * rq + 3]); *(u32x2*)(W + ob + 8 * rq) = w2; }
                    else *(f32x4*)(U + ob + 8 * rq) = (f32x4){acc[4 * rq], acc[4 * rq + 1], acc[4 * rq + 2], acc[4 * rq + 3]}; } } }
        __syncthreads();
    }
}

__device__ __forceinline__ void ph_dn_scan(const Args& a, LAS unsigned char* lds, int bid, int G, int tid) {
    LAS float* Sl = (LAS float*)lds;
    LAS float* Wl = Sl + 128 * 16;
    LAS unsigned* Ql = (LAS unsigned*)(Wl + 64 * 129);
    LAS unsigned* Kl = Ql + 64 * 65;
    LAS float* Al = (LAS float*)(Kl + 64 * 65);
    LAS float* UL = Al + 64 * 65;
    LAS float* VN = UL + 64 * 16;
    LAS float* gcl = VN + 64 * 17; LAS float* dkl = gcl + 64; LAS float* egl = dkl + 64;
    const bf16* QN = (const bf16*)(a.ws + WS_QN); const bf16* KN = (const bf16*)(a.ws + WS_KN);
    const float* GC = (const float*)(a.ws + WS_GC); const float* U = (const float*)(a.ws + WS_U); const bf16* W = (const bf16*)(a.ws + WS_W);
    const bf16* ATT = (const bf16*)(a.ws + WS_ATT); float* O = (float*)(a.ws + WS_O);
    for (int u = bid; u < 256; u += G) {
        const int s = u & 7, h = (u >> 3) & 3, b = u >> 5;
        for (int i = tid; i < 128 * 16; i += NTHR) Sl[i] = 0.f;
        __syncthreads();
        const int c = tid & 15, i0 = tid >> 4;
        for (int n = 0; n < 32; ++n) {
            const int r0 = b * SEQ + n * 64, ci = (b * 4 + h) * 32 + n;
            { const int row = tid >> 3, seg = tid & 7; const size_t go = (size_t)(r0 + row) * 512 + h * 128 + seg * 16;
                { const u32x4 w0 = *(const u32x4*)(W + go), w1 = *(const u32x4*)(W + go + 8); LAS float* wd = Wl + row * 129 + seg * 16;
#pragma unroll
                    for (int q = 0; q < 4; ++q) { wd[2 * q] = bf_lo(w0[q]); wd[2 * q + 1] = bf_hi(w0[q]); wd[8 + 2 * q] = bf_lo(w1[q]); wd[8 + 2 * q + 1] = bf_hi(w1[q]); } }
                const u32x4 q0 = *(const u32x4*)(QN + go), q1 = *(const u32x4*)(QN + go + 8), k0 = *(const u32x4*)(KN + go), k1 = *(const u32x4*)(KN + go + 8);
                LAS unsigned* qd = Ql + row * 65 + seg * 8; LAS unsigned* kd = Kl + row * 65 + seg * 8;
#pragma unroll
                for (int q = 0; q < 4; ++q) { qd[q] = q0[q]; qd[4 + q] = q1[q]; kd[q] = k0[q]; kd[4 + q] = k1[q]; }
                const int idx = tid * 8, ar = idx >> 6, ac = idx & 63;
                const u32x4 a0 = *(const u32x4*)(ATT + (size_t)ci * 4096 + idx);
                LAS float* ad = Al + ar * 65 + ac; const bool upz = (ar < 32 && ac >= 32);
                ad[0] = upz ? 0.f : bf_lo(a0.x); ad[1] = upz ? 0.f : bf_hi(a0.x); ad[2] = upz ? 0.f : bf_lo(a0.y); ad[3] = upz ? 0.f : bf_hi(a0.y); ad[4] = upz ? 0.f : bf_lo(a0.z); ad[5] = upz ? 0.f : bf_hi(a0.z); ad[6] = upz ? 0.f : bf_lo(a0.w); ad[7] = upz ? 0.f : bf_hi(a0.w);
#pragma unroll
                for (int rr = 0; rr < 2; ++rr) { const int i = i0 + 32 * rr; UL[i * 16 + c] = U[(size_t)(r0 + i) * 512 + h * 128 + s * 16 + c]; }
                if (tid < 64) gcl[tid] = GC[(size_t)(r0 + tid) * 4 + h]; }
            __syncthreads();
            if (tid < 64) { const float gl = gcl[63], gi = gcl[tid]; dkl[tid] = __expf(gl - gi); egl[tid] = __expf(gi); }
#pragma unroll
            for (int rr = 0; rr < 2; ++rr) { const int i = i0 + 32 * rr; float acc = UL[i * 16 + c];
                for (int k = 0; k < 128; ++k) acc -= Wl[i * 129 + k] * Sl[k * 16 + c];
                VN[i * 17 + c] = acc; }
            __syncthreads();
#pragma unroll
            for (int rr = 0; rr < 2; ++rr) { const int i = i0 + 32 * rr; float acc = 0.f;
                for (int k2 = 0; k2 < 64; ++k2) { const unsigned qw = Ql[i * 65 + k2]; acc += bf_lo(qw) * Sl[(2 * k2) * 16 + c] + bf_hi(qw) * Sl[(2 * k2 + 1) * 16 + c]; }
                acc *= egl[i];
                for (int j = 0; j <= i; ++j) acc += Al[i * 65 + j] * VN[j * 17 + c];
                O[(size_t)(r0 + i) * 512 + h * 128 + s * 16 + c] = acc; }
            __syncthreads();
            { const float eg = __expf(gcl[63]);
#pragma unroll
                for (int m = 0; m < 4; ++m) { const int kk = i0 + 32 * m; float acc = Sl[kk * 16 + c] * eg;
                    for (int j = 0; j < 64; ++j) { const unsigned kw = Kl[j * 65 + (kk >> 1)]; const float kv = (kk & 1) ? bf_hi(kw) : bf_lo(kw); acc += kv * dkl[j] * VN[j * 17 + c]; }
                    Sl[kk * 16 + c] = acc; } }
            __syncthreads();
        }
    }
}

constexpr int SC_WP = 272, SC_AP = 144;
constexpr int SC_W = 0, SC_Q = 64 * SC_WP, SC_A = 2 * 64 * SC_WP, SC_K = SC_A + 64 * SC_AP, SC_GC = SC_K + 128 * SC_AP, SC_BUF = SC_GC + 1024;
static_assert(2 * SC_BUF <= RING_BYTES, "scan LDS");
struct ScanPf { u32x4 w0, w1, q0, q1, at, k0, k1; float g, gl; };
__device__ __forceinline__ ScanPf scan_load(const bf16* W, const bf16* QN, const bf16* ATT, const bf16* KT, const float* GC, int r0, int h, int ci, int tid) {
    ScanPf p; const int row = tid >> 4, seg = tid & 15; const size_t go = (size_t)(r0 + row) * 512 + h * 128 + seg * 8;
    p.w0 = *(const u32x4*)(W + go); p.w1 = *(const u32x4*)(W + go + (size_t)32 * 512); p.q0 = *(const u32x4*)(QN + go); p.q1 = *(const u32x4*)(QN + go + (size_t)32 * 512);
    p.at = *(const u32x4*)(ATT + (size_t)ci * 4096 + tid * 8);
    p.k0 = *(const u32x4*)(KT + (size_t)ci * 8192 + tid * 8); p.k1 = *(const u32x4*)(KT + (size_t)ci * 8192 + 4096 + tid * 8);
    p.g = GC[(size_t)(r0 + (tid & 63)) * 4 + h]; p.gl = GC[(size_t)(r0 + 63) * 4 + h]; return p;
}
__device__ __forceinline__ void scan_store(const ScanPf& p, LAS unsigned char* buf, int tid) {
    const int row = tid >> 4, seg = tid & 15;
    *(LAS u32x4*)(buf + SC_W + row * SC_WP + seg * 16) = p.w0; *(LAS u32x4*)(buf + SC_W + (row + 32) * SC_WP + seg * 16) = p.w1;
    *(LAS u32x4*)(buf + SC_Q + row * SC_WP + seg * 16) = p.q0; *(LAS u32x4*)(buf + SC_Q + (row + 32) * SC_WP + seg * 16) = p.q1;
    *(LAS u32x4*)(buf + SC_A + (tid >> 3) * SC_AP + (tid & 7) * 16) = p.at;
    *(LAS u32x4*)(buf + SC_K + (tid >> 3) * SC_AP + (tid & 7) * 16) = p.k0; *(LAS u32x4*)(buf + SC_K + (64 + (tid >> 3)) * SC_AP + (tid & 7) * 16) = p.k1;
    if (tid < 64) { LAS float* gp = (LAS float*)(buf + SC_GC); gp[tid] = __expf(p.g); gp[64 + tid] = __expf(p.gl - p.g); if (tid == 0) gp[128] = __expf(p.gl); }
}
__device__ __forceinline__ bf16x8 frag2(const LAS unsigned char* p) { const u32x2 lo = *(const LAS u32x2*)p, hi = *(const LAS u32x2*)(p + 16); const u32x4 v = {lo.x, lo.y, hi.x, hi.y}; return __builtin_bit_cast(bf16x8, v); }
__device__ __forceinline__ void ph_dn_scan_mfma(const Args& a, LAS unsigned char* lds, int bid, int G, int tid, int wave, int lane) {
    const bf16* QN = (const bf16*)(a.ws + WS_QN); const bf16* KT = (const bf16*)(a.ws + WS_KT); const bf16* W = (const bf16*)(a.ws + WS_W); const bf16* ATT = (const bf16*)(a.ws + WS_ATT);
    const float* GC = (const float*)(a.ws + WS_GC); const float* U = (const float*)(a.ws + WS_U); float* O = (float*)(a.ws + WS_O);
    const int n = lane & 31, hh = lane >> 5;
    for (int u = bid; u < 32; u += G) {
        const int h = u & 3, b = u >> 2;
        f32x16 S[4];
#pragma unroll
        for (int k = 0; k < 4; ++k)
#pragma unroll
            for (int r = 0; r < 16; ++r) S[k][r] = 0.f;
        __syncthreads();
        { const ScanPf p0 = scan_load(W, QN, ATT, KT, GC, b * SEQ, h, (b * 4 + h) * 32, tid); scan_store(p0, lds, tid); }
        __syncthreads();
#pragma unroll 1
        for (int nn = 0; nn < 32; ++nn) {
            const int r0 = b * SEQ + nn * 64; LAS unsigned char* buf = lds + (nn & 1) * SC_BUF; const LAS float* gp = (const LAS float*)(buf + SC_GC);
            ScanPf pf; if (nn + 1 < 32) pf = scan_load(W, QN, ATT, KT, GC, r0 + 64, h, (b * 4 + h) * 32 + nn + 1, tid);
            if (wave < 4) {
                const size_t ubase = (size_t)r0 * 512 + h * 128 + 32 * wave + n;
                f32x16 vn[2];
#pragma unroll
                for (int ib = 0; ib < 2; ++ib)
#pragma unroll
                    for (int r = 0; r < 16; ++r) vn[ib][r] = U[ubase + (size_t)(32 * ib + (r & 3) + 8 * (r >> 2) + 4 * hh) * 512];
                bf16x8 Sb[4][2];
#pragma unroll
                for (int k = 0; k < 4; ++k)
#pragma unroll
                    for (int s2 = 0; s2 < 2; ++s2) { u32x4 w4; w4.x = pg8::cvt_pk_bf16(S[k][8 * s2], S[k][8 * s2 + 1]); w4.y = pg8::cvt_pk_bf16(S[k][8 * s2 + 2], S[k][8 * s2 + 3]);
                        w4.z = pg8::cvt_pk_bf16(S[k][8 * s2 + 4], S[k][8 * s2 + 5]); w4.w = pg8::cvt_pk_bf16(S[k][8 * s2 + 6], S[k][8 * s2 + 7]); Sb[k][s2] = __builtin_bit_cast(bf16x8, w4); }
#pragma unroll
                for (int ib = 0; ib < 2; ++ib) { f32x16 acc;
#pragma unroll
                    for (int r = 0; r < 16; ++r) acc[r] = 0.f;
#pragma unroll
                    for (int k = 0; k < 4; ++k)
#pragma unroll
                        for (int s2 = 0; s2 < 2; ++s2) acc = __builtin_amdgcn_mfma_f32_32x32x16_bf16(frag2(buf + SC_W + (32 * ib + n) * SC_WP + (32 * k + 16 * s2 + 4 * hh) * 2), Sb[k][s2], acc, 0, 0, 0);
#pragma unroll
                    for (int r = 0; r < 16; ++r) vn[ib][r] -= acc[r]; }
                bf16x8 vb[2][2], vd[2][2];
#pragma unroll
                for (int jb = 0; jb < 2; ++jb)
#pragma unroll
                    for (int s2 = 0; s2 < 2; ++s2) { const f32x4 d0 = *(const LAS f32x4*)(gp + 64 + 32 * jb + 16 * s2 + 4 * hh), d1 = *(const LAS f32x4*)(gp + 64 + 32 * jb + 16 * s2 + 8 + 4 * hh);
                        const float* v = nullptr; (void)v; u32x4 w4, w5;
                        w4.x = pg8::cvt_pk_bf16(vn[jb][8 * s2], vn[jb][8 * s2 + 1]); w4.y = pg8::cvt_pk_bf16(vn[jb][8 * s2 + 2], vn[jb][8 * s2 + 3]);
                        w4.z = pg8::cvt_pk_bf16(vn[jb][8 * s2 + 4], vn[jb][8 * s2 + 5]); w4.w = pg8::cvt_pk_bf16(vn[jb][8 * s2 + 6], vn[jb][8 * s2 + 7]);
                        w5.x = pg8::cvt_pk_bf16(vn[jb][8 * s2] * d0.x, vn[jb][8 * s2 + 1] * d0.y); w5.y = pg8::cvt_pk_bf16(vn[jb][8 * s2 + 2] * d0.z, vn[jb][8 * s2 + 3] * d0.w);
                        w5.z = pg8::cvt_pk_bf16(vn[jb][8 * s2 + 4] * d1.x, vn[jb][8 * s2 + 5] * d1.y); w5.w = pg8::cvt_pk_bf16(vn[jb][8 * s2 + 6] * d1.z, vn[jb][8 * s2 + 7] * d1.w);
                        vb[jb][s2] = __builtin_bit_cast(bf16x8, w4); vd[jb][s2] = __builtin_bit_cast(bf16x8, w5); }
#pragma unroll
                for (int ib = 0; ib < 2; ++ib) { f32x16 acc;
#pragma unroll
                    for (int r = 0; r < 16; ++r) acc[r] = 0.f;
#pragma unroll
                    for (int k = 0; k < 4; ++k)
#pragma unroll
                        for (int s2 = 0; s2 < 2; ++s2) acc = __builtin_amdgcn_mfma_f32_32x32x16_bf16(frag2(buf + SC_Q + (32 * ib + n) * SC_WP + (32 * k + 16 * s2 + 4 * hh) * 2), Sb[k][s2], acc, 0, 0, 0);
#pragma unroll
                    for (int rq = 0; rq < 4; ++rq) { const f32x4 e4 = *(const LAS f32x4*)(gp + 32 * ib + 8 * rq + 4 * hh);
                        acc[4 * rq] *= e4.x; acc[4 * rq + 1] *= e4.y; acc[4 * rq + 2] *= e4.z; acc[4 * rq + 3] *= e4.w; }
#pragma unroll
                    for (int jb = 0; jb < 2; ++jb) { if (jb > ib) continue;
#pragma unroll
                        for (int s2 = 0; s2 < 2; ++s2) acc = __builtin_amdgcn_mfma_f32_32x32x16_bf16(frag2(buf + SC_A + (32 * ib + n) * SC_AP + (32 * jb + 16 * s2 + 4 * hh) * 2), vb[jb][s2], acc, 0, 0, 0); }
#pragma unroll
                    for (int r = 0; r < 16; ++r) O[ubase + (size_t)(32 * ib + (r & 3) + 8 * (r >> 2) + 4 * hh) * 512] = acc[r]; }
                const float egl = gp[128];
#pragma unroll
                for (int k = 0; k < 4; ++k) {
#pragma unroll
                    for (int r = 0; r < 16; ++r) S[k][r] *= egl;
#pragma unroll
                    for (int jb = 0; jb < 2; ++jb)
#pragma unroll
                        for (int s2 = 0; s2 < 2; ++s2) S[k] = __builtin_amdgcn_mfma_f32_32x32x16_bf16(frag2(buf + SC_K + (32 * k + n) * SC_AP + (32 * jb + 16 * s2 + 4 * hh) * 2), vd[jb][s2], S[k], 0, 0, 0); }
            }
            if (nn + 1 < 32) scan_store(pf, lds + ((nn + 1) & 1) * SC_BUF, tid);
            __syncthreads();
        }
    }
}

__device__ __forceinline__ void ph_dn_out(const Args& a, int l, int gw, int NGW, int lane) {
    const float* O = (const float*)(a.ws + WS_O); const bf16* P = (const bf16*)(a.ws + WS_P); bf16* Y = (bf16*)(a.ws + WS_Y);
    const float* nw = a.in[6] + l * 128;
    for (int tok = gw; tok < NT; tok += NGW) {
#pragma unroll
        for (int h = 0; h < 4; ++h) { const float o0 = O[(size_t)tok * 512 + h * 128 + 2 * lane], o1 = O[(size_t)tok * 512 + h * 128 + 2 * lane + 1];
            const float ss = wave_sum(o0 * o0 + o1 * o1); const float r = rsqrtf(ss * (1.0f / 128.0f) + EPS);
            const unsigned zw = *(const unsigned*)(P + (size_t)tok * NP + C_Z + h * 128 + 2 * lane);
            const float y0 = o0 * r * nw[2 * lane] * siluf_(bf_lo(zw)), y1 = o1 * r * nw[2 * lane + 1] * siluf_(bf_hi(zw));
            *(unsigned*)(Y + (size_t)tok * DM + h * 128 + 2 * lane) = pk2(y0, y1); }
    }
}

__device__ __forceinline__ void nsa_qk(const bf16* krow, const LAS float* qs, float (&s)[4]) {
#pragma unroll
    for (int h = 0; h < 4; ++h) s[h] = 0.f;
#pragma unroll 1
    for (int i = 0; i < 8; ++i) { const u32x4 kr = *(const u32x4*)(krow + 8 * i);
#pragma unroll
        for (int hf = 0; hf < 2; ++hf) { const float k0 = bf_lo(kr[2 * hf]), k1 = bf_hi(kr[2 * hf]), k2 = bf_lo(kr[2 * hf + 1]), k3 = bf_hi(kr[2 * hf + 1]);
#pragma unroll
            for (int h = 0; h < 4; ++h) { const f32x4 qv = *(const LAS f32x4*)(qs + h * 64 + i * 8 + hf * 4); s[h] += (qv.x * k0 + qv.y * k1) + (qv.z * k2 + qv.w * k3); } } }
}
__device__ __forceinline__ void nsa_pv(const float (&p)[4], LAS float* pw, const bf16* vbase, int vpitch, int kmax, int lane, float (&o)[4][2]) {
    *(LAS f32x4*)(pw + lane * 4) = (f32x4){p[0], p[1], p[2], p[3]};
    LDS_WAIT();
    const int dp = lane & 31, par = lane >> 5;
#pragma unroll 8
    for (int kk = 0; kk < 32; ++kk) { const int key = 2 * kk + par; const f32x4 pv = *(const LAS f32x4*)(pw + key * 4);
        const int row = key < kmax ? key : kmax; const unsigned vv = *(const unsigned*)(vbase + (size_t)row * vpitch + 2 * dp);
        const float v0 = bf_lo(vv), v1 = bf_hi(vv);
#pragma unroll
        for (int h = 0; h < 4; ++h) { o[h][0] += pv[h] * v0; o[h][1] += pv[h] * v1; } }
    LDS_WAIT();
}
__device__ __forceinline__ void nsa_tile(const bf16* krow, bool valid, int dist, const LAS float* qs, const LAS float* btl, LAS float* pw, const bf16* vbase, int vpitch, int lane,
                                         float (&m)[4], float (&lsum)[4], float (&o)[4][2]) {
    float s[4], p[4]; nsa_qk(krow, qs, s);
    const int dd = dist < 0 ? 0 : (dist > 2047 ? 2047 : dist);
#pragma unroll
    for (int h = 0; h < 4; ++h) { const float sv = valid ? s[h] + btl[h * 2048 + dd] : -1e30f; const float mn = fmaxf(m[h], wave_max(sv));
        const float corr = __expf(m[h] - mn); p[h] = valid ? __expf(sv - mn) : 0.f; lsum[h] = lsum[h] * corr + wave_sum(p[h]); o[h][0] *= corr; o[h][1] *= corr; m[h] = mn; }
    nsa_pv(p, pw, vbase, vpitch, 63, lane, o);
}

__device__ __forceinline__ void ph_nsa(const Args& a, LAS unsigned char* lds, int bid, int G, int tid, int wave, int lane) {
    LAS float* btl = (LAS float*)lds;
    LAS float* qs = (LAS float*)(lds + 32768 + wave * 4096);
    LAS float* pw = qs + 256;
    LAS float* ps = pw + 256;
    const float* BT = (const float*)(a.ws + WS_BT);
    for (int i = tid; i < 4 * 2048; i += NTHR) btl[i] = BT[i];
    __syncthreads();
    const bf16* P = (const bf16*)(a.ws + WS_P); const bf16* NQ = (const bf16*)(a.ws + WS_NQ);
    const bf16* KS = (const bf16*)(a.ws + WS_KS); const bf16* KW = (const bf16*)(a.ws + WS_KW);
    const bf16* KCMP = (const bf16*)(a.ws + WS_KCMP); const bf16* VCMP = (const bf16*)(a.ws + WS_VCMP); bf16* Y = (bf16*)(a.ws + WS_Y);
    const int gw = bid * NWAVES + wave, NGW = G * NWAVES;
    for (int it = gw; it < NT; it += NGW) {
        const int b = it / SEQ, t = ((it % SEQ) + 293 * b) & (SEQ - 1);
        const int tok = b * SEQ + t;
#pragma unroll
        for (int i = 0; i < 4; ++i) qs[lane + 64 * i] = bf2f(NQ[(size_t)tok * 256 + lane + 64 * i]);
        LDS_WAIT();
        float ocmp[4][2], oslc[4][2], owin[4][2];
        {
            float sA[4], sB[4], pA[4], pB[4];
            const int jA = lane, jB = 64 + lane; const bool vA = (16 * jA + 31 <= t), vB = (jB < 127) && (16 * jB + 31 <= t);
            nsa_qk(KCMP + (size_t)(b * 128 + jA) * 64, qs, sA);
            nsa_qk(KCMP + (size_t)(b * 128 + (jB < 127 ? jB : 126)) * 64, qs, sB);
            int dA = t - 16 * jA - 31, dB = t - 16 * jB - 31; dA = dA < 0 ? 0 : dA; dB = dB < 0 ? 0 : dB;
#pragma unroll
            for (int h = 0; h < 4; ++h) { const float a_ = vA ? sA[h] + btl[h * 2048 + dA] : -1e30f, b_ = vB ? sB[h] + btl[h * 2048 + dB] : -1e30f;
                const float mx = wave_max(fmaxf(a_, b_)); pA[h] = vA ? __expf(a_ - mx) : 0.f; pB[h] = vB ? __expf(b_ - mx) : 0.f;
                const float ls = wave_sum(pA[h] + pB[h]); const float inv = ls > 0.f ? 1.0f / ls : 0.f; pA[h] *= inv; pB[h] *= inv; }
            ps[lane] = (pA[0] + pA[1]) + (pA[2] + pA[3]); ps[64 + lane] = (pB[0] + pB[1]) + (pB[2] + pB[3]);
#pragma unroll
            for (int h = 0; h < 4; ++h) { ocmp[h][0] = 0.f; ocmp[h][1] = 0.f; }
            nsa_pv(pA, pw, VCMP + (size_t)(b * 128) * 64, 64, 63, lane, ocmp);
            nsa_pv(pB, pw, VCMP + (size_t)(b * 128 + 64) * 64, 64, 62, lane, ocmp);
#pragma unroll
            for (int h = 0; h < 4; ++h) { ocmp[h][0] += __shfl_xor(ocmp[h][0], 32); ocmp[h][1] += __shfl_xor(ocmp[h][1], 32); }
        }
        unsigned selmask;
        {
            const int sb = lane & 31, cur = t >> 6; float imp = 0.f;
#pragma unroll
            for (int dj = -1; dj <= 3; ++dj) { const int j = 4 * sb + dj; if (j >= 0 && j <= 126) imp += ps[j]; }
            if (sb > cur) imp = -1.0f; else if (sb == 0 || sb == cur || sb == cur - 1) imp = 1e4f;
            int rank = 0;
            for (int s2 = 0; s2 < 32; ++s2) { const float v2 = __shfl(imp, s2); rank += (v2 > imp || (v2 == imp && s2 < sb)) ? 1 : 0; }
            const bool sel = (lane < 32) && (rank < 16) && (sb <= cur);
            selmask = (unsigned)__ballot(sel);
        }
        {
            float m[4], ls[4];
#pragma unroll
            for (int h = 0; h < 4; ++h) { m[h] = -1e30f; ls[h] = 0.f; oslc[h][0] = 0.f; oslc[h][1] = 0.f; }
            unsigned mk = selmask;
            while (mk) { const int sblk = __builtin_ctz(mk); mk &= mk - 1u; const int key = 64 * sblk + lane;
                nsa_tile(KS + (size_t)(b * SEQ + key) * 64, key <= t, t - key, qs, btl, pw, P + (size_t)(b * SEQ + 64 * sblk) * NP + C_KV + 192, NP, lane, m, ls, oslc); }
#pragma unroll
            for (int h = 0; h < 4; ++h) { const float inv = ls[h] > 0.f ? 1.0f / ls[h] : 0.f; oslc[h][0] = (oslc[h][0] + __shfl_xor(oslc[h][0], 32)) * inv; oslc[h][1] = (oslc[h][1] + __shfl_xor(oslc[h][1], 32)) * inv; }
        }
        {
            float m[4], ls[4];
#pragma unroll
            for (int h = 0; h < 4; ++h) { m[h] = -1e30f; ls[h] = 0.f; owin[h][0] = 0.f; owin[h][1] = 0.f; }
            const int lo = t - 511 > 0 ? t - 511 : 0;
            for (int kt = lo >> 6; kt <= (t >> 6); ++kt) { const int key = 64 * kt + lane;
                nsa_tile(KW + (size_t)(b * SEQ + key) * 64, key <= t && key >= lo, t - key, qs, btl, pw, P + (size_t)(b * SEQ + 64 * kt) * NP + C_KV + 320, NP, lane, m, ls, owin); }
#pragma unroll
            for (int h = 0; h < 4; ++h) { const float inv = ls[h] > 0.f ? 1.0f / ls[h] : 0.f; owin[h][0] = (owin[h][0] + __shfl_xor(owin[h][0], 32)) * inv; owin[h][1] = (owin[h][1] + __shfl_xor(owin[h][1], 32)) * inv; }
        }
        if (lane < 32) {
#pragma unroll
            for (int h = 0; h < 4; ++h) { const bf16* gp = P + (size_t)tok * NP + C_G + h * 3;
                const float g0 = sigmoidf_(bf2f(gp[0])), g1 = sigmoidf_(bf2f(gp[1])), g2 = sigmoidf_(bf2f(gp[2]));
                const float y0 = g0 * ocmp[h][0] + g1 * oslc[h][0] + g2 * owin[h][0], y1 = g0 * ocmp[h][1] + g1 * oslc[h][1] + g2 * owin[h][1];
                *(unsigned*)(Y + (size_t)tok * DM + 512 + h * 64 + 2 * lane) = pk2(y0, y1); }
        }
    }
}

constexpr int NSA_KT_PITCH = 144, NSA_VT_PITCH = 136;
struct NsaStage { u32x4 kv, vv; };
__device__ __forceinline__ NsaStage nsa_load(const bf16* Kbase, int kpitch, const bf16* Vbase, int vpitch, int tid) {
    const int key = tid >> 3, seg = tid & 7; NsaStage s;
    s.kv = *(const u32x4*)(Kbase + (size_t)key * kpitch + seg * 8); s.vv = *(const u32x4*)(Vbase + (size_t)key * vpitch + seg * 8); return s;
}
__device__ __forceinline__ void nsa_store(const NsaStage& s, LAS unsigned char* Kt, LAS unsigned char* Vt, int tid) {
    const int key = tid >> 3, seg = tid & 7;
    *(LAS u32x4*)(Kt + key * NSA_KT_PITCH + seg * 16) = s.kv;
#pragma unroll
    for (int i = 0; i < 4; ++i) { const unsigned w = s.vv[i];
        *(LAS unsigned short*)(Vt + (seg * 8 + 2 * i) * NSA_VT_PITCH + key * 2) = (unsigned short)(w & 0xffffu);
        *(LAS unsigned short*)(Vt + (seg * 8 + 2 * i + 1) * NSA_VT_PITCH + key * 2) = (unsigned short)(w >> 16); }
}
__device__ __forceinline__ void nsa_st(const LAS unsigned char* Kt, const bf16x8 (&qf)[4], int n, int hh, f32x16 (&s)[2]) {
#pragma unroll
    for (int kb = 0; kb < 2; ++kb) {
#pragma unroll
        for (int r = 0; r < 16; ++r) s[kb][r] = 0.f;
#pragma unroll
        for (int ks = 0; ks < 4; ++ks) { const bf16x8 af = *(const LAS bf16x8*)(Kt + (kb * 32 + n) * NSA_KT_PITCH + (16 * ks + 8 * hh) * 2);
            s[kb] = __builtin_amdgcn_mfma_f32_32x32x16_bf16(af, qf[ks], s[kb], 0, 0, 0); } }
}
__device__ __forceinline__ void nsa_pvm(const LAS unsigned char* Vt, const bf16x8 (&pf)[2][2], int n, int hh, f32x16 (&o)[2]) {
#pragma unroll
    for (int db = 0; db < 2; ++db)
#pragma unroll
        for (int kb = 0; kb < 2; ++kb)
#pragma unroll
            for (int s2 = 0; s2 < 2; ++s2) { const LAS unsigned char* p = Vt + (db * 32 + n) * NSA_VT_PITCH + (kb * 32 + 16 * s2 + 4 * hh) * 2;
                const u32x2 lo = *(const LAS u32x2*)p, hi = *(const LAS u32x2*)(p + 16);
                const u32x4 av = {lo.x, lo.y, hi.x, hi.y};
                o[db] = __builtin_amdgcn_mfma_f32_32x32x16_bf16(__builtin_bit_cast(bf16x8, av), pf[kb][s2], o[db], 0, 0, 0); }
}
__device__ __forceinline__ void nsa_pack(const f32x16 (&p)[2], bf16x8 (&pf)[2][2]) {
#pragma unroll
    for (int kb = 0; kb < 2; ++kb)
#pragma unroll
        for (int s2 = 0; s2 < 2; ++s2) { u32x4 w;
            w.x = pg8::cvt_pk_bf16(p[kb][8 * s2 + 0], p[kb][8 * s2 + 1]); w.y = pg8::cvt_pk_bf16(p[kb][8 * s2 + 2], p[kb][8 * s2 + 3]);
            w.z = pg8::cvt_pk_bf16(p[kb][8 * s2 + 4], p[kb][8 * s2 + 5]); w.w = pg8::cvt_pk_bf16(p[kb][8 * s2 + 6], p[kb][8 * s2 + 7]);
            pf[kb][s2] = __builtin_bit_cast(bf16x8, w); }
}
__device__ __forceinline__ void nsa_tile_mfma(const LAS unsigned char* Kt, const LAS unsigned char* Vt, const LAS float* btlh, const bf16x8 (&qf)[4], int n, int hh,
                                              int key0, int tq, bool colsel, int lowk, float& m, float& l, f32x16 (&o)[2]) {
    f32x16 s[2]; nsa_st(Kt, qf, n, hh, s);
    float tmax = -1e30f;
#pragma unroll
    for (int kb = 0; kb < 2; ++kb)
#pragma unroll
        for (int r = 0; r < 16; ++r) { const int key = key0 + kb * 32 + (r & 3) + 8 * (r >> 2) + 4 * hh; const int dist = tq - key;
            const bool valid = colsel && dist >= 0 && key >= lowk; const float x = s[kb][r] + btlh[dist < 0 ? 0 : dist];
            s[kb][r] = valid ? x : -1e30f; tmax = fmaxf(tmax, s[kb][r]); }
    tmax = fmaxf(tmax, __shfl_xor(tmax, 32));
    const float mn = fmaxf(m, tmax), corr = __expf(m - mn); float rs = 0.f;
#pragma unroll
    for (int kb = 0; kb < 2; ++kb)
#pragma unroll
        for (int r = 0; r < 16; ++r) { const float x = s[kb][r]; const float p = x > -1e29f ? __expf(x - mn) : 0.f; s[kb][r] = p; rs += p; }
    rs += __shfl_xor(rs, 32);
    l = l * corr + rs; m = mn;
#pragma unroll
    for (int db = 0; db < 2; ++db)
#pragma unroll
        for (int r = 0; r < 16; ++r) o[db][r] *= corr;
    bf16x8 pf[2][2]; nsa_pack(s, pf);
    nsa_pvm(Vt, pf, n, hh, o);
}

__device__ __forceinline__ void ph_nsa_mfma(const Args& a, LAS unsigned char* lds, int bid, int G, int tid, int wave, int lane) {
    LAS float* btl = (LAS float*)lds;
    LAS unsigned char* Kt = lds + 32768;
    LAS unsigned char* Vt = lds + 32768 + 9216;
    LAS float* PS = (LAS float*)(lds + 51200);
    LAS unsigned* MK = (LAS unsigned*)(lds + 84480);
    const float* BT = (const float*)(a.ws + WS_BT);
    for (int i = tid; i < 4 * 2048; i += NTHR) btl[i] = BT[i];
    const bf16* P = (const bf16*)(a.ws + WS_P); const bf16* NQ = (const bf16*)(a.ws + WS_NQ);
    const bf16* KS = (const bf16*)(a.ws + WS_KS); const bf16* KW = (const bf16*)(a.ws + WS_KW);
    const bf16* KCMP = (const bf16*)(a.ws + WS_KCMP); const bf16* VCMP = (const bf16*)(a.ws + WS_VCMP); bf16* Y = (bf16*)(a.ws + WS_Y);
    const int n = lane & 31, hh = lane >> 5, tl = n >> 2, h = n & 3;
    const LAS float* btlh = btl + h * 2048;
    for (int u = bid; u < 256; u += G) {
        const int b = u >> 5, qt = 31 - (u & 31), t0 = 64 * qt, tq = t0 + 8 * wave + tl, tok = b * SEQ + tq;
        bf16x8 qf[4];
#pragma unroll
        for (int ks = 0; ks < 4; ++ks) qf[ks] = *(const bf16x8*)(NQ + (size_t)tok * 256 + h * 64 + 16 * ks + 8 * hh);
        float gate[3];
#pragma unroll
        for (int br = 0; br < 3; ++br) gate[br] = sigmoidf_(bf2f(P[(size_t)tok * NP + C_G + h * 3 + br]));
        f32x16 yacc[2];
#pragma unroll
        for (int db = 0; db < 2; ++db)
#pragma unroll
            for (int r = 0; r < 16; ++r) yacc[db][r] = 0.f;
        {
            f32x16 sc[2][2];
#pragma unroll
            for (int ct = 0; ct < 2; ++ct) {
                __syncthreads();
                { const NsaStage st = nsa_load(KCMP + (size_t)(b * 128 + ct * 64) * 64, 64, VCMP + (size_t)(b * 128 + ct * 64) * 64, 64, tid); nsa_store(st, Kt, Vt + ct * 0, tid); }
                __syncthreads();
                nsa_st(Kt, qf, n, hh, sc[ct]);
            }
            float mx = -1e30f;
#pragma unroll
            for (int ct = 0; ct < 2; ++ct)
#pragma unroll
                for (int kb = 0; kb < 2; ++kb)
#pragma unroll
                    for (int r = 0; r < 16; ++r) { const int j = ct * 64 + kb * 32 + (r & 3) + 8 * (r >> 2) + 4 * hh; const int dist = tq - 16 * j - 31;
                        const float x = sc[ct][kb][r] + btlh[dist < 0 ? 0 : dist]; sc[ct][kb][r] = dist >= 0 ? x : -1e30f; mx = fmaxf(mx, sc[ct][kb][r]); }
            mx = fmaxf(mx, __shfl_xor(mx, 32));
            float rs = 0.f;
#pragma unroll
            for (int ct = 0; ct < 2; ++ct)
#pragma unroll
                for (int kb = 0; kb < 2; ++kb)
#pragma unroll
                    for (int r = 0; r < 16; ++r) { const float x = sc[ct][kb][r]; const float p = x > -1e29f ? __expf(x - mx) : 0.f; sc[ct][kb][r] = p; rs += p; }
            rs += __shfl_xor(rs, 32);
            const float inv = rs > 0.f ? 1.0f / rs : 0.f;
#pragma unroll
            for (int ct = 0; ct < 2; ++ct)
#pragma unroll
                for (int kb = 0; kb < 2; ++kb)
#pragma unroll
                    for (int r = 0; r < 16; ++r) { const float p = sc[ct][kb][r] * inv; sc[ct][kb][r] = p;
                        float v = p; v += __shfl_xor(v, 1); v += __shfl_xor(v, 2);
                        if (h == 0) PS[(8 * wave + tl) * 129 + ct * 64 + kb * 32 + (r & 3) + 8 * (r >> 2) + 4 * hh] = v; }
            f32x16 o[2];
#pragma unroll
            for (int db = 0; db < 2; ++db)
#pragma unroll
                for (int r = 0; r < 16; ++r) o[db][r] = 0.f;
            { bf16x8 pf[2][2]; nsa_pack(sc[1], pf); nsa_pvm(Vt, pf, n, hh, o); }
            __syncthreads();
            { const NsaStage st = nsa_load(KCMP + (size_t)(b * 128) * 64, 64, VCMP + (size_t)(b * 128) * 64, 64, tid); nsa_store(st, Kt, Vt, tid); }
            __syncthreads();
            { bf16x8 pf[2][2]; nsa_pack(sc[0], pf); nsa_pvm(Vt, pf, n, hh, o); }
#pragma unroll
            for (int db = 0; db < 2; ++db)
#pragma unroll
                for (int r = 0; r < 16; ++r) yacc[db][r] += gate[0] * o[db][r];
        }
        LDS_WAIT();
        for (int t2 = 0; t2 < 8; ++t2) {
            const int tqq = t0 + 8 * wave + t2, sb = lane & 31, cur = tqq >> 6; const LAS float* row = PS + (8 * wave + t2) * 129; float imp = 0.f;
#pragma unroll
            for (int dj = -1; dj <= 3; ++dj) { const int j = 4 * sb + dj; if (j >= 0 && j <= 126) imp += row[j]; }
            if (sb > cur) imp = -1.0f; else if (sb == 0 || sb == cur || sb == cur - 1) imp = 1e4f;
            int rank = 0;
            for (int s2 = 0; s2 < 32; ++s2) { const float v2 = __shfl(imp, s2); rank += (v2 > imp || (v2 == imp && s2 < sb)) ? 1 : 0; }
            const unsigned msk = (unsigned)__ballot((lane < 32) && (rank < 16) && (sb <= cur));
            if (lane == 0) MK[8 * wave + t2] = msk;
        }
        __syncthreads();
        unsigned anymask, wmask; const unsigned mymask = MK[8 * wave + tl];
        { unsigned v = MK[lane];
#pragma unroll
            for (int o_ = 1; o_ < 64; o_ <<= 1) v |= (unsigned)__shfl_xor((int)v, o_);
            anymask = (unsigned)__builtin_amdgcn_readfirstlane((int)v);
            unsigned w = MK[8 * wave + (lane & 7)]; w |= (unsigned)__shfl_xor((int)w, 1); w |= (unsigned)__shfl_xor((int)w, 2); w |= (unsigned)__shfl_xor((int)w, 4);
            wmask = (unsigned)__builtin_amdgcn_readfirstlane((int)w); }
        {
            float m = -1e30f, l = 0.f; f32x16 o[2];
#pragma unroll
            for (int db = 0; db < 2; ++db)
#pragma unroll
                for (int r = 0; r < 16; ++r) o[db][r] = 0.f;
            unsigned mk = anymask;
            NsaStage st; { const int s0 = __builtin_ctz(mk); st = nsa_load(KS + (size_t)(b * SEQ + 64 * s0) * 64, 64, P + (size_t)(b * SEQ + 64 * s0) * NP + C_KV + 192, NP, tid); }
            while (mk) {
                const int sblk = __builtin_ctz(mk); mk &= mk - 1u;
                __syncthreads();
                nsa_store(st, Kt, Vt, tid);
                __syncthreads();
                if (mk) { const int s1 = __builtin_ctz(mk); st = nsa_load(KS + (size_t)(b * SEQ + 64 * s1) * 64, 64, P + (size_t)(b * SEQ + 64 * s1) * NP + C_KV + 192, NP, tid); }
                if ((wmask >> sblk) & 1u) nsa_tile_mfma(Kt, Vt, btlh, qf, n, hh, 64 * sblk, tq, ((mymask >> sblk) & 1u) != 0u, 0, m, l, o);
            }
            const float inv = l > 0.f ? gate[1] / l : 0.f;
#pragma unroll
            for (int db = 0; db < 2; ++db)
#pragma unroll
                for (int r = 0; r < 16; ++r) yacc[db][r] += inv * o[db][r];
        }
        {
            float m = -1e30f, l = 0.f; f32x16 o[2];
#pragma unroll
            for (int db = 0; db < 2; ++db)
#pragma unroll
                for (int r = 0; r < 16; ++r) o[db][r] = 0.f;
            const int kt0 = (t0 - 511 > 0 ? t0 - 511 : 0) >> 6;
            NsaStage st = nsa_load(KW + (size_t)(b * SEQ + 64 * kt0) * 64, 64, P + (size_t)(b * SEQ + 64 * kt0) * NP + C_KV + 320, NP, tid);
            for (int kt = kt0; kt <= qt; ++kt) {
                __syncthreads();
                nsa_store(st, Kt, Vt, tid);
                __syncthreads();
                if (kt < qt) st = nsa_load(KW + (size_t)(b * SEQ + 64 * (kt + 1)) * 64, 64, P + (size_t)(b * SEQ + 64 * (kt + 1)) * NP + C_KV + 320, NP, tid);
                nsa_tile_mfma(Kt, Vt, btlh, qf, n, hh, 64 * kt, tq, true, tq - 511, m, l, o);
            }
            const float inv = l > 0.f ? gate[2] / l : 0.f;
#pragma unroll
            for (int db = 0; db < 2; ++db)
#pragma unroll
                for (int r = 0; r < 16; ++r) yacc[db][r] += inv * o[db][r];
        }
#pragma unroll
        for (int db = 0; db < 2; ++db)
#pragma unroll
            for (int rq = 0; rq < 4; ++rq) { u32x2 w; w.x = pk2(yacc[db][4 * rq], yacc[db][4 * rq + 1]); w.y = pk2(yacc[db][4 * rq + 2], yacc[db][4 * rq + 3]);
                *(u32x2*)(Y + (size_t)tok * DM + 512 + h * 64 + db * 32 + 8 * rq + 4 * hh) = w; }
        __syncthreads();
    }
}

__device__ __forceinline__ void ph_router(const Args& a, int l, const float* X1, LAS unsigned char* lds, int bid, int G, int tid, int wave, int lane) {
    LAS float* hrow = (LAS float*)lds + wave * 1024;
    LAS int* lcnt = (LAS int*)(lds + 32768); LAS int* asg_e = lcnt + 32; LAS int* asg_p = asg_e + 256; LAS float* asg_w = (LAS float*)(asg_p + 256); LAS int* gbase = (LAS int*)(asg_w + 256);
    bf16* H2 = (bf16*)(a.ws + WS_XN); unsigned* cnt = (unsigned*)(a.ws + WS_CTL) + CW_CNT + 64 * l;
    int* EIDX = (int*)(a.ws + WS_EIDX); int* EPOS = (int*)(a.ws + WS_EPOS); float* EW = (float*)(a.ws + WS_EW);
    const float* fw = a.in[17] + (size_t)l * DM; const float* rw = a.in[18] + (size_t)l * DM * NE; const float* rb = a.in[19] + l * NE;
    for (int u = bid; u < NT / 64; u += G) {
        const int tok0 = u * 64;
        if (tid < 32) lcnt[tid] = 0;
        __syncthreads();
        for (int i = 0; i < 8; ++i) {
            const int tl = wave * 8 + i, tok = tok0 + tl;
            f32x4 v[4]; float ss = 0.f;
#pragma unroll
            for (int j = 0; j < 4; ++j) { v[j] = *(const f32x4*)(X1 + (size_t)tok * DM + 4 * (64 * j + lane)); ss += (v[j].x * v[j].x + v[j].y * v[j].y) + (v[j].z * v[j].z + v[j].w * v[j].w); }
            const float r = rsqrtf(wave_sum(ss) * (1.0f / DM) + EPS);
#pragma unroll
            for (int j = 0; j < 4; ++j) { const f32x4 y = v[j] * r * *(const f32x4*)(fw + 4 * (64 * j + lane));
                u32x2 o; o.x = pk2(y.x, y.y); o.y = pk2(y.z, y.w); *(u32x2*)(H2 + (size_t)tok * DM + 4 * (64 * j + lane)) = o;
                *(LAS f32x4*)(hrow + 4 * (64 * j + lane)) = y; }
            LDS_WAIT();
            const int e = lane & 31, half = lane >> 5; float acc = 0.f;
            for (int d = 0; d < 512; ++d) { const int dd = half * 512 + d; acc += hrow[dd] * rw[(size_t)dd * NE + e]; }
            acc += __shfl_xor(acc, 32); acc += rb[e];
            float val = acc, tv[4]; int ti[4];
#pragma unroll
            for (int q = 0; q < 4; ++q) { const float mx = wave_max(val); const unsigned bal = (unsigned)__ballot(val == mx); const int idx = __builtin_ctz(bal);
                tv[q] = mx; ti[q] = idx; if (e == idx) val = -3.0e38f; }
            float ew[4], es = 0.f;
#pragma unroll
            for (int q = 0; q < 4; ++q) { ew[q] = __expf(tv[q] - tv[0]); es += ew[q]; }
            if (lane == 0) {
#pragma unroll
                for (int q = 0; q < 4; ++q) { const int p = __hip_atomic_fetch_add(&lcnt[ti[q]], 1, __ATOMIC_RELAXED, __HIP_MEMORY_SCOPE_WORKGROUP); asg_e[tl * 4 + q] = ti[q]; asg_p[tl * 4 + q] = p; asg_w[tl * 4 + q] = ew[q] / es; } }
            LDS_WAIT();
        }
        __syncthreads();
        if (tid < 32) gbase[tid] = (int)atomicAdd(&cnt[tid], (unsigned)lcnt[tid]);
        __syncthreads();
        if (tid < 256) { const int tok = tok0 + (tid >> 2), k = tid & 3, e = asg_e[tid];
            EIDX[(size_t)tok * 4 + k] = e; EPOS[(size_t)tok * 4 + k] = gbase[e] + asg_p[tid]; EW[(size_t)tok * 4 + k] = asg_w[tid]; }
        __syncthreads();
    }
}

__device__ __forceinline__ void build_tiles(const unsigned* cnt, LAS int* TS, LAS int* TE, int tid) {
    if (tid == 0) { int acc = 0;
        for (int e = 0; e < NE; ++e) { TS[e] = acc; const int nt = (int)((cnt[e] + 255u) >> 8); for (int i = 0; i < nt; ++i) TE[acc + i] = e; acc += nt; }
        TS[NE] = acc; }
    __syncthreads();
}

__device__ __forceinline__ void ph_gather(const Args& a, int l, LAS unsigned char* lds, int gw, int NGW, int tid, int lane) {
    LAS int* TS = (LAS int*)(lds + TS_OFF); LAS int* TE = (LAS int*)(lds + TE_OFF);
    build_tiles((const unsigned*)(a.ws + WS_CTL) + CW_CNT + 64 * l, TS, TE, tid);
    const bf16* H2 = (const bf16*)(a.ws + WS_XN); bf16* XS = (bf16*)(a.ws + WS_XS);
    const int* EIDX = (const int*)(a.ws + WS_EIDX); const int* EPOS = (const int*)(a.ws + WS_EPOS); int* SLOT = (int*)(a.ws + WS_SLOT);
    for (int tok = gw; tok < NT; tok += NGW) {
        int slot = 0;
        if (lane < 4) { const int e = EIDX[(size_t)tok * 4 + lane]; slot = TS[e] * 256 + EPOS[(size_t)tok * 4 + lane]; SLOT[(size_t)tok * 4 + lane] = slot; }
        const u32x4 r0 = *(const u32x4*)(H2 + (size_t)tok * DM + 8 * lane), r1 = *(const u32x4*)(H2 + (size_t)tok * DM + 512 + 8 * lane);
#pragma unroll
        for (int k = 0; k < 4; ++k) { const int sk = __shfl(slot, k); *(u32x4*)(XS + (size_t)sk * DM + 8 * lane) = r0; *(u32x4*)(XS + (size_t)sk * DM + 512 + 8 * lane) = r1; }
    }
}

__device__ __forceinline__ void ph_combine(const Args& a, const float* X1, float* Xo, const float* next_norm_w, int gw, int NGW, int lane) {
    const bf16* YS = (const bf16*)(a.ws + WS_YS); const int* SLOT = (const int*)(a.ws + WS_SLOT); const float* EW = (const float*)(a.ws + WS_EW); bf16* XN = (bf16*)(a.ws + WS_XN);
    for (int tok = gw; tok < NT; tok += NGW) {
        int slot = 0; float wgt = 0.f;
        if (lane < 4) { slot = SLOT[(size_t)tok * 4 + lane]; wgt = EW[(size_t)tok * 4 + lane]; }
        f32x4 v[4];
#pragma unroll
        for (int j = 0; j < 4; ++j) v[j] = *(const f32x4*)(X1 + (size_t)tok * DM + 4 * (64 * j + lane));
#pragma unroll
        for (int k = 0; k < 4; ++k) { const int sk = __shfl(slot, k); const float wk = __shfl(wgt, k);
#pragma unroll
            for (int j = 0; j < 4; ++j) { const u32x2 y = *(const u32x2*)(YS + (size_t)sk * DM + 4 * (64 * j + lane));
                v[j].x += wk * bf_lo(y.x); v[j].y += wk * bf_hi(y.x); v[j].z += wk * bf_lo(y.y); v[j].w += wk * bf_hi(y.y); } }
#pragma unroll
        for (int j = 0; j < 4; ++j) *(f32x4*)(Xo + (size_t)tok * DM + 4 * (64 * j + lane)) = v[j];
        if (next_norm_w) rms_row_to_bf16(v, next_norm_w, XN + (size_t)tok * DM, lane);
    }
}

struct Tid { int tid, lane, wave; };
__device__ __forceinline__ Tid fresh_tid() { int t = threadIdx.x; asm volatile("" : "+v"(t)); Tid r; r.tid = t; r.lane = t & 63; r.wave = __builtin_amdgcn_readfirstlane(t >> 6); return r; }
#define FT() Args A_ = args_k; { unsigned char* w_ = args_k.ws; asm volatile("" : "+s"(w_)); A_.ws = w_; } const Args& args = A_; const Tid T_ = fresh_tid(); const int tid = T_.tid, lane = T_.lane, wave = T_.wave, gw = bid * NWAVES + wave; (void)tid; (void)lane; (void)wave; (void)gw
constexpr int PH_PER_LAYER = 11, NPH = 2 + NLAYER * PH_PER_LAYER;

#if SINGLE_LAUNCH
#define BARPARM , const XcdBarrier& bar
#define BARARG , bar
#define GRID_BAR() xcd_barrier(bar)
#else
#define BARPARM
#define BARARG
#define GRID_BAR() do {} while (0)
#endif
#define IN(k) (lo <= (k) && (k) < hi)
#define SEAM(k) do { if (IN(k) && IN((k) + 1)) GRID_BAR(); } while (0)
template <int l>
__device__ __forceinline__ void run_layer(const Args& args_k, LAS unsigned char* lds, int lo, int hi, int G, int bid, int NGW BARPARM) {
        const int pb = 2 + l * PH_PER_LAYER;
#define Xin ((l == 0) ? args.in[0] : (const float*)(args.ws + WS_XB))
#define X1 ((float*)(args.ws + WS_XA))
#define Xout ((l == NLAYER - 1) ? args.out : (float*)(args.ws + WS_XB))
        if (IN(pb + 0)) {
            FT(); pg8::Gemm g{(const pg8::bf16_t*)(args.ws + WS_XN), (const pg8::bf16_t*)(args.ws + WS_WIN) + (size_t)l * NP * DM, NT, NP, DM};
            pg8::StaticOrder S; S.init(NT, NP, G, bid);
            pg8::EpiBf16Plain E{(pg8::bf16_t*)(args.ws + WS_P), NP};
            pg8::gemm_phase<pg8::EpiBf16Plain, pg8::StaticOrder, true, true>(lds, g, S, E);
        } SEAM(pb + 0);
        if (IN(pb + 1)) { { FT(); ph_compress_mfma(args, l, lds, bid, G, tid, wave, lane); } { FT(); ph_m1(args, l, lds, bid, G, tid, wave, lane); } } SEAM(pb + 1);
        if (IN(pb + 2)) { { FT(); ph_dn_chunk_mfma(args, lds, bid, G, tid, wave, lane); } __syncthreads(); { FT(); ph_nsa_mfma(args, lds, bid, G, tid, wave, lane); } } SEAM(pb + 2);
        if (IN(pb + 3)) { FT(); ph_dn_scan_mfma(args, lds, bid, G, tid, wave, lane); } SEAM(pb + 3);
        if (IN(pb + 4)) { FT(); ph_dn_out(args, l, gw, NGW, lane); } SEAM(pb + 4);
        if (IN(pb + 5)) {
            FT(); pg8::Gemm g{(const pg8::bf16_t*)(args.ws + WS_Y), (const pg8::bf16_t*)(args.ws + WS_WOUT) + (size_t)l * DM * DM, NT, DM, DM};
            pg8::StaticOrder S; S.init(NT, DM, G, bid);
            pg8::EpiResF32 E{Xin, X1, DM};
            pg8::gemm_phase<pg8::EpiResF32, pg8::StaticOrder, true, true>(lds, g, S, E);
        } SEAM(pb + 5);
        if (IN(pb + 6)) { FT(); ph_router(args, l, X1, lds, bid, G, tid, wave, lane); } SEAM(pb + 6);
        if (IN(pb + 7)) { FT(); ph_gather(args, l, lds, gw, NGW, tid, lane); } SEAM(pb + 7);
        if (IN(pb + 8)) {
            FT(); LAS int* TS = (LAS int*)(lds + TS_OFF); LAS int* TE = (LAS int*)(lds + TE_OFF);
            build_tiles((const unsigned*)(args.ws + WS_CTL) + CW_CNT + 64 * l, TS, TE, tid);
            const int ntiles = __builtin_amdgcn_readfirstlane(TS[NE]);
            pg8::Gemm g{(const pg8::bf16_t*)(args.ws + WS_XS), (const pg8::bf16_t*)(args.ws + WS_WGU) + (size_t)l * NE * 2048 * DM, ntiles * 256, NE * 2048, DM};
            pg8::MoeOrder<8> S{ntiles * 8, G, bid, (const LAS int*)TE};
            pg8::EpiSwiglu E{(pg8::bf16_t*)(args.ws + WS_ACT), args.in[21] + (size_t)l * NE * 2048};
            pg8::gemm_phase<pg8::EpiSwiglu, pg8::MoeOrder<8>, true, true>(lds, g, S, E);
        } SEAM(pb + 8);
        if (IN(pb + 9)) {
            FT(); LAS int* TS = (LAS int*)(lds + TS_OFF); LAS int* TE = (LAS int*)(lds + TE_OFF);
            build_tiles((const unsigned*)(args.ws + WS_CTL) + CW_CNT + 64 * l, TS, TE, tid);
            const int ntiles = __builtin_amdgcn_readfirstlane(TS[NE]);
            pg8::Gemm g{(const pg8::bf16_t*)(args.ws + WS_ACT), (const pg8::bf16_t*)(args.ws + WS_WD) + (size_t)l * NE * DM * DM, ntiles * 256, NE * DM, DM};
            pg8::MoeOrder<4> S{ntiles * 4, G, bid, (const LAS int*)TE};
            pg8::EpiDown E{(pg8::bf16_t*)(args.ws + WS_YS), args.in[23] + (size_t)l * NE * DM};
            pg8::gemm_phase<pg8::EpiDown, pg8::MoeOrder<4>, true, true>(lds, g, S, E);
        } SEAM(pb + 9);
        if (IN(pb + 10)) { FT(); ph_combine(args, X1, Xout, (l + 1 < NLAYER) ? args.in[1] + (size_t)(l + 1) * DM : nullptr, gw, NGW, lane); }
        if (l + 1 < NLAYER) SEAM(pb + 10);
    }

__global__ void __launch_bounds__(NTHR, 2) fwd_kernel(Args args_k) {
    extern __shared__ __attribute__((aligned(16))) unsigned char lds_raw[];
    LAS unsigned char* lds = (LAS unsigned char*)lds_raw;
    const int G = gridDim.x, bid = blockIdx.x, NGW = G * NWAVES;
    for (int u = threadIdx.x; u < (LDS_BYTES - LDSCTL_OFF) / 4; u += NTHR) ((LAS unsigned*)(lds + LDSCTL_OFF))[u] = 0u;
    __syncthreads();
#if SINGLE_LAUNCH
    XcdBarrier bar = xcd_barrier_post((unsigned*)(args_k.ws + WS_CTL) + CW_BAR, (volatile LAS unsigned*)(lds + MISC_OFF) + 8);
#endif
    const int lo = args_k.ph_lo, hi = args_k.ph_hi;

    if (IN(0)) { FT(); ph_prologue(args, lds, gw, NGW, wave, lane); } SEAM(0);
    if (IN(1)) { FT(); ph_norm0(args, gw, NGW, lane); } SEAM(1);

    run_layer<0>(args_k, lds, lo, hi, G, bid, NGW BARARG);
    run_layer<1>(args_k, lds, lo, hi, G, bid, NGW BARARG);
#undef IN
#undef SEAM
}

extern "C" void kernel_launch(void* const* d_in, const int* in_sizes, int n_in, void* d_out, int out_size, void* d_ws, size_t ws_size, hipStream_t stream) {
    static int grid = 0;
    if (grid == 0) {
        if (n_in != 25 || in_sizes[0] != NT * DM || out_size != NT * DM || ws_size < WS_END) {
            fprintf(stderr, "kernel_launch: unexpected problem (n_in %d, in0 %d, out %d, ws %zu < %zu); nothing launched\n", n_in, n_in > 0 ? in_sizes[0] : -1, out_size, ws_size, (size_t)WS_END); grid = -1; return; }
        int dev = 0, cus = 0, per_cu = 0;
        if (hipGetDevice(&dev) != hipSuccess || hipDeviceGetAttribute(&cus, hipDeviceAttributeMultiprocessorCount, dev) != hipSuccess) { grid = -1; return; }
        if (hipFuncSetAttribute((const void*)fwd_kernel, hipFuncAttributeMaxDynamicSharedMemorySize, LDS_BYTES) != hipSuccess) { fprintf(stderr, "kernel_launch: hipFuncSetAttribute failed\n"); grid = -1; return; }
        if (hipOccupancyMaxActiveBlocksPerMultiprocessor(&per_cu, (const void*)fwd_kernel, NTHR, LDS_BYTES) != hipSuccess || per_cu < 1)
            fprintf(stderr, "kernel_launch: note: occupancy query reports %d workgroups per CU\n", per_cu);
        (void)hipGetLastError();
        grid = cus;
    }
    if (grid < 0) return;
    if (hipMemsetAsync((char*)d_ws + WS_CTL, 0, CTL_ZERO_BYTES, stream) != hipSuccess) { fprintf(stderr, "kernel_launch: memset failed\n"); return; }
    Args a{};
    for (int i = 0; i < 25; ++i) a.in[i] = (const float*)d_in[i];
    a.out = (float*)d_out; a.ws = (unsigned char*)d_ws;
#if SINGLE_LAUNCH
    a.ph_lo = 0; a.ph_hi = NPH;
    hipLaunchKernelGGL(fwd_kernel, dim3(grid), dim3(NTHR), LDS_BYTES, stream, a);
#else
    for (int ph = 0; ph < NPH; ++ph) { a.ph_lo = ph; a.ph_hi = ph + 1; hipLaunchKernelGGL(fwd_kernel, dim3(grid), dim3(NTHR), LDS_BYTES, stream, a); }
#endif
}
```

```cpp
#include <hip/hip_runtime.h>
#include <cstdio>
#include <cstdint>
#include <cstddef>
namespace pg8 {
#define PG8_LAS __attribute__((address_space(3)))
typedef unsigned short bf16_t;
typedef short bf16x8 __attribute__((ext_vector_type(8)));
typedef float f32x4 __attribute__((ext_vector_type(4)));
typedef unsigned u32x4 __attribute__((ext_vector_type(4)));
constexpr int BM = 256, BK = 64, HALF = 128, HTB = HALF * BK * 2  , STAGE_BYTES = 8 * HTB, NXCD = 8, WGM = 8;

__host__ __device__ __forceinline__ int lds_byte(int r, int c) { const int st = (r >> 4) * 2 + (c >> 5), rr = r & 15, cc = c & 31, ob = rr * 64 + cc * 2; return st * 1024 + (ob ^ (((ob >> 9) & 1) << 5)); }
__host__ __device__ __forceinline__ void stage_rc(int b, int& R, int& C) { const int st = b / 1024, sb = b % 1024, swz = sb ^ (((sb >> 9) & 1) << 5); R = (st >> 1) * 16 + swz / 64; C = (st & 1) * 32 + (swz % 64) / 2; }
__host__ __device__ __forceinline__ int perm32(int rho) { const int n = rho >> 4, i = rho & 15; return 8 * (i >> 2) + 4 * n + (i & 3); }

struct Unit { int pm, pn; };
struct Gemm { const bf16_t* A; const bf16_t* Bt; int M, N, K; };

struct StaticOrder {
    int nM, nN, nwg, G, c;
    __host__ __device__ void init(int M, int N, int G_, int c_) { nM = M / BM; nN = N / BM; nwg = nM * nN; G = G_; c = c_; }
    __host__ __device__ bool next(int i, Unit& u) const {
        const long L = (long)i * G + c; if (L >= nwg) return false;
        int wgid = (int)L; { const int q = nwg / NXCD, r = nwg % NXCD, xcd = wgid % NXCD, off = wgid / NXCD; wgid = (xcd < r ? xcd * (q + 1) : r * (q + 1) + (xcd - r) * q) + off; }
        const int nig = WGM * nN, gid = wgid / nig, fm = gid * WGM, gsz = (nM - fm) < WGM ? (nM - fm) : WGM;
        u.pm = fm + ((wgid % nig) % gsz); u.pn = (wgid % nig) / gsz; return true;
    }
    __device__ __forceinline__ void a_ready(const Unit&) const {}
    __device__ __forceinline__ void done(const Unit&) const {}
};

__device__ __forceinline__ unsigned cvt_pk_bf16(float lo, float hi) { unsigned r; asm volatile("v_cvt_pk_bf16_f32 %0, %1, %2" : "=v"(r) : "v"(lo), "v"(hi)); return r; }

struct EpiBf16Plain {
    static constexpr bool PERM = true, AFTER_DRAIN = false;
    bf16_t* O; int ldc;
    __device__ __forceinline__ void operator()(const f32x4 (&acc)[2][2][4][2], const Unit& u, int wr, int wc, int fr, int fq) const {
        const int row0 = u.pm * BM + wr * 64 + fr, col0 = u.pn * BM + wc * 32 + 8 * fq;
#pragma unroll
        for (int ai = 0; ai < 2; ++ai)
#pragma unroll
            for (int m = 0; m < 4; ++m) { bf16_t* rowp = O + (size_t)(row0 + ai * HALF + m * 16) * ldc + col0;
#pragma unroll
                for (int bj = 0; bj < 2; ++bj) { const f32x4 v0 = acc[ai][bj][m][0], v1 = acc[ai][bj][m][1];
                    u32x4 w; w.x = cvt_pk_bf16(v0[0], v0[1]); w.y = cvt_pk_bf16(v0[2], v0[3]); w.z = cvt_pk_bf16(v1[0], v1[1]); w.w = cvt_pk_bf16(v1[2], v1[3]);
                    *(u32x4*)(rowp + bj * HALF) = w; } }
    }
};
struct EpiResF32 {
    static constexpr bool PERM = false, AFTER_DRAIN = false;
    const float* base; float* out; int ldc;
    __device__ __forceinline__ void operator()(const f32x4 (&acc)[2][2][4][2], const Unit& u, int wr, int wc, int fr, int fq) const {
        const int row0 = u.pm * BM + wr * 64 + fr, col0 = u.pn * BM + wc * 32 + 4 * fq;
#pragma unroll
        for (int ai = 0; ai < 2; ++ai)
#pragma unroll
            for (int m = 0; m < 4; ++m) { const size_t off = (size_t)(row0 + ai * HALF + m * 16) * ldc + col0;
#pragma unroll
                for (int bj = 0; bj < 2; ++bj)
#pragma unroll
                    for (int n = 0; n < 2; ++n) { const f32x4 b = *(const f32x4*)(base + off + bj * HALF + n * 16); *(f32x4*)(out + off + bj * HALF + n * 16) = b + acc[ai][bj][m][n]; } }
    }
};
struct EpiSwiglu {
    static constexpr bool PERM = true, AFTER_DRAIN = false;
    bf16_t* O; const float* bgu;
    __device__ __forceinline__ void operator()(const f32x4 (&acc)[2][2][4][2], const Unit& u, int wr, int wc, int fr, int fq) const {
        const int e = u.pn >> 3, pnl = u.pn & 7;
        const int row0 = u.pm * BM + wr * 64 + fr, gcol = pnl * 128 + wc * 32 + 8 * fq;
        const float* bg = bgu + (size_t)e * 2048 + gcol;
        f32x4 bgv[2], buv[2];
#pragma unroll
        for (int n = 0; n < 2; ++n) { bgv[n] = *(const f32x4*)(bg + 4 * n); buv[n] = *(const f32x4*)(bg + 1024 + 4 * n); }
#pragma unroll
        for (int ai = 0; ai < 2; ++ai)
#pragma unroll
            for (int m = 0; m < 4; ++m) { bf16_t* rowp = O + (size_t)(row0 + ai * HALF + m * 16) * 1024 + gcol;
                float r[8];
#pragma unroll
                for (int n = 0; n < 2; ++n) { const f32x4 gv = acc[ai][0][m][n] + bgv[n], uv = acc[ai][1][m][n] + buv[n];
#pragma unroll
                    for (int j = 0; j < 4; ++j) { const float g = fminf(gv[j], 7.0f), up = fminf(fmaxf(uv[j], -7.0f), 7.0f);
                        const float sg = __builtin_amdgcn_rcpf(1.0f + __expf(-1.702f * g)); r[n * 4 + j] = (up + 1.0f) * g * sg; } }
                u32x4 w; w.x = cvt_pk_bf16(r[0], r[1]); w.y = cvt_pk_bf16(r[2], r[3]); w.z = cvt_pk_bf16(r[4], r[5]); w.w = cvt_pk_bf16(r[6], r[7]);
                *(u32x4*)rowp = w; }
    }
};
struct EpiDown {
    static constexpr bool PERM = true, AFTER_DRAIN = false;
    bf16_t* O; const float* bd;
    __device__ __forceinline__ void operator()(const f32x4 (&acc)[2][2][4][2], const Unit& u, int wr, int wc, int fr, int fq) const {
        const int e = u.pn >> 2, pnl = u.pn & 3;
        const int row0 = u.pm * BM + wr * 64 + fr, col0 = pnl * BM + wc * 32 + 8 * fq;
        const float* bp = bd + (size_t)e * 1024 + col0;
        f32x4 bv[2][2];
#pragma unroll
        for (int bj = 0; bj < 2; ++bj)
#pragma unroll
            for (int n = 0; n < 2; ++n) bv[bj][n] = *(const f32x4*)(bp + bj * HALF + 4 * n);
#pragma unroll
        for (int ai = 0; ai < 2; ++ai)
#pragma unroll
            for (int m = 0; m < 4; ++m) { bf16_t* rowp = O + (size_t)(row0 + ai * HALF + m * 16) * 1024 + col0;
#pragma unroll
                for (int bj = 0; bj < 2; ++bj) { const f32x4 v0 = acc[ai][bj][m][0] + bv[bj][0], v1 = acc[ai][bj][m][1] + bv[bj][1];
                    u32x4 w; w.x = cvt_pk_bf16(v0[0], v0[1]); w.y = cvt_pk_bf16(v0[2], v0[3]); w.z = cvt_pk_bf16(v1[0], v1[1]); w.w = cvt_pk_bf16(v1[2], v1[3]);
                    *(u32x4*)(rowp + bj * HALF) = w; } }
    }
};
template <int NPN> struct MoeOrder {
    int nunits, G, c; const PG8_LAS int* texp;
    __device__ __forceinline__ bool next(int i, Unit& u) const {
        const int L = __builtin_amdgcn_readfirstlane(i * G + c); if (L >= nunits) return false;
        const int mt = L / NPN, pn = L % NPN;
        const int e = __builtin_amdgcn_readfirstlane(texp[mt]);
        u.pm = mt; u.pn = e * NPN + pn; return true;
    }
    __device__ __forceinline__ void a_ready(const Unit&) const {}
    __device__ __forceinline__ void done(const Unit&) const {}
};

template <class Epi, class Sched, bool ALIGN_EPI = false, bool SP2 = false>
__device__ __forceinline__ void gemm_phase(PG8_LAS unsigned char* lds, const Gemm g, const Sched& S, const Epi& E) {
    int tid_ = threadIdx.x; asm volatile("" : "+v"(tid_));
    const int tid = tid_, wid = __builtin_amdgcn_readfirstlane(tid >> 6), lane = tid & 63, wr = wid >> 2, wc = wid & 3, fr = lane & 15, fq = lane >> 4;
    const int K = g.K, nt = K / BK;
    unsigned voffA[2], voffB[2];
#pragma unroll
    for (int i = 0; i < 2; ++i) { int R, C; stage_rc(tid * 16 + i * 8192, R, C); const int Rb = Epi::PERM ? ((R & ~31) + perm32(R & 31)) : R;
        voffA[i] = (unsigned)(R * K + C) * 2u; voffB[i] = (unsigned)(Rb * K + C) * 2u; }
    const size_t kstep = (size_t)(BK * 2);
    const size_t hstep = (size_t)HALF * K * 2;
    const size_t tstep = 2 * hstep;
    const unsigned ldsw = (unsigned)wid * 1024u;
    const int aoff = lds_byte(wr * 64 + fr, fq * 8), boff = lds_byte(wc * 32 + fr, fq * 8);
#define PG8_SA(b, h) (((b) * 2 + (h)) * HTB)
#define PG8_SB(b, h) ((4 + (b) * 2 + (h)) * HTB)
#define PG8_STAGE(bufoff, gbase, voff) do { _Pragma("unroll") for (int _i = 0; _i < 2; ++_i) \
        __builtin_amdgcn_global_load_lds((const unsigned*)((const char*)(gbase) + (voff)[_i]), (PG8_LAS unsigned*)(lds + (bufoff) + ldsw + _i * 8192), 16, 0, 0); } while (0)
#define PG8_LDA(dst, b, h) do { _Pragma("unroll") for (int m = 0; m < 4; ++m) _Pragma("unroll") for (int k = 0; k < 2; ++k) dst[m][k] = *(const PG8_LAS bf16x8*)(lds + PG8_SA(b, h) + aoff + m * 2048 + k * 1024); } while (0)
#define PG8_LDB(dst, b, h) do { _Pragma("unroll") for (int n = 0; n < 2; ++n) _Pragma("unroll") for (int k = 0; k < 2; ++k) dst[n][k] = *(const PG8_LAS bf16x8*)(lds + PG8_SB(b, h) + boff + n * 2048 + k * 1024); } while (0)
#define PG8_MMA(ai, bj, At, Bt) do { __builtin_amdgcn_s_setprio(1); _Pragma("unroll") for (int m = 0; m < 4; ++m) _Pragma("unroll") for (int n = 0; n < 2; ++n) _Pragma("unroll") for (int k = 0; k < 2; ++k) \
        acc[ai][bj][m][n] = __builtin_amdgcn_mfma_f32_16x16x32_bf16(Bt[n][k], At[m][k], acc[ai][bj][m][n], 0, 0, 0); __builtin_amdgcn_s_setprio(0); } while (0)
#define PG8_WAIT_V(n) asm volatile("s_waitcnt vmcnt(" #n ")" ::: "memory")
#define PG8_WAIT_L(n) asm volatile("s_waitcnt lgkmcnt(" #n ")" ::: "memory")
#define PG8_BAR __builtin_amdgcn_s_barrier()
#define PG8_SCHED __builtin_amdgcn_sched_barrier(0)
    Unit cur, nxt; int ui = 0;
    if (!S.next(0, cur)) return;
    f32x4 acc[2][2][4][2];
#pragma unroll
    for (int a = 0; a < 2; ++a)
#pragma unroll
        for (int b = 0; b < 2; ++b)
#pragma unroll
            for (int m = 0; m < 4; ++m)
#pragma unroll
                for (int n = 0; n < 2; ++n) acc[a][b][m][n] = (f32x4){0.f, 0.f, 0.f, 0.f};
    bf16x8 At[4][2], B0[2][2], B1[2][2];
    const char* cA = (const char*)g.A + (size_t)cur.pm * tstep; const char* cB = (const char*)g.Bt + (size_t)cur.pn * tstep;
    S.a_ready(cur);
    if constexpr (SP2) {
        PG8_STAGE(PG8_SB(0, 0), cB, voffB); PG8_STAGE(PG8_SB(0, 1), cB + hstep, voffB); PG8_STAGE(PG8_SA(0, 0), cA, voffA); PG8_STAGE(PG8_SA(0, 1), cA + hstep, voffA);
        if (wr == 1) PG8_BAR;
        PG8_WAIT_V(2); PG8_BAR;
        PG8_STAGE(PG8_SB(1, 0), cB + kstep, voffB); PG8_STAGE(PG8_SA(1, 0), cA + kstep, voffA); PG8_STAGE(PG8_SB(1, 1), cB + hstep + kstep, voffB);
        PG8_WAIT_V(6); PG8_BAR;
    } else {
        PG8_STAGE(PG8_SB(0, 0), cB, voffB); PG8_STAGE(PG8_SA(0, 0), cA, voffA); PG8_STAGE(PG8_SB(0, 1), cB + hstep, voffB); PG8_STAGE(PG8_SA(0, 1), cA + hstep, voffA);
        if (wr == 1) PG8_BAR;
        PG8_WAIT_V(4); PG8_BAR;
        PG8_STAGE(PG8_SB(1, 0), cB + kstep, voffB); PG8_STAGE(PG8_SA(1, 0), cA + kstep, voffA); PG8_STAGE(PG8_SB(1, 1), cB + hstep + kstep, voffB);
        PG8_WAIT_V(6); PG8_BAR;
    }
    for (;;) {
        const bool has_next = S.next(ui + 1, nxt);
        const char* nA = has_next ? (const char*)g.A + (size_t)nxt.pm * tstep : cA; const char* nB = has_next ? (const char*)g.Bt + (size_t)nxt.pn * tstep : cB;
        for (int t = 0; t < nt; t += 2) {
            const bool last = (t == nt - 2);
            const char* a1 = cA + (size_t)(t + 1) * kstep;
            const char* a2 = last ? nA : cA + (size_t)(t + 2) * kstep; const char* b2 = last ? nB : cB + (size_t)(t + 2) * kstep;
            const char* a3 = a2 + kstep; const char* b3 = b2 + kstep;
            if (last && has_next) S.a_ready(nxt);
            if constexpr (SP2) {
            PG8_LDB(B0, 0, 0); PG8_LDB(B1, 0, 1); PG8_SCHED; PG8_LDA(At, 0, 0); PG8_STAGE(PG8_SA(1, 1), a1 + hstep, voffA);
            PG8_WAIT_V(8); PG8_WAIT_L(0); PG8_BAR; PG8_MMA(0, 0, At, B0); PG8_MMA(0, 1, At, B1); PG8_BAR; PG8_SCHED;
            PG8_LDA(At, 0, 1); PG8_STAGE(PG8_SB(0, 0), b2, voffB); PG8_STAGE(PG8_SB(0, 1), b2 + hstep, voffB); PG8_STAGE(PG8_SA(0, 0), a2, voffA);
            PG8_WAIT_V(8); PG8_WAIT_L(0); PG8_BAR; PG8_MMA(1, 0, At, B0); PG8_MMA(1, 1, At, B1); PG8_BAR; PG8_SCHED;
            PG8_LDB(B0, 1, 0); PG8_LDB(B1, 1, 1); PG8_SCHED; PG8_LDA(At, 1, 0); PG8_STAGE(PG8_SA(0, 1), a2 + hstep, voffA);
            PG8_WAIT_V(8); PG8_WAIT_L(0); PG8_BAR; PG8_MMA(0, 0, At, B0); PG8_MMA(0, 1, At, B1); PG8_BAR; PG8_SCHED;
            PG8_LDA(At, 1, 1); PG8_STAGE(PG8_SB(1, 0), b3, voffB); PG8_STAGE(PG8_SB(1, 1), b3 + hstep, voffB); PG8_STAGE(PG8_SA(1, 0), a3, voffA);
            PG8_WAIT_V(8); PG8_WAIT_L(0); PG8_BAR; PG8_MMA(1, 0, At, B0); PG8_MMA(1, 1, At, B1); PG8_BAR; PG8_SCHED;
            } else {
            PG8_LDB(B0, 0, 0); PG8_SCHED; PG8_LDA(At, 0, 0); PG8_STAGE(PG8_SA(1, 1), a1 + hstep, voffA);
            PG8_WAIT_L(8); PG8_BAR; PG8_WAIT_L(0); PG8_MMA(0, 0, At, B0); PG8_BAR; PG8_SCHED;
            PG8_LDB(B1, 0, 1); PG8_STAGE(PG8_SB(0, 0), b2, voffB);
            PG8_BAR; PG8_WAIT_L(0); PG8_MMA(0, 1, At, B1); PG8_BAR;
            PG8_LDA(At, 0, 1); PG8_STAGE(PG8_SA(0, 0), a2, voffA);
            PG8_BAR; PG8_WAIT_L(0); PG8_MMA(1, 0, At, B0); PG8_BAR; PG8_SCHED;
            PG8_STAGE(PG8_SB(0, 1), b2 + hstep, voffB);
            PG8_WAIT_V(6); PG8_BAR; PG8_MMA(1, 1, At, B1); PG8_BAR;
            PG8_LDB(B0, 1, 0); PG8_SCHED; PG8_LDA(At, 1, 0); PG8_STAGE(PG8_SA(0, 1), a2 + hstep, voffA);
            PG8_WAIT_L(8); PG8_BAR; PG8_WAIT_L(0); PG8_MMA(0, 0, At, B0); PG8_BAR; PG8_SCHED;
            PG8_LDB(B1, 1, 1); PG8_STAGE(PG8_SB(1, 0), b3, voffB);
            PG8_BAR; PG8_WAIT_L(0); PG8_MMA(0, 1, At, B1); PG8_BAR;
            PG8_LDA(At, 1, 1); PG8_STAGE(PG8_SA(1, 0), a3, voffA);
            PG8_BAR; PG8_WAIT_L(0); PG8_MMA(1, 0, At, B0); PG8_BAR; PG8_SCHED;
            PG8_STAGE(PG8_SB(1, 1), b3 + hstep, voffB);
            PG8_WAIT_V(6); PG8_BAR; PG8_MMA(1, 1, At, B1); PG8_BAR;
            }
        }
        if constexpr (ALIGN_EPI) { if (wr == 0) PG8_BAR; }
        if constexpr (!Epi::AFTER_DRAIN) { E(acc, cur, wr, wc, fr, fq); S.done(cur); }
        if (!has_next) break;
#pragma unroll
        for (int a = 0; a < 2; ++a)
#pragma unroll
            for (int b = 0; b < 2; ++b)
#pragma unroll
                for (int m = 0; m < 4; ++m)
#pragma unroll
                    for (int n = 0; n < 2; ++n) acc[a][b][m][n] = (f32x4){0.f, 0.f, 0.f, 0.f};
        cur = nxt; cA = nA; cB = nB; ++ui;
        if constexpr (ALIGN_EPI) { if (wr == 1) PG8_BAR; }
    }
    PG8_WAIT_V(0);
    if constexpr (!ALIGN_EPI) { if (wr == 0) PG8_BAR; }
    PG8_BAR;
    if constexpr (Epi::AFTER_DRAIN) { E.fused(acc, cur, wr, wc, fr, fq, lds, wid, lane); S.done(cur); }
#undef PG8_SA
#undef PG8_SB
#undef PG8_STAGE
#undef PG8_LDA
#undef PG8_LDB
#undef PG8_MMA
#undef PG8_WAIT_V
#undef PG8_WAIT_L
#undef PG8_BAR
#undef PG8_SCHED
}
}


#define GAS __attribute__((address_space(1)))
typedef unsigned short bf16;
typedef float f32x4 __attribute__((ext_vector_type(4)));
typedef unsigned u32x4 __attribute__((ext_vector_type(4)));
typedef unsigned u32x2 __attribute__((ext_vector_type(2)));
typedef short bf16x8 __attribute__((ext_vector_type(8)));
typedef float f32x16 __attribute__((ext_vector_type(16)));

#ifndef SINGLE_LAUNCH
#define SINGLE_LAUNCH 1
#endif

constexpr int NB = 8, SEQ = 2048, DM = 1024, NT = NB * SEQ, NLAYER = 2;
constexpr int DIN = 3220, NP = 3328;
constexpr int C_Q = 0, C_K = 512, C_V = 1024, C_Z = 1536, C_NQ = 2048, C_KV = 2304, C_CU = 2688, C_A = 3200, C_B = 3204, C_G = 3208;
constexpr int NE = 32, MAXT = 288;
constexpr int NWAVES = 8, NTHR = 512;
constexpr float EPS = 1e-6f;

constexpr size_t MiB = 1u << 20;
constexpr size_t WS_CTL = 0, CTL_ZERO_BYTES = 1 * MiB;
constexpr size_t WS_BT = 1 * MiB;
constexpr size_t WS_KCMP = 1 * MiB + 256 * 1024, WS_VCMP = 1 * MiB + 512 * 1024;
constexpr size_t WS_G = 2 * MiB, WS_BETA = 2 * MiB + 256 * 1024, WS_GC = 2 * MiB + 512 * 1024;
constexpr size_t WS_EIDX = 3 * MiB, WS_EPOS = 3 * MiB + 256 * 1024, WS_EW = 3 * MiB + 512 * 1024, WS_SLOT = 3 * MiB + 768 * 1024;
constexpr size_t WS_WIN = 4 * MiB;
constexpr size_t WS_WOUT = 17 * MiB;
constexpr size_t WS_WGU = 22 * MiB;
constexpr size_t WS_WD = 278 * MiB;
constexpr size_t WS_XA = 406 * MiB, WS_XB = 470 * MiB;
constexpr size_t WS_XN = 534 * MiB;
constexpr size_t WS_P = 566 * MiB;
constexpr size_t WS_QN = 670 * MiB, WS_KN = 686 * MiB, WS_VC = 702 * MiB;
constexpr size_t WS_U = 718 * MiB, WS_W = 750 * MiB;
constexpr size_t WS_ATT = 782 * MiB;
constexpr size_t WS_O = 798 * MiB;
constexpr size_t WS_NQ = 830 * MiB;
constexpr size_t WS_KS = 846 * MiB, WS_KW = 848 * MiB;
constexpr size_t WS_Y = 850 * MiB;
constexpr size_t WS_XS = 882 * MiB, WS_ACT = 1026 * MiB, WS_YS = 1170 * MiB;
constexpr size_t WS_KT = 1314 * MiB, WS_VT = 1330 * MiB;
constexpr size_t WS_W1T = 1346 * MiB;
constexpr size_t WS_POSW = 1349 * MiB;
constexpr size_t WS_END = 1350 * MiB;

constexpr int CW_TMO = 0, CW_BAR = 4096, CW_CNT = 16384;

constexpr int RING_BYTES = 131072;
constexpr int LDSCTL_OFF = RING_BYTES, MISC_OFF = LDSCTL_OFF, TS_OFF = LDSCTL_OFF + 128, TE_OFF = LDSCTL_OFF + 320;
constexpr int LDS_BYTES = 147456;
static_assert(TE_OFF + MAXT * 4 + 64 <= LDS_BYTES, "LDS map");

#define XB_TMO      128
#define XB_XCNT(j)  (256  + 64 * (j))
#define XB_XSUB(j)  (1280 + 64 * (j))
#define XB_XGEN(j)  (2304 + 64 * (j))
#define XB_TOP      3328
#define XB_TOPGEN   3392
#define XCD_BAR_WORDS 3456
#define XB_SPIN_CAP (1u << 22)
#define LAS __attribute__((address_space(3)))

__device__ __forceinline__ unsigned xb_ld(unsigned* p)              { return __hip_atomic_load(p, __ATOMIC_RELAXED, __HIP_MEMORY_SCOPE_AGENT); }
__device__ __forceinline__ unsigned xb_add(unsigned* p, unsigned v) { return __hip_atomic_fetch_add(p, v, __ATOMIC_RELAXED, __HIP_MEMORY_SCOPE_AGENT); }
__device__ __forceinline__ unsigned xb_xcc_id() { return (unsigned)__builtin_amdgcn_s_getreg((3 << 11) | 20) & 0xFu; }
#define XB_SPIN(cond, bar) do { unsigned _sp = 0; while (cond) { __builtin_amdgcn_s_sleep(1); \
    if ((++_sp & 255u) == 0u) { if (xb_ld(&(bar)[XB_TMO])) break; if (_sp > XB_SPIN_CAP) { atomicAdd(&(bar)[XB_TMO], 1u); break; } } } } while (0)

struct XcdBarrier {
    unsigned* bar; unsigned x;
    volatile LAS unsigned* st;
};

__device__ __forceinline__ XcdBarrier xcd_barrier_post(unsigned* bar, volatile LAS unsigned* st) {
    XcdBarrier b; b.bar = bar; b.x = xb_xcc_id(); b.st = st;
    if (threadIdx.x == 0) (void)xb_add(&bar[XB_XCNT(b.x)], 1u);
    return b;
}
__device__ __forceinline__ void xcd_barrier_complete(unsigned* bar, unsigned x, unsigned& nloc, unsigned& nx) {
    const unsigned G = gridDim.x * gridDim.y * gridDim.z;
    unsigned sum, cnt, mine, sp = 0u;
    for (;;) {
        sum = 0u; cnt = 0u; mine = 0u;
#pragma unroll
        for (unsigned j = 0; j < 16; ++j) { const unsigned c = xb_ld(&bar[XB_XCNT(j)]); sum += c; cnt += (c > 0u) ? 1u : 0u; mine = (j == x) ? c : mine; }
        if (sum == G) break;
        __builtin_amdgcn_s_sleep(1);
        if ((++sp & 255u) == 0u) { if (xb_ld(&bar[XB_TMO])) break; if (sp > XB_SPIN_CAP) { atomicAdd(&bar[XB_TMO], 1u); break; } }
    }
    nloc = mine > 0u ? mine : 1u; nx = cnt > 0u ? cnt : 1u;
}

__device__ __forceinline__ void xcd_barrier(const XcdBarrier& b) {
    asm volatile("s_waitcnt vmcnt(0)" ::: "memory");
    __syncthreads();
    if (threadIdx.x == 0) {
        unsigned* bar = b.bar;
        __builtin_amdgcn_s_waitcnt(0);
        unsigned nloc = b.st[0], nx = b.st[1];
        if (nloc == 0u) { xcd_barrier_complete(bar, b.x, nloc, nx); b.st[0] = nloc; b.st[1] = nx; }
        const unsigned old = xb_add(&bar[XB_XSUB(b.x)], 1u);
        const unsigned gen = old / nloc;
        if (old + 1u == (gen + 1u) * nloc) {
            __builtin_amdgcn_fence(__ATOMIC_RELEASE, "agent");
            asm volatile("s_waitcnt vmcnt(0)" ::: "memory");
            const unsigned og = xb_add(&bar[XB_TOP], 1u);
            const unsigned tg = og / nx;
            if (og + 1u == (tg + 1u) * nx) xb_add(&bar[XB_TOPGEN], 1u);
            else XB_SPIN(xb_ld(&bar[XB_TOPGEN]) == tg, bar);
            __builtin_amdgcn_fence(__ATOMIC_ACQUIRE, "agent");
            xb_add(&bar[XB_XGEN(b.x)], 1u);
            asm volatile("s_waitcnt vmcnt(0)" ::: "memory");
        } else {
            XB_SPIN(xb_ld(&bar[XB_XGEN(b.x)]) == gen, bar);
            __builtin_amdgcn_fence(__ATOMIC_ACQUIRE, "agent");
            asm volatile("s_waitcnt vmcnt(0)" ::: "memory");
        }
    }
    __syncthreads();
}


__device__ __forceinline__ void cnt_barrier(unsigned* cw, unsigned& k) {
    asm volatile("s_waitcnt vmcnt(0)" ::: "memory");
    __syncthreads();
    if (threadIdx.x == 0) {
        __builtin_amdgcn_fence(__ATOMIC_RELEASE, "agent");
        asm volatile("s_waitcnt vmcnt(0)" ::: "memory");
        const unsigned G = gridDim.x;
        const unsigned old = xb_add(cw, 1u);
        if (old == G * (k + 1u) - 1u) xb_add(cw + 64, 1u);
        else { unsigned sp = 0; while (xb_ld(cw + 64) == k) { __builtin_amdgcn_s_sleep(1);
                if ((++sp & 255u) == 0u) { if (xb_ld(cw + 128)) break; if (sp > XB_SPIN_CAP) { atomicAdd(cw + 128, 1u); break; } } } }
        __builtin_amdgcn_fence(__ATOMIC_ACQUIRE, "agent");
        asm volatile("s_waitcnt vmcnt(0)" ::: "memory");
    }
    ++k;
    __syncthreads();
}
__device__ __forceinline__ float bf_lo(unsigned w) { return __uint_as_float(w << 16); }
__device__ __forceinline__ float bf_hi(unsigned w) { return __uint_as_float(w & 0xffff0000u); }
__device__ __forceinline__ float bf2f(bf16 v) { return __uint_as_float(((unsigned)v) << 16); }
__device__ __forceinline__ unsigned f2bf(float f) { unsigned u = __float_as_uint(f); return (u + 0x7fffu + ((u >> 16) & 1u)) >> 16; }
__device__ __forceinline__ unsigned pk2(float lo, float hi) { return f2bf(lo) | (f2bf(hi) << 16); }
__device__ __forceinline__ float wave_sum(float v) {
#pragma unroll
    for (int o = 1; o < 64; o <<= 1) v += __shfl_xor(v, o);
    return v;
}
__device__ __forceinline__ float wave_max(float v) {
#pragma unroll
    for (int o = 1; o < 64; o <<= 1) v = fmaxf(v, __shfl_xor(v, o));
    return v;
}
__device__ __forceinline__ float sigmoidf_(float x) { return 1.0f / (1.0f + __expf(-x)); }
__device__ __forceinline__ float siluf_(float x) { return x / (1.0f + __expf(-x)); }
#define LDS_WAIT() asm volatile("s_waitcnt lgkmcnt(0)" ::: "memory")

struct Args { const float* in[25]; float* out; unsigned char* ws; int ph_lo, ph_hi; };

__device__ __forceinline__ int map_win(int n);
__device__ __forceinline__ int map_gu(int n);
template <int MAP>
__device__ __forceinline__ void transpose_item(const float* W, int K, int N, bf16* WT, LAS float* scr, int item, int nblk, int lane) {
    const int kb = item / nblk, nb = item % nblk, k0 = 64 * kb, n0 = 32 * nb;
    const int nd = n0 + (lane & 31); const int src = MAP == 1 ? map_win(nd) : (MAP == 2 ? map_gu(nd) : nd);
#pragma unroll 8
    for (int i = 0; i < 32; ++i) { const int kk = 2 * i + (lane >> 5); scr[kk * 33 + (lane & 31)] = src >= 0 ? W[(size_t)(k0 + kk) * N + src] : 0.0f; }
    LDS_WAIT();
    const int c = lane & 7;
#pragma unroll
    for (int j = 0; j < 4; ++j) { const int n = (lane >> 3) + 8 * j; const LAS float* s = scr + (8 * c) * 33 + n;
        u32x4 o; o.x = pk2(s[0 * 33], s[1 * 33]); o.y = pk2(s[2 * 33], s[3 * 33]); o.z = pk2(s[4 * 33], s[5 * 33]); o.w = pk2(s[6 * 33], s[7 * 33]);
        *(u32x4*)(WT + (size_t)(n0 + n) * K + k0 + 8 * c) = o; }
    LDS_WAIT();
}
__device__ __forceinline__ int map_win(int n) {
    if (n < 2048) return n;
    if (n < C_KV) return 2056 + (n - C_NQ);
    if (n < C_CU) return 2312 + (n - C_KV);
    if (n < C_A) return 2708 + (n - C_CU);
    if (n < C_B) return 2048 + (n - C_A);
    if (n < C_G) return 2052 + (n - C_B);
    if (n < C_G + 12) return 2696 + (n - C_G);
    return -1;
}
__device__ __forceinline__ int map_gu(int n) { const int pn = n >> 8, r = n & 255; return (r < 128 ? 0 : 1024) + 128 * pn + (r & 127); }

__device__ __forceinline__ void ph_prologue(const Args& a, LAS unsigned char* lds, int gw, int NGW, int wave, int lane) {
    LAS float* scr = (LAS float*)(lds + wave * 16384);
    bf16* WinT = (bf16*)(a.ws + WS_WIN); bf16* WoutT = (bf16*)(a.ws + WS_WOUT); bf16* WguT = (bf16*)(a.ws + WS_WGU); bf16* WdT = (bf16*)(a.ws + WS_WD);
    constexpr int I_IN = 16 * (NP / 32), I_OUT = 16 * 32, I_GU = 16 * 64, I_D = 16 * 32;
    constexpr int N_IN = NLAYER * I_IN, N_OUT = NLAYER * I_OUT, N_GU = NLAYER * NE * I_GU, N_D = NLAYER * NE * I_D;
    for (int it = gw; it < N_IN + N_OUT + N_GU + N_D; it += NGW) {
        int r = it;
        if (r < N_IN) { const int l = r / I_IN; transpose_item<1>(a.in[2] + (size_t)l * DM * DIN, DM, DIN, WinT + (size_t)l * NP * DM, scr, r % I_IN, NP / 32, lane); continue; } r -= N_IN;
        if (r < N_OUT) { const int l = r / I_OUT; transpose_item<0>(a.in[16] + (size_t)l * DM * DM, DM, DM, WoutT + (size_t)l * DM * DM, scr, r % I_OUT, 32, lane); continue; } r -= N_OUT;
        if (r < N_GU) { const int le = r / I_GU; transpose_item<2>(a.in[20] + (size_t)le * DM * 2048, DM, 2048, WguT + (size_t)le * 2048 * DM, scr, r % I_GU, 64, lane); continue; } r -= N_GU;
        { const int le = r / I_D; transpose_item<0>(a.in[22] + (size_t)le * DM * DM, DM, DM, WdT + (size_t)le * DM * DM, scr, r % I_D, 32, lane); }
    }
    { bf16* W1T = (bf16*)(a.ws + WS_W1T);
        for (int it = gw; it < 4 * 128; it += NGW) { const int mtx = it >> 7; transpose_item<0>(a.in[10] + (size_t)mtx * 2048 * 128, 2048, 128, W1T + (size_t)mtx * 128 * 2048, scr, it & 127, 4, lane); }
        float* POSW = (float*)(a.ws + WS_POSW);
        const int id = gw * 64 + lane;
        if (id < 512) { const int mtx = id >> 7, n = id & 127; const float* w1 = a.in[10] + (size_t)mtx * 2048 * 128; const float* pos = a.in[9] + (size_t)mtx * 2048; float acc = 0.f;
            for (int k = 0; k < 2048; ++k) acc += pos[k] * w1[(size_t)k * 128 + n];
            POSW[id] = acc; } }
    float* BT = (float*)(a.ws + WS_BT);
    for (int i = gw * 64 + lane; i < 4 * 2048; i += NGW * 64) {
        const int h = i >> 11, n = i & 2047; int bk;
        if (n < 16) bk = n; else { const float v = logf((float)n / 16.0f) / 2.0794415416798357f * 16.0f; bk = 16 + (int)v; bk = bk < 31 ? bk : 31; }
        BT[i] = a.in[24][bk * 4 + h];
    }
}

__device__ __forceinline__ void rms_row_to_bf16(const f32x4 (&v)[4], const float* w, bf16* orow, int lane) {
    float s = 0.f;
#pragma unroll
    for (int j = 0; j < 4; ++j) s += (v[j].x * v[j].x + v[j].y * v[j].y) + (v[j].z * v[j].z + v[j].w * v[j].w);
    const float r = rsqrtf(wave_sum(s) * (1.0f / DM) + EPS);
#pragma unroll
    for (int j = 0; j < 4; ++j) { const f32x4 wv = *(const f32x4*)(w + 4 * (64 * j + lane)); const f32x4 y = v[j] * r * wv;
        u32x2 o; o.x = pk2(y.x, y.y); o.y = pk2(y.z, y.w); *(u32x2*)(orow + 4 * (64 * j + lane)) = o; }
}

__device__ __forceinline__ void ph_norm0(const Args& a, int gw, int NGW, int lane) {
    bf16* XN = (bf16*)(a.ws + WS_XN);
    for (int tok = gw; tok < NT; tok += NGW) {
        f32x4 v[4];
#pragma unroll
        for (int j = 0; j < 4; ++j) v[j] = *(const f32x4*)(a.in[0] + (size_t)tok * DM + 4 * (64 * j + lane));
        rms_row_to_bf16(v, a.in[1], XN + (size_t)tok * DM, lane);
    }
}

__device__ __forceinline__ void ph_compress_mfma(const Args& a, int l, LAS unsigned char* lds, int bid, int G, int tid, int wave, int lane) {
    LAS float* hid = (LAS float*)lds;
    const bf16* P = (const bf16*)(a.ws + WS_P); bf16* KCMP = (bf16*)(a.ws + WS_KCMP); bf16* VCMP = (bf16*)(a.ws + WS_VCMP);
    const int r = lane & 15, q = lane >> 4;
    for (int u = bid; u < 128; u += G) {
        const int b = u >> 4, kv = (u >> 3) & 1, j0 = 16 * (u & 7);
        const bf16* arow = P + (size_t)(b * SEQ) * NP + C_KV + kv * 64;
        const bf16* brow = (const bf16*)(a.ws + WS_W1T) + ((size_t)(l * 2 + kv) * 128 + 16 * wave + r) * 2048 + 8 * q;
        const float pw = ((const float*)(a.ws + WS_POSW))[(l * 2 + kv) * 128 + 16 * wave + r];
        f32x4 acc = {0.f, 0.f, 0.f, 0.f};
#pragma unroll 8
        for (int ks = 0; ks < 64; ++ks) { int tk = 16 * (j0 + r) + (ks >> 1); tk = tk < SEQ ? tk : SEQ - 1;
            const bf16x8 af = *(const bf16x8*)(arow + (size_t)tk * NP + (ks & 1) * 32 + 8 * q); const bf16x8 bfr = *(const bf16x8*)(brow + 32 * ks);
            acc = __builtin_amdgcn_mfma_f32_16x16x32_bf16(af, bfr, acc, 0, 0, 0); }
#pragma unroll
        for (int i = 0; i < 4; ++i) hid[(4 * q + i) * 132 + 16 * wave + r] = siluf_(acc[i] + pw);
        __syncthreads();
        { const int row = tid >> 5, c2 = tid & 31; const float* w2 = a.in[11] + (size_t)(l * 2 + kv) * 128 * 64; float o0 = 0.f, o1 = 0.f;
            for (int nn = 0; nn < 128; ++nn) { const float hv = hid[row * 132 + nn]; o0 += hv * w2[nn * 64 + 2 * c2]; o1 += hv * w2[nn * 64 + 2 * c2 + 1]; }
            if (kv == 0) { float ss = o0 * o0 + o1 * o1;
#pragma unroll
                for (int o_ = 1; o_ < 32; o_ <<= 1) ss += __shfl_xor(ss, o_);
                const float sc = rsqrtf(ss * (1.0f / 64.0f) + EPS); o0 *= sc * a.in[8][l * 192 + 2 * c2]; o1 *= sc * a.in[8][l * 192 + 2 * c2 + 1]; }
            const int j = j0 + row;
            *(unsigned*)((kv ? VCMP : KCMP) + (size_t)(b * 128 + j) * 64 + 2 * c2) = (j < 127) ? pk2(o0, o1) : 0u; }
        __syncthreads();
    }
}

__device__ __forceinline__ void ph_m1(const Args& a, int l, LAS unsigned char* lds, int bid, int G, int tid, int wave, int lane) {
    const bf16* P = (const bf16*)(a.ws + WS_P);
    bf16* QN = (bf16*)(a.ws + WS_QN); bf16* KN = (bf16*)(a.ws + WS_KN); bf16* VC = (bf16*)(a.ws + WS_VC);
    bf16* KT = (bf16*)(a.ws + WS_KT); bf16* VT = (bf16*)(a.ws + WS_VT);
    float* Gb = (float*)(a.ws + WS_G); float* BETA = (float*)(a.ws + WS_BETA);
    bf16* NQ = (bf16*)(a.ws + WS_NQ); bf16* KS = (bf16*)(a.ws + WS_KS); bf16* KW = (bf16*)(a.ws + WS_KW); bf16* Y = (bf16*)(a.ws + WS_Y);
    const float* convw = a.in[3] + (size_t)l * 4 * 1536; const float* a_log = a.in[4] + l * 4; const float* dt_bias = a.in[5] + l * 4;
    const float* qnw = a.in[7] + l * 64; const float* knw = a.in[8] + l * 192;
    const float* dww = a.in[12] + (size_t)l * 31 * 256; const float* dwb = a.in[13] + l * 256; const float* lnw = a.in[14] + l * 256; const float* lnb = a.in[15] + l * 256;
    LAS float* dwl = (LAS float*)(lds + 65536);
    for (int i = tid; i < 31 * 256; i += NTHR) dwl[i] = dww[i];
    __syncthreads();
    for (int u = bid; u < NT / 64; u += G) {
        const int b = u >> 5, nchunk = u & 31, tw = nchunk * 64 + 8 * wave;
        const bf16* pw0 = P + (size_t)(b * SEQ + tw) * NP;
#pragma unroll
        for (int ten = 0; ten < 3; ++ten)
#pragma unroll 1
            for (int h = 0; h < 4; ++h) { const int cb = ten * 512 + h * 128 + 2 * lane;
                float w0[4], w1[4];
#pragma unroll
                for (int j = 0; j < 4; ++j) { w0[j] = convw[j * 1536 + cb]; w1[j] = convw[j * 1536 + cb + 1]; }
                float xa[3], xb[3];
#pragma unroll
                for (int j = 0; j < 3; ++j) { unsigned w = 0u; if (tw - 3 + j >= 0) w = *(const unsigned*)(pw0 + (ptrdiff_t)(j - 3) * NP + cb); xa[j] = bf_lo(w); xb[j] = bf_hi(w); }
                unsigned pk[8];
#pragma unroll
                for (int i = 0; i < 8; ++i) { const unsigned w = *(const unsigned*)(pw0 + (size_t)i * NP + cb); const float ca = bf_lo(w), cbv = bf_hi(w);
                    float y0 = siluf_(w0[0] * xa[0] + w0[1] * xa[1] + w0[2] * xa[2] + w0[3] * ca), y1 = siluf_(w1[0] * xb[0] + w1[1] * xb[1] + w1[2] * xb[2] + w1[3] * cbv);
                    xa[0] = xa[1]; xa[1] = xa[2]; xa[2] = ca; xb[0] = xb[1]; xb[1] = xb[2]; xb[2] = cbv;
                    if (ten < 2) { const float ss = wave_sum(y0 * y0 + y1 * y1); const float sc = rsqrtf(ss + EPS) * (ten == 0 ? 0.08838834764831845f : 1.0f); y0 *= sc; y1 *= sc; }
                    pk[i] = pk2(y0, y1);
                    bf16* dst = ten == 0 ? QN : (ten == 1 ? KN : VC);
                    *(unsigned*)(dst + (size_t)(b * SEQ + tw + i) * 512 + h * 128 + 2 * lane) = pk[i]; }
                if (ten >= 1) {
                    bf16* tb = (ten == 1 ? KT : VT) + ((size_t)((b * 4 + h) * 32 + nchunk) * 128 + 2 * lane) * 64 + 8 * wave;
                    u32x4 lo, hi;
                    lo.x = (pk[0] & 0xffffu) | (pk[1] << 16); lo.y = (pk[2] & 0xffffu) | (pk[3] << 16); lo.z = (pk[4] & 0xffffu) | (pk[5] << 16); lo.w = (pk[6] & 0xffffu) | (pk[7] << 16);
                    hi.x = (pk[0] >> 16) | (pk[1] & 0xffff0000u); hi.y = (pk[2] >> 16) | (pk[3] & 0xffff0000u); hi.z = (pk[4] >> 16) | (pk[5] & 0xffff0000u); hi.w = (pk[6] >> 16) | (pk[7] & 0xffff0000u);
                    *(u32x4*)tb = lo; *(u32x4*)(tb + 64) = hi; } }
        if (lane < 32) { const int i = lane >> 2, hd = lane & 3; const size_t tok = (size_t)(b * SEQ + tw + i); const bf16* prow = P + tok * NP;
            const float av = bf2f(prow[C_A + hd]), bv = bf2f(prow[C_B + hd]);
            BETA[tok * 4 + hd] = sigmoidf_(bv);
            const float x = av + dt_bias[hd]; const float sp = x > 20.0f ? x : log1pf(expf(x));
            Gb[tok * 4 + hd] = -expf(a_log[hd]) * sp; }
        for (int i = 0; i < 8; ++i) { const size_t tok = (size_t)(b * SEQ + tw + i); const bf16* prow = P + tok * NP;
#pragma unroll
            for (int h = 0; h < 4; ++h) { const float x = bf2f(prow[C_NQ + h * 64 + lane]); const float ss = wave_sum(x * x);
                NQ[tok * 256 + h * 64 + lane] = (bf16)f2bf(x * rsqrtf(ss * (1.0f / 64.0f) + EPS) * qnw[lane] * 0.125f); }
            { const float x = bf2f(prow[C_KV + 128 + lane]); const float ss = wave_sum(x * x); KS[tok * 64 + lane] = (bf16)f2bf(x * rsqrtf(ss * (1.0f / 64.0f) + EPS) * knw[64 + lane]); }
            { const float x = bf2f(prow[C_KV + 256 + lane]); const float ss = wave_sum(x * x); KW[tok * 64 + lane] = (bf16)f2bf(x * rsqrtf(ss * (1.0f / 64.0f) + EPS) * knw[128 + lane]); } }
        { const int c = 4 * lane; f32x4 acc[8]; const f32x4 bias = *(const f32x4*)(dwb + c);
#pragma unroll
            for (int i = 0; i < 8; ++i) acc[i] = bias;
            for (int r = 0; r < 38; ++r) { const int tin = tw - 30 + r; if (tin < 0) continue;
                const bf16* pr = pw0 + (ptrdiff_t)(r - 30) * NP + C_CU + c; const u32x2 av = *(const u32x2*)pr, gv = *(const u32x2*)(pr + 256);
                f32x4 gl; gl.x = bf_lo(av.x) * sigmoidf_(bf_lo(gv.x)); gl.y = bf_hi(av.x) * sigmoidf_(bf_hi(gv.x)); gl.z = bf_lo(av.y) * sigmoidf_(bf_lo(gv.y)); gl.w = bf_hi(av.y) * sigmoidf_(bf_hi(gv.y));
#pragma unroll
                for (int i = 0; i < 8; ++i) { const int j = r - i; if (j >= 0 && j <= 30) { const f32x4 w = *(const LAS f32x4*)(dwl + j * 256 + c); acc[i] += w * gl; } } }
            const f32x4 lw = *(const f32x4*)(lnw + c), lb = *(const f32x4*)(lnb + c);
#pragma unroll
            for (int i = 0; i < 8; ++i) { const f32x4 x = acc[i]; const float mean = wave_sum((x.x + x.y) + (x.z + x.w)) * (1.0f / 256.0f);
                const f32x4 d = x - mean; const float var = wave_sum((d.x * d.x + d.y * d.y) + (d.z * d.z + d.w * d.w)) * (1.0f / 256.0f);
                const float rr = rsqrtf(var + EPS); const f32x4 y = d * rr * lw + lb;
                u32x2 o; o.x = pk2(siluf_(y.x), siluf_(y.y)); o.y = pk2(siluf_(y.z), siluf_(y.w));
                *(u32x2*)(Y + (size_t)(b * SEQ + tw + i) * DM + 768 + c) = o; } }
    }
}

__device__ __forceinline__ void ph_dn_chunk(const Args& a, LAS unsigned char* lds, int bid, int G, int tid, int wave, int lane) {
    LAS float* Kf = (LAS float*)lds;
    LAS float* QV = Kf + 64 * 129;
    LAS float* Lm = QV + 64 * 129;
    LAS float* Tm = Lm + 64 * 65;
    LAS float* gcl = Tm + 64 * 65; LAS float* betal = gcl + 64; LAS float* bkl = betal + 64;
    const bf16* QN = (const bf16*)(a.ws + WS_QN); const bf16* KN = (const bf16*)(a.ws + WS_KN); const bf16* VC = (const bf16*)(a.ws + WS_VC);
    const float* Gb = (const float*)(a.ws + WS_G); const float* BETA = (const float*)(a.ws + WS_BETA); float* GC = (float*)(a.ws + WS_GC);
    float* U = (float*)(a.ws + WS_U); float* W = (float*)(a.ws + WS_W); float* ATT = (float*)(a.ws + WS_ATT);
    for (int ci = bid; ci < 1024; ci += G) {
        const int n = ci & 31, h = (ci >> 5) & 3, b = ci >> 7; const int r0 = b * SEQ + n * 64;
        { const int row = tid >> 3, seg = tid & 7; const size_t go = (size_t)(r0 + row) * 512 + h * 128 + seg * 16;
            const u32x4 k0 = *(const u32x4*)(KN + go), k1 = *(const u32x4*)(KN + go + 8), q0 = *(const u32x4*)(QN + go), q1 = *(const u32x4*)(QN + go + 8);
            LAS float* kd = Kf + row * 129 + seg * 16; LAS float* qd = QV + row * 129 + seg * 16;
#pragma unroll
            for (int e = 0; e < 4; ++e) { kd[2 * e] = bf_lo(k0[e]); kd[2 * e + 1] = bf_hi(k0[e]); kd[8 + 2 * e] = bf_lo(k1[e]); kd[8 + 2 * e + 1] = bf_hi(k1[e]);
                qd[2 * e] = bf_lo(q0[e]); qd[2 * e + 1] = bf_hi(q0[e]); qd[8 + 2 * e] = bf_lo(q1[e]); qd[8 + 2 * e + 1] = bf_hi(q1[e]); } }
        if (wave == 0) { float g = Gb[(size_t)(r0 + lane) * 4 + h];
#pragma unroll
            for (int off = 1; off < 64; off <<= 1) { const float v = __shfl_up(g, off); if (lane >= off) g += v; }
            const float be = BETA[(size_t)(r0 + lane) * 4 + h];
            gcl[lane] = g; GC[(size_t)(r0 + lane) * 4 + h] = g; betal[lane] = be; bkl[lane] = be * __expf(g); }
        __syncthreads();
        { const int i = tid >> 3, jg = tid & 7; float kk[8], qk[8];
#pragma unroll
            for (int m = 0; m < 8; ++m) { kk[m] = 0.f; qk[m] = 0.f; }
            for (int c = 0; c < 128; ++c) { const float ak = Kf[i * 129 + c], aq = QV[i * 129 + c];
#pragma unroll
                for (int m = 0; m < 8; ++m) { const float kj = Kf[(jg + 8 * m) * 129 + c]; kk[m] += ak * kj; qk[m] += aq * kj; } }
            const float gi = gcl[i], bi = betal[i];
#pragma unroll
            for (int m = 0; m < 8; ++m) { const int j = jg + 8 * m; const float dec = (j <= i) ? __expf(gi - gcl[j]) : 0.f;
                Lm[i * 65 + j] = (j < i) ? bi * kk[m] * dec : 0.f;
                ATT[(size_t)ci * 4096 + i * 64 + j] = (j <= i) ? qk[m] * dec : 0.f; } }
        __syncthreads();
        if (wave == 0) {
            for (int i = 0; i < 64; ++i) { float acc = (i == lane) ? 1.f : 0.f;
                for (int j = 0; j < i; ++j) acc -= Lm[i * 65 + j] * Tm[j * 65 + lane];
                Tm[i * 65 + lane] = acc; }
        } else {
            for (int e = tid - 64; e < 512; e += 448) { const int row = e >> 3, seg = e & 7; const size_t go = (size_t)(r0 + row) * 512 + h * 128 + seg * 16;
                const u32x4 v0 = *(const u32x4*)(VC + go), v1 = *(const u32x4*)(VC + go + 8); LAS float* vd = QV + row * 129 + seg * 16;
#pragma unroll
                for (int q = 0; q < 4; ++q) { vd[2 * q] = bf_lo(v0[q]); vd[2 * q + 1] = bf_hi(v0[q]); vd[8 + 2 * q] = bf_lo(v1[q]); vd[8 + 2 * q + 1] = bf_hi(v1[q]); } }
        }
        __syncthreads();
        { const int c = tid & 127, part = (tid >> 7) & 1, rg = tid >> 8; float acc[32];
#pragma unroll
            for (int ii = 0; ii < 32; ++ii) acc[ii] = 0.f;
            for (int j = 0; j < 64; ++j) { const float x = part ? Kf[j * 129 + c] * bkl[j] : QV[j * 129 + c] * betal[j];
#pragma unroll
                for (int ii = 0; ii < 32; ++ii) acc[ii] += Tm[(rg * 32 + ii) * 65 + j] * x; }
            float* dst = part ? W : U;
#pragma unroll
            for (int ii = 0; ii < 32; ++ii) dst[(size_t)(r0 + rg * 32 + ii) * 512 + h * 128 + c] = acc[ii]; }
        __syncthreads();
    }
}

constexpr int LM_PITCH = 68;
__device__ __forceinline__ void ph_dn_chunk_mfma(const Args& a, LAS unsigned char* lds, int bid, int G, int tid, int wave, int lane) {
    LAS float* Lm = (LAS float*)lds;
    LAS float* gcl = (LAS float*)(lds + 4 * 64 * LM_PITCH * 4);
    LAS float* betal = gcl + 256; LAS float* bkl = betal + 256;
    const bf16* QN = (const bf16*)(a.ws + WS_QN); const bf16* KN = (const bf16*)(a.ws + WS_KN);
    const bf16* KT = (const bf16*)(a.ws + WS_KT); const bf16* VT = (const bf16*)(a.ws + WS_VT);
    const float* Gb = (const float*)(a.ws + WS_G); const float* BETA = (const float*)(a.ws + WS_BETA); float* GC = (float*)(a.ws + WS_GC);
    float* U = (float*)(a.ws + WS_U); bf16* W = (bf16*)(a.ws + WS_W); bf16* ATT = (bf16*)(a.ws + WS_ATT);
    const int n = lane & 31, hh = lane >> 5;
    for (int cb = bid * 4; cb < 1024; cb += G * 4) {
        if (wave < 4) { const int ci = cb + wave, nn = ci & 31, h = (ci >> 5) & 3, b = ci >> 7, r0 = b * SEQ + nn * 64;
            float g = Gb[(size_t)(r0 + lane) * 4 + h];
#pragma unroll
            for (int off = 1; off < 64; off <<= 1) { const float v = __shfl_up(g, off); if (lane >= off) g += v; }
            const float be = BETA[(size_t)(r0 + lane) * 4 + h];
            gcl[wave * 64 + lane] = g; GC[(size_t)(r0 + lane) * 4 + h] = g; betal[wave * 64 + lane] = be; bkl[wave * 64 + lane] = be * __expf(g); }
        __syncthreads();
#pragma unroll 1
        for (int q = 0; q < 3; ++q) { const int id = 3 * wave + q, c = id / 6, wq = id % 6, isq = wq >= 3 ? 1 : 0, blk = wq % 3, ib = blk >= 1 ? 1 : 0, jb = blk == 2 ? 1 : 0;
            const int ci = cb + c, nn = ci & 31, h = (ci >> 5) & 3, b = ci >> 7, r0 = b * SEQ + nn * 64;
            const bf16* ap = (isq ? QN : KN) + (size_t)(r0 + 32 * ib + n) * 512 + h * 128 + 8 * hh;
            const bf16* bp = KN + (size_t)(r0 + 32 * jb + n) * 512 + h * 128 + 8 * hh;
            f32x16 acc;
#pragma unroll
            for (int r = 0; r < 16; ++r) acc[r] = 0.f;
#pragma unroll
            for (int ks = 0; ks < 8; ++ks) acc = __builtin_amdgcn_mfma_f32_32x32x16_bf16(*(const bf16x8*)(ap + 16 * ks), *(const bf16x8*)(bp + 16 * ks), acc, 0, 0, 0);
            const int j = 32 * jb + n; const float gj = gcl[c * 64 + j];
#pragma unroll
            for (int r = 0; r < 16; ++r) { const int i = 32 * ib + (r & 3) + 8 * (r >> 2) + 4 * hh; const float dec = __expf(fminf(gcl[c * 64 + i] - gj, 0.f));
                if (isq) ATT[(size_t)ci * 4096 + i * 64 + j] = (bf16)((j <= i) ? f2bf(acc[r] * dec) : 0u);
                else Lm[c * 64 * LM_PITCH + i * LM_PITCH + j] = (j < i) ? betal[c * 64 + i] * acc[r] * dec : 0.f; } }
        __syncthreads();
        if (wave < 4) { LAS float* L = Lm + wave * 64 * LM_PITCH;
            for (int i = 0; i < 64; ++i) { float a0 = (i == lane) ? 1.f : 0.f, a1 = 0.f, a2 = 0.f, a3 = 0.f; int j = 0;
                for (; j + 3 < i; j += 4) { a0 -= L[i * LM_PITCH + j] * L[j * LM_PITCH + lane]; a1 -= L[i * LM_PITCH + j + 1] * L[(j + 1) * LM_PITCH + lane];
                    a2 -= L[i * LM_PITCH + j + 2] * L[(j + 2) * LM_PITCH + lane]; a3 -= L[i * LM_PITCH + j + 3] * L[(j + 3) * LM_PITCH + lane]; }
                for (; j < i; ++j) a0 -= L[i * LM_PITCH + j] * L[j * LM_PITCH + lane];
                L[i * LM_PITCH + lane] = (a0 + a1) + (a2 + a3); } }
        __syncthreads();
#pragma unroll 1
        for (int q = 0; q < 4; ++q) { const int id = wave * 4 + q, c = id >> 3, ten = (id >> 2) & 1, db = id & 3;
            const int ci = cb + c, nn = ci & 31, h = (ci >> 5) & 3, b = ci >> 7, r0 = b * SEQ + nn * 64;
            const bf16* arow = (ten ? KT : VT) + ((size_t)ci * 128 + 32 * db + n) * 64 + 8 * hh;
            const LAS float* scl = (ten ? bkl : betal) + c * 64;
            const LAS float* L = Lm + c * 64 * LM_PITCH;
#pragma unroll
            for (int ib = 0; ib < 2; ++ib) { f32x16 acc;
#pragma unroll
                for (int r = 0; r < 16; ++r) acc[r] = 0.f;
#pragma unroll
                for (int ks = 0; ks < 4; ++ks) { if (ib == 0 && ks >= 2) continue;
                    const LAS float* tp = L + (32 * ib + n) * LM_PITCH + 16 * ks + 8 * hh;
                    const f32x4 t0 = *(const LAS f32x4*)tp, t1 = *(const LAS f32x4*)(tp + 4), s0 = *(const LAS f32x4*)(scl + 16 * ks + 8 * hh), s1 = *(const LAS f32x4*)(scl + 16 * ks + 8 * hh + 4);
                    u32x4 bw; bw.x = pg8::cvt_pk_bf16(t0.x * s0.x, t0.y * s0.y); bw.y = pg8::cvt_pk_bf16(t0.z * s0.z, t0.w * s0.w); bw.z = pg8::cvt_pk_bf16(t1.x * s1.x, t1.y * s1.y); bw.w = pg8::cvt_pk_bf16(t1.z * s1.z, t1.w * s1.w);
                    acc = __builtin_amdgcn_mfma_f32_32x32x16_bf16(*(const bf16x8*)(arow + 16 * ks), __builtin_bit_cast(bf16x8, bw), acc, 0, 0, 0); }
                const size_t ob = (size_t)(r0 + 32 * ib + n) * 512 + h * 128 + 32 * db + 4 * hh;
#pragma unroll
                for (int rq = 0; rq < 4; ++rq) {
                    if (ten) { u32x2 w2; w2.x = pk2(acc[4 * rq], acc[4 * rq + 1]); w2.y = pk2(acc[4 * rq + 2], acc[4 * rq + 3]); *(u32x2*)(W + ob + 8 * rq) = w2; }
                    else *(f32x4*)(U + ob + 8 * rq) = (f32x4){acc[4 * rq], acc[4 * rq + 1], acc[4 * rq + 2], acc[4 * rq + 3]}; } } }
        __syncthreads();
    }
}

__device__ __forceinline__ void ph_dn_scan(const Args& a, LAS unsigned char* lds, int bid, int G, int tid) {
    LAS float* Sl = (LAS float*)lds;
    LAS float* Wl = Sl + 128 * 16;
    LAS unsigned* Ql = (LAS unsigned*)(Wl + 64 * 129);
    LAS unsigned* Kl = Ql + 64 * 65;
    LAS float* Al = (LAS float*)(Kl + 64 * 65);
    LAS float* UL = Al + 64 * 65;
    LAS float* VN = UL + 64 * 16;
    LAS float* gcl = VN + 64 * 17; LAS float* dkl = gcl + 64; LAS float* egl = dkl + 64;
    const bf16* QN = (const bf16*)(a.ws + WS_QN); const bf16* KN = (const bf16*)(a.ws + WS_KN);
    const float* GC = (const float*)(a.ws + WS_GC); const float* U = (const float*)(a.ws + WS_U); const bf16* W = (const bf16*)(a.ws + WS_W);
    const bf16* ATT = (const bf16*)(a.ws + WS_ATT); float* O = (float*)(a.ws + WS_O);
    for (int u = bid; u < 256; u += G) {
        const int s = u & 7, h = (u >> 3) & 3, b = u >> 5;
        for (int i = tid; i < 128 * 16; i += NTHR) Sl[i] = 0.f;
        __syncthreads();
        const int c = tid & 15, i0 = tid >> 4;
        for (int n = 0; n < 32; ++n) {
            const int r0 = b * SEQ + n * 64, ci = (b * 4 + h) * 32 + n;
            { const int row = tid >> 3, seg = tid & 7; const size_t go = (size_t)(r0 + row) * 512 + h * 128 + seg * 16;
                { const u32x4 w0 = *(const u32x4*)(W + go), w1 = *(const u32x4*)(W + go + 8); LAS float* wd = Wl + row * 129 + seg * 16;
#pragma unroll
                    for (int q = 0; q < 4; ++q) { wd[2 * q] = bf_lo(w0[q]); wd[2 * q + 1] = bf_hi(w0[q]); wd[8 + 2 * q] = bf_lo(w1[q]); wd[8 + 2 * q + 1] = bf_hi(w1[q]); } }
                const u32x4 q0 = *(const u32x4*)(QN + go), q1 = *(const u32x4*)(QN + go + 8), k0 = *(const u32x4*)(KN + go), k1 = *(const u32x4*)(KN + go + 8);
                LAS unsigned* qd = Ql + row * 65 + seg * 8; LAS unsigned* kd = Kl + row * 65 + seg * 8;
#pragma unroll
                for (int q = 0; q < 4; ++q) { qd[q] = q0[q]; qd[4 + q] = q1[q]; kd[q] = k0[q]; kd[4 + q] = k1[q]; }
                const int idx = tid * 8, ar = idx >> 6, ac = idx & 63;
                const u32x4 a0 = *(const u32x4*)(ATT + (size_t)ci * 4096 + idx);
                LAS float* ad = Al + ar * 65 + ac; const bool upz = (ar < 32 && ac >= 32);
                ad[0] = upz ? 0.f : bf_lo(a0.x); ad[1] = upz ? 0.f : bf_hi(a0.x); ad[2] = upz ? 0.f : bf_lo(a0.y); ad[3] = upz ? 0.f : bf_hi(a0.y); ad[4] = upz ? 0.f : bf_lo(a0.z); ad[5] = upz ? 0.f : bf_hi(a0.z); ad[6] = upz ? 0.f : bf_lo(a0.w); ad[7] = upz ? 0.f : bf_hi(a0.w);
#pragma unroll
                for (int rr = 0; rr < 2; ++rr) { const int i = i0 + 32 * rr; UL[i * 16 + c] = U[(size_t)(r0 + i) * 512 + h * 128 + s * 16 + c]; }
                if (tid < 64) gcl[tid] = GC[(size_t)(r0 + tid) * 4 + h]; }
            __syncthreads();
            if (tid < 64) { const float gl = gcl[63], gi = gcl[tid]; dkl[tid] = __expf(gl - gi); egl[tid] = __expf(gi); }
#pragma unroll
            for (int rr = 0; rr < 2; ++rr) { const int i = i0 + 32 * rr; float acc = UL[i * 16 + c];
                for (int k = 0; k < 128; ++k) acc -= Wl[i * 129 + k] * Sl[k * 16 + c];
                VN[i * 17 + c] = acc; }
            __syncthreads();
#pragma unroll
            for (int rr = 0; rr < 2; ++rr) { const int i = i0 + 32 * rr; float acc = 0.f;
                for (int k2 = 0; k2 < 64; ++k2) { const unsigned qw = Ql[i * 65 + k2]; acc += bf_lo(qw) * Sl[(2 * k2) * 16 + c] + bf_hi(qw) * Sl[(2 * k2 + 1) * 16 + c]; }
                acc *= egl[i];
                for (int j = 0; j <= i; ++j) acc += Al[i * 65 + j] * VN[j * 17 + c];
                O[(size_t)(r0 + i) * 512 + h * 128 + s * 16 + c] = acc; }
            __syncthreads();
            { const float eg = __expf(gcl[63]);
#pragma unroll
                for (int m = 0; m < 4; ++m) { const int kk = i0 + 32 * m; float acc = Sl[kk * 16 + c] * eg;
                    for (int j = 0; j < 64; ++j) { const unsigned kw = Kl[j * 65 + (kk >> 1)]; const float kv = (kk & 1) ? bf_hi(kw) : bf_lo(kw); acc += kv * dkl[j] * VN[j * 17 + c]; }
                    Sl[kk * 16 + c] = acc; } }
            __syncthreads();
        }
    }
}

constexpr int SC_WP = 272, SC_AP = 144;
constexpr int SC_W = 0, SC_Q = 64 * SC_WP, SC_A = 2 * 64 * SC_WP, SC_K = SC_A + 64 * SC_AP, SC_GC = SC_K + 128 * SC_AP, SC_BUF = SC_GC + 1024;
static_assert(2 * SC_BUF <= RING_BYTES, "scan LDS");
struct ScanPf { u32x4 w0, w1, q0, q1, at, k0, k1; float g, gl; };
__device__ __forceinline__ ScanPf scan_load(const bf16* W, const bf16* QN, const bf16* ATT, const bf16* KT, const float* GC, int r0, int h, int ci, int tid) {
    ScanPf p; const int row = tid >> 4, seg = tid & 15; const size_t go = (size_t)(r0 + row) * 512 + h * 128 + seg * 8;
    p.w0 = *(const u32x4*)(W + go); p.w1 = *(const u32x4*)(W + go + (size_t)32 * 512); p.q0 = *(const u32x4*)(QN + go); p.q1 = *(const u32x4*)(QN + go + (size_t)32 * 512);
    p.at = *(const u32x4*)(ATT + (size_t)ci * 4096 + tid * 8);
    p.k0 = *(const u32x4*)(KT + (size_t)ci * 8192 + tid * 8); p.k1 = *(const u32x4*)(KT + (size_t)ci * 8192 + 4096 + tid * 8);
    p.g = GC[(size_t)(r0 + (tid & 63)) * 4 + h]; p.gl = GC[(size_t)(r0 + 63) * 4 + h]; return p;
}
__device__ __forceinline__ void scan_store(const ScanPf& p, LAS unsigned char* buf, int tid) {
    const int row = tid >> 4, seg = tid & 15;
    *(LAS u32x4*)(buf + SC_W + row * SC_WP + seg * 16) = p.w0; *(LAS u32x4*)(buf + SC_W + (row + 32) * SC_WP + seg * 16) = p.w1;
    *(LAS u32x4*)(buf + SC_Q + row * SC_WP + seg * 16) = p.q0; *(LAS u32x4*)(buf + SC_Q + (row + 32) * SC_WP + seg * 16) = p.q1;
    *(LAS u32x4*)(buf + SC_A + (tid >> 3) * SC_AP + (tid & 7) * 16) = p.at;
    *(LAS u32x4*)(buf + SC_K + (tid >> 3) * SC_AP + (tid & 7) * 16) = p.k0; *(LAS u32x4*)(buf + SC_K + (64 + (tid >> 3)) * SC_AP + (tid & 7) * 16) = p.k1;
    if (tid < 64) { LAS float* gp = (LAS float*)(buf + SC_GC); gp[tid] = __expf(p.g); gp[64 + tid] = __expf(p.gl - p.g); if (tid == 0) gp[128] = __expf(p.gl); }
}
__device__ __forceinline__ bf16x8 frag2(const LAS unsigned char* p) { const u32x2 lo = *(const LAS u32x2*)p, hi = *(const LAS u32x2*)(p + 16); const u32x4 v = {lo.x, lo.y, hi.x, hi.y}; return __builtin_bit_cast(bf16x8, v); }
__device__ __forceinline__ void ph_dn_scan_mfma(const Args& a, LAS unsigned char* lds, int bid, int G, int tid, int wave, int lane) {
    const bf16* QN = (const bf16*)(a.ws + WS_QN); const bf16* KT = (const bf16*)(a.ws + WS_KT); const bf16* W = (const bf16*)(a.ws + WS_W); const bf16* ATT = (const bf16*)(a.ws + WS_ATT);
    const float* GC = (const float*)(a.ws + WS_GC); const float* U = (const float*)(a.ws + WS_U); float* O = (float*)(a.ws + WS_O);
    const int n = lane & 31, hh = lane >> 5;
    for (int u = bid; u < 32; u += G) {
        const int h = u & 3, b = u >> 2;
        f32x16 S[4];
#pragma unroll
        for (int k = 0; k < 4; ++k)
#pragma unroll
            for (int r = 0; r < 16; ++r) S[k][r] = 0.f;
        __syncthreads();
        { const ScanPf p0 = scan_load(W, QN, ATT, KT, GC, b * SEQ, h, (b * 4 + h) * 32, tid); scan_store(p0, lds, tid); }
        __syncthreads();
#pragma unroll 1
        for (int nn = 0; nn < 32; ++nn) {
            const int r0 = b * SEQ + nn * 64; LAS unsigned char* buf = lds + (nn & 1) * SC_BUF; const LAS float* gp = (const LAS float*)(buf + SC_GC);
            ScanPf pf; if (nn + 1 < 32) pf = scan_load(W, QN, ATT, KT, GC, r0 + 64, h, (b * 4 + h) * 32 + nn + 1, tid);
            if (wave < 4) {
                const size_t ubase = (size_t)r0 * 512 + h * 128 + 32 * wave + n;
                f32x16 vn[2];
#pragma unroll
                for (int ib = 0; ib < 2; ++ib)
#pragma unroll
                    for (int r = 0; r < 16; ++r) vn[ib][r] = U[ubase + (size_t)(32 * ib + (r & 3) + 8 * (r >> 2) + 4 * hh) * 512];
                bf16x8 Sb[4][2];
#pragma unroll
                for (int k = 0; k < 4; ++k)
#pragma unroll
                    for (int s2 = 0; s2 < 2; ++s2) { u32x4 w4; w4.x = pg8::cvt_pk_bf16(S[k][8 * s2], S[k][8 * s2 + 1]); w4.y = pg8::cvt_pk_bf16(S[k][8 * s2 + 2], S[k][8 * s2 + 3]);
                        w4.z = pg8::cvt_pk_bf16(S[k][8 * s2 + 4], S[k][8 * s2 + 5]); w4.w = pg8::cvt_pk_bf16(S[k][8 * s2 + 6], S[k][8 * s2 + 7]); Sb[k][s2] = __builtin_bit_cast(bf16x8, w4); }
#pragma unroll
                for (int ib = 0; ib < 2; ++ib) { f32x16 acc;
#pragma unroll
                    for (int r = 0; r < 16; ++r) acc[r] = 0.f;
#pragma unroll
                    for (int k = 0; k < 4; ++k)
#pragma unroll
                        for (int s2 = 0; s2 < 2; ++s2) acc = __builtin_amdgcn_mfma_f32_32x32x16_bf16(frag2(buf + SC_W + (32 * ib + n) * SC_WP + (32 * k + 16 * s2 + 4 * hh) * 2), Sb[k][s2], acc, 0, 0, 0);
#pragma unroll
                    for (int r = 0; r < 16; ++r) vn[ib][r] -= acc[r]; }
                bf16x8 vb[2][2], vd[2][2];
#pragma unroll
                for (int jb = 0; jb < 2; ++jb)
#pragma unroll
                    for (int s2 = 0; s2 < 2; ++s2) { const f32x4 d0 = *(const LAS f32x4*)(gp + 64 + 32 * jb + 16 * s2 + 4 * hh), d1 = *(const LAS f32x4*)(gp + 64 + 32 * jb + 16 * s2 + 8 + 4 * hh);
                        const float* v = nullptr; (void)v; u32x4 w4, w5;
                        w4.x = pg8::cvt_pk_bf16(vn[jb][8 * s2], vn[jb][8 * s2 + 1]); w4.y = pg8::cvt_pk_bf16(vn[jb][8 * s2 + 2], vn[jb][8 * s2 + 3]);
                        w4.z = pg8::cvt_pk_bf16(vn[jb][8 * s2 + 4], vn[jb][8 * s2 + 5]); w4.w = pg8::cvt_pk_bf16(vn[jb][8 * s2 + 6], vn[jb][8 * s2 + 7]);
                        w5.x = pg8::cvt_pk_bf16(vn[jb][8 * s2] * d0.x, vn[jb][8 * s2 + 1] * d0.y); w5.y = pg8::cvt_pk_bf16(vn[jb][8 * s2 + 2] * d0.z, vn[jb][8 * s2 + 3] * d0.w);
                        w5.z = pg8::cvt_pk_bf16(vn[jb][8 * s2 + 4] * d1.x, vn[jb][8 * s2 + 5] * d1.y); w5.w = pg8::cvt_pk_bf16(vn[jb][8 * s2 + 6] * d1.z, vn[jb][8 * s2 + 7] * d1.w);
                        vb[jb][s2] = __builtin_bit_cast(bf16x8, w4); vd[jb][s2] = __builtin_bit_cast(bf16x8, w5); }
#pragma unroll
                for (int ib = 0; ib < 2; ++ib) { f32x16 acc;
#pragma unroll
                    for (int r = 0; r < 16; ++r) acc[r] = 0.f;
#pragma unroll
                    for (int k = 0; k < 4; ++k)
#pragma unroll
                        for (int s2 = 0; s2 < 2; ++s2) acc = __builtin_amdgcn_mfma_f32_32x32x16_bf16(frag2(buf + SC_Q + (32 * ib + n) * SC_WP + (32 * k + 16 * s2 + 4 * hh) * 2), Sb[k][s2], acc, 0, 0, 0);
#pragma unroll
                    for (int rq = 0; rq < 4; ++rq) { const f32x4 e4 = *(const LAS f32x4*)(gp + 32 * ib + 8 * rq + 4 * hh);
                        acc[4 * rq] *= e4.x; acc[4 * rq + 1] *= e4.y; acc[4 * rq + 2] *= e4.z; acc[4 * rq + 3] *= e4.w; }
#pragma unroll
                    for (int jb = 0; jb < 2; ++jb) { if (jb > ib) continue;
#pragma unroll
                        for (int s2 = 0; s2 < 2; ++s2) acc = __builtin_amdgcn_mfma_f32_32x32x16_bf16(frag2(buf + SC_A + (32 * ib + n) * SC_AP + (32 * jb + 16 * s2 + 4 * hh) * 2), vb[jb][s2], acc, 0, 0, 0); }
#pragma unroll
                    for (int r = 0; r < 16; ++r) O[ubase + (size_t)(32 * ib + (r & 3) + 8 * (r >> 2) + 4 * hh) * 512] = acc[r]; }
                const float egl = gp[128];
#pragma unroll
                for (int k = 0; k < 4; ++k) {
#pragma unroll
                    for (int r = 0; r < 16; ++r) S[k][r] *= egl;
#pragma unroll
                    for (int jb = 0; jb < 2; ++jb)
#pragma unroll
                        for (int s2 = 0; s2 < 2; ++s2) S[k] = __builtin_amdgcn_mfma_f32_32x32x16_bf16(frag2(buf + SC_K + (32 * k + n) * SC_AP + (32 * jb + 16 * s2 + 4 * hh) * 2), vd[jb][s2], S[k], 0, 0, 0); }
            }
            if (nn + 1 < 32) scan_store(pf, lds + ((nn + 1) & 1) * SC_BUF, tid);
            __syncthreads();
        }
    }
}

__device__ __forceinline__ void ph_dn_out(const Args& a, int l, int gw, int NGW, int lane) {
    const float* O = (const float*)(a.ws + WS_O); const bf16* P = (const bf16*)(a.ws + WS_P); bf16* Y = (bf16*)(a.ws + WS_Y);
    const float* nw = a.in[6] + l * 128;
    for (int tok = gw; tok < NT; tok += NGW) {
#pragma unroll
        for (int h = 0; h < 4; ++h) { const float o0 = O[(size_t)tok * 512 + h * 128 + 2 * lane], o1 = O[(size_t)tok * 512 + h * 128 + 2 * lane + 1];
            const float ss = wave_sum(o0 * o0 + o1 * o1); const float r = rsqrtf(ss * (1.0f / 128.0f) + EPS);
            const unsigned zw = *(const unsigned*)(P + (size_t)tok * NP + C_Z + h * 128 + 2 * lane);
            const float y0 = o0 * r * nw[2 * lane] * siluf_(bf_lo(zw)), y1 = o1 * r * nw[2 * lane + 1] * siluf_(bf_hi(zw));
            *(unsigned*)(Y + (size_t)tok * DM + h * 128 + 2 * lane) = pk2(y0, y1); }
    }
}

__device__ __forceinline__ void nsa_qk(const bf16* krow, const LAS float* qs, float (&s)[4]) {
#pragma unroll
    for (int h = 0; h < 4; ++h) s[h] = 0.f;
#pragma unroll 1
    for (int i = 0; i < 8; ++i) { const u32x4 kr = *(const u32x4*)(krow + 8 * i);
#pragma unroll
        for (int hf = 0; hf < 2; ++hf) { const float k0 = bf_lo(kr[2 * hf]), k1 = bf_hi(kr[2 * hf]), k2 = bf_lo(kr[2 * hf + 1]), k3 = bf_hi(kr[2 * hf + 1]);
#pragma unroll
            for (int h = 0; h < 4; ++h) { const f32x4 qv = *(const LAS f32x4*)(qs + h * 64 + i * 8 + hf * 4); s[h] += (qv.x * k0 + qv.y * k1) + (qv.z * k2 + qv.w * k3); } } }
}
__device__ __forceinline__ void nsa_pv(const float (&p)[4], LAS float* pw, const bf16* vbase, int vpitch, int kmax, int lane, float (&o)[4][2]) {
    *(LAS f32x4*)(pw + lane * 4) = (f32x4){p[0], p[1], p[2], p[3]};
    LDS_WAIT();
    const int dp = lane & 31, par = lane >> 5;
#pragma unroll 8
    for (int kk = 0; kk < 32; ++kk) { const int key = 2 * kk + par; const f32x4 pv = *(const LAS f32x4*)(pw + key * 4);
        const int row = key < kmax ? key : kmax; const unsigned vv = *(const unsigned*)(vbase + (size_t)row * vpitch + 2 * dp);
        const float v0 = bf_lo(vv), v1 = bf_hi(vv);
#pragma unroll
        for (int h = 0; h < 4; ++h) { o[h][0] += pv[h] * v0; o[h][1] += pv[h] * v1; } }
    LDS_WAIT();
}
__device__ __forceinline__ void nsa_tile(const bf16* krow, bool valid, int dist, const LAS float* qs, const LAS float* btl, LAS float* pw, const bf16* vbase, int vpitch, int lane,
                                         float (&m)[4], float (&lsum)[4], float (&o)[4][2]) {
    float s[4], p[4]; nsa_qk(krow, qs, s);
    const int dd = dist < 0 ? 0 : (dist > 2047 ? 2047 : dist);
#pragma unroll
    for (int h = 0; h < 4; ++h) { const float sv = valid ? s[h] + btl[h * 2048 + dd] : -1e30f; const float mn = fmaxf(m[h], wave_max(sv));
        const float corr = __expf(m[h] - mn); p[h] = valid ? __expf(sv - mn) : 0.f; lsum[h] = lsum[h] * corr + wave_sum(p[h]); o[h][0] *= corr; o[h][1] *= corr; m[h] = mn; }
    nsa_pv(p, pw, vbase, vpitch, 63, lane, o);
}

__device__ __forceinline__ void ph_nsa(const Args& a, LAS unsigned char* lds, int bid, int G, int tid, int wave, int lane) {
    LAS float* btl = (LAS float*)lds;
    LAS float* qs = (LAS float*)(lds + 32768 + wave * 4096);
    LAS float* pw = qs + 256;
    LAS float* ps = pw + 256;
    const float* BT = (const float*)(a.ws + WS_BT);
    for (int i = tid; i < 4 * 2048; i += NTHR) btl[i] = BT[i];
    __syncthreads();
    const bf16* P = (const bf16*)(a.ws + WS_P); const bf16* NQ = (const bf16*)(a.ws + WS_NQ);
    const bf16* KS = (const bf16*)(a.ws + WS_KS); const bf16* KW = (const bf16*)(a.ws + WS_KW);
    const bf16* KCMP = (const bf16*)(a.ws + WS_KCMP); const bf16* VCMP = (const bf16*)(a.ws + WS_VCMP); bf16* Y = (bf16*)(a.ws + WS_Y);
    const int gw = bid * NWAVES + wave, NGW = G * NWAVES;
    for (int it = gw; it < NT; it += NGW) {
        const int b = it / SEQ, t = ((it % SEQ) + 293 * b) & (SEQ - 1);
        const int tok = b * SEQ + t;
#pragma unroll
        for (int i = 0; i < 4; ++i) qs[lane + 64 * i] = bf2f(NQ[(size_t)tok * 256 + lane + 64 * i]);
        LDS_WAIT();
        float ocmp[4][2], oslc[4][2], owin[4][2];
        {
            float sA[4], sB[4], pA[4], pB[4];
            const int jA = lane, jB = 64 + lane; const bool vA = (16 * jA + 31 <= t), vB = (jB < 127) && (16 * jB + 31 <= t);
            nsa_qk(KCMP + (size_t)(b * 128 + jA) * 64, qs, sA);
            nsa_qk(KCMP + (size_t)(b * 128 + (jB < 127 ? jB : 126)) * 64, qs, sB);
            int dA = t - 16 * jA - 31, dB = t - 16 * jB - 31; dA = dA < 0 ? 0 : dA; dB = dB < 0 ? 0 : dB;
#pragma unroll
            for (int h = 0; h < 4; ++h) { const float a_ = vA ? sA[h] + btl[h * 2048 + dA] : -1e30f, b_ = vB ? sB[h] + btl[h * 2048 + dB] : -1e30f;
                const float mx = wave_max(fmaxf(a_, b_)); pA[h] = vA ? __expf(a_ - mx) : 0.f; pB[h] = vB ? __expf(b_ - mx) : 0.f;
                const float ls = wave_sum(pA[h] + pB[h]); const float inv = ls > 0.f ? 1.0f / ls : 0.f; pA[h] *= inv; pB[h] *= inv; }
            ps[lane] = (pA[0] + pA[1]) + (pA[2] + pA[3]); ps[64 + lane] = (pB[0] + pB[1]) + (pB[2] + pB[3]);
#pragma unroll
            for (int h = 0; h < 4; ++h) { ocmp[h][0] = 0.f; ocmp[h][1] = 0.f; }
            nsa_pv(pA, pw, VCMP + (size_t)(b * 128) * 64, 64, 63, lane, ocmp);
            nsa_pv(pB, pw, VCMP + (size_t)(b * 128 + 64) * 64, 64, 62, lane, ocmp);
#pragma unroll
            for (int h = 0; h < 4; ++h) { ocmp[h][0] += __shfl_xor(ocmp[h][0], 32); ocmp[h][1] += __shfl_xor(ocmp[h][1], 32); }
        }
        unsigned selmask;
        {
            const int sb = lane & 31, cur = t >> 6; float imp = 0.f;
#pragma unroll
            for (int dj = -1; dj <= 3; ++dj) { const int j = 4 * sb + dj; if (j >= 0 && j <= 126) imp += ps[j]; }
            if (sb > cur) imp = -1.0f; else if (sb == 0 || sb == cur || sb == cur - 1) imp = 1e4f;
            int rank = 0;
            for (int s2 = 0; s2 < 32; ++s2) { const float v2 = __shfl(imp, s2); rank += (v2 > imp || (v2 == imp && s2 < sb)) ? 1 : 0; }
            const bool sel = (lane < 32) && (rank < 16) && (sb <= cur);
            selmask = (unsigned)__ballot(sel);
        }
        {
            float m[4], ls[4];
#pragma unroll
            for (int h = 0; h < 4; ++h) { m[h] = -1e30f; ls[h] = 0.f; oslc[h][0] = 0.f; oslc[h][1] = 0.f; }
            unsigned mk = selmask;
            while (mk) { const int sblk = __builtin_ctz(mk); mk &= mk - 1u; const int key = 64 * sblk + lane;
                nsa_tile(KS + (size_t)(b * SEQ + key) * 64, key <= t, t - key, qs, btl, pw, P + (size_t)(b * SEQ + 64 * sblk) * NP + C_KV + 192, NP, lane, m, ls, oslc); }
#pragma unroll
            for (int h = 0; h < 4; ++h) { const float inv = ls[h] > 0.f ? 1.0f / ls[h] : 0.f; oslc[h][0] = (oslc[h][0] + __shfl_xor(oslc[h][0], 32)) * inv; oslc[h][1] = (oslc[h][1] + __shfl_xor(oslc[h][1], 32)) * inv; }
        }
        {
            float m[4], ls[4];
#pragma unroll
            for (int h = 0; h < 4; ++h) { m[h] = -1e30f; ls[h] = 0.f; owin[h][0] = 0.f; owin[h][1] = 0.f; }
            const int lo = t - 511 > 0 ? t - 511 : 0;
            for (int kt = lo >> 6; kt <= (t >> 6); ++kt) { const int key = 64 * kt + lane;
                nsa_tile(KW + (size_t)(b * SEQ + key) * 64, key <= t && key >= lo, t - key, qs, btl, pw, P + (size_t)(b * SEQ + 64 * kt) * NP + C_KV + 320, NP, lane, m, ls, owin); }
#pragma unroll
            for (int h = 0; h < 4; ++h) { const float inv = ls[h] > 0.f ? 1.0f / ls[h] : 0.f; owin[h][0] = (owin[h][0] + __shfl_xor(owin[h][0], 32)) * inv; owin[h][1] = (owin[h][1] + __shfl_xor(owin[h][1], 32)) * inv; }
        }
        if (lane < 32) {
#pragma unroll
            for (int h = 0; h < 4; ++h) { const bf16* gp = P + (size_t)tok * NP + C_G + h * 3;
                const float g0 = sigmoidf_(bf2f(gp[0])), g1 = sigmoidf_(bf2f(gp[1])), g2 = sigmoidf_(bf2f(gp[2]));
                const float y0 = g0 * ocmp[h][0] + g1 * oslc[h][0] + g2 * owin[h][0], y1 = g0 * ocmp[h][1] + g1 * oslc[h][1] + g2 * owin[h][1];
                *(unsigned*)(Y + (size_t)tok * DM + 512 + h * 64 + 2 * lane) = pk2(y0, y1); }
        }
    }
}

constexpr int NSA_KT_PITCH = 144, NSA_VT_PITCH = 136;
struct NsaStage { u32x4 kv, vv; };
__device__ __forceinline__ NsaStage nsa_load(const bf16* Kbase, int kpitch, const bf16* Vbase, int vpitch, int tid) {
    const int key = tid >> 3, seg = tid & 7; NsaStage s;
    s.kv = *(const u32x4*)(Kbase + (size_t)key * kpitch + seg * 8); s.vv = *(const u32x4*)(Vbase + (size_t)key * vpitch + seg * 8); return s;
}
__device__ __forceinline__ void nsa_store(const NsaStage& s, LAS unsigned char* Kt, LAS unsigned char* Vt, int tid) {
    const int key = tid >> 3, seg = tid & 7;
    *(LAS u32x4*)(Kt + key * NSA_KT_PITCH + seg * 16) = s.kv;
#pragma unroll
    for (int i = 0; i < 4; ++i) { const unsigned w = s.vv[i];
        *(LAS unsigned short*)(Vt + (seg * 8 + 2 * i) * NSA_VT_PITCH + key * 2) = (unsigned short)(w & 0xffffu);
        *(LAS unsigned short*)(Vt + (seg * 8 + 2 * i + 1) * NSA_VT_PITCH + key * 2) = (unsigned short)(w >> 16); }
}
__device__ __forceinline__ void nsa_st(const LAS unsigned char* Kt, const bf16x8 (&qf)[4], int n, int hh, f32x16 (&s)[2]) {
#pragma unroll
    for (int kb = 0; kb < 2; ++kb) {
#pragma unroll
        for (int r = 0; r < 16; ++r) s[kb][r] = 0.f;
#pragma unroll
        for (int ks = 0; ks < 4; ++ks) { const bf16x8 af = *(const LAS bf16x8*)(Kt + (kb * 32 + n) * NSA_KT_PITCH + (16 * ks + 8 * hh) * 2);
            s[kb] = __builtin_amdgcn_mfma_f32_32x32x16_bf16(af, qf[ks], s[kb], 0, 0, 0); } }
}
__device__ __forceinline__ void nsa_pvm(const LAS unsigned char* Vt, const bf16x8 (&pf)[2][2], int n, int hh, f32x16 (&o)[2]) {
#pragma unroll
    for (int db = 0; db < 2; ++db)
#pragma unroll
        for (int kb = 0; kb < 2; ++kb)
#pragma unroll
            for (int s2 = 0; s2 < 2; ++s2) { const LAS unsigned char* p = Vt + (db * 32 + n) * NSA_VT_PITCH + (kb * 32 + 16 * s2 + 4 * hh) * 2;
                const u32x2 lo = *(const LAS u32x2*)p, hi = *(const LAS u32x2*)(p + 16);
                const u32x4 av = {lo.x, lo.y, hi.x, hi.y};
                o[db] = __builtin_amdgcn_mfma_f32_32x32x16_bf16(__builtin_bit_cast(bf16x8, av), pf[kb][s2], o[db], 0, 0, 0); }
}
__device__ __forceinline__ void nsa_pack(const f32x16 (&p)[2], bf16x8 (&pf)[2][2]) {
#pragma unroll
    for (int kb = 0; kb < 2; ++kb)
#pragma unroll
        for (int s2 = 0; s2 < 2; ++s2) { u32x4 w;
            w.x = pg8::cvt_pk_bf16(p[kb][8 * s2 + 0], p[kb][8 * s2 + 1]); w.y = pg8::cvt_pk_bf16(p[kb][8 * s2 + 2], p[kb][8 * s2 + 3]);
            w.z = pg8::cvt_pk_bf16(p[kb][8 * s2 + 4], p[kb][8 * s2 + 5]); w.w = pg8::cvt_pk_bf16(p[kb][8 * s2 + 6], p[kb][8 * s2 + 7]);
            pf[kb][s2] = __builtin_bit_cast(bf16x8, w); }
}
__device__ __forceinline__ void nsa_tile_mfma(const LAS unsigned char* Kt, const LAS unsigned char* Vt, const LAS float* btlh, const bf16x8 (&qf)[4], int n, int hh,
                                              int key0, int tq, bool colsel, int lowk, float& m, float& l, f32x16 (&o)[2]) {
    f32x16 s[2]; nsa_st(Kt, qf, n, hh, s);
    float tmax = -1e30f;
#pragma unroll
    for (int kb = 0; kb < 2; ++kb)
#pragma unroll
        for (int r = 0; r < 16; ++r) { const int key = key0 + kb * 32 + (r & 3) + 8 * (r >> 2) + 4 * hh; const int dist = tq - key;
            const bool valid = colsel && dist >= 0 && key >= lowk; const float x = s[kb][r] + btlh[dist < 0 ? 0 : dist];
            s[kb][r] = valid ? x : -1e30f; tmax = fmaxf(tmax, s[kb][r]); }
    tmax = fmaxf(tmax, __shfl_xor(tmax, 32));
    const float mn = fmaxf(m, tmax), corr = __expf(m - mn); float rs = 0.f;
#pragma unroll
    for (int kb = 0; kb < 2; ++kb)
#pragma unroll
        for (int r = 0; r < 16; ++r) { const float x = s[kb][r]; const float p = x > -1e29f ? __expf(x - mn) : 0.f; s[kb][r] = p; rs += p; }
    rs += __shfl_xor(rs, 32);
    l = l * corr + rs; m = mn;
#pragma unroll
    for (int db = 0; db < 2; ++db)
#pragma unroll
        for (int r = 0; r < 16; ++r) o[db][r] *= corr;
    bf16x8 pf[2][2]; nsa_pack(s, pf);
    nsa_pvm(Vt, pf, n, hh, o);
}

__device__ __forceinline__ void ph_nsa_mfma(const Args& a, LAS unsigned char* lds, int ubeg, int ustep, int tid, int wave, int lane) {
    LAS float* btl = (LAS float*)lds;
    LAS unsigned char* Kt = lds + 32768;
    LAS unsigned char* Vt = lds + 32768 + 9216;
    LAS float* PS = (LAS float*)(lds + 51200);
    LAS unsigned* MK = (LAS unsigned*)(lds + 84480);
    const float* BT = (const float*)(a.ws + WS_BT);
    for (int i = tid; i < 4 * 2048; i += NTHR) btl[i] = BT[i];
    const bf16* P = (const bf16*)(a.ws + WS_P); const bf16* NQ = (const bf16*)(a.ws + WS_NQ);
    const bf16* KS = (const bf16*)(a.ws + WS_KS); const bf16* KW = (const bf16*)(a.ws + WS_KW);
    const bf16* KCMP = (const bf16*)(a.ws + WS_KCMP); const bf16* VCMP = (const bf16*)(a.ws + WS_VCMP); bf16* Y = (bf16*)(a.ws + WS_Y);
    const int n = lane & 31, hh = lane >> 5, tl = n >> 2, h = n & 3;
    const LAS float* btlh = btl + h * 2048;
    __syncthreads();
    for (int u = ubeg; u < 256; u += ustep) {
        const int b = u & 7, qt = 31 - (u >> 3), t0 = 64 * qt, tq = t0 + 8 * wave + tl, tok = b * SEQ + tq;
        bf16x8 qf[4];
#pragma unroll
        for (int ks = 0; ks < 4; ++ks) qf[ks] = *(const bf16x8*)(NQ + (size_t)tok * 256 + h * 64 + 16 * ks + 8 * hh);
        float gate[3];
#pragma unroll
        for (int br = 0; br < 3; ++br) gate[br] = sigmoidf_(bf2f(P[(size_t)tok * NP + C_G + h * 3 + br]));
        f32x16 yacc[2];
#pragma unroll
        for (int db = 0; db < 2; ++db)
#pragma unroll
            for (int r = 0; r < 16; ++r) yacc[db][r] = 0.f;
        {
            f32x16 sc[2][2];
#pragma unroll
            for (int ct = 0; ct < 2; ++ct) {
                __syncthreads();
                { const NsaStage st = nsa_load(KCMP + (size_t)(b * 128 + ct * 64) * 64, 64, VCMP + (size_t)(b * 128 + ct * 64) * 64, 64, tid); nsa_store(st, Kt, Vt + ct * 0, tid); }
                __syncthreads();
                nsa_st(Kt, qf, n, hh, sc[ct]);
            }
            float mx = -1e30f;
#pragma unroll
            for (int ct = 0; ct < 2; ++ct)
#pragma unroll
                for (int kb = 0; kb < 2; ++kb)
#pragma unroll
                    for (int r = 0; r < 16; ++r) { const int j = ct * 64 + kb * 32 + (r & 3) + 8 * (r >> 2) + 4 * hh; const int dist = tq - 16 * j - 31;
                        const float x = sc[ct][kb][r] + btlh[dist < 0 ? 0 : dist]; sc[ct][kb][r] = dist >= 0 ? x : -1e30f; mx = fmaxf(mx, sc[ct][kb][r]); }
            mx = fmaxf(mx, __shfl_xor(mx, 32));
            float rs = 0.f;
#pragma unroll
            for (int ct = 0; ct < 2; ++ct)
#pragma unroll
                for (int kb = 0; kb < 2; ++kb)
#pragma unroll
                    for (int r = 0; r < 16; ++r) { const float x = sc[ct][kb][r]; const float p = x > -1e29f ? __expf(x - mx) : 0.f; sc[ct][kb][r] = p; rs += p; }
            rs += __shfl_xor(rs, 32);
            const float inv = rs > 0.f ? 1.0f / rs : 0.f;
#pragma unroll
            for (int ct = 0; ct < 2; ++ct)
#pragma unroll
                for (int kb = 0; kb < 2; ++kb)
#pragma unroll
                    for (int r = 0; r < 16; ++r) { const float p = sc[ct][kb][r] * inv; sc[ct][kb][r] = p;
                        float v = p; v += __shfl_xor(v, 1); v += __shfl_xor(v, 2);
                        if (h == 0) PS[(8 * wave + tl) * 129 + ct * 64 + kb * 32 + (r & 3) + 8 * (r >> 2) + 4 * hh] = v; }
            f32x16 o[2];
#pragma unroll
            for (int db = 0; db < 2; ++db)
#pragma unroll
                for (int r = 0; r < 16; ++r) o[db][r] = 0.f;
            { bf16x8 pf[2][2]; nsa_pack(sc[1], pf); nsa_pvm(Vt, pf, n, hh, o); }
            __syncthreads();
            { const NsaStage st = nsa_load(KCMP + (size_t)(b * 128) * 64, 64, VCMP + (size_t)(b * 128) * 64, 64, tid); nsa_store(st, Kt, Vt, tid); }
            __syncthreads();
            { bf16x8 pf[2][2]; nsa_pack(sc[0], pf); nsa_pvm(Vt, pf, n, hh, o); }
#pragma unroll
            for (int db = 0; db < 2; ++db)
#pragma unroll
                for (int r = 0; r < 16; ++r) yacc[db][r] += gate[0] * o[db][r];
        }
        LDS_WAIT();
        for (int t2 = 0; t2 < 8; ++t2) {
            const int tqq = t0 + 8 * wave + t2, sb = lane & 31, cur = tqq >> 6; const LAS float* row = PS + (8 * wave + t2) * 129; float imp = 0.f;
#pragma unroll
            for (int dj = -1; dj <= 3; ++dj) { const int j = 4 * sb + dj; if (j >= 0 && j <= 126) imp += row[j]; }
            if (sb > cur) imp = -1.0f; else if (sb == 0 || sb == cur || sb == cur - 1) imp = 1e4f;
            int rank = 0;
            for (int s2 = 0; s2 < 32; ++s2) { const float v2 = __shfl(imp, s2); rank += (v2 > imp || (v2 == imp && s2 < sb)) ? 1 : 0; }
            const unsigned msk = (unsigned)__ballot((lane < 32) && (rank < 16) && (sb <= cur));
            if (lane == 0) MK[8 * wave + t2] = msk;
        }
        __syncthreads();
        unsigned anymask, wmask; const unsigned mymask = MK[8 * wave + tl];
        { unsigned v = MK[lane];
#pragma unroll
            for (int o_ = 1; o_ < 64; o_ <<= 1) v |= (unsigned)__shfl_xor((int)v, o_);
            anymask = (unsigned)__builtin_amdgcn_readfirstlane((int)v);
            unsigned w = MK[8 * wave + (lane & 7)]; w |= (unsigned)__shfl_xor((int)w, 1); w |= (unsigned)__shfl_xor((int)w, 2); w |= (unsigned)__shfl_xor((int)w, 4);
            wmask = (unsigned)__builtin_amdgcn_readfirstlane((int)w); }
        {
            float m = -1e30f, l = 0.f; f32x16 o[2];
#pragma unroll
            for (int db = 0; db < 2; ++db)
#pragma unroll
                for (int r = 0; r < 16; ++r) o[db][r] = 0.f;
            unsigned mk = anymask;
            NsaStage st; { const int s0 = __builtin_ctz(mk); st = nsa_load(KS + (size_t)(b * SEQ + 64 * s0) * 64, 64, P + (size_t)(b * SEQ + 64 * s0) * NP + C_KV + 192, NP, tid); }
            while (mk) {
                const int sblk = __builtin_ctz(mk); mk &= mk - 1u;
                __syncthreads();
                nsa_store(st, Kt, Vt, tid);
                __syncthreads();
                if (mk) { const int s1 = __builtin_ctz(mk); st = nsa_load(KS + (size_t)(b * SEQ + 64 * s1) * 64, 64, P + (size_t)(b * SEQ + 64 * s1) * NP + C_KV + 192, NP, tid); }
                if ((wmask >> sblk) & 1u) nsa_tile_mfma(Kt, Vt, btlh, qf, n, hh, 64 * sblk, tq, ((mymask >> sblk) & 1u) != 0u, 0, m, l, o);
            }
            const float inv = l > 0.f ? gate[1] / l : 0.f;
#pragma unroll
            for (int db = 0; db < 2; ++db)
#pragma unroll
                for (int r = 0; r < 16; ++r) yacc[db][r] += inv * o[db][r];
        }
        {
            float m = -1e30f, l = 0.f; f32x16 o[2];
#pragma unroll
            for (int db = 0; db < 2; ++db)
#pragma unroll
                for (int r = 0; r < 16; ++r) o[db][r] = 0.f;
            const int kt0 = (t0 - 511 > 0 ? t0 - 511 : 0) >> 6;
            NsaStage st = nsa_load(KW + (size_t)(b * SEQ + 64 * kt0) * 64, 64, P + (size_t)(b * SEQ + 64 * kt0) * NP + C_KV + 320, NP, tid);
            for (int kt = kt0; kt <= qt; ++kt) {
                __syncthreads();
                nsa_store(st, Kt, Vt, tid);
                __syncthreads();
                if (kt < qt) st = nsa_load(KW + (size_t)(b * SEQ + 64 * (kt + 1)) * 64, 64, P + (size_t)(b * SEQ + 64 * (kt + 1)) * NP + C_KV + 320, NP, tid);
                nsa_tile_mfma(Kt, Vt, btlh, qf, n, hh, 64 * kt, tq, true, tq - 511, m, l, o);
            }
            const float inv = l > 0.f ? gate[2] / l : 0.f;
#pragma unroll
            for (int db = 0; db < 2; ++db)
#pragma unroll
                for (int r = 0; r < 16; ++r) yacc[db][r] += inv * o[db][r];
        }
#pragma unroll
        for (int db = 0; db < 2; ++db)
#pragma unroll
            for (int rq = 0; rq < 4; ++rq) { u32x2 w; w.x = pk2(yacc[db][4 * rq], yacc[db][4 * rq + 1]); w.y = pk2(yacc[db][4 * rq + 2], yacc[db][4 * rq + 3]);
                *(u32x2*)(Y + (size_t)tok * DM + 512 + h * 64 + db * 32 + 8 * rq + 4 * hh) = w; }
        __syncthreads();
    }
}

__device__ __forceinline__ void ph_router(const Args& a, int l, const float* X1, LAS unsigned char* lds, int bid, int G, int tid, int wave, int lane) {
    LAS float* hrow = (LAS float*)lds + wave * 1024;
    LAS int* lcnt = (LAS int*)(lds + 32768); LAS int* asg_e = lcnt + 32; LAS int* asg_p = asg_e + 256; LAS float* asg_w = (LAS float*)(asg_p + 256); LAS int* gbase = (LAS int*)(asg_w + 256);
    bf16* H2 = (bf16*)(a.ws + WS_XN); unsigned* cnt = (unsigned*)(a.ws + WS_CTL) + CW_CNT + 64 * l;
    int* EIDX = (int*)(a.ws + WS_EIDX); int* EPOS = (int*)(a.ws + WS_EPOS); float* EW = (float*)(a.ws + WS_EW);
    const float* fw = a.in[17] + (size_t)l * DM; const float* rw = a.in[18] + (size_t)l * DM * NE; const float* rb = a.in[19] + l * NE;
    for (int u = bid; u < NT / 64; u += G) {
        const int tok0 = u * 64;
        if (tid < 32) lcnt[tid] = 0;
        __syncthreads();
        for (int i = 0; i < 8; ++i) {
            const int tl = wave * 8 + i, tok = tok0 + tl;
            f32x4 v[4]; float ss = 0.f;
#pragma unroll
            for (int j = 0; j < 4; ++j) { v[j] = *(const f32x4*)(X1 + (size_t)tok * DM + 4 * (64 * j + lane)); ss += (v[j].x * v[j].x + v[j].y * v[j].y) + (v[j].z * v[j].z + v[j].w * v[j].w); }
            const float r = rsqrtf(wave_sum(ss) * (1.0f / DM) + EPS);
#pragma unroll
            for (int j = 0; j < 4; ++j) { const f32x4 y = v[j] * r * *(const f32x4*)(fw + 4 * (64 * j + lane));
                u32x2 o; o.x = pk2(y.x, y.y); o.y = pk2(y.z, y.w); *(u32x2*)(H2 + (size_t)tok * DM + 4 * (64 * j + lane)) = o;
                *(LAS f32x4*)(hrow + 4 * (64 * j + lane)) = y; }
            LDS_WAIT();
            const int e = lane & 31, half = lane >> 5; float acc = 0.f;
            for (int d = 0; d < 512; ++d) { const int dd = half * 512 + d; acc += hrow[dd] * rw[(size_t)dd * NE + e]; }
            acc += __shfl_xor(acc, 32); acc += rb[e];
            float val = acc, tv[4]; int ti[4];
#pragma unroll
            for (int q = 0; q < 4; ++q) { const float mx = wave_max(val); const unsigned bal = (unsigned)__ballot(val == mx); const int idx = __builtin_ctz(bal);
                tv[q] = mx; ti[q] = idx; if (e == idx) val = -3.0e38f; }
            float ew[4], es = 0.f;
#pragma unroll
            for (int q = 0; q < 4; ++q) { ew[q] = __expf(tv[q] - tv[0]); es += ew[q]; }
            if (lane == 0) {
#pragma unroll
                for (int q = 0; q < 4; ++q) { const int p = __hip_atomic_fetch_add(&lcnt[ti[q]], 1, __ATOMIC_RELAXED, __HIP_MEMORY_SCOPE_WORKGROUP); asg_e[tl * 4 + q] = ti[q]; asg_p[tl * 4 + q] = p; asg_w[tl * 4 + q] = ew[q] / es; } }
            LDS_WAIT();
        }
        __syncthreads();
        if (tid < 32) gbase[tid] = (int)atomicAdd(&cnt[tid], (unsigned)lcnt[tid]);
        __syncthreads();
        if (tid < 256) { const int tok = tok0 + (tid >> 2), k = tid & 3, e = asg_e[tid];
            EIDX[(size_t)tok * 4 + k] = e; EPOS[(size_t)tok * 4 + k] = gbase[e] + asg_p[tid]; EW[(size_t)tok * 4 + k] = asg_w[tid]; }
        __syncthreads();
    }
}

__device__ __forceinline__ void build_tiles(const unsigned* cnt, LAS int* TS, LAS int* TE, int tid) {
    if (tid == 0) { int acc = 0;
        for (int e = 0; e < NE; ++e) { TS[e] = acc; const int nt = (int)((cnt[e] + 255u) >> 8); for (int i = 0; i < nt; ++i) TE[acc + i] = e; acc += nt; }
        TS[NE] = acc; }
    __syncthreads();
}

__device__ __forceinline__ void ph_gather(const Args& a, int l, LAS unsigned char* lds, int gw, int NGW, int tid, int lane) {
    LAS int* TS = (LAS int*)(lds + TS_OFF); LAS int* TE = (LAS int*)(lds + TE_OFF);
    build_tiles((const unsigned*)(a.ws + WS_CTL) + CW_CNT + 64 * l, TS, TE, tid);
    const bf16* H2 = (const bf16*)(a.ws + WS_XN); bf16* XS = (bf16*)(a.ws + WS_XS);
    const int* EIDX = (const int*)(a.ws + WS_EIDX); const int* EPOS = (const int*)(a.ws + WS_EPOS); int* SLOT = (int*)(a.ws + WS_SLOT);
    for (int tok = gw; tok < NT; tok += NGW) {
        int slot = 0;
        if (lane < 4) { const int e = EIDX[(size_t)tok * 4 + lane]; slot = TS[e] * 256 + EPOS[(size_t)tok * 4 + lane]; SLOT[(size_t)tok * 4 + lane] = slot; }
        const u32x4 r0 = *(const u32x4*)(H2 + (size_t)tok * DM + 8 * lane), r1 = *(const u32x4*)(H2 + (size_t)tok * DM + 512 + 8 * lane);
#pragma unroll
        for (int k = 0; k < 4; ++k) { const int sk = __shfl(slot, k); *(u32x4*)(XS + (size_t)sk * DM + 8 * lane) = r0; *(u32x4*)(XS + (size_t)sk * DM + 512 + 8 * lane) = r1; }
    }
}

__device__ __forceinline__ void ph_combine(const Args& a, const float* X1, float* Xo, const float* next_norm_w, int gw, int NGW, int lane) {
    const bf16* YS = (const bf16*)(a.ws + WS_YS); const int* SLOT = (const int*)(a.ws + WS_SLOT); const float* EW = (const float*)(a.ws + WS_EW); bf16* XN = (bf16*)(a.ws + WS_XN);
    for (int tok = gw; tok < NT; tok += NGW) {
        int slot = 0; float wgt = 0.f;
        if (lane < 4) { slot = SLOT[(size_t)tok * 4 + lane]; wgt = EW[(size_t)tok * 4 + lane]; }
        f32x4 v[4];
#pragma unroll
        for (int j = 0; j < 4; ++j) v[j] = *(const f32x4*)(X1 + (size_t)tok * DM + 4 * (64 * j + lane));
#pragma unroll
        for (int k = 0; k < 4; ++k) { const int sk = __shfl(slot, k); const float wk = __shfl(wgt, k);
#pragma unroll
            for (int j = 0; j < 4; ++j) { const u32x2 y = *(const u32x2*)(YS + (size_t)sk * DM + 4 * (64 * j + lane));
                v[j].x += wk * bf_lo(y.x); v[j].y += wk * bf_hi(y.x); v[j].z += wk * bf_lo(y.y); v[j].w += wk * bf_hi(y.y); } }
#pragma unroll
        for (int j = 0; j < 4; ++j) *(f32x4*)(Xo + (size_t)tok * DM + 4 * (64 * j + lane)) = v[j];
        if (next_norm_w) rms_row_to_bf16(v, next_norm_w, XN + (size_t)tok * DM, lane);
    }
}

struct Tid { int tid, lane, wave; };
__device__ __forceinline__ Tid fresh_tid() { int t = threadIdx.x; asm volatile("" : "+v"(t)); Tid r; r.tid = t; r.lane = t & 63; r.wave = __builtin_amdgcn_readfirstlane(t >> 6); return r; }
#define FT() Args A_ = args_k; { unsigned char* w_ = args_k.ws; asm volatile("" : "+s"(w_)); A_.ws = w_; } const Args& args = A_; const Tid T_ = fresh_tid(); const int tid = T_.tid, lane = T_.lane, wave = T_.wave, gw = bid * NWAVES + wave; (void)tid; (void)lane; (void)wave; (void)gw
constexpr int PH_PER_LAYER = 11, NPH = 2 + NLAYER * PH_PER_LAYER;

#if SINGLE_LAUNCH
#define BARPARM , unsigned* barw, unsigned& bark
#define BARARG , barw, bark
#define GRID_BAR() cnt_barrier(barw, bark)
#else
#define BARPARM
#define BARARG
#define GRID_BAR() do {} while (0)
#endif
#define IN(k) (lo <= (k) && (k) < hi)
#define SEAM(k) do { if (IN(k) && IN((k) + 1)) GRID_BAR(); } while (0)
template <int l>
__device__ __forceinline__ void run_layer(const Args& args_k, LAS unsigned char* lds, int lo, int hi, int G, int bid, int NGW BARPARM) {
        const int pb = 2 + l * PH_PER_LAYER;
#define Xin ((l == 0) ? args.in[0] : (const float*)(args.ws + WS_XB))
#define X1 ((float*)(args.ws + WS_XA))
#define Xout ((l == NLAYER - 1) ? args.out : (float*)(args.ws + WS_XB))
        if (IN(pb + 0)) {
            FT(); pg8::Gemm g{(const pg8::bf16_t*)(args.ws + WS_XN), (const pg8::bf16_t*)(args.ws + WS_WIN) + (size_t)l * NP * DM, NT, NP, DM};
            pg8::StaticOrder S; S.init(NT, NP, G, bid);
            pg8::EpiBf16Plain E{(pg8::bf16_t*)(args.ws + WS_P), NP};
            pg8::gemm_phase<pg8::EpiBf16Plain, pg8::StaticOrder, true, true>(lds, g, S, E);
        } SEAM(pb + 0);
        if (IN(pb + 1)) { { FT(); ph_compress_mfma(args, l, lds, bid, G, tid, wave, lane); } { FT(); ph_m1(args, l, lds, bid, G, tid, wave, lane); } } SEAM(pb + 1);
        if (IN(pb + 2)) { FT(); ph_dn_chunk_mfma(args, lds, bid, G, tid, wave, lane); } SEAM(pb + 2);
        if (IN(pb + 3)) {
            const bool small = G <= 64;
            if (small || bid < 32) { FT(); ph_dn_scan_mfma(args, lds, bid, small ? G : 32, tid, wave, lane); }
            if (small || bid >= 32) { FT(); ph_nsa_mfma(args, lds, small ? bid : bid - 32, small ? G : G - 32, tid, wave, lane); } } SEAM(pb + 3);
        if (IN(pb + 4)) { FT(); ph_dn_out(args, l, gw, NGW, lane); } SEAM(pb + 4);
        if (IN(pb + 5)) {
            FT(); pg8::Gemm g{(const pg8::bf16_t*)(args.ws + WS_Y), (const pg8::bf16_t*)(args.ws + WS_WOUT) + (size_t)l * DM * DM, NT, DM, DM};
            pg8::StaticOrder S; S.init(NT, DM, G, bid);
            pg8::EpiResF32 E{Xin, X1, DM};
            pg8::gemm_phase<pg8::EpiResF32, pg8::StaticOrder, true, true>(lds, g, S, E);
        } SEAM(pb + 5);
        if (IN(pb + 6)) { FT(); ph_router(args, l, X1, lds, bid, G, tid, wave, lane); } SEAM(pb + 6);
        if (IN(pb + 7)) { FT(); ph_gather(args, l, lds, gw, NGW, tid, lane); } SEAM(pb + 7);
        if (IN(pb + 8)) {
            FT(); LAS int* TS = (LAS int*)(lds + TS_OFF); LAS int* TE = (LAS int*)(lds + TE_OFF);
            build_tiles((const unsigned*)(args.ws + WS_CTL) + CW_CNT + 64 * l, TS, TE, tid);
            const int ntiles = __builtin_amdgcn_readfirstlane(TS[NE]);
            pg8::Gemm g{(const pg8::bf16_t*)(args.ws + WS_XS), (const pg8::bf16_t*)(args.ws + WS_WGU) + (size_t)l * NE * 2048 * DM, ntiles * 256, NE * 2048, DM};
            pg8::MoeOrder<8> S{ntiles * 8, G, bid, (const LAS int*)TE};
            pg8::EpiSwiglu E{(pg8::bf16_t*)(args.ws + WS_ACT), args.in[21] + (size_t)l * NE * 2048};
            pg8::gemm_phase<pg8::EpiSwiglu, pg8::MoeOrder<8>, true, true>(lds, g, S, E);
        } SEAM(pb + 8);
        if (IN(pb + 9)) {
            FT(); LAS int* TS = (LAS int*)(lds + TS_OFF); LAS int* TE = (LAS int*)(lds + TE_OFF);
            build_tiles((const unsigned*)(args.ws + WS_CTL) + CW_CNT + 64 * l, TS, TE, tid);
            const int ntiles = __builtin_amdgcn_readfirstlane(TS[NE]);
            pg8::Gemm g{(const pg8::bf16_t*)(args.ws + WS_ACT), (const pg8::bf16_t*)(args.ws + WS_WD) + (size_t)l * NE * DM * DM, ntiles * 256, NE * DM, DM};
            pg8::MoeOrder<4> S{ntiles * 4, G, bid, (const LAS int*)TE};
            pg8::EpiDown E{(pg8::bf16_t*)(args.ws + WS_YS), args.in[23] + (size_t)l * NE * DM};
            pg8::gemm_phase<pg8::EpiDown, pg8::MoeOrder<4>, true, true>(lds, g, S, E);
        } SEAM(pb + 9);
        if (IN(pb + 10)) { FT(); ph_combine(args, X1, Xout, (l + 1 < NLAYER) ? args.in[1] + (size_t)(l + 1) * DM : nullptr, gw, NGW, lane); }
        if (l + 1 < NLAYER) SEAM(pb + 10);
    }

__global__ void __launch_bounds__(NTHR, 2) fwd_kernel(Args args_k) {
    extern __shared__ __attribute__((aligned(16))) unsigned char lds_raw[];
    LAS unsigned char* lds = (LAS unsigned char*)lds_raw;
    const int G = gridDim.x, bid = blockIdx.x, NGW = G * NWAVES;
    for (int u = threadIdx.x; u < (LDS_BYTES - LDSCTL_OFF) / 4; u += NTHR) ((LAS unsigned*)(lds + LDSCTL_OFF))[u] = 0u;
    __syncthreads();
#if SINGLE_LAUNCH
    unsigned* barw = (unsigned*)(args_k.ws + WS_CTL) + CW_BAR; unsigned bark = 0u;
#endif
    const int lo = args_k.ph_lo, hi = args_k.ph_hi;

    if (IN(0)) { FT(); ph_prologue(args, lds, gw, NGW, wave, lane); } SEAM(0);
    if (IN(1)) { FT(); ph_norm0(args, gw, NGW, lane); } SEAM(1);

    run_layer<0>(args_k, lds, lo, hi, G, bid, NGW BARARG);
    run_layer<1>(args_k, lds, lo, hi, G, bid, NGW BARARG);
#undef IN
#undef SEAM
}

extern "C" void kernel_launch(void* const* d_in, const int* in_sizes, int n_in, void* d_out, int out_size, void* d_ws, size_t ws_size, hipStream_t stream) {
    static int grid = 0;
    if (grid == 0) {
        if (n_in != 25 || in_sizes[0] != NT * DM || out_size != NT * DM || ws_size < WS_END) {
            fprintf(stderr, "kernel_launch: unexpected problem (n_in %d, in0 %d, out %d, ws %zu < %zu); nothing launched\n", n_in, n_in > 0 ? in_sizes[0] : -1, out_size, ws_size, (size_t)WS_END); grid = -1; return; }
        int dev = 0, cus = 0, per_cu = 0;
        if (hipGetDevice(&dev) != hipSuccess || hipDeviceGetAttribute(&cus, hipDeviceAttributeMultiprocessorCount, dev) != hipSuccess) { grid = -1; return; }
        if (hipFuncSetAttribute((const void*)fwd_kernel, hipFuncAttributeMaxDynamicSharedMemorySize, LDS_BYTES) != hipSuccess) { fprintf(stderr, "kernel_launch: hipFuncSetAttribute failed\n"); grid = -1; return; }
        if (hipOccupancyMaxActiveBlocksPerMultiprocessor(&per_cu, (const void*)fwd_kernel, NTHR, LDS_BYTES) != hipSuccess || per_cu < 1)
            fprintf(stderr, "kernel_launch: note: occupancy query reports %d workgroups per CU\n", per_cu);
        (void)hipGetLastError();
        grid = cus;
    }
    if (grid < 0) return;
    if (hipMemsetAsync((char*)d_ws + WS_CTL, 0, CTL_ZERO_BYTES, stream) != hipSuccess) { fprintf(stderr, "kernel_launch: memset failed\n"); return; }
    Args a{};
    for (int i = 0; i < 25; ++i) a.in[i] = (const float*)d_in[i];
    a.out = (float*)d_out; a.ws = (unsigned char*)d_ws;
#if SINGLE_LAUNCH
    a.ph_lo = 0; a.ph_hi = NPH;
    hipLaunchKernelGGL(fwd_kernel, dim3(grid), dim3(NTHR), LDS_BYTES, stream, a);
#else
    for (int ph = 0; ph < NPH; ++ph) { a.ph_lo = ph; a.ph_hi = ph + 1; hipLaunchKernelGGL(fwd_kernel, dim3(grid), dim3(NTHR), LDS_BYTES, stream, a); }
#endif
}
```

```cpp
#include <hip/hip_runtime.h>
#include <cstdio>
#include <cstdint>
#include <cstddef>
namespace pg8 {
#define PG8_LAS __attribute__((address_space(3)))
typedef unsigned short bf16_t;
typedef short bf16x8 __attribute__((ext_vector_type(8)));
typedef float f32x4 __attribute__((ext_vector_type(4)));
typedef unsigned u32x4 __attribute__((ext_vector_type(4)));
constexpr int BM = 256, BK = 64, HALF = 128, HTB = HALF * BK * 2  , STAGE_BYTES = 8 * HTB, NXCD = 8, WGM = 8;

__host__ __device__ __forceinline__ int lds_byte(int r, int c) { const int st = (r >> 4) * 2 + (c >> 5), rr = r & 15, cc = c & 31, ob = rr * 64 + cc * 2; return st * 1024 + (ob ^ (((ob >> 9) & 1) << 5)); }
__host__ __device__ __forceinline__ void stage_rc(int b, int& R, int& C) { const int st = b / 1024, sb = b % 1024, swz = sb ^ (((sb >> 9) & 1) << 5); R = (st >> 1) * 16 + swz / 64; C = (st & 1) * 32 + (swz % 64) / 2; }
__host__ __device__ __forceinline__ int perm32(int rho) { const int n = rho >> 4, i = rho & 15; return 8 * (i >> 2) + 4 * n + (i & 3); }

struct Unit { int pm, pn; };
struct Gemm { const bf16_t* A; const bf16_t* Bt; int M, N, K; };

struct StaticOrder {
    int nM, nN, nwg, G, c;
    __host__ __device__ void init(int M, int N, int G_, int c_) { nM = M / BM; nN = N / BM; nwg = nM * nN; G = G_; c = c_; }
    __host__ __device__ bool next(int i, Unit& u) const {
        const long L = (long)i * G + c; if (L >= nwg) return false;
        int wgid = (int)L; { const int q = nwg / NXCD, r = nwg % NXCD, xcd = wgid % NXCD, off = wgid / NXCD; wgid = (xcd < r ? xcd * (q + 1) : r * (q + 1) + (xcd - r) * q) + off; }
        const int nig = WGM * nN, gid = wgid / nig, fm = gid * WGM, gsz = (nM - fm) < WGM ? (nM - fm) : WGM;
        u.pm = fm + ((wgid % nig) % gsz); u.pn = (wgid % nig) / gsz; return true;
    }
    __device__ __forceinline__ void a_ready(const Unit&) const {}
    __device__ __forceinline__ void done(const Unit&) const {}
};

__device__ __forceinline__ unsigned cvt_pk_bf16(float lo, float hi) { unsigned r; asm volatile("v_cvt_pk_bf16_f32 %0, %1, %2" : "=v"(r) : "v"(lo), "v"(hi)); return r; }

struct EpiBf16Plain {
    static constexpr bool PERM = true, AFTER_DRAIN = false;
    bf16_t* O; int ldc;
    __device__ __forceinline__ void operator()(const f32x4 (&acc)[2][2][4][2], const Unit& u, int wr, int wc, int fr, int fq) const {
        const int row0 = u.pm * BM + wr * 64 + fr, col0 = u.pn * BM + wc * 32 + 8 * fq;
#pragma unroll
        for (int ai = 0; ai < 2; ++ai)
#pragma unroll
            for (int m = 0; m < 4; ++m) { bf16_t* rowp = O + (size_t)(row0 + ai * HALF + m * 16) * ldc + col0;
#pragma unroll
                for (int bj = 0; bj < 2; ++bj) { const f32x4 v0 = acc[ai][bj][m][0], v1 = acc[ai][bj][m][1];
                    u32x4 w; w.x = cvt_pk_bf16(v0[0], v0[1]); w.y = cvt_pk_bf16(v0[2], v0[3]); w.z = cvt_pk_bf16(v1[0], v1[1]); w.w = cvt_pk_bf16(v1[2], v1[3]);
                    *(u32x4*)(rowp + bj * HALF) = w; } }
    }
};
struct EpiResF32 {
    static constexpr bool PERM = false, AFTER_DRAIN = false;
    const float* base; float* out; int ldc;
    __device__ __forceinline__ void operator()(const f32x4 (&acc)[2][2][4][2], const Unit& u, int wr, int wc, int fr, int fq) const {
        const int row0 = u.pm * BM + wr * 64 + fr, col0 = u.pn * BM + wc * 32 + 4 * fq;
#pragma unroll
        for (int ai = 0; ai < 2; ++ai)
#pragma unroll
            for (int m = 0; m < 4; ++m) { const size_t off = (size_t)(row0 + ai * HALF + m * 16) * ldc + col0;
#pragma unroll
                for (int bj = 0; bj < 2; ++bj)
#pragma unroll
                    for (int n = 0; n < 2; ++n) { const f32x4 b = *(const f32x4*)(base + off + bj * HALF + n * 16); *(f32x4*)(out + off + bj * HALF + n * 16) = b + acc[ai][bj][m][n]; } }
    }
};
struct EpiSwiglu {
    static constexpr bool PERM = true, AFTER_DRAIN = false;
    bf16_t* O; const float* bgu;
    __device__ __forceinline__ void operator()(const f32x4 (&acc)[2][2][4][2], const Unit& u, int wr, int wc, int fr, int fq) const {
        const int e = u.pn >> 3, pnl = u.pn & 7;
        const int row0 = u.pm * BM + wr * 64 + fr, gcol = pnl * 128 + wc * 32 + 8 * fq;
        const float* bg = bgu + (size_t)e * 2048 + gcol;
        f32x4 bgv[2], buv[2];
#pragma unroll
        for (int n = 0; n < 2; ++n) { bgv[n] = *(const f32x4*)(bg + 4 * n); buv[n] = *(const f32x4*)(bg + 1024 + 4 * n); }
#pragma unroll
        for (int ai = 0; ai < 2; ++ai)
#pragma unroll
            for (int m = 0; m < 4; ++m) { bf16_t* rowp = O + (size_t)(row0 + ai * HALF + m * 16) * 1024 + gcol;
                float r[8];
#pragma unroll
                for (int n = 0; n < 2; ++n) { const f32x4 gv = acc[ai][0][m][n] + bgv[n], uv = acc[ai][1][m][n] + buv[n];
#pragma unroll
                    for (int j = 0; j < 4; ++j) { const float g = fminf(gv[j], 7.0f), up = fminf(fmaxf(uv[j], -7.0f), 7.0f);
                        const float sg = __builtin_amdgcn_rcpf(1.0f + __expf(-1.702f * g)); r[n * 4 + j] = (up + 1.0f) * g * sg; } }
                u32x4 w; w.x = cvt_pk_bf16(r[0], r[1]); w.y = cvt_pk_bf16(r[2], r[3]); w.z = cvt_pk_bf16(r[4], r[5]); w.w = cvt_pk_bf16(r[6], r[7]);
                *(u32x4*)rowp = w; }
    }
};
struct EpiDown {
    static constexpr bool PERM = true, AFTER_DRAIN = false;
    bf16_t* O; const float* bd;
    __device__ __forceinline__ void operator()(const f32x4 (&acc)[2][2][4][2], const Unit& u, int wr, int wc, int fr, int fq) const {
        const int e = u.pn >> 2, pnl = u.pn & 3;
        const int row0 = u.pm * BM + wr * 64 + fr, col0 = pnl * BM + wc * 32 + 8 * fq;
        const float* bp = bd + (size_t)e * 1024 + col0;
        f32x4 bv[2][2];
#pragma unroll
        for (int bj = 0; bj < 2; ++bj)
#pragma unroll
            for (int n = 0; n < 2; ++n) bv[bj][n] = *(const f32x4*)(bp + bj * HALF + 4 * n);
#pragma unroll
        for (int ai = 0; ai < 2; ++ai)
#pragma unroll
            for (int m = 0; m < 4; ++m) { bf16_t* rowp = O + (size_t)(row0 + ai * HALF + m * 16) * 1024 + col0;
#pragma unroll
                for (int bj = 0; bj < 2; ++bj) { const f32x4 v0 = acc[ai][bj][m][0] + bv[bj][0], v1 = acc[ai][bj][m][1] + bv[bj][1];
                    u32x4 w; w.x = cvt_pk_bf16(v0[0], v0[1]); w.y = cvt_pk_bf16(v0[2], v0[3]); w.z = cvt_pk_bf16(v1[0], v1[1]); w.w = cvt_pk_bf16(v1[2], v1[3]);
                    *(u32x4*)(rowp + bj * HALF) = w; } }
    }
};
template <int NPN> struct MoeOrder {
    int ntiles, G, c; const PG8_LAS int* texp;
    __device__ __forceinline__ bool next(int i, Unit& u) const {
        constexpr int MT = 32 / NPN; int mt, pn;
        if (G == 256) { const int chunk = i * 8 + (c & 7), r = c >> 3; pn = r / MT; mt = chunk * MT + (r % MT); }
        else { const int L = i * G + c; mt = L / NPN; pn = L % NPN; }
        mt = __builtin_amdgcn_readfirstlane(mt); if (mt >= ntiles) return false;
        const int e = __builtin_amdgcn_readfirstlane(texp[mt]);
        u.pm = mt; u.pn = e * NPN + pn; return true;
    }
    __device__ __forceinline__ void a_ready(const Unit&) const {}
    __device__ __forceinline__ void done(const Unit&) const {}
};

template <class Epi, class Sched, bool ALIGN_EPI = false, bool SP2 = false>
__device__ __forceinline__ void gemm_phase(PG8_LAS unsigned char* lds, const Gemm g, const Sched& S, const Epi& E) {
    int tid_ = threadIdx.x; asm volatile("" : "+v"(tid_));
    const int tid = tid_, wid = __builtin_amdgcn_readfirstlane(tid >> 6), lane = tid & 63, wr = wid >> 2, wc = wid & 3, fr = lane & 15, fq = lane >> 4;
    const int K = g.K, nt = K / BK;
    unsigned voffA[2], voffB[2];
#pragma unroll
    for (int i = 0; i < 2; ++i) { int R, C; stage_rc(tid * 16 + i * 8192, R, C); const int Rb = Epi::PERM ? ((R & ~31) + perm32(R & 31)) : R;
        voffA[i] = (unsigned)(R * K + C) * 2u; voffB[i] = (unsigned)(Rb * K + C) * 2u; }
    const size_t kstep = (size_t)(BK * 2);
    const size_t hstep = (size_t)HALF * K * 2;
    const size_t tstep = 2 * hstep;
    const unsigned ldsw = (unsigned)wid * 1024u;
    const int aoff = lds_byte(wr * 64 + fr, fq * 8), boff = lds_byte(wc * 32 + fr, fq * 8);
#define PG8_SA(b, h) (((b) * 2 + (h)) * HTB)
#define PG8_SB(b, h) ((4 + (b) * 2 + (h)) * HTB)
#define PG8_STAGE(bufoff, gbase, voff) do { _Pragma("unroll") for (int _i = 0; _i < 2; ++_i) \
        __builtin_amdgcn_global_load_lds((const unsigned*)((const char*)(gbase) + (voff)[_i]), (PG8_LAS unsigned*)(lds + (bufoff) + ldsw + _i * 8192), 16, 0, 0); } while (0)
#define PG8_LDA(dst, b, h) do { _Pragma("unroll") for (int m = 0; m < 4; ++m) _Pragma("unroll") for (int k = 0; k < 2; ++k) dst[m][k] = *(const PG8_LAS bf16x8*)(lds + PG8_SA(b, h) + aoff + m * 2048 + k * 1024); } while (0)
#define PG8_LDB(dst, b, h) do { _Pragma("unroll") for (int n = 0; n < 2; ++n) _Pragma("unroll") for (int k = 0; k < 2; ++k) dst[n][k] = *(const PG8_LAS bf16x8*)(lds + PG8_SB(b, h) + boff + n * 2048 + k * 1024); } while (0)
#define PG8_MMA(ai, bj, At, Bt) do { __builtin_amdgcn_s_setprio(1); _Pragma("unroll") for (int m = 0; m < 4; ++m) _Pragma("unroll") for (int n = 0; n < 2; ++n) _Pragma("unroll") for (int k = 0; k < 2; ++k) \
        acc[ai][bj][m][n] = __builtin_amdgcn_mfma_f32_16x16x32_bf16(Bt[n][k], At[m][k], acc[ai][bj][m][n], 0, 0, 0); __builtin_amdgcn_s_setprio(0); } while (0)
#define PG8_WAIT_V(n) asm volatile("s_waitcnt vmcnt(" #n ")" ::: "memory")
#define PG8_WAIT_L(n) asm volatile("s_waitcnt lgkmcnt(" #n ")" ::: "memory")
#define PG8_BAR __builtin_amdgcn_s_barrier()
#define PG8_SCHED __builtin_amdgcn_sched_barrier(0)
    Unit cur, nxt; int ui = 0;
    if (!S.next(0, cur)) return;
    f32x4 acc[2][2][4][2];
#pragma unroll
    for (int a = 0; a < 2; ++a)
#pragma unroll
        for (int b = 0; b < 2; ++b)
#pragma unroll
            for (int m = 0; m < 4; ++m)
#pragma unroll
                for (int n = 0; n < 2; ++n) acc[a][b][m][n] = (f32x4){0.f, 0.f, 0.f, 0.f};
    bf16x8 At[4][2], B0[2][2], B1[2][2];
    const char* cA = (const char*)g.A + (size_t)cur.pm * tstep; const char* cB = (const char*)g.Bt + (size_t)cur.pn * tstep;
    S.a_ready(cur);
    if constexpr (SP2) {
        PG8_STAGE(PG8_SB(0, 0), cB, voffB); PG8_STAGE(PG8_SB(0, 1), cB + hstep, voffB); PG8_STAGE(PG8_SA(0, 0), cA, voffA); PG8_STAGE(PG8_SA(0, 1), cA + hstep, voffA);
        if (wr == 1) PG8_BAR;
        PG8_WAIT_V(2); PG8_BAR;
        PG8_STAGE(PG8_SB(1, 0), cB + kstep, voffB); PG8_STAGE(PG8_SA(1, 0), cA + kstep, voffA); PG8_STAGE(PG8_SB(1, 1), cB + hstep + kstep, voffB);
        PG8_WAIT_V(6); PG8_BAR;
    } else {
        PG8_STAGE(PG8_SB(0, 0), cB, voffB); PG8_STAGE(PG8_SA(0, 0), cA, voffA); PG8_STAGE(PG8_SB(0, 1), cB + hstep, voffB); PG8_STAGE(PG8_SA(0, 1), cA + hstep, voffA);
        if (wr == 1) PG8_BAR;
        PG8_WAIT_V(4); PG8_BAR;
        PG8_STAGE(PG8_SB(1, 0), cB + kstep, voffB); PG8_STAGE(PG8_SA(1, 0), cA + kstep, voffA); PG8_STAGE(PG8_SB(1, 1), cB + hstep + kstep, voffB);
        PG8_WAIT_V(6); PG8_BAR;
    }
    for (;;) {
        const bool has_next = S.next(ui + 1, nxt);
        const char* nA = has_next ? (const char*)g.A + (size_t)nxt.pm * tstep : cA; const char* nB = has_next ? (const char*)g.Bt + (size_t)nxt.pn * tstep : cB;
        for (int t = 0; t < nt; t += 2) {
            const bool last = (t == nt - 2);
            const char* a1 = cA + (size_t)(t + 1) * kstep;
            const char* a2 = last ? nA : cA + (size_t)(t + 2) * kstep; const char* b2 = last ? nB : cB + (size_t)(t + 2) * kstep;
            const char* a3 = a2 + kstep; const char* b3 = b2 + kstep;
            if (last && has_next) S.a_ready(nxt);
            if constexpr (SP2) {
            PG8_LDB(B0, 0, 0); PG8_LDB(B1, 0, 1); PG8_SCHED; PG8_LDA(At, 0, 0); PG8_STAGE(PG8_SA(1, 1), a1 + hstep, voffA);
            PG8_WAIT_V(8); PG8_WAIT_L(0); PG8_BAR; PG8_MMA(0, 0, At, B0); PG8_MMA(0, 1, At, B1); PG8_BAR; PG8_SCHED;
            PG8_LDA(At, 0, 1); PG8_STAGE(PG8_SB(0, 0), b2, voffB); PG8_STAGE(PG8_SB(0, 1), b2 + hstep, voffB); PG8_STAGE(PG8_SA(0, 0), a2, voffA);
            PG8_WAIT_V(8); PG8_WAIT_L(0); PG8_BAR; PG8_MMA(1, 0, At, B0); PG8_MMA(1, 1, At, B1); PG8_BAR; PG8_SCHED;
            PG8_LDB(B0, 1, 0); PG8_LDB(B1, 1, 1); PG8_SCHED; PG8_LDA(At, 1, 0); PG8_STAGE(PG8_SA(0, 1), a2 + hstep, voffA);
            PG8_WAIT_V(8); PG8_WAIT_L(0); PG8_BAR; PG8_MMA(0, 0, At, B0); PG8_MMA(0, 1, At, B1); PG8_BAR; PG8_SCHED;
            PG8_LDA(At, 1, 1); PG8_STAGE(PG8_SB(1, 0), b3, voffB); PG8_STAGE(PG8_SB(1, 1), b3 + hstep, voffB); PG8_STAGE(PG8_SA(1, 0), a3, voffA);
            PG8_WAIT_V(8); PG8_WAIT_L(0); PG8_BAR; PG8_MMA(1, 0, At, B0); PG8_MMA(1, 1, At, B1); PG8_BAR; PG8_SCHED;
            } else {
            PG8_LDB(B0, 0, 0); PG8_SCHED; PG8_LDA(At, 0, 0); PG8_STAGE(PG8_SA(1, 1), a1 + hstep, voffA);
            PG8_WAIT_L(8); PG8_BAR; PG8_WAIT_L(0); PG8_MMA(0, 0, At, B0); PG8_BAR; PG8_SCHED;
            PG8_LDB(B1, 0, 1); PG8_STAGE(PG8_SB(0, 0), b2, voffB);
            PG8_BAR; PG8_WAIT_L(0); PG8_MMA(0, 1, At, B1); PG8_BAR;
            PG8_LDA(At, 0, 1); PG8_STAGE(PG8_SA(0, 0), a2, voffA);
            PG8_BAR; PG8_WAIT_L(0); PG8_MMA(1, 0, At, B0); PG8_BAR; PG8_SCHED;
            PG8_STAGE(PG8_SB(0, 1), b2 + hstep, voffB);
            PG8_WAIT_V(6); PG8_BAR; PG8_MMA(1, 1, At, B1); PG8_BAR;
            PG8_LDB(B0, 1, 0); PG8_SCHED; PG8_LDA(At, 1, 0); PG8_STAGE(PG8_SA(0, 1), a2 + hstep, voffA);
            PG8_WAIT_L(8); PG8_BAR; PG8_WAIT_L(0); PG8_MMA(0, 0, At, B0); PG8_BAR; PG8_SCHED;
            PG8_LDB(B1, 1, 1); PG8_STAGE(PG8_SB(1, 0), b3, voffB);
            PG8_BAR; PG8_WAIT_L(0); PG8_MMA(0, 1, At, B1); PG8_BAR;
            PG8_LDA(At, 1, 1); PG8_STAGE(PG8_SA(1, 0), a3, voffA);
            PG8_BAR; PG8_WAIT_L(0); PG8_MMA(1, 0, At, B0); PG8_BAR; PG8_SCHED;
            PG8_STAGE(PG8_SB(1, 1), b3 + hstep, voffB);
            PG8_WAIT_V(6); PG8_BAR; PG8_MMA(1, 1, At, B1); PG8_BAR;
            }
        }
        if constexpr (ALIGN_EPI) { if (wr == 0) PG8_BAR; }
        if constexpr (!Epi::AFTER_DRAIN) { E(acc, cur, wr, wc, fr, fq); S.done(cur); }
        if (!has_next) break;
#pragma unroll
        for (int a = 0; a < 2; ++a)
#pragma unroll
            for (int b = 0; b < 2; ++b)
#pragma unroll
                for (int m = 0; m < 4; ++m)
#pragma unroll
                    for (int n = 0; n < 2; ++n) acc[a][b][m][n] = (f32x4){0.f, 0.f, 0.f, 0.f};
        cur = nxt; cA = nA; cB = nB; ++ui;
        if constexpr (ALIGN_EPI) { if (wr == 1) PG8_BAR; }
    }
    PG8_WAIT_V(0);
    if constexpr (!ALIGN_EPI) { if (wr == 0) PG8_BAR; }
    PG8_BAR;
    if constexpr (Epi::AFTER_DRAIN) { E.fused(acc, cur, wr, wc, fr, fq, lds, wid, lane); S.done(cur); }
#undef PG8_SA
#undef PG8_SB
#undef PG8_STAGE
#undef PG8_LDA
#undef PG8_LDB
#undef PG8_MMA
#undef PG8_WAIT_V
#undef PG8_WAIT_L
#undef PG8_BAR
#undef PG8_SCHED
}
}


#define GAS __attribute__((address_space(1)))
typedef unsigned short bf16;
typedef float f32x4 __attribute__((ext_vector_type(4)));
typedef unsigned u32x4 __attribute__((ext_vector_type(4)));
typedef unsigned u32x2 __attribute__((ext_vector_type(2)));
typedef short bf16x8 __attribute__((ext_vector_type(8)));
typedef float f32x16 __attribute__((ext_vector_type(16)));

#ifndef SINGLE_LAUNCH
#define SINGLE_LAUNCH 1
#endif

constexpr int NB = 8, SEQ = 2048, DM = 1024, NT = NB * SEQ, NLAYER = 2;
constexpr int DIN = 3220, NP = 3328;
constexpr int C_Q = 0, C_K = 512, C_V = 1024, C_Z = 1536, C_NQ = 2048, C_KV = 2304, C_CU = 2688, C_A = 3200, C_B = 3204, C_G = 3208;
constexpr int NE = 32, MAXT = 288;
constexpr int NWAVES = 8, NTHR = 512;
constexpr float EPS = 1e-6f;

constexpr size_t MiB = 1u << 20;
constexpr size_t WS_CTL = 0, CTL_ZERO_BYTES = 1 * MiB;
constexpr size_t WS_BT = 1 * MiB;
constexpr size_t WS_KCMP = 1 * MiB + 256 * 1024, WS_VCMP = 1 * MiB + 512 * 1024;
constexpr size_t WS_G = 2 * MiB, WS_BETA = 2 * MiB + 256 * 1024, WS_GC = 2 * MiB + 512 * 1024;
constexpr size_t WS_EIDX = 3 * MiB, WS_EPOS = 3 * MiB + 256 * 1024, WS_EW = 3 * MiB + 512 * 1024, WS_SLOT = 3 * MiB + 768 * 1024;
constexpr size_t WS_WIN = 4 * MiB;
constexpr size_t WS_WOUT = 17 * MiB;
constexpr size_t WS_WGU = 22 * MiB;
constexpr size_t WS_WD = 278 * MiB;
constexpr size_t WS_XA = 406 * MiB, WS_XB = 470 * MiB;
constexpr size_t WS_XN = 534 * MiB;
constexpr size_t WS_P = 566 * MiB;
constexpr size_t WS_QN = 670 * MiB, WS_KN = 686 * MiB, WS_VC = 702 * MiB;
constexpr size_t WS_U = 718 * MiB, WS_W = 750 * MiB;
constexpr size_t WS_ATT = 782 * MiB;
constexpr size_t WS_O = 798 * MiB;
constexpr size_t WS_NQ = 830 * MiB;
constexpr size_t WS_KS = 846 * MiB, WS_KW = 848 * MiB;
constexpr size_t WS_Y = 850 * MiB;
constexpr size_t WS_XS = 882 * MiB, WS_ACT = 1026 * MiB, WS_YS = 1170 * MiB;
constexpr size_t WS_KT = 1314 * MiB, WS_VT = 1330 * MiB;
constexpr size_t WS_W1T = 1346 * MiB;
constexpr size_t WS_POSW = 1349 * MiB;
constexpr size_t WS_RWH = 1350 * MiB, WS_RWL = 1351 * MiB;
constexpr size_t WS_END = 1352 * MiB;

constexpr int CW_TMO = 0, CW_BAR = 4096, CW_CNT = 16384;

constexpr int RING_BYTES = 131072;
constexpr int LDSCTL_OFF = RING_BYTES, MISC_OFF = LDSCTL_OFF, TS_OFF = LDSCTL_OFF + 128, TE_OFF = LDSCTL_OFF + 320;
constexpr int LDS_BYTES = 147456;
static_assert(TE_OFF + MAXT * 4 + 64 <= LDS_BYTES, "LDS map");

#define XB_TMO      128
#define XB_XCNT(j)  (256  + 64 * (j))
#define XB_XSUB(j)  (1280 + 64 * (j))
#define XB_XGEN(j)  (2304 + 64 * (j))
#define XB_TOP      3328
#define XB_TOPGEN   3392
#define XCD_BAR_WORDS 3456
#define XB_SPIN_CAP (1u << 22)
#define LAS __attribute__((address_space(3)))

__device__ __forceinline__ unsigned xb_ld(unsigned* p)              { return __hip_atomic_load(p, __ATOMIC_RELAXED, __HIP_MEMORY_SCOPE_AGENT); }
__device__ __forceinline__ unsigned xb_add(unsigned* p, unsigned v) { return __hip_atomic_fetch_add(p, v, __ATOMIC_RELAXED, __HIP_MEMORY_SCOPE_AGENT); }
__device__ __forceinline__ unsigned xb_xcc_id() { return (unsigned)__builtin_amdgcn_s_getreg((3 << 11) | 20) & 0xFu; }
#define XB_SPIN(cond, bar) do { unsigned _sp = 0; while (cond) { __builtin_amdgcn_s_sleep(1); \
    if ((++_sp & 255u) == 0u) { if (xb_ld(&(bar)[XB_TMO])) break; if (_sp > XB_SPIN_CAP) { atomicAdd(&(bar)[XB_TMO], 1u); break; } } } } while (0)

struct XcdBarrier {
    unsigned* bar; unsigned x;
    volatile LAS unsigned* st;
};

__device__ __forceinline__ XcdBarrier xcd_barrier_post(unsigned* bar, volatile LAS unsigned* st) {
    XcdBarrier b; b.bar = bar; b.x = xb_xcc_id(); b.st = st;
    if (threadIdx.x == 0) (void)xb_add(&bar[XB_XCNT(b.x)], 1u);
    return b;
}
__device__ __forceinline__ void xcd_barrier_complete(unsigned* bar, unsigned x, unsigned& nloc, unsigned& nx) {
    const unsigned G = gridDim.x * gridDim.y * gridDim.z;
    unsigned sum, cnt, mine, sp = 0u;
    for (;;) {
        sum = 0u; cnt = 0u; mine = 0u;
#pragma unroll
        for (unsigned j = 0; j < 16; ++j) { const unsigned c = xb_ld(&bar[XB_XCNT(j)]); sum += c; cnt += (c > 0u) ? 1u : 0u; mine = (j == x) ? c : mine; }
        if (sum == G) break;
        __builtin_amdgcn_s_sleep(1);
        if ((++sp & 255u) == 0u) { if (xb_ld(&bar[XB_TMO])) break; if (sp > XB_SPIN_CAP) { atomicAdd(&bar[XB_TMO], 1u); break; } }
    }
    nloc = mine > 0u ? mine : 1u; nx = cnt > 0u ? cnt : 1u;
}

__device__ __forceinline__ void xcd_barrier(const XcdBarrier& b) {
    asm volatile("s_waitcnt vmcnt(0)" ::: "memory");
    __syncthreads();
    if (threadIdx.x == 0) {
        unsigned* bar = b.bar;
        __builtin_amdgcn_s_waitcnt(0);
        unsigned nloc = b.st[0], nx = b.st[1];
        if (nloc == 0u) { xcd_barrier_complete(bar, b.x, nloc, nx); b.st[0] = nloc; b.st[1] = nx; }
        const unsigned old = xb_add(&bar[XB_XSUB(b.x)], 1u);
        const unsigned gen = old / nloc;
        if (old + 1u == (gen + 1u) * nloc) {
            __builtin_amdgcn_fence(__ATOMIC_RELEASE, "agent");
            asm volatile("s_waitcnt vmcnt(0)" ::: "memory");
            const unsigned og = xb_add(&bar[XB_TOP], 1u);
            const unsigned tg = og / nx;
            if (og + 1u == (tg + 1u) * nx) xb_add(&bar[XB_TOPGEN], 1u);
            else XB_SPIN(xb_ld(&bar[XB_TOPGEN]) == tg, bar);
            __builtin_amdgcn_fence(__ATOMIC_ACQUIRE, "agent");
            xb_add(&bar[XB_XGEN(b.x)], 1u);
            asm volatile("s_waitcnt vmcnt(0)" ::: "memory");
        } else {
            XB_SPIN(xb_ld(&bar[XB_XGEN(b.x)]) == gen, bar);
            __builtin_amdgcn_fence(__ATOMIC_ACQUIRE, "agent");
            asm volatile("s_waitcnt vmcnt(0)" ::: "memory");
        }
    }
    __syncthreads();
}


__device__ __forceinline__ void cnt_barrier(unsigned* cw, unsigned& k) {
    asm volatile("s_waitcnt vmcnt(0)" ::: "memory");
    __syncthreads();
    if (threadIdx.x == 0) {
        __builtin_amdgcn_fence(__ATOMIC_RELEASE, "agent");
        asm volatile("s_waitcnt vmcnt(0)" ::: "memory");
        const unsigned G = gridDim.x;
        const unsigned old = xb_add(cw, 1u);
        if (old == G * (k + 1u) - 1u) xb_add(cw + 64, 1u);
        else { unsigned sp = 0; while (xb_ld(cw + 64) == k) { __builtin_amdgcn_s_sleep(1);
                if ((++sp & 255u) == 0u) { if (xb_ld(cw + 128)) break; if (sp > XB_SPIN_CAP) { atomicAdd(cw + 128, 1u); break; } } } }
        __builtin_amdgcn_fence(__ATOMIC_ACQUIRE, "agent");
        asm volatile("s_waitcnt vmcnt(0)" ::: "memory");
    }
    ++k;
    __syncthreads();
}
__device__ __forceinline__ float bf_lo(unsigned w) { return __uint_as_float(w << 16); }
__device__ __forceinline__ float bf_hi(unsigned w) { return __uint_as_float(w & 0xffff0000u); }
__device__ __forceinline__ float bf2f(bf16 v) { return __uint_as_float(((unsigned)v) << 16); }
__device__ __forceinline__ unsigned f2bf(float f) { unsigned u = __float_as_uint(f); return (u + 0x7fffu + ((u >> 16) & 1u)) >> 16; }
__device__ __forceinline__ unsigned pk2(float lo, float hi) { return f2bf(lo) | (f2bf(hi) << 16); }
__device__ __forceinline__ float wave_sum(float v) {
#pragma unroll
    for (int o = 1; o < 64; o <<= 1) v += __shfl_xor(v, o);
    return v;
}
__device__ __forceinline__ float wave_max(float v) {
#pragma unroll
    for (int o = 1; o < 64; o <<= 1) v = fmaxf(v, __shfl_xor(v, o));
    return v;
}
__device__ __forceinline__ float sigmoidf_(float x) { return 1.0f / (1.0f + __expf(-x)); }
__device__ __forceinline__ float siluf_(float x) { return x / (1.0f + __expf(-x)); }
#define LDS_WAIT() asm volatile("s_waitcnt lgkmcnt(0)" ::: "memory")

struct Args { const float* in[25]; float* out; unsigned char* ws; int ph_lo, ph_hi; };

__device__ __forceinline__ int map_win(int n);
__device__ __forceinline__ int map_gu(int n);
template <int MAP>
__device__ __forceinline__ void transpose_item(const float* W, int K, int N, bf16* WT, LAS float* scr, int item, int nblk, int lane) {
    const int kb = item / nblk, nb = item % nblk, k0 = 64 * kb, n0 = 32 * nb;
    const int nd = n0 + (lane & 31); const int src = MAP == 1 ? map_win(nd) : (MAP == 2 ? map_gu(nd) : nd);
#pragma unroll 8
    for (int i = 0; i < 32; ++i) { const int kk = 2 * i + (lane >> 5); scr[kk * 33 + (lane & 31)] = src >= 0 ? W[(size_t)(k0 + kk) * N + src] : 0.0f; }
    LDS_WAIT();
    const int c = lane & 7;
#pragma unroll
    for (int j = 0; j < 4; ++j) { const int n = (lane >> 3) + 8 * j; const LAS float* s = scr + (8 * c) * 33 + n;
        u32x4 o; o.x = pk2(s[0 * 33], s[1 * 33]); o.y = pk2(s[2 * 33], s[3 * 33]); o.z = pk2(s[4 * 33], s[5 * 33]); o.w = pk2(s[6 * 33], s[7 * 33]);
        *(u32x4*)(WT + (size_t)(n0 + n) * K + k0 + 8 * c) = o; }
    LDS_WAIT();
}
__device__ __forceinline__ int map_win(int n) {
    if (n < 2048) return n;
    if (n < C_KV) return 2056 + (n - C_NQ);
    if (n < C_CU) return 2312 + (n - C_KV);
    if (n < C_A) return 2708 + (n - C_CU);
    if (n < C_B) return 2048 + (n - C_A);
    if (n < C_G) return 2052 + (n - C_B);
    if (n < C_G + 12) return 2696 + (n - C_G);
    return -1;
}
__device__ __forceinline__ int map_gu(int n) { const int pn = n >> 8, r = n & 255; return (r < 128 ? 0 : 1024) + 128 * pn + (r & 127); }

__device__ __forceinline__ void ph_prologue(const Args& a, LAS unsigned char* lds, int gw, int NGW, int wave, int lane) {
    LAS float* scr = (LAS float*)(lds + wave * 16384);
    bf16* WinT = (bf16*)(a.ws + WS_WIN); bf16* WoutT = (bf16*)(a.ws + WS_WOUT); bf16* WguT = (bf16*)(a.ws + WS_WGU); bf16* WdT = (bf16*)(a.ws + WS_WD);
    constexpr int I_IN = 16 * (NP / 32), I_OUT = 16 * 32, I_GU = 16 * 64, I_D = 16 * 32;
    constexpr int N_IN = NLAYER * I_IN, N_OUT = NLAYER * I_OUT, N_GU = NLAYER * NE * I_GU, N_D = NLAYER * NE * I_D;
    for (int it = gw; it < N_IN + N_OUT + N_GU + N_D; it += NGW) {
        int r = it;
        if (r < N_IN) { const int l = r / I_IN; transpose_item<1>(a.in[2] + (size_t)l * DM * DIN, DM, DIN, WinT + (size_t)l * NP * DM, scr, r % I_IN, NP / 32, lane); continue; } r -= N_IN;
        if (r < N_OUT) { const int l = r / I_OUT; transpose_item<0>(a.in[16] + (size_t)l * DM * DM, DM, DM, WoutT + (size_t)l * DM * DM, scr, r % I_OUT, 32, lane); continue; } r -= N_OUT;
        if (r < N_GU) { const int le = r / I_GU; transpose_item<2>(a.in[20] + (size_t)le * DM * 2048, DM, 2048, WguT + (size_t)le * 2048 * DM, scr, r % I_GU, 64, lane); continue; } r -= N_GU;
        { const int le = r / I_D; transpose_item<0>(a.in[22] + (size_t)le * DM * DM, DM, DM, WdT + (size_t)le * DM * DM, scr, r % I_D, 32, lane); }
    }
    { bf16* W1T = (bf16*)(a.ws + WS_W1T);
        for (int it = gw; it < 4 * 128; it += NGW) { const int mtx = it >> 7; transpose_item<0>(a.in[10] + (size_t)mtx * 2048 * 128, 2048, 128, W1T + (size_t)mtx * 128 * 2048, scr, it & 127, 4, lane); }
        float* POSW = (float*)(a.ws + WS_POSW);
        const int id = gw * 64 + lane;
        if (id < 512) { const int mtx = id >> 7, n = id & 127; const float* w1 = a.in[10] + (size_t)mtx * 2048 * 128; const float* pos = a.in[9] + (size_t)mtx * 2048; float acc = 0.f;
            for (int k = 0; k < 2048; ++k) acc += pos[k] * w1[(size_t)k * 128 + n];
            POSW[id] = acc; } }
    { bf16* RWH = (bf16*)(a.ws + WS_RWH); bf16* RWL = (bf16*)(a.ws + WS_RWL);
        for (int i = gw * 64 + lane; i < NLAYER * NE * DM; i += NGW * 64) { const int d = i & (DM - 1), e = (i >> 10) & (NE - 1), l = i >> 15;
            const float w = a.in[18][((size_t)l * DM + d) * NE + e]; const unsigned hi = f2bf(w); const float lo = w - __uint_as_float(hi << 16);
            RWH[i] = (bf16)hi; RWL[i] = (bf16)f2bf(lo); } }
    float* BT = (float*)(a.ws + WS_BT);
    for (int i = gw * 64 + lane; i < 4 * 2048; i += NGW * 64) {
        const int h = i >> 11, n = i & 2047; int bk;
        if (n < 16) bk = n; else { const float v = logf((float)n / 16.0f) / 2.0794415416798357f * 16.0f; bk = 16 + (int)v; bk = bk < 31 ? bk : 31; }
        BT[i] = a.in[24][bk * 4 + h];
    }
}

__device__ __forceinline__ void rms_row_to_bf16(const f32x4 (&v)[4], const float* w, bf16* orow, int lane) {
    float s = 0.f;
#pragma unroll
    for (int j = 0; j < 4; ++j) s += (v[j].x * v[j].x + v[j].y * v[j].y) + (v[j].z * v[j].z + v[j].w * v[j].w);
    const float r = rsqrtf(wave_sum(s) * (1.0f / DM) + EPS);
#pragma unroll
    for (int j = 0; j < 4; ++j) { const f32x4 wv = *(const f32x4*)(w + 4 * (64 * j + lane)); const f32x4 y = v[j] * r * wv;
        u32x2 o; o.x = pk2(y.x, y.y); o.y = pk2(y.z, y.w); *(u32x2*)(orow + 4 * (64 * j + lane)) = o; }
}

__device__ __forceinline__ void ph_norm0(const Args& a, int gw, int NGW, int lane) {
    bf16* XN = (bf16*)(a.ws + WS_XN);
    for (int tok = gw; tok < NT; tok += NGW) {
        f32x4 v[4];
#pragma unroll
        for (int j = 0; j < 4; ++j) v[j] = *(const f32x4*)(a.in[0] + (size_t)tok * DM + 4 * (64 * j + lane));
        rms_row_to_bf16(v, a.in[1], XN + (size_t)tok * DM, lane);
    }
}

__device__ __forceinline__ void ph_compress_mfma(const Args& a, int l, LAS unsigned char* lds, int bid, int G, int tid, int wave, int lane) {
    LAS float* hid = (LAS float*)lds;
    const bf16* P = (const bf16*)(a.ws + WS_P); bf16* KCMP = (bf16*)(a.ws + WS_KCMP); bf16* VCMP = (bf16*)(a.ws + WS_VCMP);
    const int r = lane & 15, q = lane >> 4;
    for (int u = bid; u < 128; u += G) {
        const int b = u >> 4, kv = (u >> 3) & 1, j0 = 16 * (u & 7);
        const bf16* arow = P + (size_t)(b * SEQ) * NP + C_KV + kv * 64;
        const bf16* brow = (const bf16*)(a.ws + WS_W1T) + ((size_t)(l * 2 + kv) * 128 + 16 * wave + r) * 2048 + 8 * q;
        const float pw = ((const float*)(a.ws + WS_POSW))[(l * 2 + kv) * 128 + 16 * wave + r];
        f32x4 acc = {0.f, 0.f, 0.f, 0.f};
#pragma unroll 8
        for (int ks = 0; ks < 64; ++ks) { int tk = 16 * (j0 + r) + (ks >> 1); tk = tk < SEQ ? tk : SEQ - 1;
            const bf16x8 af = *(const bf16x8*)(arow + (size_t)tk * NP + (ks & 1) * 32 + 8 * q); const bf16x8 bfr = *(const bf16x8*)(brow + 32 * ks);
            acc = __builtin_amdgcn_mfma_f32_16x16x32_bf16(af, bfr, acc, 0, 0, 0); }
#pragma unroll
        for (int i = 0; i < 4; ++i) hid[(4 * q + i) * 132 + 16 * wave + r] = siluf_(acc[i] + pw);
        __syncthreads();
        { const int row = tid >> 5, c2 = tid & 31; const float* w2 = a.in[11] + (size_t)(l * 2 + kv) * 128 * 64; float o0 = 0.f, o1 = 0.f;
            for (int nn = 0; nn < 128; ++nn) { const float hv = hid[row * 132 + nn]; o0 += hv * w2[nn * 64 + 2 * c2]; o1 += hv * w2[nn * 64 + 2 * c2 + 1]; }
            if (kv == 0) { float ss = o0 * o0 + o1 * o1;
#pragma unroll
                for (int o_ = 1; o_ < 32; o_ <<= 1) ss += __shfl_xor(ss, o_);
                const float sc = rsqrtf(ss * (1.0f / 64.0f) + EPS); o0 *= sc * a.in[8][l * 192 + 2 * c2]; o1 *= sc * a.in[8][l * 192 + 2 * c2 + 1]; }
            const int j = j0 + row;
            *(unsigned*)((kv ? VCMP : KCMP) + (size_t)(b * 128 + j) * 64 + 2 * c2) = (j < 127) ? pk2(o0, o1) : 0u; }
        __syncthreads();
    }
}

__device__ __forceinline__ void ph_m1(const Args& a, int l, LAS unsigned char* lds, int bid, int G, int tid, int wave, int lane) {
    const bf16* P = (const bf16*)(a.ws + WS_P);
    bf16* QN = (bf16*)(a.ws + WS_QN); bf16* KN = (bf16*)(a.ws + WS_KN); bf16* VC = (bf16*)(a.ws + WS_VC);
    bf16* KT = (bf16*)(a.ws + WS_KT); bf16* VT = (bf16*)(a.ws + WS_VT);
    float* Gb = (float*)(a.ws + WS_G); float* BETA = (float*)(a.ws + WS_BETA);
    bf16* NQ = (bf16*)(a.ws + WS_NQ); bf16* KS = (bf16*)(a.ws + WS_KS); bf16* KW = (bf16*)(a.ws + WS_KW); bf16* Y = (bf16*)(a.ws + WS_Y);
    const float* convw = a.in[3] + (size_t)l * 4 * 1536; const float* a_log = a.in[4] + l * 4; const float* dt_bias = a.in[5] + l * 4;
    const float* qnw = a.in[7] + l * 64; const float* knw = a.in[8] + l * 192;
    const float* dww = a.in[12] + (size_t)l * 31 * 256; const float* dwb = a.in[13] + l * 256; const float* lnw = a.in[14] + l * 256; const float* lnb = a.in[15] + l * 256;
    LAS float* dwl = (LAS float*)(lds + 65536);
    for (int i = tid; i < 31 * 256; i += NTHR) dwl[i] = dww[i];
    __syncthreads();
    for (int u = bid; u < NT / 64; u += G) {
        const int b = u >> 5, nchunk = u & 31, tw = nchunk * 64 + 8 * wave;
        const bf16* pw0 = P + (size_t)(b * SEQ + tw) * NP;
#pragma unroll
        for (int ten = 0; ten < 3; ++ten)
#pragma unroll 1
            for (int h = 0; h < 4; ++h) { const int cb = ten * 512 + h * 128 + 2 * lane;
                float w0[4], w1[4];
#pragma unroll
                for (int j = 0; j < 4; ++j) { w0[j] = convw[j * 1536 + cb]; w1[j] = convw[j * 1536 + cb + 1]; }
                float xa[3], xb[3];
#pragma unroll
                for (int j = 0; j < 3; ++j) { unsigned w = 0u; if (tw - 3 + j >= 0) w = *(const unsigned*)(pw0 + (ptrdiff_t)(j - 3) * NP + cb); xa[j] = bf_lo(w); xb[j] = bf_hi(w); }
                unsigned pk[8], xin8[8];
#pragma unroll
                for (int i = 0; i < 8; ++i) xin8[i] = *(const unsigned*)(pw0 + (size_t)i * NP + cb);
                float ya[8], yb[8], sq[8];
#pragma unroll
                for (int i = 0; i < 8; ++i) { const unsigned w = xin8[i]; const float ca = bf_lo(w), cbv = bf_hi(w);
                    ya[i] = siluf_(w0[0] * xa[0] + w0[1] * xa[1] + w0[2] * xa[2] + w0[3] * ca); yb[i] = siluf_(w1[0] * xb[0] + w1[1] * xb[1] + w1[2] * xb[2] + w1[3] * cbv);
                    xa[0] = xa[1]; xa[1] = xa[2]; xa[2] = ca; xb[0] = xb[1]; xb[1] = xb[2]; xb[2] = cbv; sq[i] = ya[i] * ya[i] + yb[i] * yb[i]; }
                if (ten < 2) {
#pragma unroll
                    for (int o_ = 1; o_ < 64; o_ <<= 1) {
#pragma unroll
                        for (int i = 0; i < 8; ++i) sq[i] += __shfl_xor(sq[i], o_); }
#pragma unroll
                    for (int i = 0; i < 8; ++i) { const float sc = rsqrtf(sq[i] + EPS) * (ten == 0 ? 0.08838834764831845f : 1.0f); ya[i] *= sc; yb[i] *= sc; } }
                bf16* dst = ten == 0 ? QN : (ten == 1 ? KN : VC);
#pragma unroll
                for (int i = 0; i < 8; ++i) { pk[i] = pk2(ya[i], yb[i]); *(unsigned*)(dst + (size_t)(b * SEQ + tw + i) * 512 + h * 128 + 2 * lane) = pk[i]; }
                if (ten >= 1) {
                    bf16* tb = (ten == 1 ? KT : VT) + ((size_t)((b * 4 + h) * 32 + nchunk) * 128 + 2 * lane) * 64 + 8 * wave;
                    u32x4 lo, hi;
                    lo.x = (pk[0] & 0xffffu) | (pk[1] << 16); lo.y = (pk[2] & 0xffffu) | (pk[3] << 16); lo.z = (pk[4] & 0xffffu) | (pk[5] << 16); lo.w = (pk[6] & 0xffffu) | (pk[7] << 16);
                    hi.x = (pk[0] >> 16) | (pk[1] & 0xffff0000u); hi.y = (pk[2] >> 16) | (pk[3] & 0xffff0000u); hi.z = (pk[4] >> 16) | (pk[5] & 0xffff0000u); hi.w = (pk[6] >> 16) | (pk[7] & 0xffff0000u);
                    *(u32x4*)tb = lo; *(u32x4*)(tb + 64) = hi; } }
        if (lane < 32) { const int i = lane >> 2, hd = lane & 3; const size_t tok = (size_t)(b * SEQ + tw + i); const bf16* prow = P + tok * NP;
            const float av = bf2f(prow[C_A + hd]), bv = bf2f(prow[C_B + hd]);
            BETA[tok * 4 + hd] = sigmoidf_(bv);
            const float x = av + dt_bias[hd]; const float sp = x > 20.0f ? x : log1pf(expf(x));
            Gb[tok * 4 + hd] = -expf(a_log[hd]) * sp; }
        { const float qw = qnw[lane] * 0.125f, ksw = knw[64 + lane], kww = knw[128 + lane];
#pragma unroll 2
          for (int i = 0; i < 8; ++i) { const size_t tok = (size_t)(b * SEQ + tw + i); const bf16* prow = P + tok * NP;
            float xv[6];
#pragma unroll
            for (int h = 0; h < 4; ++h) xv[h] = bf2f(prow[C_NQ + h * 64 + lane]);
            xv[4] = bf2f(prow[C_KV + 128 + lane]); xv[5] = bf2f(prow[C_KV + 256 + lane]);
            float ss[6];
#pragma unroll
            for (int h = 0; h < 6; ++h) ss[h] = xv[h] * xv[h];
#pragma unroll
            for (int o_ = 1; o_ < 64; o_ <<= 1) {
#pragma unroll
                for (int h = 0; h < 6; ++h) ss[h] += __shfl_xor(ss[h], o_); }
#pragma unroll
            for (int h = 0; h < 4; ++h) NQ[tok * 256 + h * 64 + lane] = (bf16)f2bf(xv[h] * rsqrtf(ss[h] * (1.0f / 64.0f) + EPS) * qw);
            KS[tok * 64 + lane] = (bf16)f2bf(xv[4] * rsqrtf(ss[4] * (1.0f / 64.0f) + EPS) * ksw);
            KW[tok * 64 + lane] = (bf16)f2bf(xv[5] * rsqrtf(ss[5] * (1.0f / 64.0f) + EPS) * kww); } }
        { const int c = 4 * lane; f32x4 acc[8]; const f32x4 bias = *(const f32x4*)(dwb + c);
#pragma unroll
            for (int i = 0; i < 8; ++i) acc[i] = bias;
            for (int r = 0; r < 38; ++r) { const int tin = tw - 30 + r; if (tin < 0) continue;
                const bf16* pr = pw0 + (ptrdiff_t)(r - 30) * NP + C_CU + c; const u32x2 av = *(const u32x2*)pr, gv = *(const u32x2*)(pr + 256);
                f32x4 gl; gl.x = bf_lo(av.x) * sigmoidf_(bf_lo(gv.x)); gl.y = bf_hi(av.x) * sigmoidf_(bf_hi(gv.x)); gl.z = bf_lo(av.y) * sigmoidf_(bf_lo(gv.y)); gl.w = bf_hi(av.y) * sigmoidf_(bf_hi(gv.y));
#pragma unroll
                for (int i = 0; i < 8; ++i) { const int j = r - i; if (j >= 0 && j <= 30) { const f32x4 w = *(const LAS f32x4*)(dwl + j * 256 + c); acc[i] += w * gl; } } }
            const f32x4 lw = *(const f32x4*)(lnw + c), lb = *(const f32x4*)(lnb + c);
#pragma unroll
            for (int i = 0; i < 8; ++i) { const f32x4 x = acc[i]; const float mean = wave_sum((x.x + x.y) + (x.z + x.w)) * (1.0f / 256.0f);
                const f32x4 d = x - mean; const float var = wave_sum((d.x * d.x + d.y * d.y) + (d.z * d.z + d.w * d.w)) * (1.0f / 256.0f);
                const float rr = rsqrtf(var + EPS); const f32x4 y = d * rr * lw + lb;
                u32x2 o; o.x = pk2(siluf_(y.x), siluf_(y.y)); o.y = pk2(siluf_(y.z), siluf_(y.w));
                *(u32x2*)(Y + (size_t)(b * SEQ + tw + i) * DM + 768 + c) = o; } }
    }
}

__device__ __forceinline__ void ph_dn_chunk(const Args& a, LAS unsigned char* lds, int bid, int G, int tid, int wave, int lane) {
    LAS float* Kf = (LAS float*)lds;
    LAS float* QV = Kf + 64 * 129;
    LAS float* Lm = QV + 64 * 129;
    LAS float* Tm = Lm + 64 * 65;
    LAS float* gcl = Tm + 64 * 65; LAS float* betal = gcl + 64; LAS float* bkl = betal + 64;
    const bf16* QN = (const bf16*)(a.ws + WS_QN); const bf16* KN = (const bf16*)(a.ws + WS_KN); const bf16* VC = (const bf16*)(a.ws + WS_VC);
    const float* Gb = (const float*)(a.ws + WS_G); const float* BETA = (const float*)(a.ws + WS_BETA); float* GC = (float*)(a.ws + WS_GC);
    float* U = (float*)(a.ws + WS_U); float* W = (float*)(a.ws + WS_W); float* ATT = (float*)(a.ws + WS_ATT);
    for (int ci = bid; ci < 1024; ci += G) {
        const int n = ci & 31, h = (ci >> 5) & 3, b = ci >> 7; const int r0 = b * SEQ + n * 64;
        { const int row = tid >> 3, seg = tid & 7; const size_t go = (size_t)(r0 + row) * 512 + h * 128 + seg * 16;
            const u32x4 k0 = *(const u32x4*)(KN + go), k1 = *(const u32x4*)(KN + go + 8), q0 = *(const u32x4*)(QN + go), q1 = *(const u32x4*)(QN + go + 8);
            LAS float* kd = Kf + row * 129 + seg * 16; LAS float* qd = QV + row * 129 + seg * 16;
#pragma unroll
            for (int e = 0; e < 4; ++e) { kd[2 * e] = bf_lo(k0[e]); kd[2 * e + 1] = bf_hi(k0[e]); kd[8 + 2 * e] = bf_lo(k1[e]); kd[8 + 2 * e + 1] = bf_hi(k1[e]);
                qd[2 * e] = bf_lo(q0[e]); qd[2 * e + 1] = bf_hi(q0[e]); qd[8 + 2 * e] = bf_lo(q1[e]); qd[8 + 2 * e + 1] = bf_hi(q1[e]); } }
        if (wave == 0) { float g = Gb[(size_t)(r0 + lane) * 4 + h];
#pragma unroll
            for (int off = 1; off < 64; off <<= 1) { const float v = __shfl_up(g, off); if (lane >= off) g += v; }
            const float be = BETA[(size_t)(r0 + lane) * 4 + h];
            gcl[lane] = g; GC[(size_t)(r0 + lane) * 4 + h] = g; betal[lane] = be; bkl[lane] = be * __expf(g); }
        __syncthreads();
        { const int i = tid >> 3, jg = tid & 7; float kk[8], qk[8];
#pragma unroll
            for (int m = 0; m < 8; ++m) { kk[m] = 0.f; qk[m] = 0.f; }
            for (int c = 0; c < 128; ++c) { const float ak = Kf[i * 129 + c], aq = QV[i * 129 + c];
#pragma unroll
                for (int m = 0; m < 8; ++m) { const float kj = Kf[(jg + 8 * m) * 129 + c]; kk[m] += ak * kj; qk[m] += aq * kj; } }
            const float gi = gcl[i], bi = betal[i];
#pragma unroll
            for (int m = 0; m < 8; ++m) { const int j = jg + 8 * m; const float dec = (j <= i) ? __expf(gi - gcl[j]) : 0.f;
                Lm[i * 65 + j] = (j < i) ? bi * kk[m] * dec : 0.f;
                ATT[(size_t)ci * 4096 + i * 64 + j] = (j <= i) ? qk[m] * dec : 0.f; } }
        __syncthreads();
        if (wave == 0) {
            for (int i = 0; i < 64; ++i) { float acc = (i == lane) ? 1.f : 0.f;
                for (int j = 0; j < i; ++j) acc -= Lm[i * 65 + j] * Tm[j * 65 + lane];
                Tm[i * 65 + lane] = acc; }
        } else {
            for (int e = tid - 64; e < 512; e += 448) { const int row = e >> 3, seg = e & 7; const size_t go = (size_t)(r0 + row) * 512 + h * 128 + seg * 16;
                const u32x4 v0 = *(const u32x4*)(VC + go), v1 = *(const u32x4*)(VC + go + 8); LAS float* vd = QV + row * 129 + seg * 16;
#pragma unroll
                for (int q = 0; q < 4; ++q) { vd[2 * q] = bf_lo(v0[q]); vd[2 * q + 1] = bf_hi(v0[q]); vd[8 + 2 * q] = bf_lo(v1[q]); vd[8 + 2 * q + 1] = bf_hi(v1[q]); } }
        }
        __syncthreads();
        { const int c = tid & 127, part = (tid >> 7) & 1, rg = tid >> 8; float acc[32];
#pragma unroll
            for (int ii = 0; ii < 32; ++ii) acc[ii] = 0.f;
            for (int j = 0; j < 64; ++j) { const float x = part ? Kf[j * 129 + c] * bkl[j] : QV[j * 129 + c] * betal[j];
#pragma unroll
                for (int ii = 0; ii < 32; ++ii) acc[ii] += Tm[(rg * 32 + ii) * 65 + j] * x; }
            float* dst = part ? W : U;
#pragma unroll
            for (int ii = 0; ii < 32; ++ii) dst[(size_t)(r0 + rg * 32 + ii) * 512 + h * 128 + c] = acc[ii]; }
        __syncthreads();
    }
}

constexpr int LM_PITCH = 68;
__device__ __forceinline__ void ph_dn_chunk_mfma(const Args& a, LAS unsigned char* lds, int bid, int G, int tid, int wave, int lane) {
    LAS float* Lm = (LAS float*)lds;
    LAS float* gcl = (LAS float*)(lds + 4 * 64 * LM_PITCH * 4);
    LAS float* betal = gcl + 256; LAS float* bkl = betal + 256;
    const bf16* QN = (const bf16*)(a.ws + WS_QN); const bf16* KN = (const bf16*)(a.ws + WS_KN);
    const bf16* KT = (const bf16*)(a.ws + WS_KT); const bf16* VT = (const bf16*)(a.ws + WS_VT);
    const float* Gb = (const float*)(a.ws + WS_G); const float* BETA = (const float*)(a.ws + WS_BETA); float* GC = (float*)(a.ws + WS_GC);
    float* U = (float*)(a.ws + WS_U); bf16* W = (bf16*)(a.ws + WS_W); bf16* ATT = (bf16*)(a.ws + WS_ATT);
    const int n = lane & 31, hh = lane >> 5;
    for (int cb = bid * 4; cb < 1024; cb += G * 4) {
        if (wave < 4) { const int ci = cb + wave, nn = ci & 31, h = (ci >> 5) & 3, b = ci >> 7, r0 = b * SEQ + nn * 64;
            float g = Gb[(size_t)(r0 + lane) * 4 + h];
#pragma unroll
            for (int off = 1; off < 64; off <<= 1) { const float v = __shfl_up(g, off); if (lane >= off) g += v; }
            const float be = BETA[(size_t)(r0 + lane) * 4 + h];
            gcl[wave * 64 + lane] = g; GC[(size_t)(r0 + lane) * 4 + h] = g; betal[wave * 64 + lane] = be; bkl[wave * 64 + lane] = be * __expf(g); }
        __syncthreads();
#pragma unroll 1
        for (int q = 0; q < 3; ++q) { const int id = 3 * wave + q, c = id / 6, wq = id % 6, isq = wq >= 3 ? 1 : 0, blk = wq % 3, ib = blk >= 1 ? 1 : 0, jb = blk == 2 ? 1 : 0;
            const int ci = cb + c, nn = ci & 31, h = (ci >> 5) & 3, b = ci >> 7, r0 = b * SEQ + nn * 64;
            const bf16* ap = (isq ? QN : KN) + (size_t)(r0 + 32 * ib + n) * 512 + h * 128 + 8 * hh;
            const bf16* bp = KN + (size_t)(r0 + 32 * jb + n) * 512 + h * 128 + 8 * hh;
            f32x16 acc;
#pragma unroll
            for (int r = 0; r < 16; ++r) acc[r] = 0.f;
#pragma unroll
            for (int ks = 0; ks < 8; ++ks) acc = __builtin_amdgcn_mfma_f32_32x32x16_bf16(*(const bf16x8*)(ap + 16 * ks), *(const bf16x8*)(bp + 16 * ks), acc, 0, 0, 0);
            const int j = 32 * jb + n; const float gj = gcl[c * 64 + j];
#pragma unroll
            for (int r = 0; r < 16; ++r) { const int i = 32 * ib + (r & 3) + 8 * (r >> 2) + 4 * hh; const float dec = __expf(fminf(gcl[c * 64 + i] - gj, 0.f));
                if (isq) ATT[(size_t)ci * 4096 + i * 64 + j] = (bf16)((j <= i) ? f2bf(acc[r] * dec) : 0u);
                else Lm[c * 64 * LM_PITCH + i * LM_PITCH + j] = (j < i) ? betal[c * 64 + i] * acc[r] * dec : 0.f; } }
        __syncthreads();
        if (wave < 4) { LAS float* L = Lm + wave * 64 * LM_PITCH;
            for (int i = 0; i < 64; ++i) { float a0 = (i == lane) ? 1.f : 0.f, a1 = 0.f, a2 = 0.f, a3 = 0.f; int j = 0;
                for (; j + 3 < i; j += 4) { a0 -= L[i * LM_PITCH + j] * L[j * LM_PITCH + lane]; a1 -= L[i * LM_PITCH + j + 1] * L[(j + 1) * LM_PITCH + lane];
                    a2 -= L[i * LM_PITCH + j + 2] * L[(j + 2) * LM_PITCH + lane]; a3 -= L[i * LM_PITCH + j + 3] * L[(j + 3) * LM_PITCH + lane]; }
                for (; j < i; ++j) a0 -= L[i * LM_PITCH + j] * L[j * LM_PITCH + lane];
                L[i * LM_PITCH + lane] = (a0 + a1) + (a2 + a3); } }
        __syncthreads();
#pragma unroll 1
        for (int q = 0; q < 4; ++q) { const int id = wave * 4 + q, c = id >> 3, ten = (id >> 2) & 1, db = id & 3;
            const int ci = cb + c, nn = ci & 31, h = (ci >> 5) & 3, b = ci >> 7, r0 = b * SEQ + nn * 64;
            const bf16* arow = (ten ? KT : VT) + ((size_t)ci * 128 + 32 * db + n) * 64 + 8 * hh;
            const LAS float* scl = (ten ? bkl : betal) + c * 64;
            const LAS float* L = Lm + c * 64 * LM_PITCH;
#pragma unroll
            for (int ib = 0; ib < 2; ++ib) { f32x16 acc;
#pragma unroll
                for (int r = 0; r < 16; ++r) acc[r] = 0.f;
#pragma unroll
                for (int ks = 0; ks < 4; ++ks) { if (ib == 0 && ks >= 2) continue;
                    const LAS float* tp = L + (32 * ib + n) * LM_PITCH + 16 * ks + 8 * hh;
                    const f32x4 t0 = *(const LAS f32x4*)tp, t1 = *(const LAS f32x4*)(tp + 4), s0 = *(const LAS f32x4*)(scl + 16 * ks + 8 * hh), s1 = *(const LAS f32x4*)(scl + 16 * ks + 8 * hh + 4);
                    u32x4 bw; bw.x = pg8::cvt_pk_bf16(t0.x * s0.x, t0.y * s0.y); bw.y = pg8::cvt_pk_bf16(t0.z * s0.z, t0.w * s0.w); bw.z = pg8::cvt_pk_bf16(t1.x * s1.x, t1.y * s1.y); bw.w = pg8::cvt_pk_bf16(t1.z * s1.z, t1.w * s1.w);
                    acc = __builtin_amdgcn_mfma_f32_32x32x16_bf16(*(const bf16x8*)(arow + 16 * ks), __builtin_bit_cast(bf16x8, bw), acc, 0, 0, 0); }
                const size_t ob = (size_t)(r0 + 32 * ib + n) * 512 + h * 128 + 32 * db + 4 * hh;
#pragma unroll
                for (int rq = 0; rq < 4; ++rq) {
                    if (ten) { u32x2 w2; w2.x = pk2(acc[4 * rq], acc[4 * rq + 1]); w2.y = pk2(acc[4 * rq + 2], acc[4 * rq + 3]); *(u32x2*)(W + ob + 8 * rq) = w2; }
                    else *(f32x4*)(U + ob + 8 * rq) = (f32x4){acc[4 * rq], acc[4 * rq + 1], acc[4 * rq + 2], acc[4 * rq + 3]}; } } }
        __syncthreads();
    }
}

__device__ __forceinline__ void ph_dn_scan(const Args& a, LAS unsigned char* lds, int bid, int G, int tid) {
    LAS float* Sl = (LAS float*)lds;
    LAS float* Wl = Sl + 128 * 16;
    LAS unsigned* Ql = (LAS unsigned*)(Wl + 64 * 129);
    LAS unsigned* Kl = Ql + 64 * 65;
    LAS float* Al = (LAS float*)(Kl + 64 * 65);
    LAS float* UL = Al + 64 * 65;
    LAS float* VN = UL + 64 * 16;
    LAS float* gcl = VN + 64 * 17; LAS float* dkl = gcl + 64; LAS float* egl = dkl + 64;
    const bf16* QN = (const bf16*)(a.ws + WS_QN); const bf16* KN = (const bf16*)(a.ws + WS_KN);
    const float* GC = (const float*)(a.ws + WS_GC); const float* U = (const float*)(a.ws + WS_U); const bf16* W = (const bf16*)(a.ws + WS_W);
    const bf16* ATT = (const bf16*)(a.ws + WS_ATT); float* O = (float*)(a.ws + WS_O);
    for (int u = bid; u < 256; u += G) {
        const int s = u & 7, h = (u >> 3) & 3, b = u >> 5;
        for (int i = tid; i < 128 * 16; i += NTHR) Sl[i] = 0.f;
        __syncthreads();
        const int c = tid & 15, i0 = tid >> 4;
        for (int n = 0; n < 32; ++n) {
            const int r0 = b * SEQ + n * 64, ci = (b * 4 + h) * 32 + n;
            { const int row = tid >> 3, seg = tid & 7; const size_t go = (size_t)(r0 + row) * 512 + h * 128 + seg * 16;
                { const u32x4 w0 = *(const u32x4*)(W + go), w1 = *(const u32x4*)(W + go + 8); LAS float* wd = Wl + row * 129 + seg * 16;
#pragma unroll
                    for (int q = 0; q < 4; ++q) { wd[2 * q] = bf_lo(w0[q]); wd[2 * q + 1] = bf_hi(w0[q]); wd[8 + 2 * q] = bf_lo(w1[q]); wd[8 + 2 * q + 1] = bf_hi(w1[q]); } }
                const u32x4 q0 = *(const u32x4*)(QN + go), q1 = *(const u32x4*)(QN + go + 8), k0 = *(const u32x4*)(KN + go), k1 = *(const u32x4*)(KN + go + 8);
                LAS unsigned* qd = Ql + row * 65 + seg * 8; LAS unsigned* kd = Kl + row * 65 + seg * 8;
#pragma unroll
                for (int q = 0; q < 4; ++q) { qd[q] = q0[q]; qd[4 + q] = q1[q]; kd[q] = k0[q]; kd[4 + q] = k1[q]; }
                const int idx = tid * 8, ar = idx >> 6, ac = idx & 63;
                const u32x4 a0 = *(const u32x4*)(ATT + (size_t)ci * 4096 + idx);
                LAS float* ad = Al + ar * 65 + ac; const bool upz = (ar < 32 && ac >= 32);
                ad[0] = upz ? 0.f : bf_lo(a0.x); ad[1] = upz ? 0.f : bf_hi(a0.x); ad[2] = upz ? 0.f : bf_lo(a0.y); ad[3] = upz ? 0.f : bf_hi(a0.y); ad[4] = upz ? 0.f : bf_lo(a0.z); ad[5] = upz ? 0.f : bf_hi(a0.z); ad[6] = upz ? 0.f : bf_lo(a0.w); ad[7] = upz ? 0.f : bf_hi(a0.w);
#pragma unroll
                for (int rr = 0; rr < 2; ++rr) { const int i = i0 + 32 * rr; UL[i * 16 + c] = U[(size_t)(r0 + i) * 512 + h * 128 + s * 16 + c]; }
                if (tid < 64) gcl[tid] = GC[(size_t)(r0 + tid) * 4 + h]; }
            __syncthreads();
            if (tid < 64) { const float gl = gcl[63], gi = gcl[tid]; dkl[tid] = __expf(gl - gi); egl[tid] = __expf(gi); }
#pragma unroll
            for (int rr = 0; rr < 2; ++rr) { const int i = i0 + 32 * rr; float acc = UL[i * 16 + c];
                for (int k = 0; k < 128; ++k) acc -= Wl[i * 129 + k] * Sl[k * 16 + c];
                VN[i * 17 + c] = acc; }
            __syncthreads();
#pragma unroll
            for (int rr = 0; rr < 2; ++rr) { const int i = i0 + 32 * rr; float acc = 0.f;
                for (int k2 = 0; k2 < 64; ++k2) { const unsigned qw = Ql[i * 65 + k2]; acc += bf_lo(qw) * Sl[(2 * k2) * 16 + c] + bf_hi(qw) * Sl[(2 * k2 + 1) * 16 + c]; }
                acc *= egl[i];
                for (int j = 0; j <= i; ++j) acc += Al[i * 65 + j] * VN[j * 17 + c];
                O[(size_t)(r0 + i) * 512 + h * 128 + s * 16 + c] = acc; }
            __syncthreads();
            { const float eg = __expf(gcl[63]);
#pragma unroll
                for (int m = 0; m < 4; ++m) { const int kk = i0 + 32 * m; float acc = Sl[kk * 16 + c] * eg;
                    for (int j = 0; j < 64; ++j) { const unsigned kw = Kl[j * 65 + (kk >> 1)]; const float kv = (kk & 1) ? bf_hi(kw) : bf_lo(kw); acc += kv * dkl[j] * VN[j * 17 + c]; }
                    Sl[kk * 16 + c] = acc; } }
            __syncthreads();
        }
    }
}

constexpr int SC_WP = 272, SC_AP = 144;
constexpr int SC_W = 0, SC_Q = 64 * SC_WP, SC_A = 2 * 64 * SC_WP, SC_K = SC_A + 64 * SC_AP, SC_GC = SC_K + 128 * SC_AP, SC_BUF = SC_GC + 1024;
static_assert(2 * SC_BUF <= RING_BYTES, "scan LDS");
struct ScanPf { u32x4 w0, w1, q0, q1, at, k0, k1; float g, gl; };
__device__ __forceinline__ ScanPf scan_load(const bf16* W, const bf16* QN, const bf16* ATT, const bf16* KT, const float* GC, int r0, int h, int ci, int tid) {
    ScanPf p; const int row = tid >> 4, seg = tid & 15; const size_t go = (size_t)(r0 + row) * 512 + h * 128 + seg * 8;
    p.w0 = *(const u32x4*)(W + go); p.w1 = *(const u32x4*)(W + go + (size_t)32 * 512); p.q0 = *(const u32x4*)(QN + go); p.q1 = *(const u32x4*)(QN + go + (size_t)32 * 512);
    p.at = *(const u32x4*)(ATT + (size_t)ci * 4096 + tid * 8);
    p.k0 = *(const u32x4*)(KT + (size_t)ci * 8192 + tid * 8); p.k1 = *(const u32x4*)(KT + (size_t)ci * 8192 + 4096 + tid * 8);
    p.g = GC[(size_t)(r0 + (tid & 63)) * 4 + h]; p.gl = GC[(size_t)(r0 + 63) * 4 + h]; return p;
}
__device__ __forceinline__ void scan_store(const ScanPf& p, LAS unsigned char* buf, int tid) {
    const int row = tid >> 4, seg = tid & 15;
    *(LAS u32x4*)(buf + SC_W + row * SC_WP + seg * 16) = p.w0; *(LAS u32x4*)(buf + SC_W + (row + 32) * SC_WP + seg * 16) = p.w1;
    *(LAS u32x4*)(buf + SC_Q + row * SC_WP + seg * 16) = p.q0; *(LAS u32x4*)(buf + SC_Q + (row + 32) * SC_WP + seg * 16) = p.q1;
    *(LAS u32x4*)(buf + SC_A + (tid >> 3) * SC_AP + (tid & 7) * 16) = p.at;
    *(LAS u32x4*)(buf + SC_K + (tid >> 3) * SC_AP + (tid & 7) * 16) = p.k0; *(LAS u32x4*)(buf + SC_K + (64 + (tid >> 3)) * SC_AP + (tid & 7) * 16) = p.k1;
    if (tid < 64) { LAS float* gp = (LAS float*)(buf + SC_GC); gp[tid] = __expf(p.g); gp[64 + tid] = __expf(p.gl - p.g); if (tid == 0) gp[128] = __expf(p.gl); }
}
__device__ __forceinline__ bf16x8 frag2(const LAS unsigned char* p) { const u32x2 lo = *(const LAS u32x2*)p, hi = *(const LAS u32x2*)(p + 16); const u32x4 v = {lo.x, lo.y, hi.x, hi.y}; return __builtin_bit_cast(bf16x8, v); }
__device__ __forceinline__ void ph_dn_scan_mfma(const Args& a, LAS unsigned char* lds, int bid, int G, int tid, int wave, int lane) {
    const bf16* QN = (const bf16*)(a.ws + WS_QN); const bf16* KT = (const bf16*)(a.ws + WS_KT); const bf16* W = (const bf16*)(a.ws + WS_W); const bf16* ATT = (const bf16*)(a.ws + WS_ATT);
    const float* GC = (const float*)(a.ws + WS_GC); const float* U = (const float*)(a.ws + WS_U); float* O = (float*)(a.ws + WS_O);
    const int n = lane & 31, hh = lane >> 5;
    for (int u = bid; u < 32; u += G) {
        const int h = u & 3, b = u >> 2;
        f32x16 S[4];
#pragma unroll
        for (int k = 0; k < 4; ++k)
#pragma unroll
            for (int r = 0; r < 16; ++r) S[k][r] = 0.f;
        __syncthreads();
        { const ScanPf p0 = scan_load(W, QN, ATT, KT, GC, b * SEQ, h, (b * 4 + h) * 32, tid); scan_store(p0, lds, tid); }
        __syncthreads();
#pragma unroll 1
        for (int nn = 0; nn < 32; ++nn) {
            const int r0 = b * SEQ + nn * 64; LAS unsigned char* buf = lds + (nn & 1) * SC_BUF; const LAS float* gp = (const LAS float*)(buf + SC_GC);
            ScanPf pf; if (nn + 1 < 32) pf = scan_load(W, QN, ATT, KT, GC, r0 + 64, h, (b * 4 + h) * 32 + nn + 1, tid);
            if (wave < 4) {
                const size_t ubase = (size_t)r0 * 512 + h * 128 + 32 * wave + n;
                f32x16 vn[2];
#pragma unroll
                for (int ib = 0; ib < 2; ++ib)
#pragma unroll
                    for (int r = 0; r < 16; ++r) vn[ib][r] = U[ubase + (size_t)(32 * ib + (r & 3) + 8 * (r >> 2) + 4 * hh) * 512];
                bf16x8 Sb[4][2];
#pragma unroll
                for (int k = 0; k < 4; ++k)
#pragma unroll
                    for (int s2 = 0; s2 < 2; ++s2) { u32x4 w4; w4.x = pg8::cvt_pk_bf16(S[k][8 * s2], S[k][8 * s2 + 1]); w4.y = pg8::cvt_pk_bf16(S[k][8 * s2 + 2], S[k][8 * s2 + 3]);
                        w4.z = pg8::cvt_pk_bf16(S[k][8 * s2 + 4], S[k][8 * s2 + 5]); w4.w = pg8::cvt_pk_bf16(S[k][8 * s2 + 6], S[k][8 * s2 + 7]); Sb[k][s2] = __builtin_bit_cast(bf16x8, w4); }
#pragma unroll
                for (int ib = 0; ib < 2; ++ib) { f32x16 acc;
#pragma unroll
                    for (int r = 0; r < 16; ++r) acc[r] = 0.f;
#pragma unroll
                    for (int k = 0; k < 4; ++k)
#pragma unroll
                        for (int s2 = 0; s2 < 2; ++s2) acc = __builtin_amdgcn_mfma_f32_32x32x16_bf16(frag2(buf + SC_W + (32 * ib + n) * SC_WP + (32 * k + 16 * s2 + 4 * hh) * 2), Sb[k][s2], acc, 0, 0, 0);
#pragma unroll
                    for (int r = 0; r < 16; ++r) vn[ib][r] -= acc[r]; }
                bf16x8 vb[2][2], vd[2][2];
#pragma unroll
                for (int jb = 0; jb < 2; ++jb)
#pragma unroll
                    for (int s2 = 0; s2 < 2; ++s2) { const f32x4 d0 = *(const LAS f32x4*)(gp + 64 + 32 * jb + 16 * s2 + 4 * hh), d1 = *(const LAS f32x4*)(gp + 64 + 32 * jb + 16 * s2 + 8 + 4 * hh);
                        const float* v = nullptr; (void)v; u32x4 w4, w5;
                        w4.x = pg8::cvt_pk_bf16(vn[jb][8 * s2], vn[jb][8 * s2 + 1]); w4.y = pg8::cvt_pk_bf16(vn[jb][8 * s2 + 2], vn[jb][8 * s2 + 3]);
                        w4.z = pg8::cvt_pk_bf16(vn[jb][8 * s2 + 4], vn[jb][8 * s2 + 5]); w4.w = pg8::cvt_pk_bf16(vn[jb][8 * s2 + 6], vn[jb][8 * s2 + 7]);
                        w5.x = pg8::cvt_pk_bf16(vn[jb][8 * s2] * d0.x, vn[jb][8 * s2 + 1] * d0.y); w5.y = pg8::cvt_pk_bf16(vn[jb][8 * s2 + 2] * d0.z, vn[jb][8 * s2 + 3] * d0.w);
                        w5.z = pg8::cvt_pk_bf16(vn[jb][8 * s2 + 4] * d1.x, vn[jb][8 * s2 + 5] * d1.y); w5.w = pg8::cvt_pk_bf16(vn[jb][8 * s2 + 6] * d1.z, vn[jb][8 * s2 + 7] * d1.w);
                        vb[jb][s2] = __builtin_bit_cast(bf16x8, w4); vd[jb][s2] = __builtin_bit_cast(bf16x8, w5); }
#pragma unroll
                for (int ib = 0; ib < 2; ++ib) { f32x16 acc;
#pragma unroll
                    for (int r = 0; r < 16; ++r) acc[r] = 0.f;
#pragma unroll
                    for (int k = 0; k < 4; ++k)
#pragma unroll
                        for (int s2 = 0; s2 < 2; ++s2) acc = __builtin_amdgcn_mfma_f32_32x32x16_bf16(frag2(buf + SC_Q + (32 * ib + n) * SC_WP + (32 * k + 16 * s2 + 4 * hh) * 2), Sb[k][s2], acc, 0, 0, 0);
#pragma unroll
                    for (int rq = 0; rq < 4; ++rq) { const f32x4 e4 = *(const LAS f32x4*)(gp + 32 * ib + 8 * rq + 4 * hh);
                        acc[4 * rq] *= e4.x; acc[4 * rq + 1] *= e4.y; acc[4 * rq + 2] *= e4.z; acc[4 * rq + 3] *= e4.w; }
#pragma unroll
                    for (int jb = 0; jb < 2; ++jb) { if (jb > ib) continue;
#pragma unroll
                        for (int s2 = 0; s2 < 2; ++s2) acc = __builtin_amdgcn_mfma_f32_32x32x16_bf16(frag2(buf + SC_A + (32 * ib + n) * SC_AP + (32 * jb + 16 * s2 + 4 * hh) * 2), vb[jb][s2], acc, 0, 0, 0); }
#pragma unroll
                    for (int r = 0; r < 16; ++r) O[ubase + (size_t)(32 * ib + (r & 3) + 8 * (r >> 2) + 4 * hh) * 512] = acc[r]; }
                const float egl = gp[128];
#pragma unroll
                for (int k = 0; k < 4; ++k) {
#pragma unroll
                    for (int r = 0; r < 16; ++r) S[k][r] *= egl;
#pragma unroll
                    for (int jb = 0; jb < 2; ++jb)
#pragma unroll
                        for (int s2 = 0; s2 < 2; ++s2) S[k] = __builtin_amdgcn_mfma_f32_32x32x16_bf16(frag2(buf + SC_K + (32 * k + n) * SC_AP + (32 * jb + 16 * s2 + 4 * hh) * 2), vd[jb][s2], S[k], 0, 0, 0); }
            }
            if (nn + 1 < 32) scan_store(pf, lds + ((nn + 1) & 1) * SC_BUF, tid);
            __syncthreads();
        }
    }
}

__device__ __forceinline__ void ph_dn_out(const Args& a, int l, int gw, int NGW, int lane) {
    const float* O = (const float*)(a.ws + WS_O); const bf16* P = (const bf16*)(a.ws + WS_P); bf16* Y = (bf16*)(a.ws + WS_Y);
    const float* nw = a.in[6] + l * 128;
    for (int tok = gw; tok < NT; tok += NGW) {
#pragma unroll
        for (int h = 0; h < 4; ++h) { const float o0 = O[(size_t)tok * 512 + h * 128 + 2 * lane], o1 = O[(size_t)tok * 512 + h * 128 + 2 * lane + 1];
            const float ss = wave_sum(o0 * o0 + o1 * o1); const float r = rsqrtf(ss * (1.0f / 128.0f) + EPS);
            const unsigned zw = *(const unsigned*)(P + (size_t)tok * NP + C_Z + h * 128 + 2 * lane);
            const float y0 = o0 * r * nw[2 * lane] * siluf_(bf_lo(zw)), y1 = o1 * r * nw[2 * lane + 1] * siluf_(bf_hi(zw));
            *(unsigned*)(Y + (size_t)tok * DM + h * 128 + 2 * lane) = pk2(y0, y1); }
    }
}

__device__ __forceinline__ void nsa_qk(const bf16* krow, const LAS float* qs, float (&s)[4]) {
#pragma unroll
    for (int h = 0; h < 4; ++h) s[h] = 0.f;
#pragma unroll 1
    for (int i = 0; i < 8; ++i) { const u32x4 kr = *(const u32x4*)(krow + 8 * i);
#pragma unroll
        for (int hf = 0; hf < 2; ++hf) { const float k0 = bf_lo(kr[2 * hf]), k1 = bf_hi(kr[2 * hf]), k2 = bf_lo(kr[2 * hf + 1]), k3 = bf_hi(kr[2 * hf + 1]);
#pragma unroll
            for (int h = 0; h < 4; ++h) { const f32x4 qv = *(const LAS f32x4*)(qs + h * 64 + i * 8 + hf * 4); s[h] += (qv.x * k0 + qv.y * k1) + (qv.z * k2 + qv.w * k3); } } }
}
__device__ __forceinline__ void nsa_pv(const float (&p)[4], LAS float* pw, const bf16* vbase, int vpitch, int kmax, int lane, float (&o)[4][2]) {
    *(LAS f32x4*)(pw + lane * 4) = (f32x4){p[0], p[1], p[2], p[3]};
    LDS_WAIT();
    const int dp = lane & 31, par = lane >> 5;
#pragma unroll 8
    for (int kk = 0; kk < 32; ++kk) { const int key = 2 * kk + par; const f32x4 pv = *(const LAS f32x4*)(pw + key * 4);
        const int row = key < kmax ? key : kmax; const unsigned vv = *(const unsigned*)(vbase + (size_t)row * vpitch + 2 * dp);
        const float v0 = bf_lo(vv), v1 = bf_hi(vv);
#pragma unroll
        for (int h = 0; h < 4; ++h) { o[h][0] += pv[h] * v0; o[h][1] += pv[h] * v1; } }
    LDS_WAIT();
}
__device__ __forceinline__ void nsa_tile(const bf16* krow, bool valid, int dist, const LAS float* qs, const LAS float* btl, LAS float* pw, const bf16* vbase, int vpitch, int lane,
                                         float (&m)[4], float (&lsum)[4], float (&o)[4][2]) {
    float s[4], p[4]; nsa_qk(krow, qs, s);
    const int dd = dist < 0 ? 0 : (dist > 2047 ? 2047 : dist);
#pragma unroll
    for (int h = 0; h < 4; ++h) { const float sv = valid ? s[h] + btl[h * 2048 + dd] : -1e30f; const float mn = fmaxf(m[h], wave_max(sv));
        const float corr = __expf(m[h] - mn); p[h] = valid ? __expf(sv - mn) : 0.f; lsum[h] = lsum[h] * corr + wave_sum(p[h]); o[h][0] *= corr; o[h][1] *= corr; m[h] = mn; }
    nsa_pv(p, pw, vbase, vpitch, 63, lane, o);
}

__device__ __forceinline__ void ph_nsa(const Args& a, LAS unsigned char* lds, int bid, int G, int tid, int wave, int lane) {
    LAS float* btl = (LAS float*)lds;
    LAS float* qs = (LAS float*)(lds + 32768 + wave * 4096);
    LAS float* pw = qs + 256;
    LAS float* ps = pw + 256;
    const float* BT = (const float*)(a.ws + WS_BT);
    for (int i = tid; i < 4 * 2048; i += NTHR) btl[i] = BT[i];
    __syncthreads();
    const bf16* P = (const bf16*)(a.ws + WS_P); const bf16* NQ = (const bf16*)(a.ws + WS_NQ);
    const bf16* KS = (const bf16*)(a.ws + WS_KS); const bf16* KW = (const bf16*)(a.ws + WS_KW);
    const bf16* KCMP = (const bf16*)(a.ws + WS_KCMP); const bf16* VCMP = (const bf16*)(a.ws + WS_VCMP); bf16* Y = (bf16*)(a.ws + WS_Y);
    const int gw = bid * NWAVES + wave, NGW = G * NWAVES;
    for (int it = gw; it < NT; it += NGW) {
        const int b = it / SEQ, t = ((it % SEQ) + 293 * b) & (SEQ - 1);
        const int tok = b * SEQ + t;
#pragma unroll
        for (int i = 0; i < 4; ++i) qs[lane + 64 * i] = bf2f(NQ[(size_t)tok * 256 + lane + 64 * i]);
        LDS_WAIT();
        float ocmp[4][2], oslc[4][2], owin[4][2];
        {
            float sA[4], sB[4], pA[4], pB[4];
            const int jA = lane, jB = 64 + lane; const bool vA = (16 * jA + 31 <= t), vB = (jB < 127) && (16 * jB + 31 <= t);
            nsa_qk(KCMP + (size_t)(b * 128 + jA) * 64, qs, sA);
            nsa_qk(KCMP + (size_t)(b * 128 + (jB < 127 ? jB : 126)) * 64, qs, sB);
            int dA = t - 16 * jA - 31, dB = t - 16 * jB - 31; dA = dA < 0 ? 0 : dA; dB = dB < 0 ? 0 : dB;
#pragma unroll
            for (int h = 0; h < 4; ++h) { const float a_ = vA ? sA[h] + btl[h * 2048 + dA] : -1e30f, b_ = vB ? sB[h] + btl[h * 2048 + dB] : -1e30f;
                const float mx = wave_max(fmaxf(a_, b_)); pA[h] = vA ? __expf(a_ - mx) : 0.f; pB[h] = vB ? __expf(b_ - mx) : 0.f;
                const float ls = wave_sum(pA[h] + pB[h]); const float inv = ls > 0.f ? 1.0f / ls : 0.f; pA[h] *= inv; pB[h] *= inv; }
            ps[lane] = (pA[0] + pA[1]) + (pA[2] + pA[3]); ps[64 + lane] = (pB[0] + pB[1]) + (pB[2] + pB[3]);
#pragma unroll
            for (int h = 0; h < 4; ++h) { ocmp[h][0] = 0.f; ocmp[h][1] = 0.f; }
            nsa_pv(pA, pw, VCMP + (size_t)(b * 128) * 64, 64, 63, lane, ocmp);
            nsa_pv(pB, pw, VCMP + (size_t)(b * 128 + 64) * 64, 64, 62, lane, ocmp);
#pragma unroll
            for (int h = 0; h < 4; ++h) { ocmp[h][0] += __shfl_xor(ocmp[h][0], 32); ocmp[h][1] += __shfl_xor(ocmp[h][1], 32); }
        }
        unsigned selmask;
        {
            const int sb = lane & 31, cur = t >> 6; float imp = 0.f;
#pragma unroll
            for (int dj = -1; dj <= 3; ++dj) { const int j = 4 * sb + dj; if (j >= 0 && j <= 126) imp += ps[j]; }
            if (sb > cur) imp = -1.0f; else if (sb == 0 || sb == cur || sb == cur - 1) imp = 1e4f;
            int rank = 0;
            for (int s2 = 0; s2 < 32; ++s2) { const float v2 = __shfl(imp, s2); rank += (v2 > imp || (v2 == imp && s2 < sb)) ? 1 : 0; }
            const bool sel = (lane < 32) && (rank < 16) && (sb <= cur);
            selmask = (unsigned)__ballot(sel);
        }
        {
            float m[4], ls[4];
#pragma unroll
            for (int h = 0; h < 4; ++h) { m[h] = -1e30f; ls[h] = 0.f; oslc[h][0] = 0.f; oslc[h][1] = 0.f; }
            unsigned mk = selmask;
            while (mk) { const int sblk = __builtin_ctz(mk); mk &= mk - 1u; const int key = 64 * sblk + lane;
                nsa_tile(KS + (size_t)(b * SEQ + key) * 64, key <= t, t - key, qs, btl, pw, P + (size_t)(b * SEQ + 64 * sblk) * NP + C_KV + 192, NP, lane, m, ls, oslc); }
#pragma unroll
            for (int h = 0; h < 4; ++h) { const float inv = ls[h] > 0.f ? 1.0f / ls[h] : 0.f; oslc[h][0] = (oslc[h][0] + __shfl_xor(oslc[h][0], 32)) * inv; oslc[h][1] = (oslc[h][1] + __shfl_xor(oslc[h][1], 32)) * inv; }
        }
        {
            float m[4], ls[4];
#pragma unroll
            for (int h = 0; h < 4; ++h) { m[h] = -1e30f; ls[h] = 0.f; owin[h][0] = 0.f; owin[h][1] = 0.f; }
            const int lo = t - 511 > 0 ? t - 511 : 0;
            for (int kt = lo >> 6; kt <= (t >> 6); ++kt) { const int key = 64 * kt + lane;
                nsa_tile(KW + (size_t)(b * SEQ + key) * 64, key <= t && key >= lo, t - key, qs, btl, pw, P + (size_t)(b * SEQ + 64 * kt) * NP + C_KV + 320, NP, lane, m, ls, owin); }
#pragma unroll
            for (int h = 0; h < 4; ++h) { const float inv = ls[h] > 0.f ? 1.0f / ls[h] : 0.f; owin[h][0] = (owin[h][0] + __shfl_xor(owin[h][0], 32)) * inv; owin[h][1] = (owin[h][1] + __shfl_xor(owin[h][1], 32)) * inv; }
        }
        if (lane < 32) {
#pragma unroll
            for (int h = 0; h < 4; ++h) { const bf16* gp = P + (size_t)tok * NP + C_G + h * 3;
                const float g0 = sigmoidf_(bf2f(gp[0])), g1 = sigmoidf_(bf2f(gp[1])), g2 = sigmoidf_(bf2f(gp[2]));
                const float y0 = g0 * ocmp[h][0] + g1 * oslc[h][0] + g2 * owin[h][0], y1 = g0 * ocmp[h][1] + g1 * oslc[h][1] + g2 * owin[h][1];
                *(unsigned*)(Y + (size_t)tok * DM + 512 + h * 64 + 2 * lane) = pk2(y0, y1); }
        }
    }
}

constexpr int NSA_KT_PITCH = 144, NSA_VT_PITCH = 136;
struct NsaStage { u32x4 kv, vv; };
__device__ __forceinline__ NsaStage nsa_load(const bf16* Kbase, int kpitch, const bf16* Vbase, int vpitch, int tid) {
    const int key = tid >> 3, seg = tid & 7; NsaStage s;
    s.kv = *(const u32x4*)(Kbase + (size_t)key * kpitch + seg * 8); s.vv = *(const u32x4*)(Vbase + (size_t)key * vpitch + seg * 8); return s;
}
__device__ __forceinline__ void nsa_store(const NsaStage& s, LAS unsigned char* Kt, LAS unsigned char* Vt, int tid) {
    const int key = tid >> 3, seg = tid & 7;
    *(LAS u32x4*)(Kt + key * NSA_KT_PITCH + seg * 16) = s.kv;
#pragma unroll
    for (int i = 0; i < 4; ++i) { const unsigned w = s.vv[i];
        *(LAS unsigned short*)(Vt + (seg * 8 + 2 * i) * NSA_VT_PITCH + key * 2) = (unsigned short)(w & 0xffffu);
        *(LAS unsigned short*)(Vt + (seg * 8 + 2 * i + 1) * NSA_VT_PITCH + key * 2) = (unsigned short)(w >> 16); }
}
__device__ __forceinline__ void nsa_st(const LAS unsigned char* Kt, const bf16x8 (&qf)[4], int n, int hh, f32x16 (&s)[2]) {
#pragma unroll
    for (int kb = 0; kb < 2; ++kb) {
#pragma unroll
        for (int r = 0; r < 16; ++r) s[kb][r] = 0.f;
#pragma unroll
        for (int ks = 0; ks < 4; ++ks) { const bf16x8 af = *(const LAS bf16x8*)(Kt + (kb * 32 + n) * NSA_KT_PITCH + (16 * ks + 8 * hh) * 2);
            s[kb] = __builtin_amdgcn_mfma_f32_32x32x16_bf16(af, qf[ks], s[kb], 0, 0, 0); } }
}
__device__ __forceinline__ void nsa_pvm(const LAS unsigned char* Vt, const bf16x8 (&pf)[2][2], int n, int hh, f32x16 (&o)[2]) {
#pragma unroll
    for (int db = 0; db < 2; ++db)
#pragma unroll
        for (int kb = 0; kb < 2; ++kb)
#pragma unroll
            for (int s2 = 0; s2 < 2; ++s2) { const LAS unsigned char* p = Vt + (db * 32 + n) * NSA_VT_PITCH + (kb * 32 + 16 * s2 + 4 * hh) * 2;
                const u32x2 lo = *(const LAS u32x2*)p, hi = *(const LAS u32x2*)(p + 16);
                const u32x4 av = {lo.x, lo.y, hi.x, hi.y};
                o[db] = __builtin_amdgcn_mfma_f32_32x32x16_bf16(__builtin_bit_cast(bf16x8, av), pf[kb][s2], o[db], 0, 0, 0); }
}
__device__ __forceinline__ void nsa_pack(const f32x16 (&p)[2], bf16x8 (&pf)[2][2]) {
#pragma unroll
    for (int kb = 0; kb < 2; ++kb)
#pragma unroll
        for (int s2 = 0; s2 < 2; ++s2) { u32x4 w;
            w.x = pg8::cvt_pk_bf16(p[kb][8 * s2 + 0], p[kb][8 * s2 + 1]); w.y = pg8::cvt_pk_bf16(p[kb][8 * s2 + 2], p[kb][8 * s2 + 3]);
            w.z = pg8::cvt_pk_bf16(p[kb][8 * s2 + 4], p[kb][8 * s2 + 5]); w.w = pg8::cvt_pk_bf16(p[kb][8 * s2 + 6], p[kb][8 * s2 + 7]);
            pf[kb][s2] = __builtin_bit_cast(bf16x8, w); }
}
__device__ __forceinline__ void nsa_tile_mfma(const LAS unsigned char* Kt, const LAS unsigned char* Vt, const LAS float* btlh, const bf16x8 (&qf)[4], int n, int hh,
                                              int key0, int tq, bool colsel, int lowk, float& m, float& l, f32x16 (&o)[2]) {
    f32x16 s[2]; nsa_st(Kt, qf, n, hh, s);
    float tmax = -1e30f;
#pragma unroll
    for (int kb = 0; kb < 2; ++kb)
#pragma unroll
        for (int r = 0; r < 16; ++r) { const int key = key0 + kb * 32 + (r & 3) + 8 * (r >> 2) + 4 * hh; const int dist = tq - key;
            const bool valid = colsel && dist >= 0 && key >= lowk; const float x = s[kb][r] + btlh[dist < 0 ? 0 : dist];
            s[kb][r] = valid ? x : -1e30f; tmax = fmaxf(tmax, s[kb][r]); }
    tmax = fmaxf(tmax, __shfl_xor(tmax, 32));
    const float mn = fmaxf(m, tmax), corr = __expf(m - mn); float rs = 0.f;
#pragma unroll
    for (int kb = 0; kb < 2; ++kb)
#pragma unroll
        for (int r = 0; r < 16; ++r) { const float x = s[kb][r]; const float p = x > -1e29f ? __expf(x - mn) : 0.f; s[kb][r] = p; rs += p; }
    rs += __shfl_xor(rs, 32);
    l = l * corr + rs; m = mn;
#pragma unroll
    for (int db = 0; db < 2; ++db)
#pragma unroll
        for (int r = 0; r < 16; ++r) o[db][r] *= corr;
    bf16x8 pf[2][2]; nsa_pack(s, pf);
    nsa_pvm(Vt, pf, n, hh, o);
}

__device__ __forceinline__ void ph_nsa_mfma(const Args& a, LAS unsigned char* lds, int ubeg, int ustep, int tid, int wave, int lane) {
    LAS float* btl = (LAS float*)lds;
    LAS unsigned char* Kt = lds + 32768;
    LAS unsigned char* Vt = lds + 32768 + 9216;
    LAS float* PS = (LAS float*)(lds + 51200);
    LAS unsigned* MK = (LAS unsigned*)(lds + 84480);
    const float* BT = (const float*)(a.ws + WS_BT);
    for (int i = tid; i < 4 * 2048; i += NTHR) btl[i] = BT[i];
    const bf16* P = (const bf16*)(a.ws + WS_P); const bf16* NQ = (const bf16*)(a.ws + WS_NQ);
    const bf16* KS = (const bf16*)(a.ws + WS_KS); const bf16* KW = (const bf16*)(a.ws + WS_KW);
    const bf16* KCMP = (const bf16*)(a.ws + WS_KCMP); const bf16* VCMP = (const bf16*)(a.ws + WS_VCMP); bf16* Y = (bf16*)(a.ws + WS_Y);
    const int n = lane & 31, hh = lane >> 5, tl = n >> 2, h = n & 3;
    const LAS float* btlh = btl + h * 2048;
    __syncthreads();
    for (int u = ubeg; u < 256; u += ustep) {
        const int b = u & 7, qt = 31 - (u >> 3), t0 = 64 * qt, tq = t0 + 8 * wave + tl, tok = b * SEQ + tq;
        bf16x8 qf[4];
#pragma unroll
        for (int ks = 0; ks < 4; ++ks) qf[ks] = *(const bf16x8*)(NQ + (size_t)tok * 256 + h * 64 + 16 * ks + 8 * hh);
        float gate[3];
#pragma unroll
        for (int br = 0; br < 3; ++br) gate[br] = sigmoidf_(bf2f(P[(size_t)tok * NP + C_G + h * 3 + br]));
        f32x16 yacc[2];
#pragma unroll
        for (int db = 0; db < 2; ++db)
#pragma unroll
            for (int r = 0; r < 16; ++r) yacc[db][r] = 0.f;
        {
            f32x16 sc[2][2];
#pragma unroll
            for (int ct = 0; ct < 2; ++ct) {
                __syncthreads();
                { const NsaStage st = nsa_load(KCMP + (size_t)(b * 128 + ct * 64) * 64, 64, VCMP + (size_t)(b * 128 + ct * 64) * 64, 64, tid); nsa_store(st, Kt, Vt + ct * 0, tid); }
                __syncthreads();
                nsa_st(Kt, qf, n, hh, sc[ct]);
            }
            float mx = -1e30f;
#pragma unroll
            for (int ct = 0; ct < 2; ++ct)
#pragma unroll
                for (int kb = 0; kb < 2; ++kb)
#pragma unroll
                    for (int r = 0; r < 16; ++r) { const int j = ct * 64 + kb * 32 + (r & 3) + 8 * (r >> 2) + 4 * hh; const int dist = tq - 16 * j - 31;
                        const float x = sc[ct][kb][r] + btlh[dist < 0 ? 0 : dist]; sc[ct][kb][r] = dist >= 0 ? x : -1e30f; mx = fmaxf(mx, sc[ct][kb][r]); }
            mx = fmaxf(mx, __shfl_xor(mx, 32));
            float rs = 0.f;
#pragma unroll
            for (int ct = 0; ct < 2; ++ct)
#pragma unroll
                for (int kb = 0; kb < 2; ++kb)
#pragma unroll
                    for (int r = 0; r < 16; ++r) { const float x = sc[ct][kb][r]; const float p = x > -1e29f ? __expf(x - mx) : 0.f; sc[ct][kb][r] = p; rs += p; }
            rs += __shfl_xor(rs, 32);
            const float inv = rs > 0.f ? 1.0f / rs : 0.f;
#pragma unroll
            for (int ct = 0; ct < 2; ++ct)
#pragma unroll
                for (int kb = 0; kb < 2; ++kb)
#pragma unroll
                    for (int r = 0; r < 16; ++r) { const float p = sc[ct][kb][r] * inv; sc[ct][kb][r] = p;
                        float v = p; v += __shfl_xor(v, 1); v += __shfl_xor(v, 2);
                        if (h == 0) PS[(8 * wave + tl) * 129 + ct * 64 + kb * 32 + (r & 3) + 8 * (r >> 2) + 4 * hh] = v; }
            f32x16 o[2];
#pragma unroll
            for (int db = 0; db < 2; ++db)
#pragma unroll
                for (int r = 0; r < 16; ++r) o[db][r] = 0.f;
            { bf16x8 pf[2][2]; nsa_pack(sc[1], pf); nsa_pvm(Vt, pf, n, hh, o); }
            __syncthreads();
            { const NsaStage st = nsa_load(KCMP + (size_t)(b * 128) * 64, 64, VCMP + (size_t)(b * 128) * 64, 64, tid); nsa_store(st, Kt, Vt, tid); }
            __syncthreads();
            { bf16x8 pf[2][2]; nsa_pack(sc[0], pf); nsa_pvm(Vt, pf, n, hh, o); }
#pragma unroll
            for (int db = 0; db < 2; ++db)
#pragma unroll
                for (int r = 0; r < 16; ++r) yacc[db][r] += gate[0] * o[db][r];
        }
        LDS_WAIT();
        for (int t2 = 0; t2 < 8; ++t2) {
            const int tqq = t0 + 8 * wave + t2, sb = lane & 31, cur = tqq >> 6; const LAS float* row = PS + (8 * wave + t2) * 129; float imp = 0.f;
#pragma unroll
            for (int dj = -1; dj <= 3; ++dj) { const int j = 4 * sb + dj; if (j >= 0 && j <= 126) imp += row[j]; }
            if (sb > cur) imp = -1.0f; else if (sb == 0 || sb == cur || sb == cur - 1) imp = 1e4f;
            int rank = 0;
            for (int s2 = 0; s2 < 32; ++s2) { const float v2 = __shfl(imp, s2); rank += (v2 > imp || (v2 == imp && s2 < sb)) ? 1 : 0; }
            const unsigned msk = (unsigned)__ballot((lane < 32) && (rank < 16) && (sb <= cur));
            if (lane == 0) MK[8 * wave + t2] = msk;
        }
        __syncthreads();
        unsigned anymask, wmask; const unsigned mymask = MK[8 * wave + tl];
        { unsigned v = MK[lane];
#pragma unroll
            for (int o_ = 1; o_ < 64; o_ <<= 1) v |= (unsigned)__shfl_xor((int)v, o_);
            anymask = (unsigned)__builtin_amdgcn_readfirstlane((int)v);
            unsigned w = MK[8 * wave + (lane & 7)]; w |= (unsigned)__shfl_xor((int)w, 1); w |= (unsigned)__shfl_xor((int)w, 2); w |= (unsigned)__shfl_xor((int)w, 4);
            wmask = (unsigned)__builtin_amdgcn_readfirstlane((int)w); }
        {
            float m = -1e30f, l = 0.f; f32x16 o[2];
#pragma unroll
            for (int db = 0; db < 2; ++db)
#pragma unroll
                for (int r = 0; r < 16; ++r) o[db][r] = 0.f;
            unsigned mk = anymask;
            NsaStage st; { const int s0 = __builtin_ctz(mk); st = nsa_load(KS + (size_t)(b * SEQ + 64 * s0) * 64, 64, P + (size_t)(b * SEQ + 64 * s0) * NP + C_KV + 192, NP, tid); }
            while (mk) {
                const int sblk = __builtin_ctz(mk); mk &= mk - 1u;
                __syncthreads();
                nsa_store(st, Kt, Vt, tid);
                __syncthreads();
                if (mk) { const int s1 = __builtin_ctz(mk); st = nsa_load(KS + (size_t)(b * SEQ + 64 * s1) * 64, 64, P + (size_t)(b * SEQ + 64 * s1) * NP + C_KV + 192, NP, tid); }
                if ((wmask >> sblk) & 1u) nsa_tile_mfma(Kt, Vt, btlh, qf, n, hh, 64 * sblk, tq, ((mymask >> sblk) & 1u) != 0u, 0, m, l, o);
            }
            const float inv = l > 0.f ? gate[1] / l : 0.f;
#pragma unroll
            for (int db = 0; db < 2; ++db)
#pragma unroll
                for (int r = 0; r < 16; ++r) yacc[db][r] += inv * o[db][r];
        }
        {
            float m = -1e30f, l = 0.f; f32x16 o[2];
#pragma unroll
            for (int db = 0; db < 2; ++db)
#pragma unroll
                for (int r = 0; r < 16; ++r) o[db][r] = 0.f;
            const int kt0 = (t0 - 511 > 0 ? t0 - 511 : 0) >> 6;
            NsaStage st = nsa_load(KW + (size_t)(b * SEQ + 64 * kt0) * 64, 64, P + (size_t)(b * SEQ + 64 * kt0) * NP + C_KV + 320, NP, tid);
            for (int kt = kt0; kt <= qt; ++kt) {
                __syncthreads();
                nsa_store(st, Kt, Vt, tid);
                __syncthreads();
                if (kt < qt) st = nsa_load(KW + (size_t)(b * SEQ + 64 * (kt + 1)) * 64, 64, P + (size_t)(b * SEQ + 64 * (kt + 1)) * NP + C_KV + 320, NP, tid);
                nsa_tile_mfma(Kt, Vt, btlh, qf, n, hh, 64 * kt, tq, true, tq - 511, m, l, o);
            }
            const float inv = l > 0.f ? gate[2] / l : 0.f;
#pragma unroll
            for (int db = 0; db < 2; ++db)
#pragma unroll
                for (int r = 0; r < 16; ++r) yacc[db][r] += inv * o[db][r];
        }
#pragma unroll
        for (int db = 0; db < 2; ++db)
#pragma unroll
            for (int rq = 0; rq < 4; ++rq) { u32x2 w; w.x = pk2(yacc[db][4 * rq], yacc[db][4 * rq + 1]); w.y = pk2(yacc[db][4 * rq + 2], yacc[db][4 * rq + 3]);
                *(u32x2*)(Y + (size_t)tok * DM + 512 + h * 64 + db * 32 + 8 * rq + 4 * hh) = w; }
        __syncthreads();
    }
}

constexpr int RT_PITCH = 2064;
__device__ __forceinline__ void ph_router(const Args& a, int l, const float* Xin_, const bf16* Dm, LAS unsigned char* lds, int bid, int G, int tid, int wave, int lane) {
    LAS unsigned char* Ht = lds;
    LAS float* LG = (LAS float*)(lds + 32 * RT_PITCH);
    LAS int* lcnt = (LAS int*)(lds + 32 * RT_PITCH + 64 * 33 * 4); LAS int* asg_e = lcnt + 32; LAS int* asg_p = asg_e + 256; LAS float* asg_w = (LAS float*)(asg_p + 256); LAS int* gbase = (LAS int*)(asg_w + 256);
    bf16* H2 = (bf16*)(a.ws + WS_XN); unsigned* cnt = (unsigned*)(a.ws + WS_CTL) + CW_CNT + 64 * l;
    int* EIDX = (int*)(a.ws + WS_EIDX); int* EPOS = (int*)(a.ws + WS_EPOS); float* EW = (float*)(a.ws + WS_EW);
    const float* fw = a.in[17] + (size_t)l * DM; const float* rb = a.in[19] + l * NE;
    const bf16* RWH = (const bf16*)(a.ws + WS_RWH) + (size_t)l * NE * DM; const bf16* RWL = (const bf16*)(a.ws + WS_RWL) + (size_t)l * NE * DM;
    for (int u = bid; u < NT / 64; u += G) {
        const int tok0 = u * 64;
        if (tid < 32) lcnt[tid] = 0;
#pragma unroll 1
        for (int hf = 0; hf < 2; ++hf) {
            __syncthreads();
#pragma unroll 1
            for (int i = 0; i < 4; ++i) { const int tl = 4 * wave + i, tok = tok0 + 32 * hf + tl;
                f32x4 v[4]; float ss = 0.f;
#pragma unroll
                for (int j = 0; j < 4; ++j) { v[j] = *(const f32x4*)(Xin_ + (size_t)tok * DM + 4 * (64 * j + lane)); const u32x2 dd = *(const u32x2*)(Dm + (size_t)tok * DM + 4 * (64 * j + lane));
                    v[j].x += bf_lo(dd.x); v[j].y += bf_hi(dd.x); v[j].z += bf_lo(dd.y); v[j].w += bf_hi(dd.y); ss += (v[j].x * v[j].x + v[j].y * v[j].y) + (v[j].z * v[j].z + v[j].w * v[j].w); }
                const float r = rsqrtf(wave_sum(ss) * (1.0f / DM) + EPS);
#pragma unroll
                for (int j = 0; j < 4; ++j) { const f32x4 y = v[j] * r * *(const f32x4*)(fw + 4 * (64 * j + lane));
                    u32x2 o; o.x = pk2(y.x, y.y); o.y = pk2(y.z, y.w); *(u32x2*)(H2 + (size_t)tok * DM + 4 * (64 * j + lane)) = o;
                    *(LAS u32x2*)(Ht + tl * RT_PITCH + 8 * (64 * j + lane)) = o; } }
            __syncthreads();
            if (wave < 2) { const int r = lane & 15, q = lane >> 4; f32x4 acc0 = {0.f, 0.f, 0.f, 0.f}, acc1 = {0.f, 0.f, 0.f, 0.f};
                const LAS unsigned char* arow = Ht + (16 * wave + r) * RT_PITCH + q * 16;
                const bf16* bh = RWH + (size_t)r * DM + 8 * q; const bf16* bl = RWL + (size_t)r * DM + 8 * q;
#pragma unroll 4
                for (int s = 0; s < 32; ++s) { const bf16x8 af = *(const LAS bf16x8*)(arow + s * 64);
                    acc0 = __builtin_amdgcn_mfma_f32_16x16x32_bf16(af, *(const bf16x8*)(bh + 32 * s), acc0, 0, 0, 0); acc0 = __builtin_amdgcn_mfma_f32_16x16x32_bf16(af, *(const bf16x8*)(bl + 32 * s), acc0, 0, 0, 0);
                    acc1 = __builtin_amdgcn_mfma_f32_16x16x32_bf16(af, *(const bf16x8*)(bh + 16 * DM + 32 * s), acc1, 0, 0, 0); acc1 = __builtin_amdgcn_mfma_f32_16x16x32_bf16(af, *(const bf16x8*)(bl + 16 * DM + 32 * s), acc1, 0, 0, 0); }
                const float b0 = rb[r], b1 = rb[16 + r];
#pragma unroll
                for (int i = 0; i < 4; ++i) { LAS float* lg = LG + (32 * hf + 16 * wave + 4 * q + i) * 33; lg[r] = acc0[i] + b0; lg[16 + r] = acc1[i] + b1; } }
        }
        __syncthreads();
        if (tid < 64) { const LAS float* lg = LG + tid * 33; unsigned used = 0u; float tv[4]; int ti[4];
#pragma unroll
            for (int qn = 0; qn < 4; ++qn) { float best = -3.0e38f; int bi = 0;
                for (int e = 0; e < NE; ++e) { const float v = lg[e]; if (!((used >> e) & 1u) && v > best) { best = v; bi = e; } }
                used |= 1u << bi; tv[qn] = best; ti[qn] = bi; }
            float ew[4], es = 0.f;
#pragma unroll
            for (int qn = 0; qn < 4; ++qn) { ew[qn] = __expf(tv[qn] - tv[0]); es += ew[qn]; }
#pragma unroll
            for (int qn = 0; qn < 4; ++qn) { const int p = __hip_atomic_fetch_add(&lcnt[ti[qn]], 1, __ATOMIC_RELAXED, __HIP_MEMORY_SCOPE_WORKGROUP); asg_e[tid * 4 + qn] = ti[qn]; asg_p[tid * 4 + qn] = p; asg_w[tid * 4 + qn] = ew[qn] / es; } }
        __syncthreads();
        if (tid < 32) gbase[tid] = (int)atomicAdd(&cnt[tid], (unsigned)lcnt[tid]);
        __syncthreads();
        if (tid < 256) { const int tok = tok0 + (tid >> 2), k = tid & 3, e = asg_e[tid];
            EIDX[(size_t)tok * 4 + k] = e; EPOS[(size_t)tok * 4 + k] = gbase[e] + asg_p[tid]; EW[(size_t)tok * 4 + k] = asg_w[tid]; }
        __syncthreads();
    }
}

__device__ __forceinline__ void build_tiles(const unsigned* cnt, LAS int* TS, LAS int* TE, int tid) {
    if (tid == 0) { int acc = 0;
        for (int e = 0; e < NE; ++e) { TS[e] = acc; const int nt = (int)((cnt[e] + 255u) >> 8); for (int i = 0; i < nt; ++i) TE[acc + i] = e; acc += nt; }
        TS[NE] = acc; }
    __syncthreads();
}

__device__ __forceinline__ void ph_gather(const Args& a, int l, LAS unsigned char* lds, int gw, int NGW, int tid, int lane) {
    LAS int* TS = (LAS int*)(lds + TS_OFF); LAS int* TE = (LAS int*)(lds + TE_OFF);
    build_tiles((const unsigned*)(a.ws + WS_CTL) + CW_CNT + 64 * l, TS, TE, tid);
    const bf16* H2 = (const bf16*)(a.ws + WS_XN); bf16* XS = (bf16*)(a.ws + WS_XS);
    const int* EIDX = (const int*)(a.ws + WS_EIDX); const int* EPOS = (const int*)(a.ws + WS_EPOS); int* SLOT = (int*)(a.ws + WS_SLOT);
    for (int tok = gw; tok < NT; tok += NGW) {
        int slot = 0;
        if (lane < 4) { const int e = EIDX[(size_t)tok * 4 + lane]; slot = TS[e] * 256 + EPOS[(size_t)tok * 4 + lane]; SLOT[(size_t)tok * 4 + lane] = slot; }
        const u32x4 r0 = *(const u32x4*)(H2 + (size_t)tok * DM + 8 * lane), r1 = *(const u32x4*)(H2 + (size_t)tok * DM + 512 + 8 * lane);
#pragma unroll
        for (int k = 0; k < 4; ++k) { const int sk = __shfl(slot, k); *(u32x4*)(XS + (size_t)sk * DM + 8 * lane) = r0; *(u32x4*)(XS + (size_t)sk * DM + 512 + 8 * lane) = r1; }
    }
}

__device__ __forceinline__ void ph_combine(const Args& a, const float* Xin_, const bf16* Dm, float* Xo, const float* next_norm_w, int gw, int NGW, int lane) {
    const bf16* YS = (const bf16*)(a.ws + WS_YS); const int* SLOT = (const int*)(a.ws + WS_SLOT); const float* EW = (const float*)(a.ws + WS_EW); bf16* XN = (bf16*)(a.ws + WS_XN);
    for (int tok = gw; tok < NT; tok += NGW) {
        int slot = 0; float wgt = 0.f;
        if (lane < 4) { slot = SLOT[(size_t)tok * 4 + lane]; wgt = EW[(size_t)tok * 4 + lane]; }
        f32x4 v[4];
#pragma unroll
        for (int j = 0; j < 4; ++j) { v[j] = *(const f32x4*)(Xin_ + (size_t)tok * DM + 4 * (64 * j + lane)); const u32x2 dd = *(const u32x2*)(Dm + (size_t)tok * DM + 4 * (64 * j + lane));
            v[j].x += bf_lo(dd.x); v[j].y += bf_hi(dd.x); v[j].z += bf_lo(dd.y); v[j].w += bf_hi(dd.y); }
#pragma unroll
        for (int k = 0; k < 4; ++k) { const int sk = __shfl(slot, k); const float wk = __shfl(wgt, k);
#pragma unroll
            for (int j = 0; j < 4; ++j) { const u32x2 y = *(const u32x2*)(YS + (size_t)sk * DM + 4 * (64 * j + lane));
                v[j].x += wk * bf_lo(y.x); v[j].y += wk * bf_hi(y.x); v[j].z += wk * bf_lo(y.y); v[j].w += wk * bf_hi(y.y); } }
#pragma unroll
        for (int j = 0; j < 4; ++j) *(f32x4*)(Xo + (size_t)tok * DM + 4 * (64 * j + lane)) = v[j];
        if (next_norm_w) rms_row_to_bf16(v, next_norm_w, XN + (size_t)tok * DM, lane);
    }
}

struct Tid { int tid, lane, wave; };
__device__ __forceinline__ Tid fresh_tid() { int t = threadIdx.x; asm volatile("" : "+v"(t)); Tid r; r.tid = t; r.lane = t & 63; r.wave = __builtin_amdgcn_readfirstlane(t >> 6); return r; }
#define FT() Args A_ = args_k; { unsigned char* w_ = args_k.ws; asm volatile("" : "+s"(w_)); A_.ws = w_; } const Args& args = A_; const Tid T_ = fresh_tid(); const int tid = T_.tid, lane = T_.lane, wave = T_.wave, gw = bid * NWAVES + wave; (void)tid; (void)lane; (void)wave; (void)gw
constexpr int PH_PER_LAYER = 11, NPH = 2 + NLAYER * PH_PER_LAYER;

#if SINGLE_LAUNCH
#define BARPARM , unsigned* barw, unsigned& bark
#define BARARG , barw, bark
#define GRID_BAR() cnt_barrier(barw, bark)
#else
#define BARPARM
#define BARARG
#define GRID_BAR() do {} while (0)
#endif
#define IN(k) (lo <= (k) && (k) < hi)
#define SEAM(k) do { if (IN(k) && IN((k) + 1)) GRID_BAR(); } while (0)
template <int l>
__device__ __forceinline__ void run_layer(const Args& args_k, LAS unsigned char* lds, int lo, int hi, int G, int bid, int NGW BARPARM) {
        const int pb = 2 + l * PH_PER_LAYER;
#define Xin ((l == 0) ? args.in[0] : (const float*)(args.ws + WS_XB))
#define X1 ((float*)(args.ws + WS_XA))
#define Xout ((l == NLAYER - 1) ? args.out : (float*)(args.ws + WS_XB))
        if (IN(pb + 0)) {
            FT(); pg8::Gemm g{(const pg8::bf16_t*)(args.ws + WS_XN), (const pg8::bf16_t*)(args.ws + WS_WIN) + (size_t)l * NP * DM, NT, NP, DM};
            pg8::StaticOrder S; S.init(NT, NP, G, bid);
            pg8::EpiBf16Plain E{(pg8::bf16_t*)(args.ws + WS_P), NP};
            pg8::gemm_phase<pg8::EpiBf16Plain, pg8::StaticOrder, true, true>(lds, g, S, E);
        } SEAM(pb + 0);
        if (IN(pb + 1)) { { FT(); ph_compress_mfma(args, l, lds, bid, G, tid, wave, lane); } { FT(); ph_m1(args, l, lds, bid, G, tid, wave, lane); } } SEAM(pb + 1);
        if (IN(pb + 2)) { FT(); ph_dn_chunk_mfma(args, lds, bid, G, tid, wave, lane); } SEAM(pb + 2);
        if (IN(pb + 3)) {
            const bool small = G <= 64;
            if (small || bid < 32) { FT(); ph_dn_scan_mfma(args, lds, bid, small ? G : 32, tid, wave, lane); }
            if (small || bid >= 32) { FT(); ph_nsa_mfma(args, lds, small ? bid : bid - 32, small ? G : G - 32, tid, wave, lane); } } SEAM(pb + 3);
        if (IN(pb + 4)) { FT(); ph_dn_out(args, l, gw, NGW, lane); } SEAM(pb + 4);
        if (IN(pb + 5)) {
            FT(); pg8::Gemm g{(const pg8::bf16_t*)(args.ws + WS_Y), (const pg8::bf16_t*)(args.ws + WS_WOUT) + (size_t)l * DM * DM, NT, DM, DM};
            pg8::StaticOrder S; S.init(NT, DM, G, bid);
            pg8::EpiBf16Plain E{(pg8::bf16_t*)(args.ws + WS_XA), DM};
            pg8::gemm_phase<pg8::EpiBf16Plain, pg8::StaticOrder, true, true>(lds, g, S, E);
        } SEAM(pb + 5);
        if (IN(pb + 6)) { FT(); ph_router(args, l, Xin, (const bf16*)(args.ws + WS_XA), lds, bid, G, tid, wave, lane); } SEAM(pb + 6);
        if (IN(pb + 7)) { FT(); ph_gather(args, l, lds, gw, NGW, tid, lane); } SEAM(pb + 7);
        if (IN(pb + 8)) {
            FT(); LAS int* TS = (LAS int*)(lds + TS_OFF); LAS int* TE = (LAS int*)(lds + TE_OFF);
            build_tiles((const unsigned*)(args.ws + WS_CTL) + CW_CNT + 64 * l, TS, TE, tid);
            const int ntiles = __builtin_amdgcn_readfirstlane(TS[NE]);
            pg8::Gemm g{(const pg8::bf16_t*)(args.ws + WS_XS), (const pg8::bf16_t*)(args.ws + WS_WGU) + (size_t)l * NE * 2048 * DM, ntiles * 256, NE * 2048, DM};
            pg8::MoeOrder<8> S{ntiles, G, bid, (const LAS int*)TE};
            pg8::EpiSwiglu E{(pg8::bf16_t*)(args.ws + WS_ACT), args.in[21] + (size_t)l * NE * 2048};
            pg8::gemm_phase<pg8::EpiSwiglu, pg8::MoeOrder<8>, true, true>(lds, g, S, E);
        } SEAM(pb + 8);
        if (IN(pb + 9)) {
            FT(); LAS int* TS = (LAS int*)(lds + TS_OFF); LAS int* TE = (LAS int*)(lds + TE_OFF);
            build_tiles((const unsigned*)(args.ws + WS_CTL) + CW_CNT + 64 * l, TS, TE, tid);
            const int ntiles = __builtin_amdgcn_readfirstlane(TS[NE]);
            pg8::Gemm g{(const pg8::bf16_t*)(args.ws + WS_ACT), (const pg8::bf16_t*)(args.ws + WS_WD) + (size_t)l * NE * DM * DM, ntiles * 256, NE * DM, DM};
            pg8::MoeOrder<4> S{ntiles, G, bid, (const LAS int*)TE};
            pg8::EpiDown E{(pg8::bf16_t*)(args.ws + WS_YS), args.in[23] + (size_t)l * NE * DM};
            pg8::gemm_phase<pg8::EpiDown, pg8::MoeOrder<4>, true, true>(lds, g, S, E);
        } SEAM(pb + 9);
        if (IN(pb + 10)) { FT(); ph_combine(args, Xin, (const bf16*)(args.ws + WS_XA), Xout, (l + 1 < NLAYER) ? args.in[1] + (size_t)(l + 1) * DM : nullptr, gw, NGW, lane); }
        if (l + 1 < NLAYER) SEAM(pb + 10);
    }

__global__ void __launch_bounds__(NTHR, 2) fwd_kernel(Args args_k) {
    extern __shared__ __attribute__((aligned(16))) unsigned char lds_raw[];
    LAS unsigned char* lds = (LAS unsigned char*)lds_raw;
    const int G = gridDim.x, bid = blockIdx.x, NGW = G * NWAVES;
    for (int u = threadIdx.x; u < (LDS_BYTES - LDSCTL_OFF) / 4; u += NTHR) ((LAS unsigned*)(lds + LDSCTL_OFF))[u] = 0u;
    __syncthreads();
#if SINGLE_LAUNCH
    unsigned* barw = (unsigned*)(args_k.ws + WS_CTL) + CW_BAR; unsigned bark = 0u;
#endif
    const int lo = args_k.ph_lo, hi = args_k.ph_hi;

    if (IN(0)) { FT(); ph_prologue(args, lds, gw, NGW, wave, lane); } SEAM(0);
    if (IN(1)) { FT(); ph_norm0(args, gw, NGW, lane); } SEAM(1);

    run_layer<0>(args_k, lds, lo, hi, G, bid, NGW BARARG);
    run_layer<1>(args_k, lds, lo, hi, G, bid, NGW BARARG);
#undef IN
#undef SEAM
}

extern "C" void kernel_launch(void* const* d_in, const int* in_sizes, int n_in, void* d_out, int out_size, void* d_ws, size_t ws_size, hipStream_t stream) {
    static int grid = 0;
    if (grid == 0) {
        if (n_in != 25 || in_sizes[0] != NT * DM || out_size != NT * DM || ws_size < WS_END) {
            fprintf(stderr, "kernel_launch: unexpected problem (n_in %d, in0 %d, out %d, ws %zu < %zu); nothing launched\n", n_in, n_in > 0 ? in_sizes[0] : -1, out_size, ws_size, (size_t)WS_END); grid = -1; return; }
        int dev = 0, cus = 0, per_cu = 0;
        if (hipGetDevice(&dev) != hipSuccess || hipDeviceGetAttribute(&cus, hipDeviceAttributeMultiprocessorCount, dev) != hipSuccess) { grid = -1; return; }
        if (hipFuncSetAttribute((const void*)fwd_kernel, hipFuncAttributeMaxDynamicSharedMemorySize, LDS_BYTES) != hipSuccess) { fprintf(stderr, "kernel_launch: hipFuncSetAttribute failed\n"); grid = -1; return; }
        if (hipOccupancyMaxActiveBlocksPerMultiprocessor(&per_cu, (const void*)fwd_kernel, NTHR, LDS_BYTES) != hipSuccess || per_cu < 1)
            fprintf(stderr, "kernel_launch: note: occupancy query reports %d workgroups per CU\n", per_cu);
        (void)hipGetLastError();
        grid = cus;
    }
    if (grid < 0) return;
    if (hipMemsetAsync((char*)d_ws + WS_CTL, 0, CTL_ZERO_BYTES, stream) != hipSuccess) { fprintf(stderr, "kernel_launch: memset failed\n"); return; }
    Args a{};
    for (int i = 0; i < 25; ++i) a.in[i] = (const float*)d_in[i];
    a.out = (float*)d_out; a.ws = (unsigned char*)d_ws;
#if SINGLE_LAUNCH
    a.ph_lo = 0; a.ph_hi = NPH;
    hipLaunchKernelGGL(fwd_kernel, dim3(grid), dim3(NTHR), LDS_BYTES, stream, a);
#else
    for (int ph = 0; ph < NPH; ++ph) { a.ph_lo = ph; a.ph_hi = ph + 1; hipLaunchKernelGGL(fwd_kernel, dim3(grid), dim3(NTHR), LDS_BYTES, stream, a); }
#endif
}
```

```cpp
#include <hip/hip_runtime.h>
#include <cstdio>
#include <cstdint>
#include <cstddef>
namespace pg8 {
#define PG8_LAS __attribute__((address_space(3)))
typedef unsigned short bf16_t;
typedef short bf16x8 __attribute__((ext_vector_type(8)));
typedef float f32x4 __attribute__((ext_vector_type(4)));
typedef unsigned u32x4 __attribute__((ext_vector_type(4)));
constexpr int BM = 256, BK = 64, HALF = 128, HTB = HALF * BK * 2  , STAGE_BYTES = 8 * HTB, NXCD = 8, WGM = 8;

__host__ __device__ __forceinline__ int lds_byte(int r, int c) { const int st = (r >> 4) * 2 + (c >> 5), rr = r & 15, cc = c & 31, ob = rr * 64 + cc * 2; return st * 1024 + (ob ^ (((ob >> 9) & 1) << 5)); }
__host__ __device__ __forceinline__ void stage_rc(int b, int& R, int& C) { const int st = b / 1024, sb = b % 1024, swz = sb ^ (((sb >> 9) & 1) << 5); R = (st >> 1) * 16 + swz / 64; C = (st & 1) * 32 + (swz % 64) / 2; }
__host__ __device__ __forceinline__ int perm32(int rho) { const int n = rho >> 4, i = rho & 15; return 8 * (i >> 2) + 4 * n + (i & 3); }

struct Unit { int pm, pn; };
struct Gemm { const bf16_t* A; const bf16_t* Bt; int M, N, K; };

struct StaticOrder {
    int nM, nN, nwg, G, c;
    __host__ __device__ void init(int M, int N, int G_, int c_) { nM = M / BM; nN = N / BM; nwg = nM * nN; G = G_; c = c_; }
    __host__ __device__ bool next(int i, Unit& u) const {
        const long L = (long)i * G + c; if (L >= nwg) return false;
        int wgid = (int)L; { const int q = nwg / NXCD, r = nwg % NXCD, xcd = wgid % NXCD, off = wgid / NXCD; wgid = (xcd < r ? xcd * (q + 1) : r * (q + 1) + (xcd - r) * q) + off; }
        const int nig = WGM * nN, gid = wgid / nig, fm = gid * WGM, gsz = (nM - fm) < WGM ? (nM - fm) : WGM;
        u.pm = fm + ((wgid % nig) % gsz); u.pn = (wgid % nig) / gsz; return true;
    }
    __device__ __forceinline__ void a_ready(const Unit&) const {}
    __device__ __forceinline__ void done(const Unit&) const {}
};

__device__ __forceinline__ unsigned cvt_pk_bf16(float lo, float hi) { unsigned r; asm volatile("v_cvt_pk_bf16_f32 %0, %1, %2" : "=v"(r) : "v"(lo), "v"(hi)); return r; }

struct EpiBf16Plain {
    static constexpr bool PERM = true, AFTER_DRAIN = false;
    bf16_t* O; int ldc;
    __device__ __forceinline__ void operator()(const f32x4 (&acc)[2][2][4][2], const Unit& u, int wr, int wc, int fr, int fq) const {
        const int row0 = u.pm * BM + wr * 64 + fr, col0 = u.pn * BM + wc * 32 + 8 * fq;
#pragma unroll
        for (int ai = 0; ai < 2; ++ai)
#pragma unroll
            for (int m = 0; m < 4; ++m) { bf16_t* rowp = O + (size_t)(row0 + ai * HALF + m * 16) * ldc + col0;
#pragma unroll
                for (int bj = 0; bj < 2; ++bj) { const f32x4 v0 = acc[ai][bj][m][0], v1 = acc[ai][bj][m][1];
                    u32x4 w; w.x = cvt_pk_bf16(v0[0], v0[1]); w.y = cvt_pk_bf16(v0[2], v0[3]); w.z = cvt_pk_bf16(v1[0], v1[1]); w.w = cvt_pk_bf16(v1[2], v1[3]);
                    *(u32x4*)(rowp + bj * HALF) = w; } }
    }
};
struct EpiResF32 {
    static constexpr bool PERM = false, AFTER_DRAIN = false;
    const float* base; float* out; int ldc;
    __device__ __forceinline__ void operator()(const f32x4 (&acc)[2][2][4][2], const Unit& u, int wr, int wc, int fr, int fq) const {
        const int row0 = u.pm * BM + wr * 64 + fr, col0 = u.pn * BM + wc * 32 + 4 * fq;
#pragma unroll
        for (int ai = 0; ai < 2; ++ai)
#pragma unroll
            for (int m = 0; m < 4; ++m) { const size_t off = (size_t)(row0 + ai * HALF + m * 16) * ldc + col0;
#pragma unroll
                for (int bj = 0; bj < 2; ++bj)
#pragma unroll
                    for (int n = 0; n < 2; ++n) { const f32x4 b = *(const f32x4*)(base + off + bj * HALF + n * 16); *(f32x4*)(out + off + bj * HALF + n * 16) = b + acc[ai][bj][m][n]; } }
    }
};
struct EpiSwiglu {
    static constexpr bool PERM = true, AFTER_DRAIN = false;
    bf16_t* O; const float* bgu;
    __device__ __forceinline__ void operator()(const f32x4 (&acc)[2][2][4][2], const Unit& u, int wr, int wc, int fr, int fq) const {
        const int e = u.pn >> 3, pnl = u.pn & 7;
        const int row0 = u.pm * BM + wr * 64 + fr, gcol = pnl * 128 + wc * 32 + 8 * fq;
        const float* bg = bgu + (size_t)e * 2048 + gcol;
        f32x4 bgv[2], buv[2];
#pragma unroll
        for (int n = 0; n < 2; ++n) { bgv[n] = *(const f32x4*)(bg + 4 * n); buv[n] = *(const f32x4*)(bg + 1024 + 4 * n); }
#pragma unroll
        for (int ai = 0; ai < 2; ++ai)
#pragma unroll
            for (int m = 0; m < 4; ++m) { bf16_t* rowp = O + (size_t)(row0 + ai * HALF + m * 16) * 1024 + gcol;
                float r[8];
#pragma unroll
                for (int n = 0; n < 2; ++n) { const f32x4 gv = acc[ai][0][m][n] + bgv[n], uv = acc[ai][1][m][n] + buv[n];
#pragma unroll
                    for (int j = 0; j < 4; ++j) { const float g = fminf(gv[j], 7.0f), up = fminf(fmaxf(uv[j], -7.0f), 7.0f);
                        const float sg = __builtin_amdgcn_rcpf(1.0f + __expf(-1.702f * g)); r[n * 4 + j] = (up + 1.0f) * g * sg; } }
                u32x4 w; w.x = cvt_pk_bf16(r[0], r[1]); w.y = cvt_pk_bf16(r[2], r[3]); w.z = cvt_pk_bf16(r[4], r[5]); w.w = cvt_pk_bf16(r[6], r[7]);
                *(u32x4*)rowp = w; }
    }
};
struct EpiDown {
    static constexpr bool PERM = true, AFTER_DRAIN = false;
    bf16_t* O; const float* bd;
    __device__ __forceinline__ void operator()(const f32x4 (&acc)[2][2][4][2], const Unit& u, int wr, int wc, int fr, int fq) const {
        const int e = u.pn >> 2, pnl = u.pn & 3;
        const int row0 = u.pm * BM + wr * 64 + fr, col0 = pnl * BM + wc * 32 + 8 * fq;
        const float* bp = bd + (size_t)e * 1024 + col0;
        f32x4 bv[2][2];
#pragma unroll
        for (int bj = 0; bj < 2; ++bj)
#pragma unroll
            for (int n = 0; n < 2; ++n) bv[bj][n] = *(const f32x4*)(bp + bj * HALF + 4 * n);
#pragma unroll
        for (int ai = 0; ai < 2; ++ai)
#pragma unroll
            for (int m = 0; m < 4; ++m) { bf16_t* rowp = O + (size_t)(row0 + ai * HALF + m * 16) * 1024 + col0;
#pragma unroll
                for (int bj = 0; bj < 2; ++bj) { const f32x4 v0 = acc[ai][bj][m][0] + bv[bj][0], v1 = acc[ai][bj][m][1] + bv[bj][1];
                    u32x4 w; w.x = cvt_pk_bf16(v0[0], v0[1]); w.y = cvt_pk_bf16(v0[2], v0[3]); w.z = cvt_pk_bf16(v1[0], v1[1]); w.w = cvt_pk_bf16(v1[2], v1[3]);
                    *(u32x4*)(rowp + bj * HALF) = w; } }
    }
};
template <int NPN> struct MoeOrder {
    int ntiles, G, c; const PG8_LAS int* texp;
    __device__ __forceinline__ bool next(int i, Unit& u) const {
        constexpr int MT = 32 / NPN; int mt, pn;
        if (G == 256) { const int chunk = i * 8 + (c & 7), r = c >> 3; pn = r / MT; mt = chunk * MT + (r % MT); }
        else { const int L = i * G + c; mt = L / NPN; pn = L % NPN; }
        mt = __builtin_amdgcn_readfirstlane(mt); if (mt >= ntiles) return false;
        const int e = __builtin_amdgcn_readfirstlane(texp[mt]);
        u.pm = mt; u.pn = e * NPN + pn; return true;
    }
    __device__ __forceinline__ void a_ready(const Unit&) const {}
    __device__ __forceinline__ void done(const Unit&) const {}
};

template <class Epi, class Sched, bool ALIGN_EPI = false, bool SP2 = false>
__device__ __forceinline__ void gemm_phase(PG8_LAS unsigned char* lds, const Gemm g, const Sched& S, const Epi& E) {
    int tid_ = threadIdx.x; asm volatile("" : "+v"(tid_));
    const int tid = tid_, wid = __builtin_amdgcn_readfirstlane(tid >> 6), lane = tid & 63, wr = wid >> 2, wc = wid & 3, fr = lane & 15, fq = lane >> 4;
    const int K = g.K, nt = K / BK;
    unsigned voffA[2], voffB[2];
#pragma unroll
    for (int i = 0; i < 2; ++i) { int R, C; stage_rc(tid * 16 + i * 8192, R, C); const int Rb = Epi::PERM ? ((R & ~31) + perm32(R & 31)) : R;
        voffA[i] = (unsigned)(R * K + C) * 2u; voffB[i] = (unsigned)(Rb * K + C) * 2u; }
    const size_t kstep = (size_t)(BK * 2);
    const size_t hstep = (size_t)HALF * K * 2;
    const size_t tstep = 2 * hstep;
    const unsigned ldsw = (unsigned)wid * 1024u;
    const int aoff = lds_byte(wr * 64 + fr, fq * 8), boff = lds_byte(wc * 32 + fr, fq * 8);
#define PG8_SA(b, h) (((b) * 2 + (h)) * HTB)
#define PG8_SB(b, h) ((4 + (b) * 2 + (h)) * HTB)
#define PG8_STAGE(bufoff, gbase, voff) do { _Pragma("unroll") for (int _i = 0; _i < 2; ++_i) \
        __builtin_amdgcn_global_load_lds((const unsigned*)((const char*)(gbase) + (voff)[_i]), (PG8_LAS unsigned*)(lds + (bufoff) + ldsw + _i * 8192), 16, 0, 0); } while (0)
#define PG8_LDA(dst, b, h) do { _Pragma("unroll") for (int m = 0; m < 4; ++m) _Pragma("unroll") for (int k = 0; k < 2; ++k) dst[m][k] = *(const PG8_LAS bf16x8*)(lds + PG8_SA(b, h) + aoff + m * 2048 + k * 1024); } while (0)
#define PG8_LDB(dst, b, h) do { _Pragma("unroll") for (int n = 0; n < 2; ++n) _Pragma("unroll") for (int k = 0; k < 2; ++k) dst[n][k] = *(const PG8_LAS bf16x8*)(lds + PG8_SB(b, h) + boff + n * 2048 + k * 1024); } while (0)
#define PG8_MMA(ai, bj, At, Bt) do { __builtin_amdgcn_s_setprio(1); _Pragma("unroll") for (int m = 0; m < 4; ++m) _Pragma("unroll") for (int n = 0; n < 2; ++n) _Pragma("unroll") for (int k = 0; k < 2; ++k) \
        acc[ai][bj][m][n] = __builtin_amdgcn_mfma_f32_16x16x32_bf16(Bt[n][k], At[m][k], acc[ai][bj][m][n], 0, 0, 0); __builtin_amdgcn_s_setprio(0); } while (0)
#define PG8_WAIT_V(n) asm volatile("s_waitcnt vmcnt(" #n ")" ::: "memory")
#define PG8_WAIT_L(n) asm volatile("s_waitcnt lgkmcnt(" #n ")" ::: "memory")
#define PG8_BAR __builtin_amdgcn_s_barrier()
#define PG8_SCHED __builtin_amdgcn_sched_barrier(0)
    Unit cur, nxt; int ui = 0;
    if (!S.next(0, cur)) return;
    f32x4 acc[2][2][4][2];
#pragma unroll
    for (int a = 0; a < 2; ++a)
#pragma unroll
        for (int b = 0; b < 2; ++b)
#pragma unroll
            for (int m = 0; m < 4; ++m)
#pragma unroll
                for (int n = 0; n < 2; ++n) acc[a][b][m][n] = (f32x4){0.f, 0.f, 0.f, 0.f};
    bf16x8 At[4][2], B0[2][2], B1[2][2];
    const char* cA = (const char*)g.A + (size_t)cur.pm * tstep; const char* cB = (const char*)g.Bt + (size_t)cur.pn * tstep;
    S.a_ready(cur);
    if constexpr (SP2) {
        PG8_STAGE(PG8_SB(0, 0), cB, voffB); PG8_STAGE(PG8_SB(0, 1), cB + hstep, voffB); PG8_STAGE(PG8_SA(0, 0), cA, voffA); PG8_STAGE(PG8_SA(0, 1), cA + hstep, voffA);
        if (wr == 1) PG8_BAR;
        PG8_WAIT_V(2); PG8_BAR;
        PG8_STAGE(PG8_SB(1, 0), cB + kstep, voffB); PG8_STAGE(PG8_SA(1, 0), cA + kstep, voffA); PG8_STAGE(PG8_SB(1, 1), cB + hstep + kstep, voffB);
        PG8_WAIT_V(6); PG8_BAR;
    } else {
        PG8_STAGE(PG8_SB(0, 0), cB, voffB); PG8_STAGE(PG8_SA(0, 0), cA, voffA); PG8_STAGE(PG8_SB(0, 1), cB + hstep, voffB); PG8_STAGE(PG8_SA(0, 1), cA + hstep, voffA);
        if (wr == 1) PG8_BAR;
        PG8_WAIT_V(4); PG8_BAR;
        PG8_STAGE(PG8_SB(1, 0), cB + kstep, voffB); PG8_STAGE(PG8_SA(1, 0), cA + kstep, voffA); PG8_STAGE(PG8_SB(1, 1), cB + hstep + kstep, voffB);
        PG8_WAIT_V(6); PG8_BAR;
    }
    for (;;) {
        const bool has_next = S.next(ui + 1, nxt);
        const char* nA = has_next ? (const char*)g.A + (size_t)nxt.pm * tstep : cA; const char* nB = has_next ? (const char*)g.Bt + (size_t)nxt.pn * tstep : cB;
        for (int t = 0; t < nt; t += 2) {
            const bool last = (t == nt - 2);
            const char* a1 = cA + (size_t)(t + 1) * kstep;
            const char* a2 = last ? nA : cA + (size_t)(t + 2) * kstep; const char* b2 = last ? nB : cB + (size_t)(t + 2) * kstep;
            const char* a3 = a2 + kstep; const char* b3 = b2 + kstep;
            if (last && has_next) S.a_ready(nxt);
            if constexpr (SP2) {
            PG8_LDB(B0, 0, 0); PG8_LDB(B1, 0, 1); PG8_SCHED; PG8_LDA(At, 0, 0); PG8_STAGE(PG8_SA(1, 1), a1 + hstep, voffA);
            PG8_WAIT_V(8); PG8_WAIT_L(0); PG8_BAR; PG8_MMA(0, 0, At, B0); PG8_MMA(0, 1, At, B1); PG8_BAR; PG8_SCHED;
            PG8_LDA(At, 0, 1); PG8_STAGE(PG8_SB(0, 0), b2, voffB); PG8_STAGE(PG8_SB(0, 1), b2 + hstep, voffB); PG8_STAGE(PG8_SA(0, 0), a2, voffA);
            PG8_WAIT_V(8); PG8_WAIT_L(0); PG8_BAR; PG8_MMA(1, 0, At, B0); PG8_MMA(1, 1, At, B1); PG8_BAR; PG8_SCHED;
            PG8_LDB(B0, 1, 0); PG8_LDB(B1, 1, 1); PG8_SCHED; PG8_LDA(At, 1, 0); PG8_STAGE(PG8_SA(0, 1), a2 + hstep, voffA);
            PG8_WAIT_V(8); PG8_WAIT_L(0); PG8_BAR; PG8_MMA(0, 0, At, B0); PG8_MMA(0, 1, At, B1); PG8_BAR; PG8_SCHED;
            PG8_LDA(At, 1, 1); PG8_STAGE(PG8_SB(1, 0), b3, voffB); PG8_STAGE(PG8_SB(1, 1), b3 + hstep, voffB); PG8_STAGE(PG8_SA(1, 0), a3, voffA);
            PG8_WAIT_V(8); PG8_WAIT_L(0); PG8_BAR; PG8_MMA(1, 0, At, B0); PG8_MMA(1, 1, At, B1); PG8_BAR; PG8_SCHED;
            } else {
            PG8_LDB(B0, 0, 0); PG8_SCHED; PG8_LDA(At, 0, 0); PG8_STAGE(PG8_SA(1, 1), a1 + hstep, voffA);
            PG8_WAIT_L(8); PG8_BAR; PG8_WAIT_L(0); PG8_MMA(0, 0, At, B0); PG8_BAR; PG8_SCHED;
            PG8_LDB(B1, 0, 1); PG8_STAGE(PG8_SB(0, 0), b2, voffB);
            PG8_BAR; PG8_WAIT_L(0); PG8_MMA(0, 1, At, B1); PG8_BAR;
            PG8_LDA(At, 0, 1); PG8_STAGE(PG8_SA(0, 0), a2, voffA);
            PG8_BAR; PG8_WAIT_L(0); PG8_MMA(1, 0, At, B0); PG8_BAR; PG8_SCHED;
            PG8_STAGE(PG8_SB(0, 1), b2 + hstep, voffB);
            PG8_WAIT_V(6); PG8_BAR; PG8_MMA(1, 1, At, B1); PG8_BAR;
            PG8_LDB(B0, 1, 0); PG8_SCHED; PG8_LDA(At, 1, 0); PG8_STAGE(PG8_SA(0, 1), a2 + hstep, voffA);
            PG8_WAIT_L(8); PG8_BAR; PG8_WAIT_L(0); PG8_MMA(0, 0, At, B0); PG8_BAR; PG8_SCHED;
            PG8_LDB(B1, 1, 1); PG8_STAGE(PG8_SB(1, 0), b3, voffB);
            PG8_BAR; PG8_WAIT_L(0); PG8_MMA(0, 1, At, B1); PG8_BAR;
            PG8_LDA(At, 1, 1); PG8_STAGE(PG8_SA(1, 0), a3, voffA);
            PG8_BAR; PG8_WAIT_L(0); PG8_MMA(1, 0, At, B0); PG8_BAR; PG8_SCHED;
            PG8_STAGE(PG8_SB(1, 1), b3 + hstep, voffB);
            PG8_WAIT_V(6); PG8_BAR; PG8_MMA(1, 1, At, B1); PG8_BAR;
            }
        }
        if constexpr (ALIGN_EPI) { if (wr == 0) PG8_BAR; }
        if constexpr (!Epi::AFTER_DRAIN) { E(acc, cur, wr, wc, fr, fq); S.done(cur); }
        if (!has_next) break;
#pragma unroll
        for (int a = 0; a < 2; ++a)
#pragma unroll
            for (int b = 0; b < 2; ++b)
#pragma unroll
                for (int m = 0; m < 4; ++m)
#pragma unroll
                    for (int n = 0; n < 2; ++n) acc[a][b][m][n] = (f32x4){0.f, 0.f, 0.f, 0.f};
        cur = nxt; cA = nA; cB = nB; ++ui;
        if constexpr (ALIGN_EPI) { if (wr == 1) PG8_BAR; }
    }
    PG8_WAIT_V(0);
    if constexpr (!ALIGN_EPI) { if (wr == 0) PG8_BAR; }
    PG8_BAR;
    if constexpr (Epi::AFTER_DRAIN) { E.fused(acc, cur, wr, wc, fr, fq, lds, wid, lane); S.done(cur); }
#undef PG8_SA
#undef PG8_SB
#undef PG8_STAGE
#undef PG8_LDA
#undef PG8_LDB
#undef PG8_MMA
#undef PG8_WAIT_V
#undef PG8_WAIT_L
#undef PG8_BAR
#undef PG8_SCHED
}
}


#define GAS __attribute__((address_space(1)))
typedef unsigned short bf16;
typedef float f32x4 __attribute__((ext_vector_type(4)));
typedef unsigned u32x4 __attribute__((ext_vector_type(4)));
typedef unsigned u32x2 __attribute__((ext_vector_type(2)));
typedef short bf16x8 __attribute__((ext_vector_type(8)));
typedef float f32x16 __attribute__((ext_vector_type(16)));

#ifndef SINGLE_LAUNCH
#define SINGLE_LAUNCH 1
#endif

constexpr int NB = 8, SEQ = 2048, DM = 1024, NT = NB * SEQ, NLAYER = 2;
constexpr int DIN = 3220, NP = 3328;
constexpr int C_Q = 0, C_K = 512, C_V = 1024, C_Z = 1536, C_NQ = 2048, C_KV = 2304, C_CU = 2688, C_A = 3200, C_B = 3204, C_G = 3208;
constexpr int NE = 32, MAXT = 288;
constexpr int NWAVES = 8, NTHR = 512;
constexpr float EPS = 1e-6f;

constexpr size_t MiB = 1u << 20;
constexpr size_t WS_CTL = 0, CTL_ZERO_BYTES = 1 * MiB;
constexpr size_t WS_BT = 1 * MiB;
constexpr size_t WS_KCMP = 1 * MiB + 256 * 1024, WS_VCMP = 1 * MiB + 512 * 1024;
constexpr size_t WS_G = 2 * MiB, WS_BETA = 2 * MiB + 256 * 1024, WS_GC = 2 * MiB + 512 * 1024;
constexpr size_t WS_EIDX = 3 * MiB, WS_EPOS = 3 * MiB + 256 * 1024, WS_EW = 3 * MiB + 512 * 1024, WS_SLOT = 3 * MiB + 768 * 1024;
constexpr size_t WS_WIN = 4 * MiB;
constexpr size_t WS_WOUT = 17 * MiB;
constexpr size_t WS_WGU = 22 * MiB;
constexpr size_t WS_WD = 278 * MiB;
constexpr size_t WS_XA = 406 * MiB, WS_XB = 470 * MiB;
constexpr size_t WS_XN = 534 * MiB;
constexpr size_t WS_P = 566 * MiB;
constexpr size_t WS_QN = 670 * MiB, WS_KN = 686 * MiB, WS_VC = 702 * MiB;
constexpr size_t WS_U = 718 * MiB, WS_W = 750 * MiB;
constexpr size_t WS_ATT = 782 * MiB;
constexpr size_t WS_O = 798 * MiB;
constexpr size_t WS_NQ = 830 * MiB;
constexpr size_t WS_KS = 846 * MiB, WS_KW = 848 * MiB;
constexpr size_t WS_Y = 850 * MiB;
constexpr size_t WS_XS = 882 * MiB, WS_ACT = 1026 * MiB, WS_YS = 1170 * MiB;
constexpr size_t WS_KT = 1314 * MiB, WS_VT = 1330 * MiB;
constexpr size_t WS_W1T = 1346 * MiB;
constexpr size_t WS_POSW = 1349 * MiB;
constexpr size_t WS_RWH = 1350 * MiB, WS_RWL = 1351 * MiB;
constexpr size_t WS_END = 1352 * MiB;

constexpr int CW_TMO = 0, CW_BAR = 4096, CW_CNT = 16384;

constexpr int RING_BYTES = 131072;
constexpr int LDSCTL_OFF = RING_BYTES, MISC_OFF = LDSCTL_OFF, TS_OFF = LDSCTL_OFF + 128, TE_OFF = LDSCTL_OFF + 320;
constexpr int LDS_BYTES = 147456;
static_assert(TE_OFF + MAXT * 4 + 64 <= LDS_BYTES, "LDS map");

#define XB_TMO      128
#define XB_XCNT(j)  (256  + 64 * (j))
#define XB_XSUB(j)  (1280 + 64 * (j))
#define XB_XGEN(j)  (2304 + 64 * (j))
#define XB_TOP      3328
#define XB_TOPGEN   3392
#define XCD_BAR_WORDS 3456
#define XB_SPIN_CAP (1u << 22)
#define LAS __attribute__((address_space(3)))

__device__ __forceinline__ unsigned xb_ld(unsigned* p)              { return __hip_atomic_load(p, __ATOMIC_RELAXED, __HIP_MEMORY_SCOPE_AGENT); }
__device__ __forceinline__ unsigned xb_add(unsigned* p, unsigned v) { return __hip_atomic_fetch_add(p, v, __ATOMIC_RELAXED, __HIP_MEMORY_SCOPE_AGENT); }
__device__ __forceinline__ unsigned xb_xcc_id() { return (unsigned)__builtin_amdgcn_s_getreg((3 << 11) | 20) & 0xFu; }
#define XB_SPIN(cond, bar) do { unsigned _sp = 0; while (cond) { __builtin_amdgcn_s_sleep(1); \
    if ((++_sp & 255u) == 0u) { if (xb_ld(&(bar)[XB_TMO])) break; if (_sp > XB_SPIN_CAP) { atomicAdd(&(bar)[XB_TMO], 1u); break; } } } } while (0)

struct XcdBarrier {
    unsigned* bar; unsigned x;
    volatile LAS unsigned* st;
};

__device__ __forceinline__ XcdBarrier xcd_barrier_post(unsigned* bar, volatile LAS unsigned* st) {
    XcdBarrier b; b.bar = bar; b.x = xb_xcc_id(); b.st = st;
    if (threadIdx.x == 0) (void)xb_add(&bar[XB_XCNT(b.x)], 1u);
    return b;
}
__device__ __forceinline__ void xcd_barrier_complete(unsigned* bar, unsigned x, unsigned& nloc, unsigned& nx) {
    const unsigned G = gridDim.x * gridDim.y * gridDim.z;
    unsigned sum, cnt, mine, sp = 0u;
    for (;;) {
        sum = 0u; cnt = 0u; mine = 0u;
#pragma unroll
        for (unsigned j = 0; j < 16; ++j) { const unsigned c = xb_ld(&bar[XB_XCNT(j)]); sum += c; cnt += (c > 0u) ? 1u : 0u; mine = (j == x) ? c : mine; }
        if (sum == G) break;
        __builtin_amdgcn_s_sleep(1);
        if ((++sp & 255u) == 0u) { if (xb_ld(&bar[XB_TMO])) break; if (sp > XB_SPIN_CAP) { atomicAdd(&bar[XB_TMO], 1u); break; } }
    }
    nloc = mine > 0u ? mine : 1u; nx = cnt > 0u ? cnt : 1u;
}

__device__ __forceinline__ void xcd_barrier(const XcdBarrier& b) {
    asm volatile("s_waitcnt vmcnt(0)" ::: "memory");
    __syncthreads();
    if (threadIdx.x == 0) {
        unsigned* bar = b.bar;
        __builtin_amdgcn_s_waitcnt(0);
        unsigned nloc = b.st[0], nx = b.st[1];
        if (nloc == 0u) { xcd_barrier_complete(bar, b.x, nloc, nx); b.st[0] = nloc; b.st[1] = nx; }
        const unsigned old = xb_add(&bar[XB_XSUB(b.x)], 1u);
        const unsigned gen = old / nloc;
        if (old + 1u == (gen + 1u) * nloc) {
            __builtin_amdgcn_fence(__ATOMIC_RELEASE, "agent");
            asm volatile("s_waitcnt vmcnt(0)" ::: "memory");
            const unsigned og = xb_add(&bar[XB_TOP], 1u);
            const unsigned tg = og / nx;
            if (og + 1u == (tg + 1u) * nx) xb_add(&bar[XB_TOPGEN], 1u);
            else XB_SPIN(xb_ld(&bar[XB_TOPGEN]) == tg, bar);
            __builtin_amdgcn_fence(__ATOMIC_ACQUIRE, "agent");
            xb_add(&bar[XB_XGEN(b.x)], 1u);
            asm volatile("s_waitcnt vmcnt(0)" ::: "memory");
        } else {
            XB_SPIN(xb_ld(&bar[XB_XGEN(b.x)]) == gen, bar);
            __builtin_amdgcn_fence(__ATOMIC_ACQUIRE, "agent");
            asm volatile("s_waitcnt vmcnt(0)" ::: "memory");
        }
    }
    __syncthreads();
}


__device__ __forceinline__ void cnt_barrier(unsigned* cw, unsigned& k) {
    asm volatile("s_waitcnt vmcnt(0)" ::: "memory");
    __syncthreads();
    if (threadIdx.x == 0) {
        __builtin_amdgcn_fence(__ATOMIC_RELEASE, "agent");
        asm volatile("s_waitcnt vmcnt(0)" ::: "memory");
        const unsigned G = gridDim.x;
        const unsigned old = xb_add(cw, 1u);
        if (old == G * (k + 1u) - 1u) xb_add(cw + 64, 1u);
        else { unsigned sp = 0; while (xb_ld(cw + 64) == k) { __builtin_amdgcn_s_sleep(1);
                if ((++sp & 255u) == 0u) { if (xb_ld(cw + 128)) break; if (sp > XB_SPIN_CAP) { atomicAdd(cw + 128, 1u); break; } } } }
        __builtin_amdgcn_fence(__ATOMIC_ACQUIRE, "agent");
        asm volatile("s_waitcnt vmcnt(0)" ::: "memory");
    }
    ++k;
    __syncthreads();
}
__device__ __forceinline__ float bf_lo(unsigned w) { return __uint_as_float(w << 16); }
__device__ __forceinline__ float bf_hi(unsigned w) { return __uint_as_float(w & 0xffff0000u); }
__device__ __forceinline__ float bf2f(bf16 v) { return __uint_as_float(((unsigned)v) << 16); }
__device__ __forceinline__ unsigned f2bf(float f) { unsigned u = __float_as_uint(f); return (u + 0x7fffu + ((u >> 16) & 1u)) >> 16; }
__device__ __forceinline__ unsigned pk2(float lo, float hi) { return f2bf(lo) | (f2bf(hi) << 16); }
__device__ __forceinline__ float wave_sum(float v) {
#pragma unroll
    for (int o = 1; o < 64; o <<= 1) v += __shfl_xor(v, o);
    return v;
}
__device__ __forceinline__ float wave_max(float v) {
#pragma unroll
    for (int o = 1; o < 64; o <<= 1) v = fmaxf(v, __shfl_xor(v, o));
    return v;
}
__device__ __forceinline__ float sigmoidf_(float x) { return 1.0f / (1.0f + __expf(-x)); }
__device__ __forceinline__ float siluf_(float x) { return x / (1.0f + __expf(-x)); }
#define LDS_WAIT() asm volatile("s_waitcnt lgkmcnt(0)" ::: "memory")

struct Args { const float* in[25]; float* out; unsigned char* ws; int ph_lo, ph_hi; };

__device__ __forceinline__ int map_win(int n);
__device__ __forceinline__ int map_gu(int n);
template <int MAP>
__device__ __forceinline__ void transpose_item(const float* W, int K, int N, bf16* WT, LAS float* scr, int item, int nblk, int lane) {
    const int kb = item / nblk, nb = item % nblk, k0 = 64 * kb, n0 = 32 * nb;
    const int nd = n0 + (lane & 31); const int src = MAP == 1 ? map_win(nd) : (MAP == 2 ? map_gu(nd) : nd);
#pragma unroll 8
    for (int i = 0; i < 32; ++i) { const int kk = 2 * i + (lane >> 5); scr[kk * 33 + (lane & 31)] = src >= 0 ? W[(size_t)(k0 + kk) * N + src] : 0.0f; }
    LDS_WAIT();
    const int c = lane & 7;
#pragma unroll
    for (int j = 0; j < 4; ++j) { const int n = (lane >> 3) + 8 * j; const LAS float* s = scr + (8 * c) * 33 + n;
        u32x4 o; o.x = pk2(s[0 * 33], s[1 * 33]); o.y = pk2(s[2 * 33], s[3 * 33]); o.z = pk2(s[4 * 33], s[5 * 33]); o.w = pk2(s[6 * 33], s[7 * 33]);
        *(u32x4*)(WT + (size_t)(n0 + n) * K + k0 + 8 * c) = o; }
    LDS_WAIT();
}
__device__ __forceinline__ int map_win(int n) {
    if (n < 2048) return n;
    if (n < C_KV) return 2056 + (n - C_NQ);
    if (n < C_CU) return 2312 + (n - C_KV);
    if (n < C_A) return 2708 + (n - C_CU);
    if (n < C_B) return 2048 + (n - C_A);
    if (n < C_G) return 2052 + (n - C_B);
    if (n < C_G + 12) return 2696 + (n - C_G);
    return -1;
}
__device__ __forceinline__ int map_gu(int n) { const int pn = n >> 8, r = n & 255; return (r < 128 ? 0 : 1024) + 128 * pn + (r & 127); }

__device__ __forceinline__ void ph_prologue(const Args& a, LAS unsigned char* lds, int gw, int NGW, int wave, int lane) {
    LAS float* scr = (LAS float*)(lds + wave * 16384);
    bf16* WinT = (bf16*)(a.ws + WS_WIN); bf16* WoutT = (bf16*)(a.ws + WS_WOUT); bf16* WguT = (bf16*)(a.ws + WS_WGU); bf16* WdT = (bf16*)(a.ws + WS_WD);
    constexpr int I_IN = 16 * (NP / 32), I_OUT = 16 * 32, I_GU = 16 * 64, I_D = 16 * 32;
    constexpr int N_IN = NLAYER * I_IN, N_OUT = NLAYER * I_OUT, N_GU = NLAYER * NE * I_GU, N_D = NLAYER * NE * I_D;
    for (int it = gw; it < N_IN + N_OUT + N_GU + N_D; it += NGW) {
        int r = it;
        if (r < N_IN) { const int l = r / I_IN; transpose_item<1>(a.in[2] + (size_t)l * DM * DIN, DM, DIN, WinT + (size_t)l * NP * DM, scr, r % I_IN, NP / 32, lane); continue; } r -= N_IN;
        if (r < N_OUT) { const int l = r / I_OUT; transpose_item<0>(a.in[16] + (size_t)l * DM * DM, DM, DM, WoutT + (size_t)l * DM * DM, scr, r % I_OUT, 32, lane); continue; } r -= N_OUT;
        if (r < N_GU) { const int le = r / I_GU; transpose_item<2>(a.in[20] + (size_t)le * DM * 2048, DM, 2048, WguT + (size_t)le * 2048 * DM, scr, r % I_GU, 64, lane); continue; } r -= N_GU;
        { const int le = r / I_D; transpose_item<0>(a.in[22] + (size_t)le * DM * DM, DM, DM, WdT + (size_t)le * DM * DM, scr, r % I_D, 32, lane); }
    }
    { bf16* W1T = (bf16*)(a.ws + WS_W1T);
        for (int it = gw; it < 4 * 128; it += NGW) { const int mtx = it >> 7; transpose_item<0>(a.in[10] + (size_t)mtx * 2048 * 128, 2048, 128, W1T + (size_t)mtx * 128 * 2048, scr, it & 127, 4, lane); }
        float* POSW = (float*)(a.ws + WS_POSW);
        const int id = gw * 64 + lane;
        if (id < 512) { const int mtx = id >> 7, n = id & 127; const float* w1 = a.in[10] + (size_t)mtx * 2048 * 128; const float* pos = a.in[9] + (size_t)mtx * 2048; float acc = 0.f;
            for (int k = 0; k < 2048; ++k) acc += pos[k] * w1[(size_t)k * 128 + n];
            POSW[id] = acc; } }
    { bf16* RWH = (bf16*)(a.ws + WS_RWH); bf16* RWL = (bf16*)(a.ws + WS_RWL);
        for (int i = gw * 64 + lane; i < NLAYER * NE * DM; i += NGW * 64) { const int d = i & (DM - 1), e = (i >> 10) & (NE - 1), l = i >> 15;
            const float w = a.in[18][((size_t)l * DM + d) * NE + e]; const unsigned hi = f2bf(w); const float lo = w - __uint_as_float(hi << 16);
            RWH[i] = (bf16)hi; RWL[i] = (bf16)f2bf(lo); } }
    float* BT = (float*)(a.ws + WS_BT);
    for (int i = gw * 64 + lane; i < 4 * 2048; i += NGW * 64) {
        const int h = i >> 11, n = i & 2047; int bk;
        if (n < 16) bk = n; else { const float v = logf((float)n / 16.0f) / 2.0794415416798357f * 16.0f; bk = 16 + (int)v; bk = bk < 31 ? bk : 31; }
        BT[i] = a.in[24][bk * 4 + h];
    }
}

__device__ __forceinline__ void rms_row_to_bf16(const f32x4 (&v)[4], const float* w, bf16* orow, int lane) {
    float s = 0.f;
#pragma unroll
    for (int j = 0; j < 4; ++j) s += (v[j].x * v[j].x + v[j].y * v[j].y) + (v[j].z * v[j].z + v[j].w * v[j].w);
    const float r = rsqrtf(wave_sum(s) * (1.0f / DM) + EPS);
#pragma unroll
    for (int j = 0; j < 4; ++j) { const f32x4 wv = *(const f32x4*)(w + 4 * (64 * j + lane)); const f32x4 y = v[j] * r * wv;
        u32x2 o; o.x = pk2(y.x, y.y); o.y = pk2(y.z, y.w); *(u32x2*)(orow + 4 * (64 * j + lane)) = o; }
}

__device__ __forceinline__ void ph_norm0(const Args& a, int gw, int NGW, int lane) {
    bf16* XN = (bf16*)(a.ws + WS_XN);
    for (int tok = gw; tok < NT; tok += NGW) {
        f32x4 v[4];
#pragma unroll
        for (int j = 0; j < 4; ++j) v[j] = *(const f32x4*)(a.in[0] + (size_t)tok * DM + 4 * (64 * j + lane));
        rms_row_to_bf16(v, a.in[1], XN + (size_t)tok * DM, lane);
    }
}

__device__ __forceinline__ void ph_compress_mfma(const Args& a, int l, LAS unsigned char* lds, int bid, int G, int tid, int wave, int lane) {
    LAS float* hid = (LAS float*)lds;
    const bf16* P = (const bf16*)(a.ws + WS_P); bf16* KCMP = (bf16*)(a.ws + WS_KCMP); bf16* VCMP = (bf16*)(a.ws + WS_VCMP);
    const int r = lane & 15, q = lane >> 4;
    for (int u = bid; u < 128; u += G) {
        const int b = u >> 4, kv = (u >> 3) & 1, j0 = 16 * (u & 7);
        const bf16* arow = P + (size_t)(b * SEQ) * NP + C_KV + kv * 64;
        const bf16* brow = (const bf16*)(a.ws + WS_W1T) + ((size_t)(l * 2 + kv) * 128 + 16 * wave + r) * 2048 + 8 * q;
        const float pw = ((const float*)(a.ws + WS_POSW))[(l * 2 + kv) * 128 + 16 * wave + r];
        f32x4 acc = {0.f, 0.f, 0.f, 0.f};
#pragma unroll 8
        for (int ks = 0; ks < 64; ++ks) { int tk = 16 * (j0 + r) + (ks >> 1); tk = tk < SEQ ? tk : SEQ - 1;
            const bf16x8 af = *(const bf16x8*)(arow + (size_t)tk * NP + (ks & 1) * 32 + 8 * q); const bf16x8 bfr = *(const bf16x8*)(brow + 32 * ks);
            acc = __builtin_amdgcn_mfma_f32_16x16x32_bf16(af, bfr, acc, 0, 0, 0); }
#pragma unroll
        for (int i = 0; i < 4; ++i) hid[(4 * q + i) * 132 + 16 * wave + r] = siluf_(acc[i] + pw);
        __syncthreads();
        { const int row = tid >> 5, c2 = tid & 31; const float* w2 = a.in[11] + (size_t)(l * 2 + kv) * 128 * 64; float o0 = 0.f, o1 = 0.f;
            for (int nn = 0; nn < 128; ++nn) { const float hv = hid[row * 132 + nn]; o0 += hv * w2[nn * 64 + 2 * c2]; o1 += hv * w2[nn * 64 + 2 * c2 + 1]; }
            if (kv == 0) { float ss = o0 * o0 + o1 * o1;
#pragma unroll
                for (int o_ = 1; o_ < 32; o_ <<= 1) ss += __shfl_xor(ss, o_);
                const float sc = rsqrtf(ss * (1.0f / 64.0f) + EPS); o0 *= sc * a.in[8][l * 192 + 2 * c2]; o1 *= sc * a.in[8][l * 192 + 2 * c2 + 1]; }
            const int j = j0 + row;
            *(unsigned*)((kv ? VCMP : KCMP) + (size_t)(b * 128 + j) * 64 + 2 * c2) = (j < 127) ? pk2(o0, o1) : 0u; }
        __syncthreads();
    }
}

__device__ __forceinline__ void ph_m1(const Args& a, int l, LAS unsigned char* lds, int bid, int G, int tid, int wave, int lane) {
    const bf16* P = (const bf16*)(a.ws + WS_P);
    bf16* QN = (bf16*)(a.ws + WS_QN); bf16* KN = (bf16*)(a.ws + WS_KN); bf16* VC = (bf16*)(a.ws + WS_VC);
    bf16* KT = (bf16*)(a.ws + WS_KT); bf16* VT = (bf16*)(a.ws + WS_VT);
    float* Gb = (float*)(a.ws + WS_G); float* BETA = (float*)(a.ws + WS_BETA);
    bf16* NQ = (bf16*)(a.ws + WS_NQ); bf16* KS = (bf16*)(a.ws + WS_KS); bf16* KW = (bf16*)(a.ws + WS_KW); bf16* Y = (bf16*)(a.ws + WS_Y);
    const float* convw = a.in[3] + (size_t)l * 4 * 1536; const float* a_log = a.in[4] + l * 4; const float* dt_bias = a.in[5] + l * 4;
    const float* qnw = a.in[7] + l * 64; const float* knw = a.in[8] + l * 192;
    const float* dww = a.in[12] + (size_t)l * 31 * 256; const float* dwb = a.in[13] + l * 256; const float* lnw = a.in[14] + l * 256; const float* lnb = a.in[15] + l * 256;
    LAS float* dwl = (LAS float*)(lds + 65536);
    for (int i = tid; i < 31 * 256; i += NTHR) dwl[i] = dww[i];
    __syncthreads();
    for (int u = bid; u < NT / 64; u += G) {
        const int b = u >> 5, nchunk = u & 31, tw = nchunk * 64 + 8 * wave;
        const bf16* pw0 = P + (size_t)(b * SEQ + tw) * NP;
#pragma unroll
        for (int ten = 0; ten < 3; ++ten)
#pragma unroll 1
            for (int h = 0; h < 4; ++h) { const int cb = ten * 512 + h * 128 + 2 * lane;
                float w0[4], w1[4];
#pragma unroll
                for (int j = 0; j < 4; ++j) { w0[j] = convw[j * 1536 + cb]; w1[j] = convw[j * 1536 + cb + 1]; }
                float xa[3], xb[3];
#pragma unroll
                for (int j = 0; j < 3; ++j) { unsigned w = 0u; if (tw - 3 + j >= 0) w = *(const unsigned*)(pw0 + (ptrdiff_t)(j - 3) * NP + cb); xa[j] = bf_lo(w); xb[j] = bf_hi(w); }
                unsigned pk[8], xin8[8];
#pragma unroll
                for (int i = 0; i < 8; ++i) xin8[i] = *(const unsigned*)(pw0 + (size_t)i * NP + cb);
                float ya[8], yb[8], sq[8];
#pragma unroll
                for (int i = 0; i < 8; ++i) { const unsigned w = xin8[i]; const float ca = bf_lo(w), cbv = bf_hi(w);
                    ya[i] = siluf_(w0[0] * xa[0] + w0[1] * xa[1] + w0[2] * xa[2] + w0[3] * ca); yb[i] = siluf_(w1[0] * xb[0] + w1[1] * xb[1] + w1[2] * xb[2] + w1[3] * cbv);
                    xa[0] = xa[1]; xa[1] = xa[2]; xa[2] = ca; xb[0] = xb[1]; xb[1] = xb[2]; xb[2] = cbv; sq[i] = ya[i] * ya[i] + yb[i] * yb[i]; }
                if (ten < 2) {
#pragma unroll
                    for (int o_ = 1; o_ < 64; o_ <<= 1) {
#pragma unroll
                        for (int i = 0; i < 8; ++i) sq[i] += __shfl_xor(sq[i], o_); }
#pragma unroll
                    for (int i = 0; i < 8; ++i) { const float sc = rsqrtf(sq[i] + EPS) * (ten == 0 ? 0.08838834764831845f : 1.0f); ya[i] *= sc; yb[i] *= sc; } }
                bf16* dst = ten == 0 ? QN : (ten == 1 ? KN : VC);
#pragma unroll
                for (int i = 0; i < 8; ++i) { pk[i] = pk2(ya[i], yb[i]); *(unsigned*)(dst + (size_t)(b * SEQ + tw + i) * 512 + h * 128 + 2 * lane) = pk[i]; }
                if (ten >= 1) {
                    bf16* tb = (ten == 1 ? KT : VT) + ((size_t)((b * 4 + h) * 32 + nchunk) * 128 + 2 * lane) * 64 + 8 * wave;
                    u32x4 lo, hi;
                    lo.x = (pk[0] & 0xffffu) | (pk[1] << 16); lo.y = (pk[2] & 0xffffu) | (pk[3] << 16); lo.z = (pk[4] & 0xffffu) | (pk[5] << 16); lo.w = (pk[6] & 0xffffu) | (pk[7] << 16);
                    hi.x = (pk[0] >> 16) | (pk[1] & 0xffff0000u); hi.y = (pk[2] >> 16) | (pk[3] & 0xffff0000u); hi.z = (pk[4] >> 16) | (pk[5] & 0xffff0000u); hi.w = (pk[6] >> 16) | (pk[7] & 0xffff0000u);
                    *(u32x4*)tb = lo; *(u32x4*)(tb + 64) = hi; } }
        if (lane < 32) { const int i = lane >> 2, hd = lane & 3; const size_t tok = (size_t)(b * SEQ + tw + i); const bf16* prow = P + tok * NP;
            const float av = bf2f(prow[C_A + hd]), bv = bf2f(prow[C_B + hd]);
            BETA[tok * 4 + hd] = sigmoidf_(bv);
            const float x = av + dt_bias[hd]; const float sp = x > 20.0f ? x : log1pf(expf(x));
            Gb[tok * 4 + hd] = -expf(a_log[hd]) * sp; }
        { const float qw = qnw[lane] * (0.125f * 1.4426950408889634f), ksw = knw[64 + lane], kww = knw[128 + lane];
#pragma unroll 2
          for (int i = 0; i < 8; ++i) { const size_t tok = (size_t)(b * SEQ + tw + i); const bf16* prow = P + tok * NP;
            float xv[6];
#pragma unroll
            for (int h = 0; h < 4; ++h) xv[h] = bf2f(prow[C_NQ + h * 64 + lane]);
            xv[4] = bf2f(prow[C_KV + 128 + lane]); xv[5] = bf2f(prow[C_KV + 256 + lane]);
            float ss[6];
#pragma unroll
            for (int h = 0; h < 6; ++h) ss[h] = xv[h] * xv[h];
#pragma unroll
            for (int o_ = 1; o_ < 64; o_ <<= 1) {
#pragma unroll
                for (int h = 0; h < 6; ++h) ss[h] += __shfl_xor(ss[h], o_); }
#pragma unroll
            for (int h = 0; h < 4; ++h) NQ[tok * 256 + h * 64 + lane] = (bf16)f2bf(xv[h] * rsqrtf(ss[h] * (1.0f / 64.0f) + EPS) * qw);
            KS[tok * 64 + lane] = (bf16)f2bf(xv[4] * rsqrtf(ss[4] * (1.0f / 64.0f) + EPS) * ksw);
            KW[tok * 64 + lane] = (bf16)f2bf(xv[5] * rsqrtf(ss[5] * (1.0f / 64.0f) + EPS) * kww); } }
        { const int c = 4 * lane; f32x4 acc[8]; const f32x4 bias = *(const f32x4*)(dwb + c);
#pragma unroll
            for (int i = 0; i < 8; ++i) acc[i] = bias;
            for (int r = 0; r < 38; ++r) { const int tin = tw - 30 + r; if (tin < 0) continue;
                const bf16* pr = pw0 + (ptrdiff_t)(r - 30) * NP + C_CU + c; const u32x2 av = *(const u32x2*)pr, gv = *(const u32x2*)(pr + 256);
                f32x4 gl; gl.x = bf_lo(av.x) * sigmoidf_(bf_lo(gv.x)); gl.y = bf_hi(av.x) * sigmoidf_(bf_hi(gv.x)); gl.z = bf_lo(av.y) * sigmoidf_(bf_lo(gv.y)); gl.w = bf_hi(av.y) * sigmoidf_(bf_hi(gv.y));
#pragma unroll
                for (int i = 0; i < 8; ++i) { const int j = r - i; if (j >= 0 && j <= 30) { const f32x4 w = *(const LAS f32x4*)(dwl + j * 256 + c); acc[i] += w * gl; } } }
            const f32x4 lw = *(const f32x4*)(lnw + c), lb = *(const f32x4*)(lnb + c);
#pragma unroll
            for (int i = 0; i < 8; ++i) { const f32x4 x = acc[i]; const float mean = wave_sum((x.x + x.y) + (x.z + x.w)) * (1.0f / 256.0f);
                const f32x4 d = x - mean; const float var = wave_sum((d.x * d.x + d.y * d.y) + (d.z * d.z + d.w * d.w)) * (1.0f / 256.0f);
                const float rr = rsqrtf(var + EPS); const f32x4 y = d * rr * lw + lb;
                u32x2 o; o.x = pk2(siluf_(y.x), siluf_(y.y)); o.y = pk2(siluf_(y.z), siluf_(y.w));
                *(u32x2*)(Y + (size_t)(b * SEQ + tw + i) * DM + 768 + c) = o; } }
    }
}

constexpr int LM_PITCH = 68;
__device__ __forceinline__ void ph_dn_chunk_mfma(const Args& a, LAS unsigned char* lds, int bid, int G, int tid, int wave, int lane) {
    LAS float* Lm = (LAS float*)lds;
    LAS float* gcl = (LAS float*)(lds + 4 * 64 * LM_PITCH * 4);
    LAS float* betal = gcl + 256; LAS float* bkl = betal + 256;
    const bf16* QN = (const bf16*)(a.ws + WS_QN); const bf16* KN = (const bf16*)(a.ws + WS_KN);
    const bf16* KT = (const bf16*)(a.ws + WS_KT); const bf16* VT = (const bf16*)(a.ws + WS_VT);
    const float* Gb = (const float*)(a.ws + WS_G); const float* BETA = (const float*)(a.ws + WS_BETA); float* GC = (float*)(a.ws + WS_GC);
    float* U = (float*)(a.ws + WS_U); bf16* W = (bf16*)(a.ws + WS_W); bf16* ATT = (bf16*)(a.ws + WS_ATT);
    const int n = lane & 31, hh = lane >> 5;
    for (int cb = bid * 4; cb < 1024; cb += G * 4) {
        if (wave < 4) { const int ci = cb + wave, nn = ci & 31, h = (ci >> 5) & 3, b = ci >> 7, r0 = b * SEQ + nn * 64;
            float g = Gb[(size_t)(r0 + lane) * 4 + h];
#pragma unroll
            for (int off = 1; off < 64; off <<= 1) { const float v = __shfl_up(g, off); if (lane >= off) g += v; }
            const float be = BETA[(size_t)(r0 + lane) * 4 + h];
            gcl[wave * 64 + lane] = g; GC[(size_t)(r0 + lane) * 4 + h] = g; betal[wave * 64 + lane] = be; bkl[wave * 64 + lane] = be * __expf(g); }
        __syncthreads();
#pragma unroll 1
        for (int q = 0; q < 3; ++q) { const int id = 3 * wave + q, c = id / 6, wq = id % 6, isq = wq >= 3 ? 1 : 0, blk = wq % 3, ib = blk >= 1 ? 1 : 0, jb = blk == 2 ? 1 : 0;
            const int ci = cb + c, nn = ci & 31, h = (ci >> 5) & 3, b = ci >> 7, r0 = b * SEQ + nn * 64;
            const bf16* ap = (isq ? QN : KN) + (size_t)(r0 + 32 * ib + n) * 512 + h * 128 + 8 * hh;
            const bf16* bp = KN + (size_t)(r0 + 32 * jb + n) * 512 + h * 128 + 8 * hh;
            f32x16 acc;
#pragma unroll
            for (int r = 0; r < 16; ++r) acc[r] = 0.f;
#pragma unroll
            for (int ks = 0; ks < 8; ++ks) acc = __builtin_amdgcn_mfma_f32_32x32x16_bf16(*(const bf16x8*)(ap + 16 * ks), *(const bf16x8*)(bp + 16 * ks), acc, 0, 0, 0);
            const int j = 32 * jb + n; const float gj = gcl[c * 64 + j];
#pragma unroll
            for (int r = 0; r < 16; ++r) { const int i = 32 * ib + (r & 3) + 8 * (r >> 2) + 4 * hh; const float dec = __expf(fminf(gcl[c * 64 + i] - gj, 0.f));
                if (isq) ATT[(size_t)ci * 4096 + i * 64 + j] = (bf16)((j <= i) ? f2bf(acc[r] * dec) : 0u);
                else Lm[c * 64 * LM_PITCH + i * LM_PITCH + j] = (j < i) ? betal[c * 64 + i] * acc[r] * dec : 0.f; } }
        __syncthreads();
        if (wave < 4) { LAS float* L = Lm + wave * 64 * LM_PITCH;
            for (int i = 0; i < 64; ++i) { float a0 = (i == lane) ? 1.f : 0.f, a1 = 0.f, a2 = 0.f, a3 = 0.f; int j = 0;
                for (; j + 3 < i; j += 4) { a0 -= L[i * LM_PITCH + j] * L[j * LM_PITCH + lane]; a1 -= L[i * LM_PITCH + j + 1] * L[(j + 1) * LM_PITCH + lane];
                    a2 -= L[i * LM_PITCH + j + 2] * L[(j + 2) * LM_PITCH + lane]; a3 -= L[i * LM_PITCH + j + 3] * L[(j + 3) * LM_PITCH + lane]; }
                for (; j < i; ++j) a0 -= L[i * LM_PITCH + j] * L[j * LM_PITCH + lane];
                L[i * LM_PITCH + lane] = (a0 + a1) + (a2 + a3); } }
        __syncthreads();
#pragma unroll 1
        for (int q = 0; q < 4; ++q) { const int id = wave * 4 + q, c = id >> 3, ten = (id >> 2) & 1, db = id & 3;
            const int ci = cb + c, nn = ci & 31, h = (ci >> 5) & 3, b = ci >> 7, r0 = b * SEQ + nn * 64;
            const bf16* arow = (ten ? KT : VT) + ((size_t)ci * 128 + 32 * db + n) * 64 + 8 * hh;
            const LAS float* scl = (ten ? bkl : betal) + c * 64;
            const LAS float* L = Lm + c * 64 * LM_PITCH;
#pragma unroll
            for (int ib = 0; ib < 2; ++ib) { f32x16 acc;
#pragma unroll
                for (int r = 0; r < 16; ++r) acc[r] = 0.f;
#pragma unroll
                for (int ks = 0; ks < 4; ++ks) { if (ib == 0 && ks >= 2) continue;
                    const LAS float* tp = L + (32 * ib + n) * LM_PITCH + 16 * ks + 8 * hh;
                    const f32x4 t0 = *(const LAS f32x4*)tp, t1 = *(const LAS f32x4*)(tp + 4), s0 = *(const LAS f32x4*)(scl + 16 * ks + 8 * hh), s1 = *(const LAS f32x4*)(scl + 16 * ks + 8 * hh + 4);
                    u32x4 bw; bw.x = pg8::cvt_pk_bf16(t0.x * s0.x, t0.y * s0.y); bw.y = pg8::cvt_pk_bf16(t0.z * s0.z, t0.w * s0.w); bw.z = pg8::cvt_pk_bf16(t1.x * s1.x, t1.y * s1.y); bw.w = pg8::cvt_pk_bf16(t1.z * s1.z, t1.w * s1.w);
                    acc = __builtin_amdgcn_mfma_f32_32x32x16_bf16(*(const bf16x8*)(arow + 16 * ks), __builtin_bit_cast(bf16x8, bw), acc, 0, 0, 0); }
                const size_t ob = (size_t)(r0 + 32 * ib + n) * 512 + h * 128 + 32 * db + 4 * hh;
#pragma unroll
                for (int rq = 0; rq < 4; ++rq) {
                    if (ten) { u32x2 w2; w2.x = pk2(acc[4 * rq], acc[4 * rq + 1]); w2.y = pk2(acc[4 * rq + 2], acc[4 * rq + 3]); *(u32x2*)(W + ob + 8 * rq) = w2; }
                    else *(f32x4*)(U + ob + 8 * rq) = (f32x4){acc[4 * rq], acc[4 * rq + 1], acc[4 * rq + 2], acc[4 * rq + 3]}; } } }
        __syncthreads();
    }
}

constexpr int SC_WP = 272, SC_AP = 144;
constexpr int SC_W = 0, SC_Q = 64 * SC_WP, SC_A = 2 * 64 * SC_WP, SC_K = SC_A + 64 * SC_AP, SC_GC = SC_K + 128 * SC_AP, SC_BUF = SC_GC + 1024;
static_assert(2 * SC_BUF <= RING_BYTES, "scan LDS");
struct ScanPf { u32x4 w[4], q[4], at[2], k[4]; float g, gl; };
__device__ __forceinline__ ScanPf scan_load(const bf16* W, const bf16* QN, const bf16* ATT, const bf16* KT, const float* GC, int r0, int h, int ci, int lt) {
    ScanPf p; const int row = lt >> 4, seg = lt & 15;
#pragma unroll
    for (int i = 0; i < 4; ++i) { const size_t go = (size_t)(r0 + row + 16 * i) * 512 + h * 128 + seg * 8; p.w[i] = *(const u32x4*)(W + go); p.q[i] = *(const u32x4*)(QN + go); }
#pragma unroll
    for (int i = 0; i < 2; ++i) p.at[i] = *(const u32x4*)(ATT + (size_t)ci * 4096 + (lt + 256 * i) * 8);
#pragma unroll
    for (int i = 0; i < 4; ++i) p.k[i] = *(const u32x4*)(KT + (size_t)ci * 8192 + (lt + 256 * i) * 8);
    p.g = GC[(size_t)(r0 + (lt & 63)) * 4 + h]; p.gl = GC[(size_t)(r0 + 63) * 4 + h]; return p;
}
__device__ __forceinline__ void scan_store(const ScanPf& p, LAS unsigned char* buf, int lt) {
    const int row = lt >> 4, seg = lt & 15;
#pragma unroll
    for (int i = 0; i < 4; ++i) { *(LAS u32x4*)(buf + SC_W + (row + 16 * i) * SC_WP + seg * 16) = p.w[i]; *(LAS u32x4*)(buf + SC_Q + (row + 16 * i) * SC_WP + seg * 16) = p.q[i]; }
#pragma unroll
    for (int i = 0; i < 2; ++i) *(LAS u32x4*)(buf + SC_A + ((lt >> 3) + 32 * i) * SC_AP + (lt & 7) * 16) = p.at[i];
#pragma unroll
    for (int i = 0; i < 4; ++i) *(LAS u32x4*)(buf + SC_K + ((lt >> 3) + 32 * i) * SC_AP + (lt & 7) * 16) = p.k[i];
    if (lt < 64) { LAS float* gp = (LAS float*)(buf + SC_GC); gp[lt] = __expf(p.g); gp[64 + lt] = __expf(p.gl - p.g); if (lt == 0) gp[128] = __expf(p.gl); }
}
__device__ __forceinline__ bf16x8 frag2(const LAS unsigned char* p) { const u32x2 lo = *(const LAS u32x2*)p, hi = *(const LAS u32x2*)(p + 16); const u32x4 v = {lo.x, lo.y, hi.x, hi.y}; return __builtin_bit_cast(bf16x8, v); }
__device__ __forceinline__ void ph_dn_scan_mfma(const Args& a, LAS unsigned char* lds, int bid, int G, int tid, int wave, int lane) {
    const bf16* QN = (const bf16*)(a.ws + WS_QN); const bf16* KT = (const bf16*)(a.ws + WS_KT); const bf16* W = (const bf16*)(a.ws + WS_W); const bf16* ATT = (const bf16*)(a.ws + WS_ATT);
    const float* GC = (const float*)(a.ws + WS_GC); const float* U = (const float*)(a.ws + WS_U); float* O = (float*)(a.ws + WS_O);
    const int n = lane & 31, hh = lane >> 5;
    for (int u = bid; u < 32; u += G) {
        const int h = u & 3, b = u >> 2;
        f32x16 S[4];
#pragma unroll
        for (int k = 0; k < 4; ++k)
#pragma unroll
            for (int r = 0; r < 16; ++r) S[k][r] = 0.f;
        __syncthreads();
        if (wave >= 4) { const ScanPf p0 = scan_load(W, QN, ATT, KT, GC, b * SEQ, h, (b * 4 + h) * 32, tid - 256); scan_store(p0, lds, tid - 256); }
        __syncthreads();
#pragma unroll 1
        for (int nn = 0; nn < 32; ++nn) {
            const int r0 = b * SEQ + nn * 64; LAS unsigned char* buf = lds + (nn & 1) * SC_BUF; const LAS float* gp = (const LAS float*)(buf + SC_GC);
            if (wave >= 4) { if (nn + 1 < 32) { const ScanPf pf = scan_load(W, QN, ATT, KT, GC, r0 + 64, h, (b * 4 + h) * 32 + nn + 1, tid - 256); scan_store(pf, lds + ((nn + 1) & 1) * SC_BUF, tid - 256); } }
            else {
                const size_t ubase = (size_t)r0 * 512 + h * 128 + 32 * wave + n;
                f32x16 vn[2];
#pragma unroll
                for (int ib = 0; ib < 2; ++ib)
#pragma unroll
                    for (int r = 0; r < 16; ++r) vn[ib][r] = U[ubase + (size_t)(32 * ib + (r & 3) + 8 * (r >> 2) + 4 * hh) * 512];
                bf16x8 Sb[4][2];
#pragma unroll
                for (int k = 0; k < 4; ++k)
#pragma unroll
                    for (int s2 = 0; s2 < 2; ++s2) { u32x4 w4; w4.x = pg8::cvt_pk_bf16(S[k][8 * s2], S[k][8 * s2 + 1]); w4.y = pg8::cvt_pk_bf16(S[k][8 * s2 + 2], S[k][8 * s2 + 3]);
                        w4.z = pg8::cvt_pk_bf16(S[k][8 * s2 + 4], S[k][8 * s2 + 5]); w4.w = pg8::cvt_pk_bf16(S[k][8 * s2 + 6], S[k][8 * s2 + 7]); Sb[k][s2] = __builtin_bit_cast(bf16x8, w4); }
#pragma unroll
                for (int ib = 0; ib < 2; ++ib) { f32x16 acc;
#pragma unroll
                    for (int r = 0; r < 16; ++r) acc[r] = 0.f;
#pragma unroll
                    for (int k = 0; k < 4; ++k)
#pragma unroll
                        for (int s2 = 0; s2 < 2; ++s2) acc = __builtin_amdgcn_mfma_f32_32x32x16_bf16(frag2(buf + SC_W + (32 * ib + n) * SC_WP + (32 * k + 16 * s2 + 4 * hh) * 2), Sb[k][s2], acc, 0, 0, 0);
#pragma unroll
                    for (int r = 0; r < 16; ++r) vn[ib][r] -= acc[r]; }
                bf16x8 vb[2][2], vd[2][2];
#pragma unroll
                for (int jb = 0; jb < 2; ++jb)
#pragma unroll
                    for (int s2 = 0; s2 < 2; ++s2) { const f32x4 d0 = *(const LAS f32x4*)(gp + 64 + 32 * jb + 16 * s2 + 4 * hh), d1 = *(const LAS f32x4*)(gp + 64 + 32 * jb + 16 * s2 + 8 + 4 * hh);
                        const float* v = nullptr; (void)v; u32x4 w4, w5;
                        w4.x = pg8::cvt_pk_bf16(vn[jb][8 * s2], vn[jb][8 * s2 + 1]); w4.y = pg8::cvt_pk_bf16(vn[jb][8 * s2 + 2], vn[jb][8 * s2 + 3]);
                        w4.z = pg8::cvt_pk_bf16(vn[jb][8 * s2 + 4], vn[jb][8 * s2 + 5]); w4.w = pg8::cvt_pk_bf16(vn[jb][8 * s2 + 6], vn[jb][8 * s2 + 7]);
                        w5.x = pg8::cvt_pk_bf16(vn[jb][8 * s2] * d0.x, vn[jb][8 * s2 + 1] * d0.y); w5.y = pg8::cvt_pk_bf16(vn[jb][8 * s2 + 2] * d0.z, vn[jb][8 * s2 + 3] * d0.w);
                        w5.z = pg8::cvt_pk_bf16(vn[jb][8 * s2 + 4] * d1.x, vn[jb][8 * s2 + 5] * d1.y); w5.w = pg8::cvt_pk_bf16(vn[jb][8 * s2 + 6] * d1.z, vn[jb][8 * s2 + 7] * d1.w);
                        vb[jb][s2] = __builtin_bit_cast(bf16x8, w4); vd[jb][s2] = __builtin_bit_cast(bf16x8, w5); }
#pragma unroll
                for (int ib = 0; ib < 2; ++ib) { f32x16 acc;
#pragma unroll
                    for (int r = 0; r < 16; ++r) acc[r] = 0.f;
#pragma unroll
                    for (int k = 0; k < 4; ++k)
#pragma unroll
                        for (int s2 = 0; s2 < 2; ++s2) acc = __builtin_amdgcn_mfma_f32_32x32x16_bf16(frag2(buf + SC_Q + (32 * ib + n) * SC_WP + (32 * k + 16 * s2 + 4 * hh) * 2), Sb[k][s2], acc, 0, 0, 0);
#pragma unroll
                    for (int rq = 0; rq < 4; ++rq) { const f32x4 e4 = *(const LAS f32x4*)(gp + 32 * ib + 8 * rq + 4 * hh);
                        acc[4 * rq] *= e4.x; acc[4 * rq + 1] *= e4.y; acc[4 * rq + 2] *= e4.z; acc[4 * rq + 3] *= e4.w; }
#pragma unroll
                    for (int jb = 0; jb < 2; ++jb) { if (jb > ib) continue;
#pragma unroll
                        for (int s2 = 0; s2 < 2; ++s2) acc = __builtin_amdgcn_mfma_f32_32x32x16_bf16(frag2(buf + SC_A + (32 * ib + n) * SC_AP + (32 * jb + 16 * s2 + 4 * hh) * 2), vb[jb][s2], acc, 0, 0, 0); }
#pragma unroll
                    for (int r = 0; r < 16; ++r) O[ubase + (size_t)(32 * ib + (r & 3) + 8 * (r >> 2) + 4 * hh) * 512] = acc[r]; }
                const float egl = gp[128];
#pragma unroll
                for (int k = 0; k < 4; ++k) {
#pragma unroll
                    for (int r = 0; r < 16; ++r) S[k][r] *= egl;
#pragma unroll
                    for (int jb = 0; jb < 2; ++jb)
#pragma unroll
                        for (int s2 = 0; s2 < 2; ++s2) S[k] = __builtin_amdgcn_mfma_f32_32x32x16_bf16(frag2(buf + SC_K + (32 * k + n) * SC_AP + (32 * jb + 16 * s2 + 4 * hh) * 2), vd[jb][s2], S[k], 0, 0, 0); }
            }
            __syncthreads();
        }
    }
}

__device__ __forceinline__ void ph_dn_out(const Args& a, int l, int gw, int NGW, int lane) {
    const float* O = (const float*)(a.ws + WS_O); const bf16* P = (const bf16*)(a.ws + WS_P); bf16* Y = (bf16*)(a.ws + WS_Y);
    const float* nw = a.in[6] + l * 128;
    for (int tok = gw; tok < NT; tok += NGW) {
#pragma unroll
        for (int h = 0; h < 4; ++h) { const float o0 = O[(size_t)tok * 512 + h * 128 + 2 * lane], o1 = O[(size_t)tok * 512 + h * 128 + 2 * lane + 1];
            const float ss = wave_sum(o0 * o0 + o1 * o1); const float r = rsqrtf(ss * (1.0f / 128.0f) + EPS);
            const unsigned zw = *(const unsigned*)(P + (size_t)tok * NP + C_Z + h * 128 + 2 * lane);
            const float y0 = o0 * r * nw[2 * lane] * siluf_(bf_lo(zw)), y1 = o1 * r * nw[2 * lane + 1] * siluf_(bf_hi(zw));
            *(unsigned*)(Y + (size_t)tok * DM + h * 128 + 2 * lane) = pk2(y0, y1); }
    }
}

constexpr int NSA_KT_PITCH = 144, NSA_VT_PITCH = 136;
struct NsaStage { u32x4 kv, vv; };
__device__ __forceinline__ NsaStage nsa_load(const bf16* Kbase, int kpitch, const bf16* Vbase, int vpitch, int tid) {
    const int key = tid >> 3, seg = tid & 7; NsaStage s;
    s.kv = *(const u32x4*)(Kbase + (size_t)key * kpitch + seg * 8); s.vv = *(const u32x4*)(Vbase + (size_t)key * vpitch + seg * 8); return s;
}
__device__ __forceinline__ void nsa_store(const NsaStage& s, LAS unsigned char* Kt, LAS unsigned char* Vt, int tid) {
    const int key = tid >> 3, seg = tid & 7;
    *(LAS u32x4*)(Kt + key * NSA_KT_PITCH + seg * 16) = s.kv;
#pragma unroll
    for (int i = 0; i < 4; ++i) { const unsigned w = s.vv[i];
        *(LAS unsigned short*)(Vt + (seg * 8 + 2 * i) * NSA_VT_PITCH + key * 2) = (unsigned short)(w & 0xffffu);
        *(LAS unsigned short*)(Vt + (seg * 8 + 2 * i + 1) * NSA_VT_PITCH + key * 2) = (unsigned short)(w >> 16); }
}
__device__ __forceinline__ void nsa_st(const LAS unsigned char* Kt, const bf16x8 (&qf)[4], int n, int hh, f32x16 (&s)[2]) {
#pragma unroll
    for (int kb = 0; kb < 2; ++kb) {
#pragma unroll
        for (int r = 0; r < 16; ++r) s[kb][r] = 0.f;
#pragma unroll
        for (int ks = 0; ks < 4; ++ks) { const bf16x8 af = *(const LAS bf16x8*)(Kt + (kb * 32 + n) * NSA_KT_PITCH + (16 * ks + 8 * hh) * 2);
            s[kb] = __builtin_amdgcn_mfma_f32_32x32x16_bf16(af, qf[ks], s[kb], 0, 0, 0); } }
}
__device__ __forceinline__ void nsa_pvm(const LAS unsigned char* Vt, const bf16x8 (&pf)[2][2], int n, int hh, f32x16 (&o)[2]) {
#pragma unroll
    for (int db = 0; db < 2; ++db)
#pragma unroll
        for (int kb = 0; kb < 2; ++kb)
#pragma unroll
            for (int s2 = 0; s2 < 2; ++s2) { const LAS unsigned char* p = Vt + (db * 32 + n) * NSA_VT_PITCH + (kb * 32 + 16 * s2 + 4 * hh) * 2;
                const u32x2 lo = *(const LAS u32x2*)p, hi = *(const LAS u32x2*)(p + 16);
                const u32x4 av = {lo.x, lo.y, hi.x, hi.y};
                o[db] = __builtin_amdgcn_mfma_f32_32x32x16_bf16(__builtin_bit_cast(bf16x8, av), pf[kb][s2], o[db], 0, 0, 0); }
}
__device__ __forceinline__ void nsa_pack(const f32x16 (&p)[2], bf16x8 (&pf)[2][2]) {
#pragma unroll
    for (int kb = 0; kb < 2; ++kb)
#pragma unroll
        for (int s2 = 0; s2 < 2; ++s2) { u32x4 w;
            w.x = pg8::cvt_pk_bf16(p[kb][8 * s2 + 0], p[kb][8 * s2 + 1]); w.y = pg8::cvt_pk_bf16(p[kb][8 * s2 + 2], p[kb][8 * s2 + 3]);
            w.z = pg8::cvt_pk_bf16(p[kb][8 * s2 + 4], p[kb][8 * s2 + 5]); w.w = pg8::cvt_pk_bf16(p[kb][8 * s2 + 6], p[kb][8 * s2 + 7]);
            pf[kb][s2] = __builtin_bit_cast(bf16x8, w); }
}
constexpr int BT2_ROWS = 2048 + 72;
template <bool COLSEL>
__device__ __forceinline__ void nsa_tile_mfma(const LAS unsigned char* Kt, const LAS unsigned char* Vt, const LAS float* btl2h, const bf16x8 (&qf)[4], int n, int hh,
                                              int key0, int tq, bool masked, bool colsel, int maxd, float& m, float& l, f32x16 (&o)[2]) {
    f32x16 s[2]; nsa_st(Kt, qf, n, hh, s);
    const int dbase = tq - key0 - 4 * hh;
    const LAS float* bp = btl2h + (2047 - dbase) * 4;
#pragma unroll
    for (int kb = 0; kb < 2; ++kb)
#pragma unroll
        for (int r = 0; r < 16; ++r) { const int cst = kb * 32 + (r & 3) + 8 * (r >> 2); const float x = s[kb][r] + bp[cst * 4]; s[kb][r] = (!COLSEL || colsel) ? x : -3.0e38f; }
    if (masked) {
#pragma unroll
        for (int kb = 0; kb < 2; ++kb)
#pragma unroll
            for (int r = 0; r < 16; ++r) { const int dist = dbase - (kb * 32 + (r & 3) + 8 * (r >> 2)); s[kb][r] = (dist >= 0 && dist <= maxd) ? s[kb][r] : -3.0e38f; } }
    float tmax = -3.0e38f;
#pragma unroll
    for (int kb = 0; kb < 2; ++kb)
#pragma unroll
        for (int r = 0; r < 16; ++r) tmax = fmaxf(tmax, s[kb][r]);
    tmax = fmaxf(tmax, __shfl_xor(tmax, 32));
    const float mn = fmaxf(m, tmax); float rs = 0.f;
#pragma unroll
    for (int kb = 0; kb < 2; ++kb)
#pragma unroll
        for (int r = 0; r < 16; ++r) { const float p = __builtin_amdgcn_exp2f(s[kb][r] - mn); s[kb][r] = p; rs += p; }
    rs += __shfl_xor(rs, 32);
    if (__any(mn > m)) { const float corr = __builtin_amdgcn_exp2f(m - mn); l *= corr;
#pragma unroll
        for (int db = 0; db < 2; ++db)
#pragma unroll
            for (int r = 0; r < 16; ++r) o[db][r] *= corr; }
    l += rs; m = mn;
    bf16x8 pf[2][2]; nsa_pack(s, pf);
    nsa_pvm(Vt, pf, n, hh, o);
}

__device__ __forceinline__ void ph_nsa_mfma(const Args& a, LAS unsigned char* lds, int ubeg, int ustep, int uend, int tid, int wave, int lane) {
    LAS float* btl2 = (LAS float*)lds;
    constexpr int NSA_L0 = BT2_ROWS * 16;
    LAS unsigned char* Kt = lds + NSA_L0;
    LAS unsigned char* Vt = lds + NSA_L0 + 9216;
    constexpr int NSA_TB = 9216 + 8704;
    LAS float* PS = (LAS float*)(lds + NSA_L0 + 2 * NSA_TB + 256);
    LAS unsigned* MK = (LAS unsigned*)(lds + NSA_L0 + 2 * NSA_TB + 256 + 64 * 129 * 4);
    static_assert(NSA_L0 + 2 * NSA_TB + 256 + 64 * 129 * 4 + 512 <= RING_BYTES, "NSA LDS");
    const float* BT = (const float*)(a.ws + WS_BT);
    for (int i = tid; i < BT2_ROWS * 4; i += NTHR) { const int row = i >> 2, hd = i & 3; btl2[i] = row < 2048 ? BT[hd * 2048 + (2047 - row)] * 1.4426950408889634f : 0.f; }
    const bf16* P = (const bf16*)(a.ws + WS_P); const bf16* NQ = (const bf16*)(a.ws + WS_NQ);
    const bf16* KS = (const bf16*)(a.ws + WS_KS); const bf16* KW = (const bf16*)(a.ws + WS_KW);
    const bf16* KCMP = (const bf16*)(a.ws + WS_KCMP); const bf16* VCMP = (const bf16*)(a.ws + WS_VCMP); bf16* Y = (bf16*)(a.ws + WS_Y);
    const int n = lane & 31, hh = lane >> 5, tl = n >> 2, h = n & 3;
    const LAS float* btl2h = btl2 + h;
    __syncthreads();
    for (int u = ubeg; u < uend; u += ustep) {
        const int b = u & 7, qt = 31 - (u >> 3), t0 = 64 * qt, tq = t0 + 8 * wave + tl, tok = b * SEQ + tq;
        bf16x8 qf[4];
#pragma unroll
        for (int ks = 0; ks < 4; ++ks) qf[ks] = *(const bf16x8*)(NQ + (size_t)tok * 256 + h * 64 + 16 * ks + 8 * hh);
        float gate[3];
#pragma unroll
        for (int br = 0; br < 3; ++br) gate[br] = sigmoidf_(bf2f(P[(size_t)tok * NP + C_G + h * 3 + br]));
        f32x16 yacc[2];
        {
            float mx = -1e30f, rs = 0.f;
#pragma unroll 1
            for (int ct = 0; ct < 2; ++ct) {
                __syncthreads();
                { const NsaStage st = nsa_load(KCMP + (size_t)(b * 128 + ct * 64) * 64, 64, VCMP + (size_t)(b * 128 + ct * 64) * 64, 64, tid); nsa_store(st, Kt, Vt, tid); }
                __syncthreads();
                f32x16 sc[2]; nsa_st(Kt, qf, n, hh, sc);
                float tmax = -1e30f;
#pragma unroll
                for (int kb = 0; kb < 2; ++kb)
#pragma unroll
                    for (int r = 0; r < 16; ++r) { const int j = ct * 64 + kb * 32 + (r & 3) + 8 * (r >> 2) + 4 * hh; const int dist = tq - 16 * j - 31;
                        const float x = sc[kb][r] + btl2h[(2047 - (dist < 0 ? 0 : dist)) * 4]; sc[kb][r] = dist >= 0 ? x : -1e30f; tmax = fmaxf(tmax, sc[kb][r]); }
                tmax = fmaxf(tmax, __shfl_xor(tmax, 32));
                const float mn = fmaxf(mx, tmax); float ts = 0.f;
#pragma unroll
                for (int kb = 0; kb < 2; ++kb)
#pragma unroll
                    for (int r = 0; r < 16; ++r) { const float x = sc[kb][r]; ts += x > -1e29f ? __builtin_amdgcn_exp2f(x - mn) : 0.f; }
                ts += __shfl_xor(ts, 32);
                rs = rs * __builtin_amdgcn_exp2f(mx - mn) + ts; mx = mn;
            }
            const float inv = rs > 0.f ? 1.0f / rs : 0.f;
            f32x16 o[2];
#pragma unroll
            for (int db = 0; db < 2; ++db)
#pragma unroll
                for (int r = 0; r < 16; ++r) o[db][r] = 0.f;
#pragma unroll 1
            for (int cc = 0; cc < 2; ++cc) { const int ct = 1 - cc;
                if (cc == 1) { __syncthreads();
                    { const NsaStage st = nsa_load(KCMP + (size_t)(b * 128) * 64, 64, VCMP + (size_t)(b * 128) * 64, 64, tid); nsa_store(st, Kt, Vt, tid); }
                    __syncthreads(); }
                f32x16 sc[2]; nsa_st(Kt, qf, n, hh, sc);
#pragma unroll
                for (int kb = 0; kb < 2; ++kb)
#pragma unroll
                    for (int r = 0; r < 16; ++r) { const int j = ct * 64 + kb * 32 + (r & 3) + 8 * (r >> 2) + 4 * hh; const int dist = tq - 16 * j - 31;
                        const float x = sc[kb][r] + btl2h[(2047 - (dist < 0 ? 0 : dist)) * 4]; const float p = dist >= 0 ? __builtin_amdgcn_exp2f(x - mx) * inv : 0.f; sc[kb][r] = p;
                        float v = p; v += __shfl_xor(v, 1); v += __shfl_xor(v, 2);
                        if (h == 0) PS[(8 * wave + tl) * 129 + j] = v; }
                bf16x8 pf[2][2]; nsa_pack(sc, pf); nsa_pvm(Vt, pf, n, hh, o);
            }
#pragma unroll
            for (int db = 0; db < 2; ++db)
#pragma unroll
                for (int r = 0; r < 16; ++r) yacc[db][r] = gate[0] * o[db][r];
        }
        LDS_WAIT();
        for (int t2 = 0; t2 < 8; ++t2) {
            const int tqq = t0 + 8 * wave + t2, sb = lane & 31, cur = tqq >> 6; const LAS float* row = PS + (8 * wave + t2) * 129; float imp = 0.f;
#pragma unroll
            for (int dj = -1; dj <= 3; ++dj) { const int j = 4 * sb + dj; if (j >= 0 && j <= 126) imp += row[j]; }
            if (sb > cur) imp = -1.0f; else if (sb == 0 || sb == cur || sb == cur - 1) imp = 1e4f;
            int rank = 0;
            for (int s2 = 0; s2 < 32; ++s2) { const float v2 = __shfl(imp, s2); rank += (v2 > imp || (v2 == imp && s2 < sb)) ? 1 : 0; }
            const unsigned msk = (unsigned)__ballot((lane < 32) && (rank < 16) && (sb <= cur));
            if (lane == 0) MK[8 * wave + t2] = msk;
        }
        __syncthreads();
        unsigned anymask, wmask; const unsigned mymask = MK[8 * wave + tl];
        { unsigned v = MK[lane];
#pragma unroll
            for (int o_ = 1; o_ < 64; o_ <<= 1) v |= (unsigned)__shfl_xor((int)v, o_);
            anymask = (unsigned)__builtin_amdgcn_readfirstlane((int)v);
            unsigned w = MK[8 * wave + (lane & 7)]; w |= (unsigned)__shfl_xor((int)w, 1); w |= (unsigned)__shfl_xor((int)w, 2); w |= (unsigned)__shfl_xor((int)w, 4);
            wmask = (unsigned)__builtin_amdgcn_readfirstlane((int)w); }
        LAS unsigned* stash = (LAS unsigned*)PS + (wave * 16) * 64 + lane;
        __syncthreads();
#pragma unroll
        for (int db = 0; db < 2; ++db)
#pragma unroll
            for (int k = 0; k < 8; ++k) stash[(db * 8 + k) * 64] = pk2(yacc[db][2 * k], yacc[db][2 * k + 1]);
        {
            float m = -1e30f, l = 0.f; f32x16 o[2];
#pragma unroll
            for (int db = 0; db < 2; ++db)
#pragma unroll
                for (int r = 0; r < 16; ++r) o[db][r] = 0.f;
            unsigned mk = anymask; NsaStage s0, s1; bool h1 = false;
            { const int sa = __builtin_ctz(mk); s0 = nsa_load(KS + (size_t)(b * SEQ + 64 * sa) * 64, 64, P + (size_t)(b * SEQ + 64 * sa) * NP + C_KV + 192, NP, tid);
              unsigned m2 = mk & (mk - 1u); if (m2) { const int sb2 = __builtin_ctz(m2); s1 = nsa_load(KS + (size_t)(b * SEQ + 64 * sb2) * 64, 64, P + (size_t)(b * SEQ + 64 * sb2) * NP + C_KV + 192, NP, tid); h1 = true; } }
            __syncthreads();
            nsa_store(s0, Kt, Vt, tid);
            __syncthreads();
            int par = 0;
            while (mk) {
                const int sblk = __builtin_ctz(mk); mk &= mk - 1u;
                if (h1) { nsa_store(s1, Kt + (par ^ 1) * NSA_TB, Vt + (par ^ 1) * NSA_TB, tid);
                    const unsigned m3 = mk & (mk - 1u);
                    if (m3) { const int sc2 = __builtin_ctz(m3); s1 = nsa_load(KS + (size_t)(b * SEQ + 64 * sc2) * 64, 64, P + (size_t)(b * SEQ + 64 * sc2) * NP + C_KV + 192, NP, tid); } else h1 = false; }
                if ((wmask >> sblk) & 1u) nsa_tile_mfma<true>(Kt + par * NSA_TB, Vt + par * NSA_TB, btl2h, qf, n, hh, 64 * sblk, tq, 64 * sblk + 63 > t0 + 8 * wave, ((mymask >> sblk) & 1u) != 0u, 1 << 30, m, l, o);
                __syncthreads();
                par ^= 1;
            }
            const float inv = l > 0.f ? gate[1] / l : 0.f;
#pragma unroll
            for (int db = 0; db < 2; ++db)
#pragma unroll
                for (int k = 0; k < 8; ++k) { const unsigned w = stash[(db * 8 + k) * 64]; stash[(db * 8 + k) * 64] = pk2(bf_lo(w) + inv * o[db][2 * k], bf_hi(w) + inv * o[db][2 * k + 1]); }
        }
        {
            float m = -1e30f, l = 0.f; f32x16 o[2];
#pragma unroll
            for (int db = 0; db < 2; ++db)
#pragma unroll
                for (int r = 0; r < 16; ++r) o[db][r] = 0.f;
            const int kt0 = (t0 - 511 > 0 ? t0 - 511 : 0) >> 6;
            NsaStage s0 = nsa_load(KW + (size_t)(b * SEQ + 64 * kt0) * 64, 64, P + (size_t)(b * SEQ + 64 * kt0) * NP + C_KV + 320, NP, tid), s1;
            if (kt0 < qt) s1 = nsa_load(KW + (size_t)(b * SEQ + 64 * (kt0 + 1)) * 64, 64, P + (size_t)(b * SEQ + 64 * (kt0 + 1)) * NP + C_KV + 320, NP, tid);
            __syncthreads();
            nsa_store(s0, Kt, Vt, tid);
            __syncthreads();
            int par = 0;
            for (int kt = kt0; kt <= qt; ++kt) {
                if (kt < qt) { nsa_store(s1, Kt + (par ^ 1) * NSA_TB, Vt + (par ^ 1) * NSA_TB, tid);
                    if (kt + 2 <= qt) s1 = nsa_load(KW + (size_t)(b * SEQ + 64 * (kt + 2)) * 64, 64, P + (size_t)(b * SEQ + 64 * (kt + 2)) * NP + C_KV + 320, NP, tid); }
                nsa_tile_mfma<false>(Kt + par * NSA_TB, Vt + par * NSA_TB, btl2h, qf, n, hh, 64 * kt, tq, !(64 * kt + 63 <= t0 + 8 * wave && t0 + 8 * wave + 7 - 64 * kt <= 511), true, 511, m, l, o);
                __syncthreads();
                par ^= 1;
            }
            const float inv = l > 0.f ? gate[2] / l : 0.f;
#pragma unroll
            for (int db = 0; db < 2; ++db)
#pragma unroll
                for (int k = 0; k < 8; ++k) { const unsigned w = stash[(db * 8 + k) * 64]; yacc[db][2 * k] = bf_lo(w) + inv * o[db][2 * k]; yacc[db][2 * k + 1] = bf_hi(w) + inv * o[db][2 * k + 1]; }
        }
#pragma unroll
        for (int db = 0; db < 2; ++db)
#pragma unroll
            for (int rq = 0; rq < 4; ++rq) { u32x2 w; w.x = pk2(yacc[db][4 * rq], yacc[db][4 * rq + 1]); w.y = pk2(yacc[db][4 * rq + 2], yacc[db][4 * rq + 3]);
                *(u32x2*)(Y + (size_t)tok * DM + 512 + h * 64 + db * 32 + 8 * rq + 4 * hh) = w; }
        __syncthreads();
    }
}

constexpr int RT_PITCH = 2064;
__device__ __forceinline__ void ph_router(const Args& a, int l, const float* Xin_, const bf16* Dm, LAS unsigned char* lds, int bid, int G, int tid, int wave, int lane) {
    LAS unsigned char* Ht = lds;
    LAS float* LG = (LAS float*)(lds + 32 * RT_PITCH);
    LAS int* lcnt = (LAS int*)(lds + 32 * RT_PITCH + 64 * 33 * 4); LAS int* asg_e = lcnt + 32; LAS int* asg_p = asg_e + 256; LAS float* asg_w = (LAS float*)(asg_p + 256); LAS int* gbase = (LAS int*)(asg_w + 256);
    bf16* H2 = (bf16*)(a.ws + WS_XN); unsigned* cnt = (unsigned*)(a.ws + WS_CTL) + CW_CNT + 64 * l;
    int* EIDX = (int*)(a.ws + WS_EIDX); int* EPOS = (int*)(a.ws + WS_EPOS); float* EW = (float*)(a.ws + WS_EW);
    const float* fw = a.in[17] + (size_t)l * DM; const float* rb = a.in[19] + l * NE;
    const bf16* RWH = (const bf16*)(a.ws + WS_RWH) + (size_t)l * NE * DM; const bf16* RWL = (const bf16*)(a.ws + WS_RWL) + (size_t)l * NE * DM;
    for (int u = bid; u < NT / 64; u += G) {
        const int tok0 = u * 64;
        if (tid < 32) lcnt[tid] = 0;
#pragma unroll 1
        for (int hf = 0; hf < 2; ++hf) {
            __syncthreads();
#pragma unroll 1
            for (int i = 0; i < 4; ++i) { const int tl = 4 * wave + i, tok = tok0 + 32 * hf + tl;
                f32x4 v[4]; float ss = 0.f;
#pragma unroll
                for (int j = 0; j < 4; ++j) { v[j] = *(const f32x4*)(Xin_ + (size_t)tok * DM + 4 * (64 * j + lane)); const u32x2 dd = *(const u32x2*)(Dm + (size_t)tok * DM + 4 * (64 * j + lane));
                    v[j].x += bf_lo(dd.x); v[j].y += bf_hi(dd.x); v[j].z += bf_lo(dd.y); v[j].w += bf_hi(dd.y); ss += (v[j].x * v[j].x + v[j].y * v[j].y) + (v[j].z * v[j].z + v[j].w * v[j].w); }
                const float r = rsqrtf(wave_sum(ss) * (1.0f / DM) + EPS);
#pragma unroll
                for (int j = 0; j < 4; ++j) { const f32x4 y = v[j] * r * *(const f32x4*)(fw + 4 * (64 * j + lane));
                    u32x2 o; o.x = pk2(y.x, y.y); o.y = pk2(y.z, y.w); *(u32x2*)(H2 + (size_t)tok * DM + 4 * (64 * j + lane)) = o;
                    *(LAS u32x2*)(Ht + tl * RT_PITCH + 8 * (64 * j + lane)) = o; } }
            __syncthreads();
            if (wave < 2) { const int r = lane & 15, q = lane >> 4; f32x4 acc0 = {0.f, 0.f, 0.f, 0.f}, acc1 = {0.f, 0.f, 0.f, 0.f};
                const LAS unsigned char* arow = Ht + (16 * wave + r) * RT_PITCH + q * 16;
                const bf16* bh = RWH + (size_t)r * DM + 8 * q; const bf16* bl = RWL + (size_t)r * DM + 8 * q;
#pragma unroll 4
                for (int s = 0; s < 32; ++s) { const bf16x8 af = *(const LAS bf16x8*)(arow + s * 64);
                    acc0 = __builtin_amdgcn_mfma_f32_16x16x32_bf16(af, *(const bf16x8*)(bh + 32 * s), acc0, 0, 0, 0); acc0 = __builtin_amdgcn_mfma_f32_16x16x32_bf16(af, *(const bf16x8*)(bl + 32 * s), acc0, 0, 0, 0);
                    acc1 = __builtin_amdgcn_mfma_f32_16x16x32_bf16(af, *(const bf16x8*)(bh + 16 * DM + 32 * s), acc1, 0, 0, 0); acc1 = __builtin_amdgcn_mfma_f32_16x16x32_bf16(af, *(const bf16x8*)(bl + 16 * DM + 32 * s), acc1, 0, 0, 0); }
                const float b0 = rb[r], b1 = rb[16 + r];
#pragma unroll
                for (int i = 0; i < 4; ++i) { LAS float* lg = LG + (32 * hf + 16 * wave + 4 * q + i) * 33; lg[r] = acc0[i] + b0; lg[16 + r] = acc1[i] + b1; } }
        }
        __syncthreads();
        if (tid < 64) { const LAS float* lg = LG + tid * 33; unsigned used = 0u; float tv[4]; int ti[4];
#pragma unroll
            for (int qn = 0; qn < 4; ++qn) { float best = -3.0e38f; int bi = 0;
                for (int e = 0; e < NE; ++e) { const float v = lg[e]; if (!((used >> e) & 1u) && v > best) { best = v; bi = e; } }
                used |= 1u << bi; tv[qn] = best; ti[qn] = bi; }
            float ew[4], es = 0.f;
#pragma unroll
            for (int qn = 0; qn < 4; ++qn) { ew[qn] = __expf(tv[qn] - tv[0]); es += ew[qn]; }
#pragma unroll
            for (int qn = 0; qn < 4; ++qn) { const int p = __hip_atomic_fetch_add(&lcnt[ti[qn]], 1, __ATOMIC_RELAXED, __HIP_MEMORY_SCOPE_WORKGROUP); asg_e[tid * 4 + qn] = ti[qn]; asg_p[tid * 4 + qn] = p; asg_w[tid * 4 + qn] = ew[qn] / es; } }
        __syncthreads();
        if (tid < 32) gbase[tid] = (int)atomicAdd(&cnt[tid], (unsigned)lcnt[tid]);
        __syncthreads();
        if (tid < 256) { const int tok = tok0 + (tid >> 2), k = tid & 3, e = asg_e[tid];
            EIDX[(size_t)tok * 4 + k] = e; EPOS[(size_t)tok * 4 + k] = gbase[e] + asg_p[tid]; EW[(size_t)tok * 4 + k] = asg_w[tid]; }
        __syncthreads();
    }
}

__device__ __forceinline__ void build_tiles(const unsigned* cnt, LAS int* TS, LAS int* TE, int tid) {
    if (tid == 0) { int acc = 0;
        for (int e = 0; e < NE; ++e) { TS[e] = acc; const int nt = (int)((cnt[e] + 255u) >> 8); for (int i = 0; i < nt; ++i) TE[acc + i] = e; acc += nt; }
        TS[NE] = acc; }
    __syncthreads();
}

__device__ __forceinline__ void ph_gather(const Args& a, int l, LAS unsigned char* lds, int gw, int NGW, int tid, int lane) {
    LAS int* TS = (LAS int*)(lds + TS_OFF); LAS int* TE = (LAS int*)(lds + TE_OFF);
    build_tiles((const unsigned*)(a.ws + WS_CTL) + CW_CNT + 64 * l, TS, TE, tid);
    const bf16* H2 = (const bf16*)(a.ws + WS_XN); bf16* XS = (bf16*)(a.ws + WS_XS);
    const int* EIDX = (const int*)(a.ws + WS_EIDX); const int* EPOS = (const int*)(a.ws + WS_EPOS); int* SLOT = (int*)(a.ws + WS_SLOT);
    for (int tok = gw; tok < NT; tok += NGW) {
        int slot = 0;
        if (lane < 4) { const int e = EIDX[(size_t)tok * 4 + lane]; slot = TS[e] * 256 + EPOS[(size_t)tok * 4 + lane]; SLOT[(size_t)tok * 4 + lane] = slot; }
        const u32x4 r0 = *(const u32x4*)(H2 + (size_t)tok * DM + 8 * lane), r1 = *(const u32x4*)(H2 + (size_t)tok * DM + 512 + 8 * lane);
#pragma unroll
        for (int k = 0; k < 4; ++k) { const int sk = __shfl(slot, k); *(u32x4*)(XS + (size_t)sk * DM + 8 * lane) = r0; *(u32x4*)(XS + (size_t)sk * DM + 512 + 8 * lane) = r1; }
    }
}

__device__ __forceinline__ void ph_combine(const Args& a, const float* Xin_, const bf16* Dm, float* Xo, const float* next_norm_w, int gw, int NGW, int lane) {
    const bf16* YS = (const bf16*)(a.ws + WS_YS); const int* SLOT = (const int*)(a.ws + WS_SLOT); const float* EW = (const float*)(a.ws + WS_EW); bf16* XN = (bf16*)(a.ws + WS_XN);
    for (int tok = gw; tok < NT; tok += NGW) {
        int slot = 0; float wgt = 0.f;
        if (lane < 4) { slot = SLOT[(size_t)tok * 4 + lane]; wgt = EW[(size_t)tok * 4 + lane]; }
        f32x4 v[4];
#pragma unroll
        for (int j = 0; j < 4; ++j) { v[j] = *(const f32x4*)(Xin_ + (size_t)tok * DM + 4 * (64 * j + lane)); const u32x2 dd = *(const u32x2*)(Dm + (size_t)tok * DM + 4 * (64 * j + lane));
            v[j].x += bf_lo(dd.x); v[j].y += bf_hi(dd.x); v[j].z += bf_lo(dd.y); v[j].w += bf_hi(dd.y); }
#pragma unroll
        for (int k = 0; k < 4; ++k) { const int sk = __shfl(slot, k); const float wk = __shfl(wgt, k);
#pragma unroll
            for (int j = 0; j < 4; ++j) { const u32x2 y = *(const u32x2*)(YS + (size_t)sk * DM + 4 * (64 * j + lane));
                v[j].x += wk * bf_lo(y.x); v[j].y += wk * bf_hi(y.x); v[j].z += wk * bf_lo(y.y); v[j].w += wk * bf_hi(y.y); } }
#pragma unroll
        for (int j = 0; j < 4; ++j) *(f32x4*)(Xo + (size_t)tok * DM + 4 * (64 * j + lane)) = v[j];
        if (next_norm_w) rms_row_to_bf16(v, next_norm_w, XN + (size_t)tok * DM, lane);
    }
}

struct Tid { int tid, lane, wave; };
__device__ __forceinline__ Tid fresh_tid() { int t = threadIdx.x; asm volatile("" : "+v"(t)); Tid r; r.tid = t; r.lane = t & 63; r.wave = __builtin_amdgcn_readfirstlane(t >> 6); return r; }
#define FT() Args A_ = args_k; { unsigned char* w_ = args_k.ws; asm volatile("" : "+s"(w_)); A_.ws = w_; } const Args& args = A_; const Tid T_ = fresh_tid(); const int tid = T_.tid, lane = T_.lane, wave = T_.wave, gw = bid * NWAVES + wave; (void)tid; (void)lane; (void)wave; (void)gw
constexpr int PH_PER_LAYER = 11, NPH = 2 + NLAYER * PH_PER_LAYER;

#if SINGLE_LAUNCH
#define BARPARM , unsigned* barw, unsigned& bark
#define BARARG , barw, bark
#define GRID_BAR() cnt_barrier(barw, bark)
#else
#define BARPARM
#define BARARG
#define GRID_BAR() do {} while (0)
#endif
#define IN(k) (lo <= (k) && (k) < hi)
#define SEAM(k) do { if (IN(k) && IN((k) + 1)) GRID_BAR(); } while (0)
template <int l>
__device__ __forceinline__ void run_layer(const Args& args_k, LAS unsigned char* lds, int lo, int hi, int G, int bid, int NGW BARPARM) {
        const int pb = 2 + l * PH_PER_LAYER;
#define Xin ((l == 0) ? args.in[0] : (const float*)(args.ws + WS_XB))
#define X1 ((float*)(args.ws + WS_XA))
#define Xout ((l == NLAYER - 1) ? args.out : (float*)(args.ws + WS_XB))
        if (IN(pb + 0)) {
            FT(); pg8::Gemm g{(const pg8::bf16_t*)(args.ws + WS_XN), (const pg8::bf16_t*)(args.ws + WS_WIN) + (size_t)l * NP * DM, NT, NP, DM};
            pg8::StaticOrder S; S.init(NT, NP, G, bid);
            pg8::EpiBf16Plain E{(pg8::bf16_t*)(args.ws + WS_P), NP};
            pg8::gemm_phase<pg8::EpiBf16Plain, pg8::StaticOrder, true, true>(lds, g, S, E);
        } SEAM(pb + 0);
        if (IN(pb + 1)) { { FT(); ph_compress_mfma(args, l, lds, bid, G, tid, wave, lane); } { FT(); ph_m1(args, l, lds, bid, G, tid, wave, lane); } } SEAM(pb + 1);
        if (IN(pb + 2)) { FT(); ph_dn_chunk_mfma(args, lds, bid, G, tid, wave, lane); } SEAM(pb + 2);
        if (IN(pb + 3)) {
            const bool small = G <= 64;
            if (small || bid < 32) { FT(); ph_dn_scan_mfma(args, lds, bid, small ? G : 32, tid, wave, lane); }
            { int ub, us, ue;
              if (small) { ub = bid; us = G; ue = 256; }
              else if (G == 256) { if (bid >= 32) { ub = bid - 32; us = 32; ue = ub >= 192 ? 256 : ub + 1; } else { ub = 256; us = 256; ue = 256; } }
              else { ub = bid >= 32 ? bid - 32 : 256; us = G - 32; ue = 256; }
              FT(); ph_nsa_mfma(args, lds, ub, us, ue, tid, wave, lane); } } SEAM(pb + 3);
        if (IN(pb + 4)) { FT(); ph_dn_out(args, l, gw, NGW, lane); } SEAM(pb + 4);
        if (IN(pb + 5)) {
            FT(); pg8::Gemm g{(const pg8::bf16_t*)(args.ws + WS_Y), (const pg8::bf16_t*)(args.ws + WS_WOUT) + (size_t)l * DM * DM, NT, DM, DM};
            pg8::StaticOrder S; S.init(NT, DM, G, bid);
            pg8::EpiBf16Plain E{(pg8::bf16_t*)(args.ws + WS_XA), DM};
            pg8::gemm_phase<pg8::EpiBf16Plain, pg8::StaticOrder, true, true>(lds, g, S, E);
        } SEAM(pb + 5);
        if (IN(pb + 6)) { FT(); ph_router(args, l, Xin, (const bf16*)(args.ws + WS_XA), lds, bid, G, tid, wave, lane); } SEAM(pb + 6);
        if (IN(pb + 7)) { FT(); ph_gather(args, l, lds, gw, NGW, tid, lane); } SEAM(pb + 7);
        if (IN(pb + 8)) {
            FT(); LAS int* TS = (LAS int*)(lds + TS_OFF); LAS int* TE = (LAS int*)(lds + TE_OFF);
            build_tiles((const unsigned*)(args.ws + WS_CTL) + CW_CNT + 64 * l, TS, TE, tid);
            const int ntiles = __builtin_amdgcn_readfirstlane(TS[NE]);
            pg8::Gemm g{(const pg8::bf16_t*)(args.ws + WS_XS), (const pg8::bf16_t*)(args.ws + WS_WGU) + (size_t)l * NE * 2048 * DM, ntiles * 256, NE * 2048, DM};
            pg8::MoeOrder<8> S{ntiles, G, bid, (const LAS int*)TE};
            pg8::EpiSwiglu E{(pg8::bf16_t*)(args.ws + WS_ACT), args.in[21] + (size_t)l * NE * 2048};
            pg8::gemm_phase<pg8::EpiSwiglu, pg8::MoeOrder<8>, true, true>(lds, g, S, E);
        } SEAM(pb + 8);
        if (IN(pb + 9)) {
            FT(); LAS int* TS = (LAS int*)(lds + TS_OFF); LAS int* TE = (LAS int*)(lds + TE_OFF);
            build_tiles((const unsigned*)(args.ws + WS_CTL) + CW_CNT + 64 * l, TS, TE, tid);
            const int ntiles = __builtin_amdgcn_readfirstlane(TS[NE]);
            pg8::Gemm g{(const pg8::bf16_t*)(args.ws + WS_ACT), (const pg8::bf16_t*)(args.ws + WS_WD) + (size_t)l * NE * DM * DM, ntiles * 256, NE * DM, DM};
            pg8::MoeOrder<4> S{ntiles, G, bid, (const LAS int*)TE};
            pg8::EpiDown E{(pg8::bf16_t*)(args.ws + WS_YS), args.in[23] + (size_t)l * NE * DM};
            pg8::gemm_phase<pg8::EpiDown, pg8::MoeOrder<4>, true, true>(lds, g, S, E);
        } SEAM(pb + 9);
        if (IN(pb + 10)) { FT(); ph_combine(args, Xin, (const bf16*)(args.ws + WS_XA), Xout, (l + 1 < NLAYER) ? args.in[1] + (size_t)(l + 1) * DM : nullptr, gw, NGW, lane); }
        if (l + 1 < NLAYER) SEAM(pb + 10);
    }

__global__ void __launch_bounds__(NTHR, 2) fwd_kernel(Args args_k) {
    extern __shared__ __attribute__((aligned(16))) unsigned char lds_raw[];
    LAS unsigned char* lds = (LAS unsigned char*)lds_raw;
    const int G = gridDim.x, bid = blockIdx.x, NGW = G * NWAVES;
    for (int u = threadIdx.x; u < (LDS_BYTES - LDSCTL_OFF) / 4; u += NTHR) ((LAS unsigned*)(lds + LDSCTL_OFF))[u] = 0u;
    __syncthreads();
#if SINGLE_LAUNCH
    unsigned* barw = (unsigned*)(args_k.ws + WS_CTL) + CW_BAR; unsigned bark = 0u;
#endif
    const int lo = args_k.ph_lo, hi = args_k.ph_hi;

    if (IN(0)) { FT(); ph_prologue(args, lds, gw, NGW, wave, lane); } SEAM(0);
    if (IN(1)) { FT(); ph_norm0(args, gw, NGW, lane); } SEAM(1);

    run_layer<0>(args_k, lds, lo, hi, G, bid, NGW BARARG);
    run_layer<1>(args_k, lds, lo, hi, G, bid, NGW BARARG);
#undef IN
#undef SEAM
}

extern "C" void kernel_launch(void* const* d_in, const int* in_sizes, int n_in, void* d_out, int out_size, void* d_ws, size_t ws_size, hipStream_t stream) {
    static int grid = 0;
    if (grid == 0) {
        if (n_in != 25 || in_sizes[0] != NT * DM || out_size != NT * DM || ws_size < WS_END) {
            fprintf(stderr, "kernel_launch: unexpected problem (n_in %d, in0 %d, out %d, ws %zu < %zu); nothing launched\n", n_in, n_in > 0 ? in_sizes[0] : -1, out_size, ws_size, (size_t)WS_END); grid = -1; return; }
        int dev = 0, cus = 0, per_cu = 0;
        if (hipGetDevice(&dev) != hipSuccess || hipDeviceGetAttribute(&cus, hipDeviceAttributeMultiprocessorCount, dev) != hipSuccess) { grid = -1; return; }
        if (hipFuncSetAttribute((const void*)fwd_kernel, hipFuncAttributeMaxDynamicSharedMemorySize, LDS_BYTES) != hipSuccess) { fprintf(stderr, "kernel_launch: hipFuncSetAttribute failed\n"); grid = -1; return; }
        if (hipOccupancyMaxActiveBlocksPerMultiprocessor(&per_cu, (const void*)fwd_kernel, NTHR, LDS_BYTES) != hipSuccess || per_cu < 1)
            fprintf(stderr, "kernel_launch: note: occupancy query reports %d workgroups per CU\n", per_cu);
        (void)hipGetLastError();
        grid = cus;
    }
    if (grid < 0) return;
    if (hipMemsetAsync((char*)d_ws + WS_CTL, 0, CTL_ZERO_BYTES, stream) != hipSuccess) { fprintf(stderr, "kernel_launch: memset failed\n"); return; }
    Args a{};
    for (int i = 0; i < 25; ++i) a.in[i] = (const float*)d_in[i];
    a.out = (float*)d_out; a.ws = (unsigned char*)d_ws;
#if SINGLE_LAUNCH
    a.ph_lo = 0; a.ph_hi = NPH;
    hipLaunchKernelGGL(fwd_kernel, dim3(grid), dim3(NTHR), LDS_BYTES, stream, a);
#else
    for (int ph = 0; ph < NPH; ++ph) { a.ph_lo = ph; a.ph_hi = ph + 1; hipLaunchKernelGGL(fwd_kernel, dim3(grid), dim3(NTHR), LDS_BYTES, stream, a); }
#endif
}
```

```cpp
#include <hip/hip_runtime.h>
#include <cstdio>
#include <cstdint>
#include <cstddef>
namespace pg8 {
#define PG8_LAS __attribute__((address_space(3)))
#define PG8_GAS __attribute__((address_space(1)))
typedef unsigned short bf16_t;
typedef short bf16x8 __attribute__((ext_vector_type(8)));
typedef float f32x4 __attribute__((ext_vector_type(4)));
typedef unsigned u32x4 __attribute__((ext_vector_type(4)));
constexpr int BM = 256, BK = 64, HALF = 128, HTB = HALF * BK * 2  , STAGE_BYTES = 8 * HTB, NXCD = 8, WGM = 8;

__host__ __device__ __forceinline__ int lds_byte(int r, int c) { const int st = (r >> 4) * 2 + (c >> 5), rr = r & 15, cc = c & 31, ob = rr * 64 + cc * 2; return st * 1024 + (ob ^ (((ob >> 9) & 1) << 5)); }
__host__ __device__ __forceinline__ void stage_rc(int b, int& R, int& C) { const int st = b / 1024, sb = b % 1024, swz = sb ^ (((sb >> 9) & 1) << 5); R = (st >> 1) * 16 + swz / 64; C = (st & 1) * 32 + (swz % 64) / 2; }
__host__ __device__ __forceinline__ int perm32(int rho) { const int n = rho >> 4, i = rho & 15; return 8 * (i >> 2) + 4 * n + (i & 3); }

struct Unit { int pm, pn; };
struct Gemm { const bf16_t* A; const bf16_t* Bt; int M, N, K; };

struct StaticOrder {
    int nM, nN, nwg, G, c;
    __host__ __device__ void init(int M, int N, int G_, int c_) { nM = M / BM; nN = N / BM; nwg = nM * nN; G = G_; c = c_; }
    __host__ __device__ bool next(int i, Unit& u) const {
        const long L = (long)i * G + c; if (L >= nwg) return false;
        int wgid = (int)L; { const int q = nwg / NXCD, r = nwg % NXCD, xcd = wgid % NXCD, off = wgid / NXCD; wgid = (xcd < r ? xcd * (q + 1) : r * (q + 1) + (xcd - r) * q) + off; }
        const int nig = WGM * nN, gid = wgid / nig, fm = gid * WGM, gsz = (nM - fm) < WGM ? (nM - fm) : WGM;
        u.pm = fm + ((wgid % nig) % gsz); u.pn = (wgid % nig) / gsz; return true;
    }
    __device__ __forceinline__ void a_ready(const Unit&) const {}
    __device__ __forceinline__ void done(const Unit&) const {}
};

__device__ __forceinline__ unsigned cvt_pk_bf16(float lo, float hi) { unsigned r; asm volatile("v_cvt_pk_bf16_f32 %0, %1, %2" : "=v"(r) : "v"(lo), "v"(hi)); return r; }

struct EpiBf16Plain {
    static constexpr bool PERM = true, AFTER_DRAIN = false, B64 = false;
    bf16_t* O; int ldc;
    __device__ __forceinline__ void operator()(const f32x4 (&acc)[2][2][4][2], const Unit& u, int wr, int wc, int fr, int fq) const {
        const int row0 = u.pm * BM + wr * 64 + fr, col0 = u.pn * BM + wc * 32 + 8 * fq;
#pragma unroll
        for (int ai = 0; ai < 2; ++ai)
#pragma unroll
            for (int m = 0; m < 4; ++m) { bf16_t* rowp = O + (size_t)(row0 + ai * HALF + m * 16) * ldc + col0;
#pragma unroll
                for (int bj = 0; bj < 2; ++bj) { const f32x4 v0 = acc[ai][bj][m][0], v1 = acc[ai][bj][m][1];
                    u32x4 w; w.x = cvt_pk_bf16(v0[0], v0[1]); w.y = cvt_pk_bf16(v0[2], v0[3]); w.z = cvt_pk_bf16(v1[0], v1[1]); w.w = cvt_pk_bf16(v1[2], v1[3]);
                    *(PG8_GAS u32x4*)(rowp + bj * HALF) = w; } }
    }
};
struct EpiResF32 {
    static constexpr bool PERM = false, AFTER_DRAIN = false, B64 = false;
    const float* base; float* out; int ldc;
    __device__ __forceinline__ void operator()(const f32x4 (&acc)[2][2][4][2], const Unit& u, int wr, int wc, int fr, int fq) const {
        const int row0 = u.pm * BM + wr * 64 + fr, col0 = u.pn * BM + wc * 32 + 4 * fq;
#pragma unroll
        for (int ai = 0; ai < 2; ++ai)
#pragma unroll
            for (int m = 0; m < 4; ++m) { const size_t off = (size_t)(row0 + ai * HALF + m * 16) * ldc + col0;
#pragma unroll
                for (int bj = 0; bj < 2; ++bj)
#pragma unroll
                    for (int n = 0; n < 2; ++n) { const f32x4 b = *(const f32x4*)(base + off + bj * HALF + n * 16); *(PG8_GAS f32x4*)(out + off + bj * HALF + n * 16) = b + acc[ai][bj][m][n]; } }
    }
};
struct EpiSwiglu {
    static constexpr bool PERM = true, AFTER_DRAIN = false, B64 = false;
    bf16_t* O; const float* bgu;
    __device__ __forceinline__ void operator()(const f32x4 (&acc)[2][2][4][2], const Unit& u, int wr, int wc, int fr, int fq) const {
        const int e = u.pn >> 3, pnl = u.pn & 7;
        const int row0 = u.pm * BM + wr * 64 + fr, gcol = pnl * 128 + wc * 32 + 8 * fq;
        const float* bg = bgu + (size_t)e * 2048 + gcol;
        f32x4 bgv[2], buv[2];
#pragma unroll
        for (int n = 0; n < 2; ++n) { bgv[n] = *(const PG8_GAS f32x4*)(bg + 4 * n); buv[n] = *(const PG8_GAS f32x4*)(bg + 1024 + 4 * n); }
#pragma unroll
        for (int ai = 0; ai < 2; ++ai)
#pragma unroll
            for (int m = 0; m < 4; ++m) { bf16_t* rowp = O + (size_t)(row0 + ai * HALF + m * 16) * 1024 + gcol;
                float r[8];
#pragma unroll
                for (int n = 0; n < 2; ++n) { const f32x4 gv = acc[ai][0][m][n] + bgv[n], uv = acc[ai][1][m][n] + buv[n];
#pragma unroll
                    for (int j = 0; j < 4; ++j) { const float g = fminf(gv[j], 7.0f), up = fminf(fmaxf(uv[j], -7.0f), 7.0f);
                        const float sg = __builtin_amdgcn_rcpf(1.0f + __expf(-1.702f * g)); r[n * 4 + j] = (up + 1.0f) * g * sg; } }
                u32x4 w; w.x = cvt_pk_bf16(r[0], r[1]); w.y = cvt_pk_bf16(r[2], r[3]); w.z = cvt_pk_bf16(r[4], r[5]); w.w = cvt_pk_bf16(r[6], r[7]);
                *(PG8_GAS u32x4*)rowp = w; }
    }
};
struct EpiDown {
    static constexpr bool PERM = true, AFTER_DRAIN = false, B64 = false;
    bf16_t* O; const float* bd;
    __device__ __forceinline__ void operator()(const f32x4 (&acc)[2][2][4][2], const Unit& u, int wr, int wc, int fr, int fq) const {
        const int e = u.pn >> 2, pnl = u.pn & 3;
        const int row0 = u.pm * BM + wr * 64 + fr, col0 = pnl * BM + wc * 32 + 8 * fq;
        const float* bp = bd + (size_t)e * 1024 + col0;
        f32x4 bv[2][2];
#pragma unroll
        for (int bj = 0; bj < 2; ++bj)
#pragma unroll
            for (int n = 0; n < 2; ++n) bv[bj][n] = *(const PG8_GAS f32x4*)(bp + bj * HALF + 4 * n);
#pragma unroll
        for (int ai = 0; ai < 2; ++ai)
#pragma unroll
            for (int m = 0; m < 4; ++m) { bf16_t* rowp = O + (size_t)(row0 + ai * HALF + m * 16) * 1024 + col0;
#pragma unroll
                for (int bj = 0; bj < 2; ++bj) { const f32x4 v0 = acc[ai][bj][m][0] + bv[bj][0], v1 = acc[ai][bj][m][1] + bv[bj][1];
                    u32x4 w; w.x = cvt_pk_bf16(v0[0], v0[1]); w.y = cvt_pk_bf16(v0[2], v0[3]); w.z = cvt_pk_bf16(v1[0], v1[1]); w.w = cvt_pk_bf16(v1[2], v1[3]);
                    *(PG8_GAS u32x4*)(rowp + bj * HALF) = w; } }
    }
};
struct EpiDown64 {
    static constexpr bool PERM = true, AFTER_DRAIN = false, B64 = true;
    bf16_t* O; const float* bd;
    __device__ __forceinline__ void operator()(const f32x4 (&acc)[2][2][4][2], const Unit& u, int wr, int wc, int fr, int fq) const {
        const int e = u.pn >> 2, pnl = u.pn & 3;
        const int row0 = u.pm * BM + wr * 64 + fr, col0 = pnl * BM + wc * 64 + 8 * fq;
        const float* bp = bd + (size_t)e * 1024 + col0;
        f32x4 bv[2][2];
#pragma unroll
        for (int bj = 0; bj < 2; ++bj)
#pragma unroll
            for (int n = 0; n < 2; ++n) bv[bj][n] = *(const PG8_GAS f32x4*)(bp + bj * 32 + 4 * n);
#pragma unroll
        for (int ai = 0; ai < 2; ++ai)
#pragma unroll
            for (int m = 0; m < 4; ++m) { bf16_t* rowp = O + (size_t)(row0 + ai * HALF + m * 16) * 1024 + col0;
#pragma unroll
                for (int bj = 0; bj < 2; ++bj) { const f32x4 v0 = acc[ai][bj][m][0] + bv[bj][0], v1 = acc[ai][bj][m][1] + bv[bj][1];
                    u32x4 w; w.x = cvt_pk_bf16(v0[0], v0[1]); w.y = cvt_pk_bf16(v0[2], v0[3]); w.z = cvt_pk_bf16(v1[0], v1[1]); w.w = cvt_pk_bf16(v1[2], v1[3]);
                    *(PG8_GAS u32x4*)(rowp + bj * 32) = w; } }
    }
};
struct EpiBf16Plain64 {
    static constexpr bool PERM = true, AFTER_DRAIN = false, B64 = true;
    bf16_t* O; int ldc;
    __device__ __forceinline__ void operator()(const f32x4 (&acc)[2][2][4][2], const Unit& u, int wr, int wc, int fr, int fq) const {
        const int row0 = u.pm * BM + wr * 64 + fr, col0 = u.pn * BM + wc * 64 + 8 * fq;
#pragma unroll
        for (int ai = 0; ai < 2; ++ai)
#pragma unroll
            for (int m = 0; m < 4; ++m) { bf16_t* rowp = O + (size_t)(row0 + ai * HALF + m * 16) * ldc + col0;
#pragma unroll
                for (int bj = 0; bj < 2; ++bj) { const f32x4 v0 = acc[ai][bj][m][0], v1 = acc[ai][bj][m][1];
                    u32x4 w; w.x = cvt_pk_bf16(v0[0], v0[1]); w.y = cvt_pk_bf16(v0[2], v0[3]); w.z = cvt_pk_bf16(v1[0], v1[1]); w.w = cvt_pk_bf16(v1[2], v1[3]);
                    *(PG8_GAS u32x4*)(rowp + bj * 32) = w; } }
    }
};
template <int NPN> struct MoeOrder {
    int ntiles, G, c; const PG8_LAS int* texp;
    __device__ __forceinline__ bool next(int i, Unit& u) const {
        constexpr int MT = 32 / NPN; int mt, pn;
        if (G == 256) { const int chunk = i * 8 + (c & 7), r = c >> 3; pn = r / MT; mt = chunk * MT + (r % MT); }
        else { const int L = i * G + c; mt = L / NPN; pn = L % NPN; }
        mt = __builtin_amdgcn_readfirstlane(mt); if (mt >= ntiles) return false;
        const int e = __builtin_amdgcn_readfirstlane(texp[mt]);
        u.pm = mt; u.pn = e * NPN + pn; return true;
    }
    __device__ __forceinline__ void a_ready(const Unit&) const {}
    __device__ __forceinline__ void done(const Unit&) const {}
};

template <class Epi, class Sched, bool ALIGN_EPI = false, bool SP2 = false>
__device__ __forceinline__ void gemm_phase(PG8_LAS unsigned char* lds, const Gemm g, const Sched& S, const Epi& E) {
    int tid_ = threadIdx.x; asm volatile("" : "+v"(tid_));
    const int tid = tid_, wid = __builtin_amdgcn_readfirstlane(tid >> 6), lane = tid & 63, wr = wid >> 2, wc = wid & 3, fr = lane & 15, fq = lane >> 4;
    const int K = g.K, nt = K / BK;
    unsigned voffA[2], voffB[2];
#pragma unroll
    for (int i = 0; i < 2; ++i) { int R, C; stage_rc(tid * 16 + i * 8192, R, C); const int Rb = Epi::B64 ? ((R >> 5) * 64 + perm32(R & 31)) : (Epi::PERM ? ((R & ~31) + perm32(R & 31)) : R);
        voffA[i] = (unsigned)(R * K + C) * 2u; voffB[i] = (unsigned)(Rb * K + C) * 2u; }
    const size_t kstep = (size_t)(BK * 2);
    const size_t hstep = (size_t)HALF * K * 2;
    const size_t tstep = 2 * hstep;
    const size_t hstepB = Epi::B64 ? (size_t)32 * K * 2 : hstep;
    const unsigned ldsw = (unsigned)wid * 1024u;
    const int aoff = lds_byte(wr * 64 + fr, fq * 8), boff = lds_byte(wc * 32 + fr, fq * 8);
#define PG8_SA(b, h) (((b) * 2 + (h)) * HTB)
#define PG8_SB(b, h) ((4 + (b) * 2 + (h)) * HTB)
#define PG8_STAGE(bufoff, gbase, voff) do { _Pragma("unroll") for (int _i = 0; _i < 2; ++_i) \
        __builtin_amdgcn_global_load_lds((const unsigned*)((const char*)(gbase) + (voff)[_i]), (PG8_LAS unsigned*)(lds + (bufoff) + ldsw + _i * 8192), 16, 0, 0); } while (0)
#define PG8_LDA(dst, b, h) do { _Pragma("unroll") for (int m = 0; m < 4; ++m) _Pragma("unroll") for (int k = 0; k < 2; ++k) dst[m][k] = *(const PG8_LAS bf16x8*)(lds + PG8_SA(b, h) + aoff + m * 2048 + k * 1024); } while (0)
#define PG8_LDB(dst, b, h) do { _Pragma("unroll") for (int n = 0; n < 2; ++n) _Pragma("unroll") for (int k = 0; k < 2; ++k) dst[n][k] = *(const PG8_LAS bf16x8*)(lds + PG8_SB(b, h) + boff + n * 2048 + k * 1024); } while (0)
#define PG8_MMA(ai, bj, At, Bt) do { __builtin_amdgcn_s_setprio(1); _Pragma("unroll") for (int m = 0; m < 4; ++m) _Pragma("unroll") for (int n = 0; n < 2; ++n) _Pragma("unroll") for (int k = 0; k < 2; ++k) \
        acc[ai][bj][m][n] = __builtin_amdgcn_mfma_f32_16x16x32_bf16(Bt[n][k], At[m][k], acc[ai][bj][m][n], 0, 0, 0); __builtin_amdgcn_s_setprio(0); } while (0)
#define PG8_WAIT_V(n) asm volatile("s_waitcnt vmcnt(" #n ")" ::: "memory")
#define PG8_WAIT_L(n) asm volatile("s_waitcnt lgkmcnt(" #n ")" ::: "memory")
#define PG8_BAR __builtin_amdgcn_s_barrier()
#define PG8_SCHED __builtin_amdgcn_sched_barrier(0)
    Unit cur, nxt; int ui = 0;
    if (!S.next(0, cur)) return;
    f32x4 acc[2][2][4][2];
#pragma unroll
    for (int a = 0; a < 2; ++a)
#pragma unroll
        for (int b = 0; b < 2; ++b)
#pragma unroll
            for (int m = 0; m < 4; ++m)
#pragma unroll
                for (int n = 0; n < 2; ++n) acc[a][b][m][n] = (f32x4){0.f, 0.f, 0.f, 0.f};
    bf16x8 At[4][2], B0[2][2], B1[2][2];
    const char* cA = (const char*)g.A + (size_t)cur.pm * tstep; const char* cB = (const char*)g.Bt + (size_t)cur.pn * tstep;
    S.a_ready(cur);
    if constexpr (SP2) {
        PG8_STAGE(PG8_SB(0, 0), cB, voffB); PG8_STAGE(PG8_SB(0, 1), cB + hstepB, voffB); PG8_STAGE(PG8_SA(0, 0), cA, voffA); PG8_STAGE(PG8_SA(0, 1), cA + hstep, voffA);
        if (wr == 1) PG8_BAR;
        PG8_WAIT_V(2); PG8_BAR;
        PG8_STAGE(PG8_SB(1, 0), cB + kstep, voffB); PG8_STAGE(PG8_SA(1, 0), cA + kstep, voffA); PG8_STAGE(PG8_SB(1, 1), cB + hstepB + kstep, voffB);
        PG8_WAIT_V(6); PG8_BAR;
    } else {
        PG8_STAGE(PG8_SB(0, 0), cB, voffB); PG8_STAGE(PG8_SA(0, 0), cA, voffA); PG8_STAGE(PG8_SB(0, 1), cB + hstepB, voffB); PG8_STAGE(PG8_SA(0, 1), cA + hstep, voffA);
        if (wr == 1) PG8_BAR;
        PG8_WAIT_V(4); PG8_BAR;
        PG8_STAGE(PG8_SB(1, 0), cB + kstep, voffB); PG8_STAGE(PG8_SA(1, 0), cA + kstep, voffA); PG8_STAGE(PG8_SB(1, 1), cB + hstepB + kstep, voffB);
        PG8_WAIT_V(6); PG8_BAR;
    }
    for (;;) {
        const bool has_next = S.next(ui + 1, nxt);
        const char* nA = has_next ? (const char*)g.A + (size_t)nxt.pm * tstep : cA; const char* nB = has_next ? (const char*)g.Bt + (size_t)nxt.pn * tstep : cB;
        for (int t = 0; t < nt; t += 2) {
            const bool last = (t == nt - 2);
            const char* a1 = cA + (size_t)(t + 1) * kstep;
            const char* a2 = last ? nA : cA + (size_t)(t + 2) * kstep; const char* b2 = last ? nB : cB + (size_t)(t + 2) * kstep;
            const char* a3 = a2 + kstep; const char* b3 = b2 + kstep;
            if (last && has_next) S.a_ready(nxt);
            if constexpr (SP2) {
            PG8_LDB(B0, 0, 0); PG8_LDB(B1, 0, 1); PG8_SCHED; PG8_LDA(At, 0, 0); PG8_STAGE(PG8_SA(1, 1), a1 + hstep, voffA);
            PG8_WAIT_V(8); PG8_WAIT_L(0); PG8_BAR; PG8_MMA(0, 0, At, B0); PG8_MMA(0, 1, At, B1); PG8_BAR; PG8_SCHED;
            PG8_LDA(At, 0, 1); PG8_STAGE(PG8_SB(0, 0), b2, voffB); PG8_STAGE(PG8_SB(0, 1), b2 + hstepB, voffB); PG8_STAGE(PG8_SA(0, 0), a2, voffA);
            PG8_WAIT_V(8); PG8_WAIT_L(0); PG8_BAR; PG8_MMA(1, 0, At, B0); PG8_MMA(1, 1, At, B1); PG8_BAR; PG8_SCHED;
            PG8_LDB(B0, 1, 0); PG8_LDB(B1, 1, 1); PG8_SCHED; PG8_LDA(At, 1, 0); PG8_STAGE(PG8_SA(0, 1), a2 + hstep, voffA);
            PG8_WAIT_V(8); PG8_WAIT_L(0); PG8_BAR; PG8_MMA(0, 0, At, B0); PG8_MMA(0, 1, At, B1); PG8_BAR; PG8_SCHED;
            PG8_LDA(At, 1, 1); PG8_STAGE(PG8_SB(1, 0), b3, voffB); PG8_STAGE(PG8_SB(1, 1), b3 + hstepB, voffB); PG8_STAGE(PG8_SA(1, 0), a3, voffA);
            PG8_WAIT_V(8); PG8_WAIT_L(0); PG8_BAR; PG8_MMA(1, 0, At, B0); PG8_MMA(1, 1, At, B1); PG8_BAR; PG8_SCHED;
            } else {
            PG8_LDB(B0, 0, 0); PG8_SCHED; PG8_LDA(At, 0, 0); PG8_STAGE(PG8_SA(1, 1), a1 + hstep, voffA);
            PG8_WAIT_L(8); PG8_BAR; PG8_WAIT_L(0); PG8_MMA(0, 0, At, B0); PG8_BAR; PG8_SCHED;
            PG8_LDB(B1, 0, 1); PG8_STAGE(PG8_SB(0, 0), b2, voffB);
            PG8_BAR; PG8_WAIT_L(0); PG8_MMA(0, 1, At, B1); PG8_BAR;
            PG8_LDA(At, 0, 1); PG8_STAGE(PG8_SA(0, 0), a2, voffA);
            PG8_BAR; PG8_WAIT_L(0); PG8_MMA(1, 0, At, B0); PG8_BAR; PG8_SCHED;
            PG8_STAGE(PG8_SB(0, 1), b2 + hstepB, voffB);
            PG8_WAIT_V(6); PG8_BAR; PG8_MMA(1, 1, At, B1); PG8_BAR;
            PG8_LDB(B0, 1, 0); PG8_SCHED; PG8_LDA(At, 1, 0); PG8_STAGE(PG8_SA(0, 1), a2 + hstep, voffA);
            PG8_WAIT_L(8); PG8_BAR; PG8_WAIT_L(0); PG8_MMA(0, 0, At, B0); PG8_BAR; PG8_SCHED;
            PG8_LDB(B1, 1, 1); PG8_STAGE(PG8_SB(1, 0), b3, voffB);
            PG8_BAR; PG8_WAIT_L(0); PG8_MMA(0, 1, At, B1); PG8_BAR;
            PG8_LDA(At, 1, 1); PG8_STAGE(PG8_SA(1, 0), a3, voffA);
            PG8_BAR; PG8_WAIT_L(0); PG8_MMA(1, 0, At, B0); PG8_BAR; PG8_SCHED;
            PG8_STAGE(PG8_SB(1, 1), b3 + hstepB, voffB);
            PG8_WAIT_V(6); PG8_BAR; PG8_MMA(1, 1, At, B1); PG8_BAR;
            }
        }
        if constexpr (ALIGN_EPI) { if (wr == 0) PG8_BAR; }
        if constexpr (!Epi::AFTER_DRAIN) { E(acc, cur, wr, wc, fr, fq); S.done(cur); }
        if (!has_next) break;
#pragma unroll
        for (int a = 0; a < 2; ++a)
#pragma unroll
            for (int b = 0; b < 2; ++b)
#pragma unroll
                for (int m = 0; m < 4; ++m)
#pragma unroll
                    for (int n = 0; n < 2; ++n) acc[a][b][m][n] = (f32x4){0.f, 0.f, 0.f, 0.f};
        cur = nxt; cA = nA; cB = nB; ++ui;
        if constexpr (ALIGN_EPI) { if (wr == 1) PG8_BAR; }
    }
    PG8_WAIT_V(0);
    if constexpr (!ALIGN_EPI) { if (wr == 0) PG8_BAR; }
    PG8_BAR;
    if constexpr (Epi::AFTER_DRAIN) { E.fused(acc, cur, wr, wc, fr, fq, lds, wid, lane); S.done(cur); }
#undef PG8_SA
#undef PG8_SB
#undef PG8_STAGE
#undef PG8_LDA
#undef PG8_LDB
#undef PG8_MMA
#undef PG8_WAIT_V
#undef PG8_WAIT_L
#undef PG8_BAR
#undef PG8_SCHED
}
}


#define GAS __attribute__((address_space(1)))
typedef unsigned short bf16;
typedef float f32x4 __attribute__((ext_vector_type(4)));
typedef unsigned u32x4 __attribute__((ext_vector_type(4)));
typedef unsigned u32x2 __attribute__((ext_vector_type(2)));
typedef short bf16x8 __attribute__((ext_vector_type(8)));
typedef float f32x16 __attribute__((ext_vector_type(16)));

#ifndef SINGLE_LAUNCH
#define SINGLE_LAUNCH 1
#endif

constexpr int NB = 8, SEQ = 2048, DM = 1024, NT = NB * SEQ, NLAYER = 2;
constexpr int DIN = 3220, NP = 3328;
constexpr int C_Q = 0, C_K = 512, C_V = 1024, C_Z = 1536, C_NQ = 2048, C_KV = 2304, C_CU = 2688, C_A = 3200, C_B = 3204, C_G = 3208;
constexpr int NE = 32, MAXT = 288;
constexpr int NWAVES = 8, NTHR = 512;
constexpr float EPS = 1e-6f;

constexpr size_t MiB = 1u << 20;
constexpr size_t WS_CTL = 0, CTL_ZERO_BYTES = 1 * MiB;
constexpr size_t WS_BT = 1 * MiB;
constexpr size_t WS_KCMP = 1 * MiB + 256 * 1024, WS_VCMP = 1 * MiB + 512 * 1024;
constexpr size_t WS_G = 2 * MiB, WS_BETA = 2 * MiB + 256 * 1024, WS_GC = 2 * MiB + 512 * 1024;
constexpr size_t WS_EIDX = 3 * MiB, WS_EPOS = 3 * MiB + 256 * 1024, WS_EW = 3 * MiB + 512 * 1024, WS_SLOT = 3 * MiB + 768 * 1024;
constexpr size_t WS_WIN = 4 * MiB;
constexpr size_t WS_WOUT = 17 * MiB;
constexpr size_t WS_WGU = 22 * MiB;
constexpr size_t WS_WD = 278 * MiB;
constexpr size_t WS_XA = 406 * MiB, WS_XB = 470 * MiB;
constexpr size_t WS_XN = 534 * MiB;
constexpr size_t WS_P = 566 * MiB;
constexpr size_t WS_QN = 670 * MiB, WS_KN = 686 * MiB, WS_VC = 702 * MiB;
constexpr size_t WS_U = 718 * MiB, WS_W = 750 * MiB;
constexpr size_t WS_ATT = 782 * MiB;
constexpr size_t WS_O = 798 * MiB;
constexpr size_t WS_NQ = 830 * MiB;
constexpr size_t WS_KS = 846 * MiB, WS_KW = 848 * MiB;
constexpr size_t WS_Y = 850 * MiB;
constexpr size_t WS_XS = 882 * MiB, WS_ACT = 1026 * MiB, WS_YS = 1170 * MiB;
constexpr size_t WS_KT = 1314 * MiB, WS_VT = 1330 * MiB;
constexpr size_t WS_W1T = 1346 * MiB;
constexpr size_t WS_POSW = 1349 * MiB;
constexpr size_t WS_RWH = 1350 * MiB, WS_RWL = 1351 * MiB;
constexpr size_t WS_END = 1352 * MiB;

constexpr int CW_TMO = 0, CW_BAR = 4096, CW_CNT = 16384;

constexpr int RING_BYTES = 131072;
constexpr int LDSCTL_OFF = RING_BYTES, MISC_OFF = LDSCTL_OFF, TS_OFF = LDSCTL_OFF + 128, TE_OFF = LDSCTL_OFF + 320;
constexpr int LDS_BYTES = 147456;
static_assert(TE_OFF + MAXT * 4 + 64 <= LDS_BYTES, "LDS map");

#define XB_TMO      128
#define XB_XCNT(j)  (256  + 64 * (j))
#define XB_XSUB(j)  (1280 + 64 * (j))
#define XB_XGEN(j)  (2304 + 64 * (j))
#define XB_TOP      3328
#define XB_TOPGEN   3392
#define XCD_BAR_WORDS 3456
#define XB_SPIN_CAP (1u << 22)
#define LAS __attribute__((address_space(3)))

__device__ __forceinline__ unsigned xb_ld(unsigned* p)              { return __hip_atomic_load(p, __ATOMIC_RELAXED, __HIP_MEMORY_SCOPE_AGENT); }
__device__ __forceinline__ unsigned xb_add(unsigned* p, unsigned v) { return __hip_atomic_fetch_add(p, v, __ATOMIC_RELAXED, __HIP_MEMORY_SCOPE_AGENT); }
__device__ __forceinline__ unsigned xb_xcc_id() { return (unsigned)__builtin_amdgcn_s_getreg((3 << 11) | 20) & 0xFu; }
#define XB_SPIN(cond, bar) do { unsigned _sp = 0; while (cond) { __builtin_amdgcn_s_sleep(1); \
    if ((++_sp & 255u) == 0u) { if (xb_ld(&(bar)[XB_TMO])) break; if (_sp > XB_SPIN_CAP) { atomicAdd(&(bar)[XB_TMO], 1u); break; } } } } while (0)

struct XcdBarrier {
    unsigned* bar; unsigned x;
    volatile LAS unsigned* st;
};

__device__ __forceinline__ XcdBarrier xcd_barrier_post(unsigned* bar, volatile LAS unsigned* st) {
    XcdBarrier b; b.bar = bar; b.x = xb_xcc_id(); b.st = st;
    if (threadIdx.x == 0) (void)xb_add(&bar[XB_XCNT(b.x)], 1u);
    return b;
}
__device__ __forceinline__ void xcd_barrier_complete(unsigned* bar, unsigned x, unsigned& nloc, unsigned& nx) {
    const unsigned G = gridDim.x * gridDim.y * gridDim.z;
    unsigned sum, cnt, mine, sp = 0u;
    for (;;) {
        sum = 0u; cnt = 0u; mine = 0u;
#pragma unroll
        for (unsigned j = 0; j < 16; ++j) { const unsigned c = xb_ld(&bar[XB_XCNT(j)]); sum += c; cnt += (c > 0u) ? 1u : 0u; mine = (j == x) ? c : mine; }
        if (sum == G) break;
        __builtin_amdgcn_s_sleep(1);
        if ((++sp & 255u) == 0u) { if (xb_ld(&bar[XB_TMO])) break; if (sp > XB_SPIN_CAP) { atomicAdd(&bar[XB_TMO], 1u); break; } }
    }
    nloc = mine > 0u ? mine : 1u; nx = cnt > 0u ? cnt : 1u;
}

__device__ __forceinline__ void xcd_barrier(const XcdBarrier& b) {
    asm volatile("s_waitcnt vmcnt(0)" ::: "memory");
    __syncthreads();
    if (threadIdx.x == 0) {
        unsigned* bar = b.bar;
        __builtin_amdgcn_s_waitcnt(0);
        unsigned nloc = b.st[0], nx = b.st[1];
        if (nloc == 0u) { xcd_barrier_complete(bar, b.x, nloc, nx); b.st[0] = nloc; b.st[1] = nx; }
        const unsigned old = xb_add(&bar[XB_XSUB(b.x)], 1u);
        const unsigned gen = old / nloc;
        if (old + 1u == (gen + 1u) * nloc) {
            __builtin_amdgcn_fence(__ATOMIC_RELEASE, "agent");
            asm volatile("s_waitcnt vmcnt(0)" ::: "memory");
            const unsigned og = xb_add(&bar[XB_TOP], 1u);
            const unsigned tg = og / nx;
            if (og + 1u == (tg + 1u) * nx) xb_add(&bar[XB_TOPGEN], 1u);
            else XB_SPIN(xb_ld(&bar[XB_TOPGEN]) == tg, bar);
            __builtin_amdgcn_fence(__ATOMIC_ACQUIRE, "agent");
            xb_add(&bar[XB_XGEN(b.x)], 1u);
            asm volatile("s_waitcnt vmcnt(0)" ::: "memory");
        } else {
            XB_SPIN(xb_ld(&bar[XB_XGEN(b.x)]) == gen, bar);
            __builtin_amdgcn_fence(__ATOMIC_ACQUIRE, "agent");
            asm volatile("s_waitcnt vmcnt(0)" ::: "memory");
        }
    }
    __syncthreads();
}


__device__ __forceinline__ void cnt_barrier(unsigned* cw, unsigned& k) {
    asm volatile("s_waitcnt vmcnt(0)" ::: "memory");
    __syncthreads();
    if (threadIdx.x == 0) {
        __builtin_amdgcn_fence(__ATOMIC_RELEASE, "agent");
        asm volatile("s_waitcnt vmcnt(0)" ::: "memory");
        const unsigned G = gridDim.x;
        const unsigned old = xb_add(cw, 1u);
        if (old == G * (k + 1u) - 1u) xb_add(cw + 64, 1u);
        else { unsigned sp = 0; while (xb_ld(cw + 64) == k) { __builtin_amdgcn_s_sleep(1);
                if ((++sp & 255u) == 0u) { if (xb_ld(cw + 128)) break; if (sp > XB_SPIN_CAP) { atomicAdd(cw + 128, 1u); break; } } } }
        __builtin_amdgcn_fence(__ATOMIC_ACQUIRE, "agent");
        asm volatile("s_waitcnt vmcnt(0)" ::: "memory");
    }
    ++k;
    __syncthreads();
}
__device__ __forceinline__ float bf_lo(unsigned w) { return __uint_as_float(w << 16); }
__device__ __forceinline__ float bf_hi(unsigned w) { return __uint_as_float(w & 0xffff0000u); }
__device__ __forceinline__ float bf2f(bf16 v) { return __uint_as_float(((unsigned)v) << 16); }
__device__ __forceinline__ unsigned f2bf(float f) { unsigned u = __float_as_uint(f); return (u + 0x7fffu + ((u >> 16) & 1u)) >> 16; }
__device__ __forceinline__ unsigned pk2(float lo, float hi) { return f2bf(lo) | (f2bf(hi) << 16); }
__device__ __forceinline__ float wave_sum(float v) {
#pragma unroll
    for (int o = 1; o < 64; o <<= 1) v += __shfl_xor(v, o);
    return v;
}
__device__ __forceinline__ float wave_max(float v) {
#pragma unroll
    for (int o = 1; o < 64; o <<= 1) v = fmaxf(v, __shfl_xor(v, o));
    return v;
}
__device__ __forceinline__ float sigmoidf_(float x) { return 1.0f / (1.0f + __expf(-x)); }
__device__ __forceinline__ float siluf_(float x) { return x / (1.0f + __expf(-x)); }
#define LDS_WAIT() asm volatile("s_waitcnt lgkmcnt(0)" ::: "memory")

struct Args { const float* in[25]; float* out; unsigned char* ws; int ph_lo, ph_hi; };
struct ArgsG { const GAS float* in[25]; GAS float* out; GAS unsigned char* ws;
    __device__ __forceinline__ const float* I(int i) const { return (const float*)in[i]; }
    __device__ __forceinline__ unsigned char* W() const { return (unsigned char*)ws; }
    __device__ __forceinline__ float* O() const { return (float*)out; } };

__device__ __forceinline__ int map_win(int n);
__device__ __forceinline__ int map_gu(int n);
template <int MAP>
__device__ __forceinline__ void transpose_item(const float* W, int K, int N, bf16* WT, LAS float* scr, int item, int nblk, int lane) {
    const int kb = item / nblk, nb = item % nblk, k0 = 64 * kb, n0 = 32 * nb;
    const int nd = n0 + (lane & 31); const int src = MAP == 1 ? map_win(nd) : (MAP == 2 ? map_gu(nd) : nd);
#pragma unroll 8
    for (int i = 0; i < 32; ++i) { const int kk = 2 * i + (lane >> 5); scr[kk * 33 + (lane & 31)] = src >= 0 ? W[(size_t)(k0 + kk) * N + src] : 0.0f; }
    LDS_WAIT();
    const int c = lane & 7;
#pragma unroll
    for (int j = 0; j < 4; ++j) { const int n = (lane >> 3) + 8 * j; const LAS float* s = scr + (8 * c) * 33 + n;
        u32x4 o; o.x = pk2(s[0 * 33], s[1 * 33]); o.y = pk2(s[2 * 33], s[3 * 33]); o.z = pk2(s[4 * 33], s[5 * 33]); o.w = pk2(s[6 * 33], s[7 * 33]);
        *(u32x4*)(WT + (size_t)(n0 + n) * K + k0 + 8 * c) = o; }
    LDS_WAIT();
}
__device__ __forceinline__ int map_win(int n) {
    if (n < 2048) return n;
    if (n < C_KV) return 2056 + (n - C_NQ);
    if (n < C_CU) return 2312 + (n - C_KV);
    if (n < C_A) return 2708 + (n - C_CU);
    if (n < C_B) return 2048 + (n - C_A);
    if (n < C_G) return 2052 + (n - C_B);
    if (n < C_G + 12) return 2696 + (n - C_G);
    return -1;
}
__device__ __forceinline__ int map_gu(int n) { const int pn = n >> 8, r = n & 255; return (r < 128 ? 0 : 1024) + 128 * pn + (r & 127); }

__device__ __forceinline__ void ph_prologue(const ArgsG& a, LAS unsigned char* lds, int gw, int NGW, int wave, int lane) {
    LAS float* scr = (LAS float*)(lds + wave * 16384);
    bf16* WinT = (bf16*)(a.W() + WS_WIN); bf16* WoutT = (bf16*)(a.W() + WS_WOUT); bf16* WguT = (bf16*)(a.W() + WS_WGU); bf16* WdT = (bf16*)(a.W() + WS_WD);
    constexpr int I_IN = 16 * (NP / 32), I_OUT = 16 * 32, I_GU = 16 * 64, I_D = 16 * 32;
    constexpr int N_IN = NLAYER * I_IN, N_OUT = NLAYER * I_OUT, N_GU = NLAYER * NE * I_GU, N_D = NLAYER * NE * I_D;
    for (int it = gw; it < N_IN + N_OUT + N_GU + N_D; it += NGW) {
        int r = it;
        if (r < N_IN) { const int l = r / I_IN; transpose_item<1>(a.I(2) + (size_t)l * DM * DIN, DM, DIN, WinT + (size_t)l * NP * DM, scr, r % I_IN, NP / 32, lane); continue; } r -= N_IN;
        if (r < N_OUT) { const int l = r / I_OUT; transpose_item<0>(a.I(16) + (size_t)l * DM * DM, DM, DM, WoutT + (size_t)l * DM * DM, scr, r % I_OUT, 32, lane); continue; } r -= N_OUT;
        if (r < N_GU) { const int le = r / I_GU; transpose_item<2>(a.I(20) + (size_t)le * DM * 2048, DM, 2048, WguT + (size_t)le * 2048 * DM, scr, r % I_GU, 64, lane); continue; } r -= N_GU;
        { const int le = r / I_D; transpose_item<0>(a.I(22) + (size_t)le * DM * DM, DM, DM, WdT + (size_t)le * DM * DM, scr, r % I_D, 32, lane); }
    }
    { bf16* W1T = (bf16*)(a.W() + WS_W1T);
        for (int it = gw; it < 4 * 128; it += NGW) { const int mtx = it >> 7; transpose_item<0>(a.I(10) + (size_t)mtx * 2048 * 128, 2048, 128, W1T + (size_t)mtx * 128 * 2048, scr, it & 127, 4, lane); }
        float* POSW = (float*)(a.W() + WS_POSW);
        const int id = gw * 64 + lane;
        if (id < 512) { const int mtx = id >> 7, n = id & 127; const float* w1 = a.I(10) + (size_t)mtx * 2048 * 128; const float* pos = a.I(9) + (size_t)mtx * 2048; float acc = 0.f;
            for (int k = 0; k < 2048; ++k) acc += pos[k] * w1[(size_t)k * 128 + n];
            POSW[id] = acc; } }
    { bf16* RWH = (bf16*)(a.W() + WS_RWH); bf16* RWL = (bf16*)(a.W() + WS_RWL);
        for (int i = gw * 64 + lane; i < NLAYER * NE * DM; i += NGW * 64) { const int d = i & (DM - 1), e = (i >> 10) & (NE - 1), l = i >> 15;
            const float w = a.I(18)[((size_t)l * DM + d) * NE + e]; const unsigned hi = f2bf(w); const float lo = w - __uint_as_float(hi << 16);
            RWH[i] = (bf16)hi; RWL[i] = (bf16)f2bf(lo); } }
    float* BT = (float*)(a.W() + WS_BT);
    for (int i = gw * 64 + lane; i < 4 * 2048; i += NGW * 64) {
        const int h = i >> 11, n = i & 2047; int bk;
        if (n < 16) bk = n; else { const float v = logf((float)n / 16.0f) / 2.0794415416798357f * 16.0f; bk = 16 + (int)v; bk = bk < 31 ? bk : 31; }
        BT[i] = a.I(24)[bk * 4 + h];
    }
}

__device__ __forceinline__ void rms_row_to_bf16(const f32x4 (&v)[4], const float* w, bf16* orow, int lane) {
    float s = 0.f;
#pragma unroll
    for (int j = 0; j < 4; ++j) s += (v[j].x * v[j].x + v[j].y * v[j].y) + (v[j].z * v[j].z + v[j].w * v[j].w);
    const float r = rsqrtf(wave_sum(s) * (1.0f / DM) + EPS);
#pragma unroll
    for (int j = 0; j < 4; ++j) { const f32x4 wv = *(const f32x4*)(w + 4 * (64 * j + lane)); const f32x4 y = v[j] * r * wv;
        u32x2 o; o.x = pk2(y.x, y.y); o.y = pk2(y.z, y.w); *(u32x2*)(orow + 4 * (64 * j + lane)) = o; }
}

__device__ __forceinline__ void ph_norm0(const ArgsG& a, int gw, int NGW, int lane) {
    bf16* XN = (bf16*)(a.W() + WS_XN);
    for (int tok = gw; tok < NT; tok += NGW) {
        f32x4 v[4];
#pragma unroll
        for (int j = 0; j < 4; ++j) v[j] = *(const f32x4*)(a.I(0) + (size_t)tok * DM + 4 * (64 * j + lane));
        rms_row_to_bf16(v, a.I(1), XN + (size_t)tok * DM, lane);
    }
}

__device__ __forceinline__ void ph_compress_mfma(const ArgsG& a, int l, LAS unsigned char* lds, int bid, int G, int tid, int wave, int lane) {
    LAS float* hid = (LAS float*)lds;
    const bf16* P = (const bf16*)(a.W() + WS_P); bf16* KCMP = (bf16*)(a.W() + WS_KCMP); bf16* VCMP = (bf16*)(a.W() + WS_VCMP);
    const int r = lane & 15, q = lane >> 4;
    for (int u = bid; u < 128; u += G) {
        const int b = u >> 4, kv = (u >> 3) & 1, j0 = 16 * (u & 7);
        const bf16* arow = P + (size_t)(b * SEQ) * NP + C_KV + kv * 64;
        const bf16* brow = (const bf16*)(a.W() + WS_W1T) + ((size_t)(l * 2 + kv) * 128 + 16 * wave + r) * 2048 + 8 * q;
        const float pw = ((const float*)(a.W() + WS_POSW))[(l * 2 + kv) * 128 + 16 * wave + r];
        f32x4 acc = {0.f, 0.f, 0.f, 0.f};
#pragma unroll 8
        for (int ks = 0; ks < 64; ++ks) { int tk = 16 * (j0 + r) + (ks >> 1); tk = tk < SEQ ? tk : SEQ - 1;
            const bf16x8 af = *(const bf16x8*)(arow + (size_t)tk * NP + (ks & 1) * 32 + 8 * q); const bf16x8 bfr = *(const bf16x8*)(brow + 32 * ks);
            acc = __builtin_amdgcn_mfma_f32_16x16x32_bf16(af, bfr, acc, 0, 0, 0); }
#pragma unroll
        for (int i = 0; i < 4; ++i) hid[(4 * q + i) * 132 + 16 * wave + r] = siluf_(acc[i] + pw);
        __syncthreads();
        { const int row = tid >> 5, c2 = tid & 31; const float* w2 = a.I(11) + (size_t)(l * 2 + kv) * 128 * 64; float o0 = 0.f, o1 = 0.f;
            for (int nn = 0; nn < 128; ++nn) { const float hv = hid[row * 132 + nn]; o0 += hv * w2[nn * 64 + 2 * c2]; o1 += hv * w2[nn * 64 + 2 * c2 + 1]; }
            if (kv == 0) { float ss = o0 * o0 + o1 * o1;
#pragma unroll
                for (int o_ = 1; o_ < 32; o_ <<= 1) ss += __shfl_xor(ss, o_);
                const float sc = rsqrtf(ss * (1.0f / 64.0f) + EPS); o0 *= sc * a.I(8)[l * 192 + 2 * c2]; o1 *= sc * a.I(8)[l * 192 + 2 * c2 + 1]; }
            const int j = j0 + row;
            *(unsigned*)((kv ? VCMP : KCMP) + (size_t)(b * 128 + j) * 64 + 2 * c2) = (j < 127) ? pk2(o0, o1) : 0u; }
        __syncthreads();
    }
}

__device__ __forceinline__ void ph_m1(const ArgsG& a, int l, LAS unsigned char* lds, int bid, int G, int tid, int wave, int lane) {
    const bf16* P = (const bf16*)(a.W() + WS_P);
    bf16* QN = (bf16*)(a.W() + WS_QN); bf16* KN = (bf16*)(a.W() + WS_KN); bf16* VC = (bf16*)(a.W() + WS_VC);
    bf16* KT = (bf16*)(a.W() + WS_KT); bf16* VT = (bf16*)(a.W() + WS_VT);
    float* Gb = (float*)(a.W() + WS_G); float* BETA = (float*)(a.W() + WS_BETA);
    bf16* NQ = (bf16*)(a.W() + WS_NQ); bf16* KS = (bf16*)(a.W() + WS_KS); bf16* KW = (bf16*)(a.W() + WS_KW); bf16* Y = (bf16*)(a.W() + WS_Y);
    const float* convw = a.I(3) + (size_t)l * 4 * 1536; const float* a_log = a.I(4) + l * 4; const float* dt_bias = a.I(5) + l * 4;
    const float* qnw = a.I(7) + l * 64; const float* knw = a.I(8) + l * 192;
    const float* dww = a.I(12) + (size_t)l * 31 * 256; const float* dwb = a.I(13) + l * 256; const float* lnw = a.I(14) + l * 256; const float* lnb = a.I(15) + l * 256;
    LAS float* dwl = (LAS float*)(lds + 65536);
    for (int i = tid; i < 31 * 256; i += NTHR) dwl[i] = dww[i];
    __syncthreads();
    for (int u = bid; u < NT / 64; u += G) {
        const int b = u >> 5, nchunk = u & 31, tw = nchunk * 64 + 8 * wave;
        const bf16* pw0 = P + (size_t)(b * SEQ + tw) * NP;
        { unsigned cx[11], nx[11]; float cw0[4], cw1[4], nw0[4], nw1[4];
#define DN_LOAD(idx, X, W0, W1) do { const int cb_ = ((idx) >> 2) * 512 + ((idx) & 3) * 128 + 2 * lane; \
            _Pragma("unroll") for (int j = 0; j < 4; ++j) { W0[j] = convw[j * 1536 + cb_]; W1[j] = convw[j * 1536 + cb_ + 1]; } \
            _Pragma("unroll") for (int j = 0; j < 3; ++j) { X[j] = 0u; if (tw - 3 + j >= 0) X[j] = *(const unsigned*)(pw0 + (ptrdiff_t)(j - 3) * NP + cb_); } \
            _Pragma("unroll") for (int i = 0; i < 8; ++i) X[3 + i] = *(const unsigned*)(pw0 + (size_t)i * NP + cb_); } while (0)
            DN_LOAD(0, cx, cw0, cw1);
#pragma unroll 1
            for (int idx = 0; idx < 12; ++idx) { const int ten = idx >> 2, h = idx & 3;
                if (idx + 1 < 12) DN_LOAD(idx + 1, nx, nw0, nw1);
                float xa[3] = {bf_lo(cx[0]), bf_lo(cx[1]), bf_lo(cx[2])}, xb[3] = {bf_hi(cx[0]), bf_hi(cx[1]), bf_hi(cx[2])};
                float ya[8], yb[8], sq[8];
#pragma unroll
                for (int i = 0; i < 8; ++i) { const unsigned w = cx[3 + i]; const float ca = bf_lo(w), cbv = bf_hi(w);
                    ya[i] = siluf_(cw0[0] * xa[0] + cw0[1] * xa[1] + cw0[2] * xa[2] + cw0[3] * ca); yb[i] = siluf_(cw1[0] * xb[0] + cw1[1] * xb[1] + cw1[2] * xb[2] + cw1[3] * cbv);
                    xa[0] = xa[1]; xa[1] = xa[2]; xa[2] = ca; xb[0] = xb[1]; xb[1] = xb[2]; xb[2] = cbv; sq[i] = ya[i] * ya[i] + yb[i] * yb[i]; }
                if (ten < 2) {
#pragma unroll
                    for (int o_ = 1; o_ < 64; o_ <<= 1) {
#pragma unroll
                        for (int i = 0; i < 8; ++i) sq[i] += __shfl_xor(sq[i], o_); }
                    const float qs_ = ten == 0 ? 0.08838834764831845f : 1.0f;
#pragma unroll
                    for (int i = 0; i < 8; ++i) { const float sc = rsqrtf(sq[i] + EPS) * qs_; ya[i] *= sc; yb[i] *= sc; } }
                unsigned pk[8];
#pragma unroll
                for (int i = 0; i < 8; ++i) pk[i] = pk2(ya[i], yb[i]);
                if (ten < 2) { bf16* dst = ten == 0 ? QN : KN;
#pragma unroll
                    for (int i = 0; i < 8; ++i) *(unsigned*)(dst + (size_t)(b * SEQ + tw + i) * 512 + h * 128 + 2 * lane) = pk[i]; }
                if (ten >= 1) {
                    bf16* tb = (ten == 1 ? KT : VT) + ((size_t)((b * 4 + h) * 32 + nchunk) * 128 + 2 * lane) * 64 + 8 * wave;
                    u32x4 lo, hi;
                    lo.x = (pk[0] & 0xffffu) | (pk[1] << 16); lo.y = (pk[2] & 0xffffu) | (pk[3] << 16); lo.z = (pk[4] & 0xffffu) | (pk[5] << 16); lo.w = (pk[6] & 0xffffu) | (pk[7] << 16);
                    hi.x = (pk[0] >> 16) | (pk[1] & 0xffff0000u); hi.y = (pk[2] >> 16) | (pk[3] & 0xffff0000u); hi.z = (pk[4] >> 16) | (pk[5] & 0xffff0000u); hi.w = (pk[6] >> 16) | (pk[7] & 0xffff0000u);
                    *(u32x4*)tb = lo; *(u32x4*)(tb + 64) = hi; }
#pragma unroll
                for (int j = 0; j < 11; ++j) cx[j] = nx[j];
#pragma unroll
                for (int j = 0; j < 4; ++j) { cw0[j] = nw0[j]; cw1[j] = nw1[j]; } }
#undef DN_LOAD
        }
        if (lane < 32) { const int i = lane >> 2, hd = lane & 3; const size_t tok = (size_t)(b * SEQ + tw + i); const bf16* prow = P + tok * NP;
            const float av = bf2f(prow[C_A + hd]), bv = bf2f(prow[C_B + hd]);
            BETA[tok * 4 + hd] = sigmoidf_(bv);
            const float x = av + dt_bias[hd]; const float sp = x > 20.0f ? x : log1pf(expf(x));
            Gb[tok * 4 + hd] = -expf(a_log[hd]) * sp; }
        { const float qw = qnw[lane] * (0.125f * 1.4426950408889634f), ksw = knw[64 + lane], kww = knw[128 + lane];
#pragma unroll 4
          for (int i = 0; i < 8; ++i) { const size_t tok = (size_t)(b * SEQ + tw + i); const bf16* prow = P + tok * NP;
            float xv[6];
#pragma unroll
            for (int h = 0; h < 4; ++h) xv[h] = bf2f(prow[C_NQ + h * 64 + lane]);
            xv[4] = bf2f(prow[C_KV + 128 + lane]); xv[5] = bf2f(prow[C_KV + 256 + lane]);
            float ss[6];
#pragma unroll
            for (int h = 0; h < 6; ++h) ss[h] = xv[h] * xv[h];
#pragma unroll
            for (int o_ = 1; o_ < 64; o_ <<= 1) {
#pragma unroll
                for (int h = 0; h < 6; ++h) ss[h] += __shfl_xor(ss[h], o_); }
#pragma unroll
            for (int h = 0; h < 4; ++h) NQ[tok * 256 + h * 64 + lane] = (bf16)f2bf(xv[h] * rsqrtf(ss[h] * (1.0f / 64.0f) + EPS) * qw);
            KS[tok * 64 + lane] = (bf16)f2bf(xv[4] * rsqrtf(ss[4] * (1.0f / 64.0f) + EPS) * ksw);
            KW[tok * 64 + lane] = (bf16)f2bf(xv[5] * rsqrtf(ss[5] * (1.0f / 64.0f) + EPS) * kww); } }
        { const int c = 4 * lane; f32x4 acc[8]; const f32x4 bias = *(const f32x4*)(dwb + c);
#pragma unroll
            for (int i = 0; i < 8; ++i) acc[i] = bias;
#pragma unroll 1
            for (int g8 = 0; g8 < 5; ++g8) { u32x2 av[8], gv[8];
#pragma unroll
                for (int rr = 0; rr < 8; ++rr) { const int r = 8 * g8 + rr; av[rr] = (u32x2){0u, 0u}; gv[rr] = (u32x2){0u, 0u};
                    if (r < 38 && tw - 30 + r >= 0) { const bf16* pr = pw0 + (ptrdiff_t)(r - 30) * NP + C_CU + c; av[rr] = *(const u32x2*)pr; gv[rr] = *(const u32x2*)(pr + 256); } }
#pragma unroll
                for (int rr = 0; rr < 8; ++rr) { const int r = 8 * g8 + rr;
                    f32x4 gl; gl.x = bf_lo(av[rr].x) * sigmoidf_(bf_lo(gv[rr].x)); gl.y = bf_hi(av[rr].x) * sigmoidf_(bf_hi(gv[rr].x)); gl.z = bf_lo(av[rr].y) * sigmoidf_(bf_lo(gv[rr].y)); gl.w = bf_hi(av[rr].y) * sigmoidf_(bf_hi(gv[rr].y));
#pragma unroll
                    for (int i = 0; i < 8; ++i) { const int j = r - i; if (j >= 0 && j <= 30) { const f32x4 w = *(const LAS f32x4*)(dwl + j * 256 + c); acc[i] += w * gl; } } } }
            const f32x4 lw = *(const f32x4*)(lnw + c), lb = *(const f32x4*)(lnb + c);
#pragma unroll
            for (int i = 0; i < 8; ++i) { const f32x4 x = acc[i]; const float mean = wave_sum((x.x + x.y) + (x.z + x.w)) * (1.0f / 256.0f);
                const f32x4 d = x - mean; const float var = wave_sum((d.x * d.x + d.y * d.y) + (d.z * d.z + d.w * d.w)) * (1.0f / 256.0f);
                const float rr = rsqrtf(var + EPS); const f32x4 y = d * rr * lw + lb;
                u32x2 o; o.x = pk2(siluf_(y.x), siluf_(y.y)); o.y = pk2(siluf_(y.z), siluf_(y.w));
                *(u32x2*)(Y + (size_t)(b * SEQ + tw + i) * DM + 768 + c) = o; } }
    }
}

constexpr int LM_PITCH = 68;
__device__ __forceinline__ void ph_dn_chunk_mfma(const ArgsG& a, LAS unsigned char* lds, int bid, int G, int tid, int wave, int lane) {
    LAS float* Lm = (LAS float*)lds;
    LAS float* gcl = (LAS float*)(lds + 4 * 64 * LM_PITCH * 4);
    LAS float* betal = gcl + 256; LAS float* bkl = betal + 256;
    const bf16* QN = (const bf16*)(a.W() + WS_QN); const bf16* KN = (const bf16*)(a.W() + WS_KN);
    const bf16* KT = (const bf16*)(a.W() + WS_KT); const bf16* VT = (const bf16*)(a.W() + WS_VT);
    const float* Gb = (const float*)(a.W() + WS_G); const float* BETA = (const float*)(a.W() + WS_BETA); float* GC = (float*)(a.W() + WS_GC);
    float* U = (float*)(a.W() + WS_U); bf16* W = (bf16*)(a.W() + WS_W); bf16* ATT = (bf16*)(a.W() + WS_ATT);
    const int n = lane & 31, hh = lane >> 5;
    for (int cb = bid * 4; cb < 1024; cb += G * 4) {
        if (wave < 4) { const int ci = cb + wave, nn = ci & 31, h = (ci >> 5) & 3, b = ci >> 7, r0 = b * SEQ + nn * 64;
            float g = Gb[(size_t)(r0 + lane) * 4 + h];
#pragma unroll
            for (int off = 1; off < 64; off <<= 1) { const float v = __shfl_up(g, off); if (lane >= off) g += v; }
            const float be = BETA[(size_t)(r0 + lane) * 4 + h];
            gcl[wave * 64 + lane] = g; GC[(size_t)(r0 + lane) * 4 + h] = g; betal[wave * 64 + lane] = be; bkl[wave * 64 + lane] = be * __expf(g); }
        __syncthreads();
#pragma unroll 1
        for (int q = 0; q < 3; ++q) { const int id = 3 * wave + q, c = id / 6, wq = id % 6, isq = wq >= 3 ? 1 : 0, blk = wq % 3, ib = blk >= 1 ? 1 : 0, jb = blk == 2 ? 1 : 0;
            const int ci = cb + c, nn = ci & 31, h = (ci >> 5) & 3, b = ci >> 7, r0 = b * SEQ + nn * 64;
            const bf16* ap = (isq ? QN : KN) + (size_t)(r0 + 32 * ib + n) * 512 + h * 128 + 8 * hh;
            const bf16* bp = KN + (size_t)(r0 + 32 * jb + n) * 512 + h * 128 + 8 * hh;
            f32x16 acc;
#pragma unroll
            for (int r = 0; r < 16; ++r) acc[r] = 0.f;
#pragma unroll
            for (int ks = 0; ks < 8; ++ks) acc = __builtin_amdgcn_mfma_f32_32x32x16_bf16(*(const bf16x8*)(ap + 16 * ks), *(const bf16x8*)(bp + 16 * ks), acc, 0, 0, 0);
            const int j = 32 * jb + n; const float gj = gcl[c * 64 + j];
#pragma unroll
            for (int r = 0; r < 16; ++r) { const int i = 32 * ib + (r & 3) + 8 * (r >> 2) + 4 * hh; const float dec = __expf(fminf(gcl[c * 64 + i] - gj, 0.f));
                if (isq) ATT[(size_t)ci * 4096 + i * 64 + j] = (bf16)((j <= i) ? f2bf(acc[r] * dec) : 0u);
                else Lm[c * 64 * LM_PITCH + i * LM_PITCH + j] = (j < i) ? betal[c * 64 + i] * acc[r] * dec : 0.f; } }
        __syncthreads();
        if (wave < 4) { LAS float* L = Lm + wave * 64 * LM_PITCH;
            for (int i = 0; i < 64; ++i) { float a0 = (i == lane) ? 1.f : 0.f, a1 = 0.f, a2 = 0.f, a3 = 0.f; int j = 0;
                for (; j + 3 < i; j += 4) { a0 -= L[i * LM_PITCH + j] * L[j * LM_PITCH + lane]; a1 -= L[i * LM_PITCH + j + 1] * L[(j + 1) * LM_PITCH + lane];
                    a2 -= L[i * LM_PITCH + j + 2] * L[(j + 2) * LM_PITCH + lane]; a3 -= L[i * LM_PITCH + j + 3] * L[(j + 3) * LM_PITCH + lane]; }
                for (; j < i; ++j) a0 -= L[i * LM_PITCH + j] * L[j * LM_PITCH + lane];
                L[i * LM_PITCH + lane] = (a0 + a1) + (a2 + a3); } }
        __syncthreads();
#pragma unroll 1
        for (int q = 0; q < 4; ++q) { const int id = wave * 4 + q, c = id >> 3, ten = (id >> 2) & 1, db = id & 3;
            const int ci = cb + c, nn = ci & 31, h = (ci >> 5) & 3, b = ci >> 7, r0 = b * SEQ + nn * 64;
            const bf16* arow = (ten ? KT : VT) + ((size_t)ci * 128 + 32 * db + n) * 64 + 8 * hh;
            const LAS float* scl = (ten ? bkl : betal) + c * 64;
            const LAS float* L = Lm + c * 64 * LM_PITCH;
#pragma unroll
            for (int ib = 0; ib < 2; ++ib) { f32x16 acc;
#pragma unroll
                for (int r = 0; r < 16; ++r) acc[r] = 0.f;
#pragma unroll
                for (int ks = 0; ks < 4; ++ks) { if (ib == 0 && ks >= 2) continue;
                    const LAS float* tp = L + (32 * ib + n) * LM_PITCH + 16 * ks + 8 * hh;
                    const f32x4 t0 = *(const LAS f32x4*)tp, t1 = *(const LAS f32x4*)(tp + 4), s0 = *(const LAS f32x4*)(scl + 16 * ks + 8 * hh), s1 = *(const LAS f32x4*)(scl + 16 * ks + 8 * hh + 4);
                    u32x4 bw; bw.x = pg8::cvt_pk_bf16(t0.x * s0.x, t0.y * s0.y); bw.y = pg8::cvt_pk_bf16(t0.z * s0.z, t0.w * s0.w); bw.z = pg8::cvt_pk_bf16(t1.x * s1.x, t1.y * s1.y); bw.w = pg8::cvt_pk_bf16(t1.z * s1.z, t1.w * s1.w);
                    acc = __builtin_amdgcn_mfma_f32_32x32x16_bf16(*(const bf16x8*)(arow + 16 * ks), __builtin_bit_cast(bf16x8, bw), acc, 0, 0, 0); }
                const size_t ob = (size_t)(r0 + 32 * ib + n) * 512 + h * 128 + 32 * db + 4 * hh;
#pragma unroll
                for (int rq = 0; rq < 4; ++rq) {
                    if (ten) { u32x2 w2; w2.x = pk2(acc[4 * rq], acc[4 * rq + 1]); w2.y = pk2(acc[4 * rq + 2], acc[4 * rq + 3]); *(u32x2*)(W + ob + 8 * rq) = w2; }
                    else *(f32x4*)(U + ob + 8 * rq) = (f32x4){acc[4 * rq], acc[4 * rq + 1], acc[4 * rq + 2], acc[4 * rq + 3]}; } } }
        __syncthreads();
    }
}

constexpr int SC_WP = 272, SC_AP = 144;
constexpr int SC_W = 0, SC_Q = 64 * SC_WP, SC_A = 2 * 64 * SC_WP, SC_K = SC_A + 64 * SC_AP, SC_GC = SC_K + 128 * SC_AP, SC_BUF = SC_GC + 1024;
static_assert(2 * SC_BUF <= RING_BYTES, "scan LDS");
struct ScanPf { u32x4 w[4], q[4], at[2], k[4]; float g, gl; };
__device__ __forceinline__ ScanPf scan_load(const bf16* W, const bf16* QN, const bf16* ATT, const bf16* KT, const float* GC, int r0, int h, int ci, int lt) {
    ScanPf p; const int row = lt >> 4, seg = lt & 15;
#pragma unroll
    for (int i = 0; i < 4; ++i) { const size_t go = (size_t)(r0 + row + 16 * i) * 512 + h * 128 + seg * 8; p.w[i] = *(const u32x4*)(W + go); p.q[i] = *(const u32x4*)(QN + go); }
#pragma unroll
    for (int i = 0; i < 2; ++i) p.at[i] = *(const u32x4*)(ATT + (size_t)ci * 4096 + (lt + 256 * i) * 8);
#pragma unroll
    for (int i = 0; i < 4; ++i) p.k[i] = *(const u32x4*)(KT + (size_t)ci * 8192 + (lt + 256 * i) * 8);
    p.g = GC[(size_t)(r0 + (lt & 63)) * 4 + h]; p.gl = GC[(size_t)(r0 + 63) * 4 + h]; return p;
}
__device__ __forceinline__ void scan_store(const ScanPf& p, LAS unsigned char* buf, int lt) {
    const int row = lt >> 4, seg = lt & 15;
#pragma unroll
    for (int i = 0; i < 4; ++i) { *(LAS u32x4*)(buf + SC_W + (row + 16 * i) * SC_WP + seg * 16) = p.w[i]; *(LAS u32x4*)(buf + SC_Q + (row + 16 * i) * SC_WP + seg * 16) = p.q[i]; }
#pragma unroll
    for (int i = 0; i < 2; ++i) *(LAS u32x4*)(buf + SC_A + ((lt >> 3) + 32 * i) * SC_AP + (lt & 7) * 16) = p.at[i];
#pragma unroll
    for (int i = 0; i < 4; ++i) *(LAS u32x4*)(buf + SC_K + ((lt >> 3) + 32 * i) * SC_AP + (lt & 7) * 16) = p.k[i];
    if (lt < 64) { LAS float* gp = (LAS float*)(buf + SC_GC); gp[lt] = __expf(p.g); gp[64 + lt] = __expf(p.gl - p.g); if (lt == 0) gp[128] = __expf(p.gl); }
}
__device__ __forceinline__ bf16x8 frag2(const LAS unsigned char* p) { const u32x2 lo = *(const LAS u32x2*)p, hi = *(const LAS u32x2*)(p + 16); const u32x4 v = {lo.x, lo.y, hi.x, hi.y}; return __builtin_bit_cast(bf16x8, v); }
__device__ __forceinline__ void ph_dn_scan_mfma(const ArgsG& a, LAS unsigned char* lds, int bid, int G, int tid, int wave, int lane) {
    const bf16* QN = (const bf16*)(a.W() + WS_QN); const bf16* KT = (const bf16*)(a.W() + WS_KT); const bf16* W = (const bf16*)(a.W() + WS_W); const bf16* ATT = (const bf16*)(a.W() + WS_ATT);
    const float* GC = (const float*)(a.W() + WS_GC); const float* U = (const float*)(a.W() + WS_U); float* O = (float*)(a.W() + WS_O);
    const int n = lane & 31, hh = lane >> 5;
    for (int u = bid; u < 32; u += G) {
        const int h = u & 3, b = u >> 2;
        f32x16 S[4];
#pragma unroll
        for (int k = 0; k < 4; ++k)
#pragma unroll
            for (int r = 0; r < 16; ++r) S[k][r] = 0.f;
        __syncthreads();
        if (wave >= 4) { const ScanPf p0 = scan_load(W, QN, ATT, KT, GC, b * SEQ, h, (b * 4 + h) * 32, tid - 256); scan_store(p0, lds, tid - 256); }
        __syncthreads();
#pragma unroll 1
        for (int nn = 0; nn < 32; ++nn) {
            const int r0 = b * SEQ + nn * 64; LAS unsigned char* buf = lds + (nn & 1) * SC_BUF; const LAS float* gp = (const LAS float*)(buf + SC_GC);
            if (wave >= 4) { if (nn + 1 < 32) { const ScanPf pf = scan_load(W, QN, ATT, KT, GC, r0 + 64, h, (b * 4 + h) * 32 + nn + 1, tid - 256); scan_store(pf, lds + ((nn + 1) & 1) * SC_BUF, tid - 256); } }
            else {
                const size_t ubase = (size_t)r0 * 512 + h * 128 + 32 * wave + n;
                f32x16 vn[2];
#pragma unroll
                for (int ib = 0; ib < 2; ++ib)
#pragma unroll
                    for (int r = 0; r < 16; ++r) vn[ib][r] = U[ubase + (size_t)(32 * ib + (r & 3) + 8 * (r >> 2) + 4 * hh) * 512];
                bf16x8 Sb[4][2];
#pragma unroll
                for (int k = 0; k < 4; ++k)
#pragma unroll
                    for (int s2 = 0; s2 < 2; ++s2) { u32x4 w4; w4.x = pg8::cvt_pk_bf16(S[k][8 * s2], S[k][8 * s2 + 1]); w4.y = pg8::cvt_pk_bf16(S[k][8 * s2 + 2], S[k][8 * s2 + 3]);
                        w4.z = pg8::cvt_pk_bf16(S[k][8 * s2 + 4], S[k][8 * s2 + 5]); w4.w = pg8::cvt_pk_bf16(S[k][8 * s2 + 6], S[k][8 * s2 + 7]); Sb[k][s2] = __builtin_bit_cast(bf16x8, w4); }
#pragma unroll
                for (int ib = 0; ib < 2; ++ib) { f32x16 acc;
#pragma unroll
                    for (int r = 0; r < 16; ++r) acc[r] = 0.f;
#pragma unroll
                    for (int k = 0; k < 4; ++k)
#pragma unroll
                        for (int s2 = 0; s2 < 2; ++s2) acc = __builtin_amdgcn_mfma_f32_32x32x16_bf16(frag2(buf + SC_W + (32 * ib + n) * SC_WP + (32 * k + 16 * s2 + 4 * hh) * 2), Sb[k][s2], acc, 0, 0, 0);
#pragma unroll
                    for (int r = 0; r < 16; ++r) vn[ib][r] -= acc[r]; }
                bf16x8 vb[2][2], vd[2][2];
#pragma unroll
                for (int jb = 0; jb < 2; ++jb)
#pragma unroll
                    for (int s2 = 0; s2 < 2; ++s2) { const f32x4 d0 = *(const LAS f32x4*)(gp + 64 + 32 * jb + 16 * s2 + 4 * hh), d1 = *(const LAS f32x4*)(gp + 64 + 32 * jb + 16 * s2 + 8 + 4 * hh);
                        const float* v = nullptr; (void)v; u32x4 w4, w5;
                        w4.x = pg8::cvt_pk_bf16(vn[jb][8 * s2], vn[jb][8 * s2 + 1]); w4.y = pg8::cvt_pk_bf16(vn[jb][8 * s2 + 2], vn[jb][8 * s2 + 3]);
                        w4.z = pg8::cvt_pk_bf16(vn[jb][8 * s2 + 4], vn[jb][8 * s2 + 5]); w4.w = pg8::cvt_pk_bf16(vn[jb][8 * s2 + 6], vn[jb][8 * s2 + 7]);
                        w5.x = pg8::cvt_pk_bf16(vn[jb][8 * s2] * d0.x, vn[jb][8 * s2 + 1] * d0.y); w5.y = pg8::cvt_pk_bf16(vn[jb][8 * s2 + 2] * d0.z, vn[jb][8 * s2 + 3] * d0.w);
                        w5.z = pg8::cvt_pk_bf16(vn[jb][8 * s2 + 4] * d1.x, vn[jb][8 * s2 + 5] * d1.y); w5.w = pg8::cvt_pk_bf16(vn[jb][8 * s2 + 6] * d1.z, vn[jb][8 * s2 + 7] * d1.w);
                        vb[jb][s2] = __builtin_bit_cast(bf16x8, w4); vd[jb][s2] = __builtin_bit_cast(bf16x8, w5); }
#pragma unroll
                for (int ib = 0; ib < 2; ++ib) { f32x16 acc;
#pragma unroll
                    for (int r = 0; r < 16; ++r) acc[r] = 0.f;
#pragma unroll
                    for (int k = 0; k < 4; ++k)
#pragma unroll
                        for (int s2 = 0; s2 < 2; ++s2) acc = __builtin_amdgcn_mfma_f32_32x32x16_bf16(frag2(buf + SC_Q + (32 * ib + n) * SC_WP + (32 * k + 16 * s2 + 4 * hh) * 2), Sb[k][s2], acc, 0, 0, 0);
#pragma unroll
                    for (int rq = 0; rq < 4; ++rq) { const f32x4 e4 = *(const LAS f32x4*)(gp + 32 * ib + 8 * rq + 4 * hh);
                        acc[4 * rq] *= e4.x; acc[4 * rq + 1] *= e4.y; acc[4 * rq + 2] *= e4.z; acc[4 * rq + 3] *= e4.w; }
#pragma unroll
                    for (int jb = 0; jb < 2; ++jb) { if (jb > ib) continue;
#pragma unroll
                        for (int s2 = 0; s2 < 2; ++s2) acc = __builtin_amdgcn_mfma_f32_32x32x16_bf16(frag2(buf + SC_A + (32 * ib + n) * SC_AP + (32 * jb + 16 * s2 + 4 * hh) * 2), vb[jb][s2], acc, 0, 0, 0); }
#pragma unroll
                    for (int r = 0; r < 16; ++r) O[ubase + (size_t)(32 * ib + (r & 3) + 8 * (r >> 2) + 4 * hh) * 512] = acc[r]; }
                const float egl = gp[128];
#pragma unroll
                for (int k = 0; k < 4; ++k) {
#pragma unroll
                    for (int r = 0; r < 16; ++r) S[k][r] *= egl;
#pragma unroll
                    for (int jb = 0; jb < 2; ++jb)
#pragma unroll
                        for (int s2 = 0; s2 < 2; ++s2) S[k] = __builtin_amdgcn_mfma_f32_32x32x16_bf16(frag2(buf + SC_K + (32 * k + n) * SC_AP + (32 * jb + 16 * s2 + 4 * hh) * 2), vd[jb][s2], S[k], 0, 0, 0); }
            }
            __syncthreads();
        }
    }
}

__device__ __forceinline__ void ph_dn_out(const ArgsG& a, int l, int gw, int NGW, int lane) {
    const float* O = (const float*)(a.W() + WS_O); const bf16* P = (const bf16*)(a.W() + WS_P); bf16* Y = (bf16*)(a.W() + WS_Y);
    const float* nw = a.I(6) + l * 128;
    for (int tok = gw; tok < NT; tok += NGW) {
#pragma unroll
        for (int h = 0; h < 4; ++h) { const float o0 = O[(size_t)tok * 512 + h * 128 + 2 * lane], o1 = O[(size_t)tok * 512 + h * 128 + 2 * lane + 1];
            const float ss = wave_sum(o0 * o0 + o1 * o1); const float r = rsqrtf(ss * (1.0f / 128.0f) + EPS);
            const unsigned zw = *(const unsigned*)(P + (size_t)tok * NP + C_Z + h * 128 + 2 * lane);
            const float y0 = o0 * r * nw[2 * lane] * siluf_(bf_lo(zw)), y1 = o1 * r * nw[2 * lane + 1] * siluf_(bf_hi(zw));
            *(unsigned*)(Y + (size_t)tok * DM + h * 128 + 2 * lane) = pk2(y0, y1); }
    }
}

constexpr int NSA_KT_PITCH = 144, NSA_VT_PITCH = 136;
struct NsaStage { u32x4 kv, vv; };
__device__ __forceinline__ NsaStage nsa_load(const bf16* Kbase, int kpitch, const bf16* Vbase, int vpitch, int tid) {
    const int key = tid >> 3, seg = tid & 7; NsaStage s;
    s.kv = *(const u32x4*)(Kbase + (size_t)key * kpitch + seg * 8); s.vv = *(const u32x4*)(Vbase + (size_t)key * vpitch + seg * 8); return s;
}
__device__ __forceinline__ void nsa_store(const NsaStage& s, LAS unsigned char* Kt, LAS unsigned char* Vt, int tid) {
    const int key = tid >> 3, seg = tid & 7;
    *(LAS u32x4*)(Kt + key * NSA_KT_PITCH + seg * 16) = s.kv;
#pragma unroll
    for (int i = 0; i < 4; ++i) { const unsigned w = s.vv[i];
        *(LAS unsigned short*)(Vt + (seg * 8 + 2 * i) * NSA_VT_PITCH + key * 2) = (unsigned short)(w & 0xffffu);
        *(LAS unsigned short*)(Vt + (seg * 8 + 2 * i + 1) * NSA_VT_PITCH + key * 2) = (unsigned short)(w >> 16); }
}
__device__ __forceinline__ void nsa_st(const LAS unsigned char* Kt, const bf16x8 (&qf)[4], int n, int hh, f32x16 (&s)[2]) {
#pragma unroll
    for (int kb = 0; kb < 2; ++kb) {
#pragma unroll
        for (int r = 0; r < 16; ++r) s[kb][r] = 0.f;
#pragma unroll
        for (int ks = 0; ks < 4; ++ks) { const bf16x8 af = *(const LAS bf16x8*)(Kt + (kb * 32 + n) * NSA_KT_PITCH + (16 * ks + 8 * hh) * 2);
            s[kb] = __builtin_amdgcn_mfma_f32_32x32x16_bf16(af, qf[ks], s[kb], 0, 0, 0); } }
}
__device__ __forceinline__ void nsa_pvm(const LAS unsigned char* Vt, const bf16x8 (&pf)[2][2], int n, int hh, f32x16 (&o)[2]) {
#pragma unroll
    for (int db = 0; db < 2; ++db)
#pragma unroll
        for (int kb = 0; kb < 2; ++kb)
#pragma unroll
            for (int s2 = 0; s2 < 2; ++s2) { const LAS unsigned char* p = Vt + (db * 32 + n) * NSA_VT_PITCH + (kb * 32 + 16 * s2 + 4 * hh) * 2;
                const u32x2 lo = *(const LAS u32x2*)p, hi = *(const LAS u32x2*)(p + 16);
                const u32x4 av = {lo.x, lo.y, hi.x, hi.y};
                o[db] = __builtin_amdgcn_mfma_f32_32x32x16_bf16(__builtin_bit_cast(bf16x8, av), pf[kb][s2], o[db], 0, 0, 0); }
}
__device__ __forceinline__ void nsa_pack(const f32x16 (&p)[2], bf16x8 (&pf)[2][2]) {
#pragma unroll
    for (int kb = 0; kb < 2; ++kb)
#pragma unroll
        for (int s2 = 0; s2 < 2; ++s2) { u32x4 w;
            w.x = pg8::cvt_pk_bf16(p[kb][8 * s2 + 0], p[kb][8 * s2 + 1]); w.y = pg8::cvt_pk_bf16(p[kb][8 * s2 + 2], p[kb][8 * s2 + 3]);
            w.z = pg8::cvt_pk_bf16(p[kb][8 * s2 + 4], p[kb][8 * s2 + 5]); w.w = pg8::cvt_pk_bf16(p[kb][8 * s2 + 6], p[kb][8 * s2 + 7]);
            pf[kb][s2] = __builtin_bit_cast(bf16x8, w); }
}
constexpr int BT2_ROWS = 2048 + 72;
template <bool COLSEL>
__device__ __forceinline__ void nsa_tile_mfma(const LAS unsigned char* Kt, const LAS unsigned char* Vt, const LAS float* btl2h, const bf16x8 (&qf)[4], int n, int hh,
                                              int key0, int tq, bool masked, bool colsel, int maxd, float& m, float& l, f32x16 (&o)[2]) {
    f32x16 s[2]; nsa_st(Kt, qf, n, hh, s);
    const int dbase = tq - key0 - 4 * hh;
    const LAS float* bp = btl2h + (2047 - dbase) * 4;
#pragma unroll
    for (int kb = 0; kb < 2; ++kb)
#pragma unroll
        for (int r = 0; r < 16; ++r) { const int cst = kb * 32 + (r & 3) + 8 * (r >> 2); const float x = s[kb][r] + bp[cst * 4]; s[kb][r] = (!COLSEL || colsel) ? x : -3.0e38f; }
    if (masked) {
#pragma unroll
        for (int kb = 0; kb < 2; ++kb)
#pragma unroll
            for (int r = 0; r < 16; ++r) { const int dist = dbase - (kb * 32 + (r & 3) + 8 * (r >> 2)); s[kb][r] = (dist >= 0 && dist <= maxd) ? s[kb][r] : -3.0e38f; } }
    float tmax = -3.0e38f;
#pragma unroll
    for (int kb = 0; kb < 2; ++kb)
#pragma unroll
        for (int r = 0; r < 16; ++r) tmax = fmaxf(tmax, s[kb][r]);
    tmax = fmaxf(tmax, __shfl_xor(tmax, 32));
    const float mn = fmaxf(m, tmax); float rs = 0.f;
#pragma unroll
    for (int kb = 0; kb < 2; ++kb)
#pragma unroll
        for (int r = 0; r < 16; ++r) { const float p = __builtin_amdgcn_exp2f(s[kb][r] - mn); s[kb][r] = p; rs += p; }
    rs += __shfl_xor(rs, 32);
    if (__any(mn > m)) { const float corr = __builtin_amdgcn_exp2f(m - mn); l *= corr;
#pragma unroll
        for (int db = 0; db < 2; ++db)
#pragma unroll
            for (int r = 0; r < 16; ++r) o[db][r] *= corr; }
    l += rs; m = mn;
    bf16x8 pf[2][2]; nsa_pack(s, pf);
    nsa_pvm(Vt, pf, n, hh, o);
}

__device__ __forceinline__ void ph_nsa_mfma(const ArgsG& a, LAS unsigned char* lds, int ubeg, int ustep, int uend, int tid, int wave, int lane) {
    LAS float* btl2 = (LAS float*)lds;
    constexpr int NSA_L0 = BT2_ROWS * 16;
    LAS unsigned char* Kt = lds + NSA_L0;
    LAS unsigned char* Vt = lds + NSA_L0 + 9216;
    constexpr int NSA_TB = 9216 + 8704;
    LAS float* PS = (LAS float*)(lds + NSA_L0 + 2 * NSA_TB + 256);
    LAS unsigned* MK = (LAS unsigned*)(lds + NSA_L0 + 2 * NSA_TB + 256 + 64 * 129 * 4);
    static_assert(NSA_L0 + 2 * NSA_TB + 256 + 64 * 129 * 4 + 512 <= RING_BYTES, "NSA LDS");
    const float* BT = (const float*)(a.W() + WS_BT);
    for (int i = tid; i < BT2_ROWS * 4; i += NTHR) { const int row = i >> 2, hd = i & 3; btl2[i] = row < 2048 ? BT[hd * 2048 + (2047 - row)] * 1.4426950408889634f : 0.f; }
    const bf16* P = (const bf16*)(a.W() + WS_P); const bf16* NQ = (const bf16*)(a.W() + WS_NQ);
    const bf16* KS = (const bf16*)(a.W() + WS_KS); const bf16* KW = (const bf16*)(a.W() + WS_KW);
    const bf16* KCMP = (const bf16*)(a.W() + WS_KCMP); const bf16* VCMP = (const bf16*)(a.W() + WS_VCMP); bf16* Y = (bf16*)(a.W() + WS_Y);
    const int n = lane & 31, hh = lane >> 5, tl = n >> 2, h = n & 3;
    const LAS float* btl2h = btl2 + h;
    __syncthreads();
    for (int u = ubeg; u < uend; u += ustep) {
        const int b = u & 7, qt = 31 - (u >> 3), t0 = 64 * qt, tq = t0 + 8 * wave + tl, tok = b * SEQ + tq;
        bf16x8 qf[4];
#pragma unroll
        for (int ks = 0; ks < 4; ++ks) qf[ks] = *(const bf16x8*)(NQ + (size_t)tok * 256 + h * 64 + 16 * ks + 8 * hh);
        float gate[3];
#pragma unroll
        for (int br = 0; br < 3; ++br) gate[br] = sigmoidf_(bf2f(P[(size_t)tok * NP + C_G + h * 3 + br]));
        f32x16 yacc[2];
        {
            float mx = -1e30f, rs = 0.f;
#pragma unroll 1
            for (int ct = 0; ct < 2; ++ct) {
                __syncthreads();
                { const NsaStage st = nsa_load(KCMP + (size_t)(b * 128 + ct * 64) * 64, 64, VCMP + (size_t)(b * 128 + ct * 64) * 64, 64, tid); nsa_store(st, Kt, Vt, tid); }
                __syncthreads();
                f32x16 sc[2]; nsa_st(Kt, qf, n, hh, sc);
                float tmax = -1e30f;
#pragma unroll
                for (int kb = 0; kb < 2; ++kb)
#pragma unroll
                    for (int r = 0; r < 16; ++r) { const int j = ct * 64 + kb * 32 + (r & 3) + 8 * (r >> 2) + 4 * hh; const int dist = tq - 16 * j - 31;
                        const float x = sc[kb][r] + btl2h[(2047 - (dist < 0 ? 0 : dist)) * 4]; sc[kb][r] = dist >= 0 ? x : -1e30f; tmax = fmaxf(tmax, sc[kb][r]); }
                tmax = fmaxf(tmax, __shfl_xor(tmax, 32));
                const float mn = fmaxf(mx, tmax); float ts = 0.f;
#pragma unroll
                for (int kb = 0; kb < 2; ++kb)
#pragma unroll
                    for (int r = 0; r < 16; ++r) { const float x = sc[kb][r]; ts += x > -1e29f ? __builtin_amdgcn_exp2f(x - mn) : 0.f; }
                ts += __shfl_xor(ts, 32);
                rs = rs * __builtin_amdgcn_exp2f(mx - mn) + ts; mx = mn;
            }
            const float inv = rs > 0.f ? 1.0f / rs : 0.f;
            f32x16 o[2];
#pragma unroll
            for (int db = 0; db < 2; ++db)
#pragma unroll
                for (int r = 0; r < 16; ++r) o[db][r] = 0.f;
#pragma unroll 1
            for (int cc = 0; cc < 2; ++cc) { const int ct = 1 - cc;
                if (cc == 1) { __syncthreads();
                    { const NsaStage st = nsa_load(KCMP + (size_t)(b * 128) * 64, 64, VCMP + (size_t)(b * 128) * 64, 64, tid); nsa_store(st, Kt, Vt, tid); }
                    __syncthreads(); }
                f32x16 sc[2]; nsa_st(Kt, qf, n, hh, sc);
#pragma unroll
                for (int kb = 0; kb < 2; ++kb)
#pragma unroll
                    for (int r = 0; r < 16; ++r) { const int j = ct * 64 + kb * 32 + (r & 3) + 8 * (r >> 2) + 4 * hh; const int dist = tq - 16 * j - 31;
                        const float x = sc[kb][r] + btl2h[(2047 - (dist < 0 ? 0 : dist)) * 4]; const float p = dist >= 0 ? __builtin_amdgcn_exp2f(x - mx) * inv : 0.f; sc[kb][r] = p;
                        float v = p; v += __shfl_xor(v, 1); v += __shfl_xor(v, 2);
                        if (h == 0) PS[(8 * wave + tl) * 129 + j] = v; }
                bf16x8 pf[2][2]; nsa_pack(sc, pf); nsa_pvm(Vt, pf, n, hh, o);
            }
#pragma unroll
            for (int db = 0; db < 2; ++db)
#pragma unroll
                for (int r = 0; r < 16; ++r) yacc[db][r] = gate[0] * o[db][r];
        }
        LDS_WAIT();
        for (int t2 = 0; t2 < 8; ++t2) {
            const int tqq = t0 + 8 * wave + t2, sb = lane & 31, cur = tqq >> 6; const LAS float* row = PS + (8 * wave + t2) * 129; float imp = 0.f;
#pragma unroll
            for (int dj = -1; dj <= 3; ++dj) { const int j = 4 * sb + dj; if (j >= 0 && j <= 126) imp += row[j]; }
            if (sb > cur) imp = -1.0f; else if (sb == 0 || sb == cur || sb == cur - 1) imp = 1e4f;
            int rank = 0;
            for (int s2 = 0; s2 < 32; ++s2) { const float v2 = __shfl(imp, s2); rank += (v2 > imp || (v2 == imp && s2 < sb)) ? 1 : 0; }
            const unsigned msk = (unsigned)__ballot((lane < 32) && (rank < 16) && (sb <= cur));
            if (lane == 0) MK[8 * wave + t2] = msk;
        }
        __syncthreads();
        unsigned anymask, wmask; const unsigned mymask = MK[8 * wave + tl];
        { unsigned v = MK[lane];
#pragma unroll
            for (int o_ = 1; o_ < 64; o_ <<= 1) v |= (unsigned)__shfl_xor((int)v, o_);
            anymask = (unsigned)__builtin_amdgcn_readfirstlane((int)v);
            unsigned w = MK[8 * wave + (lane & 7)]; w |= (unsigned)__shfl_xor((int)w, 1); w |= (unsigned)__shfl_xor((int)w, 2); w |= (unsigned)__shfl_xor((int)w, 4);
            wmask = (unsigned)__builtin_amdgcn_readfirstlane((int)w); }
        LAS unsigned* stash = (LAS unsigned*)PS + (wave * 16) * 64 + lane;
        __syncthreads();
#pragma unroll
        for (int db = 0; db < 2; ++db)
#pragma unroll
            for (int k = 0; k < 8; ++k) stash[(db * 8 + k) * 64] = pk2(yacc[db][2 * k], yacc[db][2 * k + 1]);
        {
            float m = -1e30f, l = 0.f; f32x16 o[2];
#pragma unroll
            for (int db = 0; db < 2; ++db)
#pragma unroll
                for (int r = 0; r < 16; ++r) o[db][r] = 0.f;
            unsigned mk = anymask; NsaStage s0, s1; bool h1 = false;
            { const int sa = __builtin_ctz(mk); s0 = nsa_load(KS + (size_t)(b * SEQ + 64 * sa) * 64, 64, P + (size_t)(b * SEQ + 64 * sa) * NP + C_KV + 192, NP, tid);
              unsigned m2 = mk & (mk - 1u); if (m2) { const int sb2 = __builtin_ctz(m2); s1 = nsa_load(KS + (size_t)(b * SEQ + 64 * sb2) * 64, 64, P + (size_t)(b * SEQ + 64 * sb2) * NP + C_KV + 192, NP, tid); h1 = true; } }
            __syncthreads();
            nsa_store(s0, Kt, Vt, tid);
            __syncthreads();
            int par = 0;
            while (mk) {
                const int sblk = __builtin_ctz(mk); mk &= mk - 1u;
                if (h1) { nsa_store(s1, Kt + (par ^ 1) * NSA_TB, Vt + (par ^ 1) * NSA_TB, tid);
                    const unsigned m3 = mk & (mk - 1u);
                    if (m3) { const int sc2 = __builtin_ctz(m3); s1 = nsa_load(KS + (size_t)(b * SEQ + 64 * sc2) * 64, 64, P + (size_t)(b * SEQ + 64 * sc2) * NP + C_KV + 192, NP, tid); } else h1 = false; }
                if ((wmask >> sblk) & 1u) nsa_tile_mfma<true>(Kt + par * NSA_TB, Vt + par * NSA_TB, btl2h, qf, n, hh, 64 * sblk, tq, 64 * sblk + 63 > t0 + 8 * wave, ((mymask >> sblk) & 1u) != 0u, 1 << 30, m, l, o);
                __syncthreads();
                par ^= 1;
            }
            const float inv = l > 0.f ? gate[1] / l : 0.f;
#pragma unroll
            for (int db = 0; db < 2; ++db)
#pragma unroll
                for (int k = 0; k < 8; ++k) { const unsigned w = stash[(db * 8 + k) * 64]; stash[(db * 8 + k) * 64] = pk2(bf_lo(w) + inv * o[db][2 * k], bf_hi(w) + inv * o[db][2 * k + 1]); }
        }
        {
            float m = -1e30f, l = 0.f; f32x16 o[2];
#pragma unroll
            for (int db = 0; db < 2; ++db)
#pragma unroll
                for (int r = 0; r < 16; ++r) o[db][r] = 0.f;
            const int kt0 = (t0 - 511 > 0 ? t0 - 511 : 0) >> 6;
            NsaStage s0 = nsa_load(KW + (size_t)(b * SEQ + 64 * kt0) * 64, 64, P + (size_t)(b * SEQ + 64 * kt0) * NP + C_KV + 320, NP, tid), s1;
            if (kt0 < qt) s1 = nsa_load(KW + (size_t)(b * SEQ + 64 * (kt0 + 1)) * 64, 64, P + (size_t)(b * SEQ + 64 * (kt0 + 1)) * NP + C_KV + 320, NP, tid);
            __syncthreads();
            nsa_store(s0, Kt, Vt, tid);
            __syncthreads();
            int par = 0;
            for (int kt = kt0; kt <= qt; ++kt) {
                if (kt < qt) { nsa_store(s1, Kt + (par ^ 1) * NSA_TB, Vt + (par ^ 1) * NSA_TB, tid);
                    if (kt + 2 <= qt) s1 = nsa_load(KW + (size_t)(b * SEQ + 64 * (kt + 2)) * 64, 64, P + (size_t)(b * SEQ + 64 * (kt + 2)) * NP + C_KV + 320, NP, tid); }
                nsa_tile_mfma<false>(Kt + par * NSA_TB, Vt + par * NSA_TB, btl2h, qf, n, hh, 64 * kt, tq, !(64 * kt + 63 <= t0 + 8 * wave && t0 + 8 * wave + 7 - 64 * kt <= 511), true, 511, m, l, o);
                __syncthreads();
                par ^= 1;
            }
            const float inv = l > 0.f ? gate[2] / l : 0.f;
#pragma unroll
            for (int db = 0; db < 2; ++db)
#pragma unroll
                for (int k = 0; k < 8; ++k) { const unsigned w = stash[(db * 8 + k) * 64]; yacc[db][2 * k] = bf_lo(w) + inv * o[db][2 * k]; yacc[db][2 * k + 1] = bf_hi(w) + inv * o[db][2 * k + 1]; }
        }
#pragma unroll
        for (int db = 0; db < 2; ++db)
#pragma unroll
            for (int rq = 0; rq < 4; ++rq) { u32x2 w; w.x = pk2(yacc[db][4 * rq], yacc[db][4 * rq + 1]); w.y = pk2(yacc[db][4 * rq + 2], yacc[db][4 * rq + 3]);
                *(u32x2*)(Y + (size_t)tok * DM + 512 + h * 64 + db * 32 + 8 * rq + 4 * hh) = w; }
        __syncthreads();
    }
}

constexpr int RT_PITCH = 2064;
__device__ __forceinline__ void ph_router(const ArgsG& a, int l, const float* Xin_, const bf16* Dm, LAS unsigned char* lds, int bid, int G, int tid, int wave, int lane) {
    LAS unsigned char* Ht = lds;
    LAS float* LG = (LAS float*)(lds + 32 * RT_PITCH);
    LAS int* lcnt = (LAS int*)(lds + 32 * RT_PITCH + 64 * 33 * 4); LAS int* asg_e = lcnt + 32; LAS int* asg_p = asg_e + 256; LAS float* asg_w = (LAS float*)(asg_p + 256); LAS int* gbase = (LAS int*)(asg_w + 256);
    bf16* H2 = (bf16*)(a.W() + WS_XN); unsigned* cnt = (unsigned*)(a.W() + WS_CTL) + CW_CNT + 64 * l;
    int* EIDX = (int*)(a.W() + WS_EIDX); int* EPOS = (int*)(a.W() + WS_EPOS); float* EW = (float*)(a.W() + WS_EW);
    const float* fw = a.I(17) + (size_t)l * DM; const float* rb = a.I(19) + l * NE;
    const bf16* RWH = (const bf16*)(a.W() + WS_RWH) + (size_t)l * NE * DM; const bf16* RWL = (const bf16*)(a.W() + WS_RWL) + (size_t)l * NE * DM;
    for (int u = bid; u < NT / 64; u += G) {
        const int tok0 = u * 64;
        if (tid < 32) lcnt[tid] = 0;
#pragma unroll 1
        for (int hf = 0; hf < 2; ++hf) {
            __syncthreads();
#pragma unroll 1
            for (int i = 0; i < 4; ++i) { const int tl = 4 * wave + i, tok = tok0 + 32 * hf + tl;
                f32x4 v[4]; float ss = 0.f;
#pragma unroll
                for (int j = 0; j < 4; ++j) { v[j] = *(const f32x4*)(Xin_ + (size_t)tok * DM + 4 * (64 * j + lane)); const u32x2 dd = *(const u32x2*)(Dm + (size_t)tok * DM + 4 * (64 * j + lane));
                    v[j].x += bf_lo(dd.x); v[j].y += bf_hi(dd.x); v[j].z += bf_lo(dd.y); v[j].w += bf_hi(dd.y); ss += (v[j].x * v[j].x + v[j].y * v[j].y) + (v[j].z * v[j].z + v[j].w * v[j].w); }
                const float r = rsqrtf(wave_sum(ss) * (1.0f / DM) + EPS);
#pragma unroll
                for (int j = 0; j < 4; ++j) { const f32x4 y = v[j] * r * *(const f32x4*)(fw + 4 * (64 * j + lane));
                    u32x2 o; o.x = pk2(y.x, y.y); o.y = pk2(y.z, y.w); *(u32x2*)(H2 + (size_t)tok * DM + 4 * (64 * j + lane)) = o;
                    *(LAS u32x2*)(Ht + tl * RT_PITCH + 8 * (64 * j + lane)) = o; } }
            __syncthreads();
            if (wave < 2) { const int r = lane & 15, q = lane >> 4; f32x4 acc0 = {0.f, 0.f, 0.f, 0.f}, acc1 = {0.f, 0.f, 0.f, 0.f};
                const LAS unsigned char* arow = Ht + (16 * wave + r) * RT_PITCH + q * 16;
                const bf16* bh = RWH + (size_t)r * DM + 8 * q; const bf16* bl = RWL + (size_t)r * DM + 8 * q;
#pragma unroll 4
                for (int s = 0; s < 32; ++s) { const bf16x8 af = *(const LAS bf16x8*)(arow + s * 64);
                    acc0 = __builtin_amdgcn_mfma_f32_16x16x32_bf16(af, *(const bf16x8*)(bh + 32 * s), acc0, 0, 0, 0); acc0 = __builtin_amdgcn_mfma_f32_16x16x32_bf16(af, *(const bf16x8*)(bl + 32 * s), acc0, 0, 0, 0);
                    acc1 = __builtin_amdgcn_mfma_f32_16x16x32_bf16(af, *(const bf16x8*)(bh + 16 * DM + 32 * s), acc1, 0, 0, 0); acc1 = __builtin_amdgcn_mfma_f32_16x16x32_bf16(af, *(const bf16x8*)(bl + 16 * DM + 32 * s), acc1, 0, 0, 0); }
                const float b0 = rb[r], b1 = rb[16 + r];
#pragma unroll
                for (int i = 0; i < 4; ++i) { LAS float* lg = LG + (32 * hf + 16 * wave + 4 * q + i) * 33; lg[r] = acc0[i] + b0; lg[16 + r] = acc1[i] + b1; } }
        }
        __syncthreads();
        if (tid < 64) { const LAS float* lg = LG + tid * 33; unsigned used = 0u; float tv[4]; int ti[4];
#pragma unroll
            for (int qn = 0; qn < 4; ++qn) { float best = -3.0e38f; int bi = 0;
                for (int e = 0; e < NE; ++e) { const float v = lg[e]; if (!((used >> e) & 1u) && v > best) { best = v; bi = e; } }
                used |= 1u << bi; tv[qn] = best; ti[qn] = bi; }
            float ew[4], es = 0.f;
#pragma unroll
            for (int qn = 0; qn < 4; ++qn) { ew[qn] = __expf(tv[qn] - tv[0]); es += ew[qn]; }
#pragma unroll
            for (int qn = 0; qn < 4; ++qn) { const int p = __hip_atomic_fetch_add(&lcnt[ti[qn]], 1, __ATOMIC_RELAXED, __HIP_MEMORY_SCOPE_WORKGROUP); asg_e[tid * 4 + qn] = ti[qn]; asg_p[tid * 4 + qn] = p; asg_w[tid * 4 + qn] = ew[qn] / es; } }
        __syncthreads();
        if (tid < 32) gbase[tid] = (int)atomicAdd(&cnt[tid], (unsigned)lcnt[tid]);
        __syncthreads();
        if (tid < 256) { const int tok = tok0 + (tid >> 2), k = tid & 3, e = asg_e[tid];
            EIDX[(size_t)tok * 4 + k] = e; EPOS[(size_t)tok * 4 + k] = gbase[e] + asg_p[tid]; EW[(size_t)tok * 4 + k] = asg_w[tid]; }
        __syncthreads();
    }
}

__device__ __forceinline__ void build_tiles(const unsigned* cnt, LAS int* TS, LAS int* TE, int tid) {
    if (tid == 0) { int acc = 0;
        for (int e = 0; e < NE; ++e) { TS[e] = acc; const int nt = (int)((cnt[e] + 255u) >> 8); for (int i = 0; i < nt; ++i) TE[acc + i] = e; acc += nt; }
        TS[NE] = acc; }
    __syncthreads();
}

__device__ __forceinline__ void ph_gather(const ArgsG& a, int l, LAS unsigned char* lds, int gw, int NGW, int tid, int lane) {
    LAS int* TS = (LAS int*)(lds + TS_OFF); LAS int* TE = (LAS int*)(lds + TE_OFF);
    build_tiles((const unsigned*)(a.W() + WS_CTL) + CW_CNT + 64 * l, TS, TE, tid);
    const bf16* H2 = (const bf16*)(a.W() + WS_XN); bf16* XS = (bf16*)(a.W() + WS_XS);
    const int* EIDX = (const int*)(a.W() + WS_EIDX); const int* EPOS = (const int*)(a.W() + WS_EPOS); int* SLOT = (int*)(a.W() + WS_SLOT);
    for (int tok = gw; tok < NT; tok += NGW) {
        int slot = 0;
        if (lane < 4) { const int e = EIDX[(size_t)tok * 4 + lane]; slot = TS[e] * 256 + EPOS[(size_t)tok * 4 + lane]; SLOT[(size_t)tok * 4 + lane] = slot; }
        const u32x4 r0 = *(const u32x4*)(H2 + (size_t)tok * DM + 8 * lane), r1 = *(const u32x4*)(H2 + (size_t)tok * DM + 512 + 8 * lane);
#pragma unroll
        for (int k = 0; k < 4; ++k) { const int sk = __shfl(slot, k); *(u32x4*)(XS + (size_t)sk * DM + 8 * lane) = r0; *(u32x4*)(XS + (size_t)sk * DM + 512 + 8 * lane) = r1; }
    }
}

__device__ __forceinline__ void ph_combine(const ArgsG& a, const float* Xin_, const bf16* Dm, float* Xo, const float* next_norm_w, int gw, int NGW, int lane) {
    const bf16* YS = (const bf16*)(a.W() + WS_YS); const int* SLOT = (const int*)(a.W() + WS_SLOT); const float* EW = (const float*)(a.W() + WS_EW); bf16* XN = (bf16*)(a.W() + WS_XN);
    for (int tok = gw; tok < NT; tok += NGW) {
        int slot = 0; float wgt = 0.f;
        if (lane < 4) { slot = SLOT[(size_t)tok * 4 + lane]; wgt = EW[(size_t)tok * 4 + lane]; }
        f32x4 v[4];
#pragma unroll
        for (int j = 0; j < 4; ++j) { v[j] = *(const f32x4*)(Xin_ + (size_t)tok * DM + 4 * (64 * j + lane)); const u32x2 dd = *(const u32x2*)(Dm + (size_t)tok * DM + 4 * (64 * j + lane));
            v[j].x += bf_lo(dd.x); v[j].y += bf_hi(dd.x); v[j].z += bf_lo(dd.y); v[j].w += bf_hi(dd.y); }
#pragma unroll
        for (int k = 0; k < 4; ++k) { const int sk = __shfl(slot, k); const float wk = __shfl(wgt, k);
#pragma unroll
            for (int j = 0; j < 4; ++j) { const u32x2 y = *(const u32x2*)(YS + (size_t)sk * DM + 4 * (64 * j + lane));
                v[j].x += wk * bf_lo(y.x); v[j].y += wk * bf_hi(y.x); v[j].z += wk * bf_lo(y.y); v[j].w += wk * bf_hi(y.y); } }
#pragma unroll
        for (int j = 0; j < 4; ++j) *(f32x4*)(Xo + (size_t)tok * DM + 4 * (64 * j + lane)) = v[j];
        if (next_norm_w) rms_row_to_bf16(v, next_norm_w, XN + (size_t)tok * DM, lane);
    }
}

struct Tid { int tid, lane, wave; };
__device__ __forceinline__ Tid fresh_tid() { int t = threadIdx.x; asm volatile("" : "+v"(t)); Tid r; r.tid = t; r.lane = t & 63; r.wave = __builtin_amdgcn_readfirstlane(t >> 6); return r; }
#define FT() ArgsG A_; { unsigned char* w_ = args_k.ws; asm volatile("" : "+s"(w_)); A_.ws = (GAS unsigned char*)w_; _Pragma("unroll") for (int i_ = 0; i_ < 25; ++i_) A_.in[i_] = (const GAS float*)args_k.in[i_]; A_.out = (GAS float*)args_k.out; } const ArgsG& args = A_; const Tid T_ = fresh_tid(); const int tid = T_.tid, lane = T_.lane, wave = T_.wave, gw = bid * NWAVES + wave; (void)tid; (void)lane; (void)wave; (void)gw
constexpr int PH_PER_LAYER = 11, NPH = 2 + NLAYER * PH_PER_LAYER;

#if SINGLE_LAUNCH
#define BARPARM , unsigned* barw, unsigned& bark
#define BARARG , barw, bark
#define GRID_BAR() cnt_barrier(barw, bark)
#else
#define BARPARM
#define BARARG
#define GRID_BAR() do {} while (0)
#endif
#define IN(k) (lo <= (k) && (k) < hi)
#define SEAM(k) do { if (IN(k) && IN((k) + 1)) GRID_BAR(); } while (0)
template <int l>
__device__ __forceinline__ void run_layer(const Args& args_k, LAS unsigned char* lds, int lo, int hi, int G, int bid, int NGW BARPARM) {
        const int pb = 2 + l * PH_PER_LAYER;
#define Xin ((l == 0) ? args.I(0) : (const float*)(args.W() + WS_XB))
#define X1 ((float*)(args.W() + WS_XA))
#define Xout ((l == NLAYER - 1) ? args.O() : (float*)(args.W() + WS_XB))
        if (IN(pb + 0)) {
            FT(); pg8::Gemm g{(const pg8::bf16_t*)(args.W() + WS_XN), (const pg8::bf16_t*)(args.W() + WS_WIN) + (size_t)l * NP * DM, NT, NP, DM};
            pg8::StaticOrder S; S.init(NT, NP, G, bid);
            pg8::EpiBf16Plain E{(pg8::bf16_t*)(args.W() + WS_P), NP};
            pg8::gemm_phase<pg8::EpiBf16Plain, pg8::StaticOrder, true, true>(lds, g, S, E);
        } SEAM(pb + 0);
        if (IN(pb + 1)) { { FT(); ph_compress_mfma(args, l, lds, bid, G, tid, wave, lane); } { FT(); ph_m1(args, l, lds, bid, G, tid, wave, lane); } } SEAM(pb + 1);
        if (IN(pb + 2)) { FT(); ph_dn_chunk_mfma(args, lds, bid, G, tid, wave, lane); } SEAM(pb + 2);
        if (IN(pb + 3)) {
            const bool small = G <= 64;
            if (small || bid < 32) { FT(); ph_dn_scan_mfma(args, lds, bid, small ? G : 32, tid, wave, lane); }
            { int ub, us, ue;
              if (small) { ub = bid; us = G; ue = 256; }
              else if (G == 256) { if (bid >= 32) { ub = bid - 32; us = 32; ue = ub >= 192 ? 256 : ub + 1; } else { ub = 256; us = 256; ue = 256; } }
              else { ub = bid >= 32 ? bid - 32 : 256; us = G - 32; ue = 256; }
              FT(); ph_nsa_mfma(args, lds, ub, us, ue, tid, wave, lane); } } SEAM(pb + 3);
        if (IN(pb + 4)) { FT(); ph_dn_out(args, l, gw, NGW, lane); } SEAM(pb + 4);
        if (IN(pb + 5)) {
            FT(); pg8::Gemm g{(const pg8::bf16_t*)(args.W() + WS_Y), (const pg8::bf16_t*)(args.W() + WS_WOUT) + (size_t)l * DM * DM, NT, DM, DM};
            pg8::StaticOrder S; S.init(NT, DM, G, bid);
            pg8::EpiBf16Plain E{(pg8::bf16_t*)(args.W() + WS_XA), DM};
            pg8::gemm_phase<pg8::EpiBf16Plain, pg8::StaticOrder, true, true>(lds, g, S, E);
        } SEAM(pb + 5);
        if (IN(pb + 6)) { FT(); ph_router(args, l, Xin, (const bf16*)(args.W() + WS_XA), lds, bid, G, tid, wave, lane); } SEAM(pb + 6);
        if (IN(pb + 7)) { FT(); ph_gather(args, l, lds, gw, NGW, tid, lane); } SEAM(pb + 7);
        if (IN(pb + 8)) {
            FT(); LAS int* TS = (LAS int*)(lds + TS_OFF); LAS int* TE = (LAS int*)(lds + TE_OFF);
            build_tiles((const unsigned*)(args.W() + WS_CTL) + CW_CNT + 64 * l, TS, TE, tid);
            const int ntiles = __builtin_amdgcn_readfirstlane(TS[NE]);
            pg8::Gemm g{(const pg8::bf16_t*)(args.W() + WS_XS), (const pg8::bf16_t*)(args.W() + WS_WGU) + (size_t)l * NE * 2048 * DM, ntiles * 256, NE * 2048, DM};
            pg8::MoeOrder<8> S{ntiles, G, bid, (const LAS int*)TE};
            pg8::EpiSwiglu E{(pg8::bf16_t*)(args.W() + WS_ACT), args.I(21) + (size_t)l * NE * 2048};
            pg8::gemm_phase<pg8::EpiSwiglu, pg8::MoeOrder<8>, true, true>(lds, g, S, E);
        } SEAM(pb + 8);
        if (IN(pb + 9)) {
            FT(); LAS int* TS = (LAS int*)(lds + TS_OFF); LAS int* TE = (LAS int*)(lds + TE_OFF);
            build_tiles((const unsigned*)(args.W() + WS_CTL) + CW_CNT + 64 * l, TS, TE, tid);
            const int ntiles = __builtin_amdgcn_readfirstlane(TS[NE]);
            pg8::Gemm g{(const pg8::bf16_t*)(args.W() + WS_ACT), (const pg8::bf16_t*)(args.W() + WS_WD) + (size_t)l * NE * DM * DM, ntiles * 256, NE * DM, DM};
            pg8::MoeOrder<4> S{ntiles, G, bid, (const LAS int*)TE};
            pg8::EpiDown64 E{(pg8::bf16_t*)(args.W() + WS_YS), args.I(23) + (size_t)l * NE * DM};
            pg8::gemm_phase<pg8::EpiDown64, pg8::MoeOrder<4>, true, true>(lds, g, S, E);
        } SEAM(pb + 9);
        if (IN(pb + 10)) { FT(); ph_combine(args, Xin, (const bf16*)(args.W() + WS_XA), Xout, (l + 1 < NLAYER) ? args.I(1) + (size_t)(l + 1) * DM : nullptr, gw, NGW, lane); }
        if (l + 1 < NLAYER) SEAM(pb + 10);
    }

__global__ void __launch_bounds__(NTHR, 2) fwd_kernel(Args args_k) {
    extern __shared__ __attribute__((aligned(16))) unsigned char lds_raw[];
    LAS unsigned char* lds = (LAS unsigned char*)lds_raw;
    const int G = gridDim.x, bid = blockIdx.x, NGW = G * NWAVES;
    for (int u = threadIdx.x; u < (LDS_BYTES - LDSCTL_OFF) / 4; u += NTHR) ((LAS unsigned*)(lds + LDSCTL_OFF))[u] = 0u;
    __syncthreads();
#if SINGLE_LAUNCH
    unsigned* barw = (unsigned*)(args_k.ws + WS_CTL) + CW_BAR; unsigned bark = 0u;
#endif
    const int lo = args_k.ph_lo, hi = args_k.ph_hi;

    if (IN(0)) { FT(); ph_prologue(args, lds, gw, NGW, wave, lane); } SEAM(0);
    if (IN(1)) { FT(); ph_norm0(args, gw, NGW, lane); } SEAM(1);

    run_layer<0>(args_k, lds, lo, hi, G, bid, NGW BARARG);
    run_layer<1>(args_k, lds, lo, hi, G, bid, NGW BARARG);
#undef IN
#undef SEAM
}

extern "C" void kernel_launch(void* const* d_in, const int* in_sizes, int n_in, void* d_out, int out_size, void* d_ws, size_t ws_size, hipStream_t stream) {
    static int grid = 0;
    if (grid == 0) {
        if (n_in != 25 || in_sizes[0] != NT * DM || out_size != NT * DM || ws_size < WS_END) {
            fprintf(stderr, "kernel_launch: unexpected problem (n_in %d, in0 %d, out %d, ws %zu < %zu); nothing launched\n", n_in, n_in > 0 ? in_sizes[0] : -1, out_size, ws_size, (size_t)WS_END); grid = -1; return; }
        int dev = 0, cus = 0, per_cu = 0;
        if (hipGetDevice(&dev) != hipSuccess || hipDeviceGetAttribute(&cus, hipDeviceAttributeMultiprocessorCount, dev) != hipSuccess) { grid = -1; return; }
        if (hipFuncSetAttribute((const void*)fwd_kernel, hipFuncAttributeMaxDynamicSharedMemorySize, LDS_BYTES) != hipSuccess) { fprintf(stderr, "kernel_launch: hipFuncSetAttribute failed\n"); grid = -1; return; }
        if (hipOccupancyMaxActiveBlocksPerMultiprocessor(&per_cu, (const void*)fwd_kernel, NTHR, LDS_BYTES) != hipSuccess || per_cu < 1)
            fprintf(stderr, "kernel_launch: note: occupancy query reports %d workgroups per CU\n", per_cu);
        (void)hipGetLastError();
        grid = cus;
    }
    if (grid < 0) return;
    if (hipMemsetAsync((char*)d_ws + WS_CTL, 0, CTL_ZERO_BYTES, stream) != hipSuccess) { fprintf(stderr, "kernel_launch: memset failed\n"); return; }
    Args a{};
    for (int i = 0; i < 25; ++i) a.in[i] = (const float*)d_in[i];
    a.out = (float*)d_out; a.ws = (unsigned char*)d_ws;
#if SINGLE_LAUNCH
    a.ph_lo = 0; a.ph_hi = NPH;
    hipLaunchKernelGGL(fwd_kernel, dim3(grid), dim3(NTHR), LDS_BYTES, stream, a);
#else
    for (int ph = 0; ph < NPH; ++ph) { a.ph_lo = ph; a.ph_hi = ph + 1; hipLaunchKernelGGL(fwd_kernel, dim3(grid), dim3(NTHR), LDS_BYTES, stream, a); }
#endif
}
```

```cpp
#include <hip/hip_runtime.h>
#include <cstdio>
#include <cstdint>
#include <cstddef>
namespace pg8 {
#define PG8_LAS __attribute__((address_space(3)))
#define PG8_GAS __attribute__((address_space(1)))
typedef unsigned short bf16_t;
typedef short bf16x8 __attribute__((ext_vector_type(8)));
typedef float f32x4 __attribute__((ext_vector_type(4)));
typedef unsigned u32x4 __attribute__((ext_vector_type(4)));
constexpr int BM = 256, BK = 64, HALF = 128, HTB = HALF * BK * 2  , STAGE_BYTES = 8 * HTB, NXCD = 8, WGM = 8;

__host__ __device__ __forceinline__ int lds_byte(int r, int c) { const int st = (r >> 4) * 2 + (c >> 5), rr = r & 15, cc = c & 31, ob = rr * 64 + cc * 2; return st * 1024 + (ob ^ (((ob >> 9) & 1) << 5)); }
__host__ __device__ __forceinline__ void stage_rc(int b, int& R, int& C) { const int st = b / 1024, sb = b % 1024, swz = sb ^ (((sb >> 9) & 1) << 5); R = (st >> 1) * 16 + swz / 64; C = (st & 1) * 32 + (swz % 64) / 2; }
__host__ __device__ __forceinline__ int perm32(int rho) { const int n = rho >> 4, i = rho & 15; return 8 * (i >> 2) + 4 * n + (i & 3); }

struct Unit { int pm, pn; };
struct Gemm { const bf16_t* A; const bf16_t* Bt; int M, N, K; };

struct StaticOrder {
    static constexpr bool GATHER = false; const PG8_LAS int* rowtab = nullptr;
    int nM, nN, nwg, G, c;
    __host__ __device__ void init(int M, int N, int G_, int c_) { nM = M / BM; nN = N / BM; nwg = nM * nN; G = G_; c = c_; }
    __host__ __device__ bool next(int i, Unit& u) const {
        const long L = (long)i * G + c; if (L >= nwg) return false;
        int wgid = (int)L; { const int q = nwg / NXCD, r = nwg % NXCD, xcd = wgid % NXCD, off = wgid / NXCD; wgid = (xcd < r ? xcd * (q + 1) : r * (q + 1) + (xcd - r) * q) + off; }
        const int nig = WGM * nN, gid = wgid / nig, fm = gid * WGM, gsz = (nM - fm) < WGM ? (nM - fm) : WGM;
        u.pm = fm + ((wgid % nig) % gsz); u.pn = (wgid % nig) / gsz; return true;
    }
    __device__ __forceinline__ void a_ready(const Unit&) const {}
    __device__ __forceinline__ void done(const Unit&) const {}
};

__device__ __forceinline__ unsigned cvt_pk_bf16(float lo, float hi) { unsigned r; asm volatile("v_cvt_pk_bf16_f32 %0, %1, %2" : "=v"(r) : "v"(lo), "v"(hi)); return r; }

struct EpiBf16Plain {
    static constexpr bool PERM = true, AFTER_DRAIN = false, B64 = false;
    bf16_t* O; int ldc;
    __device__ __forceinline__ void operator()(const f32x4 (&acc)[2][2][4][2], const Unit& u, int wr, int wc, int fr, int fq) const {
        const int row0 = u.pm * BM + wr * 64 + fr, col0 = u.pn * BM + wc * 32 + 8 * fq;
#pragma unroll
        for (int ai = 0; ai < 2; ++ai)
#pragma unroll
            for (int m = 0; m < 4; ++m) { bf16_t* rowp = O + (size_t)(row0 + ai * HALF + m * 16) * ldc + col0;
#pragma unroll
                for (int bj = 0; bj < 2; ++bj) { const f32x4 v0 = acc[ai][bj][m][0], v1 = acc[ai][bj][m][1];
                    u32x4 w; w.x = cvt_pk_bf16(v0[0], v0[1]); w.y = cvt_pk_bf16(v0[2], v0[3]); w.z = cvt_pk_bf16(v1[0], v1[1]); w.w = cvt_pk_bf16(v1[2], v1[3]);
                    *(PG8_GAS u32x4*)(rowp + bj * HALF) = w; } }
    }
};
struct EpiResF32 {
    static constexpr bool PERM = false, AFTER_DRAIN = false, B64 = false;
    const float* base; float* out; int ldc;
    __device__ __forceinline__ void operator()(const f32x4 (&acc)[2][2][4][2], const Unit& u, int wr, int wc, int fr, int fq) const {
        const int row0 = u.pm * BM + wr * 64 + fr, col0 = u.pn * BM + wc * 32 + 4 * fq;
#pragma unroll
        for (int ai = 0; ai < 2; ++ai)
#pragma unroll
            for (int m = 0; m < 4; ++m) { const size_t off = (size_t)(row0 + ai * HALF + m * 16) * ldc + col0;
#pragma unroll
                for (int bj = 0; bj < 2; ++bj)
#pragma unroll
                    for (int n = 0; n < 2; ++n) { const f32x4 b = *(const f32x4*)(base + off + bj * HALF + n * 16); *(PG8_GAS f32x4*)(out + off + bj * HALF + n * 16) = b + acc[ai][bj][m][n]; } }
    }
};
struct EpiSwiglu {
    static constexpr bool PERM = true, AFTER_DRAIN = false, B64 = false;
    bf16_t* O; const float* bgu;
    __device__ __forceinline__ void operator()(const f32x4 (&acc)[2][2][4][2], const Unit& u, int wr, int wc, int fr, int fq) const {
        const int e = u.pn >> 3, pnl = u.pn & 7;
        const int row0 = u.pm * BM + wr * 64 + fr, gcol = pnl * 128 + wc * 32 + 8 * fq;
        const float* bg = bgu + (size_t)e * 2048 + gcol;
        f32x4 bgv[2], buv[2];
#pragma unroll
        for (int n = 0; n < 2; ++n) { bgv[n] = *(const PG8_GAS f32x4*)(bg + 4 * n); buv[n] = *(const PG8_GAS f32x4*)(bg + 1024 + 4 * n); }
#pragma unroll
        for (int ai = 0; ai < 2; ++ai)
#pragma unroll
            for (int m = 0; m < 4; ++m) { bf16_t* rowp = O + (size_t)(row0 + ai * HALF + m * 16) * 1024 + gcol;
                float r[8];
#pragma unroll
                for (int n = 0; n < 2; ++n) { const f32x4 gv = acc[ai][0][m][n] + bgv[n], uv = acc[ai][1][m][n] + buv[n];
#pragma unroll
                    for (int j = 0; j < 4; ++j) { const float g = fminf(gv[j], 7.0f), up = fminf(fmaxf(uv[j], -7.0f), 7.0f);
                        const float sg = __builtin_amdgcn_rcpf(1.0f + __expf(-1.702f * g)); r[n * 4 + j] = (up + 1.0f) * g * sg; } }
                u32x4 w; w.x = cvt_pk_bf16(r[0], r[1]); w.y = cvt_pk_bf16(r[2], r[3]); w.z = cvt_pk_bf16(r[4], r[5]); w.w = cvt_pk_bf16(r[6], r[7]);
                *(PG8_GAS u32x4*)rowp = w; }
    }
};
struct EpiDown {
    static constexpr bool PERM = true, AFTER_DRAIN = false, B64 = false;
    bf16_t* O; const float* bd;
    __device__ __forceinline__ void operator()(const f32x4 (&acc)[2][2][4][2], const Unit& u, int wr, int wc, int fr, int fq) const {
        const int e = u.pn >> 2, pnl = u.pn & 3;
        const int row0 = u.pm * BM + wr * 64 + fr, col0 = pnl * BM + wc * 32 + 8 * fq;
        const float* bp = bd + (size_t)e * 1024 + col0;
        f32x4 bv[2][2];
#pragma unroll
        for (int bj = 0; bj < 2; ++bj)
#pragma unroll
            for (int n = 0; n < 2; ++n) bv[bj][n] = *(const PG8_GAS f32x4*)(bp + bj * HALF + 4 * n);
#pragma unroll
        for (int ai = 0; ai < 2; ++ai)
#pragma unroll
            for (int m = 0; m < 4; ++m) { bf16_t* rowp = O + (size_t)(row0 + ai * HALF + m * 16) * 1024 + col0;
#pragma unroll
                for (int bj = 0; bj < 2; ++bj) { const f32x4 v0 = acc[ai][bj][m][0] + bv[bj][0], v1 = acc[ai][bj][m][1] + bv[bj][1];
                    u32x4 w; w.x = cvt_pk_bf16(v0[0], v0[1]); w.y = cvt_pk_bf16(v0[2], v0[3]); w.z = cvt_pk_bf16(v1[0], v1[1]); w.w = cvt_pk_bf16(v1[2], v1[3]);
                    *(PG8_GAS u32x4*)(rowp + bj * HALF) = w; } }
    }
};
struct EpiDown64 {
    static constexpr bool PERM = true, AFTER_DRAIN = false, B64 = true;
    bf16_t* O; const float* bd;
    __device__ __forceinline__ void operator()(const f32x4 (&acc)[2][2][4][2], const Unit& u, int wr, int wc, int fr, int fq) const {
        const int e = u.pn >> 2, pnl = u.pn & 3;
        const int row0 = u.pm * BM + wr * 64 + fr, col0 = pnl * BM + wc * 64 + 8 * fq;
        const float* bp = bd + (size_t)e * 1024 + col0;
        f32x4 bv[2][2];
#pragma unroll
        for (int bj = 0; bj < 2; ++bj)
#pragma unroll
            for (int n = 0; n < 2; ++n) bv[bj][n] = *(const PG8_GAS f32x4*)(bp + bj * 32 + 4 * n);
#pragma unroll
        for (int ai = 0; ai < 2; ++ai)
#pragma unroll
            for (int m = 0; m < 4; ++m) { bf16_t* rowp = O + (size_t)(row0 + ai * HALF + m * 16) * 1024 + col0;
#pragma unroll
                for (int bj = 0; bj < 2; ++bj) { const f32x4 v0 = acc[ai][bj][m][0] + bv[bj][0], v1 = acc[ai][bj][m][1] + bv[bj][1];
                    u32x4 w; w.x = cvt_pk_bf16(v0[0], v0[1]); w.y = cvt_pk_bf16(v0[2], v0[3]); w.z = cvt_pk_bf16(v1[0], v1[1]); w.w = cvt_pk_bf16(v1[2], v1[3]);
                    *(PG8_GAS u32x4*)(rowp + bj * 32) = w; } }
    }
};
struct EpiBf16Plain64 {
    static constexpr bool PERM = true, AFTER_DRAIN = false, B64 = true;
    bf16_t* O; int ldc;
    __device__ __forceinline__ void operator()(const f32x4 (&acc)[2][2][4][2], const Unit& u, int wr, int wc, int fr, int fq) const {
        const int row0 = u.pm * BM + wr * 64 + fr, col0 = u.pn * BM + wc * 64 + 8 * fq;
#pragma unroll
        for (int ai = 0; ai < 2; ++ai)
#pragma unroll
            for (int m = 0; m < 4; ++m) { bf16_t* rowp = O + (size_t)(row0 + ai * HALF + m * 16) * ldc + col0;
#pragma unroll
                for (int bj = 0; bj < 2; ++bj) { const f32x4 v0 = acc[ai][bj][m][0], v1 = acc[ai][bj][m][1];
                    u32x4 w; w.x = cvt_pk_bf16(v0[0], v0[1]); w.y = cvt_pk_bf16(v0[2], v0[3]); w.z = cvt_pk_bf16(v1[0], v1[1]); w.w = cvt_pk_bf16(v1[2], v1[3]);
                    *(PG8_GAS u32x4*)(rowp + bj * 32) = w; } }
    }
};
template <int NPN, bool GATHER_ = false> struct MoeOrder {
    static constexpr bool GATHER = GATHER_;
    int ntiles, G, c; const PG8_LAS int* texp; const PG8_LAS int* rowtab = nullptr;
    __device__ __forceinline__ bool next(int i, Unit& u) const {
        constexpr int MT = 32 / NPN; int mt, pn;
        if (G == 256) { const int chunk = i * 8 + (c & 7), r = c >> 3; pn = r / MT; mt = chunk * MT + (r % MT); }
        else { const int L = i * G + c; mt = L / NPN; pn = L % NPN; }
        mt = __builtin_amdgcn_readfirstlane(mt); if (mt >= ntiles) return false;
        const int e = __builtin_amdgcn_readfirstlane(texp[mt]);
        u.pm = mt; u.pn = e * NPN + pn; return true;
    }
    __device__ __forceinline__ void a_ready(const Unit&) const {}
    __device__ __forceinline__ void done(const Unit&) const {}
};

template <class Epi, class Sched, bool ALIGN_EPI = false, bool SP2 = false>
__device__ __forceinline__ void gemm_phase(PG8_LAS unsigned char* lds, const Gemm g, const Sched& S, const Epi& E) {
    int tid_ = threadIdx.x; asm volatile("" : "+v"(tid_));
    const int tid = tid_, wid = __builtin_amdgcn_readfirstlane(tid >> 6), lane = tid & 63, wr = wid >> 2, wc = wid & 3, fr = lane & 15, fq = lane >> 4;
    const int K = g.K, nt = K / BK;
    constexpr bool GA = Sched::GATHER;
    static_assert(!GA || SP2, "gathered A rows: SP2 loop only");
    unsigned voffA[2], voffB[2]; int RA[2], CA2[2];
#pragma unroll
    for (int i = 0; i < 2; ++i) { int R, C; stage_rc(tid * 16 + i * 8192, R, C); RA[i] = R; CA2[i] = C * 2; const int Rb = Epi::B64 ? ((R >> 5) * 64 + perm32(R & 31)) : (Epi::PERM ? ((R & ~31) + perm32(R & 31)) : R);
        voffA[i] = (unsigned)(R * K + C) * 2u; voffB[i] = (unsigned)(Rb * K + C) * 2u; }
    const size_t kstep = (size_t)(BK * 2);
    const size_t hstep = (size_t)HALF * K * 2;
    const size_t tstep = 2 * hstep;
    const size_t hstepB = Epi::B64 ? (size_t)32 * K * 2 : hstep;
    const unsigned ldsw = (unsigned)wid * 1024u;
    const int aoff = lds_byte(wr * 64 + fr, fq * 8), boff = lds_byte(wc * 32 + fr, fq * 8);
#define PG8_SA(b, h) (((b) * 2 + (h)) * HTB)
#define PG8_SB(b, h) ((4 + (b) * 2 + (h)) * HTB)
#define PG8_STAGE(bufoff, gbase, voff) do { _Pragma("unroll") for (int _i = 0; _i < 2; ++_i) \
        __builtin_amdgcn_global_load_lds((const unsigned*)((const char*)(gbase) + (voff)[_i]), (PG8_LAS unsigned*)(lds + (bufoff) + ldsw + _i * 8192), 16, 0, 0); } while (0)
#define PG8_STAGE_A(bufoff, ptr, h, V) do { if constexpr (GA) PG8_STAGE(bufoff, ptr, V[h]); else PG8_STAGE(bufoff, (ptr) + (h) * hstep, voffA); } while (0)
#define PG8_ROWOFF(V, uidx) do { _Pragma("unroll") for (int h_ = 0; h_ < 2; ++h_) _Pragma("unroll") for (int i_ = 0; i_ < 2; ++i_) V[h_][i_] = (unsigned)S.rowtab[(uidx) * 256 + h_ * 128 + RA[i_]] * (unsigned)(K * 2) + (unsigned)CA2[i_]; } while (0)
#define PG8_LDA(dst, b, h) do { _Pragma("unroll") for (int m = 0; m < 4; ++m) _Pragma("unroll") for (int k = 0; k < 2; ++k) dst[m][k] = *(const PG8_LAS bf16x8*)(lds + PG8_SA(b, h) + aoff + m * 2048 + k * 1024); } while (0)
#define PG8_LDB(dst, b, h) do { _Pragma("unroll") for (int n = 0; n < 2; ++n) _Pragma("unroll") for (int k = 0; k < 2; ++k) dst[n][k] = *(const PG8_LAS bf16x8*)(lds + PG8_SB(b, h) + boff + n * 2048 + k * 1024); } while (0)
#define PG8_MMA(ai, bj, At, Bt) do { __builtin_amdgcn_s_setprio(1); _Pragma("unroll") for (int m = 0; m < 4; ++m) _Pragma("unroll") for (int n = 0; n < 2; ++n) _Pragma("unroll") for (int k = 0; k < 2; ++k) \
        acc[ai][bj][m][n] = __builtin_amdgcn_mfma_f32_16x16x32_bf16(Bt[n][k], At[m][k], acc[ai][bj][m][n], 0, 0, 0); __builtin_amdgcn_s_setprio(0); } while (0)
#define PG8_WAIT_V(n) asm volatile("s_waitcnt vmcnt(" #n ")" ::: "memory")
#define PG8_WAIT_L(n) asm volatile("s_waitcnt lgkmcnt(" #n ")" ::: "memory")
#define PG8_BAR __builtin_amdgcn_s_barrier()
#define PG8_SCHED __builtin_amdgcn_sched_barrier(0)
    Unit cur, nxt; int ui = 0;
    if (!S.next(0, cur)) return;
    f32x4 acc[2][2][4][2];
#pragma unroll
    for (int a = 0; a < 2; ++a)
#pragma unroll
        for (int b = 0; b < 2; ++b)
#pragma unroll
            for (int m = 0; m < 4; ++m)
#pragma unroll
                for (int n = 0; n < 2; ++n) acc[a][b][m][n] = (f32x4){0.f, 0.f, 0.f, 0.f};
    bf16x8 At[4][2], B0[2][2], B1[2][2];
    const char* cA = (const char*)g.A + (GA ? (size_t)0 : (size_t)cur.pm * tstep); const char* cB = (const char*)g.Bt + (size_t)cur.pn * tstep;
    unsigned vAc[2][2] = {{0u, 0u}, {0u, 0u}}, vAn[2][2] = {{0u, 0u}, {0u, 0u}};
    if constexpr (GA) { PG8_ROWOFF(vAc, 0); }
    S.a_ready(cur);
    if constexpr (SP2) {
        PG8_STAGE(PG8_SB(0, 0), cB, voffB); PG8_STAGE(PG8_SB(0, 1), cB + hstepB, voffB); PG8_STAGE_A(PG8_SA(0, 0), cA, 0, vAc); PG8_STAGE_A(PG8_SA(0, 1), cA, 1, vAc);
        if (wr == 1) PG8_BAR;
        PG8_WAIT_V(2); PG8_BAR;
        PG8_STAGE(PG8_SB(1, 0), cB + kstep, voffB); PG8_STAGE_A(PG8_SA(1, 0), cA + kstep, 0, vAc); PG8_STAGE(PG8_SB(1, 1), cB + hstepB + kstep, voffB);
        PG8_WAIT_V(6); PG8_BAR;
    } else {
        PG8_STAGE(PG8_SB(0, 0), cB, voffB); PG8_STAGE(PG8_SA(0, 0), cA, voffA); PG8_STAGE(PG8_SB(0, 1), cB + hstepB, voffB); PG8_STAGE(PG8_SA(0, 1), cA + hstep, voffA);
        if (wr == 1) PG8_BAR;
        PG8_WAIT_V(4); PG8_BAR;
        PG8_STAGE(PG8_SB(1, 0), cB + kstep, voffB); PG8_STAGE(PG8_SA(1, 0), cA + kstep, voffA); PG8_STAGE(PG8_SB(1, 1), cB + hstepB + kstep, voffB);
        PG8_WAIT_V(6); PG8_BAR;
    }
    for (;;) {
        const bool has_next = S.next(ui + 1, nxt);
        const char* nA = (has_next && !GA) ? (const char*)g.A + (size_t)nxt.pm * tstep : cA; const char* nB = has_next ? (const char*)g.Bt + (size_t)nxt.pn * tstep : cB;
        for (int t = 0; t < nt; t += 2) {
            const bool last = (t == nt - 2);
            const char* a1 = cA + (size_t)(t + 1) * kstep;
            const char* a2 = last ? nA : cA + (size_t)(t + 2) * kstep; const char* b2 = last ? nB : cB + (size_t)(t + 2) * kstep;
            const char* a3 = a2 + kstep; const char* b3 = b2 + kstep;
            if (last && has_next) S.a_ready(nxt);
            unsigned v2[2][2] = {{0u, 0u}, {0u, 0u}};
            if constexpr (GA) { if (last) { if (has_next) { PG8_ROWOFF(vAn, ui + 1); } else {
#pragma unroll
                        for (int h_ = 0; h_ < 2; ++h_) { vAn[h_][0] = vAc[h_][0]; vAn[h_][1] = vAc[h_][1]; } } }
#pragma unroll
                for (int h_ = 0; h_ < 2; ++h_) { v2[h_][0] = last ? vAn[h_][0] : vAc[h_][0]; v2[h_][1] = last ? vAn[h_][1] : vAc[h_][1]; } }
            if constexpr (SP2) {
            PG8_LDB(B0, 0, 0); PG8_LDB(B1, 0, 1); PG8_SCHED; PG8_LDA(At, 0, 0); PG8_STAGE_A(PG8_SA(1, 1), a1, 1, vAc);
            PG8_WAIT_V(8); PG8_WAIT_L(0); PG8_BAR; PG8_MMA(0, 0, At, B0); PG8_MMA(0, 1, At, B1); PG8_BAR; PG8_SCHED;
            PG8_LDA(At, 0, 1); PG8_STAGE(PG8_SB(0, 0), b2, voffB); PG8_STAGE(PG8_SB(0, 1), b2 + hstepB, voffB); PG8_STAGE_A(PG8_SA(0, 0), a2, 0, v2);
            PG8_WAIT_V(8); PG8_WAIT_L(0); PG8_BAR; PG8_MMA(1, 0, At, B0); PG8_MMA(1, 1, At, B1); PG8_BAR; PG8_SCHED;
            PG8_LDB(B0, 1, 0); PG8_LDB(B1, 1, 1); PG8_SCHED; PG8_LDA(At, 1, 0); PG8_STAGE_A(PG8_SA(0, 1), a2, 1, v2);
            PG8_WAIT_V(8); PG8_WAIT_L(0); PG8_BAR; PG8_MMA(0, 0, At, B0); PG8_MMA(0, 1, At, B1); PG8_BAR; PG8_SCHED;
            PG8_LDA(At, 1, 1); PG8_STAGE(PG8_SB(1, 0), b3, voffB); PG8_STAGE(PG8_SB(1, 1), b3 + hstepB, voffB); PG8_STAGE_A(PG8_SA(1, 0), a3, 0, v2);
            PG8_WAIT_V(8); PG8_WAIT_L(0); PG8_BAR; PG8_MMA(1, 0, At, B0); PG8_MMA(1, 1, At, B1); PG8_BAR; PG8_SCHED;
            } else {
            PG8_LDB(B0, 0, 0); PG8_SCHED; PG8_LDA(At, 0, 0); PG8_STAGE(PG8_SA(1, 1), a1 + hstep, voffA);
            PG8_WAIT_L(8); PG8_BAR; PG8_WAIT_L(0); PG8_MMA(0, 0, At, B0); PG8_BAR; PG8_SCHED;
            PG8_LDB(B1, 0, 1); PG8_STAGE(PG8_SB(0, 0), b2, voffB);
            PG8_BAR; PG8_WAIT_L(0); PG8_MMA(0, 1, At, B1); PG8_BAR;
            PG8_LDA(At, 0, 1); PG8_STAGE(PG8_SA(0, 0), a2, voffA);
            PG8_BAR; PG8_WAIT_L(0); PG8_MMA(1, 0, At, B0); PG8_BAR; PG8_SCHED;
            PG8_STAGE(PG8_SB(0, 1), b2 + hstepB, voffB);
            PG8_WAIT_V(6); PG8_BAR; PG8_MMA(1, 1, At, B1); PG8_BAR;
            PG8_LDB(B0, 1, 0); PG8_SCHED; PG8_LDA(At, 1, 0); PG8_STAGE(PG8_SA(0, 1), a2 + hstep, voffA);
            PG8_WAIT_L(8); PG8_BAR; PG8_WAIT_L(0); PG8_MMA(0, 0, At, B0); PG8_BAR; PG8_SCHED;
            PG8_LDB(B1, 1, 1); PG8_STAGE(PG8_SB(1, 0), b3, voffB);
            PG8_BAR; PG8_WAIT_L(0); PG8_MMA(0, 1, At, B1); PG8_BAR;
            PG8_LDA(At, 1, 1); PG8_STAGE(PG8_SA(1, 0), a3, voffA);
            PG8_BAR; PG8_WAIT_L(0); PG8_MMA(1, 0, At, B0); PG8_BAR; PG8_SCHED;
            PG8_STAGE(PG8_SB(1, 1), b3 + hstepB, voffB);
            PG8_WAIT_V(6); PG8_BAR; PG8_MMA(1, 1, At, B1); PG8_BAR;
            }
        }
        if constexpr (ALIGN_EPI) { if (wr == 0) PG8_BAR; }
        if constexpr (!Epi::AFTER_DRAIN) { E(acc, cur, wr, wc, fr, fq); S.done(cur); }
        if (!has_next) break;
#pragma unroll
        for (int a = 0; a < 2; ++a)
#pragma unroll
            for (int b = 0; b < 2; ++b)
#pragma unroll
                for (int m = 0; m < 4; ++m)
#pragma unroll
                    for (int n = 0; n < 2; ++n) acc[a][b][m][n] = (f32x4){0.f, 0.f, 0.f, 0.f};
        cur = nxt; cA = nA; cB = nB; ++ui;
        if constexpr (GA) {
#pragma unroll
            for (int h_ = 0; h_ < 2; ++h_) { vAc[h_][0] = vAn[h_][0]; vAc[h_][1] = vAn[h_][1]; } }
        if constexpr (ALIGN_EPI) { if (wr == 1) PG8_BAR; }
    }
    PG8_WAIT_V(0);
    if constexpr (!ALIGN_EPI) { if (wr == 0) PG8_BAR; }
    PG8_BAR;
    if constexpr (Epi::AFTER_DRAIN) { E.fused(acc, cur, wr, wc, fr, fq, lds, wid, lane); S.done(cur); }
#undef PG8_SA
#undef PG8_SB
#undef PG8_STAGE
#undef PG8_STAGE_A
#undef PG8_ROWOFF
#undef PG8_LDA
#undef PG8_LDB
#undef PG8_MMA
#undef PG8_WAIT_V
#undef PG8_WAIT_L
#undef PG8_BAR
#undef PG8_SCHED
}
}


#define GAS __attribute__((address_space(1)))
typedef unsigned short bf16;
typedef float f32x4 __attribute__((ext_vector_type(4)));
typedef unsigned u32x4 __attribute__((ext_vector_type(4)));
typedef unsigned u32x2 __attribute__((ext_vector_type(2)));
typedef short bf16x8 __attribute__((ext_vector_type(8)));
typedef float f32x16 __attribute__((ext_vector_type(16)));

#ifndef SINGLE_LAUNCH
#define SINGLE_LAUNCH 1
#endif

constexpr int NB = 8, SEQ = 2048, DM = 1024, NT = NB * SEQ, NLAYER = 2;
constexpr int DIN = 3220, NP = 3328;
constexpr int C_Q = 0, C_K = 512, C_V = 1024, C_Z = 1536, C_NQ = 2048, C_KV = 2304, C_CU = 2688, C_A = 3200, C_B = 3204, C_G = 3208;
constexpr int NE = 32, MAXT = 288;
constexpr int NWAVES = 8, NTHR = 512;
constexpr float EPS = 1e-6f;

constexpr size_t MiB = 1u << 20;
constexpr size_t WS_CTL = 0, CTL_ZERO_BYTES = 1 * MiB;
constexpr size_t WS_BT = 1 * MiB;
constexpr size_t WS_KCMP = 1 * MiB + 256 * 1024, WS_VCMP = 1 * MiB + 512 * 1024;
constexpr size_t WS_G = 2 * MiB, WS_BETA = 2 * MiB + 256 * 1024, WS_GC = 2 * MiB + 512 * 1024;
constexpr size_t WS_EIDX = 3 * MiB, WS_EPOS = 3 * MiB + 256 * 1024, WS_EW = 3 * MiB + 512 * 1024, WS_SLOT = 3 * MiB + 768 * 1024;
constexpr size_t WS_WIN = 4 * MiB;
constexpr size_t WS_WOUT = 17 * MiB;
constexpr size_t WS_WGU = 22 * MiB;
constexpr size_t WS_WD = 278 * MiB;
constexpr size_t WS_XA = 406 * MiB, WS_XB = 470 * MiB;
constexpr size_t WS_XN = 534 * MiB;
constexpr size_t WS_P = 566 * MiB;
constexpr size_t WS_QN = 670 * MiB, WS_KN = 686 * MiB, WS_VC = 702 * MiB;
constexpr size_t WS_U = 718 * MiB, WS_W = 750 * MiB;
constexpr size_t WS_ATT = 782 * MiB;
constexpr size_t WS_O = 798 * MiB;
constexpr size_t WS_NQ = 830 * MiB;
constexpr size_t WS_KS = 846 * MiB, WS_KW = 848 * MiB;
constexpr size_t WS_Y = 850 * MiB;
constexpr size_t WS_XS = 882 * MiB, WS_ACT = 1026 * MiB, WS_YS = 1170 * MiB;
constexpr size_t WS_KT = 1314 * MiB, WS_VT = 1330 * MiB;
constexpr size_t WS_W1T = 1346 * MiB;
constexpr size_t WS_POSW = 1349 * MiB;
constexpr size_t WS_RWH = 1350 * MiB, WS_RWL = 1351 * MiB;
constexpr size_t WS_END = 1352 * MiB;

constexpr int CW_TMO = 0, CW_BAR = 4096, CW_CNT = 16384;

constexpr int RING_BYTES = 131072;
constexpr int LDSCTL_OFF = RING_BYTES, MISC_OFF = LDSCTL_OFF, TS_OFF = LDSCTL_OFF + 128, TE_OFF = LDSCTL_OFF + 320;
constexpr int LDS_BYTES = 147456;
static_assert(TE_OFF + MAXT * 4 + 64 <= LDSCTL_OFF + 2048 && LDSCTL_OFF + 2048 + 10 * 1024 <= LDS_BYTES, "LDS map");

#define XB_TMO      128
#define XB_XCNT(j)  (256  + 64 * (j))
#define XB_XSUB(j)  (1280 + 64 * (j))
#define XB_XGEN(j)  (2304 + 64 * (j))
#define XB_TOP      3328
#define XB_TOPGEN   3392
#define XCD_BAR_WORDS 3456
#define XB_SPIN_CAP (1u << 22)
#define LAS __attribute__((address_space(3)))

__device__ __forceinline__ unsigned xb_ld(unsigned* p)              { return __hip_atomic_load(p, __ATOMIC_RELAXED, __HIP_MEMORY_SCOPE_AGENT); }
__device__ __forceinline__ unsigned xb_add(unsigned* p, unsigned v) { return __hip_atomic_fetch_add(p, v, __ATOMIC_RELAXED, __HIP_MEMORY_SCOPE_AGENT); }
__device__ __forceinline__ unsigned xb_xcc_id() { return (unsigned)__builtin_amdgcn_s_getreg((3 << 11) | 20) & 0xFu; }
#define XB_SPIN(cond, bar) do { unsigned _sp = 0; while (cond) { __builtin_amdgcn_s_sleep(1); \
    if ((++_sp & 255u) == 0u) { if (xb_ld(&(bar)[XB_TMO])) break; if (_sp > XB_SPIN_CAP) { atomicAdd(&(bar)[XB_TMO], 1u); break; } } } } while (0)

struct XcdBarrier {
    unsigned* bar; unsigned x;
    volatile LAS unsigned* st;
};

__device__ __forceinline__ XcdBarrier xcd_barrier_post(unsigned* bar, volatile LAS unsigned* st) {
    XcdBarrier b; b.bar = bar; b.x = xb_xcc_id(); b.st = st;
    if (threadIdx.x == 0) (void)xb_add(&bar[XB_XCNT(b.x)], 1u);
    return b;
}
__device__ __forceinline__ void xcd_barrier_complete(unsigned* bar, unsigned x, unsigned& nloc, unsigned& nx) {
    const unsigned G = gridDim.x * gridDim.y * gridDim.z;
    unsigned sum, cnt, mine, sp = 0u;
    for (;;) {
        sum = 0u; cnt = 0u; mine = 0u;
#pragma unroll
        for (unsigned j = 0; j < 16; ++j) { const unsigned c = xb_ld(&bar[XB_XCNT(j)]); sum += c; cnt += (c > 0u) ? 1u : 0u; mine = (j == x) ? c : mine; }
        if (sum == G) break;
        __builtin_amdgcn_s_sleep(1);
        if ((++sp & 255u) == 0u) { if (xb_ld(&bar[XB_TMO])) break; if (sp > XB_SPIN_CAP) { atomicAdd(&bar[XB_TMO], 1u); break; } }
    }
    nloc = mine > 0u ? mine : 1u; nx = cnt > 0u ? cnt : 1u;
}

__device__ __forceinline__ void xcd_barrier(const XcdBarrier& b) {
    asm volatile("s_waitcnt vmcnt(0)" ::: "memory");
    __syncthreads();
    if (threadIdx.x == 0) {
        unsigned* bar = b.bar;
        __builtin_amdgcn_s_waitcnt(0);
        unsigned nloc = b.st[0], nx = b.st[1];
        if (nloc == 0u) { xcd_barrier_complete(bar, b.x, nloc, nx); b.st[0] = nloc; b.st[1] = nx; }
        const unsigned old = xb_add(&bar[XB_XSUB(b.x)], 1u);
        const unsigned gen = old / nloc;
        if (old + 1u == (gen + 1u) * nloc) {
            __builtin_amdgcn_fence(__ATOMIC_RELEASE, "agent");
            asm volatile("s_waitcnt vmcnt(0)" ::: "memory");
            const unsigned og = xb_add(&bar[XB_TOP], 1u);
            const unsigned tg = og / nx;
            if (og + 1u == (tg + 1u) * nx) xb_add(&bar[XB_TOPGEN], 1u);
            else XB_SPIN(xb_ld(&bar[XB_TOPGEN]) == tg, bar);
            __builtin_amdgcn_fence(__ATOMIC_ACQUIRE, "agent");
            xb_add(&bar[XB_XGEN(b.x)], 1u);
            asm volatile("s_waitcnt vmcnt(0)" ::: "memory");
        } else {
            XB_SPIN(xb_ld(&bar[XB_XGEN(b.x)]) == gen, bar);
            __builtin_amdgcn_fence(__ATOMIC_ACQUIRE, "agent");
            asm volatile("s_waitcnt vmcnt(0)" ::: "memory");
        }
    }
    __syncthreads();
}


__device__ __forceinline__ void cnt_barrier(unsigned* cw, unsigned& k) {
    asm volatile("s_waitcnt vmcnt(0)" ::: "memory");
    __syncthreads();
    if (threadIdx.x == 0) {
        __builtin_amdgcn_fence(__ATOMIC_RELEASE, "agent");
        asm volatile("s_waitcnt vmcnt(0)" ::: "memory");
        const unsigned G = gridDim.x;
        const unsigned old = xb_add(cw, 1u);
        if (old == G * (k + 1u) - 1u) xb_add(cw + 64, 1u);
        else { unsigned sp = 0; while (xb_ld(cw + 64) == k) { __builtin_amdgcn_s_sleep(1);
                if ((++sp & 255u) == 0u) { if (xb_ld(cw + 128)) break; if (sp > XB_SPIN_CAP) { atomicAdd(cw + 128, 1u); break; } } } }
        __builtin_amdgcn_fence(__ATOMIC_ACQUIRE, "agent");
        asm volatile("s_waitcnt vmcnt(0)" ::: "memory");
    }
    ++k;
    __syncthreads();
}
__device__ __forceinline__ float bf_lo(unsigned w) { return __uint_as_float(w << 16); }
__device__ __forceinline__ float bf_hi(unsigned w) { return __uint_as_float(w & 0xffff0000u); }
__device__ __forceinline__ float bf2f(bf16 v) { return __uint_as_float(((unsigned)v) << 16); }
__device__ __forceinline__ unsigned f2bf(float f) { unsigned u = __float_as_uint(f); return (u + 0x7fffu + ((u >> 16) & 1u)) >> 16; }
__device__ __forceinline__ unsigned pk2(float lo, float hi) { return f2bf(lo) | (f2bf(hi) << 16); }
__device__ __forceinline__ float wave_sum(float v) {
#pragma unroll
    for (int o = 1; o < 64; o <<= 1) v += __shfl_xor(v, o);
    return v;
}
__device__ __forceinline__ float wave_max(float v) {
#pragma unroll
    for (int o = 1; o < 64; o <<= 1) v = fmaxf(v, __shfl_xor(v, o));
    return v;
}
__device__ __forceinline__ float sigmoidf_(float x) { return 1.0f / (1.0f + __expf(-x)); }
__device__ __forceinline__ float siluf_(float x) { return x / (1.0f + __expf(-x)); }
#define LDS_WAIT() asm volatile("s_waitcnt lgkmcnt(0)" ::: "memory")

struct Args { const float* in[25]; float* out; unsigned char* ws; int ph_lo, ph_hi; };
struct ArgsG { const GAS float* in[25]; GAS float* out; GAS unsigned char* ws;
    __device__ __forceinline__ const float* I(int i) const { return (const float*)in[i]; }
    __device__ __forceinline__ unsigned char* W() const { return (unsigned char*)ws; }
    __device__ __forceinline__ float* O() const { return (float*)out; } };

__device__ __forceinline__ int map_win(int n);
__device__ __forceinline__ int map_gu(int n);
template <int MAP>
__device__ __forceinline__ void transpose_item(const float* W, int K, int N, bf16* WT, LAS float* scr, int item, int nblk, int lane) {
    const int kb = item / nblk, nb = item % nblk, k0 = 64 * kb, n0 = 32 * nb;
    const int nd = n0 + (lane & 31); const int src = MAP == 1 ? map_win(nd) : (MAP == 2 ? map_gu(nd) : nd);
#pragma unroll 8
    for (int i = 0; i < 32; ++i) { const int kk = 2 * i + (lane >> 5); scr[kk * 33 + (lane & 31)] = src >= 0 ? W[(size_t)(k0 + kk) * N + src] : 0.0f; }
    LDS_WAIT();
    const int c = lane & 7;
#pragma unroll
    for (int j = 0; j < 4; ++j) { const int n = (lane >> 3) + 8 * j; const LAS float* s = scr + (8 * c) * 33 + n;
        u32x4 o; o.x = pk2(s[0 * 33], s[1 * 33]); o.y = pk2(s[2 * 33], s[3 * 33]); o.z = pk2(s[4 * 33], s[5 * 33]); o.w = pk2(s[6 * 33], s[7 * 33]);
        *(u32x4*)(WT + (size_t)(n0 + n) * K + k0 + 8 * c) = o; }
    LDS_WAIT();
}
__device__ __forceinline__ int map_win(int n) {
    if (n < 2048) return n;
    if (n < C_KV) return 2056 + (n - C_NQ);
    if (n < C_CU) return 2312 + (n - C_KV);
    if (n < C_A) return 2708 + (n - C_CU);
    if (n < C_B) return 2048 + (n - C_A);
    if (n < C_G) return 2052 + (n - C_B);
    if (n < C_G + 12) return 2696 + (n - C_G);
    return -1;
}
__device__ __forceinline__ int map_gu(int n) { const int pn = n >> 8, r = n & 255; return (r < 128 ? 0 : 1024) + 128 * pn + (r & 127); }

__device__ __forceinline__ void ph_prologue(const ArgsG& a, LAS unsigned char* lds, int gw, int NGW, int wave, int lane) {
    LAS float* scr = (LAS float*)(lds + wave * 16384);
    bf16* WinT = (bf16*)(a.W() + WS_WIN); bf16* WoutT = (bf16*)(a.W() + WS_WOUT); bf16* WguT = (bf16*)(a.W() + WS_WGU); bf16* WdT = (bf16*)(a.W() + WS_WD);
    constexpr int I_IN = 16 * (NP / 32), I_OUT = 16 * 32, I_GU = 16 * 64, I_D = 16 * 32;
    constexpr int N_IN = NLAYER * I_IN, N_OUT = NLAYER * I_OUT, N_GU = NLAYER * NE * I_GU, N_D = NLAYER * NE * I_D;
    for (int it = gw; it < N_IN + N_OUT + N_GU + N_D; it += NGW) {
        int r = it;
        if (r < N_IN) { const int l = r / I_IN; transpose_item<1>(a.I(2) + (size_t)l * DM * DIN, DM, DIN, WinT + (size_t)l * NP * DM, scr, r % I_IN, NP / 32, lane); continue; } r -= N_IN;
        if (r < N_OUT) { const int l = r / I_OUT; transpose_item<0>(a.I(16) + (size_t)l * DM * DM, DM, DM, WoutT + (size_t)l * DM * DM, scr, r % I_OUT, 32, lane); continue; } r -= N_OUT;
        if (r < N_GU) { const int le = r / I_GU; transpose_item<2>(a.I(20) + (size_t)le * DM * 2048, DM, 2048, WguT + (size_t)le * 2048 * DM, scr, r % I_GU, 64, lane); continue; } r -= N_GU;
        { const int le = r / I_D; transpose_item<0>(a.I(22) + (size_t)le * DM * DM, DM, DM, WdT + (size_t)le * DM * DM, scr, r % I_D, 32, lane); }
    }
    { bf16* W1T = (bf16*)(a.W() + WS_W1T);
        for (int it = gw; it < 4 * 128; it += NGW) { const int mtx = it >> 7; transpose_item<0>(a.I(10) + (size_t)mtx * 2048 * 128, 2048, 128, W1T + (size_t)mtx * 128 * 2048, scr, it & 127, 4, lane); }
        float* POSW = (float*)(a.W() + WS_POSW);
        const int id = gw * 64 + lane;
        if (id < 512) { const int mtx = id >> 7, n = id & 127; const float* w1 = a.I(10) + (size_t)mtx * 2048 * 128; const float* pos = a.I(9) + (size_t)mtx * 2048; float acc = 0.f;
            for (int k = 0; k < 2048; ++k) acc += pos[k] * w1[(size_t)k * 128 + n];
            POSW[id] = acc; } }
    { bf16* RWH = (bf16*)(a.W() + WS_RWH); bf16* RWL = (bf16*)(a.W() + WS_RWL);
        for (int i = gw * 64 + lane; i < NLAYER * NE * DM; i += NGW * 64) { const int d = i & (DM - 1), e = (i >> 10) & (NE - 1), l = i >> 15;
            const float w = a.I(18)[((size_t)l * DM + d) * NE + e]; const unsigned hi = f2bf(w); const float lo = w - __uint_as_float(hi << 16);
            RWH[i] = (bf16)hi; RWL[i] = (bf16)f2bf(lo); } }
    float* BT = (float*)(a.W() + WS_BT);
    for (int i = gw * 64 + lane; i < 4 * 2048; i += NGW * 64) {
        const int h = i >> 11, n = i & 2047; int bk;
        if (n < 16) bk = n; else { const float v = logf((float)n / 16.0f) / 2.0794415416798357f * 16.0f; bk = 16 + (int)v; bk = bk < 31 ? bk : 31; }
        BT[i] = a.I(24)[bk * 4 + h];
    }
}

__device__ __forceinline__ void rms_row_to_bf16(const f32x4 (&v)[4], const float* w, bf16* orow, int lane) {
    float s = 0.f;
#pragma unroll
    for (int j = 0; j < 4; ++j) s += (v[j].x * v[j].x + v[j].y * v[j].y) + (v[j].z * v[j].z + v[j].w * v[j].w);
    const float r = rsqrtf(wave_sum(s) * (1.0f / DM) + EPS);
#pragma unroll
    for (int j = 0; j < 4; ++j) { const f32x4 wv = *(const f32x4*)(w + 4 * (64 * j + lane)); const f32x4 y = v[j] * r * wv;
        u32x2 o; o.x = pk2(y.x, y.y); o.y = pk2(y.z, y.w); *(u32x2*)(orow + 4 * (64 * j + lane)) = o; }
}

__device__ __forceinline__ void ph_norm0(const ArgsG& a, int gw, int NGW, int lane) {
    bf16* XN = (bf16*)(a.W() + WS_XN);
    for (int tok = gw; tok < NT; tok += NGW) {
        f32x4 v[4];
#pragma unroll
        for (int j = 0; j < 4; ++j) v[j] = *(const f32x4*)(a.I(0) + (size_t)tok * DM + 4 * (64 * j + lane));
        rms_row_to_bf16(v, a.I(1), XN + (size_t)tok * DM, lane);
    }
}

__device__ __forceinline__ void ph_compress_mfma(const ArgsG& a, int l, LAS unsigned char* lds, int bid, int G, int tid, int wave, int lane) {
    LAS float* hid = (LAS float*)lds;
    const bf16* P = (const bf16*)(a.W() + WS_P); bf16* KCMP = (bf16*)(a.W() + WS_KCMP); bf16* VCMP = (bf16*)(a.W() + WS_VCMP);
    const int r = lane & 15, q = lane >> 4;
    for (int u = bid; u < 128; u += G) {
        const int b = u >> 4, kv = (u >> 3) & 1, j0 = 16 * (u & 7);
        const bf16* arow = P + (size_t)(b * SEQ) * NP + C_KV + kv * 64;
        const bf16* brow = (const bf16*)(a.W() + WS_W1T) + ((size_t)(l * 2 + kv) * 128 + 16 * wave + r) * 2048 + 8 * q;
        const float pw = ((const float*)(a.W() + WS_POSW))[(l * 2 + kv) * 128 + 16 * wave + r];
        f32x4 acc = {0.f, 0.f, 0.f, 0.f};
#pragma unroll 8
        for (int ks = 0; ks < 64; ++ks) { int tk = 16 * (j0 + r) + (ks >> 1); tk = tk < SEQ ? tk : SEQ - 1;
            const bf16x8 af = *(const bf16x8*)(arow + (size_t)tk * NP + (ks & 1) * 32 + 8 * q); const bf16x8 bfr = *(const bf16x8*)(brow + 32 * ks);
            acc = __builtin_amdgcn_mfma_f32_16x16x32_bf16(af, bfr, acc, 0, 0, 0); }
#pragma unroll
        for (int i = 0; i < 4; ++i) hid[(4 * q + i) * 132 + 16 * wave + r] = siluf_(acc[i] + pw);
        __syncthreads();
        { const int row = tid >> 5, c2 = tid & 31; const float* w2 = a.I(11) + (size_t)(l * 2 + kv) * 128 * 64; float o0 = 0.f, o1 = 0.f;
            for (int nn = 0; nn < 128; ++nn) { const float hv = hid[row * 132 + nn]; o0 += hv * w2[nn * 64 + 2 * c2]; o1 += hv * w2[nn * 64 + 2 * c2 + 1]; }
            if (kv == 0) { float ss = o0 * o0 + o1 * o1;
#pragma unroll
                for (int o_ = 1; o_ < 32; o_ <<= 1) ss += __shfl_xor(ss, o_);
                const float sc = rsqrtf(ss * (1.0f / 64.0f) + EPS); o0 *= sc * a.I(8)[l * 192 + 2 * c2]; o1 *= sc * a.I(8)[l * 192 + 2 * c2 + 1]; }
            const int j = j0 + row;
            *(unsigned*)((kv ? VCMP : KCMP) + (size_t)(b * 128 + j) * 64 + 2 * c2) = (j < 127) ? pk2(o0, o1) : 0u; }
        __syncthreads();
    }
}

__device__ __forceinline__ void ph_m1(const ArgsG& a, int l, LAS unsigned char* lds, int bid, int G, int tid, int wave, int lane) {
    const bf16* P = (const bf16*)(a.W() + WS_P);
    bf16* QN = (bf16*)(a.W() + WS_QN); bf16* KN = (bf16*)(a.W() + WS_KN); bf16* VC = (bf16*)(a.W() + WS_VC);
    bf16* KT = (bf16*)(a.W() + WS_KT); bf16* VT = (bf16*)(a.W() + WS_VT);
    float* Gb = (float*)(a.W() + WS_G); float* BETA = (float*)(a.W() + WS_BETA);
    bf16* NQ = (bf16*)(a.W() + WS_NQ); bf16* KS = (bf16*)(a.W() + WS_KS); bf16* KW = (bf16*)(a.W() + WS_KW); bf16* Y = (bf16*)(a.W() + WS_Y);
    const float* convw = a.I(3) + (size_t)l * 4 * 1536; const float* a_log = a.I(4) + l * 4; const float* dt_bias = a.I(5) + l * 4;
    const float* qnw = a.I(7) + l * 64; const float* knw = a.I(8) + l * 192;
    const float* dww = a.I(12) + (size_t)l * 31 * 256; const float* dwb = a.I(13) + l * 256; const float* lnw = a.I(14) + l * 256; const float* lnb = a.I(15) + l * 256;
    LAS float* dwl = (LAS float*)(lds + 65536);
    for (int i = tid; i < 31 * 256; i += NTHR) dwl[i] = dww[i];
    __syncthreads();
    for (int u = bid; u < NT / 64; u += G) {
        const int b = u >> 5, nchunk = u & 31, tw = nchunk * 64 + 8 * wave;
        const bf16* pw0 = P + (size_t)(b * SEQ + tw) * NP;
        { unsigned cx[11], nx[11]; float cw0[4], cw1[4], nw0[4], nw1[4];
#define DN_LOAD(idx, X, W0, W1) do { const int cb_ = ((idx) >> 2) * 512 + ((idx) & 3) * 128 + 2 * lane; \
            _Pragma("unroll") for (int j = 0; j < 4; ++j) { W0[j] = convw[j * 1536 + cb_]; W1[j] = convw[j * 1536 + cb_ + 1]; } \
            _Pragma("unroll") for (int j = 0; j < 3; ++j) { X[j] = 0u; if (tw - 3 + j >= 0) X[j] = *(const unsigned*)(pw0 + (ptrdiff_t)(j - 3) * NP + cb_); } \
            _Pragma("unroll") for (int i = 0; i < 8; ++i) X[3 + i] = *(const unsigned*)(pw0 + (size_t)i * NP + cb_); } while (0)
            DN_LOAD(0, cx, cw0, cw1);
#pragma unroll 1
            for (int idx = 0; idx < 12; ++idx) { const int ten = idx >> 2, h = idx & 3;
                if (idx + 1 < 12) DN_LOAD(idx + 1, nx, nw0, nw1);
                float xa[3] = {bf_lo(cx[0]), bf_lo(cx[1]), bf_lo(cx[2])}, xb[3] = {bf_hi(cx[0]), bf_hi(cx[1]), bf_hi(cx[2])};
                float ya[8], yb[8], sq[8];
#pragma unroll
                for (int i = 0; i < 8; ++i) { const unsigned w = cx[3 + i]; const float ca = bf_lo(w), cbv = bf_hi(w);
                    ya[i] = siluf_(cw0[0] * xa[0] + cw0[1] * xa[1] + cw0[2] * xa[2] + cw0[3] * ca); yb[i] = siluf_(cw1[0] * xb[0] + cw1[1] * xb[1] + cw1[2] * xb[2] + cw1[3] * cbv);
                    xa[0] = xa[1]; xa[1] = xa[2]; xa[2] = ca; xb[0] = xb[1]; xb[1] = xb[2]; xb[2] = cbv; sq[i] = ya[i] * ya[i] + yb[i] * yb[i]; }
                if (ten < 2) {
#pragma unroll
                    for (int o_ = 1; o_ < 64; o_ <<= 1) {
#pragma unroll
                        for (int i = 0; i < 8; ++i) sq[i] += __shfl_xor(sq[i], o_); }
                    const float qs_ = ten == 0 ? 0.08838834764831845f : 1.0f;
#pragma unroll
                    for (int i = 0; i < 8; ++i) { const float sc = rsqrtf(sq[i] + EPS) * qs_; ya[i] *= sc; yb[i] *= sc; } }
                unsigned pk[8];
#pragma unroll
                for (int i = 0; i < 8; ++i) pk[i] = pk2(ya[i], yb[i]);
                if (ten < 2) { bf16* dst = ten == 0 ? QN : KN;
#pragma unroll
                    for (int i = 0; i < 8; ++i) *(unsigned*)(dst + (size_t)(b * SEQ + tw + i) * 512 + h * 128 + 2 * lane) = pk[i]; }
                if (ten >= 1) {
                    bf16* tb = (ten == 1 ? KT : VT) + ((size_t)((b * 4 + h) * 32 + nchunk) * 128 + 2 * lane) * 64 + 8 * wave;
                    u32x4 lo, hi;
                    lo.x = (pk[0] & 0xffffu) | (pk[1] << 16); lo.y = (pk[2] & 0xffffu) | (pk[3] << 16); lo.z = (pk[4] & 0xffffu) | (pk[5] << 16); lo.w = (pk[6] & 0xffffu) | (pk[7] << 16);
                    hi.x = (pk[0] >> 16) | (pk[1] & 0xffff0000u); hi.y = (pk[2] >> 16) | (pk[3] & 0xffff0000u); hi.z = (pk[4] >> 16) | (pk[5] & 0xffff0000u); hi.w = (pk[6] >> 16) | (pk[7] & 0xffff0000u);
                    *(u32x4*)tb = lo; *(u32x4*)(tb + 64) = hi; }
#pragma unroll
                for (int j = 0; j < 11; ++j) cx[j] = nx[j];
#pragma unroll
                for (int j = 0; j < 4; ++j) { cw0[j] = nw0[j]; cw1[j] = nw1[j]; } }
#undef DN_LOAD
        }
        if (lane < 32) { const int i = lane >> 2, hd = lane & 3; const size_t tok = (size_t)(b * SEQ + tw + i); const bf16* prow = P + tok * NP;
            const float av = bf2f(prow[C_A + hd]), bv = bf2f(prow[C_B + hd]);
            BETA[tok * 4 + hd] = sigmoidf_(bv);
            const float x = av + dt_bias[hd]; const float sp = x > 20.0f ? x : log1pf(expf(x));
            Gb[tok * 4 + hd] = -expf(a_log[hd]) * sp; }
        { const float qw = qnw[lane] * (0.125f * 1.4426950408889634f), ksw = knw[64 + lane], kww = knw[128 + lane];
#pragma unroll 4
          for (int i = 0; i < 8; ++i) { const size_t tok = (size_t)(b * SEQ + tw + i); const bf16* prow = P + tok * NP;
            float xv[6];
#pragma unroll
            for (int h = 0; h < 4; ++h) xv[h] = bf2f(prow[C_NQ + h * 64 + lane]);
            xv[4] = bf2f(prow[C_KV + 128 + lane]); xv[5] = bf2f(prow[C_KV + 256 + lane]);
            float ss[6];
#pragma unroll
            for (int h = 0; h < 6; ++h) ss[h] = xv[h] * xv[h];
#pragma unroll
            for (int o_ = 1; o_ < 64; o_ <<= 1) {
#pragma unroll
                for (int h = 0; h < 6; ++h) ss[h] += __shfl_xor(ss[h], o_); }
#pragma unroll
            for (int h = 0; h < 4; ++h) NQ[tok * 256 + h * 64 + lane] = (bf16)f2bf(xv[h] * rsqrtf(ss[h] * (1.0f / 64.0f) + EPS) * qw);
            KS[tok * 64 + lane] = (bf16)f2bf(xv[4] * rsqrtf(ss[4] * (1.0f / 64.0f) + EPS) * ksw);
            KW[tok * 64 + lane] = (bf16)f2bf(xv[5] * rsqrtf(ss[5] * (1.0f / 64.0f) + EPS) * kww); } }
        { const int c = 4 * lane; f32x4 acc[8]; const f32x4 bias = *(const f32x4*)(dwb + c);
#pragma unroll
            for (int i = 0; i < 8; ++i) acc[i] = bias;
#pragma unroll 1
            for (int g8 = 0; g8 < 5; ++g8) { u32x2 av[8], gv[8];
#pragma unroll
                for (int rr = 0; rr < 8; ++rr) { const int r = 8 * g8 + rr; av[rr] = (u32x2){0u, 0u}; gv[rr] = (u32x2){0u, 0u};
                    if (r < 38 && tw - 30 + r >= 0) { const bf16* pr = pw0 + (ptrdiff_t)(r - 30) * NP + C_CU + c; av[rr] = *(const u32x2*)pr; gv[rr] = *(const u32x2*)(pr + 256); } }
#pragma unroll
                for (int rr = 0; rr < 8; ++rr) { const int r = 8 * g8 + rr;
                    f32x4 gl; gl.x = bf_lo(av[rr].x) * sigmoidf_(bf_lo(gv[rr].x)); gl.y = bf_hi(av[rr].x) * sigmoidf_(bf_hi(gv[rr].x)); gl.z = bf_lo(av[rr].y) * sigmoidf_(bf_lo(gv[rr].y)); gl.w = bf_hi(av[rr].y) * sigmoidf_(bf_hi(gv[rr].y));
#pragma unroll
                    for (int i = 0; i < 8; ++i) { const int j = r - i; if (j >= 0 && j <= 30) { const f32x4 w = *(const LAS f32x4*)(dwl + j * 256 + c); acc[i] += w * gl; } } } }
            const f32x4 lw = *(const f32x4*)(lnw + c), lb = *(const f32x4*)(lnb + c);
#pragma unroll
            for (int i = 0; i < 8; ++i) { const f32x4 x = acc[i]; const float mean = wave_sum((x.x + x.y) + (x.z + x.w)) * (1.0f / 256.0f);
                const f32x4 d = x - mean; const float var = wave_sum((d.x * d.x + d.y * d.y) + (d.z * d.z + d.w * d.w)) * (1.0f / 256.0f);
                const float rr = rsqrtf(var + EPS); const f32x4 y = d * rr * lw + lb;
                u32x2 o; o.x = pk2(siluf_(y.x), siluf_(y.y)); o.y = pk2(siluf_(y.z), siluf_(y.w));
                *(u32x2*)(Y + (size_t)(b * SEQ + tw + i) * DM + 768 + c) = o; } }
    }
}

constexpr int LM_PITCH = 68;
__device__ __forceinline__ void ph_dn_chunk_mfma(const ArgsG& a, LAS unsigned char* lds, int bid, int G, int tid, int wave, int lane) {
    LAS float* Lm = (LAS float*)lds;
    LAS float* gcl = (LAS float*)(lds + 4 * 64 * LM_PITCH * 4);
    LAS float* betal = gcl + 256; LAS float* bkl = betal + 256;
    const bf16* QN = (const bf16*)(a.W() + WS_QN); const bf16* KN = (const bf16*)(a.W() + WS_KN);
    const bf16* KT = (const bf16*)(a.W() + WS_KT); const bf16* VT = (const bf16*)(a.W() + WS_VT);
    const float* Gb = (const float*)(a.W() + WS_G); const float* BETA = (const float*)(a.W() + WS_BETA); float* GC = (float*)(a.W() + WS_GC);
    float* U = (float*)(a.W() + WS_U); bf16* W = (bf16*)(a.W() + WS_W); bf16* ATT = (bf16*)(a.W() + WS_ATT);
    const int n = lane & 31, hh = lane >> 5;
    for (int cb = bid * 4; cb < 1024; cb += G * 4) {
        if (wave < 4) { const int ci = cb + wave, nn = ci & 31, h = (ci >> 5) & 3, b = ci >> 7, r0 = b * SEQ + nn * 64;
            float g = Gb[(size_t)(r0 + lane) * 4 + h];
#pragma unroll
            for (int off = 1; off < 64; off <<= 1) { const float v = __shfl_up(g, off); if (lane >= off) g += v; }
            const float be = BETA[(size_t)(r0 + lane) * 4 + h];
            gcl[wave * 64 + lane] = g; GC[(size_t)(r0 + lane) * 4 + h] = g; betal[wave * 64 + lane] = be; bkl[wave * 64 + lane] = be * __expf(g); }
        __syncthreads();
#pragma unroll 1
        for (int q = 0; q < 3; ++q) { const int id = 3 * wave + q, c = id / 6, wq = id % 6, isq = wq >= 3 ? 1 : 0, blk = wq % 3, ib = blk >= 1 ? 1 : 0, jb = blk == 2 ? 1 : 0;
            const int ci = cb + c, nn = ci & 31, h = (ci >> 5) & 3, b = ci >> 7, r0 = b * SEQ + nn * 64;
            const bf16* ap = (isq ? QN : KN) + (size_t)(r0 + 32 * ib + n) * 512 + h * 128 + 8 * hh;
            const bf16* bp = KN + (size_t)(r0 + 32 * jb + n) * 512 + h * 128 + 8 * hh;
            f32x16 acc;
#pragma unroll
            for (int r = 0; r < 16; ++r) acc[r] = 0.f;
#pragma unroll
            for (int ks = 0; ks < 8; ++ks) acc = __builtin_amdgcn_mfma_f32_32x32x16_bf16(*(const bf16x8*)(ap + 16 * ks), *(const bf16x8*)(bp + 16 * ks), acc, 0, 0, 0);
            const int j = 32 * jb + n; const float gj = gcl[c * 64 + j];
#pragma unroll
            for (int r = 0; r < 16; ++r) { const int i = 32 * ib + (r & 3) + 8 * (r >> 2) + 4 * hh; const float dec = __expf(fminf(gcl[c * 64 + i] - gj, 0.f));
                if (isq) ATT[(size_t)ci * 4096 + i * 64 + j] = (bf16)((j <= i) ? f2bf(acc[r] * dec) : 0u);
                else Lm[c * 64 * LM_PITCH + i * LM_PITCH + j] = (j < i) ? betal[c * 64 + i] * acc[r] * dec : 0.f; } }
        __syncthreads();
        if (wave < 4) { LAS float* L = Lm + wave * 64 * LM_PITCH;
            for (int i = 0; i < 64; ++i) { float a0 = (i == lane) ? 1.f : 0.f, a1 = 0.f, a2 = 0.f, a3 = 0.f; int j = 0;
                for (; j + 3 < i; j += 4) { a0 -= L[i * LM_PITCH + j] * L[j * LM_PITCH + lane]; a1 -= L[i * LM_PITCH + j + 1] * L[(j + 1) * LM_PITCH + lane];
                    a2 -= L[i * LM_PITCH + j + 2] * L[(j + 2) * LM_PITCH + lane]; a3 -= L[i * LM_PITCH + j + 3] * L[(j + 3) * LM_PITCH + lane]; }
                for (; j < i; ++j) a0 -= L[i * LM_PITCH + j] * L[j * LM_PITCH + lane];
                L[i * LM_PITCH + lane] = (a0 + a1) + (a2 + a3); } }
        __syncthreads();
#pragma unroll 1
        for (int q = 0; q < 4; ++q) { const int id = wave * 4 + q, c = id >> 3, ten = (id >> 2) & 1, db = id & 3;
            const int ci = cb + c, nn = ci & 31, h = (ci >> 5) & 3, b = ci >> 7, r0 = b * SEQ + nn * 64;
            const bf16* arow = (ten ? KT : VT) + ((size_t)ci * 128 + 32 * db + n) * 64 + 8 * hh;
            const LAS float* scl = (ten ? bkl : betal) + c * 64;
            const LAS float* L = Lm + c * 64 * LM_PITCH;
#pragma unroll
            for (int ib = 0; ib < 2; ++ib) { f32x16 acc;
#pragma unroll
                for (int r = 0; r < 16; ++r) acc[r] = 0.f;
#pragma unroll
                for (int ks = 0; ks < 4; ++ks) { if (ib == 0 && ks >= 2) continue;
                    const LAS float* tp = L + (32 * ib + n) * LM_PITCH + 16 * ks + 8 * hh;
                    const f32x4 t0 = *(const LAS f32x4*)tp, t1 = *(const LAS f32x4*)(tp + 4), s0 = *(const LAS f32x4*)(scl + 16 * ks + 8 * hh), s1 = *(const LAS f32x4*)(scl + 16 * ks + 8 * hh + 4);
                    u32x4 bw; bw.x = pg8::cvt_pk_bf16(t0.x * s0.x, t0.y * s0.y); bw.y = pg8::cvt_pk_bf16(t0.z * s0.z, t0.w * s0.w); bw.z = pg8::cvt_pk_bf16(t1.x * s1.x, t1.y * s1.y); bw.w = pg8::cvt_pk_bf16(t1.z * s1.z, t1.w * s1.w);
                    acc = __builtin_amdgcn_mfma_f32_32x32x16_bf16(*(const bf16x8*)(arow + 16 * ks), __builtin_bit_cast(bf16x8, bw), acc, 0, 0, 0); }
                const size_t ob = (size_t)(r0 + 32 * ib + n) * 512 + h * 128 + 32 * db + 4 * hh;
#pragma unroll
                for (int rq = 0; rq < 4; ++rq) {
                    if (ten) { u32x2 w2; w2.x = pk2(acc[4 * rq], acc[4 * rq + 1]); w2.y = pk2(acc[4 * rq + 2], acc[4 * rq + 3]); *(u32x2*)(W + ob + 8 * rq) = w2; }
                    else *(f32x4*)(U + ob + 8 * rq) = (f32x4){acc[4 * rq], acc[4 * rq + 1], acc[4 * rq + 2], acc[4 * rq + 3]}; } } }
        __syncthreads();
    }
}

constexpr int SC_WP = 272, SC_AP = 144;
constexpr int SC_W = 0, SC_Q = 64 * SC_WP, SC_A = 2 * 64 * SC_WP, SC_K = SC_A + 64 * SC_AP, SC_GC = SC_K + 128 * SC_AP, SC_BUF = SC_GC + 1024;
static_assert(2 * SC_BUF <= RING_BYTES, "scan LDS");
struct ScanPf { u32x4 w[4], q[4], at[2], k[4]; float g, gl; };
__device__ __forceinline__ ScanPf scan_load(const bf16* W, const bf16* QN, const bf16* ATT, const bf16* KT, const float* GC, int r0, int h, int ci, int lt) {
    ScanPf p; const int row = lt >> 4, seg = lt & 15;
#pragma unroll
    for (int i = 0; i < 4; ++i) { const size_t go = (size_t)(r0 + row + 16 * i) * 512 + h * 128 + seg * 8; p.w[i] = *(const u32x4*)(W + go); p.q[i] = *(const u32x4*)(QN + go); }
#pragma unroll
    for (int i = 0; i < 2; ++i) p.at[i] = *(const u32x4*)(ATT + (size_t)ci * 4096 + (lt + 256 * i) * 8);
#pragma unroll
    for (int i = 0; i < 4; ++i) p.k[i] = *(const u32x4*)(KT + (size_t)ci * 8192 + (lt + 256 * i) * 8);
    p.g = GC[(size_t)(r0 + (lt & 63)) * 4 + h]; p.gl = GC[(size_t)(r0 + 63) * 4 + h]; return p;
}
__device__ __forceinline__ void scan_store(const ScanPf& p, LAS unsigned char* buf, int lt) {
    const int row = lt >> 4, seg = lt & 15;
#pragma unroll
    for (int i = 0; i < 4; ++i) { *(LAS u32x4*)(buf + SC_W + (row + 16 * i) * SC_WP + seg * 16) = p.w[i]; *(LAS u32x4*)(buf + SC_Q + (row + 16 * i) * SC_WP + seg * 16) = p.q[i]; }
#pragma unroll
    for (int i = 0; i < 2; ++i) *(LAS u32x4*)(buf + SC_A + ((lt >> 3) + 32 * i) * SC_AP + (lt & 7) * 16) = p.at[i];
#pragma unroll
    for (int i = 0; i < 4; ++i) *(LAS u32x4*)(buf + SC_K + ((lt >> 3) + 32 * i) * SC_AP + (lt & 7) * 16) = p.k[i];
    if (lt < 64) { LAS float* gp = (LAS float*)(buf + SC_GC); gp[lt] = __expf(p.g); gp[64 + lt] = __expf(p.gl - p.g); if (lt == 0) gp[128] = __expf(p.gl); }
}
__device__ __forceinline__ bf16x8 frag2(const LAS unsigned char* p) { const u32x2 lo = *(const LAS u32x2*)p, hi = *(const LAS u32x2*)(p + 16); const u32x4 v = {lo.x, lo.y, hi.x, hi.y}; return __builtin_bit_cast(bf16x8, v); }
__device__ __forceinline__ void ph_dn_scan_mfma(const ArgsG& a, LAS unsigned char* lds, int bid, int G, int tid, int wave, int lane) {
    const bf16* QN = (const bf16*)(a.W() + WS_QN); const bf16* KT = (const bf16*)(a.W() + WS_KT); const bf16* W = (const bf16*)(a.W() + WS_W); const bf16* ATT = (const bf16*)(a.W() + WS_ATT);
    const float* GC = (const float*)(a.W() + WS_GC); const float* U = (const float*)(a.W() + WS_U); float* O = (float*)(a.W() + WS_O);
    const int n = lane & 31, hh = lane >> 5;
    for (int u = bid; u < 32; u += G) {
        const int h = u & 3, b = u >> 2;
        f32x16 S[4];
#pragma unroll
        for (int k = 0; k < 4; ++k)
#pragma unroll
            for (int r = 0; r < 16; ++r) S[k][r] = 0.f;
        __syncthreads();
        if (wave >= 4) { const ScanPf p0 = scan_load(W, QN, ATT, KT, GC, b * SEQ, h, (b * 4 + h) * 32, tid - 256); scan_store(p0, lds, tid - 256); }
        __syncthreads();
#pragma unroll 1
        for (int nn = 0; nn < 32; ++nn) {
            const int r0 = b * SEQ + nn * 64; LAS unsigned char* buf = lds + (nn & 1) * SC_BUF; const LAS float* gp = (const LAS float*)(buf + SC_GC);
            if (wave >= 4) { if (nn + 1 < 32) { const ScanPf pf = scan_load(W, QN, ATT, KT, GC, r0 + 64, h, (b * 4 + h) * 32 + nn + 1, tid - 256); scan_store(pf, lds + ((nn + 1) & 1) * SC_BUF, tid - 256); } }
            else {
                const size_t ubase = (size_t)r0 * 512 + h * 128 + 32 * wave + n;
                f32x16 vn[2];
#pragma unroll
                for (int ib = 0; ib < 2; ++ib)
#pragma unroll
                    for (int r = 0; r < 16; ++r) vn[ib][r] = U[ubase + (size_t)(32 * ib + (r & 3) + 8 * (r >> 2) + 4 * hh) * 512];
                bf16x8 Sb[4][2];
#pragma unroll
                for (int k = 0; k < 4; ++k)
#pragma unroll
                    for (int s2 = 0; s2 < 2; ++s2) { u32x4 w4; w4.x = pg8::cvt_pk_bf16(S[k][8 * s2], S[k][8 * s2 + 1]); w4.y = pg8::cvt_pk_bf16(S[k][8 * s2 + 2], S[k][8 * s2 + 3]);
                        w4.z = pg8::cvt_pk_bf16(S[k][8 * s2 + 4], S[k][8 * s2 + 5]); w4.w = pg8::cvt_pk_bf16(S[k][8 * s2 + 6], S[k][8 * s2 + 7]); Sb[k][s2] = __builtin_bit_cast(bf16x8, w4); }
#pragma unroll
                for (int ib = 0; ib < 2; ++ib) { f32x16 acc;
#pragma unroll
                    for (int r = 0; r < 16; ++r) acc[r] = 0.f;
#pragma unroll
                    for (int k = 0; k < 4; ++k)
#pragma unroll
                        for (int s2 = 0; s2 < 2; ++s2) acc = __builtin_amdgcn_mfma_f32_32x32x16_bf16(frag2(buf + SC_W + (32 * ib + n) * SC_WP + (32 * k + 16 * s2 + 4 * hh) * 2), Sb[k][s2], acc, 0, 0, 0);
#pragma unroll
                    for (int r = 0; r < 16; ++r) vn[ib][r] -= acc[r]; }
                bf16x8 vb[2][2], vd[2][2];
#pragma unroll
                for (int jb = 0; jb < 2; ++jb)
#pragma unroll
                    for (int s2 = 0; s2 < 2; ++s2) { const f32x4 d0 = *(const LAS f32x4*)(gp + 64 + 32 * jb + 16 * s2 + 4 * hh), d1 = *(const LAS f32x4*)(gp + 64 + 32 * jb + 16 * s2 + 8 + 4 * hh);
                        const float* v = nullptr; (void)v; u32x4 w4, w5;
                        w4.x = pg8::cvt_pk_bf16(vn[jb][8 * s2], vn[jb][8 * s2 + 1]); w4.y = pg8::cvt_pk_bf16(vn[jb][8 * s2 + 2], vn[jb][8 * s2 + 3]);
                        w4.z = pg8::cvt_pk_bf16(vn[jb][8 * s2 + 4], vn[jb][8 * s2 + 5]); w4.w = pg8::cvt_pk_bf16(vn[jb][8 * s2 + 6], vn[jb][8 * s2 + 7]);
                        w5.x = pg8::cvt_pk_bf16(vn[jb][8 * s2] * d0.x, vn[jb][8 * s2 + 1] * d0.y); w5.y = pg8::cvt_pk_bf16(vn[jb][8 * s2 + 2] * d0.z, vn[jb][8 * s2 + 3] * d0.w);
                        w5.z = pg8::cvt_pk_bf16(vn[jb][8 * s2 + 4] * d1.x, vn[jb][8 * s2 + 5] * d1.y); w5.w = pg8::cvt_pk_bf16(vn[jb][8 * s2 + 6] * d1.z, vn[jb][8 * s2 + 7] * d1.w);
                        vb[jb][s2] = __builtin_bit_cast(bf16x8, w4); vd[jb][s2] = __builtin_bit_cast(bf16x8, w5); }
#pragma unroll
                for (int ib = 0; ib < 2; ++ib) { f32x16 acc;
#pragma unroll
                    for (int r = 0; r < 16; ++r) acc[r] = 0.f;
#pragma unroll
                    for (int k = 0; k < 4; ++k)
#pragma unroll
                        for (int s2 = 0; s2 < 2; ++s2) acc = __builtin_amdgcn_mfma_f32_32x32x16_bf16(frag2(buf + SC_Q + (32 * ib + n) * SC_WP + (32 * k + 16 * s2 + 4 * hh) * 2), Sb[k][s2], acc, 0, 0, 0);
#pragma unroll
                    for (int rq = 0; rq < 4; ++rq) { const f32x4 e4 = *(const LAS f32x4*)(gp + 32 * ib + 8 * rq + 4 * hh);
                        acc[4 * rq] *= e4.x; acc[4 * rq + 1] *= e4.y; acc[4 * rq + 2] *= e4.z; acc[4 * rq + 3] *= e4.w; }
#pragma unroll
                    for (int jb = 0; jb < 2; ++jb) { if (jb > ib) continue;
#pragma unroll
                        for (int s2 = 0; s2 < 2; ++s2) acc = __builtin_amdgcn_mfma_f32_32x32x16_bf16(frag2(buf + SC_A + (32 * ib + n) * SC_AP + (32 * jb + 16 * s2 + 4 * hh) * 2), vb[jb][s2], acc, 0, 0, 0); }
#pragma unroll
                    for (int r = 0; r < 16; ++r) O[ubase + (size_t)(32 * ib + (r & 3) + 8 * (r >> 2) + 4 * hh) * 512] = acc[r]; }
                const float egl = gp[128];
#pragma unroll
                for (int k = 0; k < 4; ++k) {
#pragma unroll
                    for (int r = 0; r < 16; ++r) S[k][r] *= egl;
#pragma unroll
                    for (int jb = 0; jb < 2; ++jb)
#pragma unroll
                        for (int s2 = 0; s2 < 2; ++s2) S[k] = __builtin_amdgcn_mfma_f32_32x32x16_bf16(frag2(buf + SC_K + (32 * k + n) * SC_AP + (32 * jb + 16 * s2 + 4 * hh) * 2), vd[jb][s2], S[k], 0, 0, 0); }
            }
            __syncthreads();
        }
    }
}

__device__ __forceinline__ void ph_dn_out(const ArgsG& a, int l, int gw, int NGW, int lane) {
    const float* O = (const float*)(a.W() + WS_O); const bf16* P = (const bf16*)(a.W() + WS_P); bf16* Y = (bf16*)(a.W() + WS_Y);
    const float* nw = a.I(6) + l * 128;
    for (int tok = gw; tok < NT; tok += NGW) {
#pragma unroll
        for (int h = 0; h < 4; ++h) { const float o0 = O[(size_t)tok * 512 + h * 128 + 2 * lane], o1 = O[(size_t)tok * 512 + h * 128 + 2 * lane + 1];
            const float ss = wave_sum(o0 * o0 + o1 * o1); const float r = rsqrtf(ss * (1.0f / 128.0f) + EPS);
            const unsigned zw = *(const unsigned*)(P + (size_t)tok * NP + C_Z + h * 128 + 2 * lane);
            const float y0 = o0 * r * nw[2 * lane] * siluf_(bf_lo(zw)), y1 = o1 * r * nw[2 * lane + 1] * siluf_(bf_hi(zw));
            *(unsigned*)(Y + (size_t)tok * DM + h * 128 + 2 * lane) = pk2(y0, y1); }
    }
}

constexpr int NSA_KT_PITCH = 144, NSA_VT_PITCH = 136;
struct NsaStage { u32x4 kv, vv; };
__device__ __forceinline__ NsaStage nsa_load(const bf16* Kbase, int kpitch, const bf16* Vbase, int vpitch, int tid) {
    const int key = tid >> 3, seg = tid & 7; NsaStage s;
    s.kv = *(const u32x4*)(Kbase + (size_t)key * kpitch + seg * 8); s.vv = *(const u32x4*)(Vbase + (size_t)key * vpitch + seg * 8); return s;
}
__device__ __forceinline__ void nsa_store(const NsaStage& s, LAS unsigned char* Kt, LAS unsigned char* Vt, int tid) {
    const int key = tid >> 3, seg = tid & 7;
    *(LAS u32x4*)(Kt + key * NSA_KT_PITCH + seg * 16) = s.kv;
#pragma unroll
    for (int i = 0; i < 4; ++i) { const unsigned w = s.vv[i];
        *(LAS unsigned short*)(Vt + (seg * 8 + 2 * i) * NSA_VT_PITCH + key * 2) = (unsigned short)(w & 0xffffu);
        *(LAS unsigned short*)(Vt + (seg * 8 + 2 * i + 1) * NSA_VT_PITCH + key * 2) = (unsigned short)(w >> 16); }
}
__device__ __forceinline__ void nsa_st(const LAS unsigned char* Kt, const bf16x8 (&qf)[4], int n, int hh, f32x16 (&s)[2]) {
#pragma unroll
    for (int kb = 0; kb < 2; ++kb) {
#pragma unroll
        for (int r = 0; r < 16; ++r) s[kb][r] = 0.f;
#pragma unroll
        for (int ks = 0; ks < 4; ++ks) { const bf16x8 af = *(const LAS bf16x8*)(Kt + (kb * 32 + n) * NSA_KT_PITCH + (16 * ks + 8 * hh) * 2);
            s[kb] = __builtin_amdgcn_mfma_f32_32x32x16_bf16(af, qf[ks], s[kb], 0, 0, 0); } }
}
__device__ __forceinline__ void nsa_pvm(const LAS unsigned char* Vt, const bf16x8 (&pf)[2][2], int n, int hh, f32x16 (&o)[2]) {
#pragma unroll
    for (int db = 0; db < 2; ++db)
#pragma unroll
        for (int kb = 0; kb < 2; ++kb)
#pragma unroll
            for (int s2 = 0; s2 < 2; ++s2) { const LAS unsigned char* p = Vt + (db * 32 + n) * NSA_VT_PITCH + (kb * 32 + 16 * s2 + 4 * hh) * 2;
                const u32x2 lo = *(const LAS u32x2*)p, hi = *(const LAS u32x2*)(p + 16);
                const u32x4 av = {lo.x, lo.y, hi.x, hi.y};
                o[db] = __builtin_amdgcn_mfma_f32_32x32x16_bf16(__builtin_bit_cast(bf16x8, av), pf[kb][s2], o[db], 0, 0, 0); }
}
__device__ __forceinline__ void nsa_pack(const f32x16 (&p)[2], bf16x8 (&pf)[2][2]) {
#pragma unroll
    for (int kb = 0; kb < 2; ++kb)
#pragma unroll
        for (int s2 = 0; s2 < 2; ++s2) { u32x4 w;
            w.x = pg8::cvt_pk_bf16(p[kb][8 * s2 + 0], p[kb][8 * s2 + 1]); w.y = pg8::cvt_pk_bf16(p[kb][8 * s2 + 2], p[kb][8 * s2 + 3]);
            w.z = pg8::cvt_pk_bf16(p[kb][8 * s2 + 4], p[kb][8 * s2 + 5]); w.w = pg8::cvt_pk_bf16(p[kb][8 * s2 + 6], p[kb][8 * s2 + 7]);
            pf[kb][s2] = __builtin_bit_cast(bf16x8, w); }
}
constexpr int BT2_ROWS = 2048 + 72;
template <bool COLSEL>
__device__ __forceinline__ void nsa_tile_mfma(const LAS unsigned char* Kt, const LAS unsigned char* Vt, const LAS float* btl2h, const bf16x8 (&qf)[4], int n, int hh,
                                              int key0, int tq, bool masked, bool colsel, int maxd, float& m, float& l, f32x16 (&o)[2]) {
    f32x16 s[2]; nsa_st(Kt, qf, n, hh, s);
    const int dbase = tq - key0 - 4 * hh;
    const LAS float* bp = btl2h + (2047 - dbase) * 4;
#pragma unroll
    for (int kb = 0; kb < 2; ++kb)
#pragma unroll
        for (int r = 0; r < 16; ++r) { const int cst = kb * 32 + (r & 3) + 8 * (r >> 2); const float x = s[kb][r] + bp[cst * 4]; s[kb][r] = (!COLSEL || colsel) ? x : -3.0e38f; }
    if (masked) {
#pragma unroll
        for (int kb = 0; kb < 2; ++kb)
#pragma unroll
            for (int r = 0; r < 16; ++r) { const int dist = dbase - (kb * 32 + (r & 3) + 8 * (r >> 2)); s[kb][r] = (dist >= 0 && dist <= maxd) ? s[kb][r] : -3.0e38f; } }
    float tmax = -3.0e38f;
#pragma unroll
    for (int kb = 0; kb < 2; ++kb)
#pragma unroll
        for (int r = 0; r < 16; ++r) tmax = fmaxf(tmax, s[kb][r]);
    tmax = fmaxf(tmax, __shfl_xor(tmax, 32));
    const float mn = fmaxf(m, tmax); float rs = 0.f;
#pragma unroll
    for (int kb = 0; kb < 2; ++kb)
#pragma unroll
        for (int r = 0; r < 16; ++r) { const float p = __builtin_amdgcn_exp2f(s[kb][r] - mn); s[kb][r] = p; rs += p; }
    rs += __shfl_xor(rs, 32);
    if (__any(mn > m)) { const float corr = __builtin_amdgcn_exp2f(m - mn); l *= corr;
#pragma unroll
        for (int db = 0; db < 2; ++db)
#pragma unroll
            for (int r = 0; r < 16; ++r) o[db][r] *= corr; }
    l += rs; m = mn;
    bf16x8 pf[2][2]; nsa_pack(s, pf);
    nsa_pvm(Vt, pf, n, hh, o);
}

__device__ __forceinline__ void ph_nsa_mfma(const ArgsG& a, LAS unsigned char* lds, int ubeg, int ustep, int uend, int tid, int wave, int lane) {
    LAS float* btl2 = (LAS float*)lds;
    constexpr int NSA_L0 = BT2_ROWS * 16;
    LAS unsigned char* Kt = lds + NSA_L0;
    LAS unsigned char* Vt = lds + NSA_L0 + 9216;
    constexpr int NSA_TB = 9216 + 8704;
    LAS float* PS = (LAS float*)(lds + NSA_L0 + 2 * NSA_TB + 256);
    LAS unsigned* MK = (LAS unsigned*)(lds + NSA_L0 + 2 * NSA_TB + 256 + 64 * 129 * 4);
    static_assert(NSA_L0 + 2 * NSA_TB + 256 + 64 * 129 * 4 + 512 <= RING_BYTES, "NSA LDS");
    const float* BT = (const float*)(a.W() + WS_BT);
    for (int i = tid; i < BT2_ROWS * 4; i += NTHR) { const int row = i >> 2, hd = i & 3; btl2[i] = row < 2048 ? BT[hd * 2048 + (2047 - row)] * 1.4426950408889634f : 0.f; }
    const bf16* P = (const bf16*)(a.W() + WS_P); const bf16* NQ = (const bf16*)(a.W() + WS_NQ);
    const bf16* KS = (const bf16*)(a.W() + WS_KS); const bf16* KW = (const bf16*)(a.W() + WS_KW);
    const bf16* KCMP = (const bf16*)(a.W() + WS_KCMP); const bf16* VCMP = (const bf16*)(a.W() + WS_VCMP); bf16* Y = (bf16*)(a.W() + WS_Y);
    const int n = lane & 31, hh = lane >> 5, tl = n >> 2, h = n & 3;
    const LAS float* btl2h = btl2 + h;
    __syncthreads();
    for (int u = ubeg; u < uend; u += ustep) {
        const int b = u & 7, qt = 31 - (u >> 3), t0 = 64 * qt, tq = t0 + 8 * wave + tl, tok = b * SEQ + tq;
        bf16x8 qf[4];
#pragma unroll
        for (int ks = 0; ks < 4; ++ks) qf[ks] = *(const bf16x8*)(NQ + (size_t)tok * 256 + h * 64 + 16 * ks + 8 * hh);
        float gate[3];
#pragma unroll
        for (int br = 0; br < 3; ++br) gate[br] = sigmoidf_(bf2f(P[(size_t)tok * NP + C_G + h * 3 + br]));
        f32x16 yacc[2];
        {
            float mx = -1e30f, rs = 0.f;
#pragma unroll 1
            for (int ct = 0; ct < 2; ++ct) {
                __syncthreads();
                { const NsaStage st = nsa_load(KCMP + (size_t)(b * 128 + ct * 64) * 64, 64, VCMP + (size_t)(b * 128 + ct * 64) * 64, 64, tid); nsa_store(st, Kt, Vt, tid); }
                __syncthreads();
                f32x16 sc[2]; nsa_st(Kt, qf, n, hh, sc);
                float tmax = -1e30f;
#pragma unroll
                for (int kb = 0; kb < 2; ++kb)
#pragma unroll
                    for (int r = 0; r < 16; ++r) { const int j = ct * 64 + kb * 32 + (r & 3) + 8 * (r >> 2) + 4 * hh; const int dist = tq - 16 * j - 31;
                        const float x = sc[kb][r] + btl2h[(2047 - (dist < 0 ? 0 : dist)) * 4]; sc[kb][r] = dist >= 0 ? x : -1e30f; tmax = fmaxf(tmax, sc[kb][r]); }
                tmax = fmaxf(tmax, __shfl_xor(tmax, 32));
                const float mn = fmaxf(mx, tmax); float ts = 0.f;
#pragma unroll
                for (int kb = 0; kb < 2; ++kb)
#pragma unroll
                    for (int r = 0; r < 16; ++r) { const float x = sc[kb][r]; ts += x > -1e29f ? __builtin_amdgcn_exp2f(x - mn) : 0.f; }
                ts += __shfl_xor(ts, 32);
                rs = rs * __builtin_amdgcn_exp2f(mx - mn) + ts; mx = mn;
            }
            const float inv = rs > 0.f ? 1.0f / rs : 0.f;
            f32x16 o[2];
#pragma unroll
            for (int db = 0; db < 2; ++db)
#pragma unroll
                for (int r = 0; r < 16; ++r) o[db][r] = 0.f;
#pragma unroll 1
            for (int cc = 0; cc < 2; ++cc) { const int ct = 1 - cc;
                if (cc == 1) { __syncthreads();
                    { const NsaStage st = nsa_load(KCMP + (size_t)(b * 128) * 64, 64, VCMP + (size_t)(b * 128) * 64, 64, tid); nsa_store(st, Kt, Vt, tid); }
                    __syncthreads(); }
                f32x16 sc[2]; nsa_st(Kt, qf, n, hh, sc);
#pragma unroll
                for (int kb = 0; kb < 2; ++kb)
#pragma unroll
                    for (int r = 0; r < 16; ++r) { const int j = ct * 64 + kb * 32 + (r & 3) + 8 * (r >> 2) + 4 * hh; const int dist = tq - 16 * j - 31;
                        const float x = sc[kb][r] + btl2h[(2047 - (dist < 0 ? 0 : dist)) * 4]; const float p = dist >= 0 ? __builtin_amdgcn_exp2f(x - mx) * inv : 0.f; sc[kb][r] = p;
                        float v = p; v += __shfl_xor(v, 1); v += __shfl_xor(v, 2);
                        if (h == 0) PS[(8 * wave + tl) * 129 + j] = v; }
                bf16x8 pf[2][2]; nsa_pack(sc, pf); nsa_pvm(Vt, pf, n, hh, o);
            }
#pragma unroll
            for (int db = 0; db < 2; ++db)
#pragma unroll
                for (int r = 0; r < 16; ++r) yacc[db][r] = gate[0] * o[db][r];
        }
        LDS_WAIT();
        for (int t2 = 0; t2 < 8; ++t2) {
            const int tqq = t0 + 8 * wave + t2, sb = lane & 31, cur = tqq >> 6; const LAS float* row = PS + (8 * wave + t2) * 129; float imp = 0.f;
#pragma unroll
            for (int dj = -1; dj <= 3; ++dj) { const int j = 4 * sb + dj; if (j >= 0 && j <= 126) imp += row[j]; }
            if (sb > cur) imp = -1.0f; else if (sb == 0 || sb == cur || sb == cur - 1) imp = 1e4f;
            int rank = 0;
            for (int s2 = 0; s2 < 32; ++s2) { const float v2 = __shfl(imp, s2); rank += (v2 > imp || (v2 == imp && s2 < sb)) ? 1 : 0; }
            const unsigned msk = (unsigned)__ballot((lane < 32) && (rank < 16) && (sb <= cur));
            if (lane == 0) MK[8 * wave + t2] = msk;
        }
        __syncthreads();
        unsigned anymask, wmask; const unsigned mymask = MK[8 * wave + tl];
        { unsigned v = MK[lane];
#pragma unroll
            for (int o_ = 1; o_ < 64; o_ <<= 1) v |= (unsigned)__shfl_xor((int)v, o_);
            anymask = (unsigned)__builtin_amdgcn_readfirstlane((int)v);
            unsigned w = MK[8 * wave + (lane & 7)]; w |= (unsigned)__shfl_xor((int)w, 1); w |= (unsigned)__shfl_xor((int)w, 2); w |= (unsigned)__shfl_xor((int)w, 4);
            wmask = (unsigned)__builtin_amdgcn_readfirstlane((int)w); }
        LAS unsigned* stash = (LAS unsigned*)PS + (wave * 16) * 64 + lane;
        __syncthreads();
#pragma unroll
        for (int db = 0; db < 2; ++db)
#pragma unroll
            for (int k = 0; k < 8; ++k) stash[(db * 8 + k) * 64] = pk2(yacc[db][2 * k], yacc[db][2 * k + 1]);
        {
            float m = -1e30f, l = 0.f; f32x16 o[2];
#pragma unroll
            for (int db = 0; db < 2; ++db)
#pragma unroll
                for (int r = 0; r < 16; ++r) o[db][r] = 0.f;
            unsigned mk = anymask; NsaStage s0, s1; bool h1 = false;
            { const int sa = __builtin_ctz(mk); s0 = nsa_load(KS + (size_t)(b * SEQ + 64 * sa) * 64, 64, P + (size_t)(b * SEQ + 64 * sa) * NP + C_KV + 192, NP, tid);
              unsigned m2 = mk & (mk - 1u); if (m2) { const int sb2 = __builtin_ctz(m2); s1 = nsa_load(KS + (size_t)(b * SEQ + 64 * sb2) * 64, 64, P + (size_t)(b * SEQ + 64 * sb2) * NP + C_KV + 192, NP, tid); h1 = true; } }
            __syncthreads();
            nsa_store(s0, Kt, Vt, tid);
            __syncthreads();
            int par = 0;
            while (mk) {
                const int sblk = __builtin_ctz(mk); mk &= mk - 1u;
                if (h1) { nsa_store(s1, Kt + (par ^ 1) * NSA_TB, Vt + (par ^ 1) * NSA_TB, tid);
                    const unsigned m3 = mk & (mk - 1u);
                    if (m3) { const int sc2 = __builtin_ctz(m3); s1 = nsa_load(KS + (size_t)(b * SEQ + 64 * sc2) * 64, 64, P + (size_t)(b * SEQ + 64 * sc2) * NP + C_KV + 192, NP, tid); } else h1 = false; }
                if ((wmask >> sblk) & 1u) nsa_tile_mfma<true>(Kt + par * NSA_TB, Vt + par * NSA_TB, btl2h, qf, n, hh, 64 * sblk, tq, 64 * sblk + 63 > t0 + 8 * wave, ((mymask >> sblk) & 1u) != 0u, 1 << 30, m, l, o);
                __syncthreads();
                par ^= 1;
            }
            const float inv = l > 0.f ? gate[1] / l : 0.f;
#pragma unroll
            for (int db = 0; db < 2; ++db)
#pragma unroll
                for (int k = 0; k < 8; ++k) { const unsigned w = stash[(db * 8 + k) * 64]; stash[(db * 8 + k) * 64] = pk2(bf_lo(w) + inv * o[db][2 * k], bf_hi(w) + inv * o[db][2 * k + 1]); }
        }
        {
            float m = -1e30f, l = 0.f; f32x16 o[2];
#pragma unroll
            for (int db = 0; db < 2; ++db)
#pragma unroll
                for (int r = 0; r < 16; ++r) o[db][r] = 0.f;
            const int kt0 = (t0 - 511 > 0 ? t0 - 511 : 0) >> 6;
            NsaStage s0 = nsa_load(KW + (size_t)(b * SEQ + 64 * kt0) * 64, 64, P + (size_t)(b * SEQ + 64 * kt0) * NP + C_KV + 320, NP, tid), s1;
            if (kt0 < qt) s1 = nsa_load(KW + (size_t)(b * SEQ + 64 * (kt0 + 1)) * 64, 64, P + (size_t)(b * SEQ + 64 * (kt0 + 1)) * NP + C_KV + 320, NP, tid);
            __syncthreads();
            nsa_store(s0, Kt, Vt, tid);
            __syncthreads();
            int par = 0;
            for (int kt = kt0; kt <= qt; ++kt) {
                if (kt < qt) { nsa_store(s1, Kt + (par ^ 1) * NSA_TB, Vt + (par ^ 1) * NSA_TB, tid);
                    if (kt + 2 <= qt) s1 = nsa_load(KW + (size_t)(b * SEQ + 64 * (kt + 2)) * 64, 64, P + (size_t)(b * SEQ + 64 * (kt + 2)) * NP + C_KV + 320, NP, tid); }
                nsa_tile_mfma<false>(Kt + par * NSA_TB, Vt + par * NSA_TB, btl2h, qf, n, hh, 64 * kt, tq, !(64 * kt + 63 <= t0 + 8 * wave && t0 + 8 * wave + 7 - 64 * kt <= 511), true, 511, m, l, o);
                __syncthreads();
                par ^= 1;
            }
            const float inv = l > 0.f ? gate[2] / l : 0.f;
#pragma unroll
            for (int db = 0; db < 2; ++db)
#pragma unroll
                for (int k = 0; k < 8; ++k) { const unsigned w = stash[(db * 8 + k) * 64]; yacc[db][2 * k] = bf_lo(w) + inv * o[db][2 * k]; yacc[db][2 * k + 1] = bf_hi(w) + inv * o[db][2 * k + 1]; }
        }
#pragma unroll
        for (int db = 0; db < 2; ++db)
#pragma unroll
            for (int rq = 0; rq < 4; ++rq) { u32x2 w; w.x = pk2(yacc[db][4 * rq], yacc[db][4 * rq + 1]); w.y = pk2(yacc[db][4 * rq + 2], yacc[db][4 * rq + 3]);
                *(u32x2*)(Y + (size_t)tok * DM + 512 + h * 64 + db * 32 + 8 * rq + 4 * hh) = w; }
        __syncthreads();
    }
}

constexpr int RT_PITCH = 2064;
__device__ __forceinline__ void ph_router(const ArgsG& a, int l, const float* Xin_, const bf16* Dm, LAS unsigned char* lds, int bid, int G, int tid, int wave, int lane) {
    LAS unsigned char* Ht = lds;
    LAS float* LG = (LAS float*)(lds + 32 * RT_PITCH);
    LAS int* lcnt = (LAS int*)(lds + 32 * RT_PITCH + 4 * 64 * 33 * 4); LAS int* asg_e = lcnt + 32; LAS int* asg_p = asg_e + 256; LAS float* asg_w = (LAS float*)(asg_p + 256); LAS int* gbase = (LAS int*)(asg_w + 256);
    bf16* H2 = (bf16*)(a.W() + WS_XN); unsigned* cnt = (unsigned*)(a.W() + WS_CTL) + CW_CNT + 64 * l;
    int* EIDX = (int*)(a.W() + WS_EIDX); int* EPOS = (int*)(a.W() + WS_EPOS); float* EW = (float*)(a.W() + WS_EW);
    const float* fw = a.I(17) + (size_t)l * DM; const float* rb = a.I(19) + l * NE;
    const bf16* RWH = (const bf16*)(a.W() + WS_RWH) + (size_t)l * NE * DM; const bf16* RWL = (const bf16*)(a.W() + WS_RWL) + (size_t)l * NE * DM;
    for (int u = bid; u < NT / 64; u += G) {
        const int tok0 = u * 64;
        if (tid < 32) lcnt[tid] = 0;
#pragma unroll 1
        for (int hf = 0; hf < 2; ++hf) {
            __syncthreads();
#pragma unroll 1
            for (int i = 0; i < 4; ++i) { const int tl = 4 * wave + i, tok = tok0 + 32 * hf + tl;
                f32x4 v[4]; float ss = 0.f;
#pragma unroll
                for (int j = 0; j < 4; ++j) { v[j] = *(const f32x4*)(Xin_ + (size_t)tok * DM + 4 * (64 * j + lane)); const u32x2 dd = *(const u32x2*)(Dm + (size_t)tok * DM + 4 * (64 * j + lane));
                    v[j].x += bf_lo(dd.x); v[j].y += bf_hi(dd.x); v[j].z += bf_lo(dd.y); v[j].w += bf_hi(dd.y); ss += (v[j].x * v[j].x + v[j].y * v[j].y) + (v[j].z * v[j].z + v[j].w * v[j].w); }
                const float r = rsqrtf(wave_sum(ss) * (1.0f / DM) + EPS);
#pragma unroll
                for (int j = 0; j < 4; ++j) { const f32x4 y = v[j] * r * *(const f32x4*)(fw + 4 * (64 * j + lane));
                    u32x2 o; o.x = pk2(y.x, y.y); o.y = pk2(y.z, y.w); *(u32x2*)(H2 + (size_t)tok * DM + 4 * (64 * j + lane)) = o;
                    *(LAS u32x2*)(Ht + tl * RT_PITCH + 8 * (64 * j + lane)) = o; } }
            __syncthreads();
            { const int r = lane & 15, q = lane >> 4, tile = wave & 1, kq = wave >> 1; f32x4 acc0 = {0.f, 0.f, 0.f, 0.f}, acc1 = {0.f, 0.f, 0.f, 0.f};
                const LAS unsigned char* arow = Ht + (16 * tile + r) * RT_PITCH + q * 16;
                const bf16* bh = RWH + (size_t)r * DM + 8 * q; const bf16* bl = RWL + (size_t)r * DM + 8 * q;
#pragma unroll
                for (int s8 = 0; s8 < 8; ++s8) { const int s = 8 * kq + s8; const bf16x8 af = *(const LAS bf16x8*)(arow + s * 64);
                    acc0 = __builtin_amdgcn_mfma_f32_16x16x32_bf16(af, *(const bf16x8*)(bh + 32 * s), acc0, 0, 0, 0); acc0 = __builtin_amdgcn_mfma_f32_16x16x32_bf16(af, *(const bf16x8*)(bl + 32 * s), acc0, 0, 0, 0);
                    acc1 = __builtin_amdgcn_mfma_f32_16x16x32_bf16(af, *(const bf16x8*)(bh + 16 * DM + 32 * s), acc1, 0, 0, 0); acc1 = __builtin_amdgcn_mfma_f32_16x16x32_bf16(af, *(const bf16x8*)(bl + 16 * DM + 32 * s), acc1, 0, 0, 0); }
                const float b0 = kq == 0 ? rb[r] : 0.f, b1 = kq == 0 ? rb[16 + r] : 0.f;
#pragma unroll
                for (int i = 0; i < 4; ++i) { LAS float* lg = LG + kq * (64 * 33) + (32 * hf + 16 * tile + 4 * q + i) * 33; lg[r] = acc0[i] + b0; lg[16 + r] = acc1[i] + b1; } }
        }
        __syncthreads();
        if (tid < 64) { const LAS float* lg = LG + tid * 33; unsigned used = 0u; float tv[4]; int ti[4];
#pragma unroll
            for (int qn = 0; qn < 4; ++qn) { float best = -3.0e38f; int bi = 0;
                for (int e = 0; e < NE; ++e) { const float v = ((lg[e] + lg[64 * 33 + e]) + lg[2 * 64 * 33 + e]) + lg[3 * 64 * 33 + e]; if (!((used >> e) & 1u) && v > best) { best = v; bi = e; } }
                used |= 1u << bi; tv[qn] = best; ti[qn] = bi; }
            float ew[4], es = 0.f;
#pragma unroll
            for (int qn = 0; qn < 4; ++qn) { ew[qn] = __expf(tv[qn] - tv[0]); es += ew[qn]; }
#pragma unroll
            for (int qn = 0; qn < 4; ++qn) { const int p = __hip_atomic_fetch_add(&lcnt[ti[qn]], 1, __ATOMIC_RELAXED, __HIP_MEMORY_SCOPE_WORKGROUP); asg_e[tid * 4 + qn] = ti[qn]; asg_p[tid * 4 + qn] = p; asg_w[tid * 4 + qn] = ew[qn] / es; } }
        __syncthreads();
        if (tid < 32) gbase[tid] = (int)atomicAdd(&cnt[tid], (unsigned)lcnt[tid]);
        __syncthreads();
        if (tid < 256) { const int tok = tok0 + (tid >> 2), k = tid & 3, e = asg_e[tid];
            EIDX[(size_t)tok * 4 + k] = e; EPOS[(size_t)tok * 4 + k] = gbase[e] + asg_p[tid]; EW[(size_t)tok * 4 + k] = asg_w[tid]; }
        __syncthreads();
    }
}

__device__ __forceinline__ void build_tiles(const unsigned* cnt, LAS int* TS, LAS int* TE, int tid) {
    if (tid == 0) { int acc = 0;
        for (int e = 0; e < NE; ++e) { TS[e] = acc; const int nt = (int)((cnt[e] + 255u) >> 8); for (int i = 0; i < nt; ++i) TE[acc + i] = e; acc += nt; }
        TS[NE] = acc; }
    __syncthreads();
}

__device__ __forceinline__ void ph_gather(const ArgsG& a, int l, LAS unsigned char* lds, int gw, int NGW, int tid, int lane) {
    LAS int* TS = (LAS int*)(lds + TS_OFF); LAS int* TE = (LAS int*)(lds + TE_OFF);
    const unsigned* cnt = (const unsigned*)(a.W() + WS_CTL) + CW_CNT + 64 * l;
    build_tiles(cnt, TS, TE, tid);
    const int* EIDX = (const int*)(a.W() + WS_EIDX); const int* EPOS = (const int*)(a.W() + WS_EPOS); int* SLOT = (int*)(a.W() + WS_SLOT); int* S2T = (int*)(a.W() + WS_XS);
    for (int i = gw * 64 + lane; i < NT * 4; i += NGW * 64) { const int slot = TS[EIDX[i]] * 256 + EPOS[i]; SLOT[i] = slot; S2T[slot] = i >> 2; }
    for (int e = (int)blockIdx.x; e < NE; e += (int)gridDim.x) { const int beg = TS[e] * 256 + (int)cnt[e], end = TS[e + 1] * 256; for (int sidx = beg + tid; sidx < end; sidx += NTHR) S2T[sidx] = 0; }
}

__device__ __forceinline__ void ph_combine(const ArgsG& a, const float* Xin_, const bf16* Dm, float* Xo, const float* next_norm_w, int gw, int NGW, int lane) {
    const bf16* YS = (const bf16*)(a.W() + WS_YS); const int* SLOT = (const int*)(a.W() + WS_SLOT); const float* EW = (const float*)(a.W() + WS_EW); bf16* XN = (bf16*)(a.W() + WS_XN);
    for (int tok = gw; tok < NT; tok += NGW) {
        int slot = 0; float wgt = 0.f;
        if (lane < 4) { slot = SLOT[(size_t)tok * 4 + lane]; wgt = EW[(size_t)tok * 4 + lane]; }
        f32x4 v[4];
#pragma unroll
        for (int j = 0; j < 4; ++j) { v[j] = *(const f32x4*)(Xin_ + (size_t)tok * DM + 4 * (64 * j + lane)); const u32x2 dd = *(const u32x2*)(Dm + (size_t)tok * DM + 4 * (64 * j + lane));
            v[j].x += bf_lo(dd.x); v[j].y += bf_hi(dd.x); v[j].z += bf_lo(dd.y); v[j].w += bf_hi(dd.y); }
#pragma unroll
        for (int k = 0; k < 4; ++k) { const int sk = __shfl(slot, k); const float wk = __shfl(wgt, k);
#pragma unroll
            for (int j = 0; j < 4; ++j) { const u32x2 y = *(const u32x2*)(YS + (size_t)sk * DM + 4 * (64 * j + lane));
                v[j].x += wk * bf_lo(y.x); v[j].y += wk * bf_hi(y.x); v[j].z += wk * bf_lo(y.y); v[j].w += wk * bf_hi(y.y); } }
#pragma unroll
        for (int j = 0; j < 4; ++j) *(f32x4*)(Xo + (size_t)tok * DM + 4 * (64 * j + lane)) = v[j];
        if (next_norm_w) rms_row_to_bf16(v, next_norm_w, XN + (size_t)tok * DM, lane);
    }
}

struct Tid { int tid, lane, wave; };
__device__ __forceinline__ Tid fresh_tid() { int t = threadIdx.x; asm volatile("" : "+v"(t)); Tid r; r.tid = t; r.lane = t & 63; r.wave = __builtin_amdgcn_readfirstlane(t >> 6); return r; }
#define FT() ArgsG A_; { unsigned char* w_ = args_k.ws; asm volatile("" : "+s"(w_)); A_.ws = (GAS unsigned char*)w_; _Pragma("unroll") for (int i_ = 0; i_ < 25; ++i_) A_.in[i_] = (const GAS float*)args_k.in[i_]; A_.out = (GAS float*)args_k.out; } const ArgsG& args = A_; const Tid T_ = fresh_tid(); const int tid = T_.tid, lane = T_.lane, wave = T_.wave, gw = bid * NWAVES + wave; (void)tid; (void)lane; (void)wave; (void)gw
constexpr int PH_PER_LAYER = 11, NPH = 2 + NLAYER * PH_PER_LAYER;

#if SINGLE_LAUNCH
#define BARPARM , unsigned* barw, unsigned& bark
#define BARARG , barw, bark
#define GRID_BAR() cnt_barrier(barw, bark)
#else
#define BARPARM
#define BARARG
#define GRID_BAR() do {} while (0)
#endif
#define IN(k) (lo <= (k) && (k) < hi)
#define SEAM(k) do { if (IN(k) && IN((k) + 1)) GRID_BAR(); } while (0)
template <int l>
__device__ __forceinline__ void run_layer(const Args& args_k, LAS unsigned char* lds, int lo, int hi, int G, int bid, int NGW BARPARM) {
        const int pb = 2 + l * PH_PER_LAYER;
#define Xin ((l == 0) ? args.I(0) : (const float*)(args.W() + WS_XB))
#define X1 ((float*)(args.W() + WS_XA))
#define Xout ((l == NLAYER - 1) ? args.O() : (float*)(args.W() + WS_XB))
        if (IN(pb + 0)) {
            FT(); pg8::Gemm g{(const pg8::bf16_t*)(args.W() + WS_XN), (const pg8::bf16_t*)(args.W() + WS_WIN) + (size_t)l * NP * DM, NT, NP, DM};
            pg8::StaticOrder S; S.init(NT, NP, G, bid);
            pg8::EpiBf16Plain E{(pg8::bf16_t*)(args.W() + WS_P), NP};
            pg8::gemm_phase<pg8::EpiBf16Plain, pg8::StaticOrder, true, true>(lds, g, S, E);
        } SEAM(pb + 0);
        if (IN(pb + 1)) { { FT(); ph_compress_mfma(args, l, lds, bid, G, tid, wave, lane); } { FT(); ph_m1(args, l, lds, bid, G, tid, wave, lane); } } SEAM(pb + 1);
        if (IN(pb + 2)) { FT(); ph_dn_chunk_mfma(args, lds, bid, G, tid, wave, lane); } SEAM(pb + 2);
        if (IN(pb + 3)) {
            const bool small = G <= 64;
            if (small || bid < 32) { FT(); ph_dn_scan_mfma(args, lds, bid, small ? G : 32, tid, wave, lane); }
            { int ub, us, ue;
              if (small) { ub = bid; us = G; ue = 256; }
              else if (G == 256) { if (bid >= 32) { ub = bid - 32; us = 32; ue = ub >= 192 ? 256 : ub + 1; } else { ub = 256; us = 256; ue = 256; } }
              else { ub = bid >= 32 ? bid - 32 : 256; us = G - 32; ue = 256; }
              FT(); ph_nsa_mfma(args, lds, ub, us, ue, tid, wave, lane); } } SEAM(pb + 3);
        if (IN(pb + 4)) { FT(); ph_dn_out(args, l, gw, NGW, lane); } SEAM(pb + 4);
        if (IN(pb + 5)) {
            FT(); pg8::Gemm g{(const pg8::bf16_t*)(args.W() + WS_Y), (const pg8::bf16_t*)(args.W() + WS_WOUT) + (size_t)l * DM * DM, NT, DM, DM};
            pg8::StaticOrder S; S.init(NT, DM, G, bid);
            pg8::EpiBf16Plain E{(pg8::bf16_t*)(args.W() + WS_XA), DM};
            pg8::gemm_phase<pg8::EpiBf16Plain, pg8::StaticOrder, true, true>(lds, g, S, E);
        } SEAM(pb + 5);
        if (IN(pb + 6)) { FT(); ph_router(args, l, Xin, (const bf16*)(args.W() + WS_XA), lds, bid, G, tid, wave, lane); } SEAM(pb + 6);
        if (IN(pb + 7)) { FT(); ph_gather(args, l, lds, gw, NGW, tid, lane); } SEAM(pb + 7);
        if (IN(pb + 8)) {
            FT(); LAS int* TS = (LAS int*)(lds + TS_OFF); LAS int* TE = (LAS int*)(lds + TE_OFF);
            build_tiles((const unsigned*)(args.W() + WS_CTL) + CW_CNT + 64 * l, TS, TE, tid);
            const int ntiles = __builtin_amdgcn_readfirstlane(TS[NE]);
            pg8::Gemm g{(const pg8::bf16_t*)(args.W() + WS_XN), (const pg8::bf16_t*)(args.W() + WS_WGU) + (size_t)l * NE * 2048 * DM, ntiles * 256, NE * 2048, DM};
            LAS int* RT = (LAS int*)(lds + LDSCTL_OFF + 2048);
            pg8::MoeOrder<8, true> S{ntiles, G, bid, (const LAS int*)TE, (const LAS int*)RT};
            { const int* S2T = (const int*)(args.W() + WS_XS); pg8::Unit uu; for (int i = 0; i < 10 && S.next(i, uu); ++i) if (tid < 256) RT[i * 256 + tid] = S2T[(size_t)uu.pm * 256 + tid]; }
            __syncthreads();
            pg8::EpiSwiglu E{(pg8::bf16_t*)(args.W() + WS_ACT), args.I(21) + (size_t)l * NE * 2048};
            pg8::gemm_phase<pg8::EpiSwiglu, pg8::MoeOrder<8, true>, true, true>(lds, g, S, E);
        } SEAM(pb + 8);
        if (IN(pb + 9)) {
            FT(); LAS int* TS = (LAS int*)(lds + TS_OFF); LAS int* TE = (LAS int*)(lds + TE_OFF);
            build_tiles((const unsigned*)(args.W() + WS_CTL) + CW_CNT + 64 * l, TS, TE, tid);
            const int ntiles = __builtin_amdgcn_readfirstlane(TS[NE]);
            pg8::Gemm g{(const pg8::bf16_t*)(args.W() + WS_ACT), (const pg8::bf16_t*)(args.W() + WS_WD) + (size_t)l * NE * DM * DM, ntiles * 256, NE * DM, DM};
            pg8::MoeOrder<4> S{ntiles, G, bid, (const LAS int*)TE};
            pg8::EpiDown64 E{(pg8::bf16_t*)(args.W() + WS_YS), args.I(23) + (size_t)l * NE * DM};
            pg8::gemm_phase<pg8::EpiDown64, pg8::MoeOrder<4>, true, true>(lds, g, S, E);
        } SEAM(pb + 9);
        if (IN(pb + 10)) { FT(); ph_combine(args, Xin, (const bf16*)(args.W() + WS_XA), Xout, (l + 1 < NLAYER) ? args.I(1) + (size_t)(l + 1) * DM : nullptr, gw, NGW, lane); }
        if (l + 1 < NLAYER) SEAM(pb + 10);
    }

__global__ void __launch_bounds__(NTHR, 2) fwd_kernel(Args args_k) {
    extern __shared__ __attribute__((aligned(16))) unsigned char lds_raw[];
    LAS unsigned char* lds = (LAS unsigned char*)lds_raw;
    const int G = gridDim.x, bid = blockIdx.x, NGW = G * NWAVES;
    for (int u = threadIdx.x; u < (LDS_BYTES - LDSCTL_OFF) / 4; u += NTHR) ((LAS unsigned*)(lds + LDSCTL_OFF))[u] = 0u;
    __syncthreads();
#if SINGLE_LAUNCH
    unsigned* barw = (unsigned*)(args_k.ws + WS_CTL) + CW_BAR; unsigned bark = 0u;
#endif
    const int lo = args_k.ph_lo, hi = args_k.ph_hi;

    if (IN(0)) { FT(); ph_prologue(args, lds, gw, NGW, wave, lane); } SEAM(0);
    if (IN(1)) { FT(); ph_norm0(args, gw, NGW, lane); } SEAM(1);

    run_layer<0>(args_k, lds, lo, hi, G, bid, NGW BARARG);
    run_layer<1>(args_k, lds, lo, hi, G, bid, NGW BARARG);
#undef IN
#undef SEAM
}

extern "C" void kernel_launch(void* const* d_in, const int* in_sizes, int n_in, void* d_out, int out_size, void* d_ws, size_t ws_size, hipStream_t stream) {
    static int grid = 0;
    if (grid == 0) {
        if (n_in != 25 || in_sizes[0] != NT * DM || out_size != NT * DM || ws_size < WS_END) {
            fprintf(stderr, "kernel_launch: unexpected problem (n_in %d, in0 %d, out %d, ws %zu < %zu); nothing launched\n", n_in, n_in > 0 ? in_sizes[0] : -1, out_size, ws_size, (size_t)WS_END); grid = -1; return; }
        int dev = 0, cus = 0, per_cu = 0;
        if (hipGetDevice(&dev) != hipSuccess || hipDeviceGetAttribute(&cus, hipDeviceAttributeMultiprocessorCount, dev) != hipSuccess) { grid = -1; return; }
        if (hipFuncSetAttribute((const void*)fwd_kernel, hipFuncAttributeMaxDynamicSharedMemorySize, LDS_BYTES) != hipSuccess) { fprintf(stderr, "kernel_launch: hipFuncSetAttribute failed\n"); grid = -1; return; }
        if (hipOccupancyMaxActiveBlocksPerMultiprocessor(&per_cu, (const void*)fwd_kernel, NTHR, LDS_BYTES) != hipSuccess || per_cu < 1)
            fprintf(stderr, "kernel_launch: note: occupancy query reports %d workgroups per CU\n", per_cu);
        (void)hipGetLastError();
        grid = cus;
    }
    if (grid < 0) return;
    if (hipMemsetAsync((char*)d_ws + WS_CTL, 0, CTL_ZERO_BYTES, stream) != hipSuccess) { fprintf(stderr, "kernel_launch: memset failed\n"); return; }
    Args a{};
    for (int i = 0; i < 25; ++i) a.in[i] = (const float*)d_in[i];
    a.out = (float*)d_out; a.ws = (unsigned char*)d_ws;
#if SINGLE_LAUNCH
    a.ph_lo = 0; a.ph_hi = NPH;
    hipLaunchKernelGGL(fwd_kernel, dim3(grid), dim3(NTHR), LDS_BYTES, stream, a);
#else
    for (int ph = 0; ph < NPH; ++ph) { a.ph_lo = ph; a.ph_hi = ph + 1; hipLaunchKernelGGL(fwd_kernel, dim3(grid), dim3(NTHR), LDS_BYTES, stream, a); }
#endif
}
```

```cpp
#include <hip/hip_runtime.h>
#include <cstdio>
#include <cstdint>
#include <cstddef>
namespace pg8 {
#define PG8_LAS __attribute__((address_space(3)))
#define PG8_GAS __attribute__((address_space(1)))
typedef unsigned short bf16_t;
typedef short bf16x8 __attribute__((ext_vector_type(8)));
typedef float f32x4 __attribute__((ext_vector_type(4)));
typedef unsigned u32x4 __attribute__((ext_vector_type(4)));
constexpr int BM = 256, BK = 64, HALF = 128, HTB = HALF * BK * 2  , STAGE_BYTES = 8 * HTB, NXCD = 8, WGM = 8;

__host__ __device__ __forceinline__ int lds_byte(int r, int c) { const int st = (r >> 4) * 2 + (c >> 5), rr = r & 15, cc = c & 31, ob = rr * 64 + cc * 2; return st * 1024 + (ob ^ (((ob >> 9) & 1) << 5)); }
__host__ __device__ __forceinline__ void stage_rc(int b, int& R, int& C) { const int st = b / 1024, sb = b % 1024, swz = sb ^ (((sb >> 9) & 1) << 5); R = (st >> 1) * 16 + swz / 64; C = (st & 1) * 32 + (swz % 64) / 2; }
__host__ __device__ __forceinline__ int perm32(int rho) { const int n = rho >> 4, i = rho & 15; return 8 * (i >> 2) + 4 * n + (i & 3); }

struct Unit { int pm, pn; };
struct Gemm { const bf16_t* A; const bf16_t* Bt; int M, N, K; };

struct StaticOrder {
    static constexpr bool GATHER = false; const PG8_LAS int* rowtab = nullptr;
    int nM, nN, nwg, G, c;
    __host__ __device__ void init(int M, int N, int G_, int c_) { nM = M / BM; nN = N / BM; nwg = nM * nN; G = G_; c = c_; }
    __host__ __device__ bool next(int i, Unit& u) const {
        const long L = (long)i * G + c; if (L >= nwg) return false;
        int wgid = (int)L; { const int q = nwg / NXCD, r = nwg % NXCD, xcd = wgid % NXCD, off = wgid / NXCD; wgid = (xcd < r ? xcd * (q + 1) : r * (q + 1) + (xcd - r) * q) + off; }
        const int nig = WGM * nN, gid = wgid / nig, fm = gid * WGM, gsz = (nM - fm) < WGM ? (nM - fm) : WGM;
        u.pm = fm + ((wgid % nig) % gsz); u.pn = (wgid % nig) / gsz; return true;
    }
    __device__ __forceinline__ void a_ready(const Unit&) const {}
    __device__ __forceinline__ void done(const Unit&) const {}
};

__device__ __forceinline__ unsigned cvt_pk_bf16(float lo, float hi) { unsigned r; asm volatile("v_cvt_pk_bf16_f32 %0, %1, %2" : "=v"(r) : "v"(lo), "v"(hi)); return r; }

struct EpiBf16Plain {
    static constexpr bool PERM = true, AFTER_DRAIN = false, B64 = false;
    bf16_t* O; int ldc;
    __device__ __forceinline__ void operator()(const f32x4 (&acc)[2][2][4][2], const Unit& u, int wr, int wc, int fr, int fq) const {
        const int row0 = u.pm * BM + wr * 64 + fr, col0 = u.pn * BM + wc * 32 + 8 * fq;
#pragma unroll
        for (int ai = 0; ai < 2; ++ai)
#pragma unroll
            for (int m = 0; m < 4; ++m) { bf16_t* rowp = O + (size_t)(row0 + ai * HALF + m * 16) * ldc + col0;
#pragma unroll
                for (int bj = 0; bj < 2; ++bj) { const f32x4 v0 = acc[ai][bj][m][0], v1 = acc[ai][bj][m][1];
                    u32x4 w; w.x = cvt_pk_bf16(v0[0], v0[1]); w.y = cvt_pk_bf16(v0[2], v0[3]); w.z = cvt_pk_bf16(v1[0], v1[1]); w.w = cvt_pk_bf16(v1[2], v1[3]);
                    *(PG8_GAS u32x4*)(rowp + bj * HALF) = w; } }
    }
};
struct EpiResF32 {
    static constexpr bool PERM = false, AFTER_DRAIN = false, B64 = false;
    const float* base; float* out; int ldc;
    __device__ __forceinline__ void operator()(const f32x4 (&acc)[2][2][4][2], const Unit& u, int wr, int wc, int fr, int fq) const {
        const int row0 = u.pm * BM + wr * 64 + fr, col0 = u.pn * BM + wc * 32 + 4 * fq;
#pragma unroll
        for (int ai = 0; ai < 2; ++ai)
#pragma unroll
            for (int m = 0; m < 4; ++m) { const size_t off = (size_t)(row0 + ai * HALF + m * 16) * ldc + col0;
#pragma unroll
                for (int bj = 0; bj < 2; ++bj)
#pragma unroll
                    for (int n = 0; n < 2; ++n) { const f32x4 b = *(const f32x4*)(base + off + bj * HALF + n * 16); *(PG8_GAS f32x4*)(out + off + bj * HALF + n * 16) = b + acc[ai][bj][m][n]; } }
    }
};
struct EpiSwiglu {
    static constexpr bool PERM = true, AFTER_DRAIN = false, B64 = false;
    bf16_t* O; const float* bgu;
    __device__ __forceinline__ void operator()(const f32x4 (&acc)[2][2][4][2], const Unit& u, int wr, int wc, int fr, int fq) const {
        const int e = u.pn >> 3, pnl = u.pn & 7;
        const int row0 = u.pm * BM + wr * 64 + fr, gcol = pnl * 128 + wc * 32 + 8 * fq;
        const float* bg = bgu + (size_t)e * 2048 + gcol;
        f32x4 bgv[2], buv[2];
#pragma unroll
        for (int n = 0; n < 2; ++n) { bgv[n] = *(const PG8_GAS f32x4*)(bg + 4 * n); buv[n] = *(const PG8_GAS f32x4*)(bg + 1024 + 4 * n); }
#pragma unroll
        for (int ai = 0; ai < 2; ++ai)
#pragma unroll
            for (int m = 0; m < 4; ++m) { bf16_t* rowp = O + (size_t)(row0 + ai * HALF + m * 16) * 1024 + gcol;
                float r[8];
#pragma unroll
                for (int n = 0; n < 2; ++n) { const f32x4 gv = acc[ai][0][m][n] + bgv[n], uv = acc[ai][1][m][n] + buv[n];
#pragma unroll
                    for (int j = 0; j < 4; ++j) { const float g = fminf(gv[j], 7.0f), up = fminf(fmaxf(uv[j], -7.0f), 7.0f);
                        const float sg = __builtin_amdgcn_rcpf(1.0f + __expf(-1.702f * g)); r[n * 4 + j] = (up + 1.0f) * g * sg; } }
                u32x4 w; w.x = cvt_pk_bf16(r[0], r[1]); w.y = cvt_pk_bf16(r[2], r[3]); w.z = cvt_pk_bf16(r[4], r[5]); w.w = cvt_pk_bf16(r[6], r[7]);
                *(PG8_GAS u32x4*)rowp = w; }
    }
};
struct EpiDown {
    static constexpr bool PERM = true, AFTER_DRAIN = false, B64 = false;
    bf16_t* O; const float* bd;
    __device__ __forceinline__ void operator()(const f32x4 (&acc)[2][2][4][2], const Unit& u, int wr, int wc, int fr, int fq) const {
        const int e = u.pn >> 2, pnl = u.pn & 3;
        const int row0 = u.pm * BM + wr * 64 + fr, col0 = pnl * BM + wc * 32 + 8 * fq;
        const float* bp = bd + (size_t)e * 1024 + col0;
        f32x4 bv[2][2];
#pragma unroll
        for (int bj = 0; bj < 2; ++bj)
#pragma unroll
            for (int n = 0; n < 2; ++n) bv[bj][n] = *(const PG8_GAS f32x4*)(bp + bj * HALF + 4 * n);
#pragma unroll
        for (int ai = 0; ai < 2; ++ai)
#pragma unroll
            for (int m = 0; m < 4; ++m) { bf16_t* rowp = O + (size_t)(row0 + ai * HALF + m * 16) * 1024 + col0;
#pragma unroll
                for (int bj = 0; bj < 2; ++bj) { const f32x4 v0 = acc[ai][bj][m][0] + bv[bj][0], v1 = acc[ai][bj][m][1] + bv[bj][1];
                    u32x4 w; w.x = cvt_pk_bf16(v0[0], v0[1]); w.y = cvt_pk_bf16(v0[2], v0[3]); w.z = cvt_pk_bf16(v1[0], v1[1]); w.w = cvt_pk_bf16(v1[2], v1[3]);
                    *(PG8_GAS u32x4*)(rowp + bj * HALF) = w; } }
    }
};
struct EpiDown64 {
    static constexpr bool PERM = true, AFTER_DRAIN = false, B64 = true;
    bf16_t* O; const float* bd;
    __device__ __forceinline__ void operator()(const f32x4 (&acc)[2][2][4][2], const Unit& u, int wr, int wc, int fr, int fq) const {
        const int e = u.pn >> 2, pnl = u.pn & 3;
        const int row0 = u.pm * BM + wr * 64 + fr, col0 = pnl * BM + wc * 64 + 8 * fq;
        const float* bp = bd + (size_t)e * 1024 + col0;
        f32x4 bv[2][2];
#pragma unroll
        for (int bj = 0; bj < 2; ++bj)
#pragma unroll
            for (int n = 0; n < 2; ++n) bv[bj][n] = *(const PG8_GAS f32x4*)(bp + bj * 32 + 4 * n);
#pragma unroll
        for (int ai = 0; ai < 2; ++ai)
#pragma unroll
            for (int m = 0; m < 4; ++m) { bf16_t* rowp = O + (size_t)(row0 + ai * HALF + m * 16) * 1024 + col0;
#pragma unroll
                for (int bj = 0; bj < 2; ++bj) { const f32x4 v0 = acc[ai][bj][m][0] + bv[bj][0], v1 = acc[ai][bj][m][1] + bv[bj][1];
                    u32x4 w; w.x = cvt_pk_bf16(v0[0], v0[1]); w.y = cvt_pk_bf16(v0[2], v0[3]); w.z = cvt_pk_bf16(v1[0], v1[1]); w.w = cvt_pk_bf16(v1[2], v1[3]);
                    *(PG8_GAS u32x4*)(rowp + bj * 32) = w; } }
    }
};
struct EpiBf16Plain64 {
    static constexpr bool PERM = true, AFTER_DRAIN = false, B64 = true;
    bf16_t* O; int ldc;
    __device__ __forceinline__ void operator()(const f32x4 (&acc)[2][2][4][2], const Unit& u, int wr, int wc, int fr, int fq) const {
        const int row0 = u.pm * BM + wr * 64 + fr, col0 = u.pn * BM + wc * 64 + 8 * fq;
#pragma unroll
        for (int ai = 0; ai < 2; ++ai)
#pragma unroll
            for (int m = 0; m < 4; ++m) { bf16_t* rowp = O + (size_t)(row0 + ai * HALF + m * 16) * ldc + col0;
#pragma unroll
                for (int bj = 0; bj < 2; ++bj) { const f32x4 v0 = acc[ai][bj][m][0], v1 = acc[ai][bj][m][1];
                    u32x4 w; w.x = cvt_pk_bf16(v0[0], v0[1]); w.y = cvt_pk_bf16(v0[2], v0[3]); w.z = cvt_pk_bf16(v1[0], v1[1]); w.w = cvt_pk_bf16(v1[2], v1[3]);
                    *(PG8_GAS u32x4*)(rowp + bj * 32) = w; } }
    }
};
template <int NPN, bool GATHER_ = false> struct MoeOrder {
    static constexpr bool GATHER = GATHER_;
    int ntiles, G, c; const PG8_LAS int* texp; const PG8_LAS int* rowtab = nullptr;
    __device__ __forceinline__ bool next(int i, Unit& u) const {
        constexpr int MT = 32 / NPN; int mt, pn;
        if (G == 256) { const int chunk = i * 8 + (c & 7), r = c >> 3; pn = r / MT; mt = chunk * MT + (r % MT); }
        else { const int L = i * G + c; mt = L / NPN; pn = L % NPN; }
        mt = __builtin_amdgcn_readfirstlane(mt); if (mt >= ntiles) return false;
        const int e = __builtin_amdgcn_readfirstlane(texp[mt]);
        u.pm = mt; u.pn = e * NPN + pn; return true;
    }
    __device__ __forceinline__ void a_ready(const Unit&) const {}
    __device__ __forceinline__ void done(const Unit&) const {}
};

template <class Epi, class Sched, bool ALIGN_EPI = false, bool SP2 = false>
__device__ __forceinline__ void gemm_phase(PG8_LAS unsigned char* lds, const Gemm g, const Sched& S, const Epi& E) {
    int tid_ = threadIdx.x; asm volatile("" : "+v"(tid_));
    const int tid = tid_, wid = __builtin_amdgcn_readfirstlane(tid >> 6), lane = tid & 63, wr = wid >> 2, wc = wid & 3, fr = lane & 15, fq = lane >> 4;
    const int K = g.K, nt = K / BK;
    constexpr bool GA = Sched::GATHER;
    static_assert(!GA || SP2, "gathered A rows: SP2 loop only");
    unsigned voffA[2], voffB[2]; int RA[2], CA2[2];
#pragma unroll
    for (int i = 0; i < 2; ++i) { int R, C; stage_rc(tid * 16 + i * 8192, R, C); RA[i] = R; CA2[i] = C * 2; const int Rb = Epi::B64 ? ((R >> 5) * 64 + perm32(R & 31)) : (Epi::PERM ? ((R & ~31) + perm32(R & 31)) : R);
        voffA[i] = (unsigned)(R * K + C) * 2u; voffB[i] = (unsigned)(Rb * K + C) * 2u; }
    const size_t kstep = (size_t)(BK * 2);
    const size_t hstep = (size_t)HALF * K * 2;
    const size_t tstep = 2 * hstep;
    const size_t hstepB = Epi::B64 ? (size_t)32 * K * 2 : hstep;
    const unsigned ldsw = (unsigned)wid * 1024u;
    const int aoff = lds_byte(wr * 64 + fr, fq * 8), boff = lds_byte(wc * 32 + fr, fq * 8);
#define PG8_SA(b, h) (((b) * 2 + (h)) * HTB)
#define PG8_SB(b, h) ((4 + (b) * 2 + (h)) * HTB)
#define PG8_STAGE(bufoff, gbase, voff) do { _Pragma("unroll") for (int _i = 0; _i < 2; ++_i) \
        __builtin_amdgcn_global_load_lds((const unsigned*)((const char*)(gbase) + (voff)[_i]), (PG8_LAS unsigned*)(lds + (bufoff) + ldsw + _i * 8192), 16, 0, 0); } while (0)
#define PG8_STAGE_A(bufoff, ptr, h, V) do { if constexpr (GA) PG8_STAGE(bufoff, ptr, V[h]); else PG8_STAGE(bufoff, (ptr) + (h) * hstep, voffA); } while (0)
#define PG8_ROWOFF(V, uidx) do { _Pragma("unroll") for (int h_ = 0; h_ < 2; ++h_) _Pragma("unroll") for (int i_ = 0; i_ < 2; ++i_) V[h_][i_] = (unsigned)S.rowtab[(uidx) * 256 + h_ * 128 + RA[i_]] * (unsigned)(K * 2) + (unsigned)CA2[i_]; } while (0)
#define PG8_LDA(dst, b, h) do { _Pragma("unroll") for (int m = 0; m < 4; ++m) _Pragma("unroll") for (int k = 0; k < 2; ++k) dst[m][k] = *(const PG8_LAS bf16x8*)(lds + PG8_SA(b, h) + aoff + m * 2048 + k * 1024); } while (0)
#define PG8_LDB(dst, b, h) do { _Pragma("unroll") for (int n = 0; n < 2; ++n) _Pragma("unroll") for (int k = 0; k < 2; ++k) dst[n][k] = *(const PG8_LAS bf16x8*)(lds + PG8_SB(b, h) + boff + n * 2048 + k * 1024); } while (0)
#define PG8_MMA(ai, bj, At, Bt) do { __builtin_amdgcn_s_setprio(1); _Pragma("unroll") for (int m = 0; m < 4; ++m) _Pragma("unroll") for (int n = 0; n < 2; ++n) _Pragma("unroll") for (int k = 0; k < 2; ++k) \
        acc[ai][bj][m][n] = __builtin_amdgcn_mfma_f32_16x16x32_bf16(Bt[n][k], At[m][k], acc[ai][bj][m][n], 0, 0, 0); __builtin_amdgcn_s_setprio(0); } while (0)
#define PG8_WAIT_V(n) asm volatile("s_waitcnt vmcnt(" #n ")" ::: "memory")
#define PG8_WAIT_L(n) asm volatile("s_waitcnt lgkmcnt(" #n ")" ::: "memory")
#define PG8_BAR __builtin_amdgcn_s_barrier()
#define PG8_SCHED __builtin_amdgcn_sched_barrier(0)
    Unit cur, nxt; int ui = 0;
    if (!S.next(0, cur)) return;
    f32x4 acc[2][2][4][2];
#pragma unroll
    for (int a = 0; a < 2; ++a)
#pragma unroll
        for (int b = 0; b < 2; ++b)
#pragma unroll
            for (int m = 0; m < 4; ++m)
#pragma unroll
                for (int n = 0; n < 2; ++n) acc[a][b][m][n] = (f32x4){0.f, 0.f, 0.f, 0.f};
    bf16x8 At[4][2], B0[2][2], B1[2][2];
    const char* cA = (const char*)g.A + (GA ? (size_t)0 : (size_t)cur.pm * tstep); const char* cB = (const char*)g.Bt + (size_t)cur.pn * tstep;
    unsigned vAc[2][2] = {{0u, 0u}, {0u, 0u}}, vAn[2][2] = {{0u, 0u}, {0u, 0u}};
    if constexpr (GA) { PG8_ROWOFF(vAc, 0); }
    S.a_ready(cur);
    if constexpr (SP2) {
        PG8_STAGE(PG8_SB(0, 0), cB, voffB); PG8_STAGE(PG8_SB(0, 1), cB + hstepB, voffB); PG8_STAGE_A(PG8_SA(0, 0), cA, 0, vAc); PG8_STAGE_A(PG8_SA(0, 1), cA, 1, vAc);
        if (wr == 1) PG8_BAR;
        PG8_WAIT_V(2); PG8_BAR;
        PG8_STAGE(PG8_SB(1, 0), cB + kstep, voffB); PG8_STAGE_A(PG8_SA(1, 0), cA + kstep, 0, vAc); PG8_STAGE(PG8_SB(1, 1), cB + hstepB + kstep, voffB);
        PG8_WAIT_V(6); PG8_BAR;
    } else {
        PG8_STAGE(PG8_SB(0, 0), cB, voffB); PG8_STAGE(PG8_SA(0, 0), cA, voffA); PG8_STAGE(PG8_SB(0, 1), cB + hstepB, voffB); PG8_STAGE(PG8_SA(0, 1), cA + hstep, voffA);
        if (wr == 1) PG8_BAR;
        PG8_WAIT_V(4); PG8_BAR;
        PG8_STAGE(PG8_SB(1, 0), cB + kstep, voffB); PG8_STAGE(PG8_SA(1, 0), cA + kstep, voffA); PG8_STAGE(PG8_SB(1, 1), cB + hstepB + kstep, voffB);
        PG8_WAIT_V(6); PG8_BAR;
    }
    for (;;) {
        const bool has_next = S.next(ui + 1, nxt);
        const char* nA = (has_next && !GA) ? (const char*)g.A + (size_t)nxt.pm * tstep : cA; const char* nB = has_next ? (const char*)g.Bt + (size_t)nxt.pn * tstep : cB;
        for (int t = 0; t < nt; t += 2) {
            const bool last = (t == nt - 2);
            const char* a1 = cA + (size_t)(t + 1) * kstep;
            const char* a2 = last ? nA : cA + (size_t)(t + 2) * kstep; const char* b2 = last ? nB : cB + (size_t)(t + 2) * kstep;
            const char* a3 = a2 + kstep; const char* b3 = b2 + kstep;
            if (last && has_next) S.a_ready(nxt);
            unsigned v2[2][2] = {{0u, 0u}, {0u, 0u}};
            if constexpr (GA) { if (last) { if (has_next) { PG8_ROWOFF(vAn, ui + 1); } else {
#pragma unroll
                        for (int h_ = 0; h_ < 2; ++h_) { vAn[h_][0] = vAc[h_][0]; vAn[h_][1] = vAc[h_][1]; } } }
#pragma unroll
                for (int h_ = 0; h_ < 2; ++h_) { v2[h_][0] = last ? vAn[h_][0] : vAc[h_][0]; v2[h_][1] = last ? vAn[h_][1] : vAc[h_][1]; } }
            if constexpr (SP2) {
            PG8_LDB(B0, 0, 0); PG8_LDB(B1, 0, 1); PG8_SCHED; PG8_LDA(At, 0, 0); PG8_STAGE_A(PG8_SA(1, 1), a1, 1, vAc);
            PG8_WAIT_V(8); PG8_WAIT_L(0); PG8_BAR; PG8_MMA(0, 0, At, B0); PG8_MMA(0, 1, At, B1); PG8_BAR; PG8_SCHED;
            PG8_LDA(At, 0, 1); PG8_STAGE(PG8_SB(0, 0), b2, voffB); PG8_STAGE(PG8_SB(0, 1), b2 + hstepB, voffB); PG8_STAGE_A(PG8_SA(0, 0), a2, 0, v2);
            PG8_WAIT_V(8); PG8_WAIT_L(0); PG8_BAR; PG8_MMA(1, 0, At, B0); PG8_MMA(1, 1, At, B1); PG8_BAR; PG8_SCHED;
            PG8_LDB(B0, 1, 0); PG8_LDB(B1, 1, 1); PG8_SCHED; PG8_LDA(At, 1, 0); PG8_STAGE_A(PG8_SA(0, 1), a2, 1, v2);
            PG8_WAIT_V(8); PG8_WAIT_L(0); PG8_BAR; PG8_MMA(0, 0, At, B0); PG8_MMA(0, 1, At, B1); PG8_BAR; PG8_SCHED;
            PG8_LDA(At, 1, 1); PG8_STAGE(PG8_SB(1, 0), b3, voffB); PG8_STAGE(PG8_SB(1, 1), b3 + hstepB, voffB); PG8_STAGE_A(PG8_SA(1, 0), a3, 0, v2);
            PG8_WAIT_V(8); PG8_WAIT_L(0); PG8_BAR; PG8_MMA(1, 0, At, B0); PG8_MMA(1, 1, At, B1); PG8_BAR; PG8_SCHED;
            } else {
            PG8_LDB(B0, 0, 0); PG8_SCHED; PG8_LDA(At, 0, 0); PG8_STAGE(PG8_SA(1, 1), a1 + hstep, voffA);
            PG8_WAIT_L(8); PG8_BAR; PG8_WAIT_L(0); PG8_MMA(0, 0, At, B0); PG8_BAR; PG8_SCHED;
            PG8_LDB(B1, 0, 1); PG8_STAGE(PG8_SB(0, 0), b2, voffB);
            PG8_BAR; PG8_WAIT_L(0); PG8_MMA(0, 1, At, B1); PG8_BAR;
            PG8_LDA(At, 0, 1); PG8_STAGE(PG8_SA(0, 0), a2, voffA);
            PG8_BAR; PG8_WAIT_L(0); PG8_MMA(1, 0, At, B0); PG8_BAR; PG8_SCHED;
            PG8_STAGE(PG8_SB(0, 1), b2 + hstepB, voffB);
            PG8_WAIT_V(6); PG8_BAR; PG8_MMA(1, 1, At, B1); PG8_BAR;
            PG8_LDB(B0, 1, 0); PG8_SCHED; PG8_LDA(At, 1, 0); PG8_STAGE(PG8_SA(0, 1), a2 + hstep, voffA);
            PG8_WAIT_L(8); PG8_BAR; PG8_WAIT_L(0); PG8_MMA(0, 0, At, B0); PG8_BAR; PG8_SCHED;
            PG8_LDB(B1, 1, 1); PG8_STAGE(PG8_SB(1, 0), b3, voffB);
            PG8_BAR; PG8_WAIT_L(0); PG8_MMA(0, 1, At, B1); PG8_BAR;
            PG8_LDA(At, 1, 1); PG8_STAGE(PG8_SA(1, 0), a3, voffA);
            PG8_BAR; PG8_WAIT_L(0); PG8_MMA(1, 0, At, B0); PG8_BAR; PG8_SCHED;
            PG8_STAGE(PG8_SB(1, 1), b3 + hstepB, voffB);
            PG8_WAIT_V(6); PG8_BAR; PG8_MMA(1, 1, At, B1); PG8_BAR;
            }
        }
        if constexpr (ALIGN_EPI) { if (wr == 0) PG8_BAR; }
        if constexpr (!Epi::AFTER_DRAIN) { E(acc, cur, wr, wc, fr, fq); S.done(cur); }
        if (!has_next) break;
#pragma unroll
        for (int a = 0; a < 2; ++a)
#pragma unroll
            for (int b = 0; b < 2; ++b)
#pragma unroll
                for (int m = 0; m < 4; ++m)
#pragma unroll
                    for (int n = 0; n < 2; ++n) acc[a][b][m][n] = (f32x4){0.f, 0.f, 0.f, 0.f};
        cur = nxt; cA = nA; cB = nB; ++ui;
        if constexpr (GA) {
#pragma unroll
            for (int h_ = 0; h_ < 2; ++h_) { vAc[h_][0] = vAn[h_][0]; vAc[h_][1] = vAn[h_][1]; } }
        if constexpr (ALIGN_EPI) { if (wr == 1) PG8_BAR; }
    }
    PG8_WAIT_V(0);
    if constexpr (!ALIGN_EPI) { if (wr == 0) PG8_BAR; }
    PG8_BAR;
    if constexpr (Epi::AFTER_DRAIN) { E.fused(acc, cur, wr, wc, fr, fq, lds, wid, lane); S.done(cur); }
#undef PG8_SA
#undef PG8_SB
#undef PG8_STAGE
#undef PG8_STAGE_A
#undef PG8_ROWOFF
#undef PG8_LDA
#undef PG8_LDB
#undef PG8_MMA
#undef PG8_WAIT_V
#undef PG8_WAIT_L
#undef PG8_BAR
#undef PG8_SCHED
}
}


#define GAS __attribute__((address_space(1)))
typedef unsigned short bf16;
typedef float f32x4 __attribute__((ext_vector_type(4)));
typedef unsigned u32x4 __attribute__((ext_vector_type(4)));
typedef unsigned u32x2 __attribute__((ext_vector_type(2)));
typedef short bf16x8 __attribute__((ext_vector_type(8)));
typedef float f32x16 __attribute__((ext_vector_type(16)));

#ifndef SINGLE_LAUNCH
#define SINGLE_LAUNCH 1
#endif

constexpr int NB = 8, SEQ = 2048, DM = 1024, NT = NB * SEQ, NLAYER = 2;
constexpr int DIN = 3220, NP = 3328;
constexpr int C_Q = 0, C_K = 512, C_V = 1024, C_Z = 1536, C_NQ = 2048, C_KV = 2304, C_CU = 2688, C_A = 3200, C_B = 3204, C_G = 3208;
constexpr int NE = 32, MAXT = 288;
constexpr int NWAVES = 8, NTHR = 512;
constexpr float EPS = 1e-6f;

constexpr size_t MiB = 1u << 20;
constexpr size_t WS_CTL = 0, CTL_ZERO_BYTES = 4096;
constexpr size_t WS_BT = 1 * MiB;
constexpr size_t WS_KCMP = 1 * MiB + 256 * 1024, WS_VCMP = 1 * MiB + 512 * 1024;
constexpr size_t WS_G = 2 * MiB, WS_BETA = 2 * MiB + 256 * 1024, WS_GC = 2 * MiB + 512 * 1024;
constexpr size_t WS_EIDX = 3 * MiB, WS_EPOS = 3 * MiB + 256 * 1024, WS_EW = 3 * MiB + 512 * 1024, WS_SLOT = 3 * MiB + 768 * 1024;
constexpr size_t WS_WIN = 4 * MiB;
constexpr size_t WS_WOUT = 17 * MiB;
constexpr size_t WS_WGU = 22 * MiB;
constexpr size_t WS_WD = 278 * MiB;
constexpr size_t WS_XA = 406 * MiB, WS_XB = 470 * MiB;
constexpr size_t WS_XN = 534 * MiB;
constexpr size_t WS_P = 566 * MiB;
constexpr size_t WS_QN = 670 * MiB, WS_KN = 686 * MiB, WS_VC = 702 * MiB;
constexpr size_t WS_U = 718 * MiB, WS_W = 750 * MiB;
constexpr size_t WS_ATT = 782 * MiB;
constexpr size_t WS_O = 798 * MiB;
constexpr size_t WS_NQ = 830 * MiB;
constexpr size_t WS_KS = 846 * MiB, WS_KW = 848 * MiB;
constexpr size_t WS_Y = 850 * MiB;
constexpr size_t WS_XS = 882 * MiB, WS_ACT = 1026 * MiB, WS_YS = 1170 * MiB;
constexpr size_t WS_KT = 1314 * MiB, WS_VT = 1330 * MiB;
constexpr size_t WS_W1T = 1346 * MiB;
constexpr size_t WS_POSW = 1349 * MiB;
constexpr size_t WS_RWH = 1350 * MiB, WS_RWL = 1351 * MiB;
constexpr size_t WS_END = 1352 * MiB;

constexpr int CW_TMO = 0, CW_BAR = 64, CW_CNT = 512;

constexpr int RING_BYTES = 131072;
constexpr int LDSCTL_OFF = RING_BYTES, MISC_OFF = LDSCTL_OFF, TS_OFF = LDSCTL_OFF + 128, TE_OFF = LDSCTL_OFF + 320;
constexpr int LDS_BYTES = 147456;
static_assert(TE_OFF + MAXT * 4 + 64 <= LDSCTL_OFF + 2048 && LDSCTL_OFF + 2048 + 10 * 1024 <= LDS_BYTES, "LDS map");

#define XB_TMO      128
#define XB_XCNT(j)  (256  + 64 * (j))
#define XB_XSUB(j)  (1280 + 64 * (j))
#define XB_XGEN(j)  (2304 + 64 * (j))
#define XB_TOP      3328
#define XB_TOPGEN   3392
#define XCD_BAR_WORDS 3456
#define XB_SPIN_CAP (1u << 22)
#define LAS __attribute__((address_space(3)))

__device__ __forceinline__ unsigned xb_ld(unsigned* p)              { return __hip_atomic_load(p, __ATOMIC_RELAXED, __HIP_MEMORY_SCOPE_AGENT); }
__device__ __forceinline__ unsigned xb_add(unsigned* p, unsigned v) { return __hip_atomic_fetch_add(p, v, __ATOMIC_RELAXED, __HIP_MEMORY_SCOPE_AGENT); }
__device__ __forceinline__ unsigned xb_xcc_id() { return (unsigned)__builtin_amdgcn_s_getreg((3 << 11) | 20) & 0xFu; }
#define XB_SPIN(cond, bar) do { unsigned _sp = 0; while (cond) { __builtin_amdgcn_s_sleep(1); \
    if ((++_sp & 255u) == 0u) { if (xb_ld(&(bar)[XB_TMO])) break; if (_sp > XB_SPIN_CAP) { atomicAdd(&(bar)[XB_TMO], 1u); break; } } } } while (0)

struct XcdBarrier {
    unsigned* bar; unsigned x;
    volatile LAS unsigned* st;
};

__device__ __forceinline__ XcdBarrier xcd_barrier_post(unsigned* bar, volatile LAS unsigned* st) {
    XcdBarrier b; b.bar = bar; b.x = xb_xcc_id(); b.st = st;
    if (threadIdx.x == 0) (void)xb_add(&bar[XB_XCNT(b.x)], 1u);
    return b;
}
__device__ __forceinline__ void xcd_barrier_complete(unsigned* bar, unsigned x, unsigned& nloc, unsigned& nx) {
    const unsigned G = gridDim.x * gridDim.y * gridDim.z;
    unsigned sum, cnt, mine, sp = 0u;
    for (;;) {
        sum = 0u; cnt = 0u; mine = 0u;
#pragma unroll
        for (unsigned j = 0; j < 16; ++j) { const unsigned c = xb_ld(&bar[XB_XCNT(j)]); sum += c; cnt += (c > 0u) ? 1u : 0u; mine = (j == x) ? c : mine; }
        if (sum == G) break;
        __builtin_amdgcn_s_sleep(1);
        if ((++sp & 255u) == 0u) { if (xb_ld(&bar[XB_TMO])) break; if (sp > XB_SPIN_CAP) { atomicAdd(&bar[XB_TMO], 1u); break; } }
    }
    nloc = mine > 0u ? mine : 1u; nx = cnt > 0u ? cnt : 1u;
}

__device__ __forceinline__ void xcd_barrier(const XcdBarrier& b) {
    asm volatile("s_waitcnt vmcnt(0)" ::: "memory");
    __syncthreads();
    if (threadIdx.x == 0) {
        unsigned* bar = b.bar;
        __builtin_amdgcn_s_waitcnt(0);
        unsigned nloc = b.st[0], nx = b.st[1];
        if (nloc == 0u) { xcd_barrier_complete(bar, b.x, nloc, nx); b.st[0] = nloc; b.st[1] = nx; }
        const unsigned old = xb_add(&bar[XB_XSUB(b.x)], 1u);
        const unsigned gen = old / nloc;
        if (old + 1u == (gen + 1u) * nloc) {
            __builtin_amdgcn_fence(__ATOMIC_RELEASE, "agent");
            asm volatile("s_waitcnt vmcnt(0)" ::: "memory");
            const unsigned og = xb_add(&bar[XB_TOP], 1u);
            const unsigned tg = og / nx;
            if (og + 1u == (tg + 1u) * nx) xb_add(&bar[XB_TOPGEN], 1u);
            else XB_SPIN(xb_ld(&bar[XB_TOPGEN]) == tg, bar);
            __builtin_amdgcn_fence(__ATOMIC_ACQUIRE, "agent");
            xb_add(&bar[XB_XGEN(b.x)], 1u);
            asm volatile("s_waitcnt vmcnt(0)" ::: "memory");
        } else {
            XB_SPIN(xb_ld(&bar[XB_XGEN(b.x)]) == gen, bar);
            __builtin_amdgcn_fence(__ATOMIC_ACQUIRE, "agent");
            asm volatile("s_waitcnt vmcnt(0)" ::: "memory");
        }
    }
    __syncthreads();
}


__device__ __forceinline__ void cnt_barrier(unsigned* cw, unsigned& k) {
    asm volatile("s_waitcnt vmcnt(0)" ::: "memory");
    __syncthreads();
    if (threadIdx.x == 0) {
        __builtin_amdgcn_fence(__ATOMIC_RELEASE, "agent");
        asm volatile("s_waitcnt vmcnt(0)" ::: "memory");
        const unsigned G = gridDim.x;
        const unsigned old = xb_add(cw, 1u);
        if (old == G * (k + 1u) - 1u) xb_add(cw + 64, 1u);
        else { unsigned sp = 0; while (xb_ld(cw + 64) == k) { __builtin_amdgcn_s_sleep(1);
                if ((++sp & 255u) == 0u) { if (xb_ld(cw + 128)) break; if (sp > XB_SPIN_CAP) { atomicAdd(cw + 128, 1u); break; } } } }
        __builtin_amdgcn_fence(__ATOMIC_ACQUIRE, "agent");
        asm volatile("s_waitcnt vmcnt(0)" ::: "memory");
    }
    ++k;
    __syncthreads();
}
__device__ __forceinline__ float bf_lo(unsigned w) { return __uint_as_float(w << 16); }
__device__ __forceinline__ float bf_hi(unsigned w) { return __uint_as_float(w & 0xffff0000u); }
__device__ __forceinline__ float bf2f(bf16 v) { return __uint_as_float(((unsigned)v) << 16); }
__device__ __forceinline__ unsigned f2bf(float f) { unsigned u = __float_as_uint(f); return (u + 0x7fffu + ((u >> 16) & 1u)) >> 16; }
__device__ __forceinline__ unsigned pk2(float lo, float hi) { return f2bf(lo) | (f2bf(hi) << 16); }
__device__ __forceinline__ float wave_sum(float v) {
#pragma unroll
    for (int o = 1; o < 64; o <<= 1) v += __shfl_xor(v, o);
    return v;
}
__device__ __forceinline__ float wave_max(float v) {
#pragma unroll
    for (int o = 1; o < 64; o <<= 1) v = fmaxf(v, __shfl_xor(v, o));
    return v;
}
__device__ __forceinline__ float sigmoidf_(float x) { return 1.0f / (1.0f + __expf(-x)); }
__device__ __forceinline__ float siluf_(float x) { return x / (1.0f + __expf(-x)); }
#define LDS_WAIT() asm volatile("s_waitcnt lgkmcnt(0)" ::: "memory")

struct Args { const float* in[25]; float* out; unsigned char* ws; int ph_lo, ph_hi; };
struct ArgsG { const GAS float* in[25]; GAS float* out; GAS unsigned char* ws;
    __device__ __forceinline__ const float* I(int i) const { return (const float*)in[i]; }
    __device__ __forceinline__ unsigned char* W() const { return (unsigned char*)ws; }
    __device__ __forceinline__ float* O() const { return (float*)out; } };

__device__ __forceinline__ int map_win(int n);
__device__ __forceinline__ int map_gu(int n);
template <int MAP>
__device__ __forceinline__ void transpose_item(const float* W, int K, int N, bf16* WT, LAS float* scr, int item, int nblk, int lane) {
    const int kb = item / nblk, nb = item % nblk, k0 = 64 * kb, n0 = 32 * nb;
    const int nd = n0 + (lane & 31); const int src = MAP == 1 ? map_win(nd) : (MAP == 2 ? map_gu(nd) : nd);
#pragma unroll 8
    for (int i = 0; i < 32; ++i) { const int kk = 2 * i + (lane >> 5); scr[kk * 33 + (lane & 31)] = src >= 0 ? W[(size_t)(k0 + kk) * N + src] : 0.0f; }
    LDS_WAIT();
    const int c = lane & 7;
#pragma unroll
    for (int j = 0; j < 4; ++j) { const int n = (lane >> 3) + 8 * j; const LAS float* s = scr + (8 * c) * 33 + n;
        u32x4 o; o.x = pk2(s[0 * 33], s[1 * 33]); o.y = pk2(s[2 * 33], s[3 * 33]); o.z = pk2(s[4 * 33], s[5 * 33]); o.w = pk2(s[6 * 33], s[7 * 33]);
        *(u32x4*)(WT + (size_t)(n0 + n) * K + k0 + 8 * c) = o; }
    LDS_WAIT();
}
__device__ __forceinline__ int map_win(int n) {
    if (n < 2048) return n;
    if (n < C_KV) return 2056 + (n - C_NQ);
    if (n < C_CU) return 2312 + (n - C_KV);
    if (n < C_A) return 2708 + (n - C_CU);
    if (n < C_B) return 2048 + (n - C_A);
    if (n < C_G) return 2052 + (n - C_B);
    if (n < C_G + 12) return 2696 + (n - C_G);
    return -1;
}
__device__ __forceinline__ int map_gu(int n) { const int pn = n >> 8, r = n & 255; return (r < 128 ? 0 : 1024) + 128 * pn + (r & 127); }

__device__ __forceinline__ void ph_prologue(const ArgsG& a, LAS unsigned char* lds, int gw, int NGW, int wave, int lane) {
    LAS float* scr = (LAS float*)(lds + wave * 16384);
    bf16* WinT = (bf16*)(a.W() + WS_WIN); bf16* WoutT = (bf16*)(a.W() + WS_WOUT); bf16* WguT = (bf16*)(a.W() + WS_WGU); bf16* WdT = (bf16*)(a.W() + WS_WD);
    constexpr int I_IN = 16 * (NP / 32), I_OUT = 16 * 32, I_GU = 16 * 64, I_D = 16 * 32;
    constexpr int N_IN = NLAYER * I_IN, N_OUT = NLAYER * I_OUT, N_GU = NLAYER * NE * I_GU, N_D = NLAYER * NE * I_D;
    for (int it = gw; it < N_IN + N_OUT + N_GU + N_D; it += NGW) {
        int r = it;
        if (r < N_IN) { const int l = r / I_IN; transpose_item<1>(a.I(2) + (size_t)l * DM * DIN, DM, DIN, WinT + (size_t)l * NP * DM, scr, r % I_IN, NP / 32, lane); continue; } r -= N_IN;
        if (r < N_OUT) { const int l = r / I_OUT; transpose_item<0>(a.I(16) + (size_t)l * DM * DM, DM, DM, WoutT + (size_t)l * DM * DM, scr, r % I_OUT, 32, lane); continue; } r -= N_OUT;
        if (r < N_GU) { const int le = r / I_GU; transpose_item<2>(a.I(20) + (size_t)le * DM * 2048, DM, 2048, WguT + (size_t)le * 2048 * DM, scr, r % I_GU, 64, lane); continue; } r -= N_GU;
        { const int le = r / I_D; transpose_item<0>(a.I(22) + (size_t)le * DM * DM, DM, DM, WdT + (size_t)le * DM * DM, scr, r % I_D, 32, lane); }
    }
    { bf16* W1T = (bf16*)(a.W() + WS_W1T);
        for (int it = gw; it < 4 * 128; it += NGW) { const int mtx = it >> 7; transpose_item<0>(a.I(10) + (size_t)mtx * 2048 * 128, 2048, 128, W1T + (size_t)mtx * 128 * 2048, scr, it & 127, 4, lane); }
        float* POSW = (float*)(a.W() + WS_POSW);
        const int id = gw * 64 + lane;
        if (id < 512) { const int mtx = id >> 7, n = id & 127; const float* w1 = a.I(10) + (size_t)mtx * 2048 * 128; const float* pos = a.I(9) + (size_t)mtx * 2048; float acc = 0.f;
            for (int k = 0; k < 2048; ++k) acc += pos[k] * w1[(size_t)k * 128 + n];
            POSW[id] = acc; } }
    { bf16* RWH = (bf16*)(a.W() + WS_RWH); bf16* RWL = (bf16*)(a.W() + WS_RWL);
        for (int i = gw * 64 + lane; i < NLAYER * NE * DM; i += NGW * 64) { const int d = i & (DM - 1), e = (i >> 10) & (NE - 1), l = i >> 15;
            const float w = a.I(18)[((size_t)l * DM + d) * NE + e]; const unsigned hi = f2bf(w); const float lo = w - __uint_as_float(hi << 16);
            RWH[i] = (bf16)hi; RWL[i] = (bf16)f2bf(lo); } }
    float* BT = (float*)(a.W() + WS_BT);
    for (int i = gw * 64 + lane; i < 4 * 2048; i += NGW * 64) {
        const int h = i >> 11, n = i & 2047; int bk;
        if (n < 16) bk = n; else { const float v = logf((float)n / 16.0f) / 2.0794415416798357f * 16.0f; bk = 16 + (int)v; bk = bk < 31 ? bk : 31; }
        BT[i] = a.I(24)[bk * 4 + h];
    }
}

__device__ __forceinline__ void rms_row_to_bf16(const f32x4 (&v)[4], const float* w, bf16* orow, int lane) {
    float s = 0.f;
#pragma unroll
    for (int j = 0; j < 4; ++j) s += (v[j].x * v[j].x + v[j].y * v[j].y) + (v[j].z * v[j].z + v[j].w * v[j].w);
    const float r = rsqrtf(wave_sum(s) * (1.0f / DM) + EPS);
#pragma unroll
    for (int j = 0; j < 4; ++j) { const f32x4 wv = *(const f32x4*)(w + 4 * (64 * j + lane)); const f32x4 y = v[j] * r * wv;
        u32x2 o; o.x = pk2(y.x, y.y); o.y = pk2(y.z, y.w); *(u32x2*)(orow + 4 * (64 * j + lane)) = o; }
}

__device__ __forceinline__ void ph_norm0(const ArgsG& a, int gw, int NGW, int lane) {
    bf16* XN = (bf16*)(a.W() + WS_XN);
    for (int tok = gw; tok < NT; tok += NGW) {
        f32x4 v[4];
#pragma unroll
        for (int j = 0; j < 4; ++j) v[j] = *(const f32x4*)(a.I(0) + (size_t)tok * DM + 4 * (64 * j + lane));
        rms_row_to_bf16(v, a.I(1), XN + (size_t)tok * DM, lane);
    }
}

__device__ __forceinline__ void ph_compress_mfma(const ArgsG& a, int l, LAS unsigned char* lds, int bid, int G, int tid, int wave, int lane) {
    LAS float* part = (LAS float*)lds;
    LAS float* hid = (LAS float*)(lds + 8 * 16 * 132 * 4);
    const bf16* P = (const bf16*)(a.W() + WS_P); bf16* KCMP = (bf16*)(a.W() + WS_KCMP); bf16* VCMP = (bf16*)(a.W() + WS_VCMP);
    const int r = lane & 15, q = lane >> 4;
    for (int u = bid; u < 128; u += G) {
        const int b = u >> 4, kv = (u >> 3) & 1, j0 = 16 * (u & 7);
        const bf16* arow = P + (size_t)(b * SEQ) * NP + C_KV + kv * 64;
        const bf16* brow = (const bf16*)(a.W() + WS_W1T) + ((size_t)(l * 2 + kv) * 128 + r) * 2048 + 8 * q;
        f32x4 acc[8];
#pragma unroll
        for (int nb = 0; nb < 8; ++nb) acc[nb] = (f32x4){0.f, 0.f, 0.f, 0.f};
#pragma unroll
        for (int s8 = 0; s8 < 8; ++s8) { const int ks = 8 * wave + s8; int tk = 16 * (j0 + r) + (ks >> 1); tk = tk < SEQ ? tk : SEQ - 1;
            const bf16x8 af = *(const bf16x8*)(arow + (size_t)tk * NP + (ks & 1) * 32 + 8 * q);
#pragma unroll
            for (int nb = 0; nb < 8; ++nb) acc[nb] = __builtin_amdgcn_mfma_f32_16x16x32_bf16(af, *(const bf16x8*)(brow + (size_t)(16 * nb) * 2048 + 32 * ks), acc[nb], 0, 0, 0); }
#pragma unroll
        for (int nb = 0; nb < 8; ++nb)
#pragma unroll
            for (int i = 0; i < 4; ++i) part[(wave * 16 + 4 * q + i) * 132 + 16 * nb + r] = acc[nb][i];
        __syncthreads();
        { const float* POSW = (const float*)(a.W() + WS_POSW) + (l * 2 + kv) * 128;
            for (int e = tid; e < 16 * 128; e += NTHR) { const int row = e >> 7, n = e & 127; float sacc = POSW[n];
#pragma unroll
                for (int w = 0; w < 8; ++w) sacc += part[(w * 16 + row) * 132 + n];
                hid[row * 132 + n] = siluf_(sacc); } }
        __syncthreads();
        { const int row = tid >> 5, c2 = tid & 31; const float* w2 = a.I(11) + (size_t)(l * 2 + kv) * 128 * 64; float o0 = 0.f, o1 = 0.f;
            for (int nn = 0; nn < 128; ++nn) { const float hv = hid[row * 132 + nn]; o0 += hv * w2[nn * 64 + 2 * c2]; o1 += hv * w2[nn * 64 + 2 * c2 + 1]; }
            if (kv == 0) { float ss = o0 * o0 + o1 * o1;
#pragma unroll
                for (int o_ = 1; o_ < 32; o_ <<= 1) ss += __shfl_xor(ss, o_);
                const float sc = rsqrtf(ss * (1.0f / 64.0f) + EPS); o0 *= sc * a.I(8)[l * 192 + 2 * c2]; o1 *= sc * a.I(8)[l * 192 + 2 * c2 + 1]; }
            const int j = j0 + row;
            *(unsigned*)((kv ? VCMP : KCMP) + (size_t)(b * 128 + j) * 64 + 2 * c2) = (j < 127) ? pk2(o0, o1) : 0u; }
        __syncthreads();
    }
}

__device__ __forceinline__ void ph_m1(const ArgsG& a, int l, LAS unsigned char* lds, int bid, int G, int tid, int wave, int lane) {
    const bf16* P = (const bf16*)(a.W() + WS_P);
    bf16* QN = (bf16*)(a.W() + WS_QN); bf16* KN = (bf16*)(a.W() + WS_KN); bf16* VC = (bf16*)(a.W() + WS_VC);
    bf16* KT = (bf16*)(a.W() + WS_KT); bf16* VT = (bf16*)(a.W() + WS_VT);
    float* Gb = (float*)(a.W() + WS_G); float* BETA = (float*)(a.W() + WS_BETA);
    bf16* NQ = (bf16*)(a.W() + WS_NQ); bf16* KS = (bf16*)(a.W() + WS_KS); bf16* KW = (bf16*)(a.W() + WS_KW); bf16* Y = (bf16*)(a.W() + WS_Y);
    const float* convw = a.I(3) + (size_t)l * 4 * 1536; const float* a_log = a.I(4) + l * 4; const float* dt_bias = a.I(5) + l * 4;
    const float* qnw = a.I(7) + l * 64; const float* knw = a.I(8) + l * 192;
    const float* dww = a.I(12) + (size_t)l * 31 * 256; const float* dwb = a.I(13) + l * 256; const float* lnw = a.I(14) + l * 256; const float* lnb = a.I(15) + l * 256;
    LAS float* dwl = (LAS float*)(lds + 65536);
    for (int i = tid; i < 31 * 256; i += NTHR) dwl[i] = dww[i];
    __syncthreads();
    for (int u = bid; u < NT / 64; u += G) {
        const int b = u >> 5, nchunk = u & 31, tw = nchunk * 64 + 8 * wave;
        const bf16* pw0 = P + (size_t)(b * SEQ + tw) * NP;
        { unsigned cx[11], nx[11]; float cw0[4], cw1[4], nw0[4], nw1[4];
#define DN_LOAD(idx, X, W0, W1) do { const int cb_ = ((idx) >> 2) * 512 + ((idx) & 3) * 128 + 2 * lane; \
            _Pragma("unroll") for (int j = 0; j < 4; ++j) { W0[j] = convw[j * 1536 + cb_]; W1[j] = convw[j * 1536 + cb_ + 1]; } \
            _Pragma("unroll") for (int j = 0; j < 3; ++j) { X[j] = 0u; if (tw - 3 + j >= 0) X[j] = *(const unsigned*)(pw0 + (ptrdiff_t)(j - 3) * NP + cb_); } \
            _Pragma("unroll") for (int i = 0; i < 8; ++i) X[3 + i] = *(const unsigned*)(pw0 + (size_t)i * NP + cb_); } while (0)
            DN_LOAD(0, cx, cw0, cw1);
#pragma unroll 1
            for (int idx = 0; idx < 12; ++idx) { const int ten = idx >> 2, h = idx & 3;
                if (idx + 1 < 12) DN_LOAD(idx + 1, nx, nw0, nw1);
                float xa[3] = {bf_lo(cx[0]), bf_lo(cx[1]), bf_lo(cx[2])}, xb[3] = {bf_hi(cx[0]), bf_hi(cx[1]), bf_hi(cx[2])};
                float ya[8], yb[8], sq[8];
#pragma unroll
                for (int i = 0; i < 8; ++i) { const unsigned w = cx[3 + i]; const float ca = bf_lo(w), cbv = bf_hi(w);
                    ya[i] = siluf_(cw0[0] * xa[0] + cw0[1] * xa[1] + cw0[2] * xa[2] + cw0[3] * ca); yb[i] = siluf_(cw1[0] * xb[0] + cw1[1] * xb[1] + cw1[2] * xb[2] + cw1[3] * cbv);
                    xa[0] = xa[1]; xa[1] = xa[2]; xa[2] = ca; xb[0] = xb[1]; xb[1] = xb[2]; xb[2] = cbv; sq[i] = ya[i] * ya[i] + yb[i] * yb[i]; }
                if (ten < 2) {
#pragma unroll
                    for (int o_ = 1; o_ < 64; o_ <<= 1) {
#pragma unroll
                        for (int i = 0; i < 8; ++i) sq[i] += __shfl_xor(sq[i], o_); }
                    const float qs_ = ten == 0 ? 0.08838834764831845f : 1.0f;
#pragma unroll
                    for (int i = 0; i < 8; ++i) { const float sc = rsqrtf(sq[i] + EPS) * qs_; ya[i] *= sc; yb[i] *= sc; } }
                unsigned pk[8];
#pragma unroll
                for (int i = 0; i < 8; ++i) pk[i] = pk2(ya[i], yb[i]);
                if (ten < 2) { bf16* dst = ten == 0 ? QN : KN;
#pragma unroll
                    for (int i = 0; i < 8; ++i) *(unsigned*)(dst + (size_t)(b * SEQ + tw + i) * 512 + h * 128 + 2 * lane) = pk[i]; }
                if (ten >= 1) {
                    bf16* tb = (ten == 1 ? KT : VT) + ((size_t)((b * 4 + h) * 32 + nchunk) * 128 + 2 * lane) * 64 + 8 * wave;
                    u32x4 lo, hi;
                    lo.x = (pk[0] & 0xffffu) | (pk[1] << 16); lo.y = (pk[2] & 0xffffu) | (pk[3] << 16); lo.z = (pk[4] & 0xffffu) | (pk[5] << 16); lo.w = (pk[6] & 0xffffu) | (pk[7] << 16);
                    hi.x = (pk[0] >> 16) | (pk[1] & 0xffff0000u); hi.y = (pk[2] >> 16) | (pk[3] & 0xffff0000u); hi.z = (pk[4] >> 16) | (pk[5] & 0xffff0000u); hi.w = (pk[6] >> 16) | (pk[7] & 0xffff0000u);
                    *(u32x4*)tb = lo; *(u32x4*)(tb + 64) = hi; }
#pragma unroll
                for (int j = 0; j < 11; ++j) cx[j] = nx[j];
#pragma unroll
                for (int j = 0; j < 4; ++j) { cw0[j] = nw0[j]; cw1[j] = nw1[j]; } }
#undef DN_LOAD
        }
        if (lane < 32) { const int i = lane >> 2, hd = lane & 3; const size_t tok = (size_t)(b * SEQ + tw + i); const bf16* prow = P + tok * NP;
            const float av = bf2f(prow[C_A + hd]), bv = bf2f(prow[C_B + hd]);
            BETA[tok * 4 + hd] = sigmoidf_(bv);
            const float x = av + dt_bias[hd]; const float sp = x > 20.0f ? x : log1pf(expf(x));
            Gb[tok * 4 + hd] = -expf(a_log[hd]) * sp; }
        { const float qw = qnw[lane] * (0.125f * 1.4426950408889634f), ksw = knw[64 + lane], kww = knw[128 + lane];
#pragma unroll 4
          for (int i = 0; i < 8; ++i) { const size_t tok = (size_t)(b * SEQ + tw + i); const bf16* prow = P + tok * NP;
            float xv[6];
#pragma unroll
            for (int h = 0; h < 4; ++h) xv[h] = bf2f(prow[C_NQ + h * 64 + lane]);
            xv[4] = bf2f(prow[C_KV + 128 + lane]); xv[5] = bf2f(prow[C_KV + 256 + lane]);
            float ss[6];
#pragma unroll
            for (int h = 0; h < 6; ++h) ss[h] = xv[h] * xv[h];
#pragma unroll
            for (int o_ = 1; o_ < 64; o_ <<= 1) {
#pragma unroll
                for (int h = 0; h < 6; ++h) ss[h] += __shfl_xor(ss[h], o_); }
#pragma unroll
            for (int h = 0; h < 4; ++h) NQ[tok * 256 + h * 64 + lane] = (bf16)f2bf(xv[h] * rsqrtf(ss[h] * (1.0f / 64.0f) + EPS) * qw);
            KS[tok * 64 + lane] = (bf16)f2bf(xv[4] * rsqrtf(ss[4] * (1.0f / 64.0f) + EPS) * ksw);
            KW[tok * 64 + lane] = (bf16)f2bf(xv[5] * rsqrtf(ss[5] * (1.0f / 64.0f) + EPS) * kww); } }
        { const int c = 4 * lane; f32x4 acc[8]; const f32x4 bias = *(const f32x4*)(dwb + c);
#pragma unroll
            for (int i = 0; i < 8; ++i) acc[i] = bias;
#pragma unroll 1
            for (int g8 = 0; g8 < 5; ++g8) { u32x2 av[8], gv[8];
#pragma unroll
                for (int rr = 0; rr < 8; ++rr) { const int r = 8 * g8 + rr; av[rr] = (u32x2){0u, 0u}; gv[rr] = (u32x2){0u, 0u};
                    if (r < 38 && tw - 30 + r >= 0) { const bf16* pr = pw0 + (ptrdiff_t)(r - 30) * NP + C_CU + c; av[rr] = *(const u32x2*)pr; gv[rr] = *(const u32x2*)(pr + 256); } }
#pragma unroll
                for (int rr = 0; rr < 8; ++rr) { const int r = 8 * g8 + rr;
                    f32x4 gl; gl.x = bf_lo(av[rr].x) * sigmoidf_(bf_lo(gv[rr].x)); gl.y = bf_hi(av[rr].x) * sigmoidf_(bf_hi(gv[rr].x)); gl.z = bf_lo(av[rr].y) * sigmoidf_(bf_lo(gv[rr].y)); gl.w = bf_hi(av[rr].y) * sigmoidf_(bf_hi(gv[rr].y));
#pragma unroll
                    for (int i = 0; i < 8; ++i) { const int j = r - i; if (j >= 0 && j <= 30) { const f32x4 w = *(const LAS f32x4*)(dwl + j * 256 + c); acc[i] += w * gl; } } } }
            const f32x4 lw = *(const f32x4*)(lnw + c), lb = *(const f32x4*)(lnb + c);
#pragma unroll
            for (int i = 0; i < 8; ++i) { const f32x4 x = acc[i]; const float mean = wave_sum((x.x + x.y) + (x.z + x.w)) * (1.0f / 256.0f);
                const f32x4 d = x - mean; const float var = wave_sum((d.x * d.x + d.y * d.y) + (d.z * d.z + d.w * d.w)) * (1.0f / 256.0f);
                const float rr = rsqrtf(var + EPS); const f32x4 y = d * rr * lw + lb;
                u32x2 o; o.x = pk2(siluf_(y.x), siluf_(y.y)); o.y = pk2(siluf_(y.z), siluf_(y.w));
                *(u32x2*)(Y + (size_t)(b * SEQ + tw + i) * DM + 768 + c) = o; } }
    }
}

constexpr int LM_PITCH = 68;
__device__ __forceinline__ void ph_dn_chunk_mfma(const ArgsG& a, LAS unsigned char* lds, int bid, int G, int tid, int wave, int lane) {
    LAS float* Lm = (LAS float*)lds;
    LAS float* gcl = (LAS float*)(lds + 4 * 64 * LM_PITCH * 4);
    LAS float* betal = gcl + 256; LAS float* bkl = betal + 256;
    const bf16* QN = (const bf16*)(a.W() + WS_QN); const bf16* KN = (const bf16*)(a.W() + WS_KN);
    const bf16* KT = (const bf16*)(a.W() + WS_KT); const bf16* VT = (const bf16*)(a.W() + WS_VT);
    const float* Gb = (const float*)(a.W() + WS_G); const float* BETA = (const float*)(a.W() + WS_BETA); float* GC = (float*)(a.W() + WS_GC);
    float* U = (float*)(a.W() + WS_U); bf16* W = (bf16*)(a.W() + WS_W); bf16* ATT = (bf16*)(a.W() + WS_ATT);
    const int n = lane & 31, hh = lane >> 5;
    for (int cb = bid * 4; cb < 1024; cb += G * 4) {
        if (wave < 4) { const int ci = cb + wave, nn = ci & 31, h = (ci >> 5) & 3, b = ci >> 7, r0 = b * SEQ + nn * 64;
            float g = Gb[(size_t)(r0 + lane) * 4 + h];
#pragma unroll
            for (int off = 1; off < 64; off <<= 1) { const float v = __shfl_up(g, off); if (lane >= off) g += v; }
            const float be = BETA[(size_t)(r0 + lane) * 4 + h];
            gcl[wave * 64 + lane] = g; GC[(size_t)(r0 + lane) * 4 + h] = g; betal[wave * 64 + lane] = be; bkl[wave * 64 + lane] = be * __expf(g); }
        __syncthreads();
#pragma unroll 1
        for (int q = 0; q < 3; ++q) { const int id = 3 * wave + q, c = id / 6, wq = id % 6, isq = wq >= 3 ? 1 : 0, blk = wq % 3, ib = blk >= 1 ? 1 : 0, jb = blk == 2 ? 1 : 0;
            const int ci = cb + c, nn = ci & 31, h = (ci >> 5) & 3, b = ci >> 7, r0 = b * SEQ + nn * 64;
            const bf16* ap = (isq ? QN : KN) + (size_t)(r0 + 32 * ib + n) * 512 + h * 128 + 8 * hh;
            const bf16* bp = KN + (size_t)(r0 + 32 * jb + n) * 512 + h * 128 + 8 * hh;
            f32x16 acc;
#pragma unroll
            for (int r = 0; r < 16; ++r) acc[r] = 0.f;
#pragma unroll
            for (int ks = 0; ks < 8; ++ks) acc = __builtin_amdgcn_mfma_f32_32x32x16_bf16(*(const bf16x8*)(ap + 16 * ks), *(const bf16x8*)(bp + 16 * ks), acc, 0, 0, 0);
            const int j = 32 * jb + n; const float gj = gcl[c * 64 + j];
#pragma unroll
            for (int r = 0; r < 16; ++r) { const int i = 32 * ib + (r & 3) + 8 * (r >> 2) + 4 * hh; const float dec = __expf(fminf(gcl[c * 64 + i] - gj, 0.f));
                if (isq) ATT[(size_t)ci * 4096 + i * 64 + j] = (bf16)((j <= i) ? f2bf(acc[r] * dec) : 0u);
                else Lm[c * 64 * LM_PITCH + i * LM_PITCH + j] = (j < i) ? betal[c * 64 + i] * acc[r] * dec : 0.f; } }
        __syncthreads();
        if (wave < 4) { LAS float* L = Lm + wave * 64 * LM_PITCH;
            for (int i = 0; i < 64; ++i) { float a0 = (i == lane) ? 1.f : 0.f, a1 = 0.f, a2 = 0.f, a3 = 0.f; int j = 0;
                for (; j + 3 < i; j += 4) { a0 -= L[i * LM_PITCH + j] * L[j * LM_PITCH + lane]; a1 -= L[i * LM_PITCH + j + 1] * L[(j + 1) * LM_PITCH + lane];
                    a2 -= L[i * LM_PITCH + j + 2] * L[(j + 2) * LM_PITCH + lane]; a3 -= L[i * LM_PITCH + j + 3] * L[(j + 3) * LM_PITCH + lane]; }
                for (; j < i; ++j) a0 -= L[i * LM_PITCH + j] * L[j * LM_PITCH + lane];
                L[i * LM_PITCH + lane] = (a0 + a1) + (a2 + a3); } }
        __syncthreads();
#pragma unroll 1
        for (int q = 0; q < 4; ++q) { const int id = wave * 4 + q, c = id >> 3, ten = (id >> 2) & 1, db = id & 3;
            const int ci = cb + c, nn = ci & 31, h = (ci >> 5) & 3, b = ci >> 7, r0 = b * SEQ + nn * 64;
            const bf16* arow = (ten ? KT : VT) + ((size_t)ci * 128 + 32 * db + n) * 64 + 8 * hh;
            const LAS float* scl = (ten ? bkl : betal) + c * 64;
            const LAS float* L = Lm + c * 64 * LM_PITCH;
#pragma unroll
            for (int ib = 0; ib < 2; ++ib) { f32x16 acc;
#pragma unroll
                for (int r = 0; r < 16; ++r) acc[r] = 0.f;
#pragma unroll
                for (int ks = 0; ks < 4; ++ks) { if (ib == 0 && ks >= 2) continue;
                    const LAS float* tp = L + (32 * ib + n) * LM_PITCH + 16 * ks + 8 * hh;
                    const f32x4 t0 = *(const LAS f32x4*)tp, t1 = *(const LAS f32x4*)(tp + 4), s0 = *(const LAS f32x4*)(scl + 16 * ks + 8 * hh), s1 = *(const LAS f32x4*)(scl + 16 * ks + 8 * hh + 4);
                    u32x4 bw; bw.x = pg8::cvt_pk_bf16(t0.x * s0.x, t0.y * s0.y); bw.y = pg8::cvt_pk_bf16(t0.z * s0.z, t0.w * s0.w); bw.z = pg8::cvt_pk_bf16(t1.x * s1.x, t1.y * s1.y); bw.w = pg8::cvt_pk_bf16(t1.z * s1.z, t1.w * s1.w);
                    acc = __builtin_amdgcn_mfma_f32_32x32x16_bf16(*(const bf16x8*)(arow + 16 * ks), __builtin_bit_cast(bf16x8, bw), acc, 0, 0, 0); }
                const size_t ob = (size_t)(r0 + 32 * ib + n) * 512 + h * 128 + 32 * db + 4 * hh;
#pragma unroll
                for (int rq = 0; rq < 4; ++rq) {
                    if (ten) { u32x2 w2; w2.x = pk2(acc[4 * rq], acc[4 * rq + 1]); w2.y = pk2(acc[4 * rq + 2], acc[4 * rq + 3]); *(u32x2*)(W + ob + 8 * rq) = w2; }
                    else *(f32x4*)(U + ob + 8 * rq) = (f32x4){acc[4 * rq], acc[4 * rq + 1], acc[4 * rq + 2], acc[4 * rq + 3]}; } } }
        __syncthreads();
    }
}

constexpr int SC_WP = 272, SC_AP = 144;
constexpr int SC_W = 0, SC_Q = 64 * SC_WP, SC_A = 2 * 64 * SC_WP, SC_K = SC_A + 64 * SC_AP, SC_GC = SC_K + 128 * SC_AP, SC_BUF = SC_GC + 1024;
static_assert(2 * SC_BUF <= RING_BYTES, "scan LDS");
struct ScanPf { u32x4 w[4], q[4], at[2], k[4]; float g, gl; };
__device__ __forceinline__ ScanPf scan_load(const bf16* W, const bf16* QN, const bf16* ATT, const bf16* KT, const float* GC, int r0, int h, int ci, int lt) {
    ScanPf p; const int row = lt >> 4, seg = lt & 15;
#pragma unroll
    for (int i = 0; i < 4; ++i) { const size_t go = (size_t)(r0 + row + 16 * i) * 512 + h * 128 + seg * 8; p.w[i] = *(const u32x4*)(W + go); p.q[i] = *(const u32x4*)(QN + go); }
#pragma unroll
    for (int i = 0; i < 2; ++i) p.at[i] = *(const u32x4*)(ATT + (size_t)ci * 4096 + (lt + 256 * i) * 8);
#pragma unroll
    for (int i = 0; i < 4; ++i) p.k[i] = *(const u32x4*)(KT + (size_t)ci * 8192 + (lt + 256 * i) * 8);
    p.g = GC[(size_t)(r0 + (lt & 63)) * 4 + h]; p.gl = GC[(size_t)(r0 + 63) * 4 + h]; return p;
}
__device__ __forceinline__ void scan_store(const ScanPf& p, LAS unsigned char* buf, int lt) {
    const int row = lt >> 4, seg = lt & 15;
#pragma unroll
    for (int i = 0; i < 4; ++i) { *(LAS u32x4*)(buf + SC_W + (row + 16 * i) * SC_WP + seg * 16) = p.w[i]; *(LAS u32x4*)(buf + SC_Q + (row + 16 * i) * SC_WP + seg * 16) = p.q[i]; }
#pragma unroll
    for (int i = 0; i < 2; ++i) *(LAS u32x4*)(buf + SC_A + ((lt >> 3) + 32 * i) * SC_AP + (lt & 7) * 16) = p.at[i];
#pragma unroll
    for (int i = 0; i < 4; ++i) *(LAS u32x4*)(buf + SC_K + ((lt >> 3) + 32 * i) * SC_AP + (lt & 7) * 16) = p.k[i];
    if (lt < 64) { LAS float* gp = (LAS float*)(buf + SC_GC); gp[lt] = __expf(p.g); gp[64 + lt] = __expf(p.gl - p.g); if (lt == 0) gp[128] = __expf(p.gl); }
}
__device__ __forceinline__ bf16x8 frag2(const LAS unsigned char* p) { const u32x2 lo = *(const LAS u32x2*)p, hi = *(const LAS u32x2*)(p + 16); const u32x4 v = {lo.x, lo.y, hi.x, hi.y}; return __builtin_bit_cast(bf16x8, v); }
__device__ __forceinline__ void ph_dn_scan_mfma(const ArgsG& a, LAS unsigned char* lds, int bid, int G, int tid, int wave, int lane) {
    const bf16* QN = (const bf16*)(a.W() + WS_QN); const bf16* KT = (const bf16*)(a.W() + WS_KT); const bf16* W = (const bf16*)(a.W() + WS_W); const bf16* ATT = (const bf16*)(a.W() + WS_ATT);
    const float* GC = (const float*)(a.W() + WS_GC); const float* U = (const float*)(a.W() + WS_U); float* O = (float*)(a.W() + WS_O);
    const int n = lane & 31, hh = lane >> 5;
    for (int u = bid; u < 32; u += G) {
        const int h = u & 3, b = u >> 2;
        f32x16 S[4];
#pragma unroll
        for (int k = 0; k < 4; ++k)
#pragma unroll
            for (int r = 0; r < 16; ++r) S[k][r] = 0.f;
        __syncthreads();
        if (wave >= 4) { const ScanPf p0 = scan_load(W, QN, ATT, KT, GC, b * SEQ, h, (b * 4 + h) * 32, tid - 256); scan_store(p0, lds, tid - 256); }
        __syncthreads();
#pragma unroll 1
        for (int nn = 0; nn < 32; ++nn) {
            const int r0 = b * SEQ + nn * 64; LAS unsigned char* buf = lds + (nn & 1) * SC_BUF; const LAS float* gp = (const LAS float*)(buf + SC_GC);
            if (wave >= 4) { if (nn + 1 < 32) { const ScanPf pf = scan_load(W, QN, ATT, KT, GC, r0 + 64, h, (b * 4 + h) * 32 + nn + 1, tid - 256); scan_store(pf, lds + ((nn + 1) & 1) * SC_BUF, tid - 256); } }
            else {
                const size_t ubase = (size_t)r0 * 512 + h * 128 + 32 * wave + n;
                f32x16 vn[2];
#pragma unroll
                for (int ib = 0; ib < 2; ++ib)
#pragma unroll
                    for (int r = 0; r < 16; ++r) vn[ib][r] = U[ubase + (size_t)(32 * ib + (r & 3) + 8 * (r >> 2) + 4 * hh) * 512];
                bf16x8 Sb[4][2];
#pragma unroll
                for (int k = 0; k < 4; ++k)
#pragma unroll
                    for (int s2 = 0; s2 < 2; ++s2) { u32x4 w4; w4.x = pg8::cvt_pk_bf16(S[k][8 * s2], S[k][8 * s2 + 1]); w4.y = pg8::cvt_pk_bf16(S[k][8 * s2 + 2], S[k][8 * s2 + 3]);
                        w4.z = pg8::cvt_pk_bf16(S[k][8 * s2 + 4], S[k][8 * s2 + 5]); w4.w = pg8::cvt_pk_bf16(S[k][8 * s2 + 6], S[k][8 * s2 + 7]); Sb[k][s2] = __builtin_bit_cast(bf16x8, w4); }
#pragma unroll
                for (int ib = 0; ib < 2; ++ib) { f32x16 acc;
#pragma unroll
                    for (int r = 0; r < 16; ++r) acc[r] = 0.f;
#pragma unroll
                    for (int k = 0; k < 4; ++k)
#pragma unroll
                        for (int s2 = 0; s2 < 2; ++s2) acc = __builtin_amdgcn_mfma_f32_32x32x16_bf16(frag2(buf + SC_W + (32 * ib + n) * SC_WP + (32 * k + 16 * s2 + 4 * hh) * 2), Sb[k][s2], acc, 0, 0, 0);
#pragma unroll
                    for (int r = 0; r < 16; ++r) vn[ib][r] -= acc[r]; }
                bf16x8 vb[2][2], vd[2][2];
#pragma unroll
                for (int jb = 0; jb < 2; ++jb)
#pragma unroll
                    for (int s2 = 0; s2 < 2; ++s2) { const f32x4 d0 = *(const LAS f32x4*)(gp + 64 + 32 * jb + 16 * s2 + 4 * hh), d1 = *(const LAS f32x4*)(gp + 64 + 32 * jb + 16 * s2 + 8 + 4 * hh);
                        const float* v = nullptr; (void)v; u32x4 w4, w5;
                        w4.x = pg8::cvt_pk_bf16(vn[jb][8 * s2], vn[jb][8 * s2 + 1]); w4.y = pg8::cvt_pk_bf16(vn[jb][8 * s2 + 2], vn[jb][8 * s2 + 3]);
                        w4.z = pg8::cvt_pk_bf16(vn[jb][8 * s2 + 4], vn[jb][8 * s2 + 5]); w4.w = pg8::cvt_pk_bf16(vn[jb][8 * s2 + 6], vn[jb][8 * s2 + 7]);
                        w5.x = pg8::cvt_pk_bf16(vn[jb][8 * s2] * d0.x, vn[jb][8 * s2 + 1] * d0.y); w5.y = pg8::cvt_pk_bf16(vn[jb][8 * s2 + 2] * d0.z, vn[jb][8 * s2 + 3] * d0.w);
                        w5.z = pg8::cvt_pk_bf16(vn[jb][8 * s2 + 4] * d1.x, vn[jb][8 * s2 + 5] * d1.y); w5.w = pg8::cvt_pk_bf16(vn[jb][8 * s2 + 6] * d1.z, vn[jb][8 * s2 + 7] * d1.w);
                        vb[jb][s2] = __builtin_bit_cast(bf16x8, w4); vd[jb][s2] = __builtin_bit_cast(bf16x8, w5); }
#pragma unroll
                for (int ib = 0; ib < 2; ++ib) { f32x16 acc;
#pragma unroll
                    for (int r = 0; r < 16; ++r) acc[r] = 0.f;
#pragma unroll
                    for (int k = 0; k < 4; ++k)
#pragma unroll
                        for (int s2 = 0; s2 < 2; ++s2) acc = __builtin_amdgcn_mfma_f32_32x32x16_bf16(frag2(buf + SC_Q + (32 * ib + n) * SC_WP + (32 * k + 16 * s2 + 4 * hh) * 2), Sb[k][s2], acc, 0, 0, 0);
#pragma unroll
                    for (int rq = 0; rq < 4; ++rq) { const f32x4 e4 = *(const LAS f32x4*)(gp + 32 * ib + 8 * rq + 4 * hh);
                        acc[4 * rq] *= e4.x; acc[4 * rq + 1] *= e4.y; acc[4 * rq + 2] *= e4.z; acc[4 * rq + 3] *= e4.w; }
#pragma unroll
                    for (int jb = 0; jb < 2; ++jb) { if (jb > ib) continue;
#pragma unroll
                        for (int s2 = 0; s2 < 2; ++s2) acc = __builtin_amdgcn_mfma_f32_32x32x16_bf16(frag2(buf + SC_A + (32 * ib + n) * SC_AP + (32 * jb + 16 * s2 + 4 * hh) * 2), vb[jb][s2], acc, 0, 0, 0); }
#pragma unroll
                    for (int r = 0; r < 16; ++r) O[ubase + (size_t)(32 * ib + (r & 3) + 8 * (r >> 2) + 4 * hh) * 512] = acc[r]; }
                const float egl = gp[128];
#pragma unroll
                for (int k = 0; k < 4; ++k) {
#pragma unroll
                    for (int r = 0; r < 16; ++r) S[k][r] *= egl;
#pragma unroll
                    for (int jb = 0; jb < 2; ++jb)
#pragma unroll
                        for (int s2 = 0; s2 < 2; ++s2) S[k] = __builtin_amdgcn_mfma_f32_32x32x16_bf16(frag2(buf + SC_K + (32 * k + n) * SC_AP + (32 * jb + 16 * s2 + 4 * hh) * 2), vd[jb][s2], S[k], 0, 0, 0); }
            }
            __syncthreads();
        }
    }
}

__device__ __forceinline__ void ph_dn_out(const ArgsG& a, int l, int gw, int NGW, int lane) {
    const float* O = (const float*)(a.W() + WS_O); const bf16* P = (const bf16*)(a.W() + WS_P); bf16* Y = (bf16*)(a.W() + WS_Y);
    const float* nw = a.I(6) + l * 128;
    for (int tok = gw; tok < NT; tok += NGW) {
#pragma unroll
        for (int h = 0; h < 4; ++h) { const float o0 = O[(size_t)tok * 512 + h * 128 + 2 * lane], o1 = O[(size_t)tok * 512 + h * 128 + 2 * lane + 1];
            const float ss = wave_sum(o0 * o0 + o1 * o1); const float r = rsqrtf(ss * (1.0f / 128.0f) + EPS);
            const unsigned zw = *(const unsigned*)(P + (size_t)tok * NP + C_Z + h * 128 + 2 * lane);
            const float y0 = o0 * r * nw[2 * lane] * siluf_(bf_lo(zw)), y1 = o1 * r * nw[2 * lane + 1] * siluf_(bf_hi(zw));
            *(unsigned*)(Y + (size_t)tok * DM + h * 128 + 2 * lane) = pk2(y0, y1); }
    }
}

constexpr int NSA_KT_PITCH = 144, NSA_VT_PITCH = 136;
struct NsaStage { u32x4 kv, vv; };
__device__ __forceinline__ NsaStage nsa_load(const bf16* Kbase, int kpitch, const bf16* Vbase, int vpitch, int tid) {
    const int key = tid >> 3, seg = tid & 7; NsaStage s;
    s.kv = *(const u32x4*)(Kbase + (size_t)key * kpitch + seg * 8); s.vv = *(const u32x4*)(Vbase + (size_t)key * vpitch + seg * 8); return s;
}
__device__ __forceinline__ void nsa_store(const NsaStage& s, LAS unsigned char* Kt, LAS unsigned char* Vt, int tid) {
    const int key = tid >> 3, seg = tid & 7;
    *(LAS u32x4*)(Kt + key * NSA_KT_PITCH + seg * 16) = s.kv;
#pragma unroll
    for (int i = 0; i < 4; ++i) { const unsigned w = s.vv[i];
        *(LAS unsigned short*)(Vt + (seg * 8 + 2 * i) * NSA_VT_PITCH + key * 2) = (unsigned short)(w & 0xffffu);
        *(LAS unsigned short*)(Vt + (seg * 8 + 2 * i + 1) * NSA_VT_PITCH + key * 2) = (unsigned short)(w >> 16); }
}
__device__ __forceinline__ void nsa_st(const LAS unsigned char* Kt, const bf16x8 (&qf)[4], int n, int hh, f32x16 (&s)[2]) {
#pragma unroll
    for (int kb = 0; kb < 2; ++kb) {
#pragma unroll
        for (int r = 0; r < 16; ++r) s[kb][r] = 0.f;
#pragma unroll
        for (int ks = 0; ks < 4; ++ks) { const bf16x8 af = *(const LAS bf16x8*)(Kt + (kb * 32 + n) * NSA_KT_PITCH + (16 * ks + 8 * hh) * 2);
            s[kb] = __builtin_amdgcn_mfma_f32_32x32x16_bf16(af, qf[ks], s[kb], 0, 0, 0); } }
}
__device__ __forceinline__ void nsa_pvm(const LAS unsigned char* Vt, const bf16x8 (&pf)[2][2], int n, int hh, f32x16 (&o)[2]) {
#pragma unroll
    for (int db = 0; db < 2; ++db)
#pragma unroll
        for (int kb = 0; kb < 2; ++kb)
#pragma unroll
            for (int s2 = 0; s2 < 2; ++s2) { const LAS unsigned char* p = Vt + (db * 32 + n) * NSA_VT_PITCH + (kb * 32 + 16 * s2 + 4 * hh) * 2;
                const u32x2 lo = *(const LAS u32x2*)p, hi = *(const LAS u32x2*)(p + 16);
                const u32x4 av = {lo.x, lo.y, hi.x, hi.y};
                o[db] = __builtin_amdgcn_mfma_f32_32x32x16_bf16(__builtin_bit_cast(bf16x8, av), pf[kb][s2], o[db], 0, 0, 0); }
}
__device__ __forceinline__ void nsa_pack(const f32x16 (&p)[2], bf16x8 (&pf)[2][2]) {
#pragma unroll
    for (int kb = 0; kb < 2; ++kb)
#pragma unroll
        for (int s2 = 0; s2 < 2; ++s2) { u32x4 w;
            w.x = pg8::cvt_pk_bf16(p[kb][8 * s2 + 0], p[kb][8 * s2 + 1]); w.y = pg8::cvt_pk_bf16(p[kb][8 * s2 + 2], p[kb][8 * s2 + 3]);
            w.z = pg8::cvt_pk_bf16(p[kb][8 * s2 + 4], p[kb][8 * s2 + 5]); w.w = pg8::cvt_pk_bf16(p[kb][8 * s2 + 6], p[kb][8 * s2 + 7]);
            pf[kb][s2] = __builtin_bit_cast(bf16x8, w); }
}
constexpr int BT2_ROWS = 2048 + 72;
template <bool COLSEL>
__device__ __forceinline__ void nsa_tile_mfma(const LAS unsigned char* Kt, const LAS unsigned char* Vt, const LAS float* btl2h, const bf16x8 (&qf)[4], int n, int hh,
                                              int key0, int tq, bool masked, bool colsel, int maxd, float& m, float& l, f32x16 (&o)[2]) {
    f32x16 s[2]; nsa_st(Kt, qf, n, hh, s);
    const int dbase = tq - key0 - 4 * hh;
    const LAS float* bp = btl2h + (2047 - dbase) * 4;
#pragma unroll
    for (int kb = 0; kb < 2; ++kb)
#pragma unroll
        for (int r = 0; r < 16; ++r) { const int cst = kb * 32 + (r & 3) + 8 * (r >> 2); const float x = s[kb][r] + bp[cst * 4]; s[kb][r] = (!COLSEL || colsel) ? x : -3.0e38f; }
    if (masked) {
#pragma unroll
        for (int kb = 0; kb < 2; ++kb)
#pragma unroll
            for (int r = 0; r < 16; ++r) { const int dist = dbase - (kb * 32 + (r & 3) + 8 * (r >> 2)); s[kb][r] = (dist >= 0 && dist <= maxd) ? s[kb][r] : -3.0e38f; } }
    float tmax = -3.0e38f;
#pragma unroll
    for (int kb = 0; kb < 2; ++kb)
#pragma unroll
        for (int r = 0; r < 16; ++r) tmax = fmaxf(tmax, s[kb][r]);
    tmax = fmaxf(tmax, __shfl_xor(tmax, 32));
    const float mn = fmaxf(m, tmax); float rs = 0.f;
#pragma unroll
    for (int kb = 0; kb < 2; ++kb)
#pragma unroll
        for (int r = 0; r < 16; ++r) { const float p = __builtin_amdgcn_exp2f(s[kb][r] - mn); s[kb][r] = p; rs += p; }
    rs += __shfl_xor(rs, 32);
    if (__any(mn > m)) { const float corr = __builtin_amdgcn_exp2f(m - mn); l *= corr;
#pragma unroll
        for (int db = 0; db < 2; ++db)
#pragma unroll
            for (int r = 0; r < 16; ++r) o[db][r] *= corr; }
    l += rs; m = mn;
    bf16x8 pf[2][2]; nsa_pack(s, pf);
    nsa_pvm(Vt, pf, n, hh, o);
}

__device__ __forceinline__ void ph_nsa_mfma(const ArgsG& a, LAS unsigned char* lds, int ubeg, int ustep, int uend, int tid, int wave, int lane) {
    LAS float* btl2 = (LAS float*)lds;
    constexpr int NSA_L0 = BT2_ROWS * 16;
    LAS unsigned char* Kt = lds + NSA_L0;
    LAS unsigned char* Vt = lds + NSA_L0 + 9216;
    constexpr int NSA_TB = 9216 + 8704;
    LAS float* PS = (LAS float*)(lds + NSA_L0 + 2 * NSA_TB + 256);
    LAS unsigned* MK = (LAS unsigned*)(lds + NSA_L0 + 2 * NSA_TB + 256 + 64 * 129 * 4);
    static_assert(NSA_L0 + 2 * NSA_TB + 256 + 64 * 129 * 4 + 512 <= RING_BYTES, "NSA LDS");
    const float* BT = (const float*)(a.W() + WS_BT);
    for (int i = tid; i < BT2_ROWS * 4; i += NTHR) { const int row = i >> 2, hd = i & 3; btl2[i] = row < 2048 ? BT[hd * 2048 + (2047 - row)] * 1.4426950408889634f : 0.f; }
    const bf16* P = (const bf16*)(a.W() + WS_P); const bf16* NQ = (const bf16*)(a.W() + WS_NQ);
    const bf16* KS = (const bf16*)(a.W() + WS_KS); const bf16* KW = (const bf16*)(a.W() + WS_KW);
    const bf16* KCMP = (const bf16*)(a.W() + WS_KCMP); const bf16* VCMP = (const bf16*)(a.W() + WS_VCMP); bf16* Y = (bf16*)(a.W() + WS_Y);
    const int n = lane & 31, hh = lane >> 5, tl = n >> 2, h = n & 3;
    const LAS float* btl2h = btl2 + h;
    __syncthreads();
    for (int u = ubeg; u < uend; u += ustep) {
        const int b = u & 7, qt = 31 - (u >> 3), t0 = 64 * qt, tq = t0 + 8 * wave + tl, tok = b * SEQ + tq;
        bf16x8 qf[4];
#pragma unroll
        for (int ks = 0; ks < 4; ++ks) qf[ks] = *(const bf16x8*)(NQ + (size_t)tok * 256 + h * 64 + 16 * ks + 8 * hh);
        float gate[3];
#pragma unroll
        for (int br = 0; br < 3; ++br) gate[br] = sigmoidf_(bf2f(P[(size_t)tok * NP + C_G + h * 3 + br]));
        f32x16 yacc[2];
        {
            float mx = -1e30f, rs = 0.f;
#pragma unroll 1
            for (int ct = 0; ct < 2; ++ct) {
                __syncthreads();
                { const NsaStage st = nsa_load(KCMP + (size_t)(b * 128 + ct * 64) * 64, 64, VCMP + (size_t)(b * 128 + ct * 64) * 64, 64, tid); nsa_store(st, Kt, Vt, tid); }
                __syncthreads();
                f32x16 sc[2]; nsa_st(Kt, qf, n, hh, sc);
                float tmax = -1e30f;
#pragma unroll
                for (int kb = 0; kb < 2; ++kb)
#pragma unroll
                    for (int r = 0; r < 16; ++r) { const int j = ct * 64 + kb * 32 + (r & 3) + 8 * (r >> 2) + 4 * hh; const int dist = tq - 16 * j - 31;
                        const float x = sc[kb][r] + btl2h[(2047 - (dist < 0 ? 0 : dist)) * 4]; sc[kb][r] = dist >= 0 ? x : -1e30f; tmax = fmaxf(tmax, sc[kb][r]); }
                tmax = fmaxf(tmax, __shfl_xor(tmax, 32));
                const float mn = fmaxf(mx, tmax); float ts = 0.f;
#pragma unroll
                for (int kb = 0; kb < 2; ++kb)
#pragma unroll
                    for (int r = 0; r < 16; ++r) { const float x = sc[kb][r]; ts += x > -1e29f ? __builtin_amdgcn_exp2f(x - mn) : 0.f; }
                ts += __shfl_xor(ts, 32);
                rs = rs * __builtin_amdgcn_exp2f(mx - mn) + ts; mx = mn;
            }
            const float inv = rs > 0.f ? 1.0f / rs : 0.f;
            f32x16 o[2];
#pragma unroll
            for (int db = 0; db < 2; ++db)
#pragma unroll
                for (int r = 0; r < 16; ++r) o[db][r] = 0.f;
#pragma unroll 1
            for (int cc = 0; cc < 2; ++cc) { const int ct = 1 - cc;
                if (cc == 1) { __syncthreads();
                    { const NsaStage st = nsa_load(KCMP + (size_t)(b * 128) * 64, 64, VCMP + (size_t)(b * 128) * 64, 64, tid); nsa_store(st, Kt, Vt, tid); }
                    __syncthreads(); }
                f32x16 sc[2]; nsa_st(Kt, qf, n, hh, sc);
#pragma unroll
                for (int kb = 0; kb < 2; ++kb)
#pragma unroll
                    for (int r = 0; r < 16; ++r) { const int j = ct * 64 + kb * 32 + (r & 3) + 8 * (r >> 2) + 4 * hh; const int dist = tq - 16 * j - 31;
                        const float x = sc[kb][r] + btl2h[(2047 - (dist < 0 ? 0 : dist)) * 4]; const float p = dist >= 0 ? __builtin_amdgcn_exp2f(x - mx) * inv : 0.f; sc[kb][r] = p;
                        float v = p; v += __shfl_xor(v, 1); v += __shfl_xor(v, 2);
                        if (h == 0) PS[(8 * wave + tl) * 129 + j] = v; }
                bf16x8 pf[2][2]; nsa_pack(sc, pf); nsa_pvm(Vt, pf, n, hh, o);
            }
#pragma unroll
            for (int db = 0; db < 2; ++db)
#pragma unroll
                for (int r = 0; r < 16; ++r) yacc[db][r] = gate[0] * o[db][r];
        }
        LDS_WAIT();
        for (int t2 = 0; t2 < 8; ++t2) {
            const int tqq = t0 + 8 * wave + t2, sb = lane & 31, cur = tqq >> 6; const LAS float* row = PS + (8 * wave + t2) * 129; float imp = 0.f;
#pragma unroll
            for (int dj = -1; dj <= 3; ++dj) { const int j = 4 * sb + dj; if (j >= 0 && j <= 126) imp += row[j]; }
            if (sb > cur) imp = -1.0f; else if (sb == 0 || sb == cur || sb == cur - 1) imp = 1e4f;
            int rank = 0;
            for (int s2 = 0; s2 < 32; ++s2) { const float v2 = __shfl(imp, s2); rank += (v2 > imp || (v2 == imp && s2 < sb)) ? 1 : 0; }
            const unsigned msk = (unsigned)__ballot((lane < 32) && (rank < 16) && (sb <= cur));
            if (lane == 0) MK[8 * wave + t2] = msk;
        }
        __syncthreads();
        unsigned anymask, wmask; const unsigned mymask = MK[8 * wave + tl];
        { unsigned v = MK[lane];
#pragma unroll
            for (int o_ = 1; o_ < 64; o_ <<= 1) v |= (unsigned)__shfl_xor((int)v, o_);
            anymask = (unsigned)__builtin_amdgcn_readfirstlane((int)v);
            unsigned w = MK[8 * wave + (lane & 7)]; w |= (unsigned)__shfl_xor((int)w, 1); w |= (unsigned)__shfl_xor((int)w, 2); w |= (unsigned)__shfl_xor((int)w, 4);
            wmask = (unsigned)__builtin_amdgcn_readfirstlane((int)w); }
        LAS unsigned* stash = (LAS unsigned*)PS + (wave * 16) * 64 + lane;
        __syncthreads();
#pragma unroll
        for (int db = 0; db < 2; ++db)
#pragma unroll
            for (int k = 0; k < 8; ++k) stash[(db * 8 + k) * 64] = pk2(yacc[db][2 * k], yacc[db][2 * k + 1]);
        {
            float m = -1e30f, l = 0.f; f32x16 o[2];
#pragma unroll
            for (int db = 0; db < 2; ++db)
#pragma unroll
                for (int r = 0; r < 16; ++r) o[db][r] = 0.f;
            unsigned mk = anymask; NsaStage s0, s1; bool h1 = false;
            { const int sa = __builtin_ctz(mk); s0 = nsa_load(KS + (size_t)(b * SEQ + 64 * sa) * 64, 64, P + (size_t)(b * SEQ + 64 * sa) * NP + C_KV + 192, NP, tid);
              unsigned m2 = mk & (mk - 1u); if (m2) { const int sb2 = __builtin_ctz(m2); s1 = nsa_load(KS + (size_t)(b * SEQ + 64 * sb2) * 64, 64, P + (size_t)(b * SEQ + 64 * sb2) * NP + C_KV + 192, NP, tid); h1 = true; } }
            __syncthreads();
            nsa_store(s0, Kt, Vt, tid);
            __syncthreads();
            int par = 0;
            while (mk) {
                const int sblk = __builtin_ctz(mk); mk &= mk - 1u;
                if (h1) { nsa_store(s1, Kt + (par ^ 1) * NSA_TB, Vt + (par ^ 1) * NSA_TB, tid);
                    const unsigned m3 = mk & (mk - 1u);
                    if (m3) { const int sc2 = __builtin_ctz(m3); s1 = nsa_load(KS + (size_t)(b * SEQ + 64 * sc2) * 64, 64, P + (size_t)(b * SEQ + 64 * sc2) * NP + C_KV + 192, NP, tid); } else h1 = false; }
                if ((wmask >> sblk) & 1u) nsa_tile_mfma<true>(Kt + par * NSA_TB, Vt + par * NSA_TB, btl2h, qf, n, hh, 64 * sblk, tq, 64 * sblk + 63 > t0 + 8 * wave, ((mymask >> sblk) & 1u) != 0u, 1 << 30, m, l, o);
                __syncthreads();
                par ^= 1;
            }
            const float inv = l > 0.f ? gate[1] / l : 0.f;
#pragma unroll
            for (int db = 0; db < 2; ++db)
#pragma unroll
                for (int k = 0; k < 8; ++k) { const unsigned w = stash[(db * 8 + k) * 64]; stash[(db * 8 + k) * 64] = pk2(bf_lo(w) + inv * o[db][2 * k], bf_hi(w) + inv * o[db][2 * k + 1]); }
        }
        {
            float m = -1e30f, l = 0.f; f32x16 o[2];
#pragma unroll
            for (int db = 0; db < 2; ++db)
#pragma unroll
                for (int r = 0; r < 16; ++r) o[db][r] = 0.f;
            const int kt0 = (t0 - 511 > 0 ? t0 - 511 : 0) >> 6;
            NsaStage s0 = nsa_load(KW + (size_t)(b * SEQ + 64 * kt0) * 64, 64, P + (size_t)(b * SEQ + 64 * kt0) * NP + C_KV + 320, NP, tid), s1;
            if (kt0 < qt) s1 = nsa_load(KW + (size_t)(b * SEQ + 64 * (kt0 + 1)) * 64, 64, P + (size_t)(b * SEQ + 64 * (kt0 + 1)) * NP + C_KV + 320, NP, tid);
            __syncthreads();
            nsa_store(s0, Kt, Vt, tid);
            __syncthreads();
            int par = 0;
            for (int kt = kt0; kt <= qt; ++kt) {
                if (kt < qt) { nsa_store(s1, Kt + (par ^ 1) * NSA_TB, Vt + (par ^ 1) * NSA_TB, tid);
                    if (kt + 2 <= qt) s1 = nsa_load(KW + (size_t)(b * SEQ + 64 * (kt + 2)) * 64, 64, P + (size_t)(b * SEQ + 64 * (kt + 2)) * NP + C_KV + 320, NP, tid); }
                nsa_tile_mfma<false>(Kt + par * NSA_TB, Vt + par * NSA_TB, btl2h, qf, n, hh, 64 * kt, tq, !(64 * kt + 63 <= t0 + 8 * wave && t0 + 8 * wave + 7 - 64 * kt <= 511), true, 511, m, l, o);
                __syncthreads();
                par ^= 1;
            }
            const float inv = l > 0.f ? gate[2] / l : 0.f;
#pragma unroll
            for (int db = 0; db < 2; ++db)
#pragma unroll
                for (int k = 0; k < 8; ++k) { const unsigned w = stash[(db * 8 + k) * 64]; yacc[db][2 * k] = bf_lo(w) + inv * o[db][2 * k]; yacc[db][2 * k + 1] = bf_hi(w) + inv * o[db][2 * k + 1]; }
        }
#pragma unroll
        for (int db = 0; db < 2; ++db)
#pragma unroll
            for (int rq = 0; rq < 4; ++rq) { u32x2 w; w.x = pk2(yacc[db][4 * rq], yacc[db][4 * rq + 1]); w.y = pk2(yacc[db][4 * rq + 2], yacc[db][4 * rq + 3]);
                *(u32x2*)(Y + (size_t)tok * DM + 512 + h * 64 + db * 32 + 8 * rq + 4 * hh) = w; }
        __syncthreads();
    }
}

constexpr int RT_PITCH = 2064;
__device__ __forceinline__ void ph_router(const ArgsG& a, int l, const float* Xin_, const bf16* Dm, LAS unsigned char* lds, int bid, int G, int tid, int wave, int lane) {
    LAS unsigned char* Ht = lds;
    LAS float* LG = (LAS float*)(lds + 32 * RT_PITCH);
    LAS int* lcnt = (LAS int*)(lds + 32 * RT_PITCH + 4 * 64 * 33 * 4); LAS int* asg_e = lcnt + 32; LAS int* asg_p = asg_e + 256; LAS float* asg_w = (LAS float*)(asg_p + 256); LAS int* gbase = (LAS int*)(asg_w + 256);
    bf16* H2 = (bf16*)(a.W() + WS_XN); unsigned* cnt = (unsigned*)(a.W() + WS_CTL) + CW_CNT + 64 * l;
    int* EIDX = (int*)(a.W() + WS_EIDX); int* EPOS = (int*)(a.W() + WS_EPOS); float* EW = (float*)(a.W() + WS_EW);
    const float* fw = a.I(17) + (size_t)l * DM; const float* rb = a.I(19) + l * NE;
    const bf16* RWH = (const bf16*)(a.W() + WS_RWH) + (size_t)l * NE * DM; const bf16* RWL = (const bf16*)(a.W() + WS_RWL) + (size_t)l * NE * DM;
    for (int u = bid; u < NT / 64; u += G) {
        const int tok0 = u * 64;
        if (tid < 32) lcnt[tid] = 0;
#pragma unroll 1
        for (int hf = 0; hf < 2; ++hf) {
            __syncthreads();
#pragma unroll 1
            for (int i = 0; i < 4; ++i) { const int tl = 4 * wave + i, tok = tok0 + 32 * hf + tl;
                f32x4 v[4]; float ss = 0.f;
#pragma unroll
                for (int j = 0; j < 4; ++j) { v[j] = *(const f32x4*)(Xin_ + (size_t)tok * DM + 4 * (64 * j + lane)); const u32x2 dd = *(const u32x2*)(Dm + (size_t)tok * DM + 4 * (64 * j + lane));
                    v[j].x += bf_lo(dd.x); v[j].y += bf_hi(dd.x); v[j].z += bf_lo(dd.y); v[j].w += bf_hi(dd.y); ss += (v[j].x * v[j].x + v[j].y * v[j].y) + (v[j].z * v[j].z + v[j].w * v[j].w); }
                const float r = rsqrtf(wave_sum(ss) * (1.0f / DM) + EPS);
#pragma unroll
                for (int j = 0; j < 4; ++j) { const f32x4 y = v[j] * r * *(const f32x4*)(fw + 4 * (64 * j + lane));
                    u32x2 o; o.x = pk2(y.x, y.y); o.y = pk2(y.z, y.w); *(u32x2*)(H2 + (size_t)tok * DM + 4 * (64 * j + lane)) = o;
                    *(LAS u32x2*)(Ht + tl * RT_PITCH + 8 * (64 * j + lane)) = o; } }
            __syncthreads();
            { const int r = lane & 15, q = lane >> 4, tile = wave & 1, kq = wave >> 1; f32x4 acc0 = {0.f, 0.f, 0.f, 0.f}, acc1 = {0.f, 0.f, 0.f, 0.f};
                const LAS unsigned char* arow = Ht + (16 * tile + r) * RT_PITCH + q * 16;
                const bf16* bh = RWH + (size_t)r * DM + 8 * q; const bf16* bl = RWL + (size_t)r * DM + 8 * q;
#pragma unroll
                for (int s8 = 0; s8 < 8; ++s8) { const int s = 8 * kq + s8; const bf16x8 af = *(const LAS bf16x8*)(arow + s * 64);
                    acc0 = __builtin_amdgcn_mfma_f32_16x16x32_bf16(af, *(const bf16x8*)(bh + 32 * s), acc0, 0, 0, 0); acc0 = __builtin_amdgcn_mfma_f32_16x16x32_bf16(af, *(const bf16x8*)(bl + 32 * s), acc0, 0, 0, 0);
                    acc1 = __builtin_amdgcn_mfma_f32_16x16x32_bf16(af, *(const bf16x8*)(bh + 16 * DM + 32 * s), acc1, 0, 0, 0); acc1 = __builtin_amdgcn_mfma_f32_16x16x32_bf16(af, *(const bf16x8*)(bl + 16 * DM + 32 * s), acc1, 0, 0, 0); }
                const float b0 = kq == 0 ? rb[r] : 0.f, b1 = kq == 0 ? rb[16 + r] : 0.f;
#pragma unroll
                for (int i = 0; i < 4; ++i) { LAS float* lg = LG + kq * (64 * 33) + (32 * hf + 16 * tile + 4 * q + i) * 33; lg[r] = acc0[i] + b0; lg[16 + r] = acc1[i] + b1; } }
        }
        __syncthreads();
        if (tid < 64) { const LAS float* lg = LG + tid * 33; unsigned used = 0u; float tv[4]; int ti[4];
#pragma unroll
            for (int qn = 0; qn < 4; ++qn) { float best = -3.0e38f; int bi = 0;
                for (int e = 0; e < NE; ++e) { const float v = ((lg[e] + lg[64 * 33 + e]) + lg[2 * 64 * 33 + e]) + lg[3 * 64 * 33 + e]; if (!((used >> e) & 1u) && v > best) { best = v; bi = e; } }
                used |= 1u << bi; tv[qn] = best; ti[qn] = bi; }
            float ew[4], es = 0.f;
#pragma unroll
            for (int qn = 0; qn < 4; ++qn) { ew[qn] = __expf(tv[qn] - tv[0]); es += ew[qn]; }
#pragma unroll
            for (int qn = 0; qn < 4; ++qn) { const int p = __hip_atomic_fetch_add(&lcnt[ti[qn]], 1, __ATOMIC_RELAXED, __HIP_MEMORY_SCOPE_WORKGROUP); asg_e[tid * 4 + qn] = ti[qn]; asg_p[tid * 4 + qn] = p; asg_w[tid * 4 + qn] = ew[qn] / es; } }
        __syncthreads();
        if (tid < 32) gbase[tid] = (int)atomicAdd(&cnt[tid], (unsigned)lcnt[tid]);
        __syncthreads();
        if (tid < 256) { const int tok = tok0 + (tid >> 2), k = tid & 3, e = asg_e[tid];
            EIDX[(size_t)tok * 4 + k] = e; EPOS[(size_t)tok * 4 + k] = gbase[e] + asg_p[tid]; EW[(size_t)tok * 4 + k] = asg_w[tid]; }
        __syncthreads();
    }
}

__device__ __forceinline__ void build_tiles(const unsigned* cnt, LAS int* TS, LAS int* TE, int tid) {
    if (tid == 0) { int acc = 0;
        for (int e = 0; e < NE; ++e) { TS[e] = acc; const int nt = (int)((cnt[e] + 255u) >> 8); for (int i = 0; i < nt; ++i) TE[acc + i] = e; acc += nt; }
        TS[NE] = acc; }
    __syncthreads();
}

__device__ __forceinline__ void ph_gather(const ArgsG& a, int l, LAS unsigned char* lds, int gw, int NGW, int tid, int lane) {
    LAS int* TS = (LAS int*)(lds + TS_OFF); LAS int* TE = (LAS int*)(lds + TE_OFF);
    const unsigned* cnt = (const unsigned*)(a.W() + WS_CTL) + CW_CNT + 64 * l;
    build_tiles(cnt, TS, TE, tid);
    const int* EIDX = (const int*)(a.W() + WS_EIDX); const int* EPOS = (const int*)(a.W() + WS_EPOS); int* SLOT = (int*)(a.W() + WS_SLOT); int* S2T = (int*)(a.W() + WS_XS);
    for (int i = gw * 64 + lane; i < NT * 4; i += NGW * 64) { const int slot = TS[EIDX[i]] * 256 + EPOS[i]; SLOT[i] = slot; S2T[slot] = i >> 2; }
    for (int e = (int)blockIdx.x; e < NE; e += (int)gridDim.x) { const int beg = TS[e] * 256 + (int)cnt[e], end = TS[e + 1] * 256; for (int sidx = beg + tid; sidx < end; sidx += NTHR) S2T[sidx] = 0; }
}

__device__ __forceinline__ void ph_combine(const ArgsG& a, const float* Xin_, const bf16* Dm, float* Xo, const float* next_norm_w, int gw, int NGW, int lane) {
    const bf16* YS = (const bf16*)(a.W() + WS_YS); const int* SLOT = (const int*)(a.W() + WS_SLOT); const float* EW = (const float*)(a.W() + WS_EW); bf16* XN = (bf16*)(a.W() + WS_XN);
    for (int tok = gw; tok < NT; tok += NGW) {
        int slot = 0; float wgt = 0.f;
        if (lane < 4) { slot = SLOT[(size_t)tok * 4 + lane]; wgt = EW[(size_t)tok * 4 + lane]; }
        f32x4 v[4];
#pragma unroll
        for (int j = 0; j < 4; ++j) { v[j] = *(const f32x4*)(Xin_ + (size_t)tok * DM + 4 * (64 * j + lane)); const u32x2 dd = *(const u32x2*)(Dm + (size_t)tok * DM + 4 * (64 * j + lane));
            v[j].x += bf_lo(dd.x); v[j].y += bf_hi(dd.x); v[j].z += bf_lo(dd.y); v[j].w += bf_hi(dd.y); }
#pragma unroll
        for (int k = 0; k < 4; ++k) { const int sk = __shfl(slot, k); const float wk = __shfl(wgt, k);
#pragma unroll
            for (int j = 0; j < 4; ++j) { const u32x2 y = *(const u32x2*)(YS + (size_t)sk * DM + 4 * (64 * j + lane));
                v[j].x += wk * bf_lo(y.x); v[j].y += wk * bf_hi(y.x); v[j].z += wk * bf_lo(y.y); v[j].w += wk * bf_hi(y.y); } }
#pragma unroll
        for (int j = 0; j < 4; ++j) *(f32x4*)(Xo + (size_t)tok * DM + 4 * (64 * j + lane)) = v[j];
        if (next_norm_w) rms_row_to_bf16(v, next_norm_w, XN + (size_t)tok * DM, lane);
    }
}

struct Tid { int tid, lane, wave; };
__device__ __forceinline__ Tid fresh_tid() { int t = threadIdx.x; asm volatile("" : "+v"(t)); Tid r; r.tid = t; r.lane = t & 63; r.wave = __builtin_amdgcn_readfirstlane(t >> 6); return r; }
#define FT() ArgsG A_; { unsigned char* w_ = args_k.ws; asm volatile("" : "+s"(w_)); A_.ws = (GAS unsigned char*)w_; _Pragma("unroll") for (int i_ = 0; i_ < 25; ++i_) A_.in[i_] = (const GAS float*)args_k.in[i_]; A_.out = (GAS float*)args_k.out; } const ArgsG& args = A_; const Tid T_ = fresh_tid(); const int tid = T_.tid, lane = T_.lane, wave = T_.wave, gw = bid * NWAVES + wave; (void)tid; (void)lane; (void)wave; (void)gw
constexpr int PH_PER_LAYER = 11, NPH = 2 + NLAYER * PH_PER_LAYER;

#if SINGLE_LAUNCH
#define BARPARM , unsigned* barw, unsigned& bark
#define BARARG , barw, bark
#define GRID_BAR() cnt_barrier(barw, bark)
#else
#define BARPARM
#define BARARG
#define GRID_BAR() do {} while (0)
#endif
#define IN(k) (lo <= (k) && (k) < hi)
#define SEAM(k) do { if (IN(k) && IN((k) + 1)) GRID_BAR(); } while (0)
template <int l>
__device__ __forceinline__ void run_layer(const Args& args_k, LAS unsigned char* lds, int lo, int hi, int G, int bid, int NGW BARPARM) {
        const int pb = 2 + l * PH_PER_LAYER;
#define Xin ((l == 0) ? args.I(0) : (const float*)(args.W() + WS_XB))
#define X1 ((float*)(args.W() + WS_XA))
#define Xout ((l == NLAYER - 1) ? args.O() : (float*)(args.W() + WS_XB))
        if (IN(pb + 0)) {
            FT(); pg8::Gemm g{(const pg8::bf16_t*)(args.W() + WS_XN), (const pg8::bf16_t*)(args.W() + WS_WIN) + (size_t)l * NP * DM, NT, NP, DM};
            pg8::StaticOrder S; S.init(NT, NP, G, bid);
            pg8::EpiBf16Plain E{(pg8::bf16_t*)(args.W() + WS_P), NP};
            pg8::gemm_phase<pg8::EpiBf16Plain, pg8::StaticOrder, true, true>(lds, g, S, E);
        } SEAM(pb + 0);
        if (IN(pb + 1)) { { FT(); ph_compress_mfma(args, l, lds, bid, G, tid, wave, lane); } { FT(); ph_m1(args, l, lds, bid, G, tid, wave, lane); } } SEAM(pb + 1);
        if (IN(pb + 2)) { FT(); ph_dn_chunk_mfma(args, lds, bid, G, tid, wave, lane); } SEAM(pb + 2);
        if (IN(pb + 3)) {
            const bool small = G <= 64;
            if (small || bid < 32) { FT(); ph_dn_scan_mfma(args, lds, bid, small ? G : 32, tid, wave, lane); }
            { int ub, us, ue;
              if (small) { ub = bid; us = G; ue = 256; }
              else if (G == 256) { if (bid >= 32) { ub = bid - 32; us = 32; ue = ub >= 192 ? 256 : ub + 1; } else { ub = 256; us = 256; ue = 256; } }
              else { ub = bid >= 32 ? bid - 32 : 256; us = G - 32; ue = 256; }
              FT(); ph_nsa_mfma(args, lds, ub, us, ue, tid, wave, lane); } } SEAM(pb + 3);
        if (IN(pb + 4)) { FT(); ph_dn_out(args, l, gw, NGW, lane); } SEAM(pb + 4);
        if (IN(pb + 5)) {
            FT(); pg8::Gemm g{(const pg8::bf16_t*)(args.W() + WS_Y), (const pg8::bf16_t*)(args.W() + WS_WOUT) + (size_t)l * DM * DM, NT, DM, DM};
            pg8::StaticOrder S; S.init(NT, DM, G, bid);
            pg8::EpiBf16Plain E{(pg8::bf16_t*)(args.W() + WS_XA), DM};
            pg8::gemm_phase<pg8::EpiBf16Plain, pg8::StaticOrder, true, true>(lds, g, S, E);
        } SEAM(pb + 5);
        if (IN(pb + 6)) { FT(); ph_router(args, l, Xin, (const bf16*)(args.W() + WS_XA), lds, bid, G, tid, wave, lane); } SEAM(pb + 6);
        if (IN(pb + 7)) { FT(); ph_gather(args, l, lds, gw, NGW, tid, lane); } SEAM(pb + 7);
        if (IN(pb + 8)) {
            FT(); LAS int* TS = (LAS int*)(lds + TS_OFF); LAS int* TE = (LAS int*)(lds + TE_OFF);
            build_tiles((const unsigned*)(args.W() + WS_CTL) + CW_CNT + 64 * l, TS, TE, tid);
            const int ntiles = __builtin_amdgcn_readfirstlane(TS[NE]);
            pg8::Gemm g{(const pg8::bf16_t*)(args.W() + WS_XN), (const pg8::bf16_t*)(args.W() + WS_WGU) + (size_t)l * NE * 2048 * DM, ntiles * 256, NE * 2048, DM};
            LAS int* RT = (LAS int*)(lds + LDSCTL_OFF + 2048);
            pg8::MoeOrder<8, true> S{ntiles, G, bid, (const LAS int*)TE, (const LAS int*)RT};
            { const int* S2T = (const int*)(args.W() + WS_XS); pg8::Unit uu; for (int i = 0; i < 10 && S.next(i, uu); ++i) if (tid < 256) RT[i * 256 + tid] = S2T[(size_t)uu.pm * 256 + tid]; }
            __syncthreads();
            pg8::EpiSwiglu E{(pg8::bf16_t*)(args.W() + WS_ACT), args.I(21) + (size_t)l * NE * 2048};
            pg8::gemm_phase<pg8::EpiSwiglu, pg8::MoeOrder<8, true>, true, true>(lds, g, S, E);
        } SEAM(pb + 8);
        if (IN(pb + 9)) {
            FT(); LAS int* TS = (LAS int*)(lds + TS_OFF); LAS int* TE = (LAS int*)(lds + TE_OFF);
            build_tiles((const unsigned*)(args.W() + WS_CTL) + CW_CNT + 64 * l, TS, TE, tid);
            const int ntiles = __builtin_amdgcn_readfirstlane(TS[NE]);
            pg8::Gemm g{(const pg8::bf16_t*)(args.W() + WS_ACT), (const pg8::bf16_t*)(args.W() + WS_WD) + (size_t)l * NE * DM * DM, ntiles * 256, NE * DM, DM};
            pg8::MoeOrder<4> S{ntiles, G, bid, (const LAS int*)TE};
            pg8::EpiDown64 E{(pg8::bf16_t*)(args.W() + WS_YS), args.I(23) + (size_t)l * NE * DM};
            pg8::gemm_phase<pg8::EpiDown64, pg8::MoeOrder<4>, true, true>(lds, g, S, E);
        } SEAM(pb + 9);
        if (IN(pb + 10)) { FT(); ph_combine(args, Xin, (const bf16*)(args.W() + WS_XA), Xout, (l + 1 < NLAYER) ? args.I(1) + (size_t)(l + 1) * DM : nullptr, gw, NGW, lane); }
        if (l + 1 < NLAYER) SEAM(pb + 10);
    }

__global__ void __launch_bounds__(NTHR, 2) fwd_kernel(Args args_k) {
    extern __shared__ __attribute__((aligned(16))) unsigned char lds_raw[];
    LAS unsigned char* lds = (LAS unsigned char*)lds_raw;
    const int G = gridDim.x, bid = blockIdx.x, NGW = G * NWAVES;
    for (int u = threadIdx.x; u < (LDS_BYTES - LDSCTL_OFF) / 4; u += NTHR) ((LAS unsigned*)(lds + LDSCTL_OFF))[u] = 0u;
    __syncthreads();
#if SINGLE_LAUNCH
    unsigned* barw = (unsigned*)(args_k.ws + WS_CTL) + CW_BAR; unsigned bark = 0u;
#endif
    const int lo = args_k.ph_lo, hi = args_k.ph_hi;

    if (IN(0)) { FT(); ph_prologue(args, lds, gw, NGW, wave, lane); } SEAM(0);
    if (IN(1)) { FT(); ph_norm0(args, gw, NGW, lane); } SEAM(1);

    run_layer<0>(args_k, lds, lo, hi, G, bid, NGW BARARG);
    run_layer<1>(args_k, lds, lo, hi, G, bid, NGW BARARG);
#undef IN
#undef SEAM
}

extern "C" void kernel_launch(void* const* d_in, const int* in_sizes, int n_in, void* d_out, int out_size, void* d_ws, size_t ws_size, hipStream_t stream) {
    static int grid = 0;
    if (grid == 0) {
        if (n_in != 25 || in_sizes[0] != NT * DM || out_size != NT * DM || ws_size < WS_END) {
            fprintf(stderr, "kernel_launch: unexpected problem (n_in %d, in0 %d, out %d, ws %zu < %zu); nothing launched\n", n_in, n_in > 0 ? in_sizes[0] : -1, out_size, ws_size, (size_t)WS_END); grid = -1; return; }
        int dev = 0, cus = 0, per_cu = 0;
        if (hipGetDevice(&dev) != hipSuccess || hipDeviceGetAttribute(&cus, hipDeviceAttributeMultiprocessorCount, dev) != hipSuccess) { grid = -1; return; }
        if (hipFuncSetAttribute((const void*)fwd_kernel, hipFuncAttributeMaxDynamicSharedMemorySize, LDS_BYTES) != hipSuccess) { fprintf(stderr, "kernel_launch: hipFuncSetAttribute failed\n"); grid = -1; return; }
        if (hipOccupancyMaxActiveBlocksPerMultiprocessor(&per_cu, (const void*)fwd_kernel, NTHR, LDS_BYTES) != hipSuccess || per_cu < 1)
            fprintf(stderr, "kernel_launch: note: occupancy query reports %d workgroups per CU\n", per_cu);
        (void)hipGetLastError();
        grid = cus;
    }
    if (grid < 0) return;
    if (hipMemsetAsync((char*)d_ws + WS_CTL, 0, CTL_ZERO_BYTES, stream) != hipSuccess) { fprintf(stderr, "kernel_launch: memset failed\n"); return; }
    Args a{};
    for (int i = 0; i < 25; ++i) a.in[i] = (const float*)d_in[i];
    a.out = (float*)d_out; a.ws = (unsigned char*)d_ws;
#if SINGLE_LAUNCH
    a.ph_lo = 0; a.ph_hi = NPH;
    hipLaunchKernelGGL(fwd_kernel, dim3(grid), dim3(NTHR), LDS_BYTES, stream, a);
#else
    for (int ph = 0; ph < NPH; ++ph) { a.ph_lo = ph; a.ph_hi = ph + 1; hipLaunchKernelGGL(fwd_kernel, dim3(grid), dim3(NTHR), LDS_BYTES, stream, a); }
#endif
}
```

```cpp
#include <hip/hip_runtime.h>
#include <cstdio>
#include <cstdint>
#include <cstddef>
namespace pg8 {
#define PG8_LAS __attribute__((address_space(3)))
#define PG8_GAS __attribute__((address_space(1)))
typedef unsigned short bf16_t;
typedef short bf16x8 __attribute__((ext_vector_type(8)));
typedef float f32x4 __attribute__((ext_vector_type(4)));
typedef unsigned u32x4 __attribute__((ext_vector_type(4)));
constexpr int BM = 256, BK = 64, HALF = 128, HTB = HALF * BK * 2  , STAGE_BYTES = 8 * HTB, NXCD = 8, WGM = 8;

__host__ __device__ __forceinline__ int lds_byte(int r, int c) { const int st = (r >> 4) * 2 + (c >> 5), rr = r & 15, cc = c & 31, ob = rr * 64 + cc * 2; return st * 1024 + (ob ^ (((ob >> 9) & 1) << 5)); }
__host__ __device__ __forceinline__ void stage_rc(int b, int& R, int& C) { const int st = b / 1024, sb = b % 1024, swz = sb ^ (((sb >> 9) & 1) << 5); R = (st >> 1) * 16 + swz / 64; C = (st & 1) * 32 + (swz % 64) / 2; }
__host__ __device__ __forceinline__ int perm32(int rho) { const int n = rho >> 4, i = rho & 15; return 8 * (i >> 2) + 4 * n + (i & 3); }

struct Unit { int pm, pn; };
struct Gemm { const bf16_t* A; const bf16_t* Bt; int M, N, K; };

struct StaticOrder {
    static constexpr bool GATHER = false; const PG8_LAS int* rowtab = nullptr;
    int nM, nN, nwg, G, c;
    __host__ __device__ void init(int M, int N, int G_, int c_) { nM = M / BM; nN = N / BM; nwg = nM * nN; G = G_; c = c_; }
    __host__ __device__ bool next(int i, Unit& u) const {
        const long L = (long)i * G + c; if (L >= nwg) return false;
        int wgid = (int)L; { const int q = nwg / NXCD, r = nwg % NXCD, xcd = wgid % NXCD, off = wgid / NXCD; wgid = (xcd < r ? xcd * (q + 1) : r * (q + 1) + (xcd - r) * q) + off; }
        const int nig = WGM * nN, gid = wgid / nig, fm = gid * WGM, gsz = (nM - fm) < WGM ? (nM - fm) : WGM;
        u.pm = fm + ((wgid % nig) % gsz); u.pn = (wgid % nig) / gsz; return true;
    }
    __device__ __forceinline__ void a_ready(const Unit&) const {}
    __device__ __forceinline__ void done(const Unit&) const {}
};

__device__ __forceinline__ unsigned cvt_pk_bf16(float lo, float hi) { unsigned r; asm volatile("v_cvt_pk_bf16_f32 %0, %1, %2" : "=v"(r) : "v"(lo), "v"(hi)); return r; }

struct EpiBf16Plain {
    static constexpr bool PERM = true, AFTER_DRAIN = false, B64 = false;
    bf16_t* O; int ldc;
    __device__ __forceinline__ void operator()(const f32x4 (&acc)[2][2][4][2], const Unit& u, int wr, int wc, int fr, int fq) const {
        const int row0 = u.pm * BM + wr * 64 + fr, col0 = u.pn * BM + wc * 32 + 8 * fq;
#pragma unroll
        for (int ai = 0; ai < 2; ++ai)
#pragma unroll
            for (int m = 0; m < 4; ++m) { bf16_t* rowp = O + (size_t)(row0 + ai * HALF + m * 16) * ldc + col0;
#pragma unroll
                for (int bj = 0; bj < 2; ++bj) { const f32x4 v0 = acc[ai][bj][m][0], v1 = acc[ai][bj][m][1];
                    u32x4 w; w.x = cvt_pk_bf16(v0[0], v0[1]); w.y = cvt_pk_bf16(v0[2], v0[3]); w.z = cvt_pk_bf16(v1[0], v1[1]); w.w = cvt_pk_bf16(v1[2], v1[3]);
                    *(PG8_GAS u32x4*)(rowp + bj * HALF) = w; } }
    }
};
struct EpiResF32 {
    static constexpr bool PERM = false, AFTER_DRAIN = false, B64 = false;
    const float* base; float* out; int ldc;
    __device__ __forceinline__ void operator()(const f32x4 (&acc)[2][2][4][2], const Unit& u, int wr, int wc, int fr, int fq) const {
        const int row0 = u.pm * BM + wr * 64 + fr, col0 = u.pn * BM + wc * 32 + 4 * fq;
#pragma unroll
        for (int ai = 0; ai < 2; ++ai)
#pragma unroll
            for (int m = 0; m < 4; ++m) { const size_t off = (size_t)(row0 + ai * HALF + m * 16) * ldc + col0;
#pragma unroll
                for (int bj = 0; bj < 2; ++bj)
#pragma unroll
                    for (int n = 0; n < 2; ++n) { const f32x4 b = *(const f32x4*)(base + off + bj * HALF + n * 16); *(PG8_GAS f32x4*)(out + off + bj * HALF + n * 16) = b + acc[ai][bj][m][n]; } }
    }
};
struct EpiSwiglu {
    static constexpr bool PERM = true, AFTER_DRAIN = false, B64 = false;
    bf16_t* O; const float* bgu;
    __device__ __forceinline__ void operator()(const f32x4 (&acc)[2][2][4][2], const Unit& u, int wr, int wc, int fr, int fq) const {
        const int e = u.pn >> 3, pnl = u.pn & 7;
        const int row0 = u.pm * BM + wr * 64 + fr, gcol = pnl * 128 + wc * 32 + 8 * fq;
        const float* bg = bgu + (size_t)e * 2048 + gcol;
        f32x4 bgv[2], buv[2];
#pragma unroll
        for (int n = 0; n < 2; ++n) { bgv[n] = *(const PG8_GAS f32x4*)(bg + 4 * n); buv[n] = *(const PG8_GAS f32x4*)(bg + 1024 + 4 * n); }
#pragma unroll
        for (int ai = 0; ai < 2; ++ai)
#pragma unroll
            for (int m = 0; m < 4; ++m) { bf16_t* rowp = O + (size_t)(row0 + ai * HALF + m * 16) * 1024 + gcol;
                float r[8];
#pragma unroll
                for (int n = 0; n < 2; ++n) { const f32x4 gv = acc[ai][0][m][n] + bgv[n], uv = acc[ai][1][m][n] + buv[n];
#pragma unroll
                    for (int j = 0; j < 4; ++j) { const float g = fminf(gv[j], 7.0f), up = fminf(fmaxf(uv[j], -7.0f), 7.0f);
                        const float sg = __builtin_amdgcn_rcpf(1.0f + __expf(-1.702f * g)); r[n * 4 + j] = (up + 1.0f) * g * sg; } }
                u32x4 w; w.x = cvt_pk_bf16(r[0], r[1]); w.y = cvt_pk_bf16(r[2], r[3]); w.z = cvt_pk_bf16(r[4], r[5]); w.w = cvt_pk_bf16(r[6], r[7]);
                *(PG8_GAS u32x4*)rowp = w; }
    }
};
struct EpiDown {
    static constexpr bool PERM = true, AFTER_DRAIN = false, B64 = false;
    bf16_t* O; const float* bd;
    __device__ __forceinline__ void operator()(const f32x4 (&acc)[2][2][4][2], const Unit& u, int wr, int wc, int fr, int fq) const {
        const int e = u.pn >> 2, pnl = u.pn & 3;
        const int row0 = u.pm * BM + wr * 64 + fr, col0 = pnl * BM + wc * 32 + 8 * fq;
        const float* bp = bd + (size_t)e * 1024 + col0;
        f32x4 bv[2][2];
#pragma unroll
        for (int bj = 0; bj < 2; ++bj)
#pragma unroll
            for (int n = 0; n < 2; ++n) bv[bj][n] = *(const PG8_GAS f32x4*)(bp + bj * HALF + 4 * n);
#pragma unroll
        for (int ai = 0; ai < 2; ++ai)
#pragma unroll
            for (int m = 0; m < 4; ++m) { bf16_t* rowp = O + (size_t)(row0 + ai * HALF + m * 16) * 1024 + col0;
#pragma unroll
                for (int bj = 0; bj < 2; ++bj) { const f32x4 v0 = acc[ai][bj][m][0] + bv[bj][0], v1 = acc[ai][bj][m][1] + bv[bj][1];
                    u32x4 w; w.x = cvt_pk_bf16(v0[0], v0[1]); w.y = cvt_pk_bf16(v0[2], v0[3]); w.z = cvt_pk_bf16(v1[0], v1[1]); w.w = cvt_pk_bf16(v1[2], v1[3]);
                    *(PG8_GAS u32x4*)(rowp + bj * HALF) = w; } }
    }
};
struct EpiDown64 {
    static constexpr bool PERM = true, AFTER_DRAIN = false, B64 = true;
    bf16_t* O; const float* bd;
    __device__ __forceinline__ void operator()(const f32x4 (&acc)[2][2][4][2], const Unit& u, int wr, int wc, int fr, int fq) const {
        const int e = u.pn >> 2, pnl = u.pn & 3;
        const int row0 = u.pm * BM + wr * 64 + fr, col0 = pnl * BM + wc * 64 + 8 * fq;
        const float* bp = bd + (size_t)e * 1024 + col0;
        f32x4 bv[2][2];
#pragma unroll
        for (int bj = 0; bj < 2; ++bj)
#pragma unroll
            for (int n = 0; n < 2; ++n) bv[bj][n] = *(const PG8_GAS f32x4*)(bp + bj * 32 + 4 * n);
#pragma unroll
        for (int ai = 0; ai < 2; ++ai)
#pragma unroll
            for (int m = 0; m < 4; ++m) { bf16_t* rowp = O + (size_t)(row0 + ai * HALF + m * 16) * 1024 + col0;
#pragma unroll
                for (int bj = 0; bj < 2; ++bj) { const f32x4 v0 = acc[ai][bj][m][0] + bv[bj][0], v1 = acc[ai][bj][m][1] + bv[bj][1];
                    u32x4 w; w.x = cvt_pk_bf16(v0[0], v0[1]); w.y = cvt_pk_bf16(v0[2], v0[3]); w.z = cvt_pk_bf16(v1[0], v1[1]); w.w = cvt_pk_bf16(v1[2], v1[3]);
                    *(PG8_GAS u32x4*)(rowp + bj * 32) = w; } }
    }
};
struct EpiBf16Plain64 {
    static constexpr bool PERM = true, AFTER_DRAIN = false, B64 = true;
    bf16_t* O; int ldc;
    __device__ __forceinline__ void operator()(const f32x4 (&acc)[2][2][4][2], const Unit& u, int wr, int wc, int fr, int fq) const {
        const int row0 = u.pm * BM + wr * 64 + fr, col0 = u.pn * BM + wc * 64 + 8 * fq;
#pragma unroll
        for (int ai = 0; ai < 2; ++ai)
#pragma unroll
            for (int m = 0; m < 4; ++m) { bf16_t* rowp = O + (size_t)(row0 + ai * HALF + m * 16) * ldc + col0;
#pragma unroll
                for (int bj = 0; bj < 2; ++bj) { const f32x4 v0 = acc[ai][bj][m][0], v1 = acc[ai][bj][m][1];
                    u32x4 w; w.x = cvt_pk_bf16(v0[0], v0[1]); w.y = cvt_pk_bf16(v0[2], v0[3]); w.z = cvt_pk_bf16(v1[0], v1[1]); w.w = cvt_pk_bf16(v1[2], v1[3]);
                    *(PG8_GAS u32x4*)(rowp + bj * 32) = w; } }
    }
};
template <int NPN, bool GATHER_ = false> struct MoeOrder {
    static constexpr bool GATHER = GATHER_;
    int ntiles, G, c; const PG8_LAS int* texp; const PG8_LAS int* rowtab = nullptr;
    __device__ __forceinline__ bool next(int i, Unit& u) const {
        constexpr int MT = 32 / NPN; int mt, pn;
        if (G == 256) { const int chunk = i * 8 + (c & 7), r = c >> 3; pn = r / MT; mt = chunk * MT + (r % MT); }
        else { const int L = i * G + c; mt = L / NPN; pn = L % NPN; }
        mt = __builtin_amdgcn_readfirstlane(mt); if (mt >= ntiles) return false;
        const int e = __builtin_amdgcn_readfirstlane(texp[mt]);
        u.pm = mt; u.pn = e * NPN + pn; return true;
    }
    __device__ __forceinline__ void a_ready(const Unit&) const {}
    __device__ __forceinline__ void done(const Unit&) const {}
};

template <class Epi, class Sched, bool ALIGN_EPI = false, bool SP2 = false>
__device__ __forceinline__ void gemm_phase(PG8_LAS unsigned char* lds, const Gemm g, const Sched& S, const Epi& E) {
    int tid_ = threadIdx.x; asm volatile("" : "+v"(tid_));
    const int tid = tid_, wid = __builtin_amdgcn_readfirstlane(tid >> 6), lane = tid & 63, wr = wid >> 2, wc = wid & 3, fr = lane & 15, fq = lane >> 4;
    const int K = g.K, nt = K / BK;
    constexpr bool GA = Sched::GATHER;
    static_assert(!GA || SP2, "gathered A rows: SP2 loop only");
    unsigned voffA[2], voffB[2]; int RA[2], CA2[2];
#pragma unroll
    for (int i = 0; i < 2; ++i) { int R, C; stage_rc(tid * 16 + i * 8192, R, C); RA[i] = R; CA2[i] = C * 2; const int Rb = Epi::B64 ? ((R >> 5) * 64 + perm32(R & 31)) : (Epi::PERM ? ((R & ~31) + perm32(R & 31)) : R);
        voffA[i] = (unsigned)(R * K + C) * 2u; voffB[i] = (unsigned)(Rb * K + C) * 2u; }
    const size_t kstep = (size_t)(BK * 2);
    const size_t hstep = (size_t)HALF * K * 2;
    const size_t tstep = 2 * hstep;
    const size_t hstepB = Epi::B64 ? (size_t)32 * K * 2 : hstep;
    const unsigned ldsw = (unsigned)wid * 1024u;
    const int aoff = lds_byte(wr * 64 + fr, fq * 8), boff = lds_byte(wc * 32 + fr, fq * 8);
#define PG8_SA(b, h) (((b) * 2 + (h)) * HTB)
#define PG8_SB(b, h) ((4 + (b) * 2 + (h)) * HTB)
#define PG8_STAGE(bufoff, gbase, voff) do { _Pragma("unroll") for (int _i = 0; _i < 2; ++_i) \
        __builtin_amdgcn_global_load_lds((const unsigned*)((const char*)(gbase) + (voff)[_i]), (PG8_LAS unsigned*)(lds + (bufoff) + ldsw + _i * 8192), 16, 0, 0); } while (0)
#define PG8_STAGE_A(bufoff, ptr, h, V) do { if constexpr (GA) PG8_STAGE(bufoff, ptr, V[h]); else PG8_STAGE(bufoff, (ptr) + (h) * hstep, voffA); } while (0)
#define PG8_ROWOFF(V, uidx) do { _Pragma("unroll") for (int h_ = 0; h_ < 2; ++h_) _Pragma("unroll") for (int i_ = 0; i_ < 2; ++i_) V[h_][i_] = (unsigned)S.rowtab[(uidx) * 256 + h_ * 128 + RA[i_]] * (unsigned)(K * 2) + (unsigned)CA2[i_]; } while (0)
#define PG8_LDA(dst, b, h) do { _Pragma("unroll") for (int m = 0; m < 4; ++m) _Pragma("unroll") for (int k = 0; k < 2; ++k) dst[m][k] = *(const PG8_LAS bf16x8*)(lds + PG8_SA(b, h) + aoff + m * 2048 + k * 1024); } while (0)
#define PG8_LDB(dst, b, h) do { _Pragma("unroll") for (int n = 0; n < 2; ++n) _Pragma("unroll") for (int k = 0; k < 2; ++k) dst[n][k] = *(const PG8_LAS bf16x8*)(lds + PG8_SB(b, h) + boff + n * 2048 + k * 1024); } while (0)
#define PG8_MMA(ai, bj, At, Bt) do { __builtin_amdgcn_s_setprio(1); _Pragma("unroll") for (int m = 0; m < 4; ++m) _Pragma("unroll") for (int n = 0; n < 2; ++n) _Pragma("unroll") for (int k = 0; k < 2; ++k) \
        acc[ai][bj][m][n] = __builtin_amdgcn_mfma_f32_16x16x32_bf16(Bt[n][k], At[m][k], acc[ai][bj][m][n], 0, 0, 0); __builtin_amdgcn_s_setprio(0); } while (0)
#define PG8_WAIT_V(n) asm volatile("s_waitcnt vmcnt(" #n ")" ::: "memory")
#define PG8_WAIT_L(n) asm volatile("s_waitcnt lgkmcnt(" #n ")" ::: "memory")
#define PG8_BAR __builtin_amdgcn_s_barrier()
#define PG8_SCHED __builtin_amdgcn_sched_barrier(0)
    Unit cur, nxt; int ui = 0;
    if (!S.next(0, cur)) return;
    f32x4 acc[2][2][4][2];
#pragma unroll
    for (int a = 0; a < 2; ++a)
#pragma unroll
        for (int b = 0; b < 2; ++b)
#pragma unroll
            for (int m = 0; m < 4; ++m)
#pragma unroll
                for (int n = 0; n < 2; ++n) acc[a][b][m][n] = (f32x4){0.f, 0.f, 0.f, 0.f};
    bf16x8 At[4][2], B0[2][2], B1[2][2];
    const char* cA = (const char*)g.A + (GA ? (size_t)0 : (size_t)cur.pm * tstep); const char* cB = (const char*)g.Bt + (size_t)cur.pn * tstep;
    unsigned vAc[2][2] = {{0u, 0u}, {0u, 0u}}, vAn[2][2] = {{0u, 0u}, {0u, 0u}};
    if constexpr (GA) { PG8_ROWOFF(vAc, 0); }
    S.a_ready(cur);
    if constexpr (SP2) {
        PG8_STAGE(PG8_SB(0, 0), cB, voffB); PG8_STAGE(PG8_SB(0, 1), cB + hstepB, voffB); PG8_STAGE_A(PG8_SA(0, 0), cA, 0, vAc); PG8_STAGE_A(PG8_SA(0, 1), cA, 1, vAc);
        if (wr == 1) PG8_BAR;
        PG8_WAIT_V(2); PG8_BAR;
        PG8_STAGE(PG8_SB(1, 0), cB + kstep, voffB); PG8_STAGE_A(PG8_SA(1, 0), cA + kstep, 0, vAc); PG8_STAGE(PG8_SB(1, 1), cB + hstepB + kstep, voffB);
        PG8_WAIT_V(6); PG8_BAR;
    } else {
        PG8_STAGE(PG8_SB(0, 0), cB, voffB); PG8_STAGE(PG8_SA(0, 0), cA, voffA); PG8_STAGE(PG8_SB(0, 1), cB + hstepB, voffB); PG8_STAGE(PG8_SA(0, 1), cA + hstep, voffA);
        if (wr == 1) PG8_BAR;
        PG8_WAIT_V(4); PG8_BAR;
        PG8_STAGE(PG8_SB(1, 0), cB + kstep, voffB); PG8_STAGE(PG8_SA(1, 0), cA + kstep, voffA); PG8_STAGE(PG8_SB(1, 1), cB + hstepB + kstep, voffB);
        PG8_WAIT_V(6); PG8_BAR;
    }
    for (;;) {
        const bool has_next = S.next(ui + 1, nxt);
        const char* nA = (has_next && !GA) ? (const char*)g.A + (size_t)nxt.pm * tstep : cA; const char* nB = has_next ? (const char*)g.Bt + (size_t)nxt.pn * tstep : cB;
        for (int t = 0; t < nt; t += 2) {
            const bool last = (t == nt - 2);
            const char* a1 = cA + (size_t)(t + 1) * kstep;
            const char* a2 = last ? nA : cA + (size_t)(t + 2) * kstep; const char* b2 = last ? nB : cB + (size_t)(t + 2) * kstep;
            const char* a3 = a2 + kstep; const char* b3 = b2 + kstep;
            if (last && has_next) S.a_ready(nxt);
            unsigned v2[2][2] = {{0u, 0u}, {0u, 0u}};
            if constexpr (GA) { if (last) { if (has_next) { PG8_ROWOFF(vAn, ui + 1); } else {
#pragma unroll
                        for (int h_ = 0; h_ < 2; ++h_) { vAn[h_][0] = vAc[h_][0]; vAn[h_][1] = vAc[h_][1]; } } }
#pragma unroll
                for (int h_ = 0; h_ < 2; ++h_) { v2[h_][0] = last ? vAn[h_][0] : vAc[h_][0]; v2[h_][1] = last ? vAn[h_][1] : vAc[h_][1]; } }
            if constexpr (SP2) {
            PG8_LDB(B0, 0, 0); PG8_LDB(B1, 0, 1); PG8_SCHED; PG8_LDA(At, 0, 0); PG8_STAGE_A(PG8_SA(1, 1), a1, 1, vAc);
            PG8_WAIT_V(8); PG8_WAIT_L(0); PG8_BAR; PG8_MMA(0, 0, At, B0); PG8_MMA(0, 1, At, B1); PG8_BAR; PG8_SCHED;
            PG8_LDA(At, 0, 1); PG8_STAGE(PG8_SB(0, 0), b2, voffB); PG8_STAGE(PG8_SB(0, 1), b2 + hstepB, voffB); PG8_STAGE_A(PG8_SA(0, 0), a2, 0, v2);
            PG8_WAIT_V(8); PG8_WAIT_L(0); PG8_BAR; PG8_MMA(1, 0, At, B0); PG8_MMA(1, 1, At, B1); PG8_BAR; PG8_SCHED;
            PG8_LDB(B0, 1, 0); PG8_LDB(B1, 1, 1); PG8_SCHED; PG8_LDA(At, 1, 0); PG8_STAGE_A(PG8_SA(0, 1), a2, 1, v2);
            PG8_WAIT_V(8); PG8_WAIT_L(0); PG8_BAR; PG8_MMA(0, 0, At, B0); PG8_MMA(0, 1, At, B1); PG8_BAR; PG8_SCHED;
            PG8_LDA(At, 1, 1); PG8_STAGE(PG8_SB(1, 0), b3, voffB); PG8_STAGE(PG8_SB(1, 1), b3 + hstepB, voffB); PG8_STAGE_A(PG8_SA(1, 0), a3, 0, v2);
            PG8_WAIT_V(8); PG8_WAIT_L(0); PG8_BAR; PG8_MMA(1, 0, At, B0); PG8_MMA(1, 1, At, B1); PG8_BAR; PG8_SCHED;
            } else {
            PG8_LDB(B0, 0, 0); PG8_SCHED; PG8_LDA(At, 0, 0); PG8_STAGE(PG8_SA(1, 1), a1 + hstep, voffA);
            PG8_WAIT_L(8); PG8_BAR; PG8_WAIT_L(0); PG8_MMA(0, 0, At, B0); PG8_BAR; PG8_SCHED;
            PG8_LDB(B1, 0, 1); PG8_STAGE(PG8_SB(0, 0), b2, voffB);
            PG8_BAR; PG8_WAIT_L(0); PG8_MMA(0, 1, At, B1); PG8_BAR;
            PG8_LDA(At, 0, 1); PG8_STAGE(PG8_SA(0, 0), a2, voffA);
            PG8_BAR; PG8_WAIT_L(0); PG8_MMA(1, 0, At, B0); PG8_BAR; PG8_SCHED;
            PG8_STAGE(PG8_SB(0, 1), b2 + hstepB, voffB);
            PG8_WAIT_V(6); PG8_BAR; PG8_MMA(1, 1, At, B1); PG8_BAR;
            PG8_LDB(B0, 1, 0); PG8_SCHED; PG8_LDA(At, 1, 0); PG8_STAGE(PG8_SA(0, 1), a2 + hstep, voffA);
            PG8_WAIT_L(8); PG8_BAR; PG8_WAIT_L(0); PG8_MMA(0, 0, At, B0); PG8_BAR; PG8_SCHED;
            PG8_LDB(B1, 1, 1); PG8_STAGE(PG8_SB(1, 0), b3, voffB);
            PG8_BAR; PG8_WAIT_L(0); PG8_MMA(0, 1, At, B1); PG8_BAR;
            PG8_LDA(At, 1, 1); PG8_STAGE(PG8_SA(1, 0), a3, voffA);
            PG8_BAR; PG8_WAIT_L(0); PG8_MMA(1, 0, At, B0); PG8_BAR; PG8_SCHED;
            PG8_STAGE(PG8_SB(1, 1), b3 + hstepB, voffB);
            PG8_WAIT_V(6); PG8_BAR; PG8_MMA(1, 1, At, B1); PG8_BAR;
            }
        }
        if constexpr (ALIGN_EPI) { if (wr == 0) PG8_BAR; }
        if constexpr (!Epi::AFTER_DRAIN) { E(acc, cur, wr, wc, fr, fq); S.done(cur); }
        if (!has_next) break;
#pragma unroll
        for (int a = 0; a < 2; ++a)
#pragma unroll
            for (int b = 0; b < 2; ++b)
#pragma unroll
                for (int m = 0; m < 4; ++m)
#pragma unroll
                    for (int n = 0; n < 2; ++n) acc[a][b][m][n] = (f32x4){0.f, 0.f, 0.f, 0.f};
        cur = nxt; cA = nA; cB = nB; ++ui;
        if constexpr (GA) {
#pragma unroll
            for (int h_ = 0; h_ < 2; ++h_) { vAc[h_][0] = vAn[h_][0]; vAc[h_][1] = vAn[h_][1]; } }
        if constexpr (ALIGN_EPI) { if (wr == 1) PG8_BAR; }
    }
    PG8_WAIT_V(0);
    if constexpr (!ALIGN_EPI) { if (wr == 0) PG8_BAR; }
    PG8_BAR;
    if constexpr (Epi::AFTER_DRAIN) { E.fused(acc, cur, wr, wc, fr, fq, lds, wid, lane); S.done(cur); }
#undef PG8_SA
#undef PG8_SB
#undef PG8_STAGE
#undef PG8_STAGE_A
#undef PG8_ROWOFF
#undef PG8_LDA
#undef PG8_LDB
#undef PG8_MMA
#undef PG8_WAIT_V
#undef PG8_WAIT_L
#undef PG8_BAR
#undef PG8_SCHED
}
}


#define GAS __attribute__((address_space(1)))
typedef unsigned short bf16;
typedef float f32x4 __attribute__((ext_vector_type(4)));
typedef unsigned u32x4 __attribute__((ext_vector_type(4)));
typedef unsigned u32x2 __attribute__((ext_vector_type(2)));
typedef short bf16x8 __attribute__((ext_vector_type(8)));
typedef float f32x16 __attribute__((ext_vector_type(16)));

#ifndef SINGLE_LAUNCH
#define SINGLE_LAUNCH 1
#endif

constexpr int NB = 8, SEQ = 2048, DM = 1024, NT = NB * SEQ, NLAYER = 2;
constexpr int DIN = 3220, NP = 3328;
constexpr int C_Q = 0, C_K = 512, C_V = 1024, C_Z = 1536, C_NQ = 2048, C_KV = 2304, C_CU = 2688, C_A = 3200, C_B = 3204, C_G = 3208;
constexpr int NE = 32, MAXT = 288;
constexpr int NWAVES = 8, NTHR = 512;
constexpr float EPS = 1e-6f;

constexpr size_t MiB = 1u << 20;
constexpr size_t WS_CTL = 0, CTL_ZERO_BYTES = 4096;
constexpr size_t WS_BT = 1 * MiB;
constexpr size_t WS_KCMP = 1 * MiB + 256 * 1024, WS_VCMP = 1 * MiB + 512 * 1024;
constexpr size_t WS_G = 2 * MiB, WS_BETA = 2 * MiB + 256 * 1024, WS_GC = 2 * MiB + 512 * 1024;
constexpr size_t WS_EIDX = 3 * MiB, WS_EPOS = 3 * MiB + 256 * 1024, WS_EW = 3 * MiB + 512 * 1024, WS_SLOT = 3 * MiB + 768 * 1024;
constexpr size_t WS_WIN = 4 * MiB;
constexpr size_t WS_WOUT = 17 * MiB;
constexpr size_t WS_WGU = 22 * MiB;
constexpr size_t WS_WD = 278 * MiB;
constexpr size_t WS_XA = 406 * MiB, WS_XB = 470 * MiB;
constexpr size_t WS_XN = 534 * MiB;
constexpr size_t WS_P = 566 * MiB;
constexpr size_t WS_QN = 670 * MiB, WS_KN = 686 * MiB, WS_VC = 702 * MiB;
constexpr size_t WS_U = 718 * MiB, WS_W = 750 * MiB;
constexpr size_t WS_ATT = 782 * MiB;
constexpr size_t WS_O = 798 * MiB;
constexpr size_t WS_NQ = 830 * MiB;
constexpr size_t WS_KS = 846 * MiB, WS_KW = 848 * MiB;
constexpr size_t WS_Y = 850 * MiB;
constexpr size_t WS_XS = 882 * MiB, WS_ACT = 1026 * MiB, WS_YS = 1170 * MiB;
constexpr size_t WS_KT = 1314 * MiB, WS_VT = 1330 * MiB;
constexpr size_t WS_W1T = 1346 * MiB;
constexpr size_t WS_POSW = 1349 * MiB;
constexpr size_t WS_RWH = 1350 * MiB, WS_RWL = 1351 * MiB;
constexpr size_t WS_END = 1352 * MiB;

constexpr int CW_TMO = 0, CW_BAR = 64, CW_CNT = 512;

constexpr int RING_BYTES = 131072;
constexpr int LDSCTL_OFF = RING_BYTES, MISC_OFF = LDSCTL_OFF, TS_OFF = LDSCTL_OFF + 128, TE_OFF = LDSCTL_OFF + 320;
constexpr int LDS_BYTES = 147456;
static_assert(TE_OFF + MAXT * 4 + 64 <= LDSCTL_OFF + 2048 && LDSCTL_OFF + 2048 + 10 * 1024 <= LDS_BYTES, "LDS map");

#define XB_TMO      128
#define XB_XCNT(j)  (256  + 64 * (j))
#define XB_XSUB(j)  (1280 + 64 * (j))
#define XB_XGEN(j)  (2304 + 64 * (j))
#define XB_TOP      3328
#define XB_TOPGEN   3392
#define XCD_BAR_WORDS 3456
#define XB_SPIN_CAP (1u << 22)
#define LAS __attribute__((address_space(3)))

__device__ __forceinline__ unsigned xb_ld(unsigned* p)              { return __hip_atomic_load(p, __ATOMIC_RELAXED, __HIP_MEMORY_SCOPE_AGENT); }
__device__ __forceinline__ unsigned xb_add(unsigned* p, unsigned v) { return __hip_atomic_fetch_add(p, v, __ATOMIC_RELAXED, __HIP_MEMORY_SCOPE_AGENT); }
__device__ __forceinline__ unsigned xb_xcc_id() { return (unsigned)__builtin_amdgcn_s_getreg((3 << 11) | 20) & 0xFu; }
#define XB_SPIN(cond, bar) do { unsigned _sp = 0; while (cond) { __builtin_amdgcn_s_sleep(1); \
    if ((++_sp & 255u) == 0u) { if (xb_ld(&(bar)[XB_TMO])) break; if (_sp > XB_SPIN_CAP) { atomicAdd(&(bar)[XB_TMO], 1u); break; } } } } while (0)

struct XcdBarrier {
    unsigned* bar; unsigned x;
    volatile LAS unsigned* st;
};

__device__ __forceinline__ XcdBarrier xcd_barrier_post(unsigned* bar, volatile LAS unsigned* st) {
    XcdBarrier b; b.bar = bar; b.x = xb_xcc_id(); b.st = st;
    if (threadIdx.x == 0) (void)xb_add(&bar[XB_XCNT(b.x)], 1u);
    return b;
}
__device__ __forceinline__ void xcd_barrier_complete(unsigned* bar, unsigned x, unsigned& nloc, unsigned& nx) {
    const unsigned G = gridDim.x * gridDim.y * gridDim.z;
    unsigned sum, cnt, mine, sp = 0u;
    for (;;) {
        sum = 0u; cnt = 0u; mine = 0u;
#pragma unroll
        for (unsigned j = 0; j < 16; ++j) { const unsigned c = xb_ld(&bar[XB_XCNT(j)]); sum += c; cnt += (c > 0u) ? 1u : 0u; mine = (j == x) ? c : mine; }
        if (sum == G) break;
        __builtin_amdgcn_s_sleep(1);
        if ((++sp & 255u) == 0u) { if (xb_ld(&bar[XB_TMO])) break; if (sp > XB_SPIN_CAP) { atomicAdd(&bar[XB_TMO], 1u); break; } }
    }
    nloc = mine > 0u ? mine : 1u; nx = cnt > 0u ? cnt : 1u;
}

__device__ __forceinline__ void xcd_barrier(const XcdBarrier& b) {
    asm volatile("s_waitcnt vmcnt(0)" ::: "memory");
    __syncthreads();
    if (threadIdx.x == 0) {
        unsigned* bar = b.bar;
        __builtin_amdgcn_s_waitcnt(0);
        unsigned nloc = b.st[0], nx = b.st[1];
        if (nloc == 0u) { xcd_barrier_complete(bar, b.x, nloc, nx); b.st[0] = nloc; b.st[1] = nx; }
        const unsigned old = xb_add(&bar[XB_XSUB(b.x)], 1u);
        const unsigned gen = old / nloc;
        if (old + 1u == (gen + 1u) * nloc) {
            __builtin_amdgcn_fence(__ATOMIC_RELEASE, "agent");
            asm volatile("s_waitcnt vmcnt(0)" ::: "memory");
            const unsigned og = xb_add(&bar[XB_TOP], 1u);
            const unsigned tg = og / nx;
            if (og + 1u == (tg + 1u) * nx) xb_add(&bar[XB_TOPGEN], 1u);
            else XB_SPIN(xb_ld(&bar[XB_TOPGEN]) == tg, bar);
            __builtin_amdgcn_fence(__ATOMIC_ACQUIRE, "agent");
            xb_add(&bar[XB_XGEN(b.x)], 1u);
            asm volatile("s_waitcnt vmcnt(0)" ::: "memory");
        } else {
            XB_SPIN(xb_ld(&bar[XB_XGEN(b.x)]) == gen, bar);
            __builtin_amdgcn_fence(__ATOMIC_ACQUIRE, "agent");
            asm volatile("s_waitcnt vmcnt(0)" ::: "memory");
        }
    }
    __syncthreads();
}


__device__ __forceinline__ void cnt_barrier(unsigned* cw, unsigned& k) {
    asm volatile("s_waitcnt vmcnt(0)" ::: "memory");
    __syncthreads();
    if (threadIdx.x == 0) {
        __builtin_amdgcn_fence(__ATOMIC_RELEASE, "agent");
        asm volatile("s_waitcnt vmcnt(0)" ::: "memory");
        const unsigned G = gridDim.x;
        const unsigned old = xb_add(cw, 1u);
        if (old == G * (k + 1u) - 1u) xb_add(cw + 64, 1u);
        else { unsigned sp = 0; while (xb_ld(cw + 64) == k) { __builtin_amdgcn_s_sleep(1);
                if ((++sp & 255u) == 0u) { if (xb_ld(cw + 128)) break; if (sp > XB_SPIN_CAP) { atomicAdd(cw + 128, 1u); break; } } } }
        __builtin_amdgcn_fence(__ATOMIC_ACQUIRE, "agent");
        asm volatile("s_waitcnt vmcnt(0)" ::: "memory");
    }
    ++k;
    __syncthreads();
}
__device__ __forceinline__ float bf_lo(unsigned w) { return __uint_as_float(w << 16); }
__device__ __forceinline__ float bf_hi(unsigned w) { return __uint_as_float(w & 0xffff0000u); }
__device__ __forceinline__ float bf2f(bf16 v) { return __uint_as_float(((unsigned)v) << 16); }
__device__ __forceinline__ unsigned f2bf(float f) { unsigned u = __float_as_uint(f); return (u + 0x7fffu + ((u >> 16) & 1u)) >> 16; }
__device__ __forceinline__ unsigned pk2(float lo, float hi) { unsigned r; asm("v_cvt_pk_bf16_f32 %0, %1, %2" : "=v"(r) : "v"(lo), "v"(hi)); return r; }
__device__ __forceinline__ float wave_sum(float v) {
#pragma unroll
    for (int o = 1; o < 64; o <<= 1) v += __shfl_xor(v, o);
    return v;
}
__device__ __forceinline__ float wave_max(float v) {
#pragma unroll
    for (int o = 1; o < 64; o <<= 1) v = fmaxf(v, __shfl_xor(v, o));
    return v;
}
__device__ __forceinline__ float sigmoidf_(float x) { return 1.0f / (1.0f + __expf(-x)); }
__device__ __forceinline__ float siluf_(float x) { return x / (1.0f + __expf(-x)); }
#define LDS_WAIT() asm volatile("s_waitcnt lgkmcnt(0)" ::: "memory")

struct Args { const float* in[25]; float* out; unsigned char* ws; int ph_lo, ph_hi; };
struct ArgsG { const GAS float* in[25]; GAS float* out; GAS unsigned char* ws;
    __device__ __forceinline__ const float* I(int i) const { return (const float*)in[i]; }
    __device__ __forceinline__ unsigned char* W() const { return (unsigned char*)ws; }
    __device__ __forceinline__ float* O() const { return (float*)out; } };

__device__ __forceinline__ int map_win(int n);
__device__ __forceinline__ int map_gu(int n);
template <int MAP>
__device__ __forceinline__ void transpose_item(const float* W, int K, int N, bf16* WT, LAS float* scr, int item, int nblk, int lane) {
    const int kb = item / nblk, nb = item % nblk, k0 = 64 * kb, n0 = 32 * nb;
    const int nd = n0 + (lane & 31); const int src = MAP == 1 ? map_win(nd) : (MAP == 2 ? map_gu(nd) : nd);
#pragma unroll 8
    for (int i = 0; i < 32; ++i) { const int kk = 2 * i + (lane >> 5); scr[kk * 33 + (lane & 31)] = src >= 0 ? W[(size_t)(k0 + kk) * N + src] : 0.0f; }
    LDS_WAIT();
    const int c = lane & 7;
#pragma unroll
    for (int j = 0; j < 4; ++j) { const int n = (lane >> 3) + 8 * j; const LAS float* s = scr + (8 * c) * 33 + n;
        u32x4 o; o.x = pk2(s[0 * 33], s[1 * 33]); o.y = pk2(s[2 * 33], s[3 * 33]); o.z = pk2(s[4 * 33], s[5 * 33]); o.w = pk2(s[6 * 33], s[7 * 33]);
        *(u32x4*)(WT + (size_t)(n0 + n) * K + k0 + 8 * c) = o; }
    LDS_WAIT();
}
__device__ __forceinline__ int map_win(int n) {
    if (n < 2048) return n;
    if (n < C_KV) return 2056 + (n - C_NQ);
    if (n < C_CU) return 2312 + (n - C_KV);
    if (n < C_A) return 2708 + (n - C_CU);
    if (n < C_B) return 2048 + (n - C_A);
    if (n < C_G) return 2052 + (n - C_B);
    if (n < C_G + 12) return 2696 + (n - C_G);
    return -1;
}
__device__ __forceinline__ int map_gu(int n) { const int pn = n >> 8, r = n & 255; return (r < 128 ? 0 : 1024) + 128 * pn + (r & 127); }

__device__ __forceinline__ void ph_prologue(const ArgsG& a, LAS unsigned char* lds, int gw, int NGW, int wave, int lane) {
    LAS float* scr = (LAS float*)(lds + wave * 16384);
    bf16* WinT = (bf16*)(a.W() + WS_WIN); bf16* WoutT = (bf16*)(a.W() + WS_WOUT); bf16* WguT = (bf16*)(a.W() + WS_WGU); bf16* WdT = (bf16*)(a.W() + WS_WD);
    constexpr int I_IN = 16 * (NP / 32), I_OUT = 16 * 32, I_GU = 16 * 64, I_D = 16 * 32;
    constexpr int N_IN = NLAYER * I_IN, N_OUT = NLAYER * I_OUT, N_GU = NLAYER * NE * I_GU, N_D = NLAYER * NE * I_D;
    for (int it = gw; it < N_IN + N_OUT + N_GU + N_D; it += NGW) {
        int r = it;
        if (r < N_IN) { const int l = r / I_IN; transpose_item<1>(a.I(2) + (size_t)l * DM * DIN, DM, DIN, WinT + (size_t)l * NP * DM, scr, r % I_IN, NP / 32, lane); continue; } r -= N_IN;
        if (r < N_OUT) { const int l = r / I_OUT; transpose_item<0>(a.I(16) + (size_t)l * DM * DM, DM, DM, WoutT + (size_t)l * DM * DM, scr, r % I_OUT, 32, lane); continue; } r -= N_OUT;
        if (r < N_GU) { const int le = r / I_GU; transpose_item<2>(a.I(20) + (size_t)le * DM * 2048, DM, 2048, WguT + (size_t)le * 2048 * DM, scr, r % I_GU, 64, lane); continue; } r -= N_GU;
        { const int le = r / I_D; transpose_item<0>(a.I(22) + (size_t)le * DM * DM, DM, DM, WdT + (size_t)le * DM * DM, scr, r % I_D, 32, lane); }
    }
    { bf16* W1T = (bf16*)(a.W() + WS_W1T);
        for (int it = gw; it < 4 * 128; it += NGW) { const int mtx = it >> 7; transpose_item<0>(a.I(10) + (size_t)mtx * 2048 * 128, 2048, 128, W1T + (size_t)mtx * 128 * 2048, scr, it & 127, 4, lane); }
        float* POSW = (float*)(a.W() + WS_POSW);
        const int id = gw * 64 + lane;
        if (id < 512) { const int mtx = id >> 7, n = id & 127; const float* w1 = a.I(10) + (size_t)mtx * 2048 * 128; const float* pos = a.I(9) + (size_t)mtx * 2048; float acc = 0.f;
            for (int k = 0; k < 2048; ++k) acc += pos[k] * w1[(size_t)k * 128 + n];
            POSW[id] = acc; } }
    { bf16* RWH = (bf16*)(a.W() + WS_RWH); bf16* RWL = (bf16*)(a.W() + WS_RWL);
        for (int i = gw * 64 + lane; i < NLAYER * NE * DM; i += NGW * 64) { const int d = i & (DM - 1), e = (i >> 10) & (NE - 1), l = i >> 15;
            const float w = a.I(18)[((size_t)l * DM + d) * NE + e]; const unsigned hi = f2bf(w); const float lo = w - __uint_as_float(hi << 16);
            RWH[i] = (bf16)hi; RWL[i] = (bf16)f2bf(lo); } }
    float* BT = (float*)(a.W() + WS_BT);
    for (int i = gw * 64 + lane; i < 4 * 2048; i += NGW * 64) {
        const int h = i >> 11, n = i & 2047; int bk;
        if (n < 16) bk = n; else { const float v = logf((float)n / 16.0f) / 2.0794415416798357f * 16.0f; bk = 16 + (int)v; bk = bk < 31 ? bk : 31; }
        BT[i] = a.I(24)[bk * 4 + h];
    }
}

__device__ __forceinline__ void rms_row_to_bf16(const f32x4 (&v)[4], const float* w, bf16* orow, int lane) {
    float s = 0.f;
#pragma unroll
    for (int j = 0; j < 4; ++j) s += (v[j].x * v[j].x + v[j].y * v[j].y) + (v[j].z * v[j].z + v[j].w * v[j].w);
    const float r = rsqrtf(wave_sum(s) * (1.0f / DM) + EPS);
#pragma unroll
    for (int j = 0; j < 4; ++j) { const f32x4 wv = *(const f32x4*)(w + 4 * (64 * j + lane)); const f32x4 y = v[j] * r * wv;
        u32x2 o; o.x = pk2(y.x, y.y); o.y = pk2(y.z, y.w); *(u32x2*)(orow + 4 * (64 * j + lane)) = o; }
}

__device__ __forceinline__ void ph_norm0(const ArgsG& a, int gw, int NGW, int lane) {
    bf16* XN = (bf16*)(a.W() + WS_XN);
    for (int tok = gw; tok < NT; tok += NGW) {
        f32x4 v[4];
#pragma unroll
        for (int j = 0; j < 4; ++j) v[j] = *(const f32x4*)(a.I(0) + (size_t)tok * DM + 4 * (64 * j + lane));
        rms_row_to_bf16(v, a.I(1), XN + (size_t)tok * DM, lane);
    }
}

__device__ __forceinline__ void ph_compress_mfma(const ArgsG& a, int l, LAS unsigned char* lds, int bid, int G, int tid, int wave, int lane) {
    LAS float* part = (LAS float*)lds;
    LAS float* hid = (LAS float*)(lds + 8 * 16 * 132 * 4);
    const bf16* P = (const bf16*)(a.W() + WS_P); bf16* KCMP = (bf16*)(a.W() + WS_KCMP); bf16* VCMP = (bf16*)(a.W() + WS_VCMP);
    const int r = lane & 15, q = lane >> 4;
    for (int u = bid; u < 128; u += G) {
        const int b = u >> 4, kv = (u >> 3) & 1, j0 = 16 * (u & 7);
        const bf16* arow = P + (size_t)(b * SEQ) * NP + C_KV + kv * 64;
        const bf16* brow = (const bf16*)(a.W() + WS_W1T) + ((size_t)(l * 2 + kv) * 128 + r) * 2048 + 8 * q;
        f32x4 acc[8];
#pragma unroll
        for (int nb = 0; nb < 8; ++nb) acc[nb] = (f32x4){0.f, 0.f, 0.f, 0.f};
#pragma unroll
        for (int s8 = 0; s8 < 8; ++s8) { const int ks = 8 * wave + s8; int tk = 16 * (j0 + r) + (ks >> 1); tk = tk < SEQ ? tk : SEQ - 1;
            const bf16x8 af = *(const bf16x8*)(arow + (size_t)tk * NP + (ks & 1) * 32 + 8 * q);
#pragma unroll
            for (int nb = 0; nb < 8; ++nb) acc[nb] = __builtin_amdgcn_mfma_f32_16x16x32_bf16(af, *(const bf16x8*)(brow + (size_t)(16 * nb) * 2048 + 32 * ks), acc[nb], 0, 0, 0); }
#pragma unroll
        for (int nb = 0; nb < 8; ++nb)
#pragma unroll
            for (int i = 0; i < 4; ++i) part[(wave * 16 + 4 * q + i) * 132 + 16 * nb + r] = acc[nb][i];
        __syncthreads();
        { const float* POSW = (const float*)(a.W() + WS_POSW) + (l * 2 + kv) * 128;
            for (int e = tid; e < 16 * 128; e += NTHR) { const int row = e >> 7, n = e & 127; float sacc = POSW[n];
#pragma unroll
                for (int w = 0; w < 8; ++w) sacc += part[(w * 16 + row) * 132 + n];
                hid[row * 132 + n] = siluf_(sacc); } }
        __syncthreads();
        { const int row = tid >> 5, c2 = tid & 31; const float* w2 = a.I(11) + (size_t)(l * 2 + kv) * 128 * 64; float o0 = 0.f, o1 = 0.f;
            for (int nn = 0; nn < 128; ++nn) { const float hv = hid[row * 132 + nn]; o0 += hv * w2[nn * 64 + 2 * c2]; o1 += hv * w2[nn * 64 + 2 * c2 + 1]; }
            if (kv == 0) { float ss = o0 * o0 + o1 * o1;
#pragma unroll
                for (int o_ = 1; o_ < 32; o_ <<= 1) ss += __shfl_xor(ss, o_);
                const float sc = rsqrtf(ss * (1.0f / 64.0f) + EPS); o0 *= sc * a.I(8)[l * 192 + 2 * c2]; o1 *= sc * a.I(8)[l * 192 + 2 * c2 + 1]; }
            const int j = j0 + row;
            *(unsigned*)((kv ? VCMP : KCMP) + (size_t)(b * 128 + j) * 64 + 2 * c2) = (j < 127) ? pk2(o0, o1) : 0u; }
        __syncthreads();
    }
}

__device__ __forceinline__ void ph_m1(const ArgsG& a, int l, LAS unsigned char* lds, int bid, int G, int tid, int wave, int lane) {
    const bf16* P = (const bf16*)(a.W() + WS_P);
    bf16* QN = (bf16*)(a.W() + WS_QN); bf16* KN = (bf16*)(a.W() + WS_KN); bf16* VC = (bf16*)(a.W() + WS_VC);
    bf16* KT = (bf16*)(a.W() + WS_KT); bf16* VT = (bf16*)(a.W() + WS_VT);
    float* Gb = (float*)(a.W() + WS_G); float* BETA = (float*)(a.W() + WS_BETA);
    bf16* NQ = (bf16*)(a.W() + WS_NQ); bf16* KS = (bf16*)(a.W() + WS_KS); bf16* KW = (bf16*)(a.W() + WS_KW); bf16* Y = (bf16*)(a.W() + WS_Y);
    const float* convw = a.I(3) + (size_t)l * 4 * 1536; const float* a_log = a.I(4) + l * 4; const float* dt_bias = a.I(5) + l * 4;
    const float* qnw = a.I(7) + l * 64; const float* knw = a.I(8) + l * 192;
    const float* dww = a.I(12) + (size_t)l * 31 * 256; const float* dwb = a.I(13) + l * 256; const float* lnw = a.I(14) + l * 256; const float* lnb = a.I(15) + l * 256;
    LAS float* dwl = (LAS float*)(lds + 65536);
    for (int i = tid; i < 31 * 256; i += NTHR) dwl[i] = dww[i];
    __syncthreads();
    for (int u = bid; u < NT / 64; u += G) {
        const int b = u >> 5, nchunk = u & 31, tw = nchunk * 64 + 8 * wave;
        const bf16* pw0 = P + (size_t)(b * SEQ + tw) * NP;
        { unsigned cx[11], nx[11]; float cw0[4], cw1[4], nw0[4], nw1[4];
#define DN_LOAD(idx, X, W0, W1) do { const int cb_ = ((idx) >> 2) * 512 + ((idx) & 3) * 128 + 2 * lane; \
            _Pragma("unroll") for (int j = 0; j < 4; ++j) { W0[j] = convw[j * 1536 + cb_]; W1[j] = convw[j * 1536 + cb_ + 1]; } \
            _Pragma("unroll") for (int j = 0; j < 3; ++j) { X[j] = 0u; if (tw - 3 + j >= 0) X[j] = *(const unsigned*)(pw0 + (ptrdiff_t)(j - 3) * NP + cb_); } \
            _Pragma("unroll") for (int i = 0; i < 8; ++i) X[3 + i] = *(const unsigned*)(pw0 + (size_t)i * NP + cb_); } while (0)
            DN_LOAD(0, cx, cw0, cw1);
#pragma unroll 1
            for (int idx = 0; idx < 12; ++idx) { const int ten = idx >> 2, h = idx & 3;
                if (idx + 1 < 12) DN_LOAD(idx + 1, nx, nw0, nw1);
                float xa[3] = {bf_lo(cx[0]), bf_lo(cx[1]), bf_lo(cx[2])}, xb[3] = {bf_hi(cx[0]), bf_hi(cx[1]), bf_hi(cx[2])};
                float ya[8], yb[8], sq[8];
#pragma unroll
                for (int i = 0; i < 8; ++i) { const unsigned w = cx[3 + i]; const float ca = bf_lo(w), cbv = bf_hi(w);
                    ya[i] = siluf_(cw0[0] * xa[0] + cw0[1] * xa[1] + cw0[2] * xa[2] + cw0[3] * ca); yb[i] = siluf_(cw1[0] * xb[0] + cw1[1] * xb[1] + cw1[2] * xb[2] + cw1[3] * cbv);
                    xa[0] = xa[1]; xa[1] = xa[2]; xa[2] = ca; xb[0] = xb[1]; xb[1] = xb[2]; xb[2] = cbv; sq[i] = ya[i] * ya[i] + yb[i] * yb[i]; }
                if (ten < 2) {
#pragma unroll
                    for (int o_ = 1; o_ < 64; o_ <<= 1) {
#pragma unroll
                        for (int i = 0; i < 8; ++i) sq[i] += __shfl_xor(sq[i], o_); }
                    const float qs_ = ten == 0 ? 0.08838834764831845f : 1.0f;
#pragma unroll
                    for (int i = 0; i < 8; ++i) { const float sc = rsqrtf(sq[i] + EPS) * qs_; ya[i] *= sc; yb[i] *= sc; } }
                unsigned pk[8];
#pragma unroll
                for (int i = 0; i < 8; ++i) pk[i] = pk2(ya[i], yb[i]);
                if (ten < 2) { bf16* dst = ten == 0 ? QN : KN;
#pragma unroll
                    for (int i = 0; i < 8; ++i) *(unsigned*)(dst + (size_t)(b * SEQ + tw + i) * 512 + h * 128 + 2 * lane) = pk[i]; }
                if (ten >= 1) {
                    bf16* tb = (ten == 1 ? KT : VT) + ((size_t)((b * 4 + h) * 32 + nchunk) * 128 + 2 * lane) * 64 + 8 * wave;
                    u32x4 lo, hi;
                    lo.x = (pk[0] & 0xffffu) | (pk[1] << 16); lo.y = (pk[2] & 0xffffu) | (pk[3] << 16); lo.z = (pk[4] & 0xffffu) | (pk[5] << 16); lo.w = (pk[6] & 0xffffu) | (pk[7] << 16);
                    hi.x = (pk[0] >> 16) | (pk[1] & 0xffff0000u); hi.y = (pk[2] >> 16) | (pk[3] & 0xffff0000u); hi.z = (pk[4] >> 16) | (pk[5] & 0xffff0000u); hi.w = (pk[6] >> 16) | (pk[7] & 0xffff0000u);
                    *(u32x4*)tb = lo; *(u32x4*)(tb + 64) = hi; }
#pragma unroll
                for (int j = 0; j < 11; ++j) cx[j] = nx[j];
#pragma unroll
                for (int j = 0; j < 4; ++j) { cw0[j] = nw0[j]; cw1[j] = nw1[j]; } }
#undef DN_LOAD
        }
        if (lane < 32) { const int i = lane >> 2, hd = lane & 3; const size_t tok = (size_t)(b * SEQ + tw + i); const bf16* prow = P + tok * NP;
            const float av = bf2f(prow[C_A + hd]), bv = bf2f(prow[C_B + hd]);
            BETA[tok * 4 + hd] = sigmoidf_(bv);
            const float x = av + dt_bias[hd]; const float sp = x > 20.0f ? x : log1pf(expf(x));
            Gb[tok * 4 + hd] = -expf(a_log[hd]) * sp; }
        { const float qw = qnw[lane] * (0.125f * 1.4426950408889634f), ksw = knw[64 + lane], kww = knw[128 + lane];
#pragma unroll 4
          for (int i = 0; i < 8; ++i) { const size_t tok = (size_t)(b * SEQ + tw + i); const bf16* prow = P + tok * NP;
            float xv[6];
#pragma unroll
            for (int h = 0; h < 4; ++h) xv[h] = bf2f(prow[C_NQ + h * 64 + lane]);
            xv[4] = bf2f(prow[C_KV + 128 + lane]); xv[5] = bf2f(prow[C_KV + 256 + lane]);
            float ss[6];
#pragma unroll
            for (int h = 0; h < 6; ++h) ss[h] = xv[h] * xv[h];
#pragma unroll
            for (int o_ = 1; o_ < 64; o_ <<= 1) {
#pragma unroll
                for (int h = 0; h < 6; ++h) ss[h] += __shfl_xor(ss[h], o_); }
#pragma unroll
            for (int h = 0; h < 4; ++h) NQ[tok * 256 + h * 64 + lane] = (bf16)f2bf(xv[h] * rsqrtf(ss[h] * (1.0f / 64.0f) + EPS) * qw);
            KS[tok * 64 + lane] = (bf16)f2bf(xv[4] * rsqrtf(ss[4] * (1.0f / 64.0f) + EPS) * ksw);
            KW[tok * 64 + lane] = (bf16)f2bf(xv[5] * rsqrtf(ss[5] * (1.0f / 64.0f) + EPS) * kww); } }
        { const int c = 4 * lane; f32x4 acc[8]; const f32x4 bias = *(const f32x4*)(dwb + c);
#pragma unroll
            for (int i = 0; i < 8; ++i) acc[i] = bias;
#pragma unroll 1
            for (int g8 = 0; g8 < 5; ++g8) { u32x2 av[8], gv[8];
#pragma unroll
                for (int rr = 0; rr < 8; ++rr) { const int r = 8 * g8 + rr; av[rr] = (u32x2){0u, 0u}; gv[rr] = (u32x2){0u, 0u};
                    if (r < 38 && tw - 30 + r >= 0) { const bf16* pr = pw0 + (ptrdiff_t)(r - 30) * NP + C_CU + c; av[rr] = *(const u32x2*)pr; gv[rr] = *(const u32x2*)(pr + 256); } }
#pragma unroll
                for (int rr = 0; rr < 8; ++rr) { const int r = 8 * g8 + rr;
                    f32x4 gl; gl.x = bf_lo(av[rr].x) * sigmoidf_(bf_lo(gv[rr].x)); gl.y = bf_hi(av[rr].x) * sigmoidf_(bf_hi(gv[rr].x)); gl.z = bf_lo(av[rr].y) * sigmoidf_(bf_lo(gv[rr].y)); gl.w = bf_hi(av[rr].y) * sigmoidf_(bf_hi(gv[rr].y));
#pragma unroll
                    for (int i = 0; i < 8; ++i) { const int j = r - i; if (j >= 0 && j <= 30) { const f32x4 w = *(const LAS f32x4*)(dwl + j * 256 + c); acc[i] += w * gl; } } } }
            const f32x4 lw = *(const f32x4*)(lnw + c), lb = *(const f32x4*)(lnb + c);
#pragma unroll
            for (int i = 0; i < 8; ++i) { const f32x4 x = acc[i]; const float mean = wave_sum((x.x + x.y) + (x.z + x.w)) * (1.0f / 256.0f);
                const f32x4 d = x - mean; const float var = wave_sum((d.x * d.x + d.y * d.y) + (d.z * d.z + d.w * d.w)) * (1.0f / 256.0f);
                const float rr = rsqrtf(var + EPS); const f32x4 y = d * rr * lw + lb;
                u32x2 o; o.x = pk2(siluf_(y.x), siluf_(y.y)); o.y = pk2(siluf_(y.z), siluf_(y.w));
                *(u32x2*)(Y + (size_t)(b * SEQ + tw + i) * DM + 768 + c) = o; } }
    }
}

constexpr int LM_PITCH = 68;
__device__ __forceinline__ void ph_dn_chunk_mfma(const ArgsG& a, LAS unsigned char* lds, int bid, int G, int tid, int wave, int lane) {
    LAS float* Lm = (LAS float*)lds;
    LAS float* gcl = (LAS float*)(lds + 4 * 64 * LM_PITCH * 4);
    LAS float* betal = gcl + 256; LAS float* bkl = betal + 256;
    const bf16* QN = (const bf16*)(a.W() + WS_QN); const bf16* KN = (const bf16*)(a.W() + WS_KN);
    const bf16* KT = (const bf16*)(a.W() + WS_KT); const bf16* VT = (const bf16*)(a.W() + WS_VT);
    const float* Gb = (const float*)(a.W() + WS_G); const float* BETA = (const float*)(a.W() + WS_BETA); float* GC = (float*)(a.W() + WS_GC);
    float* U = (float*)(a.W() + WS_U); bf16* W = (bf16*)(a.W() + WS_W); bf16* ATT = (bf16*)(a.W() + WS_ATT);
    const int n = lane & 31, hh = lane >> 5;
    for (int cb = bid; cb < 256; cb += G) {
        if (wave < 4) { const int b = cb >> 5, nn = cb & 31, h = wave, ci = (b * 4 + h) * 32 + nn, r0 = b * SEQ + nn * 64; (void)ci;
            float g = Gb[(size_t)(r0 + lane) * 4 + h];
#pragma unroll
            for (int off = 1; off < 64; off <<= 1) { const float v = __shfl_up(g, off); if (lane >= off) g += v; }
            const float be = BETA[(size_t)(r0 + lane) * 4 + h];
            gcl[wave * 64 + lane] = g; GC[(size_t)(r0 + lane) * 4 + h] = g; betal[wave * 64 + lane] = be; bkl[wave * 64 + lane] = be * __expf(g); }
        __syncthreads();
#pragma unroll 1
        for (int q = 0; q < 3; ++q) { const int id = 3 * wave + q, c = id / 6, wq = id % 6, isq = wq >= 3 ? 1 : 0, blk = wq % 3, ib = blk >= 1 ? 1 : 0, jb = blk == 2 ? 1 : 0;
            const int b = cb >> 5, nn = cb & 31, h = c, ci = (b * 4 + h) * 32 + nn, r0 = b * SEQ + nn * 64;
            const bf16* ap = (isq ? QN : KN) + (size_t)(r0 + 32 * ib + n) * 512 + h * 128 + 8 * hh;
            const bf16* bp = KN + (size_t)(r0 + 32 * jb + n) * 512 + h * 128 + 8 * hh;
            f32x16 acc;
#pragma unroll
            for (int r = 0; r < 16; ++r) acc[r] = 0.f;
#pragma unroll
            for (int ks = 0; ks < 8; ++ks) acc = __builtin_amdgcn_mfma_f32_32x32x16_bf16(*(const bf16x8*)(ap + 16 * ks), *(const bf16x8*)(bp + 16 * ks), acc, 0, 0, 0);
            const int j = 32 * jb + n; const float gj = gcl[c * 64 + j];
#pragma unroll
            for (int r = 0; r < 16; ++r) { const int i = 32 * ib + (r & 3) + 8 * (r >> 2) + 4 * hh; const float dec = __expf(fminf(gcl[c * 64 + i] - gj, 0.f));
                if (isq) ATT[(size_t)ci * 4096 + i * 64 + j] = (bf16)((j <= i) ? f2bf(acc[r] * dec) : 0u);
                else Lm[c * 64 * LM_PITCH + i * LM_PITCH + j] = (j < i) ? betal[c * 64 + i] * acc[r] * dec : 0.f; } }
        __syncthreads();
        if (wave < 4) { LAS float* L = Lm + wave * 64 * LM_PITCH; float T[64];
#pragma unroll
            for (int i = 0; i < 64; ++i) { float a0 = (i == lane) ? 1.f : 0.f, a1 = 0.f, a2 = 0.f, a3 = 0.f;
#pragma unroll
                for (int j4 = 0; j4 + 3 < i; j4 += 4) { const f32x4 lv = *(const LAS f32x4*)(L + i * LM_PITCH + j4);
                    a0 -= lv.x * T[j4]; a1 -= lv.y * T[j4 + 1]; a2 -= lv.z * T[j4 + 2]; a3 -= lv.w * T[j4 + 3]; }
#pragma unroll
                for (int j = (i / 4) * 4; j < i; ++j) a0 -= L[i * LM_PITCH + j] * T[j];
                T[i] = (a0 + a1) + (a2 + a3); }
#pragma unroll
            for (int i = 0; i < 64; ++i) L[i * LM_PITCH + lane] = T[i]; }
        __syncthreads();
#pragma unroll 1
        for (int q = 0; q < 4; ++q) { const int id = wave * 4 + q, c = id >> 3, ten = (id >> 2) & 1, db = id & 3;
            const int b = cb >> 5, nn = cb & 31, h = c, ci = (b * 4 + h) * 32 + nn, r0 = b * SEQ + nn * 64;
            const bf16* arow = (ten ? KT : VT) + ((size_t)ci * 128 + 32 * db + n) * 64 + 8 * hh;
            const LAS float* scl = (ten ? bkl : betal) + c * 64;
            const LAS float* L = Lm + c * 64 * LM_PITCH;
#pragma unroll
            for (int ib = 0; ib < 2; ++ib) { f32x16 acc;
#pragma unroll
                for (int r = 0; r < 16; ++r) acc[r] = 0.f;
#pragma unroll
                for (int ks = 0; ks < 4; ++ks) { if (ib == 0 && ks >= 2) continue;
                    const LAS float* tp = L + (32 * ib + n) * LM_PITCH + 16 * ks + 8 * hh;
                    const f32x4 t0 = *(const LAS f32x4*)tp, t1 = *(const LAS f32x4*)(tp + 4), s0 = *(const LAS f32x4*)(scl + 16 * ks + 8 * hh), s1 = *(const LAS f32x4*)(scl + 16 * ks + 8 * hh + 4);
                    u32x4 bw; bw.x = pg8::cvt_pk_bf16(t0.x * s0.x, t0.y * s0.y); bw.y = pg8::cvt_pk_bf16(t0.z * s0.z, t0.w * s0.w); bw.z = pg8::cvt_pk_bf16(t1.x * s1.x, t1.y * s1.y); bw.w = pg8::cvt_pk_bf16(t1.z * s1.z, t1.w * s1.w);
                    acc = __builtin_amdgcn_mfma_f32_32x32x16_bf16(*(const bf16x8*)(arow + 16 * ks), __builtin_bit_cast(bf16x8, bw), acc, 0, 0, 0); }
                const size_t ob = (size_t)(r0 + 32 * ib + n) * 512 + h * 128 + 32 * db + 4 * hh;
#pragma unroll
                for (int rq = 0; rq < 4; ++rq) {
                    if (ten) { u32x2 w2; w2.x = pk2(acc[4 * rq], acc[4 * rq + 1]); w2.y = pk2(acc[4 * rq + 2], acc[4 * rq + 3]); *(u32x2*)(W + ob + 8 * rq) = w2; }
                    else *(f32x4*)(U + ob + 8 * rq) = (f32x4){acc[4 * rq], acc[4 * rq + 1], acc[4 * rq + 2], acc[4 * rq + 3]}; } } }
        __syncthreads();
    }
}

constexpr int SC_WP = 272, SC_AP = 144;
constexpr int SC_W = 0, SC_Q = 64 * SC_WP, SC_A = 2 * 64 * SC_WP, SC_K = SC_A + 64 * SC_AP, SC_GC = SC_K + 128 * SC_AP, SC_BUF = SC_GC + 1024;
static_assert(2 * SC_BUF <= RING_BYTES, "scan LDS");
struct ScanPf { u32x4 w[4], q[4], at[2], k[4]; float g, gl; };
__device__ __forceinline__ ScanPf scan_load(const bf16* W, const bf16* QN, const bf16* ATT, const bf16* KT, const float* GC, int r0, int h, int ci, int lt) {
    ScanPf p; const int row = lt >> 4, seg = lt & 15;
#pragma unroll
    for (int i = 0; i < 4; ++i) { const size_t go = (size_t)(r0 + row + 16 * i) * 512 + h * 128 + seg * 8; p.w[i] = *(const u32x4*)(W + go); p.q[i] = *(const u32x4*)(QN + go); }
#pragma unroll
    for (int i = 0; i < 2; ++i) p.at[i] = *(const u32x4*)(ATT + (size_t)ci * 4096 + (lt + 256 * i) * 8);
#pragma unroll
    for (int i = 0; i < 4; ++i) p.k[i] = *(const u32x4*)(KT + (size_t)ci * 8192 + (lt + 256 * i) * 8);
    p.g = GC[(size_t)(r0 + (lt & 63)) * 4 + h]; p.gl = GC[(size_t)(r0 + 63) * 4 + h]; return p;
}
__device__ __forceinline__ void scan_store(const ScanPf& p, LAS unsigned char* buf, int lt) {
    const int row = lt >> 4, seg = lt & 15;
#pragma unroll
    for (int i = 0; i < 4; ++i) { *(LAS u32x4*)(buf + SC_W + (row + 16 * i) * SC_WP + seg * 16) = p.w[i]; *(LAS u32x4*)(buf + SC_Q + (row + 16 * i) * SC_WP + seg * 16) = p.q[i]; }
#pragma unroll
    for (int i = 0; i < 2; ++i) *(LAS u32x4*)(buf + SC_A + ((lt >> 3) + 32 * i) * SC_AP + (lt & 7) * 16) = p.at[i];
#pragma unroll
    for (int i = 0; i < 4; ++i) *(LAS u32x4*)(buf + SC_K + ((lt >> 3) + 32 * i) * SC_AP + (lt & 7) * 16) = p.k[i];
    if (lt < 64) { LAS float* gp = (LAS float*)(buf + SC_GC); gp[lt] = __expf(p.g); gp[64 + lt] = __expf(p.gl - p.g); if (lt == 0) gp[128] = __expf(p.gl); }
}
__device__ __forceinline__ bf16x8 frag2(const LAS unsigned char* p) { const u32x2 lo = *(const LAS u32x2*)p, hi = *(const LAS u32x2*)(p + 16); const u32x4 v = {lo.x, lo.y, hi.x, hi.y}; return __builtin_bit_cast(bf16x8, v); }
__device__ __forceinline__ void ph_dn_scan_mfma(const ArgsG& a, LAS unsigned char* lds, int bid, int G, int tid, int wave, int lane) {
    const bf16* QN = (const bf16*)(a.W() + WS_QN); const bf16* KT = (const bf16*)(a.W() + WS_KT); const bf16* W = (const bf16*)(a.W() + WS_W); const bf16* ATT = (const bf16*)(a.W() + WS_ATT);
    const float* GC = (const float*)(a.W() + WS_GC); const float* U = (const float*)(a.W() + WS_U); float* O = (float*)(a.W() + WS_O);
    const int n = lane & 31, hh = lane >> 5;
    for (int u = bid; u < 32; u += G) {
        const int h = u & 3, b = u >> 2;
        f32x16 S[4];
#pragma unroll
        for (int k = 0; k < 4; ++k)
#pragma unroll
            for (int r = 0; r < 16; ++r) S[k][r] = 0.f;
        __syncthreads();
        if (wave >= 4) { const ScanPf p0 = scan_load(W, QN, ATT, KT, GC, b * SEQ, h, (b * 4 + h) * 32, tid - 256); scan_store(p0, lds, tid - 256); }
        __syncthreads();
#pragma unroll 1
        for (int nn = 0; nn < 32; ++nn) {
            const int r0 = b * SEQ + nn * 64; LAS unsigned char* buf = lds + (nn & 1) * SC_BUF; const LAS float* gp = (const LAS float*)(buf + SC_GC);
            if (wave >= 4) { if (nn + 1 < 32) { const ScanPf pf = scan_load(W, QN, ATT, KT, GC, r0 + 64, h, (b * 4 + h) * 32 + nn + 1, tid - 256); scan_store(pf, lds + ((nn + 1) & 1) * SC_BUF, tid - 256); } }
            else {
                const size_t ubase = (size_t)r0 * 512 + h * 128 + 32 * wave + n;
                f32x16 vn[2];
#pragma unroll
                for (int ib = 0; ib < 2; ++ib)
#pragma unroll
                    for (int r = 0; r < 16; ++r) vn[ib][r] = U[ubase + (size_t)(32 * ib + (r & 3) + 8 * (r >> 2) + 4 * hh) * 512];
                bf16x8 Sb[4][2];
#pragma unroll
                for (int k = 0; k < 4; ++k)
#pragma unroll
                    for (int s2 = 0; s2 < 2; ++s2) { u32x4 w4; w4.x = pg8::cvt_pk_bf16(S[k][8 * s2], S[k][8 * s2 + 1]); w4.y = pg8::cvt_pk_bf16(S[k][8 * s2 + 2], S[k][8 * s2 + 3]);
                        w4.z = pg8::cvt_pk_bf16(S[k][8 * s2 + 4], S[k][8 * s2 + 5]); w4.w = pg8::cvt_pk_bf16(S[k][8 * s2 + 6], S[k][8 * s2 + 7]); Sb[k][s2] = __builtin_bit_cast(bf16x8, w4); }
#pragma unroll
                for (int ib = 0; ib < 2; ++ib) { f32x16 acc;
#pragma unroll
                    for (int r = 0; r < 16; ++r) acc[r] = 0.f;
#pragma unroll
                    for (int k = 0; k < 4; ++k)
#pragma unroll
                        for (int s2 = 0; s2 < 2; ++s2) acc = __builtin_amdgcn_mfma_f32_32x32x16_bf16(frag2(buf + SC_W + (32 * ib + n) * SC_WP + (32 * k + 16 * s2 + 4 * hh) * 2), Sb[k][s2], acc, 0, 0, 0);
#pragma unroll
                    for (int r = 0; r < 16; ++r) vn[ib][r] -= acc[r]; }
                bf16x8 vb[2][2], vd[2][2];
#pragma unroll
                for (int jb = 0; jb < 2; ++jb)
#pragma unroll
                    for (int s2 = 0; s2 < 2; ++s2) { const f32x4 d0 = *(const LAS f32x4*)(gp + 64 + 32 * jb + 16 * s2 + 4 * hh), d1 = *(const LAS f32x4*)(gp + 64 + 32 * jb + 16 * s2 + 8 + 4 * hh);
                        const float* v = nullptr; (void)v; u32x4 w4, w5;
                        w4.x = pg8::cvt_pk_bf16(vn[jb][8 * s2], vn[jb][8 * s2 + 1]); w4.y = pg8::cvt_pk_bf16(vn[jb][8 * s2 + 2], vn[jb][8 * s2 + 3]);
                        w4.z = pg8::cvt_pk_bf16(vn[jb][8 * s2 + 4], vn[jb][8 * s2 + 5]); w4.w = pg8::cvt_pk_bf16(vn[jb][8 * s2 + 6], vn[jb][8 * s2 + 7]);
                        w5.x = pg8::cvt_pk_bf16(vn[jb][8 * s2] * d0.x, vn[jb][8 * s2 + 1] * d0.y); w5.y = pg8::cvt_pk_bf16(vn[jb][8 * s2 + 2] * d0.z, vn[jb][8 * s2 + 3] * d0.w);
                        w5.z = pg8::cvt_pk_bf16(vn[jb][8 * s2 + 4] * d1.x, vn[jb][8 * s2 + 5] * d1.y); w5.w = pg8::cvt_pk_bf16(vn[jb][8 * s2 + 6] * d1.z, vn[jb][8 * s2 + 7] * d1.w);
                        vb[jb][s2] = __builtin_bit_cast(bf16x8, w4); vd[jb][s2] = __builtin_bit_cast(bf16x8, w5); }
#pragma unroll
                for (int ib = 0; ib < 2; ++ib) { f32x16 acc;
#pragma unroll
                    for (int r = 0; r < 16; ++r) acc[r] = 0.f;
#pragma unroll
                    for (int k = 0; k < 4; ++k)
#pragma unroll
                        for (int s2 = 0; s2 < 2; ++s2) acc = __builtin_amdgcn_mfma_f32_32x32x16_bf16(frag2(buf + SC_Q + (32 * ib + n) * SC_WP + (32 * k + 16 * s2 + 4 * hh) * 2), Sb[k][s2], acc, 0, 0, 0);
#pragma unroll
                    for (int rq = 0; rq < 4; ++rq) { const f32x4 e4 = *(const LAS f32x4*)(gp + 32 * ib + 8 * rq + 4 * hh);
                        acc[4 * rq] *= e4.x; acc[4 * rq + 1] *= e4.y; acc[4 * rq + 2] *= e4.z; acc[4 * rq + 3] *= e4.w; }
#pragma unroll
                    for (int jb = 0; jb < 2; ++jb) { if (jb > ib) continue;
#pragma unroll
                        for (int s2 = 0; s2 < 2; ++s2) acc = __builtin_amdgcn_mfma_f32_32x32x16_bf16(frag2(buf + SC_A + (32 * ib + n) * SC_AP + (32 * jb + 16 * s2 + 4 * hh) * 2), vb[jb][s2], acc, 0, 0, 0); }
#pragma unroll
                    for (int r = 0; r < 16; ++r) O[ubase + (size_t)(32 * ib + (r & 3) + 8 * (r >> 2) + 4 * hh) * 512] = acc[r]; }
                const float egl = gp[128];
#pragma unroll
                for (int k = 0; k < 4; ++k) {
#pragma unroll
                    for (int r = 0; r < 16; ++r) S[k][r] *= egl;
#pragma unroll
                    for (int jb = 0; jb < 2; ++jb)
#pragma unroll
                        for (int s2 = 0; s2 < 2; ++s2) S[k] = __builtin_amdgcn_mfma_f32_32x32x16_bf16(frag2(buf + SC_K + (32 * k + n) * SC_AP + (32 * jb + 16 * s2 + 4 * hh) * 2), vd[jb][s2], S[k], 0, 0, 0); }
            }
            __syncthreads();
        }
    }
}

__device__ __forceinline__ void ph_dn_out(const ArgsG& a, int l, int gw, int NGW, int lane) {
    const float* O = (const float*)(a.W() + WS_O); const bf16* P = (const bf16*)(a.W() + WS_P); bf16* Y = (bf16*)(a.W() + WS_Y);
    const float* nw = a.I(6) + l * 128;
    for (int tok = gw; tok < NT; tok += NGW) {
#pragma unroll
        for (int h = 0; h < 4; ++h) { const float o0 = O[(size_t)tok * 512 + h * 128 + 2 * lane], o1 = O[(size_t)tok * 512 + h * 128 + 2 * lane + 1];
            const float ss = wave_sum(o0 * o0 + o1 * o1); const float r = rsqrtf(ss * (1.0f / 128.0f) + EPS);
            const unsigned zw = *(const unsigned*)(P + (size_t)tok * NP + C_Z + h * 128 + 2 * lane);
            const float y0 = o0 * r * nw[2 * lane] * siluf_(bf_lo(zw)), y1 = o1 * r * nw[2 * lane + 1] * siluf_(bf_hi(zw));
            *(unsigned*)(Y + (size_t)tok * DM + h * 128 + 2 * lane) = pk2(y0, y1); }
    }
}

constexpr int NSA_KT_PITCH = 144, NSA_VT_PITCH = 136;
struct NsaStage { u32x4 kv, vv; };
__device__ __forceinline__ NsaStage nsa_load(const bf16* Kbase, int kpitch, const bf16* Vbase, int vpitch, int tid) {
    const int key = tid >> 3, seg = tid & 7; NsaStage s;
    s.kv = *(const u32x4*)(Kbase + (size_t)key * kpitch + seg * 8); s.vv = *(const u32x4*)(Vbase + (size_t)key * vpitch + seg * 8); return s;
}
__device__ __forceinline__ void nsa_store(const NsaStage& s, LAS unsigned char* Kt, LAS unsigned char* Vt, int tid) {
    const int key = tid >> 3, seg = tid & 7;
    *(LAS u32x4*)(Kt + key * NSA_KT_PITCH + seg * 16) = s.kv;
#pragma unroll
    for (int i = 0; i < 4; ++i) { const unsigned w = s.vv[i];
        *(LAS unsigned short*)(Vt + (seg * 8 + 2 * i) * NSA_VT_PITCH + key * 2) = (unsigned short)(w & 0xffffu);
        *(LAS unsigned short*)(Vt + (seg * 8 + 2 * i + 1) * NSA_VT_PITCH + key * 2) = (unsigned short)(w >> 16); }
}
__device__ __forceinline__ void nsa_st(const LAS unsigned char* Kt, const bf16x8 (&qf)[4], int n, int hh, f32x16 (&s)[2]) {
#pragma unroll
    for (int kb = 0; kb < 2; ++kb) {
#pragma unroll
        for (int r = 0; r < 16; ++r) s[kb][r] = 0.f;
#pragma unroll
        for (int ks = 0; ks < 4; ++ks) { const bf16x8 af = *(const LAS bf16x8*)(Kt + (kb * 32 + n) * NSA_KT_PITCH + (16 * ks + 8 * hh) * 2);
            s[kb] = __builtin_amdgcn_mfma_f32_32x32x16_bf16(af, qf[ks], s[kb], 0, 0, 0); } }
}
__device__ __forceinline__ void nsa_pvm(const LAS unsigned char* Vt, const bf16x8 (&pf)[2][2], int n, int hh, f32x16 (&o)[2]) {
#pragma unroll
    for (int db = 0; db < 2; ++db)
#pragma unroll
        for (int kb = 0; kb < 2; ++kb)
#pragma unroll
            for (int s2 = 0; s2 < 2; ++s2) { const LAS unsigned char* p = Vt + (db * 32 + n) * NSA_VT_PITCH + (kb * 32 + 16 * s2 + 4 * hh) * 2;
                const u32x2 lo = *(const LAS u32x2*)p, hi = *(const LAS u32x2*)(p + 16);
                const u32x4 av = {lo.x, lo.y, hi.x, hi.y};
                o[db] = __builtin_amdgcn_mfma_f32_32x32x16_bf16(__builtin_bit_cast(bf16x8, av), pf[kb][s2], o[db], 0, 0, 0); }
}
__device__ __forceinline__ void nsa_pack(const f32x16 (&p)[2], bf16x8 (&pf)[2][2]) {
#pragma unroll
    for (int kb = 0; kb < 2; ++kb)
#pragma unroll
        for (int s2 = 0; s2 < 2; ++s2) { u32x4 w;
            w.x = pg8::cvt_pk_bf16(p[kb][8 * s2 + 0], p[kb][8 * s2 + 1]); w.y = pg8::cvt_pk_bf16(p[kb][8 * s2 + 2], p[kb][8 * s2 + 3]);
            w.z = pg8::cvt_pk_bf16(p[kb][8 * s2 + 4], p[kb][8 * s2 + 5]); w.w = pg8::cvt_pk_bf16(p[kb][8 * s2 + 6], p[kb][8 * s2 + 7]);
            pf[kb][s2] = __builtin_bit_cast(bf16x8, w); }
}
constexpr int BT2_ROWS = 2048 + 72;
template <bool COLSEL>
__device__ __forceinline__ void nsa_tile_mfma(const LAS unsigned char* Kt, const LAS unsigned char* Vt, const LAS float* btl2h, const bf16x8 (&qf)[4], int n, int hh,
                                              int key0, int tq, bool masked, bool colsel, int maxd, float& m, float& l, f32x16 (&o)[2]) {
    f32x16 s[2]; nsa_st(Kt, qf, n, hh, s);
    const int dbase = tq - key0 - 4 * hh;
    const LAS float* bp = btl2h + (2047 - dbase) * 4;
#pragma unroll
    for (int kb = 0; kb < 2; ++kb)
#pragma unroll
        for (int r = 0; r < 16; ++r) { const int cst = kb * 32 + (r & 3) + 8 * (r >> 2); const float x = s[kb][r] + bp[cst * 4]; s[kb][r] = (!COLSEL || colsel) ? x : -3.0e38f; }
    if (masked) {
#pragma unroll
        for (int kb = 0; kb < 2; ++kb)
#pragma unroll
            for (int r = 0; r < 16; ++r) { const int dist = dbase - (kb * 32 + (r & 3) + 8 * (r >> 2)); s[kb][r] = (dist >= 0 && dist <= maxd) ? s[kb][r] : -3.0e38f; } }
    float tmax = -3.0e38f;
#pragma unroll
    for (int kb = 0; kb < 2; ++kb)
#pragma unroll
        for (int r = 0; r < 16; ++r) tmax = fmaxf(tmax, s[kb][r]);
    tmax = fmaxf(tmax, __shfl_xor(tmax, 32));
    const float mn = fmaxf(m, tmax); float rs = 0.f;
#pragma unroll
    for (int kb = 0; kb < 2; ++kb)
#pragma unroll
        for (int r = 0; r < 16; ++r) { const float p = __builtin_amdgcn_exp2f(s[kb][r] - mn); s[kb][r] = p; rs += p; }
    rs += __shfl_xor(rs, 32);
    if (__any(mn > m)) { const float corr = __builtin_amdgcn_exp2f(m - mn); l *= corr;
#pragma unroll
        for (int db = 0; db < 2; ++db)
#pragma unroll
            for (int r = 0; r < 16; ++r) o[db][r] *= corr; }
    l += rs; m = mn;
    bf16x8 pf[2][2]; nsa_pack(s, pf);
    nsa_pvm(Vt, pf, n, hh, o);
}

__device__ __forceinline__ void ph_nsa_mfma(const ArgsG& a, LAS unsigned char* lds, int ubeg, int ustep, int uend, int tid, int wave, int lane) {
    LAS float* btl2 = (LAS float*)lds;
    constexpr int NSA_L0 = BT2_ROWS * 16;
    LAS unsigned char* Kt = lds + NSA_L0;
    LAS unsigned char* Vt = lds + NSA_L0 + 9216;
    constexpr int NSA_TB = 9216 + 8704;
    LAS float* PS = (LAS float*)(lds + NSA_L0 + 2 * NSA_TB + 256);
    LAS unsigned* MK = (LAS unsigned*)(lds + NSA_L0 + 2 * NSA_TB + 256 + 64 * 129 * 4);
    static_assert(NSA_L0 + 2 * NSA_TB + 256 + 64 * 129 * 4 + 512 <= RING_BYTES, "NSA LDS");
    const float* BT = (const float*)(a.W() + WS_BT);
    for (int i = tid; i < BT2_ROWS * 4; i += NTHR) { const int row = i >> 2, hd = i & 3; btl2[i] = row < 2048 ? BT[hd * 2048 + (2047 - row)] * 1.4426950408889634f : 0.f; }
    const bf16* P = (const bf16*)(a.W() + WS_P); const bf16* NQ = (const bf16*)(a.W() + WS_NQ);
    const bf16* KS = (const bf16*)(a.W() + WS_KS); const bf16* KW = (const bf16*)(a.W() + WS_KW);
    const bf16* KCMP = (const bf16*)(a.W() + WS_KCMP); const bf16* VCMP = (const bf16*)(a.W() + WS_VCMP); bf16* Y = (bf16*)(a.W() + WS_Y);
    const int n = lane & 31, hh = lane >> 5, tl = n >> 2, h = n & 3;
    const LAS float* btl2h = btl2 + h;
    __syncthreads();
    for (int u = ubeg; u < uend; u += ustep) {
        const int b = u & 7, qt = 31 - (u >> 3), t0 = 64 * qt, tq = t0 + 8 * wave + tl, tok = b * SEQ + tq;
        bf16x8 qf[4];
#pragma unroll
        for (int ks = 0; ks < 4; ++ks) qf[ks] = *(const bf16x8*)(NQ + (size_t)tok * 256 + h * 64 + 16 * ks + 8 * hh);
        float gate[3];
#pragma unroll
        for (int br = 0; br < 3; ++br) gate[br] = sigmoidf_(bf2f(P[(size_t)tok * NP + C_G + h * 3 + br]));
        f32x16 yacc[2];
        {
            float mx = -1e30f, rs = 0.f;
#pragma unroll 1
            for (int ct = 0; ct < 2; ++ct) {
                __syncthreads();
                { const NsaStage st = nsa_load(KCMP + (size_t)(b * 128 + ct * 64) * 64, 64, VCMP + (size_t)(b * 128 + ct * 64) * 64, 64, tid); nsa_store(st, Kt, Vt, tid); }
                __syncthreads();
                f32x16 sc[2]; nsa_st(Kt, qf, n, hh, sc);
                float tmax = -1e30f;
#pragma unroll
                for (int kb = 0; kb < 2; ++kb)
#pragma unroll
                    for (int r = 0; r < 16; ++r) { const int j = ct * 64 + kb * 32 + (r & 3) + 8 * (r >> 2) + 4 * hh; const int dist = tq - 16 * j - 31;
                        const float x = sc[kb][r] + btl2h[(2047 - (dist < 0 ? 0 : dist)) * 4]; sc[kb][r] = dist >= 0 ? x : -1e30f; tmax = fmaxf(tmax, sc[kb][r]); }
                tmax = fmaxf(tmax, __shfl_xor(tmax, 32));
                const float mn = fmaxf(mx, tmax); float ts = 0.f;
#pragma unroll
                for (int kb = 0; kb < 2; ++kb)
#pragma unroll
                    for (int r = 0; r < 16; ++r) { const float x = sc[kb][r]; ts += x > -1e29f ? __builtin_amdgcn_exp2f(x - mn) : 0.f; }
                ts += __shfl_xor(ts, 32);
                rs = rs * __builtin_amdgcn_exp2f(mx - mn) + ts; mx = mn;
            }
            const float inv = rs > 0.f ? 1.0f / rs : 0.f;
            f32x16 o[2];
#pragma unroll
            for (int db = 0; db < 2; ++db)
#pragma unroll
                for (int r = 0; r < 16; ++r) o[db][r] = 0.f;
#pragma unroll 1
            for (int cc = 0; cc < 2; ++cc) { const int ct = 1 - cc;
                if (cc == 1) { __syncthreads();
                    { const NsaStage st = nsa_load(KCMP + (size_t)(b * 128) * 64, 64, VCMP + (size_t)(b * 128) * 64, 64, tid); nsa_store(st, Kt, Vt, tid); }
                    __syncthreads(); }
                f32x16 sc[2]; nsa_st(Kt, qf, n, hh, sc);
#pragma unroll
                for (int kb = 0; kb < 2; ++kb)
#pragma unroll
                    for (int r = 0; r < 16; ++r) { const int j = ct * 64 + kb * 32 + (r & 3) + 8 * (r >> 2) + 4 * hh; const int dist = tq - 16 * j - 31;
                        const float x = sc[kb][r] + btl2h[(2047 - (dist < 0 ? 0 : dist)) * 4]; const float p = dist >= 0 ? __builtin_amdgcn_exp2f(x - mx) * inv : 0.f; sc[kb][r] = p;
                        float v = p; v += __shfl_xor(v, 1); v += __shfl_xor(v, 2);
                        if (h == 0) PS[(8 * wave + tl) * 129 + j] = v; }
                bf16x8 pf[2][2]; nsa_pack(sc, pf); nsa_pvm(Vt, pf, n, hh, o);
            }
#pragma unroll
            for (int db = 0; db < 2; ++db)
#pragma unroll
                for (int r = 0; r < 16; ++r) yacc[db][r] = gate[0] * o[db][r];
        }
        LDS_WAIT();
        for (int t2 = 0; t2 < 8; ++t2) {
            const int tqq = t0 + 8 * wave + t2, sb = lane & 31, cur = tqq >> 6; const LAS float* row = PS + (8 * wave + t2) * 129; float imp = 0.f;
#pragma unroll
            for (int dj = -1; dj <= 3; ++dj) { const int j = 4 * sb + dj; if (j >= 0 && j <= 126) imp += row[j]; }
            if (sb > cur) imp = -1.0f; else if (sb == 0 || sb == cur || sb == cur - 1) imp = 1e4f;
            int rank = 0;
            for (int s2 = 0; s2 < 32; ++s2) { const float v2 = __shfl(imp, s2); rank += (v2 > imp || (v2 == imp && s2 < sb)) ? 1 : 0; }
            const unsigned msk = (unsigned)__ballot((lane < 32) && (rank < 16) && (sb <= cur));
            if (lane == 0) MK[8 * wave + t2] = msk;
        }
        __syncthreads();
        unsigned anymask, wmask; const unsigned mymask = MK[8 * wave + tl];
        { unsigned v = MK[lane];
#pragma unroll
            for (int o_ = 1; o_ < 64; o_ <<= 1) v |= (unsigned)__shfl_xor((int)v, o_);
            anymask = (unsigned)__builtin_amdgcn_readfirstlane((int)v);
            unsigned w = MK[8 * wave + (lane & 7)]; w |= (unsigned)__shfl_xor((int)w, 1); w |= (unsigned)__shfl_xor((int)w, 2); w |= (unsigned)__shfl_xor((int)w, 4);
            wmask = (unsigned)__builtin_amdgcn_readfirstlane((int)w); }
        LAS unsigned* stash = (LAS unsigned*)PS + (wave * 16) * 64 + lane;
        __syncthreads();
#pragma unroll
        for (int db = 0; db < 2; ++db)
#pragma unroll
            for (int k = 0; k < 8; ++k) stash[(db * 8 + k) * 64] = pk2(yacc[db][2 * k], yacc[db][2 * k + 1]);
        {
            float m = -1e30f, l = 0.f; f32x16 o[2];
#pragma unroll
            for (int db = 0; db < 2; ++db)
#pragma unroll
                for (int r = 0; r < 16; ++r) o[db][r] = 0.f;
            unsigned mk = anymask; NsaStage s0, s1; bool h1 = false;
            { const int sa = __builtin_ctz(mk); s0 = nsa_load(KS + (size_t)(b * SEQ + 64 * sa) * 64, 64, P + (size_t)(b * SEQ + 64 * sa) * NP + C_KV + 192, NP, tid);
              unsigned m2 = mk & (mk - 1u); if (m2) { const int sb2 = __builtin_ctz(m2); s1 = nsa_load(KS + (size_t)(b * SEQ + 64 * sb2) * 64, 64, P + (size_t)(b * SEQ + 64 * sb2) * NP + C_KV + 192, NP, tid); h1 = true; } }
            __syncthreads();
            nsa_store(s0, Kt, Vt, tid);
            __syncthreads();
            int par = 0;
            while (mk) {
                const int sblk = __builtin_ctz(mk); mk &= mk - 1u;
                if (h1) { nsa_store(s1, Kt + (par ^ 1) * NSA_TB, Vt + (par ^ 1) * NSA_TB, tid);
                    const unsigned m3 = mk & (mk - 1u);
                    if (m3) { const int sc2 = __builtin_ctz(m3); s1 = nsa_load(KS + (size_t)(b * SEQ + 64 * sc2) * 64, 64, P + (size_t)(b * SEQ + 64 * sc2) * NP + C_KV + 192, NP, tid); } else h1 = false; }
                if ((wmask >> sblk) & 1u) nsa_tile_mfma<true>(Kt + par * NSA_TB, Vt + par * NSA_TB, btl2h, qf, n, hh, 64 * sblk, tq, 64 * sblk + 63 > t0 + 8 * wave, ((mymask >> sblk) & 1u) != 0u, 1 << 30, m, l, o);
                __syncthreads();
                par ^= 1;
            }
            const float inv = l > 0.f ? gate[1] / l : 0.f;
#pragma unroll
            for (int db = 0; db < 2; ++db)
#pragma unroll
                for (int k = 0; k < 8; ++k) { const unsigned w = stash[(db * 8 + k) * 64]; stash[(db * 8 + k) * 64] = pk2(bf_lo(w) + inv * o[db][2 * k], bf_hi(w) + inv * o[db][2 * k + 1]); }
        }
        {
            float m = -1e30f, l = 0.f; f32x16 o[2];
#pragma unroll
            for (int db = 0; db < 2; ++db)
#pragma unroll
                for (int r = 0; r < 16; ++r) o[db][r] = 0.f;
            const int kt0 = (t0 - 511 > 0 ? t0 - 511 : 0) >> 6;
            NsaStage s0 = nsa_load(KW + (size_t)(b * SEQ + 64 * kt0) * 64, 64, P + (size_t)(b * SEQ + 64 * kt0) * NP + C_KV + 320, NP, tid), s1;
            if (kt0 < qt) s1 = nsa_load(KW + (size_t)(b * SEQ + 64 * (kt0 + 1)) * 64, 64, P + (size_t)(b * SEQ + 64 * (kt0 + 1)) * NP + C_KV + 320, NP, tid);
            __syncthreads();
            nsa_store(s0, Kt, Vt, tid);
            __syncthreads();
            int par = 0;
            for (int kt = kt0; kt <= qt; ++kt) {
                if (kt < qt) { nsa_store(s1, Kt + (par ^ 1) * NSA_TB, Vt + (par ^ 1) * NSA_TB, tid);
                    if (kt + 2 <= qt) s1 = nsa_load(KW + (size_t)(b * SEQ + 64 * (kt + 2)) * 64, 64, P + (size_t)(b * SEQ + 64 * (kt + 2)) * NP + C_KV + 320, NP, tid); }
                nsa_tile_mfma<false>(Kt + par * NSA_TB, Vt + par * NSA_TB, btl2h, qf, n, hh, 64 * kt, tq, !(64 * kt + 63 <= t0 + 8 * wave && t0 + 8 * wave + 7 - 64 * kt <= 511), true, 511, m, l, o);
                __syncthreads();
                par ^= 1;
            }
            const float inv = l > 0.f ? gate[2] / l : 0.f;
#pragma unroll
            for (int db = 0; db < 2; ++db)
#pragma unroll
                for (int k = 0; k < 8; ++k) { const unsigned w = stash[(db * 8 + k) * 64]; yacc[db][2 * k] = bf_lo(w) + inv * o[db][2 * k]; yacc[db][2 * k + 1] = bf_hi(w) + inv * o[db][2 * k + 1]; }
        }
#pragma unroll
        for (int db = 0; db < 2; ++db)
#pragma unroll
            for (int rq = 0; rq < 4; ++rq) { u32x2 w; w.x = pk2(yacc[db][4 * rq], yacc[db][4 * rq + 1]); w.y = pk2(yacc[db][4 * rq + 2], yacc[db][4 * rq + 3]);
                *(u32x2*)(Y + (size_t)tok * DM + 512 + h * 64 + db * 32 + 8 * rq + 4 * hh) = w; }
        __syncthreads();
    }
}

constexpr int RT_PITCH = 2064;
__device__ __forceinline__ void ph_router(const ArgsG& a, int l, const float* Xin_, const bf16* Dm, LAS unsigned char* lds, int bid, int G, int tid, int wave, int lane) {
    LAS unsigned char* Ht = lds;
    LAS float* LG = (LAS float*)(lds + 32 * RT_PITCH);
    LAS int* lcnt = (LAS int*)(lds + 32 * RT_PITCH + 4 * 64 * 33 * 4); LAS int* asg_e = lcnt + 32; LAS int* asg_p = asg_e + 256; LAS float* asg_w = (LAS float*)(asg_p + 256); LAS int* gbase = (LAS int*)(asg_w + 256);
    bf16* H2 = (bf16*)(a.W() + WS_XN); unsigned* cnt = (unsigned*)(a.W() + WS_CTL) + CW_CNT + 64 * l;
    int* EIDX = (int*)(a.W() + WS_EIDX); int* EPOS = (int*)(a.W() + WS_EPOS); float* EW = (float*)(a.W() + WS_EW); int* POSTOK = (int*)(a.W() + WS_XS);
    const float* fw = a.I(17) + (size_t)l * DM; const float* rb = a.I(19) + l * NE;
    const bf16* RWH = (const bf16*)(a.W() + WS_RWH) + (size_t)l * NE * DM; const bf16* RWL = (const bf16*)(a.W() + WS_RWL) + (size_t)l * NE * DM;
    for (int u = bid; u < NT / 64; u += G) {
        const int tok0 = u * 64;
        if (tid < 32) lcnt[tid] = 0;
#pragma unroll 1
        for (int hf = 0; hf < 2; ++hf) {
            __syncthreads();
#pragma unroll 1
            for (int i = 0; i < 4; ++i) { const int tl = 4 * wave + i, tok = tok0 + 32 * hf + tl;
                f32x4 v[4]; float ss = 0.f;
#pragma unroll
                for (int j = 0; j < 4; ++j) { v[j] = *(const f32x4*)(Xin_ + (size_t)tok * DM + 4 * (64 * j + lane)); const u32x2 dd = *(const u32x2*)(Dm + (size_t)tok * DM + 4 * (64 * j + lane));
                    v[j].x += bf_lo(dd.x); v[j].y += bf_hi(dd.x); v[j].z += bf_lo(dd.y); v[j].w += bf_hi(dd.y); ss += (v[j].x * v[j].x + v[j].y * v[j].y) + (v[j].z * v[j].z + v[j].w * v[j].w); }
                const float r = rsqrtf(wave_sum(ss) * (1.0f / DM) + EPS);
#pragma unroll
                for (int j = 0; j < 4; ++j) { const f32x4 y = v[j] * r * *(const f32x4*)(fw + 4 * (64 * j + lane));
                    u32x2 o; o.x = pk2(y.x, y.y); o.y = pk2(y.z, y.w); *(u32x2*)(H2 + (size_t)tok * DM + 4 * (64 * j + lane)) = o;
                    *(LAS u32x2*)(Ht + tl * RT_PITCH + 8 * (64 * j + lane)) = o; } }
            __syncthreads();
            { const int r = lane & 15, q = lane >> 4, tile = wave & 1, kq = wave >> 1; f32x4 acc0 = {0.f, 0.f, 0.f, 0.f}, acc1 = {0.f, 0.f, 0.f, 0.f};
                const LAS unsigned char* arow = Ht + (16 * tile + r) * RT_PITCH + q * 16;
                const bf16* bh = RWH + (size_t)r * DM + 8 * q; const bf16* bl = RWL + (size_t)r * DM + 8 * q;
#pragma unroll
                for (int s8 = 0; s8 < 8; ++s8) { const int s = 8 * kq + s8; const bf16x8 af = *(const LAS bf16x8*)(arow + s * 64);
                    acc0 = __builtin_amdgcn_mfma_f32_16x16x32_bf16(af, *(const bf16x8*)(bh + 32 * s), acc0, 0, 0, 0); acc0 = __builtin_amdgcn_mfma_f32_16x16x32_bf16(af, *(const bf16x8*)(bl + 32 * s), acc0, 0, 0, 0);
                    acc1 = __builtin_amdgcn_mfma_f32_16x16x32_bf16(af, *(const bf16x8*)(bh + 16 * DM + 32 * s), acc1, 0, 0, 0); acc1 = __builtin_amdgcn_mfma_f32_16x16x32_bf16(af, *(const bf16x8*)(bl + 16 * DM + 32 * s), acc1, 0, 0, 0); }
                const float b0 = kq == 0 ? rb[r] : 0.f, b1 = kq == 0 ? rb[16 + r] : 0.f;
#pragma unroll
                for (int i = 0; i < 4; ++i) { LAS float* lg = LG + kq * (64 * 33) + (32 * hf + 16 * tile + 4 * q + i) * 33; lg[r] = acc0[i] + b0; lg[16 + r] = acc1[i] + b1; } }
        }
        __syncthreads();
        if (tid < 64) { const LAS float* lg = LG + tid * 33; unsigned used = 0u; float tv[4]; int ti[4];
#pragma unroll
            for (int qn = 0; qn < 4; ++qn) { float best = -3.0e38f; int bi = 0;
                for (int e = 0; e < NE; ++e) { const float v = ((lg[e] + lg[64 * 33 + e]) + lg[2 * 64 * 33 + e]) + lg[3 * 64 * 33 + e]; if (!((used >> e) & 1u) && v > best) { best = v; bi = e; } }
                used |= 1u << bi; tv[qn] = best; ti[qn] = bi; }
            float ew[4], es = 0.f;
#pragma unroll
            for (int qn = 0; qn < 4; ++qn) { ew[qn] = __expf(tv[qn] - tv[0]); es += ew[qn]; }
#pragma unroll
            for (int qn = 0; qn < 4; ++qn) { const int p = __hip_atomic_fetch_add(&lcnt[ti[qn]], 1, __ATOMIC_RELAXED, __HIP_MEMORY_SCOPE_WORKGROUP); asg_e[tid * 4 + qn] = ti[qn]; asg_p[tid * 4 + qn] = p; asg_w[tid * 4 + qn] = ew[qn] / es; } }
        __syncthreads();
        if (tid < 32) gbase[tid] = (int)atomicAdd(&cnt[tid], (unsigned)lcnt[tid]);
        __syncthreads();
        if (tid < 256) { const int tok = tok0 + (tid >> 2), k = tid & 3, e = asg_e[tid];
            const int pos = gbase[e] + asg_p[tid];
            EIDX[(size_t)tok * 4 + k] = e; EPOS[(size_t)tok * 4 + k] = pos; EW[(size_t)tok * 4 + k] = asg_w[tid]; POSTOK[(size_t)e * NT + pos] = tok; }
        __syncthreads();
    }
}

__device__ __forceinline__ void build_tiles(const unsigned* cnt, LAS int* TS, LAS int* TE, int tid) {
    if (tid == 0) { int acc = 0;
        for (int e = 0; e < NE; ++e) { TS[e] = acc; const int nt = (int)((cnt[e] + 255u) >> 8); for (int i = 0; i < nt; ++i) TE[acc + i] = e; acc += nt; }
        TS[NE] = acc; }
    __syncthreads();
}

__device__ __forceinline__ void ph_gather(const ArgsG& a, int l, LAS unsigned char* lds, int gw, int NGW, int tid, int lane) {
    LAS int* TS = (LAS int*)(lds + TS_OFF); LAS int* TE = (LAS int*)(lds + TE_OFF);
    const unsigned* cnt = (const unsigned*)(a.W() + WS_CTL) + CW_CNT + 64 * l;
    build_tiles(cnt, TS, TE, tid);
    const int* EIDX = (const int*)(a.W() + WS_EIDX); const int* EPOS = (const int*)(a.W() + WS_EPOS); int* SLOT = (int*)(a.W() + WS_SLOT); int* S2T = (int*)(a.W() + WS_XS);
    for (int i = gw * 64 + lane; i < NT * 4; i += NGW * 64) { const int slot = TS[EIDX[i]] * 256 + EPOS[i]; SLOT[i] = slot; S2T[slot] = i >> 2; }
    for (int e = (int)blockIdx.x; e < NE; e += (int)gridDim.x) { const int beg = TS[e] * 256 + (int)cnt[e], end = TS[e + 1] * 256; for (int sidx = beg + tid; sidx < end; sidx += NTHR) S2T[sidx] = 0; }
}

__device__ __forceinline__ void ph_combine(const ArgsG& a, int l, LAS unsigned char* lds, const float* Xin_, const bf16* Dm, float* Xo, const float* next_norm_w, int gw, int NGW, int tid, int lane) {
    LAS int* TS = (LAS int*)(lds + TS_OFF); LAS int* TE = (LAS int*)(lds + TE_OFF);
    build_tiles((const unsigned*)(a.W() + WS_CTL) + CW_CNT + 64 * l, TS, TE, tid);
    const int* EIDX = (const int*)(a.W() + WS_EIDX); const int* EPOS = (const int*)(a.W() + WS_EPOS);
    const bf16* YS = (const bf16*)(a.W() + WS_YS); const float* EW = (const float*)(a.W() + WS_EW); bf16* XN = (bf16*)(a.W() + WS_XN);
    for (int tok = gw; tok < NT; tok += NGW) {
        int slot = 0; float wgt = 0.f;
        if (lane < 4) { slot = TS[EIDX[(size_t)tok * 4 + lane]] * 256 + EPOS[(size_t)tok * 4 + lane]; wgt = EW[(size_t)tok * 4 + lane]; }
        f32x4 v[4];
#pragma unroll
        for (int j = 0; j < 4; ++j) { v[j] = *(const f32x4*)(Xin_ + (size_t)tok * DM + 4 * (64 * j + lane)); const u32x2 dd = *(const u32x2*)(Dm + (size_t)tok * DM + 4 * (64 * j + lane));
            v[j].x += bf_lo(dd.x); v[j].y += bf_hi(dd.x); v[j].z += bf_lo(dd.y); v[j].w += bf_hi(dd.y); }
#pragma unroll
        for (int k = 0; k < 4; ++k) { const int sk = __shfl(slot, k); const float wk = __shfl(wgt, k);
#pragma unroll
            for (int j = 0; j < 4; ++j) { const u32x2 y = *(const u32x2*)(YS + (size_t)sk * DM + 4 * (64 * j + lane));
                v[j].x += wk * bf_lo(y.x); v[j].y += wk * bf_hi(y.x); v[j].z += wk * bf_lo(y.y); v[j].w += wk * bf_hi(y.y); } }
#pragma unroll
        for (int j = 0; j < 4; ++j) *(f32x4*)(Xo + (size_t)tok * DM + 4 * (64 * j + lane)) = v[j];
        if (next_norm_w) rms_row_to_bf16(v, next_norm_w, XN + (size_t)tok * DM, lane);
    }
}

struct Tid { int tid, lane, wave; };
__device__ __forceinline__ Tid fresh_tid() { int t = threadIdx.x; asm volatile("" : "+v"(t)); Tid r; r.tid = t; r.lane = t & 63; r.wave = __builtin_amdgcn_readfirstlane(t >> 6); return r; }
#define FT() ArgsG A_; { unsigned char* w_ = args_k.ws; asm volatile("" : "+s"(w_)); A_.ws = (GAS unsigned char*)w_; _Pragma("unroll") for (int i_ = 0; i_ < 25; ++i_) A_.in[i_] = (const GAS float*)args_k.in[i_]; A_.out = (GAS float*)args_k.out; } const ArgsG& args = A_; const Tid T_ = fresh_tid(); const int tid = T_.tid, lane = T_.lane, wave = T_.wave, gw = bid * NWAVES + wave; (void)tid; (void)lane; (void)wave; (void)gw
constexpr int PH_PER_LAYER = 11, NPH = 2 + NLAYER * PH_PER_LAYER;

#if SINGLE_LAUNCH
#define BARPARM , unsigned* barw, unsigned& bark
#define BARARG , barw, bark
#define GRID_BAR() cnt_barrier(barw, bark)
#else
#define BARPARM
#define BARARG
#define GRID_BAR() do {} while (0)
#endif
#define IN(k) (lo <= (k) && (k) < hi)
#define SEAM(k) do { if (IN(k) && IN((k) + 1)) GRID_BAR(); } while (0)
template <int l>
__device__ __forceinline__ void run_layer(const Args& args_k, LAS unsigned char* lds, int lo, int hi, int G, int bid, int NGW BARPARM) {
        const int pb = 2 + l * PH_PER_LAYER;
#define Xin ((l == 0) ? args.I(0) : (const float*)(args.W() + WS_XB))
#define X1 ((float*)(args.W() + WS_XA))
#define Xout ((l == NLAYER - 1) ? args.O() : (float*)(args.W() + WS_XB))
        if (IN(pb + 0)) {
            FT(); pg8::Gemm g{(const pg8::bf16_t*)(args.W() + WS_XN), (const pg8::bf16_t*)(args.W() + WS_WIN) + (size_t)l * NP * DM, NT, NP, DM};
            pg8::StaticOrder S; S.init(NT, NP, G, bid);
            pg8::EpiBf16Plain E{(pg8::bf16_t*)(args.W() + WS_P), NP};
            pg8::gemm_phase<pg8::EpiBf16Plain, pg8::StaticOrder, true, true>(lds, g, S, E);
        } SEAM(pb + 0);
        if (IN(pb + 1)) { { FT(); ph_compress_mfma(args, l, lds, bid, G, tid, wave, lane); } { FT(); ph_m1(args, l, lds, bid, G, tid, wave, lane); }
            asm volatile("s_waitcnt vmcnt(0)" ::: "memory"); __syncthreads();
            if (G == 256) { FT(); ph_dn_chunk_mfma(args, lds, bid, G, tid, wave, lane); } }
        if (G != 256) { SEAM(pb + 1); if (IN(pb + 1)) { FT(); ph_dn_chunk_mfma(args, lds, bid, G, tid, wave, lane); } } SEAM(pb + 1);
        if (IN(pb + 3)) {
            const bool small = G <= 64;
            if (small || bid < 32) { FT(); ph_dn_scan_mfma(args, lds, bid, small ? G : 32, tid, wave, lane); }
            { int ub, us, ue;
              if (small) { ub = bid; us = G; ue = 256; }
              else if (G == 256) { if (bid >= 32) { ub = bid - 32; us = 32; ue = ub >= 192 ? 256 : ub + 1; } else { ub = 256; us = 256; ue = 256; } }
              else { ub = bid >= 32 ? bid - 32 : 256; us = G - 32; ue = 256; }
              FT(); ph_nsa_mfma(args, lds, ub, us, ue, tid, wave, lane); } } SEAM(pb + 3);
        if (IN(pb + 4)) { FT(); ph_dn_out(args, l, gw, NGW, lane); } SEAM(pb + 4);
        if (IN(pb + 5)) {
            FT(); pg8::Gemm g{(const pg8::bf16_t*)(args.W() + WS_Y), (const pg8::bf16_t*)(args.W() + WS_WOUT) + (size_t)l * DM * DM, NT, DM, DM};
            pg8::StaticOrder S; S.init(NT, DM, G, bid);
            pg8::EpiBf16Plain E{(pg8::bf16_t*)(args.W() + WS_XA), DM};
            pg8::gemm_phase<pg8::EpiBf16Plain, pg8::StaticOrder, true, true>(lds, g, S, E);
        } SEAM(pb + 5);
        if (IN(pb + 6)) { FT(); ph_router(args, l, Xin, (const bf16*)(args.W() + WS_XA), lds, bid, G, tid, wave, lane); } SEAM(pb + 6);
        if (IN(pb + 8)) {
            FT(); LAS int* TS = (LAS int*)(lds + TS_OFF); LAS int* TE = (LAS int*)(lds + TE_OFF);
            build_tiles((const unsigned*)(args.W() + WS_CTL) + CW_CNT + 64 * l, TS, TE, tid);
            const int ntiles = __builtin_amdgcn_readfirstlane(TS[NE]);
            pg8::Gemm g{(const pg8::bf16_t*)(args.W() + WS_XN), (const pg8::bf16_t*)(args.W() + WS_WGU) + (size_t)l * NE * 2048 * DM, ntiles * 256, NE * 2048, DM};
            LAS int* RT = (LAS int*)(lds + LDSCTL_OFF + 2048);
            pg8::MoeOrder<8, true> S{ntiles, G, bid, (const LAS int*)TE, (const LAS int*)RT};
            { const int* POSTOK = (const int*)(args.W() + WS_XS); const unsigned* cntp = (const unsigned*)(args.W() + WS_CTL) + CW_CNT + 64 * l; pg8::Unit uu;
              for (int i = 0; i < 10 && S.next(i, uu); ++i) if (tid < 256) { const int e = TE[uu.pm], pos = uu.pm * 256 + tid - TS[e] * 256; RT[i * 256 + tid] = pos < (int)cntp[e] ? POSTOK[(size_t)e * NT + pos] : 0; } }
            __syncthreads();
            pg8::EpiSwiglu E{(pg8::bf16_t*)(args.W() + WS_ACT), args.I(21) + (size_t)l * NE * 2048};
            pg8::gemm_phase<pg8::EpiSwiglu, pg8::MoeOrder<8, true>, true, true>(lds, g, S, E);
        } SEAM(pb + 8);
        if (IN(pb + 9)) {
            FT(); LAS int* TS = (LAS int*)(lds + TS_OFF); LAS int* TE = (LAS int*)(lds + TE_OFF);
            build_tiles((const unsigned*)(args.W() + WS_CTL) + CW_CNT + 64 * l, TS, TE, tid);
            const int ntiles = __builtin_amdgcn_readfirstlane(TS[NE]);
            pg8::Gemm g{(const pg8::bf16_t*)(args.W() + WS_ACT), (const pg8::bf16_t*)(args.W() + WS_WD) + (size_t)l * NE * DM * DM, ntiles * 256, NE * DM, DM};
            pg8::MoeOrder<4> S{ntiles, G, bid, (const LAS int*)TE};
            pg8::EpiDown64 E{(pg8::bf16_t*)(args.W() + WS_YS), args.I(23) + (size_t)l * NE * DM};
            pg8::gemm_phase<pg8::EpiDown64, pg8::MoeOrder<4>, true, true>(lds, g, S, E);
        } SEAM(pb + 9);
        if (IN(pb + 10)) { FT(); ph_combine(args, l, lds, Xin, (const bf16*)(args.W() + WS_XA), Xout, (l + 1 < NLAYER) ? args.I(1) + (size_t)(l + 1) * DM : nullptr, gw, NGW, tid, lane); }
        if (l + 1 < NLAYER) SEAM(pb + 10);
    }

__global__ void __launch_bounds__(NTHR, 2) fwd_kernel(Args args_k) {
    extern __shared__ __attribute__((aligned(16))) unsigned char lds_raw[];
    LAS unsigned char* lds = (LAS unsigned char*)lds_raw;
    const int G = gridDim.x, bid = blockIdx.x, NGW = G * NWAVES;
    for (int u = threadIdx.x; u < (LDS_BYTES - LDSCTL_OFF) / 4; u += NTHR) ((LAS unsigned*)(lds + LDSCTL_OFF))[u] = 0u;
    __syncthreads();
#if SINGLE_LAUNCH
    unsigned* barw = (unsigned*)(args_k.ws + WS_CTL) + CW_BAR; unsigned bark = 0u;
#endif
    const int lo = args_k.ph_lo, hi = args_k.ph_hi;

    if (IN(0)) { { FT(); ph_norm0(args, gw, NGW, lane); } { FT(); ph_prologue(args, lds, gw, NGW, wave, lane); } } SEAM(0);

    run_layer<0>(args_k, lds, lo, hi, G, bid, NGW BARARG);
    run_layer<1>(args_k, lds, lo, hi, G, bid, NGW BARARG);
#undef IN
#undef SEAM
}

extern "C" void kernel_launch(void* const* d_in, const int* in_sizes, int n_in, void* d_out, int out_size, void* d_ws, size_t ws_size, hipStream_t stream) {
    static int grid = 0;
    if (grid == 0) {
        if (n_in != 25 || in_sizes[0] != NT * DM || out_size != NT * DM || ws_size < WS_END) {
            fprintf(stderr, "kernel_launch: unexpected problem (n_in %d, in0 %d, out %d, ws %zu < %zu); nothing launched\n", n_in, n_in > 0 ? in_sizes[0] : -1, out_size, ws_size, (size_t)WS_END); grid = -1; return; }
        int dev = 0, cus = 0, per_cu = 0;
        if (hipGetDevice(&dev) != hipSuccess || hipDeviceGetAttribute(&cus, hipDeviceAttributeMultiprocessorCount, dev) != hipSuccess) { grid = -1; return; }
        if (hipFuncSetAttribute((const void*)fwd_kernel, hipFuncAttributeMaxDynamicSharedMemorySize, LDS_BYTES) != hipSuccess) { fprintf(stderr, "kernel_launch: hipFuncSetAttribute failed\n"); grid = -1; return; }
        if (hipOccupancyMaxActiveBlocksPerMultiprocessor(&per_cu, (const void*)fwd_kernel, NTHR, LDS_BYTES) != hipSuccess || per_cu < 1)
            fprintf(stderr, "kernel_launch: note: occupancy query reports %d workgroups per CU\n", per_cu);
        (void)hipGetLastError();
        grid = cus;
    }
    if (grid < 0) return;
    if (hipMemsetAsync((char*)d_ws + WS_CTL, 0, CTL_ZERO_BYTES, stream) != hipSuccess) { fprintf(stderr, "kernel_launch: memset failed\n"); return; }
    Args a{};
    for (int i = 0; i < 25; ++i) a.in[i] = (const float*)d_in[i];
    a.out = (float*)d_out; a.ws = (unsigned char*)d_ws;
#if SINGLE_LAUNCH
    a.ph_lo = 0; a.ph_hi = NPH;
    hipLaunchKernelGGL(fwd_kernel, dim3(grid), dim3(NTHR), LDS_BYTES, stream, a);
#else
    for (int ph = 0; ph < NPH; ++ph) { a.ph_lo = ph; a.ph_hi = ph + 1; hipLaunchKernelGGL(fwd_kernel, dim3(grid), dim3(NTHR), LDS_BYTES, stream, a); }
#endif
}
```

```cpp
#include <hip/hip_runtime.h>
#include <cstdio>
#include <cstdint>
#include <cstddef>
namespace pg8 {
#define PG8_LAS __attribute__((address_space(3)))
#define PG8_GAS __attribute__((address_space(1)))
typedef unsigned short bf16_t;
typedef short bf16x8 __attribute__((ext_vector_type(8)));
typedef float f32x4 __attribute__((ext_vector_type(4)));
typedef unsigned u32x4 __attribute__((ext_vector_type(4)));
constexpr int BM = 256, BK = 64, HALF = 128, HTB = HALF * BK * 2  , STAGE_BYTES = 8 * HTB, NXCD = 8, WGM = 8;

__host__ __device__ __forceinline__ int lds_byte(int r, int c) { const int st = (r >> 4) * 2 + (c >> 5), rr = r & 15, cc = c & 31, ob = rr * 64 + cc * 2; return st * 1024 + (ob ^ (((ob >> 9) & 1) << 5)); }
__host__ __device__ __forceinline__ void stage_rc(int b, int& R, int& C) { const int st = b / 1024, sb = b % 1024, swz = sb ^ (((sb >> 9) & 1) << 5); R = (st >> 1) * 16 + swz / 64; C = (st & 1) * 32 + (swz % 64) / 2; }
__host__ __device__ __forceinline__ int perm32(int rho) { const int n = rho >> 4, i = rho & 15; return 8 * (i >> 2) + 4 * n + (i & 3); }

struct Unit { int pm, pn; };
struct Gemm { const bf16_t* A; const bf16_t* Bt; int M, N, K; };

struct StaticOrder {
    static constexpr bool GATHER = false; const PG8_LAS int* rowtab = nullptr;
    int nM, nN, nwg, G, c;
    __host__ __device__ void init(int M, int N, int G_, int c_) { nM = M / BM; nN = N / BM; nwg = nM * nN; G = G_; c = c_; }
    __host__ __device__ bool next(int i, Unit& u) const {
        const long L = (long)i * G + c; if (L >= nwg) return false;
        int wgid = (int)L; { const int q = nwg / NXCD, r = nwg % NXCD, xcd = wgid % NXCD, off = wgid / NXCD; wgid = (xcd < r ? xcd * (q + 1) : r * (q + 1) + (xcd - r) * q) + off; }
        const int nig = WGM * nN, gid = wgid / nig, fm = gid * WGM, gsz = (nM - fm) < WGM ? (nM - fm) : WGM;
        u.pm = fm + ((wgid % nig) % gsz); u.pn = (wgid % nig) / gsz; return true;
    }
    __device__ __forceinline__ void a_ready(const Unit&) const {}
    __device__ __forceinline__ void done(const Unit&) const {}
};

__device__ __forceinline__ unsigned cvt_pk_bf16(float lo, float hi) { unsigned r; asm volatile("v_cvt_pk_bf16_f32 %0, %1, %2" : "=v"(r) : "v"(lo), "v"(hi)); return r; }

struct EpiBf16Plain {
    static constexpr bool PERM = true, AFTER_DRAIN = false, B64 = false;
    bf16_t* O; int ldc;
    __device__ __forceinline__ void operator()(const f32x4 (&acc)[2][2][4][2], const Unit& u, int wr, int wc, int fr, int fq) const {
        const int row0 = u.pm * BM + wr * 64 + fr, col0 = u.pn * BM + wc * 32 + 8 * fq;
#pragma unroll
        for (int ai = 0; ai < 2; ++ai)
#pragma unroll
            for (int m = 0; m < 4; ++m) { bf16_t* rowp = O + (size_t)(row0 + ai * HALF + m * 16) * ldc + col0;
#pragma unroll
                for (int bj = 0; bj < 2; ++bj) { const f32x4 v0 = acc[ai][bj][m][0], v1 = acc[ai][bj][m][1];
                    u32x4 w; w.x = cvt_pk_bf16(v0[0], v0[1]); w.y = cvt_pk_bf16(v0[2], v0[3]); w.z = cvt_pk_bf16(v1[0], v1[1]); w.w = cvt_pk_bf16(v1[2], v1[3]);
                    *(PG8_GAS u32x4*)(rowp + bj * HALF) = w; } }
    }
};
struct EpiResF32 {
    static constexpr bool PERM = false, AFTER_DRAIN = false, B64 = false;
    const float* base; float* out; int ldc;
    __device__ __forceinline__ void operator()(const f32x4 (&acc)[2][2][4][2], const Unit& u, int wr, int wc, int fr, int fq) const {
        const int row0 = u.pm * BM + wr * 64 + fr, col0 = u.pn * BM + wc * 32 + 4 * fq;
#pragma unroll
        for (int ai = 0; ai < 2; ++ai)
#pragma unroll
            for (int m = 0; m < 4; ++m) { const size_t off = (size_t)(row0 + ai * HALF + m * 16) * ldc + col0;
#pragma unroll
                for (int bj = 0; bj < 2; ++bj)
#pragma unroll
                    for (int n = 0; n < 2; ++n) { const f32x4 b = *(const f32x4*)(base + off + bj * HALF + n * 16); *(PG8_GAS f32x4*)(out + off + bj * HALF + n * 16) = b + acc[ai][bj][m][n]; } }
    }
};
struct EpiSwiglu {
    static constexpr bool PERM = true, AFTER_DRAIN = false, B64 = false;
    bf16_t* O; const float* bgu;
    __device__ __forceinline__ void operator()(const f32x4 (&acc)[2][2][4][2], const Unit& u, int wr, int wc, int fr, int fq) const {
        const int e = u.pn >> 3, pnl = u.pn & 7;
        const int row0 = u.pm * BM + wr * 64 + fr, gcol = pnl * 128 + wc * 32 + 8 * fq;
        const float* bg = bgu + (size_t)e * 2048 + gcol;
        f32x4 bgv[2], buv[2];
#pragma unroll
        for (int n = 0; n < 2; ++n) { bgv[n] = *(const PG8_GAS f32x4*)(bg + 4 * n); buv[n] = *(const PG8_GAS f32x4*)(bg + 1024 + 4 * n); }
#pragma unroll
        for (int ai = 0; ai < 2; ++ai)
#pragma unroll
            for (int m = 0; m < 4; ++m) { bf16_t* rowp = O + (size_t)(row0 + ai * HALF + m * 16) * 1024 + gcol;
                float r[8];
#pragma unroll
                for (int n = 0; n < 2; ++n) { const f32x4 gv = acc[ai][0][m][n] + bgv[n], uv = acc[ai][1][m][n] + buv[n];
#pragma unroll
                    for (int j = 0; j < 4; ++j) { const float g = fminf(gv[j], 7.0f), up = fminf(fmaxf(uv[j], -7.0f), 7.0f);
                        const float sg = __builtin_amdgcn_rcpf(1.0f + __expf(-1.702f * g)); r[n * 4 + j] = (up + 1.0f) * g * sg; } }
                u32x4 w; w.x = cvt_pk_bf16(r[0], r[1]); w.y = cvt_pk_bf16(r[2], r[3]); w.z = cvt_pk_bf16(r[4], r[5]); w.w = cvt_pk_bf16(r[6], r[7]);
                *(PG8_GAS u32x4*)rowp = w; }
    }
};
struct EpiDown {
    static constexpr bool PERM = true, AFTER_DRAIN = false, B64 = false;
    bf16_t* O; const float* bd;
    __device__ __forceinline__ void operator()(const f32x4 (&acc)[2][2][4][2], const Unit& u, int wr, int wc, int fr, int fq) const {
        const int e = u.pn >> 2, pnl = u.pn & 3;
        const int row0 = u.pm * BM + wr * 64 + fr, col0 = pnl * BM + wc * 32 + 8 * fq;
        const float* bp = bd + (size_t)e * 1024 + col0;
        f32x4 bv[2][2];
#pragma unroll
        for (int bj = 0; bj < 2; ++bj)
#pragma unroll
            for (int n = 0; n < 2; ++n) bv[bj][n] = *(const PG8_GAS f32x4*)(bp + bj * HALF + 4 * n);
#pragma unroll
        for (int ai = 0; ai < 2; ++ai)
#pragma unroll
            for (int m = 0; m < 4; ++m) { bf16_t* rowp = O + (size_t)(row0 + ai * HALF + m * 16) * 1024 + col0;
#pragma unroll
                for (int bj = 0; bj < 2; ++bj) { const f32x4 v0 = acc[ai][bj][m][0] + bv[bj][0], v1 = acc[ai][bj][m][1] + bv[bj][1];
                    u32x4 w; w.x = cvt_pk_bf16(v0[0], v0[1]); w.y = cvt_pk_bf16(v0[2], v0[3]); w.z = cvt_pk_bf16(v1[0], v1[1]); w.w = cvt_pk_bf16(v1[2], v1[3]);
                    *(PG8_GAS u32x4*)(rowp + bj * HALF) = w; } }
    }
};
struct EpiDown64 {
    static constexpr bool PERM = true, AFTER_DRAIN = false, B64 = true;
    bf16_t* O; const float* bd;
    __device__ __forceinline__ void operator()(const f32x4 (&acc)[2][2][4][2], const Unit& u, int wr, int wc, int fr, int fq) const {
        const int e = u.pn >> 2, pnl = u.pn & 3;
        const int row0 = u.pm * BM + wr * 64 + fr, col0 = pnl * BM + wc * 64 + 8 * fq;
        const float* bp = bd + (size_t)e * 1024 + col0;
        f32x4 bv[2][2];
#pragma unroll
        for (int bj = 0; bj < 2; ++bj)
#pragma unroll
            for (int n = 0; n < 2; ++n) bv[bj][n] = *(const PG8_GAS f32x4*)(bp + bj * 32 + 4 * n);
#pragma unroll
        for (int ai = 0; ai < 2; ++ai)
#pragma unroll
            for (int m = 0; m < 4; ++m) { bf16_t* rowp = O + (size_t)(row0 + ai * HALF + m * 16) * 1024 + col0;
#pragma unroll
                for (int bj = 0; bj < 2; ++bj) { const f32x4 v0 = acc[ai][bj][m][0] + bv[bj][0], v1 = acc[ai][bj][m][1] + bv[bj][1];
                    u32x4 w; w.x = cvt_pk_bf16(v0[0], v0[1]); w.y = cvt_pk_bf16(v0[2], v0[3]); w.z = cvt_pk_bf16(v1[0], v1[1]); w.w = cvt_pk_bf16(v1[2], v1[3]);
                    *(PG8_GAS u32x4*)(rowp + bj * 32) = w; } }
    }
};
struct EpiBf16Plain64 {
    static constexpr bool PERM = true, AFTER_DRAIN = false, B64 = true;
    bf16_t* O; int ldc;
    __device__ __forceinline__ void operator()(const f32x4 (&acc)[2][2][4][2], const Unit& u, int wr, int wc, int fr, int fq) const {
        const int row0 = u.pm * BM + wr * 64 + fr, col0 = u.pn * BM + wc * 64 + 8 * fq;
#pragma unroll
        for (int ai = 0; ai < 2; ++ai)
#pragma unroll
            for (int m = 0; m < 4; ++m) { bf16_t* rowp = O + (size_t)(row0 + ai * HALF + m * 16) * ldc + col0;
#pragma unroll
                for (int bj = 0; bj < 2; ++bj) { const f32x4 v0 = acc[ai][bj][m][0], v1 = acc[ai][bj][m][1];
                    u32x4 w; w.x = cvt_pk_bf16(v0[0], v0[1]); w.y = cvt_pk_bf16(v0[2], v0[3]); w.z = cvt_pk_bf16(v1[0], v1[1]); w.w = cvt_pk_bf16(v1[2], v1[3]);
                    *(PG8_GAS u32x4*)(rowp + bj * 32) = w; } }
    }
};
template <int NPN, bool GATHER_ = false> struct MoeOrder {
    static constexpr bool GATHER = GATHER_;
    int ntiles, G, c; const PG8_LAS int* texp; const PG8_LAS int* rowtab = nullptr;
    __device__ __forceinline__ bool next(int i, Unit& u) const {
        constexpr int MT = 32 / NPN; int mt, pn;
        if (G == 256) { const int chunk = i * 8 + (c & 7), r = c >> 3; pn = r / MT; mt = chunk * MT + (r % MT); }
        else { const int L = i * G + c; mt = L / NPN; pn = L % NPN; }
        mt = __builtin_amdgcn_readfirstlane(mt); if (mt >= ntiles) return false;
        const int e = __builtin_amdgcn_readfirstlane(texp[mt]);
        u.pm = mt; u.pn = e * NPN + pn; return true;
    }
    __device__ __forceinline__ void a_ready(const Unit&) const {}
    __device__ __forceinline__ void done(const Unit&) const {}
};

template <class Epi, class Sched, bool ALIGN_EPI = false, bool SP2 = false>
__device__ __forceinline__ void gemm_phase(PG8_LAS unsigned char* lds, const Gemm g, const Sched& S, const Epi& E) {
    int tid_ = threadIdx.x; asm volatile("" : "+v"(tid_));
    const int tid = tid_, wid = __builtin_amdgcn_readfirstlane(tid >> 6), lane = tid & 63, wr = wid >> 2, wc = wid & 3, fr = lane & 15, fq = lane >> 4;
    const int K = g.K, nt = K / BK;
    constexpr bool GA = Sched::GATHER;
    static_assert(!GA || SP2, "gathered A rows: SP2 loop only");
    unsigned voffA[2], voffB[2]; int RA[2], CA2[2];
#pragma unroll
    for (int i = 0; i < 2; ++i) { int R, C; stage_rc(tid * 16 + i * 8192, R, C); RA[i] = R; CA2[i] = C * 2; const int Rb = Epi::B64 ? ((R >> 5) * 64 + perm32(R & 31)) : (Epi::PERM ? ((R & ~31) + perm32(R & 31)) : R);
        voffA[i] = (unsigned)(R * K + C) * 2u; voffB[i] = (unsigned)(Rb * K + C) * 2u; }
    const size_t kstep = (size_t)(BK * 2);
    const size_t hstep = (size_t)HALF * K * 2;
    const size_t tstep = 2 * hstep;
    const size_t hstepB = Epi::B64 ? (size_t)32 * K * 2 : hstep;
    const unsigned ldsw = (unsigned)wid * 1024u;
    const int aoff = lds_byte(wr * 64 + fr, fq * 8), boff = lds_byte(wc * 32 + fr, fq * 8);
#define PG8_SA(b, h) (((b) * 2 + (h)) * HTB)
#define PG8_SB(b, h) ((4 + (b) * 2 + (h)) * HTB)
#define PG8_STAGE(bufoff, gbase, voff) do { _Pragma("unroll") for (int _i = 0; _i < 2; ++_i) \
        __builtin_amdgcn_global_load_lds((const unsigned*)((const char*)(gbase) + (voff)[_i]), (PG8_LAS unsigned*)(lds + (bufoff) + ldsw + _i * 8192), 16, 0, 0); } while (0)
#define PG8_STAGE_A(bufoff, ptr, h, V) do { if constexpr (GA) PG8_STAGE(bufoff, ptr, V[h]); else PG8_STAGE(bufoff, (ptr) + (h) * hstep, voffA); } while (0)
#define PG8_ROWOFF(V, uidx) do { _Pragma("unroll") for (int h_ = 0; h_ < 2; ++h_) _Pragma("unroll") for (int i_ = 0; i_ < 2; ++i_) V[h_][i_] = (unsigned)S.rowtab[(uidx) * 256 + h_ * 128 + RA[i_]] * (unsigned)(K * 2) + (unsigned)CA2[i_]; } while (0)
#define PG8_LDA(dst, b, h) do { _Pragma("unroll") for (int m = 0; m < 4; ++m) _Pragma("unroll") for (int k = 0; k < 2; ++k) dst[m][k] = *(const PG8_LAS bf16x8*)(lds + PG8_SA(b, h) + aoff + m * 2048 + k * 1024); } while (0)
#define PG8_LDB(dst, b, h) do { _Pragma("unroll") for (int n = 0; n < 2; ++n) _Pragma("unroll") for (int k = 0; k < 2; ++k) dst[n][k] = *(const PG8_LAS bf16x8*)(lds + PG8_SB(b, h) + boff + n * 2048 + k * 1024); } while (0)
#define PG8_MMA(ai, bj, At, Bt) do { __builtin_amdgcn_s_setprio(1); _Pragma("unroll") for (int m = 0; m < 4; ++m) _Pragma("unroll") for (int n = 0; n < 2; ++n) _Pragma("unroll") for (int k = 0; k < 2; ++k) \
        acc[ai][bj][m][n] = __builtin_amdgcn_mfma_f32_16x16x32_bf16(Bt[n][k], At[m][k], acc[ai][bj][m][n], 0, 0, 0); __builtin_amdgcn_s_setprio(0); } while (0)
#define PG8_WAIT_V(n) asm volatile("s_waitcnt vmcnt(" #n ")" ::: "memory")
#define PG8_WAIT_L(n) asm volatile("s_waitcnt lgkmcnt(" #n ")" ::: "memory")
#define PG8_BAR __builtin_amdgcn_s_barrier()
#define PG8_SCHED __builtin_amdgcn_sched_barrier(0)
    Unit cur, nxt; int ui = 0;
    if (!S.next(0, cur)) return;
    f32x4 acc[2][2][4][2];
#pragma unroll
    for (int a = 0; a < 2; ++a)
#pragma unroll
        for (int b = 0; b < 2; ++b)
#pragma unroll
            for (int m = 0; m < 4; ++m)
#pragma unroll
                for (int n = 0; n < 2; ++n) acc[a][b][m][n] = (f32x4){0.f, 0.f, 0.f, 0.f};
    bf16x8 At[4][2], B0[2][2], B1[2][2];
    const char* cA = (const char*)g.A + (GA ? (size_t)0 : (size_t)cur.pm * tstep); const char* cB = (const char*)g.Bt + (size_t)cur.pn * tstep;
    unsigned vAc[2][2] = {{0u, 0u}, {0u, 0u}}, vAn[2][2] = {{0u, 0u}, {0u, 0u}};
    if constexpr (GA) { PG8_ROWOFF(vAc, 0); }
    S.a_ready(cur);
    if constexpr (SP2) {
        PG8_STAGE(PG8_SB(0, 0), cB, voffB); PG8_STAGE(PG8_SB(0, 1), cB + hstepB, voffB); PG8_STAGE_A(PG8_SA(0, 0), cA, 0, vAc); PG8_STAGE_A(PG8_SA(0, 1), cA, 1, vAc);
        if (wr == 1) PG8_BAR;
        PG8_WAIT_V(2); PG8_BAR;
        PG8_STAGE(PG8_SB(1, 0), cB + kstep, voffB); PG8_STAGE_A(PG8_SA(1, 0), cA + kstep, 0, vAc); PG8_STAGE(PG8_SB(1, 1), cB + hstepB + kstep, voffB);
        PG8_WAIT_V(6); PG8_BAR;
    } else {
        PG8_STAGE(PG8_SB(0, 0), cB, voffB); PG8_STAGE(PG8_SA(0, 0), cA, voffA); PG8_STAGE(PG8_SB(0, 1), cB + hstepB, voffB); PG8_STAGE(PG8_SA(0, 1), cA + hstep, voffA);
        if (wr == 1) PG8_BAR;
        PG8_WAIT_V(4); PG8_BAR;
        PG8_STAGE(PG8_SB(1, 0), cB + kstep, voffB); PG8_STAGE(PG8_SA(1, 0), cA + kstep, voffA); PG8_STAGE(PG8_SB(1, 1), cB + hstepB + kstep, voffB);
        PG8_WAIT_V(6); PG8_BAR;
    }
    for (;;) {
        const bool has_next = S.next(ui + 1, nxt);
        const char* nA = (has_next && !GA) ? (const char*)g.A + (size_t)nxt.pm * tstep : cA; const char* nB = has_next ? (const char*)g.Bt + (size_t)nxt.pn * tstep : cB;
        for (int t = 0; t < nt; t += 2) {
            const bool last = (t == nt - 2);
            const char* a1 = cA + (size_t)(t + 1) * kstep;
            const char* a2 = last ? nA : cA + (size_t)(t + 2) * kstep; const char* b2 = last ? nB : cB + (size_t)(t + 2) * kstep;
            const char* a3 = a2 + kstep; const char* b3 = b2 + kstep;
            if (last && has_next) S.a_ready(nxt);
            unsigned v2[2][2] = {{0u, 0u}, {0u, 0u}};
            if constexpr (GA) { if (last) { if (has_next) { PG8_ROWOFF(vAn, ui + 1); } else {
#pragma unroll
                        for (int h_ = 0; h_ < 2; ++h_) { vAn[h_][0] = vAc[h_][0]; vAn[h_][1] = vAc[h_][1]; } } }
#pragma unroll
                for (int h_ = 0; h_ < 2; ++h_) { v2[h_][0] = last ? vAn[h_][0] : vAc[h_][0]; v2[h_][1] = last ? vAn[h_][1] : vAc[h_][1]; } }
            if constexpr (SP2) {
            PG8_LDB(B0, 0, 0); PG8_LDB(B1, 0, 1); PG8_SCHED; PG8_LDA(At, 0, 0); PG8_STAGE_A(PG8_SA(1, 1), a1, 1, vAc);
            PG8_WAIT_V(8); PG8_WAIT_L(0); PG8_BAR; PG8_MMA(0, 0, At, B0); PG8_MMA(0, 1, At, B1); PG8_BAR; PG8_SCHED;
            PG8_LDA(At, 0, 1); PG8_STAGE(PG8_SB(0, 0), b2, voffB); PG8_STAGE(PG8_SB(0, 1), b2 + hstepB, voffB); PG8_STAGE_A(PG8_SA(0, 0), a2, 0, v2);
            PG8_WAIT_V(8); PG8_WAIT_L(0); PG8_BAR; PG8_MMA(1, 0, At, B0); PG8_MMA(1, 1, At, B1); PG8_BAR; PG8_SCHED;
            PG8_LDB(B0, 1, 0); PG8_LDB(B1, 1, 1); PG8_SCHED; PG8_LDA(At, 1, 0); PG8_STAGE_A(PG8_SA(0, 1), a2, 1, v2);
            PG8_WAIT_V(8); PG8_WAIT_L(0); PG8_BAR; PG8_MMA(0, 0, At, B0); PG8_MMA(0, 1, At, B1); PG8_BAR; PG8_SCHED;
            PG8_LDA(At, 1, 1); PG8_STAGE(PG8_SB(1, 0), b3, voffB); PG8_STAGE(PG8_SB(1, 1), b3 + hstepB, voffB); PG8_STAGE_A(PG8_SA(1, 0), a3, 0, v2);
            PG8_WAIT_V(8); PG8_WAIT_L(0); PG8_BAR; PG8_MMA(1, 0, At, B0); PG8_MMA(1, 1, At, B1); PG8_BAR; PG8_SCHED;
            } else {
            PG8_LDB(B0, 0, 0); PG8_SCHED; PG8_LDA(At, 0, 0); PG8_STAGE(PG8_SA(1, 1), a1 + hstep, voffA);
            PG8_WAIT_L(8); PG8_BAR; PG8_WAIT_L(0); PG8_MMA(0, 0, At, B0); PG8_BAR; PG8_SCHED;
            PG8_LDB(B1, 0, 1); PG8_STAGE(PG8_SB(0, 0), b2, voffB);
            PG8_BAR; PG8_WAIT_L(0); PG8_MMA(0, 1, At, B1); PG8_BAR;
            PG8_LDA(At, 0, 1); PG8_STAGE(PG8_SA(0, 0), a2, voffA);
            PG8_BAR; PG8_WAIT_L(0); PG8_MMA(1, 0, At, B0); PG8_BAR; PG8_SCHED;
            PG8_STAGE(PG8_SB(0, 1), b2 + hstepB, voffB);
            PG8_WAIT_V(6); PG8_BAR; PG8_MMA(1, 1, At, B1); PG8_BAR;
            PG8_LDB(B0, 1, 0); PG8_SCHED; PG8_LDA(At, 1, 0); PG8_STAGE(PG8_SA(0, 1), a2 + hstep, voffA);
            PG8_WAIT_L(8); PG8_BAR; PG8_WAIT_L(0); PG8_MMA(0, 0, At, B0); PG8_BAR; PG8_SCHED;
            PG8_LDB(B1, 1, 1); PG8_STAGE(PG8_SB(1, 0), b3, voffB);
            PG8_BAR; PG8_WAIT_L(0); PG8_MMA(0, 1, At, B1); PG8_BAR;
            PG8_LDA(At, 1, 1); PG8_STAGE(PG8_SA(1, 0), a3, voffA);
            PG8_BAR; PG8_WAIT_L(0); PG8_MMA(1, 0, At, B0); PG8_BAR; PG8_SCHED;
            PG8_STAGE(PG8_SB(1, 1), b3 + hstepB, voffB);
            PG8_WAIT_V(6); PG8_BAR; PG8_MMA(1, 1, At, B1); PG8_BAR;
            }
        }
        if constexpr (ALIGN_EPI) { if (wr == 0) PG8_BAR; }
        if constexpr (!Epi::AFTER_DRAIN) { E(acc, cur, wr, wc, fr, fq); S.done(cur); }
        if (!has_next) break;
#pragma unroll
        for (int a = 0; a < 2; ++a)
#pragma unroll
            for (int b = 0; b < 2; ++b)
#pragma unroll
                for (int m = 0; m < 4; ++m)
#pragma unroll
                    for (int n = 0; n < 2; ++n) acc[a][b][m][n] = (f32x4){0.f, 0.f, 0.f, 0.f};
        cur = nxt; cA = nA; cB = nB; ++ui;
        if constexpr (GA) {
#pragma unroll
            for (int h_ = 0; h_ < 2; ++h_) { vAc[h_][0] = vAn[h_][0]; vAc[h_][1] = vAn[h_][1]; } }
        if constexpr (ALIGN_EPI) { if (wr == 1) PG8_BAR; }
    }
    PG8_WAIT_V(0);
    if constexpr (!ALIGN_EPI) { if (wr == 0) PG8_BAR; }
    PG8_BAR;
    if constexpr (Epi::AFTER_DRAIN) { E.fused(acc, cur, wr, wc, fr, fq, lds, wid, lane); S.done(cur); }
#undef PG8_SA
#undef PG8_SB
#undef PG8_STAGE
#undef PG8_STAGE_A
#undef PG8_ROWOFF
#undef PG8_LDA
#undef PG8_LDB
#undef PG8_MMA
#undef PG8_WAIT_V
#undef PG8_WAIT_L
#undef PG8_BAR
#undef PG8_SCHED
}
}


#define GAS __attribute__((address_space(1)))
typedef unsigned short bf16;
typedef float f32x4 __attribute__((ext_vector_type(4)));
typedef unsigned u32x4 __attribute__((ext_vector_type(4)));
typedef unsigned u32x2 __attribute__((ext_vector_type(2)));
typedef short bf16x8 __attribute__((ext_vector_type(8)));
typedef float f32x16 __attribute__((ext_vector_type(16)));

#ifndef SINGLE_LAUNCH
#define SINGLE_LAUNCH 1
#endif

constexpr int NB = 8, SEQ = 2048, DM = 1024, NT = NB * SEQ, NLAYER = 2;
constexpr int DIN = 3220, NP = 3328;
constexpr int C_Q = 0, C_K = 512, C_V = 1024, C_Z = 1536, C_NQ = 2048, C_KV = 2304, C_CU = 2688, C_A = 3200, C_B = 3204, C_G = 3208;
constexpr int NE = 32, MAXT = 288;
constexpr int NWAVES = 8, NTHR = 512;
constexpr float EPS = 1e-6f;

constexpr size_t MiB = 1u << 20;
constexpr size_t WS_CTL = 0, CTL_ZERO_BYTES = 4096;
constexpr size_t WS_BT = 1 * MiB;
constexpr size_t WS_KCMP = 1 * MiB + 256 * 1024, WS_VCMP = 1 * MiB + 512 * 1024;
constexpr size_t WS_G = 2 * MiB, WS_BETA = 2 * MiB + 256 * 1024, WS_GC = 2 * MiB + 512 * 1024;
constexpr size_t WS_EIDX = 3 * MiB, WS_EPOS = 3 * MiB + 256 * 1024, WS_EW = 3 * MiB + 512 * 1024, WS_SLOT = 3 * MiB + 768 * 1024;
constexpr size_t WS_WIN = 4 * MiB;
constexpr size_t WS_WOUT = 17 * MiB;
constexpr size_t WS_WGU = 22 * MiB;
constexpr size_t WS_WD = 278 * MiB;
constexpr size_t WS_XA = 406 * MiB, WS_XB = 470 * MiB;
constexpr size_t WS_XN = 534 * MiB;
constexpr size_t WS_P = 566 * MiB;
constexpr size_t WS_QN = 670 * MiB, WS_KN = 686 * MiB, WS_VC = 702 * MiB;
constexpr size_t WS_U = 718 * MiB, WS_W = 750 * MiB;
constexpr size_t WS_ATT = 782 * MiB;
constexpr size_t WS_O = 798 * MiB;
constexpr size_t WS_NQ = 830 * MiB;
constexpr size_t WS_KS = 846 * MiB, WS_KW = 848 * MiB;
constexpr size_t WS_Y = 850 * MiB;
constexpr size_t WS_XS = 882 * MiB, WS_ACT = 1026 * MiB, WS_YS = 1170 * MiB;
constexpr size_t WS_KT = 1314 * MiB, WS_VT = 1330 * MiB;
constexpr size_t WS_W1T = 1346 * MiB;
constexpr size_t WS_POSW = 1349 * MiB;
constexpr size_t WS_RWH = 1350 * MiB, WS_RWL = 1351 * MiB;
constexpr size_t WS_END = 1352 * MiB;

constexpr int CW_TMO = 0, CW_BAR = 64, CW_CNT = 512;

constexpr int RING_BYTES = 131072;
constexpr int LDSCTL_OFF = RING_BYTES, MISC_OFF = LDSCTL_OFF, TS_OFF = LDSCTL_OFF + 128, TE_OFF = LDSCTL_OFF + 320;
constexpr int LDS_BYTES = 147456;
static_assert(TE_OFF + MAXT * 4 + 64 <= LDSCTL_OFF + 2048 && LDSCTL_OFF + 2048 + 10 * 1024 <= LDS_BYTES, "LDS map");

#define XB_TMO      128
#define XB_XCNT(j)  (256  + 64 * (j))
#define XB_XSUB(j)  (1280 + 64 * (j))
#define XB_XGEN(j)  (2304 + 64 * (j))
#define XB_TOP      3328
#define XB_TOPGEN   3392
#define XCD_BAR_WORDS 3456
#define XB_SPIN_CAP (1u << 22)
#define LAS __attribute__((address_space(3)))

__device__ __forceinline__ unsigned xb_ld(unsigned* p)              { return __hip_atomic_load(p, __ATOMIC_RELAXED, __HIP_MEMORY_SCOPE_AGENT); }
__device__ __forceinline__ unsigned xb_add(unsigned* p, unsigned v) { return __hip_atomic_fetch_add(p, v, __ATOMIC_RELAXED, __HIP_MEMORY_SCOPE_AGENT); }
__device__ __forceinline__ unsigned xb_xcc_id() { return (unsigned)__builtin_amdgcn_s_getreg((3 << 11) | 20) & 0xFu; }
#define XB_SPIN(cond, bar) do { unsigned _sp = 0; while (cond) { __builtin_amdgcn_s_sleep(1); \
    if ((++_sp & 255u) == 0u) { if (xb_ld(&(bar)[XB_TMO])) break; if (_sp > XB_SPIN_CAP) { atomicAdd(&(bar)[XB_TMO], 1u); break; } } } } while (0)

struct XcdBarrier {
    unsigned* bar; unsigned x;
    volatile LAS unsigned* st;
};

__device__ __forceinline__ XcdBarrier xcd_barrier_post(unsigned* bar, volatile LAS unsigned* st) {
    XcdBarrier b; b.bar = bar; b.x = xb_xcc_id(); b.st = st;
    if (threadIdx.x == 0) (void)xb_add(&bar[XB_XCNT(b.x)], 1u);
    return b;
}
__device__ __forceinline__ void xcd_barrier_complete(unsigned* bar, unsigned x, unsigned& nloc, unsigned& nx) {
    const unsigned G = gridDim.x * gridDim.y * gridDim.z;
    unsigned sum, cnt, mine, sp = 0u;
    for (;;) {
        sum = 0u; cnt = 0u; mine = 0u;
#pragma unroll
        for (unsigned j = 0; j < 16; ++j) { const unsigned c = xb_ld(&bar[XB_XCNT(j)]); sum += c; cnt += (c > 0u) ? 1u : 0u; mine = (j == x) ? c : mine; }
        if (sum == G) break;
        __builtin_amdgcn_s_sleep(1);
        if ((++sp & 255u) == 0u) { if (xb_ld(&bar[XB_TMO])) break; if (sp > XB_SPIN_CAP) { atomicAdd(&bar[XB_TMO], 1u); break; } }
    }
    nloc = mine > 0u ? mine : 1u; nx = cnt > 0u ? cnt : 1u;
}

__device__ __forceinline__ void xcd_barrier(const XcdBarrier& b) {
    asm volatile("s_waitcnt vmcnt(0)" ::: "memory");
    __syncthreads();
    if (threadIdx.x == 0) {
        unsigned* bar = b.bar;
        __builtin_amdgcn_s_waitcnt(0);
        unsigned nloc = b.st[0], nx = b.st[1];
        if (nloc == 0u) { xcd_barrier_complete(bar, b.x, nloc, nx); b.st[0] = nloc; b.st[1] = nx; }
        const unsigned old = xb_add(&bar[XB_XSUB(b.x)], 1u);
        const unsigned gen = old / nloc;
        if (old + 1u == (gen + 1u) * nloc) {
            __builtin_amdgcn_fence(__ATOMIC_RELEASE, "agent");
            asm volatile("s_waitcnt vmcnt(0)" ::: "memory");
            const unsigned og = xb_add(&bar[XB_TOP], 1u);
            const unsigned tg = og / nx;
            if (og + 1u == (tg + 1u) * nx) xb_add(&bar[XB_TOPGEN], 1u);
            else XB_SPIN(xb_ld(&bar[XB_TOPGEN]) == tg, bar);
            __builtin_amdgcn_fence(__ATOMIC_ACQUIRE, "agent");
            xb_add(&bar[XB_XGEN(b.x)], 1u);
            asm volatile("s_waitcnt vmcnt(0)" ::: "memory");
        } else {
            XB_SPIN(xb_ld(&bar[XB_XGEN(b.x)]) == gen, bar);
            __builtin_amdgcn_fence(__ATOMIC_ACQUIRE, "agent");
            asm volatile("s_waitcnt vmcnt(0)" ::: "memory");
        }
    }
    __syncthreads();
}


__device__ __forceinline__ void cnt_barrier(unsigned* cw, unsigned& k) {
    asm volatile("s_waitcnt vmcnt(0)" ::: "memory");
    __syncthreads();
    if (threadIdx.x == 0) {
        __builtin_amdgcn_fence(__ATOMIC_RELEASE, "agent");
        asm volatile("s_waitcnt vmcnt(0)" ::: "memory");
        const unsigned G = gridDim.x;
        const unsigned old = xb_add(cw, 1u);
        if (old == G * (k + 1u) - 1u) xb_add(cw + 64, 1u);
        else { unsigned sp = 0; while (xb_ld(cw + 64) == k) { __builtin_amdgcn_s_sleep(1);
                if ((++sp & 255u) == 0u) { if (xb_ld(cw + 128)) break; if (sp > XB_SPIN_CAP) { atomicAdd(cw + 128, 1u); break; } } } }
        __builtin_amdgcn_fence(__ATOMIC_ACQUIRE, "agent");
        asm volatile("s_waitcnt vmcnt(0)" ::: "memory");
    }
    ++k;
    __syncthreads();
}
__device__ __forceinline__ float bf_lo(unsigned w) { return __uint_as_float(w << 16); }
__device__ __forceinline__ float bf_hi(unsigned w) { return __uint_as_float(w & 0xffff0000u); }
__device__ __forceinline__ float bf2f(bf16 v) { return __uint_as_float(((unsigned)v) << 16); }
__device__ __forceinline__ unsigned f2bf(float f) { unsigned u = __float_as_uint(f); return (u + 0x7fffu + ((u >> 16) & 1u)) >> 16; }
__device__ __forceinline__ unsigned pk2(float lo, float hi) { unsigned r; asm("v_cvt_pk_bf16_f32 %0, %1, %2" : "=v"(r) : "v"(lo), "v"(hi)); return r; }
__device__ __forceinline__ float wave_sum(float v) {
#pragma unroll
    for (int o = 1; o < 64; o <<= 1) v += __shfl_xor(v, o);
    return v;
}
__device__ __forceinline__ float wave_max(float v) {
#pragma unroll
    for (int o = 1; o < 64; o <<= 1) v = fmaxf(v, __shfl_xor(v, o));
    return v;
}
__device__ __forceinline__ float sigmoidf_(float x) { return 1.0f / (1.0f + __expf(-x)); }
__device__ __forceinline__ float siluf_(float x) { return x / (1.0f + __expf(-x)); }
#define LDS_WAIT() asm volatile("s_waitcnt lgkmcnt(0)" ::: "memory")

struct Args { const float* in[25]; float* out; unsigned char* ws; int ph_lo, ph_hi; };
struct ArgsG { const GAS float* in[25]; GAS float* out; GAS unsigned char* ws;
    __device__ __forceinline__ const float* I(int i) const { return (const float*)in[i]; }
    __device__ __forceinline__ unsigned char* W() const { return (unsigned char*)ws; }
    __device__ __forceinline__ float* O() const { return (float*)out; } };

__device__ __forceinline__ int map_win(int n);
__device__ __forceinline__ int map_gu(int n);
template <int MAP>
__device__ __forceinline__ void transpose_item(const float* W, int K, int N, bf16* WT, LAS float* scr, int item, int nblk, int lane) {
    const int kb = item / nblk, nb = item % nblk, k0 = 64 * kb, n0 = 32 * nb;
    const int nd = n0 + (lane & 31); const int src = MAP == 1 ? map_win(nd) : (MAP == 2 ? map_gu(nd) : nd);
#pragma unroll 8
    for (int i = 0; i < 32; ++i) { const int kk = 2 * i + (lane >> 5); scr[kk * 33 + (lane & 31)] = src >= 0 ? W[(size_t)(k0 + kk) * N + src] : 0.0f; }
    LDS_WAIT();
    const int c = lane & 7;
#pragma unroll
    for (int j = 0; j < 4; ++j) { const int n = (lane >> 3) + 8 * j; const LAS float* s = scr + (8 * c) * 33 + n;
        u32x4 o; o.x = pk2(s[0 * 33], s[1 * 33]); o.y = pk2(s[2 * 33], s[3 * 33]); o.z = pk2(s[4 * 33], s[5 * 33]); o.w = pk2(s[6 * 33], s[7 * 33]);
        *(u32x4*)(WT + (size_t)(n0 + n) * K + k0 + 8 * c) = o; }
    LDS_WAIT();
}
__device__ __forceinline__ int map_win(int n) {
    if (n < 2048) return n;
    if (n < C_KV) return 2056 + (n - C_NQ);
    if (n < C_CU) return 2312 + (n - C_KV);
    if (n < C_A) return 2708 + (n - C_CU);
    if (n < C_B) return 2048 + (n - C_A);
    if (n < C_G) return 2052 + (n - C_B);
    if (n < C_G + 12) return 2696 + (n - C_G);
    return -1;
}
__device__ __forceinline__ int map_gu(int n) { const int pn = n >> 8, r = n & 255; return (r < 128 ? 0 : 1024) + 128 * pn + (r & 127); }

__device__ __forceinline__ void ph_prologue(const ArgsG& a, LAS unsigned char* lds, int gw, int NGW, int wave, int lane) {
    LAS float* scr = (LAS float*)(lds + wave * 16384);
    bf16* WinT = (bf16*)(a.W() + WS_WIN); bf16* WoutT = (bf16*)(a.W() + WS_WOUT); bf16* WguT = (bf16*)(a.W() + WS_WGU); bf16* WdT = (bf16*)(a.W() + WS_WD);
    constexpr int I_IN = 16 * (NP / 32), I_OUT = 16 * 32, I_GU = 16 * 64, I_D = 16 * 32;
    constexpr int N_IN = NLAYER * I_IN, N_OUT = NLAYER * I_OUT, N_GU = NLAYER * NE * I_GU, N_D = NLAYER * NE * I_D;
    for (int it = gw; it < N_IN + N_OUT + N_GU + N_D; it += NGW) {
        int r = it;
        if (r < N_IN) { const int l = r / I_IN; transpose_item<1>(a.I(2) + (size_t)l * DM * DIN, DM, DIN, WinT + (size_t)l * NP * DM, scr, r % I_IN, NP / 32, lane); continue; } r -= N_IN;
        if (r < N_OUT) { const int l = r / I_OUT; transpose_item<0>(a.I(16) + (size_t)l * DM * DM, DM, DM, WoutT + (size_t)l * DM * DM, scr, r % I_OUT, 32, lane); continue; } r -= N_OUT;
        if (r < N_GU) { const int le = r / I_GU; transpose_item<2>(a.I(20) + (size_t)le * DM * 2048, DM, 2048, WguT + (size_t)le * 2048 * DM, scr, r % I_GU, 64, lane); continue; } r -= N_GU;
        { const int le = r / I_D; transpose_item<0>(a.I(22) + (size_t)le * DM * DM, DM, DM, WdT + (size_t)le * DM * DM, scr, r % I_D, 32, lane); }
    }
    { bf16* W1T = (bf16*)(a.W() + WS_W1T);
        for (int it = gw; it < 4 * 128; it += NGW) { const int mtx = it >> 7; transpose_item<0>(a.I(10) + (size_t)mtx * 2048 * 128, 2048, 128, W1T + (size_t)mtx * 128 * 2048, scr, it & 127, 4, lane); }
        float* POSW = (float*)(a.W() + WS_POSW);
        const int id = gw * 64 + lane;
        if (id < 512) { const int mtx = id >> 7, n = id & 127; const float* w1 = a.I(10) + (size_t)mtx * 2048 * 128; const float* pos = a.I(9) + (size_t)mtx * 2048; float acc = 0.f;
            for (int k = 0; k < 2048; ++k) acc += pos[k] * w1[(size_t)k * 128 + n];
            POSW[id] = acc; } }
    { bf16* RWH = (bf16*)(a.W() + WS_RWH); bf16* RWL = (bf16*)(a.W() + WS_RWL);
        for (int i = gw * 64 + lane; i < NLAYER * NE * DM; i += NGW * 64) { const int d = i & (DM - 1), e = (i >> 10) & (NE - 1), l = i >> 15;
            const float w = a.I(18)[((size_t)l * DM + d) * NE + e]; const unsigned hi = f2bf(w); const float lo = w - __uint_as_float(hi << 16);
            RWH[i] = (bf16)hi; RWL[i] = (bf16)f2bf(lo); } }
    float* BT = (float*)(a.W() + WS_BT);
    for (int i = gw * 64 + lane; i < 4 * 2048; i += NGW * 64) {
        const int h = i >> 11, n = i & 2047; int bk;
        if (n < 16) bk = n; else { const float v = logf((float)n / 16.0f) / 2.0794415416798357f * 16.0f; bk = 16 + (int)v; bk = bk < 31 ? bk : 31; }
        BT[i] = a.I(24)[bk * 4 + h];
    }
}

__device__ __forceinline__ void rms_row_to_bf16(const f32x4 (&v)[4], const float* w, bf16* orow, int lane) {
    float s = 0.f;
#pragma unroll
    for (int j = 0; j < 4; ++j) s += (v[j].x * v[j].x + v[j].y * v[j].y) + (v[j].z * v[j].z + v[j].w * v[j].w);
    const float r = rsqrtf(wave_sum(s) * (1.0f / DM) + EPS);
#pragma unroll
    for (int j = 0; j < 4; ++j) { const f32x4 wv = *(const f32x4*)(w + 4 * (64 * j + lane)); const f32x4 y = v[j] * r * wv;
        u32x2 o; o.x = pk2(y.x, y.y); o.y = pk2(y.z, y.w); *(u32x2*)(orow + 4 * (64 * j + lane)) = o; }
}

__device__ __forceinline__ void ph_norm0(const ArgsG& a, int gw, int NGW, int lane) {
    bf16* XN = (bf16*)(a.W() + WS_XN);
    for (int tok = gw; tok < NT; tok += NGW) {
        f32x4 v[4];
#pragma unroll
        for (int j = 0; j < 4; ++j) v[j] = *(const f32x4*)(a.I(0) + (size_t)tok * DM + 4 * (64 * j + lane));
        rms_row_to_bf16(v, a.I(1), XN + (size_t)tok * DM, lane);
    }
}

__device__ __forceinline__ void ph_compress_mfma(const ArgsG& a, int l, LAS unsigned char* lds, int bid, int G, int tid, int wave, int lane) {
    LAS float* part = (LAS float*)lds;
    LAS float* hid = (LAS float*)(lds + 8 * 16 * 132 * 4);
    const bf16* P = (const bf16*)(a.W() + WS_P); bf16* KCMP = (bf16*)(a.W() + WS_KCMP); bf16* VCMP = (bf16*)(a.W() + WS_VCMP);
    const int r = lane & 15, q = lane >> 4;
    for (int u = bid; u < 128; u += G) {
        const int b = u >> 4, kv = (u >> 3) & 1, j0 = 16 * (u & 7);
        const bf16* arow = P + (size_t)(b * SEQ) * NP + C_KV + kv * 64;
        const bf16* brow = (const bf16*)(a.W() + WS_W1T) + ((size_t)(l * 2 + kv) * 128 + r) * 2048 + 8 * q;
        f32x4 acc[8];
#pragma unroll
        for (int nb = 0; nb < 8; ++nb) acc[nb] = (f32x4){0.f, 0.f, 0.f, 0.f};
#pragma unroll
        for (int s8 = 0; s8 < 8; ++s8) { const int ks = 8 * wave + s8; int tk = 16 * (j0 + r) + (ks >> 1); tk = tk < SEQ ? tk : SEQ - 1;
            const bf16x8 af = *(const bf16x8*)(arow + (size_t)tk * NP + (ks & 1) * 32 + 8 * q);
#pragma unroll
            for (int nb = 0; nb < 8; ++nb) acc[nb] = __builtin_amdgcn_mfma_f32_16x16x32_bf16(af, *(const bf16x8*)(brow + (size_t)(16 * nb) * 2048 + 32 * ks), acc[nb], 0, 0, 0); }
#pragma unroll
        for (int nb = 0; nb < 8; ++nb)
#pragma unroll
            for (int i = 0; i < 4; ++i) part[(wave * 16 + 4 * q + i) * 132 + 16 * nb + r] = acc[nb][i];
        __syncthreads();
        { const float* POSW = (const float*)(a.W() + WS_POSW) + (l * 2 + kv) * 128;
            for (int e = tid; e < 16 * 128; e += NTHR) { const int row = e >> 7, n = e & 127; float sacc = POSW[n];
#pragma unroll
                for (int w = 0; w < 8; ++w) sacc += part[(w * 16 + row) * 132 + n];
                hid[row * 132 + n] = siluf_(sacc); } }
        __syncthreads();
        { const int row = tid >> 5, c2 = tid & 31; const float* w2 = a.I(11) + (size_t)(l * 2 + kv) * 128 * 64; float o0 = 0.f, o1 = 0.f;
            for (int nn = 0; nn < 128; ++nn) { const float hv = hid[row * 132 + nn]; o0 += hv * w2[nn * 64 + 2 * c2]; o1 += hv * w2[nn * 64 + 2 * c2 + 1]; }
            if (kv == 0) { float ss = o0 * o0 + o1 * o1;
#pragma unroll
                for (int o_ = 1; o_ < 32; o_ <<= 1) ss += __shfl_xor(ss, o_);
                const float sc = rsqrtf(ss * (1.0f / 64.0f) + EPS); o0 *= sc * a.I(8)[l * 192 + 2 * c2]; o1 *= sc * a.I(8)[l * 192 + 2 * c2 + 1]; }
            const int j = j0 + row;
            *(unsigned*)((kv ? VCMP : KCMP) + (size_t)(b * 128 + j) * 64 + 2 * c2) = (j < 127) ? pk2(o0, o1) : 0u; }
        __syncthreads();
    }
}

__device__ __forceinline__ void ph_m1(const ArgsG& a, int l, LAS unsigned char* lds, int bid, int G, int tid, int wave, int lane) {
    const bf16* P = (const bf16*)(a.W() + WS_P);
    bf16* QN = (bf16*)(a.W() + WS_QN); bf16* KN = (bf16*)(a.W() + WS_KN); bf16* VC = (bf16*)(a.W() + WS_VC);
    bf16* KT = (bf16*)(a.W() + WS_KT); bf16* VT = (bf16*)(a.W() + WS_VT);
    float* Gb = (float*)(a.W() + WS_G); float* BETA = (float*)(a.W() + WS_BETA);
    bf16* NQ = (bf16*)(a.W() + WS_NQ); bf16* KS = (bf16*)(a.W() + WS_KS); bf16* KW = (bf16*)(a.W() + WS_KW); bf16* Y = (bf16*)(a.W() + WS_Y);
    const float* convw = a.I(3) + (size_t)l * 4 * 1536; const float* a_log = a.I(4) + l * 4; const float* dt_bias = a.I(5) + l * 4;
    const float* qnw = a.I(7) + l * 64; const float* knw = a.I(8) + l * 192;
    const float* dww = a.I(12) + (size_t)l * 31 * 256; const float* dwb = a.I(13) + l * 256; const float* lnw = a.I(14) + l * 256; const float* lnb = a.I(15) + l * 256;
    LAS float* dwl = (LAS float*)(lds + 65536);
    for (int i = tid; i < 31 * 256; i += NTHR) dwl[i] = dww[i];
    __syncthreads();
    for (int u = bid; u < NT / 64; u += G) {
        const int b = u >> 5, nchunk = u & 31, tw = nchunk * 64 + 8 * wave;
        const bf16* pw0 = P + (size_t)(b * SEQ + tw) * NP;
        { unsigned cx[11], nx[11]; float cw0[4], cw1[4], nw0[4], nw1[4];
#define DN_LOAD(idx, X, W0, W1) do { const int cb_ = ((idx) >> 2) * 512 + ((idx) & 3) * 128 + 2 * lane; \
            _Pragma("unroll") for (int j = 0; j < 4; ++j) { W0[j] = convw[j * 1536 + cb_]; W1[j] = convw[j * 1536 + cb_ + 1]; } \
            _Pragma("unroll") for (int j = 0; j < 3; ++j) { X[j] = 0u; if (tw - 3 + j >= 0) X[j] = *(const unsigned*)(pw0 + (ptrdiff_t)(j - 3) * NP + cb_); } \
            _Pragma("unroll") for (int i = 0; i < 8; ++i) X[3 + i] = *(const unsigned*)(pw0 + (size_t)i * NP + cb_); } while (0)
            DN_LOAD(0, cx, cw0, cw1);
#pragma unroll 1
            for (int idx = 0; idx < 12; ++idx) { const int ten = idx >> 2, h = idx & 3;
                if (idx + 1 < 12) DN_LOAD(idx + 1, nx, nw0, nw1);
                float xa[3] = {bf_lo(cx[0]), bf_lo(cx[1]), bf_lo(cx[2])}, xb[3] = {bf_hi(cx[0]), bf_hi(cx[1]), bf_hi(cx[2])};
                float ya[8], yb[8], sq[8];
#pragma unroll
                for (int i = 0; i < 8; ++i) { const unsigned w = cx[3 + i]; const float ca = bf_lo(w), cbv = bf_hi(w);
                    ya[i] = siluf_(cw0[0] * xa[0] + cw0[1] * xa[1] + cw0[2] * xa[2] + cw0[3] * ca); yb[i] = siluf_(cw1[0] * xb[0] + cw1[1] * xb[1] + cw1[2] * xb[2] + cw1[3] * cbv);
                    xa[0] = xa[1]; xa[1] = xa[2]; xa[2] = ca; xb[0] = xb[1]; xb[1] = xb[2]; xb[2] = cbv; sq[i] = ya[i] * ya[i] + yb[i] * yb[i]; }
                if (ten < 2) {
#pragma unroll
                    for (int o_ = 1; o_ < 64; o_ <<= 1) {
#pragma unroll
                        for (int i = 0; i < 8; ++i) sq[i] += __shfl_xor(sq[i], o_); }
                    const float qs_ = ten == 0 ? 0.08838834764831845f : 1.0f;
#pragma unroll
                    for (int i = 0; i < 8; ++i) { const float sc = rsqrtf(sq[i] + EPS) * qs_; ya[i] *= sc; yb[i] *= sc; } }
                unsigned pk[8];
#pragma unroll
                for (int i = 0; i < 8; ++i) pk[i] = pk2(ya[i], yb[i]);
                if (ten < 2) { bf16* dst = ten == 0 ? QN : KN;
#pragma unroll
                    for (int i = 0; i < 8; ++i) *(unsigned*)(dst + (size_t)(b * SEQ + tw + i) * 512 + h * 128 + 2 * lane) = pk[i]; }
                if (ten >= 1) {
                    bf16* tb = (ten == 1 ? KT : VT) + ((size_t)((b * 4 + h) * 32 + nchunk) * 128 + 2 * lane) * 64 + 8 * wave;
                    u32x4 lo, hi;
                    lo.x = (pk[0] & 0xffffu) | (pk[1] << 16); lo.y = (pk[2] & 0xffffu) | (pk[3] << 16); lo.z = (pk[4] & 0xffffu) | (pk[5] << 16); lo.w = (pk[6] & 0xffffu) | (pk[7] << 16);
                    hi.x = (pk[0] >> 16) | (pk[1] & 0xffff0000u); hi.y = (pk[2] >> 16) | (pk[3] & 0xffff0000u); hi.z = (pk[4] >> 16) | (pk[5] & 0xffff0000u); hi.w = (pk[6] >> 16) | (pk[7] & 0xffff0000u);
                    *(u32x4*)tb = lo; *(u32x4*)(tb + 64) = hi; }
#pragma unroll
                for (int j = 0; j < 11; ++j) cx[j] = nx[j];
#pragma unroll
                for (int j = 0; j < 4; ++j) { cw0[j] = nw0[j]; cw1[j] = nw1[j]; } }
#undef DN_LOAD
        }
        if (lane < 32) { const int i = lane >> 2, hd = lane & 3; const size_t tok = (size_t)(b * SEQ + tw + i); const bf16* prow = P + tok * NP;
            const float av = bf2f(prow[C_A + hd]), bv = bf2f(prow[C_B + hd]);
            BETA[tok * 4 + hd] = sigmoidf_(bv);
            const float x = av + dt_bias[hd]; const float sp = x > 20.0f ? x : log1pf(expf(x));
            Gb[tok * 4 + hd] = -expf(a_log[hd]) * sp; }
        { const float qw = qnw[lane] * (0.125f * 1.4426950408889634f), ksw = knw[64 + lane], kww = knw[128 + lane];
#pragma unroll 4
          for (int i = 0; i < 8; ++i) { const size_t tok = (size_t)(b * SEQ + tw + i); const bf16* prow = P + tok * NP;
            float xv[6];
#pragma unroll
            for (int h = 0; h < 4; ++h) xv[h] = bf2f(prow[C_NQ + h * 64 + lane]);
            xv[4] = bf2f(prow[C_KV + 128 + lane]); xv[5] = bf2f(prow[C_KV + 256 + lane]);
            float ss[6];
#pragma unroll
            for (int h = 0; h < 6; ++h) ss[h] = xv[h] * xv[h];
#pragma unroll
            for (int o_ = 1; o_ < 64; o_ <<= 1) {
#pragma unroll
                for (int h = 0; h < 6; ++h) ss[h] += __shfl_xor(ss[h], o_); }
#pragma unroll
            for (int h = 0; h < 4; ++h) NQ[tok * 256 + h * 64 + lane] = (bf16)f2bf(xv[h] * rsqrtf(ss[h] * (1.0f / 64.0f) + EPS) * qw);
            KS[tok * 64 + lane] = (bf16)f2bf(xv[4] * rsqrtf(ss[4] * (1.0f / 64.0f) + EPS) * ksw);
            KW[tok * 64 + lane] = (bf16)f2bf(xv[5] * rsqrtf(ss[5] * (1.0f / 64.0f) + EPS) * kww); } }
        { const int c = 4 * lane; f32x4 acc[8]; const f32x4 bias = *(const f32x4*)(dwb + c);
#pragma unroll
            for (int i = 0; i < 8; ++i) acc[i] = bias;
#pragma unroll 1
            for (int g8 = 0; g8 < 5; ++g8) { u32x2 av[8], gv[8];
#pragma unroll
                for (int rr = 0; rr < 8; ++rr) { const int r = 8 * g8 + rr; av[rr] = (u32x2){0u, 0u}; gv[rr] = (u32x2){0u, 0u};
                    if (r < 38 && tw - 30 + r >= 0) { const bf16* pr = pw0 + (ptrdiff_t)(r - 30) * NP + C_CU + c; av[rr] = *(const u32x2*)pr; gv[rr] = *(const u32x2*)(pr + 256); } }
#pragma unroll
                for (int rr = 0; rr < 8; ++rr) { const int r = 8 * g8 + rr;
                    f32x4 gl; gl.x = bf_lo(av[rr].x) * sigmoidf_(bf_lo(gv[rr].x)); gl.y = bf_hi(av[rr].x) * sigmoidf_(bf_hi(gv[rr].x)); gl.z = bf_lo(av[rr].y) * sigmoidf_(bf_lo(gv[rr].y)); gl.w = bf_hi(av[rr].y) * sigmoidf_(bf_hi(gv[rr].y));
#pragma unroll
                    for (int i = 0; i < 8; ++i) { const int j = r - i; if (j >= 0 && j <= 30) { const f32x4 w = *(const LAS f32x4*)(dwl + j * 256 + c); acc[i] += w * gl; } } } }
            const f32x4 lw = *(const f32x4*)(lnw + c), lb = *(const f32x4*)(lnb + c);
#pragma unroll
            for (int i = 0; i < 8; ++i) { const f32x4 x = acc[i]; const float mean = wave_sum((x.x + x.y) + (x.z + x.w)) * (1.0f / 256.0f);
                const f32x4 d = x - mean; const float var = wave_sum((d.x * d.x + d.y * d.y) + (d.z * d.z + d.w * d.w)) * (1.0f / 256.0f);
                const float rr = rsqrtf(var + EPS); const f32x4 y = d * rr * lw + lb;
                u32x2 o; o.x = pk2(siluf_(y.x), siluf_(y.y)); o.y = pk2(siluf_(y.z), siluf_(y.w));
                *(u32x2*)(Y + (size_t)(b * SEQ + tw + i) * DM + 768 + c) = o; } }
    }
}

constexpr int LM_PITCH = 68;
__device__ __forceinline__ void ph_dn_chunk_mfma(const ArgsG& a, LAS unsigned char* lds, int bid, int G, int tid, int wave, int lane) {
    LAS float* Lm = (LAS float*)lds;
    LAS float* gcl = (LAS float*)(lds + 4 * 64 * LM_PITCH * 4);
    LAS float* betal = gcl + 256; LAS float* bkl = betal + 256;
    const bf16* QN = (const bf16*)(a.W() + WS_QN); const bf16* KN = (const bf16*)(a.W() + WS_KN);
    const bf16* KT = (const bf16*)(a.W() + WS_KT); const bf16* VT = (const bf16*)(a.W() + WS_VT);
    const float* Gb = (const float*)(a.W() + WS_G); const float* BETA = (const float*)(a.W() + WS_BETA); float* GC = (float*)(a.W() + WS_GC);
    float* U = (float*)(a.W() + WS_U); bf16* W = (bf16*)(a.W() + WS_W); bf16* ATT = (bf16*)(a.W() + WS_ATT);
    const int n = lane & 31, hh = lane >> 5;
    for (int cb = bid; cb < 256; cb += G) {
        if (wave < 4) { const int b = cb >> 5, nn = cb & 31, h = wave, ci = (b * 4 + h) * 32 + nn, r0 = b * SEQ + nn * 64; (void)ci;
            float g = Gb[(size_t)(r0 + lane) * 4 + h];
#pragma unroll
            for (int off = 1; off < 64; off <<= 1) { const float v = __shfl_up(g, off); if (lane >= off) g += v; }
            const float be = BETA[(size_t)(r0 + lane) * 4 + h];
            gcl[wave * 64 + lane] = g; GC[(size_t)(r0 + lane) * 4 + h] = g; betal[wave * 64 + lane] = be; bkl[wave * 64 + lane] = be * __expf(g); }
        __syncthreads();
#pragma unroll 1
        for (int q = 0; q < 3; ++q) { const int id = 3 * wave + q, c = id / 6, wq = id % 6, isq = wq >= 3 ? 1 : 0, blk = wq % 3, ib = blk >= 1 ? 1 : 0, jb = blk == 2 ? 1 : 0;
            const int b = cb >> 5, nn = cb & 31, h = c, ci = (b * 4 + h) * 32 + nn, r0 = b * SEQ + nn * 64;
            const bf16* ap = (isq ? QN : KN) + (size_t)(r0 + 32 * ib + n) * 512 + h * 128 + 8 * hh;
            const bf16* bp = KN + (size_t)(r0 + 32 * jb + n) * 512 + h * 128 + 8 * hh;
            f32x16 acc;
#pragma unroll
            for (int r = 0; r < 16; ++r) acc[r] = 0.f;
#pragma unroll
            for (int ks = 0; ks < 8; ++ks) acc = __builtin_amdgcn_mfma_f32_32x32x16_bf16(*(const bf16x8*)(ap + 16 * ks), *(const bf16x8*)(bp + 16 * ks), acc, 0, 0, 0);
            const int j = 32 * jb + n; const float gj = gcl[c * 64 + j];
#pragma unroll
            for (int r = 0; r < 16; ++r) { const int i = 32 * ib + (r & 3) + 8 * (r >> 2) + 4 * hh; const float dec = __expf(fminf(gcl[c * 64 + i] - gj, 0.f));
                if (isq) ATT[(size_t)ci * 4096 + i * 64 + j] = (bf16)((j <= i) ? f2bf(acc[r] * dec) : 0u);
                else Lm[c * 64 * LM_PITCH + i * LM_PITCH + j] = (j < i) ? betal[c * 64 + i] * acc[r] * dec : 0.f; } }
        __syncthreads();
        if (wave < 4) { LAS float* L = Lm + wave * 64 * LM_PITCH; float T[64];
#pragma unroll
            for (int i = 0; i < 64; ++i) { float a0 = (i == lane) ? 1.f : 0.f, a1 = 0.f, a2 = 0.f, a3 = 0.f;
#pragma unroll
                for (int j4 = 0; j4 + 3 < i; j4 += 4) { const f32x4 lv = *(const LAS f32x4*)(L + i * LM_PITCH + j4);
                    a0 -= lv.x * T[j4]; a1 -= lv.y * T[j4 + 1]; a2 -= lv.z * T[j4 + 2]; a3 -= lv.w * T[j4 + 3]; }
#pragma unroll
                for (int j = (i / 4) * 4; j < i; ++j) a0 -= L[i * LM_PITCH + j] * T[j];
                T[i] = (a0 + a1) + (a2 + a3); }
#pragma unroll
            for (int i = 0; i < 64; ++i) L[i * LM_PITCH + lane] = T[i]; }
        __syncthreads();
#pragma unroll 1
        for (int q = 0; q < 4; ++q) { const int id = wave * 4 + q, c = id >> 3, ten = (id >> 2) & 1, db = id & 3;
            const int b = cb >> 5, nn = cb & 31, h = c, ci = (b * 4 + h) * 32 + nn, r0 = b * SEQ + nn * 64;
            const bf16* arow = (ten ? KT : VT) + ((size_t)ci * 128 + 32 * db + n) * 64 + 8 * hh;
            const LAS float* scl = (ten ? bkl : betal) + c * 64;
            const LAS float* L = Lm + c * 64 * LM_PITCH;
#pragma unroll
            for (int ib = 0; ib < 2; ++ib) { f32x16 acc;
#pragma unroll
                for (int r = 0; r < 16; ++r) acc[r] = 0.f;
#pragma unroll
                for (int ks = 0; ks < 4; ++ks) { if (ib == 0 && ks >= 2) continue;
                    const LAS float* tp = L + (32 * ib + n) * LM_PITCH + 16 * ks + 8 * hh;
                    const f32x4 t0 = *(const LAS f32x4*)tp, t1 = *(const LAS f32x4*)(tp + 4), s0 = *(const LAS f32x4*)(scl + 16 * ks + 8 * hh), s1 = *(const LAS f32x4*)(scl + 16 * ks + 8 * hh + 4);
                    u32x4 bw; bw.x = pg8::cvt_pk_bf16(t0.x * s0.x, t0.y * s0.y); bw.y = pg8::cvt_pk_bf16(t0.z * s0.z, t0.w * s0.w); bw.z = pg8::cvt_pk_bf16(t1.x * s1.x, t1.y * s1.y); bw.w = pg8::cvt_pk_bf16(t1.z * s1.z, t1.w * s1.w);
                    acc = __builtin_amdgcn_mfma_f32_32x32x16_bf16(*(const bf16x8*)(arow + 16 * ks), __builtin_bit_cast(bf16x8, bw), acc, 0, 0, 0); }
                const size_t ob = (size_t)(r0 + 32 * ib + n) * 512 + h * 128 + 32 * db + 4 * hh;
#pragma unroll
                for (int rq = 0; rq < 4; ++rq) {
                    if (ten) { u32x2 w2; w2.x = pk2(acc[4 * rq], acc[4 * rq + 1]); w2.y = pk2(acc[4 * rq + 2], acc[4 * rq + 3]); *(u32x2*)(W + ob + 8 * rq) = w2; }
                    else *(f32x4*)(U + ob + 8 * rq) = (f32x4){acc[4 * rq], acc[4 * rq + 1], acc[4 * rq + 2], acc[4 * rq + 3]}; } } }
        __syncthreads();
    }
}

constexpr int SC_WP = 272, SC_AP = 144;
constexpr int SC_W = 0, SC_Q = 64 * SC_WP, SC_A = 2 * 64 * SC_WP, SC_K = SC_A + 64 * SC_AP, SC_GC = SC_K + 128 * SC_AP, SC_BUF = SC_GC + 1024;
static_assert(2 * SC_BUF <= RING_BYTES, "scan LDS");
struct ScanPf { u32x4 w[4], q[4], at[2], k[4]; float g, gl; };
__device__ __forceinline__ ScanPf scan_load(const bf16* W, const bf16* QN, const bf16* ATT, const bf16* KT, const float* GC, int r0, int h, int ci, int lt) {
    ScanPf p; const int row = lt >> 4, seg = lt & 15;
#pragma unroll
    for (int i = 0; i < 4; ++i) { const size_t go = (size_t)(r0 + row + 16 * i) * 512 + h * 128 + seg * 8; p.w[i] = *(const u32x4*)(W + go); p.q[i] = *(const u32x4*)(QN + go); }
#pragma unroll
    for (int i = 0; i < 2; ++i) p.at[i] = *(const u32x4*)(ATT + (size_t)ci * 4096 + (lt + 256 * i) * 8);
#pragma unroll
    for (int i = 0; i < 4; ++i) p.k[i] = *(const u32x4*)(KT + (size_t)ci * 8192 + (lt + 256 * i) * 8);
    p.g = GC[(size_t)(r0 + (lt & 63)) * 4 + h]; p.gl = GC[(size_t)(r0 + 63) * 4 + h]; return p;
}
__device__ __forceinline__ void scan_store(const ScanPf& p, LAS unsigned char* buf, int lt) {
    const int row = lt >> 4, seg = lt & 15;
#pragma unroll
    for (int i = 0; i < 4; ++i) { *(LAS u32x4*)(buf + SC_W + (row + 16 * i) * SC_WP + seg * 16) = p.w[i]; *(LAS u32x4*)(buf + SC_Q + (row + 16 * i) * SC_WP + seg * 16) = p.q[i]; }
#pragma unroll
    for (int i = 0; i < 2; ++i) *(LAS u32x4*)(buf + SC_A + ((lt >> 3) + 32 * i) * SC_AP + (lt & 7) * 16) = p.at[i];
#pragma unroll
    for (int i = 0; i < 4; ++i) *(LAS u32x4*)(buf + SC_K + ((lt >> 3) + 32 * i) * SC_AP + (lt & 7) * 16) = p.k[i];
    if (lt < 64) { LAS float* gp = (LAS float*)(buf + SC_GC); gp[lt] = __expf(p.g); gp[64 + lt] = __expf(p.gl - p.g); if (lt == 0) gp[128] = __expf(p.gl); }
}
__device__ __forceinline__ bf16x8 frag2(const LAS unsigned char* p) { const u32x2 lo = *(const LAS u32x2*)p, hi = *(const LAS u32x2*)(p + 16); const u32x4 v = {lo.x, lo.y, hi.x, hi.y}; return __builtin_bit_cast(bf16x8, v); }
__device__ __forceinline__ void ph_dn_scan_mfma(const ArgsG& a, LAS unsigned char* lds, int bid, int G, int tid, int wave, int lane) {
    const bf16* QN = (const bf16*)(a.W() + WS_QN); const bf16* KT = (const bf16*)(a.W() + WS_KT); const bf16* W = (const bf16*)(a.W() + WS_W); const bf16* ATT = (const bf16*)(a.W() + WS_ATT);
    const float* GC = (const float*)(a.W() + WS_GC); const float* U = (const float*)(a.W() + WS_U); float* O = (float*)(a.W() + WS_O);
    const int n = lane & 31, hh = lane >> 5;
    for (int u = bid; u < 32; u += G) {
        const int h = u & 3, b = u >> 2;
        f32x16 S[4];
#pragma unroll
        for (int k = 0; k < 4; ++k)
#pragma unroll
            for (int r = 0; r < 16; ++r) S[k][r] = 0.f;
        __syncthreads();
        if (wave >= 4) { const ScanPf p0 = scan_load(W, QN, ATT, KT, GC, b * SEQ, h, (b * 4 + h) * 32, tid - 256); scan_store(p0, lds, tid - 256); }
        __syncthreads();
#pragma unroll 1
        for (int nn = 0; nn < 32; ++nn) {
            const int r0 = b * SEQ + nn * 64; LAS unsigned char* buf = lds + (nn & 1) * SC_BUF; const LAS float* gp = (const LAS float*)(buf + SC_GC);
            if (wave >= 4) { if (nn + 1 < 32) { const ScanPf pf = scan_load(W, QN, ATT, KT, GC, r0 + 64, h, (b * 4 + h) * 32 + nn + 1, tid - 256); scan_store(pf, lds + ((nn + 1) & 1) * SC_BUF, tid - 256); } }
            else {
                const size_t ubase = (size_t)r0 * 512 + h * 128 + 32 * wave + n;
                f32x16 vn[2];
#pragma unroll
                for (int ib = 0; ib < 2; ++ib)
#pragma unroll
                    for (int r = 0; r < 16; ++r) vn[ib][r] = U[ubase + (size_t)(32 * ib + (r & 3) + 8 * (r >> 2) + 4 * hh) * 512];
                bf16x8 Sb[4][2];
#pragma unroll
                for (int k = 0; k < 4; ++k)
#pragma unroll
                    for (int s2 = 0; s2 < 2; ++s2) { u32x4 w4; w4.x = pg8::cvt_pk_bf16(S[k][8 * s2], S[k][8 * s2 + 1]); w4.y = pg8::cvt_pk_bf16(S[k][8 * s2 + 2], S[k][8 * s2 + 3]);
                        w4.z = pg8::cvt_pk_bf16(S[k][8 * s2 + 4], S[k][8 * s2 + 5]); w4.w = pg8::cvt_pk_bf16(S[k][8 * s2 + 6], S[k][8 * s2 + 7]); Sb[k][s2] = __builtin_bit_cast(bf16x8, w4); }
#pragma unroll
                for (int ib = 0; ib < 2; ++ib) { f32x16 acc;
#pragma unroll
                    for (int r = 0; r < 16; ++r) acc[r] = 0.f;
#pragma unroll
                    for (int k = 0; k < 4; ++k)
#pragma unroll
                        for (int s2 = 0; s2 < 2; ++s2) acc = __builtin_amdgcn_mfma_f32_32x32x16_bf16(frag2(buf + SC_W + (32 * ib + n) * SC_WP + (32 * k + 16 * s2 + 4 * hh) * 2), Sb[k][s2], acc, 0, 0, 0);
#pragma unroll
                    for (int r = 0; r < 16; ++r) vn[ib][r] -= acc[r]; }
                bf16x8 vb[2][2], vd[2][2];
#pragma unroll
                for (int jb = 0; jb < 2; ++jb)
#pragma unroll
                    for (int s2 = 0; s2 < 2; ++s2) { const f32x4 d0 = *(const LAS f32x4*)(gp + 64 + 32 * jb + 16 * s2 + 4 * hh), d1 = *(const LAS f32x4*)(gp + 64 + 32 * jb + 16 * s2 + 8 + 4 * hh);
                        const float* v = nullptr; (void)v; u32x4 w4, w5;
                        w4.x = pg8::cvt_pk_bf16(vn[jb][8 * s2], vn[jb][8 * s2 + 1]); w4.y = pg8::cvt_pk_bf16(vn[jb][8 * s2 + 2], vn[jb][8 * s2 + 3]);
                        w4.z = pg8::cvt_pk_bf16(vn[jb][8 * s2 + 4], vn[jb][8 * s2 + 5]); w4.w = pg8::cvt_pk_bf16(vn[jb][8 * s2 + 6], vn[jb][8 * s2 + 7]);
                        w5.x = pg8::cvt_pk_bf16(vn[jb][8 * s2] * d0.x, vn[jb][8 * s2 + 1] * d0.y); w5.y = pg8::cvt_pk_bf16(vn[jb][8 * s2 + 2] * d0.z, vn[jb][8 * s2 + 3] * d0.w);
                        w5.z = pg8::cvt_pk_bf16(vn[jb][8 * s2 + 4] * d1.x, vn[jb][8 * s2 + 5] * d1.y); w5.w = pg8::cvt_pk_bf16(vn[jb][8 * s2 + 6] * d1.z, vn[jb][8 * s2 + 7] * d1.w);
                        vb[jb][s2] = __builtin_bit_cast(bf16x8, w4); vd[jb][s2] = __builtin_bit_cast(bf16x8, w5); }
#pragma unroll
                for (int ib = 0; ib < 2; ++ib) { f32x16 acc;
#pragma unroll
                    for (int r = 0; r < 16; ++r) acc[r] = 0.f;
#pragma unroll
                    for (int k = 0; k < 4; ++k)
#pragma unroll
                        for (int s2 = 0; s2 < 2; ++s2) acc = __builtin_amdgcn_mfma_f32_32x32x16_bf16(frag2(buf + SC_Q + (32 * ib + n) * SC_WP + (32 * k + 16 * s2 + 4 * hh) * 2), Sb[k][s2], acc, 0, 0, 0);
#pragma unroll
                    for (int rq = 0; rq < 4; ++rq) { const f32x4 e4 = *(const LAS f32x4*)(gp + 32 * ib + 8 * rq + 4 * hh);
                        acc[4 * rq] *= e4.x; acc[4 * rq + 1] *= e4.y; acc[4 * rq + 2] *= e4.z; acc[4 * rq + 3] *= e4.w; }
#pragma unroll
                    for (int jb = 0; jb < 2; ++jb) { if (jb > ib) continue;
#pragma unroll
                        for (int s2 = 0; s2 < 2; ++s2) acc = __builtin_amdgcn_mfma_f32_32x32x16_bf16(frag2(buf + SC_A + (32 * ib + n) * SC_AP + (32 * jb + 16 * s2 + 4 * hh) * 2), vb[jb][s2], acc, 0, 0, 0); }
#pragma unroll
                    for (int r = 0; r < 16; ++r) O[ubase + (size_t)(32 * ib + (r & 3) + 8 * (r >> 2) + 4 * hh) * 512] = acc[r]; }
                const float egl = gp[128];
#pragma unroll
                for (int k = 0; k < 4; ++k) {
#pragma unroll
                    for (int r = 0; r < 16; ++r) S[k][r] *= egl;
#pragma unroll
                    for (int jb = 0; jb < 2; ++jb)
#pragma unroll
                        for (int s2 = 0; s2 < 2; ++s2) S[k] = __builtin_amdgcn_mfma_f32_32x32x16_bf16(frag2(buf + SC_K + (32 * k + n) * SC_AP + (32 * jb + 16 * s2 + 4 * hh) * 2), vd[jb][s2], S[k], 0, 0, 0); }
            }
            asm volatile("s_waitcnt lgkmcnt(0)" ::: "memory"); __builtin_amdgcn_s_barrier(); asm volatile("" ::: "memory");
        }
        __syncthreads();
    }
}

__device__ __forceinline__ void ph_dn_out(const ArgsG& a, int l, int gw, int NGW, int lane) {
    const float* O = (const float*)(a.W() + WS_O); const bf16* P = (const bf16*)(a.W() + WS_P); bf16* Y = (bf16*)(a.W() + WS_Y);
    const float* nw = a.I(6) + l * 128;
    for (int tok = gw; tok < NT; tok += NGW) {
#pragma unroll
        for (int h = 0; h < 4; ++h) { const float o0 = O[(size_t)tok * 512 + h * 128 + 2 * lane], o1 = O[(size_t)tok * 512 + h * 128 + 2 * lane + 1];
            const float ss = wave_sum(o0 * o0 + o1 * o1); const float r = rsqrtf(ss * (1.0f / 128.0f) + EPS);
            const unsigned zw = *(const unsigned*)(P + (size_t)tok * NP + C_Z + h * 128 + 2 * lane);
            const float y0 = o0 * r * nw[2 * lane] * siluf_(bf_lo(zw)), y1 = o1 * r * nw[2 * lane + 1] * siluf_(bf_hi(zw));
            *(unsigned*)(Y + (size_t)tok * DM + h * 128 + 2 * lane) = pk2(y0, y1); }
    }
}

constexpr int NSA_KT_PITCH = 144, NSA_VT_PITCH = 136;
struct NsaStage { u32x4 kv, vv; };
__device__ __forceinline__ NsaStage nsa_load(const bf16* Kbase, int kpitch, const bf16* Vbase, int vpitch, int tid) {
    const int key = tid >> 3, seg = tid & 7; NsaStage s;
    s.kv = *(const u32x4*)(Kbase + (size_t)key * kpitch + seg * 8); s.vv = *(const u32x4*)(Vbase + (size_t)key * vpitch + seg * 8); return s;
}
__device__ __forceinline__ void nsa_store(const NsaStage& s, LAS unsigned char* Kt, LAS unsigned char* Vt, int tid) {
    const int key = tid >> 3, seg = tid & 7;
    *(LAS u32x4*)(Kt + key * NSA_KT_PITCH + seg * 16) = s.kv;
#pragma unroll
    for (int i = 0; i < 4; ++i) { const unsigned w = s.vv[i];
        *(LAS unsigned short*)(Vt + (seg * 8 + 2 * i) * NSA_VT_PITCH + key * 2) = (unsigned short)(w & 0xffffu);
        *(LAS unsigned short*)(Vt + (seg * 8 + 2 * i + 1) * NSA_VT_PITCH + key * 2) = (unsigned short)(w >> 16); }
}
__device__ __forceinline__ void nsa_st(const LAS unsigned char* Kt, const bf16x8 (&qf)[4], int n, int hh, f32x16 (&s)[2]) {
#pragma unroll
    for (int kb = 0; kb < 2; ++kb) {
#pragma unroll
        for (int r = 0; r < 16; ++r) s[kb][r] = 0.f;
#pragma unroll
        for (int ks = 0; ks < 4; ++ks) { const bf16x8 af = *(const LAS bf16x8*)(Kt + (kb * 32 + n) * NSA_KT_PITCH + (16 * ks + 8 * hh) * 2);
            s[kb] = __builtin_amdgcn_mfma_f32_32x32x16_bf16(af, qf[ks], s[kb], 0, 0, 0); } }
}
__device__ __forceinline__ void nsa_pvm(const LAS unsigned char* Vt, const bf16x8 (&pf)[2][2], int n, int hh, f32x16 (&o)[2]) {
#pragma unroll
    for (int db = 0; db < 2; ++db)
#pragma unroll
        for (int kb = 0; kb < 2; ++kb)
#pragma unroll
            for (int s2 = 0; s2 < 2; ++s2) { const LAS unsigned char* p = Vt + (db * 32 + n) * NSA_VT_PITCH + (kb * 32 + 16 * s2 + 4 * hh) * 2;
                const u32x2 lo = *(const LAS u32x2*)p, hi = *(const LAS u32x2*)(p + 16);
                const u32x4 av = {lo.x, lo.y, hi.x, hi.y};
                o[db] = __builtin_amdgcn_mfma_f32_32x32x16_bf16(__builtin_bit_cast(bf16x8, av), pf[kb][s2], o[db], 0, 0, 0); }
}
__device__ __forceinline__ void nsa_pack(const f32x16 (&p)[2], bf16x8 (&pf)[2][2]) {
#pragma unroll
    for (int kb = 0; kb < 2; ++kb)
#pragma unroll
        for (int s2 = 0; s2 < 2; ++s2) { u32x4 w;
            w.x = pg8::cvt_pk_bf16(p[kb][8 * s2 + 0], p[kb][8 * s2 + 1]); w.y = pg8::cvt_pk_bf16(p[kb][8 * s2 + 2], p[kb][8 * s2 + 3]);
            w.z = pg8::cvt_pk_bf16(p[kb][8 * s2 + 4], p[kb][8 * s2 + 5]); w.w = pg8::cvt_pk_bf16(p[kb][8 * s2 + 6], p[kb][8 * s2 + 7]);
            pf[kb][s2] = __builtin_bit_cast(bf16x8, w); }
}
constexpr int BT2_ROWS = 2048 + 72;
template <bool COLSEL>
__device__ __forceinline__ void nsa_tile_mfma(const LAS unsigned char* Kt, const LAS unsigned char* Vt, const LAS float* btl2h, const bf16x8 (&qf)[4], int n, int hh,
                                              int key0, int tq, bool masked, bool colsel, int maxd, float& m, float& l, f32x16 (&o)[2]) {
    f32x16 s[2]; nsa_st(Kt, qf, n, hh, s);
    const int dbase = tq - key0 - 4 * hh;
    const LAS float* bp = btl2h + (2047 - dbase) * 4;
#pragma unroll
    for (int kb = 0; kb < 2; ++kb)
#pragma unroll
        for (int r = 0; r < 16; ++r) { const int cst = kb * 32 + (r & 3) + 8 * (r >> 2); const float x = s[kb][r] + bp[cst * 4]; s[kb][r] = (!COLSEL || colsel) ? x : -3.0e38f; }
    if (masked) {
#pragma unroll
        for (int kb = 0; kb < 2; ++kb)
#pragma unroll
            for (int r = 0; r < 16; ++r) { const int dist = dbase - (kb * 32 + (r & 3) + 8 * (r >> 2)); s[kb][r] = (dist >= 0 && dist <= maxd) ? s[kb][r] : -3.0e38f; } }
    float tmax = -3.0e38f;
#pragma unroll
    for (int kb = 0; kb < 2; ++kb)
#pragma unroll
        for (int r = 0; r < 16; ++r) tmax = fmaxf(tmax, s[kb][r]);
    tmax = fmaxf(tmax, __shfl_xor(tmax, 32));
    const float mn = fmaxf(m, tmax); float rs = 0.f;
#pragma unroll
    for (int kb = 0; kb < 2; ++kb)
#pragma unroll
        for (int r = 0; r < 16; ++r) { const float p = __builtin_amdgcn_exp2f(s[kb][r] - mn); s[kb][r] = p; rs += p; }
    rs += __shfl_xor(rs, 32);
    if (__any(mn > m)) { const float corr = __builtin_amdgcn_exp2f(m - mn); l *= corr;
#pragma unroll
        for (int db = 0; db < 2; ++db)
#pragma unroll
            for (int r = 0; r < 16; ++r) o[db][r] *= corr; }
    l += rs; m = mn;
    bf16x8 pf[2][2]; nsa_pack(s, pf);
    nsa_pvm(Vt, pf, n, hh, o);
}

__device__ __forceinline__ void ph_nsa_mfma(const ArgsG& a, LAS unsigned char* lds, int ubeg, int ustep, int uend, int tid, int wave, int lane) {
    LAS float* btl2 = (LAS float*)lds;
    constexpr int NSA_L0 = BT2_ROWS * 16;
    LAS unsigned char* Kt = lds + NSA_L0;
    LAS unsigned char* Vt = lds + NSA_L0 + 9216;
    constexpr int NSA_TB = 9216 + 8704;
    LAS float* PS = (LAS float*)(lds + NSA_L0 + 2 * NSA_TB + 256);
    LAS unsigned* MK = (LAS unsigned*)(lds + NSA_L0 + 2 * NSA_TB + 256 + 64 * 129 * 4);
    static_assert(NSA_L0 + 2 * NSA_TB + 256 + 64 * 129 * 4 + 512 <= RING_BYTES, "NSA LDS");
    const float* BT = (const float*)(a.W() + WS_BT);
    for (int i = tid; i < BT2_ROWS * 4; i += NTHR) { const int row = i >> 2, hd = i & 3; btl2[i] = row < 2048 ? BT[hd * 2048 + (2047 - row)] * 1.4426950408889634f : 0.f; }
    const bf16* P = (const bf16*)(a.W() + WS_P); const bf16* NQ = (const bf16*)(a.W() + WS_NQ);
    const bf16* KS = (const bf16*)(a.W() + WS_KS); const bf16* KW = (const bf16*)(a.W() + WS_KW);
    const bf16* KCMP = (const bf16*)(a.W() + WS_KCMP); const bf16* VCMP = (const bf16*)(a.W() + WS_VCMP); bf16* Y = (bf16*)(a.W() + WS_Y);
    const int n = lane & 31, hh = lane >> 5, tl = n >> 2, h = n & 3;
    const LAS float* btl2h = btl2 + h;
    __syncthreads();
    for (int u = ubeg; u < uend; u += ustep) {
        const int b = u & 7, qt = 31 - (u >> 3), t0 = 64 * qt, tq = t0 + 8 * wave + tl, tok = b * SEQ + tq;
        bf16x8 qf[4];
#pragma unroll
        for (int ks = 0; ks < 4; ++ks) qf[ks] = *(const bf16x8*)(NQ + (size_t)tok * 256 + h * 64 + 16 * ks + 8 * hh);
        float gate[3];
#pragma unroll
        for (int br = 0; br < 3; ++br) gate[br] = sigmoidf_(bf2f(P[(size_t)tok * NP + C_G + h * 3 + br]));
        f32x16 yacc[2];
        {
            float mx = -1e30f, rs = 0.f;
#pragma unroll 1
            for (int ct = 0; ct < 2; ++ct) {
                __syncthreads();
                { const NsaStage st = nsa_load(KCMP + (size_t)(b * 128 + ct * 64) * 64, 64, VCMP + (size_t)(b * 128 + ct * 64) * 64, 64, tid); nsa_store(st, Kt, Vt, tid); }
                __syncthreads();
                f32x16 sc[2]; nsa_st(Kt, qf, n, hh, sc);
                float tmax = -1e30f;
#pragma unroll
                for (int kb = 0; kb < 2; ++kb)
#pragma unroll
                    for (int r = 0; r < 16; ++r) { const int j = ct * 64 + kb * 32 + (r & 3) + 8 * (r >> 2) + 4 * hh; const int dist = tq - 16 * j - 31;
                        const float x = sc[kb][r] + btl2h[(2047 - (dist < 0 ? 0 : dist)) * 4]; sc[kb][r] = dist >= 0 ? x : -1e30f; tmax = fmaxf(tmax, sc[kb][r]); }
                tmax = fmaxf(tmax, __shfl_xor(tmax, 32));
                const float mn = fmaxf(mx, tmax); float ts = 0.f;
#pragma unroll
                for (int kb = 0; kb < 2; ++kb)
#pragma unroll
                    for (int r = 0; r < 16; ++r) { const float x = sc[kb][r]; ts += x > -1e29f ? __builtin_amdgcn_exp2f(x - mn) : 0.f; }
                ts += __shfl_xor(ts, 32);
                rs = rs * __builtin_amdgcn_exp2f(mx - mn) + ts; mx = mn;
            }
            const float inv = rs > 0.f ? 1.0f / rs : 0.f;
            f32x16 o[2];
#pragma unroll
            for (int db = 0; db < 2; ++db)
#pragma unroll
                for (int r = 0; r < 16; ++r) o[db][r] = 0.f;
#pragma unroll 1
            for (int cc = 0; cc < 2; ++cc) { const int ct = 1 - cc;
                if (cc == 1) { __syncthreads();
                    { const NsaStage st = nsa_load(KCMP + (size_t)(b * 128) * 64, 64, VCMP + (size_t)(b * 128) * 64, 64, tid); nsa_store(st, Kt, Vt, tid); }
                    __syncthreads(); }
                f32x16 sc[2]; nsa_st(Kt, qf, n, hh, sc);
#pragma unroll
                for (int kb = 0; kb < 2; ++kb)
#pragma unroll
                    for (int r = 0; r < 16; ++r) { const int j = ct * 64 + kb * 32 + (r & 3) + 8 * (r >> 2) + 4 * hh; const int dist = tq - 16 * j - 31;
                        const float x = sc[kb][r] + btl2h[(2047 - (dist < 0 ? 0 : dist)) * 4]; const float p = dist >= 0 ? __builtin_amdgcn_exp2f(x - mx) * inv : 0.f; sc[kb][r] = p;
                        float v = p; v += __shfl_xor(v, 1); v += __shfl_xor(v, 2);
                        if (h == 0) PS[(8 * wave + tl) * 129 + j] = v; }
                bf16x8 pf[2][2]; nsa_pack(sc, pf); nsa_pvm(Vt, pf, n, hh, o);
            }
#pragma unroll
            for (int db = 0; db < 2; ++db)
#pragma unroll
                for (int r = 0; r < 16; ++r) yacc[db][r] = gate[0] * o[db][r];
        }
        LDS_WAIT();
        for (int t2 = 0; t2 < 8; ++t2) {
            const int tqq = t0 + 8 * wave + t2, sb = lane & 31, cur = tqq >> 6; const LAS float* row = PS + (8 * wave + t2) * 129; float imp = 0.f;
#pragma unroll
            for (int dj = -1; dj <= 3; ++dj) { const int j = 4 * sb + dj; if (j >= 0 && j <= 126) imp += row[j]; }
            if (sb > cur) imp = -1.0f; else if (sb == 0 || sb == cur || sb == cur - 1) imp = 1e4f;
            int rank = 0;
            for (int s2 = 0; s2 < 32; ++s2) { const float v2 = __shfl(imp, s2); rank += (v2 > imp || (v2 == imp && s2 < sb)) ? 1 : 0; }
            const unsigned msk = (unsigned)__ballot((lane < 32) && (rank < 16) && (sb <= cur));
            if (lane == 0) MK[8 * wave + t2] = msk;
        }
        __syncthreads();
        unsigned anymask, wmask; const unsigned mymask = MK[8 * wave + tl];
        { unsigned v = MK[lane];
#pragma unroll
            for (int o_ = 1; o_ < 64; o_ <<= 1) v |= (unsigned)__shfl_xor((int)v, o_);
            anymask = (unsigned)__builtin_amdgcn_readfirstlane((int)v);
            unsigned w = MK[8 * wave + (lane & 7)]; w |= (unsigned)__shfl_xor((int)w, 1); w |= (unsigned)__shfl_xor((int)w, 2); w |= (unsigned)__shfl_xor((int)w, 4);
            wmask = (unsigned)__builtin_amdgcn_readfirstlane((int)w); }
        LAS unsigned* stash = (LAS unsigned*)PS + (wave * 16) * 64 + lane;
        __syncthreads();
#pragma unroll
        for (int db = 0; db < 2; ++db)
#pragma unroll
            for (int k = 0; k < 8; ++k) stash[(db * 8 + k) * 64] = pk2(yacc[db][2 * k], yacc[db][2 * k + 1]);
        {
            float m = -1e30f, l = 0.f; f32x16 o[2];
#pragma unroll
            for (int db = 0; db < 2; ++db)
#pragma unroll
                for (int r = 0; r < 16; ++r) o[db][r] = 0.f;
            unsigned mk = anymask; NsaStage s0, s1; bool h1 = false;
            { const int sa = __builtin_ctz(mk); s0 = nsa_load(KS + (size_t)(b * SEQ + 64 * sa) * 64, 64, P + (size_t)(b * SEQ + 64 * sa) * NP + C_KV + 192, NP, tid);
              unsigned m2 = mk & (mk - 1u); if (m2) { const int sb2 = __builtin_ctz(m2); s1 = nsa_load(KS + (size_t)(b * SEQ + 64 * sb2) * 64, 64, P + (size_t)(b * SEQ + 64 * sb2) * NP + C_KV + 192, NP, tid); h1 = true; } }
            __syncthreads();
            nsa_store(s0, Kt, Vt, tid);
            __syncthreads();
            int par = 0;
            while (mk) {
                const int sblk = __builtin_ctz(mk); mk &= mk - 1u;
                if (h1) { nsa_store(s1, Kt + (par ^ 1) * NSA_TB, Vt + (par ^ 1) * NSA_TB, tid);
                    const unsigned m3 = mk & (mk - 1u);
                    if (m3) { const int sc2 = __builtin_ctz(m3); s1 = nsa_load(KS + (size_t)(b * SEQ + 64 * sc2) * 64, 64, P + (size_t)(b * SEQ + 64 * sc2) * NP + C_KV + 192, NP, tid); } else h1 = false; }
                if ((wmask >> sblk) & 1u) nsa_tile_mfma<true>(Kt + par * NSA_TB, Vt + par * NSA_TB, btl2h, qf, n, hh, 64 * sblk, tq, 64 * sblk + 63 > t0 + 8 * wave, ((mymask >> sblk) & 1u) != 0u, 1 << 30, m, l, o);
                asm volatile("s_waitcnt lgkmcnt(0)" ::: "memory"); __builtin_amdgcn_s_barrier(); asm volatile("" ::: "memory");
                par ^= 1;
            }
            const float inv = l > 0.f ? gate[1] / l : 0.f;
#pragma unroll
            for (int db = 0; db < 2; ++db)
#pragma unroll
                for (int k = 0; k < 8; ++k) { const unsigned w = stash[(db * 8 + k) * 64]; stash[(db * 8 + k) * 64] = pk2(bf_lo(w) + inv * o[db][2 * k], bf_hi(w) + inv * o[db][2 * k + 1]); }
        }
        {
            float m = -1e30f, l = 0.f; f32x16 o[2];
#pragma unroll
            for (int db = 0; db < 2; ++db)
#pragma unroll
                for (int r = 0; r < 16; ++r) o[db][r] = 0.f;
            const int kt0 = (t0 - 511 > 0 ? t0 - 511 : 0) >> 6;
            NsaStage s0 = nsa_load(KW + (size_t)(b * SEQ + 64 * kt0) * 64, 64, P + (size_t)(b * SEQ + 64 * kt0) * NP + C_KV + 320, NP, tid), s1;
            if (kt0 < qt) s1 = nsa_load(KW + (size_t)(b * SEQ + 64 * (kt0 + 1)) * 64, 64, P + (size_t)(b * SEQ + 64 * (kt0 + 1)) * NP + C_KV + 320, NP, tid);
            __syncthreads();
            nsa_store(s0, Kt, Vt, tid);
            __syncthreads();
            int par = 0;
            for (int kt = kt0; kt <= qt; ++kt) {
                if (kt < qt) { nsa_store(s1, Kt + (par ^ 1) * NSA_TB, Vt + (par ^ 1) * NSA_TB, tid);
                    if (kt + 2 <= qt) s1 = nsa_load(KW + (size_t)(b * SEQ + 64 * (kt + 2)) * 64, 64, P + (size_t)(b * SEQ + 64 * (kt + 2)) * NP + C_KV + 320, NP, tid); }
                nsa_tile_mfma<false>(Kt + par * NSA_TB, Vt + par * NSA_TB, btl2h, qf, n, hh, 64 * kt, tq, !(64 * kt + 63 <= t0 + 8 * wave && t0 + 8 * wave + 7 - 64 * kt <= 511), true, 511, m, l, o);
                asm volatile("s_waitcnt lgkmcnt(0)" ::: "memory"); __builtin_amdgcn_s_barrier(); asm volatile("" ::: "memory");
                par ^= 1;
            }
            const float inv = l > 0.f ? gate[2] / l : 0.f;
#pragma unroll
            for (int db = 0; db < 2; ++db)
#pragma unroll
                for (int k = 0; k < 8; ++k) { const unsigned w = stash[(db * 8 + k) * 64]; yacc[db][2 * k] = bf_lo(w) + inv * o[db][2 * k]; yacc[db][2 * k + 1] = bf_hi(w) + inv * o[db][2 * k + 1]; }
        }
#pragma unroll
        for (int db = 0; db < 2; ++db)
#pragma unroll
            for (int rq = 0; rq < 4; ++rq) { u32x2 w; w.x = pk2(yacc[db][4 * rq], yacc[db][4 * rq + 1]); w.y = pk2(yacc[db][4 * rq + 2], yacc[db][4 * rq + 3]);
                *(u32x2*)(Y + (size_t)tok * DM + 512 + h * 64 + db * 32 + 8 * rq + 4 * hh) = w; }
        __syncthreads();
    }
}

constexpr int RT_PITCH = 2064;
__device__ __forceinline__ void ph_router(const ArgsG& a, int l, const float* Xin_, const bf16* Dm, LAS unsigned char* lds, int bid, int G, int tid, int wave, int lane) {
    LAS unsigned char* Ht = lds;
    LAS float* LG = (LAS float*)(lds + 32 * RT_PITCH);
    LAS int* lcnt = (LAS int*)(lds + 32 * RT_PITCH + 4 * 64 * 33 * 4); LAS int* asg_e = lcnt + 32; LAS int* asg_p = asg_e + 256; LAS float* asg_w = (LAS float*)(asg_p + 256); LAS int* gbase = (LAS int*)(asg_w + 256);
    bf16* H2 = (bf16*)(a.W() + WS_XN); unsigned* cnt = (unsigned*)(a.W() + WS_CTL) + CW_CNT + 64 * l;
    int* EIDX = (int*)(a.W() + WS_EIDX); int* EPOS = (int*)(a.W() + WS_EPOS); float* EW = (float*)(a.W() + WS_EW); int* POSTOK = (int*)(a.W() + WS_XS);
    const float* fw = a.I(17) + (size_t)l * DM; const float* rb = a.I(19) + l * NE;
    const bf16* RWH = (const bf16*)(a.W() + WS_RWH) + (size_t)l * NE * DM; const bf16* RWL = (const bf16*)(a.W() + WS_RWL) + (size_t)l * NE * DM;
    for (int u = bid; u < NT / 64; u += G) {
        const int tok0 = u * 64;
        if (tid < 32) lcnt[tid] = 0;
#pragma unroll 1
        for (int hf = 0; hf < 2; ++hf) {
            __syncthreads();
#pragma unroll 1
            for (int i = 0; i < 4; ++i) { const int tl = 4 * wave + i, tok = tok0 + 32 * hf + tl;
                f32x4 v[4]; float ss = 0.f;
#pragma unroll
                for (int j = 0; j < 4; ++j) { v[j] = *(const f32x4*)(Xin_ + (size_t)tok * DM + 4 * (64 * j + lane)); const u32x2 dd = *(const u32x2*)(Dm + (size_t)tok * DM + 4 * (64 * j + lane));
                    v[j].x += bf_lo(dd.x); v[j].y += bf_hi(dd.x); v[j].z += bf_lo(dd.y); v[j].w += bf_hi(dd.y); ss += (v[j].x * v[j].x + v[j].y * v[j].y) + (v[j].z * v[j].z + v[j].w * v[j].w); }
                const float r = rsqrtf(wave_sum(ss) * (1.0f / DM) + EPS);
#pragma unroll
                for (int j = 0; j < 4; ++j) { const f32x4 y = v[j] * r * *(const f32x4*)(fw + 4 * (64 * j + lane));
                    u32x2 o; o.x = pk2(y.x, y.y); o.y = pk2(y.z, y.w); *(u32x2*)(H2 + (size_t)tok * DM + 4 * (64 * j + lane)) = o;
                    *(LAS u32x2*)(Ht + tl * RT_PITCH + 8 * (64 * j + lane)) = o; } }
            __syncthreads();
            { const int r = lane & 15, q = lane >> 4, tile = wave & 1, kq = wave >> 1; f32x4 acc0 = {0.f, 0.f, 0.f, 0.f}, acc1 = {0.f, 0.f, 0.f, 0.f};
                const LAS unsigned char* arow = Ht + (16 * tile + r) * RT_PITCH + q * 16;
                const bf16* bh = RWH + (size_t)r * DM + 8 * q; const bf16* bl = RWL + (size_t)r * DM + 8 * q;
#pragma unroll
                for (int s8 = 0; s8 < 8; ++s8) { const int s = 8 * kq + s8; const bf16x8 af = *(const LAS bf16x8*)(arow + s * 64);
                    acc0 = __builtin_amdgcn_mfma_f32_16x16x32_bf16(af, *(const bf16x8*)(bh + 32 * s), acc0, 0, 0, 0); acc0 = __builtin_amdgcn_mfma_f32_16x16x32_bf16(af, *(const bf16x8*)(bl + 32 * s), acc0, 0, 0, 0);
                    acc1 = __builtin_amdgcn_mfma_f32_16x16x32_bf16(af, *(const bf16x8*)(bh + 16 * DM + 32 * s), acc1, 0, 0, 0); acc1 = __builtin_amdgcn_mfma_f32_16x16x32_bf16(af, *(const bf16x8*)(bl + 16 * DM + 32 * s), acc1, 0, 0, 0); }
                const float b0 = kq == 0 ? rb[r] : 0.f, b1 = kq == 0 ? rb[16 + r] : 0.f;
#pragma unroll
                for (int i = 0; i < 4; ++i) { LAS float* lg = LG + kq * (64 * 33) + (32 * hf + 16 * tile + 4 * q + i) * 33; lg[r] = acc0[i] + b0; lg[16 + r] = acc1[i] + b1; } }
        }
        __syncthreads();
        if (tid < 64) { const LAS float* lg = LG + tid * 33; unsigned used = 0u; float tv[4]; int ti[4];
#pragma unroll
            for (int qn = 0; qn < 4; ++qn) { float best = -3.0e38f; int bi = 0;
                for (int e = 0; e < NE; ++e) { const float v = ((lg[e] + lg[64 * 33 + e]) + lg[2 * 64 * 33 + e]) + lg[3 * 64 * 33 + e]; if (!((used >> e) & 1u) && v > best) { best = v; bi = e; } }
                used |= 1u << bi; tv[qn] = best; ti[qn] = bi; }
            float ew[4], es = 0.f;
#pragma unroll
            for (int qn = 0; qn < 4; ++qn) { ew[qn] = __expf(tv[qn] - tv[0]); es += ew[qn]; }
#pragma unroll
            for (int qn = 0; qn < 4; ++qn) { const int p = __hip_atomic_fetch_add(&lcnt[ti[qn]], 1, __ATOMIC_RELAXED, __HIP_MEMORY_SCOPE_WORKGROUP); asg_e[tid * 4 + qn] = ti[qn]; asg_p[tid * 4 + qn] = p; asg_w[tid * 4 + qn] = ew[qn] / es; } }
        __syncthreads();
        if (tid < 32) gbase[tid] = (int)atomicAdd(&cnt[tid], (unsigned)lcnt[tid]);
        __syncthreads();
        if (tid < 256) { const int tok = tok0 + (tid >> 2), k = tid & 3, e = asg_e[tid];
            const int pos = gbase[e] + asg_p[tid];
            EIDX[(size_t)tok * 4 + k] = e; EPOS[(size_t)tok * 4 + k] = pos; EW[(size_t)tok * 4 + k] = asg_w[tid]; POSTOK[(size_t)e * NT + pos] = tok; }
        __syncthreads();
    }
}

__device__ __forceinline__ void build_tiles(const unsigned* cnt, LAS int* TS, LAS int* TE, int tid) {
    if (tid == 0) { int acc = 0;
        for (int e = 0; e < NE; ++e) { TS[e] = acc; const int nt = (int)((cnt[e] + 255u) >> 8); for (int i = 0; i < nt; ++i) TE[acc + i] = e; acc += nt; }
        TS[NE] = acc; }
    __syncthreads();
}

__device__ __forceinline__ void ph_gather(const ArgsG& a, int l, LAS unsigned char* lds, int gw, int NGW, int tid, int lane) {
    LAS int* TS = (LAS int*)(lds + TS_OFF); LAS int* TE = (LAS int*)(lds + TE_OFF);
    const unsigned* cnt = (const unsigned*)(a.W() + WS_CTL) + CW_CNT + 64 * l;
    build_tiles(cnt, TS, TE, tid);
    const int* EIDX = (const int*)(a.W() + WS_EIDX); const int* EPOS = (const int*)(a.W() + WS_EPOS); int* SLOT = (int*)(a.W() + WS_SLOT); int* S2T = (int*)(a.W() + WS_XS);
    for (int i = gw * 64 + lane; i < NT * 4; i += NGW * 64) { const int slot = TS[EIDX[i]] * 256 + EPOS[i]; SLOT[i] = slot; S2T[slot] = i >> 2; }
    for (int e = (int)blockIdx.x; e < NE; e += (int)gridDim.x) { const int beg = TS[e] * 256 + (int)cnt[e], end = TS[e + 1] * 256; for (int sidx = beg + tid; sidx < end; sidx += NTHR) S2T[sidx] = 0; }
}

__device__ __forceinline__ void ph_combine(const ArgsG& a, int l, LAS unsigned char* lds, const float* Xin_, const bf16* Dm, float* Xo, const float* next_norm_w, int gw, int NGW, int tid, int lane) {
    LAS int* TS = (LAS int*)(lds + TS_OFF); LAS int* TE = (LAS int*)(lds + TE_OFF);
    build_tiles((const unsigned*)(a.W() + WS_CTL) + CW_CNT + 64 * l, TS, TE, tid);
    const int* EIDX = (const int*)(a.W() + WS_EIDX); const int* EPOS = (const int*)(a.W() + WS_EPOS);
    const bf16* YS = (const bf16*)(a.W() + WS_YS); const float* EW = (const float*)(a.W() + WS_EW); bf16* XN = (bf16*)(a.W() + WS_XN);
    for (int tok = gw; tok < NT; tok += NGW) {
        int slot = 0; float wgt = 0.f;
        if (lane < 4) { slot = TS[EIDX[(size_t)tok * 4 + lane]] * 256 + EPOS[(size_t)tok * 4 + lane]; wgt = EW[(size_t)tok * 4 + lane]; }
        f32x4 v[4];
#pragma unroll
        for (int j = 0; j < 4; ++j) { v[j] = *(const f32x4*)(Xin_ + (size_t)tok * DM + 4 * (64 * j + lane)); const u32x2 dd = *(const u32x2*)(Dm + (size_t)tok * DM + 4 * (64 * j + lane));
            v[j].x += bf_lo(dd.x); v[j].y += bf_hi(dd.x); v[j].z += bf_lo(dd.y); v[j].w += bf_hi(dd.y); }
#pragma unroll
        for (int k = 0; k < 4; ++k) { const int sk = __shfl(slot, k); const float wk = __shfl(wgt, k);
#pragma unroll
            for (int j = 0; j < 4; ++j) { const u32x2 y = *(const u32x2*)(YS + (size_t)sk * DM + 4 * (64 * j + lane));
                v[j].x += wk * bf_lo(y.x); v[j].y += wk * bf_hi(y.x); v[j].z += wk * bf_lo(y.y); v[j].w += wk * bf_hi(y.y); } }
#pragma unroll
        for (int j = 0; j < 4; ++j) *(f32x4*)(Xo + (size_t)tok * DM + 4 * (64 * j + lane)) = v[j];
        if (next_norm_w) rms_row_to_bf16(v, next_norm_w, XN + (size_t)tok * DM, lane);
    }
}

struct Tid { int tid, lane, wave; };
__device__ __forceinline__ Tid fresh_tid() { int t = threadIdx.x; asm volatile("" : "+v"(t)); Tid r; r.tid = t; r.lane = t & 63; r.wave = __builtin_amdgcn_readfirstlane(t >> 6); return r; }
#define FT() ArgsG A_; { unsigned char* w_ = args_k.ws; asm volatile("" : "+s"(w_)); A_.ws = (GAS unsigned char*)w_; _Pragma("unroll") for (int i_ = 0; i_ < 25; ++i_) A_.in[i_] = (const GAS float*)args_k.in[i_]; A_.out = (GAS float*)args_k.out; } const ArgsG& args = A_; const Tid T_ = fresh_tid(); const int tid = T_.tid, lane = T_.lane, wave = T_.wave, gw = bid * NWAVES + wave; (void)tid; (void)lane; (void)wave; (void)gw
constexpr int PH_PER_LAYER = 11, NPH = 2 + NLAYER * PH_PER_LAYER;

#if SINGLE_LAUNCH
#define BARPARM , unsigned* barw, unsigned& bark
#define BARARG , barw, bark
#define GRID_BAR() cnt_barrier(barw, bark)
#else
#define BARPARM
#define BARARG
#define GRID_BAR() do {} while (0)
#endif
#define IN(k) (lo <= (k) && (k) < hi)
#define SEAM(k) do { if (IN(k) && IN((k) + 1)) GRID_BAR(); } while (0)
template <int l>
__device__ __forceinline__ void run_layer(const Args& args_k, LAS unsigned char* lds, int lo, int hi, int G, int bid, int NGW BARPARM) {
        const int pb = 2 + l * PH_PER_LAYER;
#define Xin ((l == 0) ? args.I(0) : (const float*)(args.W() + WS_XB))
#define X1 ((float*)(args.W() + WS_XA))
#define Xout ((l == NLAYER - 1) ? args.O() : (float*)(args.W() + WS_XB))
        if (IN(pb + 0)) {
            FT(); pg8::Gemm g{(const pg8::bf16_t*)(args.W() + WS_XN), (const pg8::bf16_t*)(args.W() + WS_WIN) + (size_t)l * NP * DM, NT, NP, DM};
            pg8::StaticOrder S; S.init(NT, NP, G, bid);
            pg8::EpiBf16Plain E{(pg8::bf16_t*)(args.W() + WS_P), NP};
            pg8::gemm_phase<pg8::EpiBf16Plain, pg8::StaticOrder, true, true>(lds, g, S, E);
        } SEAM(pb + 0);
        if (IN(pb + 1)) { { FT(); ph_compress_mfma(args, l, lds, bid, G, tid, wave, lane); } { FT(); ph_m1(args, l, lds, bid, G, tid, wave, lane); }
            asm volatile("s_waitcnt vmcnt(0)" ::: "memory"); __syncthreads();
            if (G == 256) { FT(); ph_dn_chunk_mfma(args, lds, bid, G, tid, wave, lane); } }
        if (G != 256) { SEAM(pb + 1); if (IN(pb + 1)) { FT(); ph_dn_chunk_mfma(args, lds, bid, G, tid, wave, lane); } } SEAM(pb + 1);
        if (IN(pb + 3)) {
            const bool small = G <= 64;
            if (small || bid < 32) { FT(); ph_dn_scan_mfma(args, lds, bid, small ? G : 32, tid, wave, lane); }
            { int ub, us, ue;
              if (small) { ub = bid; us = G; ue = 256; }
              else if (G == 256) { if (bid >= 32) { ub = bid - 32; us = 32; ue = ub >= 192 ? 256 : ub + 1; } else { ub = 256; us = 256; ue = 256; } }
              else { ub = bid >= 32 ? bid - 32 : 256; us = G - 32; ue = 256; }
              FT(); ph_nsa_mfma(args, lds, ub, us, ue, tid, wave, lane); } } SEAM(pb + 3);
        if (IN(pb + 4)) { FT(); ph_dn_out(args, l, gw, NGW, lane); } SEAM(pb + 4);
        if (IN(pb + 5)) {
            FT(); pg8::Gemm g{(const pg8::bf16_t*)(args.W() + WS_Y), (const pg8::bf16_t*)(args.W() + WS_WOUT) + (size_t)l * DM * DM, NT, DM, DM};
            pg8::StaticOrder S; S.init(NT, DM, G, bid);
            pg8::EpiBf16Plain E{(pg8::bf16_t*)(args.W() + WS_XA), DM};
            pg8::gemm_phase<pg8::EpiBf16Plain, pg8::StaticOrder, true, true>(lds, g, S, E);
        } SEAM(pb + 5);
        if (IN(pb + 6)) { FT(); ph_router(args, l, Xin, (const bf16*)(args.W() + WS_XA), lds, bid, G, tid, wave, lane); } SEAM(pb + 6);
        if (IN(pb + 8)) {
            FT(); LAS int* TS = (LAS int*)(lds + TS_OFF); LAS int* TE = (LAS int*)(lds + TE_OFF);
            build_tiles((const unsigned*)(args.W() + WS_CTL) + CW_CNT + 64 * l, TS, TE, tid);
            const int ntiles = __builtin_amdgcn_readfirstlane(TS[NE]);
            pg8::Gemm g{(const pg8::bf16_t*)(args.W() + WS_XN), (const pg8::bf16_t*)(args.W() + WS_WGU) + (size_t)l * NE * 2048 * DM, ntiles * 256, NE * 2048, DM};
            LAS int* RT = (LAS int*)(lds + LDSCTL_OFF + 2048);
            pg8::MoeOrder<8, true> S{ntiles, G, bid, (const LAS int*)TE, (const LAS int*)RT};
            { const int* POSTOK = (const int*)(args.W() + WS_XS); const unsigned* cntp = (const unsigned*)(args.W() + WS_CTL) + CW_CNT + 64 * l; pg8::Unit uu;
              for (int i = 0; i < 10 && S.next(i, uu); ++i) if (tid < 256) { const int e = TE[uu.pm], pos = uu.pm * 256 + tid - TS[e] * 256; RT[i * 256 + tid] = pos < (int)cntp[e] ? POSTOK[(size_t)e * NT + pos] : 0; } }
            __syncthreads();
            pg8::EpiSwiglu E{(pg8::bf16_t*)(args.W() + WS_ACT), args.I(21) + (size_t)l * NE * 2048};
            pg8::gemm_phase<pg8::EpiSwiglu, pg8::MoeOrder<8, true>, true, true>(lds, g, S, E);
        } SEAM(pb + 8);
        if (IN(pb + 9)) {
            FT(); LAS int* TS = (LAS int*)(lds + TS_OFF); LAS int* TE = (LAS int*)(lds + TE_OFF);
            build_tiles((const unsigned*)(args.W() + WS_CTL) + CW_CNT + 64 * l, TS, TE, tid);
            const int ntiles = __builtin_amdgcn_readfirstlane(TS[NE]);
            pg8::Gemm g{(const pg8::bf16_t*)(args.W() + WS_ACT), (const pg8::bf16_t*)(args.W() + WS_WD) + (size_t)l * NE * DM * DM, ntiles * 256, NE * DM, DM};
            pg8::MoeOrder<4> S{ntiles, G, bid, (const LAS int*)TE};
            pg8::EpiDown64 E{(pg8::bf16_t*)(args.W() + WS_YS), args.I(23) + (size_t)l * NE * DM};
            pg8::gemm_phase<pg8::EpiDown64, pg8::MoeOrder<4>, true, true>(lds, g, S, E);
        } SEAM(pb + 9);
        if (IN(pb + 10)) { FT(); ph_combine(args, l, lds, Xin, (const bf16*)(args.W() + WS_XA), Xout, (l + 1 < NLAYER) ? args.I(1) + (size_t)(l + 1) * DM : nullptr, gw, NGW, tid, lane); }
        if (l + 1 < NLAYER) SEAM(pb + 10);
    }

__global__ void __launch_bounds__(NTHR, 2) fwd_kernel(Args args_k) {
    extern __shared__ __attribute__((aligned(16))) unsigned char lds_raw[];
    LAS unsigned char* lds = (LAS unsigned char*)lds_raw;
    const int G = gridDim.x, bid = blockIdx.x, NGW = G * NWAVES;
    for (int u = threadIdx.x; u < (LDS_BYTES - LDSCTL_OFF) / 4; u += NTHR) ((LAS unsigned*)(lds + LDSCTL_OFF))[u] = 0u;
    __syncthreads();
#if SINGLE_LAUNCH
    unsigned* barw = (unsigned*)(args_k.ws + WS_CTL) + CW_BAR; unsigned bark = 0u;
#endif
    const int lo = args_k.ph_lo, hi = args_k.ph_hi;

    if (IN(0)) { { FT(); ph_norm0(args, gw, NGW, lane); } { FT(); ph_prologue(args, lds, gw, NGW, wave, lane); } } SEAM(0);

    run_layer<0>(args_k, lds, lo, hi, G, bid, NGW BARARG);
    run_layer<1>(args_k, lds, lo, hi, G, bid, NGW BARARG);
#undef IN
#undef SEAM
}

extern "C" void kernel_launch(void* const* d_in, const int* in_sizes, int n_in, void* d_out, int out_size, void* d_ws, size_t ws_size, hipStream_t stream) {
    static int grid = 0;
    if (grid == 0) {
        if (n_in != 25 || in_sizes[0] != NT * DM || out_size != NT * DM || ws_size < WS_END) {
            fprintf(stderr, "kernel_launch: unexpected problem (n_in %d, in0 %d, out %d, ws %zu < %zu); nothing launched\n", n_in, n_in > 0 ? in_sizes[0] : -1, out_size, ws_size, (size_t)WS_END); grid = -1; return; }
        int dev = 0, cus = 0, per_cu = 0;
        if (hipGetDevice(&dev) != hipSuccess || hipDeviceGetAttribute(&cus, hipDeviceAttributeMultiprocessorCount, dev) != hipSuccess) { grid = -1; return; }
        if (hipFuncSetAttribute((const void*)fwd_kernel, hipFuncAttributeMaxDynamicSharedMemorySize, LDS_BYTES) != hipSuccess) { fprintf(stderr, "kernel_launch: hipFuncSetAttribute failed\n"); grid = -1; return; }
        if (hipOccupancyMaxActiveBlocksPerMultiprocessor(&per_cu, (const void*)fwd_kernel, NTHR, LDS_BYTES) != hipSuccess || per_cu < 1)
            fprintf(stderr, "kernel_launch: note: occupancy query reports %d workgroups per CU\n", per_cu);
        (void)hipGetLastError();
        grid = cus;
    }
    if (grid < 0) return;
    if (hipMemsetAsync((char*)d_ws + WS_CTL, 0, CTL_ZERO_BYTES, stream) != hipSuccess) { fprintf(stderr, "kernel_launch: memset failed\n"); return; }
    Args a{};
    for (int i = 0; i < 25; ++i) a.in[i] = (const float*)d_in[i];
    a.out = (float*)d_out; a.ws = (unsigned char*)d_ws;
#if SINGLE_LAUNCH
    a.ph_lo = 0; a.ph_hi = NPH;
    hipLaunchKernelGGL(fwd_kernel, dim3(grid), dim3(NTHR), LDS_BYTES, stream, a);
#else
    for (int ph = 0; ph < NPH; ++ph) { a.ph_lo = ph; a.ph_hi = ph + 1; hipLaunchKernelGGL(fwd_kernel, dim3(grid), dim3(NTHR), LDS_BYTES, stream, a); }
#endif
}
```

```cpp
#include <hip/hip_runtime.h>
#include <cstdio>
#include <cstdint>
#include <cstddef>
namespace pg8 {
#define PG8_LAS __attribute__((address_space(3)))
#define PG8_GAS __attribute__((address_space(1)))
typedef unsigned short bf16_t;
typedef short bf16x8 __attribute__((ext_vector_type(8)));
typedef float f32x4 __attribute__((ext_vector_type(4)));
typedef unsigned u32x4 __attribute__((ext_vector_type(4)));
constexpr int BM = 256, BK = 64, HALF = 128, HTB = HALF * BK * 2  , STAGE_BYTES = 8 * HTB, NXCD = 8, WGM = 8;

__host__ __device__ __forceinline__ int lds_byte(int r, int c) { const int st = (r >> 4) * 2 + (c >> 5), rr = r & 15, cc = c & 31, ob = rr * 64 + cc * 2; return st * 1024 + (ob ^ (((ob >> 9) & 1) << 5)); }
__host__ __device__ __forceinline__ void stage_rc(int b, int& R, int& C) { const int st = b / 1024, sb = b % 1024, swz = sb ^ (((sb >> 9) & 1) << 5); R = (st >> 1) * 16 + swz / 64; C = (st & 1) * 32 + (swz % 64) / 2; }
__host__ __device__ __forceinline__ int perm32(int rho) { const int n = rho >> 4, i = rho & 15; return 8 * (i >> 2) + 4 * n + (i & 3); }

struct Unit { int pm, pn; };
struct Gemm { const bf16_t* A; const bf16_t* Bt; int M, N, K; };

struct StaticOrder {
    static constexpr bool GATHER = false; const PG8_LAS int* rowtab = nullptr;
    int nM, nN, nwg, G, c;
    __host__ __device__ void init(int M, int N, int G_, int c_) { nM = M / BM; nN = N / BM; nwg = nM * nN; G = G_; c = c_; }
    __host__ __device__ bool next(int i, Unit& u) const {
        const long L = (long)i * G + c; if (L >= nwg) return false;
        int wgid = (int)L; { const int q = nwg / NXCD, r = nwg % NXCD, xcd = wgid % NXCD, off = wgid / NXCD; wgid = (xcd < r ? xcd * (q + 1) : r * (q + 1) + (xcd - r) * q) + off; }
        const int nig = WGM * nN, gid = wgid / nig, fm = gid * WGM, gsz = (nM - fm) < WGM ? (nM - fm) : WGM;
        u.pm = fm + ((wgid % nig) % gsz); u.pn = (wgid % nig) / gsz; return true;
    }
    __device__ __forceinline__ void a_ready(const Unit&) const {}
    __device__ __forceinline__ void done(const Unit&) const {}
};

__device__ __forceinline__ unsigned cvt_pk_bf16(float lo, float hi) { unsigned r; asm volatile("v_cvt_pk_bf16_f32 %0, %1, %2" : "=v"(r) : "v"(lo), "v"(hi)); return r; }

struct EpiBf16Plain {
    static constexpr bool PERM = true, AFTER_DRAIN = false, B64 = false;
    bf16_t* O; int ldc;
    __device__ __forceinline__ void operator()(const f32x4 (&acc)[2][2][4][2], const Unit& u, int wr, int wc, int fr, int fq) const {
        const int row0 = u.pm * BM + wr * 64 + fr, col0 = u.pn * BM + wc * 32 + 8 * fq;
#pragma unroll
        for (int ai = 0; ai < 2; ++ai)
#pragma unroll
            for (int m = 0; m < 4; ++m) { bf16_t* rowp = O + (size_t)(row0 + ai * HALF + m * 16) * ldc + col0;
#pragma unroll
                for (int bj = 0; bj < 2; ++bj) { const f32x4 v0 = acc[ai][bj][m][0], v1 = acc[ai][bj][m][1];
                    u32x4 w; w.x = cvt_pk_bf16(v0[0], v0[1]); w.y = cvt_pk_bf16(v0[2], v0[3]); w.z = cvt_pk_bf16(v1[0], v1[1]); w.w = cvt_pk_bf16(v1[2], v1[3]);
                    *(PG8_GAS u32x4*)(rowp + bj * HALF) = w; } }
    }
};
struct EpiResF32 {
    static constexpr bool PERM = false, AFTER_DRAIN = false, B64 = false;
    const float* base; float* out; int ldc;
    __device__ __forceinline__ void operator()(const f32x4 (&acc)[2][2][4][2], const Unit& u, int wr, int wc, int fr, int fq) const {
        const int row0 = u.pm * BM + wr * 64 + fr, col0 = u.pn * BM + wc * 32 + 4 * fq;
#pragma unroll
        for (int ai = 0; ai < 2; ++ai)
#pragma unroll
            for (int m = 0; m < 4; ++m) { const size_t off = (size_t)(row0 + ai * HALF + m * 16) * ldc + col0;
#pragma unroll
                for (int bj = 0; bj < 2; ++bj)
#pragma unroll
                    for (int n = 0; n < 2; ++n) { const f32x4 b = *(const f32x4*)(base + off + bj * HALF + n * 16); *(PG8_GAS f32x4*)(out + off + bj * HALF + n * 16) = b + acc[ai][bj][m][n]; } }
    }
};
struct EpiSwiglu {
    static constexpr bool PERM = true, AFTER_DRAIN = false, B64 = false;
    bf16_t* O; const float* bgu;
    __device__ __forceinline__ void operator()(const f32x4 (&acc)[2][2][4][2], const Unit& u, int wr, int wc, int fr, int fq) const {
        const int e = u.pn >> 3, pnl = u.pn & 7;
        const int row0 = u.pm * BM + wr * 64 + fr, gcol = pnl * 128 + wc * 32 + 8 * fq;
        const float* bg = bgu + (size_t)e * 2048 + gcol;
        f32x4 bgv[2], buv[2];
#pragma unroll
        for (int n = 0; n < 2; ++n) { bgv[n] = *(const PG8_GAS f32x4*)(bg + 4 * n); buv[n] = *(const PG8_GAS f32x4*)(bg + 1024 + 4 * n); }
#pragma unroll
        for (int ai = 0; ai < 2; ++ai)
#pragma unroll
            for (int m = 0; m < 4; ++m) { bf16_t* rowp = O + (size_t)(row0 + ai * HALF + m * 16) * 1024 + gcol;
                float r[8];
#pragma unroll
                for (int n = 0; n < 2; ++n) { const f32x4 gv = acc[ai][0][m][n] + bgv[n], uv = acc[ai][1][m][n] + buv[n];
#pragma unroll
                    for (int j = 0; j < 4; ++j) { const float g = fminf(gv[j], 7.0f), up = fminf(fmaxf(uv[j], -7.0f), 7.0f);
                        const float sg = __builtin_amdgcn_rcpf(1.0f + __expf(-1.702f * g)); r[n * 4 + j] = (up + 1.0f) * g * sg; } }
                u32x4 w; w.x = cvt_pk_bf16(r[0], r[1]); w.y = cvt_pk_bf16(r[2], r[3]); w.z = cvt_pk_bf16(r[4], r[5]); w.w = cvt_pk_bf16(r[6], r[7]);
                *(PG8_GAS u32x4*)rowp = w; }
    }
};
struct EpiDown {
    static constexpr bool PERM = true, AFTER_DRAIN = false, B64 = false;
    bf16_t* O; const float* bd;
    __device__ __forceinline__ void operator()(const f32x4 (&acc)[2][2][4][2], const Unit& u, int wr, int wc, int fr, int fq) const {
        const int e = u.pn >> 2, pnl = u.pn & 3;
        const int row0 = u.pm * BM + wr * 64 + fr, col0 = pnl * BM + wc * 32 + 8 * fq;
        const float* bp = bd + (size_t)e * 1024 + col0;
        f32x4 bv[2][2];
#pragma unroll
        for (int bj = 0; bj < 2; ++bj)
#pragma unroll
            for (int n = 0; n < 2; ++n) bv[bj][n] = *(const PG8_GAS f32x4*)(bp + bj * HALF + 4 * n);
#pragma unroll
        for (int ai = 0; ai < 2; ++ai)
#pragma unroll
            for (int m = 0; m < 4; ++m) { bf16_t* rowp = O + (size_t)(row0 + ai * HALF + m * 16) * 1024 + col0;
#pragma unroll
                for (int bj = 0; bj < 2; ++bj) { const f32x4 v0 = acc[ai][bj][m][0] + bv[bj][0], v1 = acc[ai][bj][m][1] + bv[bj][1];
                    u32x4 w; w.x = cvt_pk_bf16(v0[0], v0[1]); w.y = cvt_pk_bf16(v0[2], v0[3]); w.z = cvt_pk_bf16(v1[0], v1[1]); w.w = cvt_pk_bf16(v1[2], v1[3]);
                    *(PG8_GAS u32x4*)(rowp + bj * HALF) = w; } }
    }
};
struct EpiDown64 {
    static constexpr bool PERM = true, AFTER_DRAIN = false, B64 = true;
    bf16_t* O; const float* bd;
    __device__ __forceinline__ void operator()(const f32x4 (&acc)[2][2][4][2], const Unit& u, int wr, int wc, int fr, int fq) const {
        const int e = u.pn >> 2, pnl = u.pn & 3;
        const int row0 = u.pm * BM + wr * 64 + fr, col0 = pnl * BM + wc * 64 + 8 * fq;
        const float* bp = bd + (size_t)e * 1024 + col0;
        f32x4 bv[2][2];
#pragma unroll
        for (int bj = 0; bj < 2; ++bj)
#pragma unroll
            for (int n = 0; n < 2; ++n) bv[bj][n] = *(const PG8_GAS f32x4*)(bp + bj * 32 + 4 * n);
#pragma unroll
        for (int ai = 0; ai < 2; ++ai)
#pragma unroll
            for (int m = 0; m < 4; ++m) { bf16_t* rowp = O + (size_t)(row0 + ai * HALF + m * 16) * 1024 + col0;
#pragma unroll
                for (int bj = 0; bj < 2; ++bj) { const f32x4 v0 = acc[ai][bj][m][0] + bv[bj][0], v1 = acc[ai][bj][m][1] + bv[bj][1];
                    u32x4 w; w.x = cvt_pk_bf16(v0[0], v0[1]); w.y = cvt_pk_bf16(v0[2], v0[3]); w.z = cvt_pk_bf16(v1[0], v1[1]); w.w = cvt_pk_bf16(v1[2], v1[3]);
                    *(PG8_GAS u32x4*)(rowp + bj * 32) = w; } }
    }
};
struct EpiBf16Plain64 {
    static constexpr bool PERM = true, AFTER_DRAIN = false, B64 = true;
    bf16_t* O; int ldc;
    __device__ __forceinline__ void operator()(const f32x4 (&acc)[2][2][4][2], const Unit& u, int wr, int wc, int fr, int fq) const {
        const int row0 = u.pm * BM + wr * 64 + fr, col0 = u.pn * BM + wc * 64 + 8 * fq;
#pragma unroll
        for (int ai = 0; ai < 2; ++ai)
#pragma unroll
            for (int m = 0; m < 4; ++m) { bf16_t* rowp = O + (size_t)(row0 + ai * HALF + m * 16) * ldc + col0;
#pragma unroll
                for (int bj = 0; bj < 2; ++bj) { const f32x4 v0 = acc[ai][bj][m][0], v1 = acc[ai][bj][m][1];
                    u32x4 w; w.x = cvt_pk_bf16(v0[0], v0[1]); w.y = cvt_pk_bf16(v0[2], v0[3]); w.z = cvt_pk_bf16(v1[0], v1[1]); w.w = cvt_pk_bf16(v1[2], v1[3]);
                    *(PG8_GAS u32x4*)(rowp + bj * 32) = w; } }
    }
};
template <int NPN, bool GATHER_ = false> struct MoeOrder {
    static constexpr bool GATHER = GATHER_;
    int ntiles, G, c; const PG8_LAS int* texp; const PG8_LAS int* rowtab = nullptr;
    __device__ __forceinline__ bool next(int i, Unit& u) const {
        constexpr int MT = 32 / NPN; int mt, pn;
        if (G == 256) { const int chunk = i * 8 + (c & 7), r = c >> 3; pn = r / MT; mt = chunk * MT + (r % MT); }
        else { const int L = i * G + c; mt = L / NPN; pn = L % NPN; }
        mt = __builtin_amdgcn_readfirstlane(mt); if (mt >= ntiles) return false;
        const int e = __builtin_amdgcn_readfirstlane(texp[mt]);
        u.pm = mt; u.pn = e * NPN + pn; return true;
    }
    __device__ __forceinline__ void a_ready(const Unit&) const {}
    __device__ __forceinline__ void done(const Unit&) const {}
};

template <class Epi, class Sched, bool ALIGN_EPI = false, bool SP2 = false>
__device__ __forceinline__ void gemm_phase(PG8_LAS unsigned char* lds, const Gemm g, const Sched& S, const Epi& E) {
    int tid_ = threadIdx.x; asm volatile("" : "+v"(tid_));
    const int tid = tid_, wid = __builtin_amdgcn_readfirstlane(tid >> 6), lane = tid & 63, wr = wid >> 2, wc = wid & 3, fr = lane & 15, fq = lane >> 4;
    const int K = g.K, nt = K / BK;
    constexpr bool GA = Sched::GATHER;
    static_assert(!GA || SP2, "gathered A rows: SP2 loop only");
    unsigned voffA[2], voffB[2]; int RA[2], CA2[2];
#pragma unroll
    for (int i = 0; i < 2; ++i) { int R, C; stage_rc(tid * 16 + i * 8192, R, C); RA[i] = R; CA2[i] = C * 2; const int Rb = Epi::B64 ? ((R >> 5) * 64 + perm32(R & 31)) : (Epi::PERM ? ((R & ~31) + perm32(R & 31)) : R);
        voffA[i] = (unsigned)(R * K + C) * 2u; voffB[i] = (unsigned)(Rb * K + C) * 2u; }
    const size_t kstep = (size_t)(BK * 2);
    const size_t hstep = (size_t)HALF * K * 2;
    const size_t tstep = 2 * hstep;
    const size_t hstepB = Epi::B64 ? (size_t)32 * K * 2 : hstep;
    const unsigned ldsw = (unsigned)wid * 1024u;
    const int aoff = lds_byte(wr * 64 + fr, fq * 8), boff = lds_byte(wc * 32 + fr, fq * 8);
#define PG8_SA(b, h) (((b) * 2 + (h)) * HTB)
#define PG8_SB(b, h) ((4 + (b) * 2 + (h)) * HTB)
#define PG8_STAGE(bufoff, gbase, voff) do { _Pragma("unroll") for (int _i = 0; _i < 2; ++_i) \
        __builtin_amdgcn_global_load_lds((const unsigned*)((const char*)(gbase) + (voff)[_i]), (PG8_LAS unsigned*)(lds + (bufoff) + ldsw + _i * 8192), 16, 0, 0); } while (0)
#define PG8_STAGE_A(bufoff, ptr, h, V) do { if constexpr (GA) PG8_STAGE(bufoff, ptr, V[h]); else PG8_STAGE(bufoff, (ptr) + (h) * hstep, voffA); } while (0)
#define PG8_ROWOFF(V, uidx) do { _Pragma("unroll") for (int h_ = 0; h_ < 2; ++h_) _Pragma("unroll") for (int i_ = 0; i_ < 2; ++i_) V[h_][i_] = (unsigned)S.rowtab[(uidx) * 256 + h_ * 128 + RA[i_]] * (unsigned)(K * 2) + (unsigned)CA2[i_]; } while (0)
#define PG8_LDA(dst, b, h) do { _Pragma("unroll") for (int m = 0; m < 4; ++m) _Pragma("unroll") for (int k = 0; k < 2; ++k) dst[m][k] = *(const PG8_LAS bf16x8*)(lds + PG8_SA(b, h) + aoff + m * 2048 + k * 1024); } while (0)
#define PG8_LDB(dst, b, h) do { _Pragma("unroll") for (int n = 0; n < 2; ++n) _Pragma("unroll") for (int k = 0; k < 2; ++k) dst[n][k] = *(const PG8_LAS bf16x8*)(lds + PG8_SB(b, h) + boff + n * 2048 + k * 1024); } while (0)
#define PG8_MMA(ai, bj, At, Bt) do { __builtin_amdgcn_s_setprio(1); _Pragma("unroll") for (int m = 0; m < 4; ++m) _Pragma("unroll") for (int n = 0; n < 2; ++n) _Pragma("unroll") for (int k = 0; k < 2; ++k) \
        acc[ai][bj][m][n] = __builtin_amdgcn_mfma_f32_16x16x32_bf16(Bt[n][k], At[m][k], acc[ai][bj][m][n], 0, 0, 0); __builtin_amdgcn_s_setprio(0); } while (0)
#define PG8_WAIT_V(n) asm volatile("s_waitcnt vmcnt(" #n ")" ::: "memory")
#define PG8_WAIT_L(n) asm volatile("s_waitcnt lgkmcnt(" #n ")" ::: "memory")
#define PG8_BAR __builtin_amdgcn_s_barrier()
#define PG8_SCHED __builtin_amdgcn_sched_barrier(0)
    Unit cur, nxt; int ui = 0;
    if (!S.next(0, cur)) return;
    f32x4 acc[2][2][4][2];
#pragma unroll
    for (int a = 0; a < 2; ++a)
#pragma unroll
        for (int b = 0; b < 2; ++b)
#pragma unroll
            for (int m = 0; m < 4; ++m)
#pragma unroll
                for (int n = 0; n < 2; ++n) acc[a][b][m][n] = (f32x4){0.f, 0.f, 0.f, 0.f};
    bf16x8 At[4][2], B0[2][2], B1[2][2];
    const char* cA = (const char*)g.A + (GA ? (size_t)0 : (size_t)cur.pm * tstep); const char* cB = (const char*)g.Bt + (size_t)cur.pn * tstep;
    unsigned vAc[2][2] = {{0u, 0u}, {0u, 0u}}, vAn[2][2] = {{0u, 0u}, {0u, 0u}};
    if constexpr (GA) { PG8_ROWOFF(vAc, 0); }
    S.a_ready(cur);
    if constexpr (SP2) {
        PG8_STAGE(PG8_SB(0, 0), cB, voffB); PG8_STAGE(PG8_SB(0, 1), cB + hstepB, voffB); PG8_STAGE_A(PG8_SA(0, 0), cA, 0, vAc); PG8_STAGE_A(PG8_SA(0, 1), cA, 1, vAc);
        if (wr == 1) PG8_BAR;
        PG8_WAIT_V(2); PG8_BAR;
        PG8_STAGE(PG8_SB(1, 0), cB + kstep, voffB); PG8_STAGE_A(PG8_SA(1, 0), cA + kstep, 0, vAc); PG8_STAGE(PG8_SB(1, 1), cB + hstepB + kstep, voffB);
        PG8_WAIT_V(6); PG8_BAR;
    } else {
        PG8_STAGE(PG8_SB(0, 0), cB, voffB); PG8_STAGE(PG8_SA(0, 0), cA, voffA); PG8_STAGE(PG8_SB(0, 1), cB + hstepB, voffB); PG8_STAGE(PG8_SA(0, 1), cA + hstep, voffA);
        if (wr == 1) PG8_BAR;
        PG8_WAIT_V(4); PG8_BAR;
        PG8_STAGE(PG8_SB(1, 0), cB + kstep, voffB); PG8_STAGE(PG8_SA(1, 0), cA + kstep, voffA); PG8_STAGE(PG8_SB(1, 1), cB + hstepB + kstep, voffB);
        PG8_WAIT_V(6); PG8_BAR;
    }
    for (;;) {
        const bool has_next = S.next(ui + 1, nxt);
        const char* nA = (has_next && !GA) ? (const char*)g.A + (size_t)nxt.pm * tstep : cA; const char* nB = has_next ? (const char*)g.Bt + (size_t)nxt.pn * tstep : cB;
        for (int t = 0; t < nt; t += 2) {
            const bool last = (t == nt - 2);
            const char* a1 = cA + (size_t)(t + 1) * kstep;
            const char* a2 = last ? nA : cA + (size_t)(t + 2) * kstep; const char* b2 = last ? nB : cB + (size_t)(t + 2) * kstep;
            const char* a3 = a2 + kstep; const char* b3 = b2 + kstep;
            if (last && has_next) S.a_ready(nxt);
            unsigned v2[2][2] = {{0u, 0u}, {0u, 0u}};
            if constexpr (GA) { if (last) { if (has_next) { PG8_ROWOFF(vAn, ui + 1); } else {
#pragma unroll
                        for (int h_ = 0; h_ < 2; ++h_) { vAn[h_][0] = vAc[h_][0]; vAn[h_][1] = vAc[h_][1]; } } }
#pragma unroll
                for (int h_ = 0; h_ < 2; ++h_) { v2[h_][0] = last ? vAn[h_][0] : vAc[h_][0]; v2[h_][1] = last ? vAn[h_][1] : vAc[h_][1]; } }
            if constexpr (SP2) {
            PG8_LDB(B0, 0, 0); PG8_LDB(B1, 0, 1); PG8_SCHED; PG8_LDA(At, 0, 0); PG8_STAGE_A(PG8_SA(1, 1), a1, 1, vAc);
            PG8_WAIT_V(8); PG8_WAIT_L(0); PG8_BAR; PG8_MMA(0, 0, At, B0); PG8_MMA(0, 1, At, B1); PG8_BAR; PG8_SCHED;
            PG8_LDA(At, 0, 1); PG8_STAGE(PG8_SB(0, 0), b2, voffB); PG8_STAGE(PG8_SB(0, 1), b2 + hstepB, voffB); PG8_STAGE_A(PG8_SA(0, 0), a2, 0, v2);
            PG8_WAIT_V(8); PG8_WAIT_L(0); PG8_BAR; PG8_MMA(1, 0, At, B0); PG8_MMA(1, 1, At, B1); PG8_BAR; PG8_SCHED;
            PG8_LDB(B0, 1, 0); PG8_LDB(B1, 1, 1); PG8_SCHED; PG8_LDA(At, 1, 0); PG8_STAGE_A(PG8_SA(0, 1), a2, 1, v2);
            PG8_WAIT_V(8); PG8_WAIT_L(0); PG8_BAR; PG8_MMA(0, 0, At, B0); PG8_MMA(0, 1, At, B1); PG8_BAR; PG8_SCHED;
            PG8_LDA(At, 1, 1); PG8_STAGE(PG8_SB(1, 0), b3, voffB); PG8_STAGE(PG8_SB(1, 1), b3 + hstepB, voffB); PG8_STAGE_A(PG8_SA(1, 0), a3, 0, v2);
            PG8_WAIT_V(8); PG8_WAIT_L(0); PG8_BAR; PG8_MMA(1, 0, At, B0); PG8_MMA(1, 1, At, B1); PG8_BAR; PG8_SCHED;
            } else {
            PG8_LDB(B0, 0, 0); PG8_SCHED; PG8_LDA(At, 0, 0); PG8_STAGE(PG8_SA(1, 1), a1 + hstep, voffA);
            PG8_WAIT_L(8); PG8_BAR; PG8_WAIT_L(0); PG8_MMA(0, 0, At, B0); PG8_BAR; PG8_SCHED;
            PG8_LDB(B1, 0, 1); PG8_STAGE(PG8_SB(0, 0), b2, voffB);
            PG8_BAR; PG8_WAIT_L(0); PG8_MMA(0, 1, At, B1); PG8_BAR;
            PG8_LDA(At, 0, 1); PG8_STAGE(PG8_SA(0, 0), a2, voffA);
            PG8_BAR; PG8_WAIT_L(0); PG8_MMA(1, 0, At, B0); PG8_BAR; PG8_SCHED;
            PG8_STAGE(PG8_SB(0, 1), b2 + hstepB, voffB);
            PG8_WAIT_V(6); PG8_BAR; PG8_MMA(1, 1, At, B1); PG8_BAR;
            PG8_LDB(B0, 1, 0); PG8_SCHED; PG8_LDA(At, 1, 0); PG8_STAGE(PG8_SA(0, 1), a2 + hstep, voffA);
            PG8_WAIT_L(8); PG8_BAR; PG8_WAIT_L(0); PG8_MMA(0, 0, At, B0); PG8_BAR; PG8_SCHED;
            PG8_LDB(B1, 1, 1); PG8_STAGE(PG8_SB(1, 0), b3, voffB);
            PG8_BAR; PG8_WAIT_L(0); PG8_MMA(0, 1, At, B1); PG8_BAR;
            PG8_LDA(At, 1, 1); PG8_STAGE(PG8_SA(1, 0), a3, voffA);
            PG8_BAR; PG8_WAIT_L(0); PG8_MMA(1, 0, At, B0); PG8_BAR; PG8_SCHED;
            PG8_STAGE(PG8_SB(1, 1), b3 + hstepB, voffB);
            PG8_WAIT_V(6); PG8_BAR; PG8_MMA(1, 1, At, B1); PG8_BAR;
            }
        }
        if constexpr (ALIGN_EPI) { if (wr == 0) PG8_BAR; }
        if constexpr (!Epi::AFTER_DRAIN) { E(acc, cur, wr, wc, fr, fq); S.done(cur); }
        if (!has_next) break;
#pragma unroll
        for (int a = 0; a < 2; ++a)
#pragma unroll
            for (int b = 0; b < 2; ++b)
#pragma unroll
                for (int m = 0; m < 4; ++m)
#pragma unroll
                    for (int n = 0; n < 2; ++n) acc[a][b][m][n] = (f32x4){0.f, 0.f, 0.f, 0.f};
        cur = nxt; cA = nA; cB = nB; ++ui;
        if constexpr (GA) {
#pragma unroll
            for (int h_ = 0; h_ < 2; ++h_) { vAc[h_][0] = vAn[h_][0]; vAc[h_][1] = vAn[h_][1]; } }
        if constexpr (ALIGN_EPI) { if (wr == 1) PG8_BAR; }
    }
    PG8_WAIT_V(0);
    if constexpr (!ALIGN_EPI) { if (wr == 0) PG8_BAR; }
    PG8_BAR;
    if constexpr (Epi::AFTER_DRAIN) { E.fused(acc, cur, wr, wc, fr, fq, lds, wid, lane); S.done(cur); }
#undef PG8_SA
#undef PG8_SB
#undef PG8_STAGE
#undef PG8_STAGE_A
#undef PG8_ROWOFF
#undef PG8_LDA
#undef PG8_LDB
#undef PG8_MMA
#undef PG8_WAIT_V
#undef PG8_WAIT_L
#undef PG8_BAR
#undef PG8_SCHED
}
}


#define GAS __attribute__((address_space(1)))
typedef unsigned short bf16;
typedef float f32x4 __attribute__((ext_vector_type(4)));
typedef unsigned u32x4 __attribute__((ext_vector_type(4)));
typedef unsigned u32x2 __attribute__((ext_vector_type(2)));
typedef short bf16x8 __attribute__((ext_vector_type(8)));
typedef float f32x16 __attribute__((ext_vector_type(16)));

#ifndef SINGLE_LAUNCH
#define SINGLE_LAUNCH 1
#endif

constexpr int NB = 8, SEQ = 2048, DM = 1024, NT = NB * SEQ, NLAYER = 2;
constexpr int DIN = 3220, NP = 3328;
constexpr int C_Q = 0, C_K = 512, C_V = 1024, C_Z = 1536, C_NQ = 2048, C_KV = 2304, C_CU = 2688, C_A = 3200, C_B = 3204, C_G = 3208;
constexpr int NE = 32, MAXT = 288;
constexpr int NWAVES = 8, NTHR = 512;
constexpr float EPS = 1e-6f;

constexpr size_t MiB = 1u << 20;
constexpr size_t WS_CTL = 0, CTL_ZERO_BYTES = 4096;
constexpr size_t WS_BT = 1 * MiB;
constexpr size_t WS_KCMP = 1 * MiB + 256 * 1024, WS_VCMP = 1 * MiB + 512 * 1024;
constexpr size_t WS_G = 2 * MiB, WS_BETA = 2 * MiB + 256 * 1024, WS_GC = 2 * MiB + 512 * 1024;
constexpr size_t WS_EIDX = 3 * MiB, WS_EPOS = 3 * MiB + 256 * 1024, WS_EW = 3 * MiB + 512 * 1024, WS_SLOT = 3 * MiB + 768 * 1024;
constexpr size_t WS_WIN = 4 * MiB;
constexpr size_t WS_WOUT = 17 * MiB;
constexpr size_t WS_WGU = 22 * MiB;
constexpr size_t WS_WD = 278 * MiB;
constexpr size_t WS_XA = 406 * MiB, WS_XB = 470 * MiB;
constexpr size_t WS_XN = 534 * MiB;
constexpr size_t WS_P = 566 * MiB;
constexpr size_t WS_QN = 670 * MiB, WS_KN = 686 * MiB, WS_VC = 702 * MiB;
constexpr size_t WS_U = 718 * MiB, WS_W = 750 * MiB;
constexpr size_t WS_ATT = 782 * MiB;
constexpr size_t WS_O = 798 * MiB;
constexpr size_t WS_NQ = 830 * MiB;
constexpr size_t WS_KS = 846 * MiB, WS_KW = 848 * MiB;
constexpr size_t WS_Y = 850 * MiB;
constexpr size_t WS_XS = 882 * MiB, WS_ACT = 1026 * MiB, WS_YS = 1170 * MiB;
constexpr size_t WS_KT = 1314 * MiB, WS_VT = 1330 * MiB;
constexpr size_t WS_W1T = 1346 * MiB;
constexpr size_t WS_POSW = 1349 * MiB;
constexpr size_t WS_RWH = 1350 * MiB, WS_RWL = 1351 * MiB;
constexpr size_t WS_END = 1352 * MiB;

constexpr int CW_TMO = 0, CW_BAR = 64, CW_CNT = 512;

constexpr int RING_BYTES = 131072;
constexpr int LDSCTL_OFF = RING_BYTES, MISC_OFF = LDSCTL_OFF, TS_OFF = LDSCTL_OFF + 128, TE_OFF = LDSCTL_OFF + 320;
constexpr int LDS_BYTES = 147456;
static_assert(TE_OFF + MAXT * 4 + 64 <= LDSCTL_OFF + 2048 && LDSCTL_OFF + 2048 + 10 * 1024 <= LDS_BYTES, "LDS map");

#define XB_TMO      128
#define XB_XCNT(j)  (256  + 64 * (j))
#define XB_XSUB(j)  (1280 + 64 * (j))
#define XB_XGEN(j)  (2304 + 64 * (j))
#define XB_TOP      3328
#define XB_TOPGEN   3392
#define XCD_BAR_WORDS 3456
#define XB_SPIN_CAP (1u << 22)
#define LAS __attribute__((address_space(3)))

__device__ __forceinline__ unsigned xb_ld(unsigned* p)              { return __hip_atomic_load(p, __ATOMIC_RELAXED, __HIP_MEMORY_SCOPE_AGENT); }
__device__ __forceinline__ unsigned xb_add(unsigned* p, unsigned v) { return __hip_atomic_fetch_add(p, v, __ATOMIC_RELAXED, __HIP_MEMORY_SCOPE_AGENT); }
__device__ __forceinline__ unsigned xb_xcc_id() { return (unsigned)__builtin_amdgcn_s_getreg((3 << 11) | 20) & 0xFu; }
#define XB_SPIN(cond, bar) do { unsigned _sp = 0; while (cond) { __builtin_amdgcn_s_sleep(1); \
    if ((++_sp & 255u) == 0u) { if (xb_ld(&(bar)[XB_TMO])) break; if (_sp > XB_SPIN_CAP) { atomicAdd(&(bar)[XB_TMO], 1u); break; } } } } while (0)

struct XcdBarrier {
    unsigned* bar; unsigned x;
    volatile LAS unsigned* st;
};

__device__ __forceinline__ XcdBarrier xcd_barrier_post(unsigned* bar, volatile LAS unsigned* st) {
    XcdBarrier b; b.bar = bar; b.x = xb_xcc_id(); b.st = st;
    if (threadIdx.x == 0) (void)xb_add(&bar[XB_XCNT(b.x)], 1u);
    return b;
}
__device__ __forceinline__ void xcd_barrier_complete(unsigned* bar, unsigned x, unsigned& nloc, unsigned& nx) {
    const unsigned G = gridDim.x * gridDim.y * gridDim.z;
    unsigned sum, cnt, mine, sp = 0u;
    for (;;) {
        sum = 0u; cnt = 0u; mine = 0u;
#pragma unroll
        for (unsigned j = 0; j < 16; ++j) { const unsigned c = xb_ld(&bar[XB_XCNT(j)]); sum += c; cnt += (c > 0u) ? 1u : 0u; mine = (j == x) ? c : mine; }
        if (sum == G) break;
        __builtin_amdgcn_s_sleep(1);
        if ((++sp & 255u) == 0u) { if (xb_ld(&bar[XB_TMO])) break; if (sp > XB_SPIN_CAP) { atomicAdd(&bar[XB_TMO], 1u); break; } }
    }
    nloc = mine > 0u ? mine : 1u; nx = cnt > 0u ? cnt : 1u;
}

__device__ __forceinline__ void xcd_barrier(const XcdBarrier& b) {
    asm volatile("s_waitcnt vmcnt(0)" ::: "memory");
    __syncthreads();
    if (threadIdx.x == 0) {
        unsigned* bar = b.bar;
        __builtin_amdgcn_s_waitcnt(0);
        unsigned nloc = b.st[0], nx = b.st[1];
        if (nloc == 0u) { xcd_barrier_complete(bar, b.x, nloc, nx); b.st[0] = nloc; b.st[1] = nx; }
        const unsigned old = xb_add(&bar[XB_XSUB(b.x)], 1u);
        const unsigned gen = old / nloc;
        if (old + 1u == (gen + 1u) * nloc) {
            __builtin_amdgcn_fence(__ATOMIC_RELEASE, "agent");
            asm volatile("s_waitcnt vmcnt(0)" ::: "memory");
            const unsigned og = xb_add(&bar[XB_TOP], 1u);
            const unsigned tg = og / nx;
            if (og + 1u == (tg + 1u) * nx) xb_add(&bar[XB_TOPGEN], 1u);
            else XB_SPIN(xb_ld(&bar[XB_TOPGEN]) == tg, bar);
            __builtin_amdgcn_fence(__ATOMIC_ACQUIRE, "agent");
            xb_add(&bar[XB_XGEN(b.x)], 1u);
            asm volatile("s_waitcnt vmcnt(0)" ::: "memory");
        } else {
            XB_SPIN(xb_ld(&bar[XB_XGEN(b.x)]) == gen, bar);
            __builtin_amdgcn_fence(__ATOMIC_ACQUIRE, "agent");
            asm volatile("s_waitcnt vmcnt(0)" ::: "memory");
        }
    }
    __syncthreads();
}


__device__ __forceinline__ void cnt_barrier(unsigned* cw, unsigned& k) {
    asm volatile("s_waitcnt vmcnt(0)" ::: "memory");
    __syncthreads();
    if (threadIdx.x == 0) {
        __builtin_amdgcn_fence(__ATOMIC_RELEASE, "agent");
        asm volatile("s_waitcnt vmcnt(0)" ::: "memory");
        const unsigned G = gridDim.x;
        const unsigned old = xb_add(cw, 1u);
        if (old == G * (k + 1u) - 1u) xb_add(cw + 64, 1u);
        else { unsigned sp = 0; while (xb_ld(cw + 64) == k) { __builtin_amdgcn_s_sleep(1);
                if ((++sp & 255u) == 0u) { if (xb_ld(cw + 128)) break; if (sp > XB_SPIN_CAP) { atomicAdd(cw + 128, 1u); break; } } } }
        __builtin_amdgcn_fence(__ATOMIC_ACQUIRE, "agent");
        asm volatile("s_waitcnt vmcnt(0)" ::: "memory");
    }
    ++k;
    __syncthreads();
}
__device__ __forceinline__ float bf_lo(unsigned w) { return __uint_as_float(w << 16); }
__device__ __forceinline__ float bf_hi(unsigned w) { return __uint_as_float(w & 0xffff0000u); }
__device__ __forceinline__ float bf2f(bf16 v) { return __uint_as_float(((unsigned)v) << 16); }
__device__ __forceinline__ unsigned f2bf(float f) { unsigned u = __float_as_uint(f); return (u + 0x7fffu + ((u >> 16) & 1u)) >> 16; }
__device__ __forceinline__ unsigned pk2(float lo, float hi) { unsigned r; asm("v_cvt_pk_bf16_f32 %0, %1, %2" : "=v"(r) : "v"(lo), "v"(hi)); return r; }
__device__ __forceinline__ float wave_sum(float v) {
#pragma unroll
    for (int o = 1; o < 64; o <<= 1) v += __shfl_xor(v, o);
    return v;
}
__device__ __forceinline__ float wave_max(float v) {
#pragma unroll
    for (int o = 1; o < 64; o <<= 1) v = fmaxf(v, __shfl_xor(v, o));
    return v;
}
__device__ __forceinline__ float sigmoidf_(float x) { return 1.0f / (1.0f + __expf(-x)); }
__device__ __forceinline__ float siluf_(float x) { return x / (1.0f + __expf(-x)); }
#define LDS_WAIT() asm volatile("s_waitcnt lgkmcnt(0)" ::: "memory")

struct Args { const float* in[25]; float* out; unsigned char* ws; int ph_lo, ph_hi; };
struct ArgsG { const GAS float* in[25]; GAS float* out; GAS unsigned char* ws;
    __device__ __forceinline__ const float* I(int i) const { return (const float*)in[i]; }
    __device__ __forceinline__ unsigned char* W() const { return (unsigned char*)ws; }
    __device__ __forceinline__ float* O() const { return (float*)out; } };

__device__ __forceinline__ int map_win(int n);
__device__ __forceinline__ int map_gu(int n);
template <int MAP>
__device__ __forceinline__ void transpose_item(const float* W, int K, int N, bf16* WT, LAS float* scr, int item, int nblk, int lane) {
    const int kb = item / nblk, nb = item % nblk, k0 = 64 * kb, n0 = 32 * nb;
    const int nd = n0 + (lane & 31); const int src = MAP == 1 ? map_win(nd) : (MAP == 2 ? map_gu(nd) : nd);
#pragma unroll 8
    for (int i = 0; i < 32; ++i) { const int kk = 2 * i + (lane >> 5); scr[kk * 33 + (lane & 31)] = src >= 0 ? W[(size_t)(k0 + kk) * N + src] : 0.0f; }
    LDS_WAIT();
    const int c = lane & 7;
#pragma unroll
    for (int j = 0; j < 4; ++j) { const int n = (lane >> 3) + 8 * j; const LAS float* s = scr + (8 * c) * 33 + n;
        u32x4 o; o.x = pk2(s[0 * 33], s[1 * 33]); o.y = pk2(s[2 * 33], s[3 * 33]); o.z = pk2(s[4 * 33], s[5 * 33]); o.w = pk2(s[6 * 33], s[7 * 33]);
        *(u32x4*)(WT + (size_t)(n0 + n) * K + k0 + 8 * c) = o; }
    LDS_WAIT();
}
__device__ __forceinline__ int map_win(int n) {
    if (n < 2048) return n;
    if (n < C_KV) return 2056 + (n - C_NQ);
    if (n < C_CU) return 2312 + (n - C_KV);
    if (n < C_A) return 2708 + (n - C_CU);
    if (n < C_B) return 2048 + (n - C_A);
    if (n < C_G) return 2052 + (n - C_B);
    if (n < C_G + 12) return 2696 + (n - C_G);
    return -1;
}
__device__ __forceinline__ int map_gu(int n) { const int pn = n >> 8, r = n & 255; return (r < 128 ? 0 : 1024) + 128 * pn + (r & 127); }

__device__ __forceinline__ void ph_prologue(const ArgsG& a, LAS unsigned char* lds, int gw, int NGW, int wave, int lane) {
    LAS float* scr = (LAS float*)(lds + wave * 16384);
    bf16* WinT = (bf16*)(a.W() + WS_WIN); bf16* WoutT = (bf16*)(a.W() + WS_WOUT); bf16* WguT = (bf16*)(a.W() + WS_WGU); bf16* WdT = (bf16*)(a.W() + WS_WD);
    constexpr int I_IN = 16 * (NP / 32), I_OUT = 16 * 32, I_GU = 16 * 64, I_D = 16 * 32;
    constexpr int N_IN = NLAYER * I_IN, N_OUT = NLAYER * I_OUT, N_GU = NLAYER * NE * I_GU, N_D = NLAYER * NE * I_D;
    for (int it = gw; it < N_IN + N_OUT + N_GU + N_D; it += NGW) {
        int r = it;
        if (r < N_IN) { const int l = r / I_IN; transpose_item<1>(a.I(2) + (size_t)l * DM * DIN, DM, DIN, WinT + (size_t)l * NP * DM, scr, r % I_IN, NP / 32, lane); continue; } r -= N_IN;
        if (r < N_OUT) { const int l = r / I_OUT; transpose_item<0>(a.I(16) + (size_t)l * DM * DM, DM, DM, WoutT + (size_t)l * DM * DM, scr, r % I_OUT, 32, lane); continue; } r -= N_OUT;
        if (r < N_GU) { const int le = r / I_GU; transpose_item<2>(a.I(20) + (size_t)le * DM * 2048, DM, 2048, WguT + (size_t)le * 2048 * DM, scr, r % I_GU, 64, lane); continue; } r -= N_GU;
        { const int le = r / I_D; transpose_item<0>(a.I(22) + (size_t)le * DM * DM, DM, DM, WdT + (size_t)le * DM * DM, scr, r % I_D, 32, lane); }
    }
    { bf16* W1T = (bf16*)(a.W() + WS_W1T);
        for (int it = gw; it < 4 * 128; it += NGW) { const int mtx = it >> 7; transpose_item<0>(a.I(10) + (size_t)mtx * 2048 * 128, 2048, 128, W1T + (size_t)mtx * 128 * 2048, scr, it & 127, 4, lane); }
        float* POSW = (float*)(a.W() + WS_POSW);
        for (int id = gw; id < 512; id += NGW) { const int mtx = id >> 7, nn_ = id & 127; const float* w1 = a.I(10) + (size_t)mtx * 2048 * 128; const float* pos = a.I(9) + (size_t)mtx * 2048; float acc = 0.f;
#pragma unroll 8
            for (int k = lane; k < 2048; k += 64) acc += pos[k] * w1[(size_t)k * 128 + nn_];
            acc = wave_sum(acc);
            if (lane == 0) POSW[id] = acc; } }
    { bf16* RWH = (bf16*)(a.W() + WS_RWH); bf16* RWL = (bf16*)(a.W() + WS_RWL);
        for (int i = gw * 64 + lane; i < NLAYER * NE * DM; i += NGW * 64) { const int d = i & (DM - 1), e = (i >> 10) & (NE - 1), l = i >> 15;
            const float w = a.I(18)[((size_t)l * DM + d) * NE + e]; const unsigned hi = f2bf(w); const float lo = w - __uint_as_float(hi << 16);
            RWH[i] = (bf16)hi; RWL[i] = (bf16)f2bf(lo); } }
    float* BT = (float*)(a.W() + WS_BT);
    for (int i = gw * 64 + lane; i < 4 * 2048; i += NGW * 64) {
        const int h = i >> 11, n = i & 2047; int bk;
        if (n < 16) bk = n; else { const float v = logf((float)n / 16.0f) / 2.0794415416798357f * 16.0f; bk = 16 + (int)v; bk = bk < 31 ? bk : 31; }
        BT[i] = a.I(24)[bk * 4 + h];
    }
}

__device__ __forceinline__ void rms_row_to_bf16(const f32x4 (&v)[4], const float* w, bf16* orow, int lane) {
    float s = 0.f;
#pragma unroll
    for (int j = 0; j < 4; ++j) s += (v[j].x * v[j].x + v[j].y * v[j].y) + (v[j].z * v[j].z + v[j].w * v[j].w);
    const float r = rsqrtf(wave_sum(s) * (1.0f / DM) + EPS);
#pragma unroll
    for (int j = 0; j < 4; ++j) { const f32x4 wv = *(const f32x4*)(w + 4 * (64 * j + lane)); const f32x4 y = v[j] * r * wv;
        u32x2 o; o.x = pk2(y.x, y.y); o.y = pk2(y.z, y.w); *(u32x2*)(orow + 4 * (64 * j + lane)) = o; }
}

__device__ __forceinline__ void ph_norm0(const ArgsG& a, int gw, int NGW, int lane) {
    bf16* XN = (bf16*)(a.W() + WS_XN);
    for (int tok = gw; tok < NT; tok += NGW) {
        f32x4 v[4];
#pragma unroll
        for (int j = 0; j < 4; ++j) v[j] = *(const f32x4*)(a.I(0) + (size_t)tok * DM + 4 * (64 * j + lane));
        rms_row_to_bf16(v, a.I(1), XN + (size_t)tok * DM, lane);
    }
}

__device__ __forceinline__ void ph_compress_mfma(const ArgsG& a, int l, LAS unsigned char* lds, int bid, int G, int tid, int wave, int lane) {
    LAS float* part = (LAS float*)lds;
    LAS float* hid = (LAS float*)(lds + 8 * 16 * 132 * 4);
    const bf16* P = (const bf16*)(a.W() + WS_P); bf16* KCMP = (bf16*)(a.W() + WS_KCMP); bf16* VCMP = (bf16*)(a.W() + WS_VCMP);
    const int r = lane & 15, q = lane >> 4;
    for (int u = bid; u < 128; u += G) {
        const int b = u >> 4, kv = (u >> 3) & 1, j0 = 16 * (u & 7);
        const bf16* arow = P + (size_t)(b * SEQ) * NP + C_KV + kv * 64;
        const bf16* brow = (const bf16*)(a.W() + WS_W1T) + ((size_t)(l * 2 + kv) * 128 + r) * 2048 + 8 * q;
        f32x4 acc[8];
#pragma unroll
        for (int nb = 0; nb < 8; ++nb) acc[nb] = (f32x4){0.f, 0.f, 0.f, 0.f};
#pragma unroll
        for (int s8 = 0; s8 < 8; ++s8) { const int ks = 8 * wave + s8; int tk = 16 * (j0 + r) + (ks >> 1); tk = tk < SEQ ? tk : SEQ - 1;
            const bf16x8 af = *(const bf16x8*)(arow + (size_t)tk * NP + (ks & 1) * 32 + 8 * q);
#pragma unroll
            for (int nb = 0; nb < 8; ++nb) acc[nb] = __builtin_amdgcn_mfma_f32_16x16x32_bf16(af, *(const bf16x8*)(brow + (size_t)(16 * nb) * 2048 + 32 * ks), acc[nb], 0, 0, 0); }
#pragma unroll
        for (int nb = 0; nb < 8; ++nb)
#pragma unroll
            for (int i = 0; i < 4; ++i) part[(wave * 16 + 4 * q + i) * 132 + 16 * nb + r] = acc[nb][i];
        __syncthreads();
        { const float* POSW = (const float*)(a.W() + WS_POSW) + (l * 2 + kv) * 128;
            for (int e = tid; e < 16 * 128; e += NTHR) { const int row = e >> 7, n = e & 127; float sacc = POSW[n];
#pragma unroll
                for (int w = 0; w < 8; ++w) sacc += part[(w * 16 + row) * 132 + n];
                hid[row * 132 + n] = siluf_(sacc); } }
        __syncthreads();
        { const int row = tid >> 5, c2 = tid & 31; const float* w2 = a.I(11) + (size_t)(l * 2 + kv) * 128 * 64; float o0 = 0.f, o1 = 0.f;
            for (int nn = 0; nn < 128; ++nn) { const float hv = hid[row * 132 + nn]; o0 += hv * w2[nn * 64 + 2 * c2]; o1 += hv * w2[nn * 64 + 2 * c2 + 1]; }
            if (kv == 0) { float ss = o0 * o0 + o1 * o1;
#pragma unroll
                for (int o_ = 1; o_ < 32; o_ <<= 1) ss += __shfl_xor(ss, o_);
                const float sc = rsqrtf(ss * (1.0f / 64.0f) + EPS); o0 *= sc * a.I(8)[l * 192 + 2 * c2]; o1 *= sc * a.I(8)[l * 192 + 2 * c2 + 1]; }
            const int j = j0 + row;
            *(unsigned*)((kv ? VCMP : KCMP) + (size_t)(b * 128 + j) * 64 + 2 * c2) = (j < 127) ? pk2(o0, o1) : 0u; }
        __syncthreads();
    }
}

__device__ __forceinline__ void ph_m1(const ArgsG& a, int l, LAS unsigned char* lds, int bid, int G, int tid, int wave, int lane) {
    const bf16* P = (const bf16*)(a.W() + WS_P);
    bf16* QN = (bf16*)(a.W() + WS_QN); bf16* KN = (bf16*)(a.W() + WS_KN); bf16* VC = (bf16*)(a.W() + WS_VC);
    bf16* KT = (bf16*)(a.W() + WS_KT); bf16* VT = (bf16*)(a.W() + WS_VT);
    float* Gb = (float*)(a.W() + WS_G); float* BETA = (float*)(a.W() + WS_BETA);
    bf16* NQ = (bf16*)(a.W() + WS_NQ); bf16* KS = (bf16*)(a.W() + WS_KS); bf16* KW = (bf16*)(a.W() + WS_KW); bf16* Y = (bf16*)(a.W() + WS_Y);
    const float* convw = a.I(3) + (size_t)l * 4 * 1536; const float* a_log = a.I(4) + l * 4; const float* dt_bias = a.I(5) + l * 4;
    const float* qnw = a.I(7) + l * 64; const float* knw = a.I(8) + l * 192;
    const float* dww = a.I(12) + (size_t)l * 31 * 256; const float* dwb = a.I(13) + l * 256; const float* lnw = a.I(14) + l * 256; const float* lnb = a.I(15) + l * 256;
    LAS float* dwl = (LAS float*)(lds + 65536);
    for (int i = tid; i < 31 * 256; i += NTHR) dwl[i] = dww[i];
    __syncthreads();
    for (int u = bid; u < NT / 64; u += G) {
        const int b = u >> 5, nchunk = u & 31, tw = nchunk * 64 + 8 * wave;
        const bf16* pw0 = P + (size_t)(b * SEQ + tw) * NP;
        { unsigned cx[11], nx[11]; float cw0[4], cw1[4], nw0[4], nw1[4];
#define DN_LOAD(idx, X, W0, W1) do { const int cb_ = ((idx) >> 2) * 512 + ((idx) & 3) * 128 + 2 * lane; \
            _Pragma("unroll") for (int j = 0; j < 4; ++j) { W0[j] = convw[j * 1536 + cb_]; W1[j] = convw[j * 1536 + cb_ + 1]; } \
            _Pragma("unroll") for (int j = 0; j < 3; ++j) { X[j] = 0u; if (tw - 3 + j >= 0) X[j] = *(const unsigned*)(pw0 + (ptrdiff_t)(j - 3) * NP + cb_); } \
            _Pragma("unroll") for (int i = 0; i < 8; ++i) X[3 + i] = *(const unsigned*)(pw0 + (size_t)i * NP + cb_); } while (0)
            DN_LOAD(0, cx, cw0, cw1);
#pragma unroll 1
            for (int idx = 0; idx < 12; ++idx) { const int ten = idx >> 2, h = idx & 3;
                if (idx + 1 < 12) DN_LOAD(idx + 1, nx, nw0, nw1);
                float xa[3] = {bf_lo(cx[0]), bf_lo(cx[1]), bf_lo(cx[2])}, xb[3] = {bf_hi(cx[0]), bf_hi(cx[1]), bf_hi(cx[2])};
                float ya[8], yb[8], sq[8];
#pragma unroll
                for (int i = 0; i < 8; ++i) { const unsigned w = cx[3 + i]; const float ca = bf_lo(w), cbv = bf_hi(w);
                    ya[i] = siluf_(cw0[0] * xa[0] + cw0[1] * xa[1] + cw0[2] * xa[2] + cw0[3] * ca); yb[i] = siluf_(cw1[0] * xb[0] + cw1[1] * xb[1] + cw1[2] * xb[2] + cw1[3] * cbv);
                    xa[0] = xa[1]; xa[1] = xa[2]; xa[2] = ca; xb[0] = xb[1]; xb[1] = xb[2]; xb[2] = cbv; sq[i] = ya[i] * ya[i] + yb[i] * yb[i]; }
                if (ten < 2) {
#pragma unroll
                    for (int o_ = 1; o_ < 64; o_ <<= 1) {
#pragma unroll
                        for (int i = 0; i < 8; ++i) sq[i] += __shfl_xor(sq[i], o_); }
                    const float qs_ = ten == 0 ? 0.08838834764831845f : 1.0f;
#pragma unroll
                    for (int i = 0; i < 8; ++i) { const float sc = rsqrtf(sq[i] + EPS) * qs_; ya[i] *= sc; yb[i] *= sc; } }
                unsigned pk[8];
#pragma unroll
                for (int i = 0; i < 8; ++i) pk[i] = pk2(ya[i], yb[i]);
                if (ten < 2) { bf16* dst = ten == 0 ? QN : KN;
#pragma unroll
                    for (int i = 0; i < 8; ++i) *(unsigned*)(dst + (size_t)(b * SEQ + tw + i) * 512 + h * 128 + 2 * lane) = pk[i]; }
                if (ten >= 1) {
                    bf16* tb = (ten == 1 ? KT : VT) + ((size_t)((b * 4 + h) * 32 + nchunk) * 128 + 2 * lane) * 64 + 8 * wave;
                    u32x4 lo, hi;
                    lo.x = (pk[0] & 0xffffu) | (pk[1] << 16); lo.y = (pk[2] & 0xffffu) | (pk[3] << 16); lo.z = (pk[4] & 0xffffu) | (pk[5] << 16); lo.w = (pk[6] & 0xffffu) | (pk[7] << 16);
                    hi.x = (pk[0] >> 16) | (pk[1] & 0xffff0000u); hi.y = (pk[2] >> 16) | (pk[3] & 0xffff0000u); hi.z = (pk[4] >> 16) | (pk[5] & 0xffff0000u); hi.w = (pk[6] >> 16) | (pk[7] & 0xffff0000u);
                    *(u32x4*)tb = lo; *(u32x4*)(tb + 64) = hi; }
#pragma unroll
                for (int j = 0; j < 11; ++j) cx[j] = nx[j];
#pragma unroll
                for (int j = 0; j < 4; ++j) { cw0[j] = nw0[j]; cw1[j] = nw1[j]; } }
#undef DN_LOAD
        }
        if (lane < 32) { const int i = lane >> 2, hd = lane & 3; const size_t tok = (size_t)(b * SEQ + tw + i); const bf16* prow = P + tok * NP;
            const float av = bf2f(prow[C_A + hd]), bv = bf2f(prow[C_B + hd]);
            BETA[tok * 4 + hd] = sigmoidf_(bv);
            const float x = av + dt_bias[hd]; const float sp = x > 20.0f ? x : log1pf(expf(x));
            Gb[tok * 4 + hd] = -expf(a_log[hd]) * sp; }
        { const float qw = qnw[lane] * (0.125f * 1.4426950408889634f), ksw = knw[64 + lane], kww = knw[128 + lane];
#pragma unroll 4
          for (int i = 0; i < 8; ++i) { const size_t tok = (size_t)(b * SEQ + tw + i); const bf16* prow = P + tok * NP;
            float xv[6];
#pragma unroll
            for (int h = 0; h < 4; ++h) xv[h] = bf2f(prow[C_NQ + h * 64 + lane]);
            xv[4] = bf2f(prow[C_KV + 128 + lane]); xv[5] = bf2f(prow[C_KV + 256 + lane]);
            float ss[6];
#pragma unroll
            for (int h = 0; h < 6; ++h) ss[h] = xv[h] * xv[h];
#pragma unroll
            for (int o_ = 1; o_ < 64; o_ <<= 1) {
#pragma unroll
                for (int h = 0; h < 6; ++h) ss[h] += __shfl_xor(ss[h], o_); }
#pragma unroll
            for (int h = 0; h < 4; ++h) NQ[tok * 256 + h * 64 + lane] = (bf16)f2bf(xv[h] * rsqrtf(ss[h] * (1.0f / 64.0f) + EPS) * qw);
            KS[tok * 64 + lane] = (bf16)f2bf(xv[4] * rsqrtf(ss[4] * (1.0f / 64.0f) + EPS) * ksw);
            KW[tok * 64 + lane] = (bf16)f2bf(xv[5] * rsqrtf(ss[5] * (1.0f / 64.0f) + EPS) * kww); } }
        { const int c = 4 * lane; f32x4 acc[8]; const f32x4 bias = *(const f32x4*)(dwb + c);
#pragma unroll
            for (int i = 0; i < 8; ++i) acc[i] = bias;
#pragma unroll 1
            for (int g8 = 0; g8 < 5; ++g8) { u32x2 av[8], gv[8];
#pragma unroll
                for (int rr = 0; rr < 8; ++rr) { const int r = 8 * g8 + rr; av[rr] = (u32x2){0u, 0u}; gv[rr] = (u32x2){0u, 0u};
                    if (r < 38 && tw - 30 + r >= 0) { const bf16* pr = pw0 + (ptrdiff_t)(r - 30) * NP + C_CU + c; av[rr] = *(const u32x2*)pr; gv[rr] = *(const u32x2*)(pr + 256); } }
#pragma unroll
                for (int rr = 0; rr < 8; ++rr) { const int r = 8 * g8 + rr;
                    f32x4 gl; gl.x = bf_lo(av[rr].x) * sigmoidf_(bf_lo(gv[rr].x)); gl.y = bf_hi(av[rr].x) * sigmoidf_(bf_hi(gv[rr].x)); gl.z = bf_lo(av[rr].y) * sigmoidf_(bf_lo(gv[rr].y)); gl.w = bf_hi(av[rr].y) * sigmoidf_(bf_hi(gv[rr].y));
#pragma unroll
                    for (int i = 0; i < 8; ++i) { const int j = r - i; if (j >= 0 && j <= 30) { const f32x4 w = *(const LAS f32x4*)(dwl + j * 256 + c); acc[i] += w * gl; } } } }
            const f32x4 lw = *(const f32x4*)(lnw + c), lb = *(const f32x4*)(lnb + c);
#pragma unroll
            for (int i = 0; i < 8; ++i) { const f32x4 x = acc[i]; const float mean = wave_sum((x.x + x.y) + (x.z + x.w)) * (1.0f / 256.0f);
                const f32x4 d = x - mean; const float var = wave_sum((d.x * d.x + d.y * d.y) + (d.z * d.z + d.w * d.w)) * (1.0f / 256.0f);
                const float rr = rsqrtf(var + EPS); const f32x4 y = d * rr * lw + lb;
                u32x2 o; o.x = pk2(siluf_(y.x), siluf_(y.y)); o.y = pk2(siluf_(y.z), siluf_(y.w));
                *(u32x2*)(Y + (size_t)(b * SEQ + tw + i) * DM + 768 + c) = o; } }
    }
}

constexpr int LM_PITCH = 68;
__device__ __forceinline__ void ph_dn_chunk_mfma(const ArgsG& a, LAS unsigned char* lds, int bid, int G, int tid, int wave, int lane) {
    LAS float* Lm = (LAS float*)lds;
    LAS float* gcl = (LAS float*)(lds + 4 * 64 * LM_PITCH * 4);
    LAS float* betal = gcl + 256; LAS float* bkl = betal + 256;
    const bf16* QN = (const bf16*)(a.W() + WS_QN); const bf16* KN = (const bf16*)(a.W() + WS_KN);
    const bf16* KT = (const bf16*)(a.W() + WS_KT); const bf16* VT = (const bf16*)(a.W() + WS_VT);
    const float* Gb = (const float*)(a.W() + WS_G); const float* BETA = (const float*)(a.W() + WS_BETA); float* GC = (float*)(a.W() + WS_GC);
    float* U = (float*)(a.W() + WS_U); bf16* W = (bf16*)(a.W() + WS_W); bf16* ATT = (bf16*)(a.W() + WS_ATT);
    const int n = lane & 31, hh = lane >> 5;
    for (int cb = bid; cb < 256; cb += G) {
        if (wave < 4) { const int b = cb >> 5, nn = cb & 31, h = wave, ci = (b * 4 + h) * 32 + nn, r0 = b * SEQ + nn * 64; (void)ci;
            float g = Gb[(size_t)(r0 + lane) * 4 + h];
#pragma unroll
            for (int off = 1; off < 64; off <<= 1) { const float v = __shfl_up(g, off); if (lane >= off) g += v; }
            const float be = BETA[(size_t)(r0 + lane) * 4 + h];
            gcl[wave * 64 + lane] = g; GC[(size_t)(r0 + lane) * 4 + h] = g; betal[wave * 64 + lane] = be; bkl[wave * 64 + lane] = be * __expf(g); }
        __syncthreads();
        { bf16x8 fa[8], fb[8], na[8], nb[8];
#define CH_LOAD(Q, FA, FB) do { const int id_ = 3 * wave + (Q), c_ = id_ / 6, wq_ = id_ % 6, isq_ = wq_ >= 3 ? 1 : 0, blk_ = wq_ % 3, ib_ = blk_ >= 1 ? 1 : 0, jb_ = blk_ == 2 ? 1 : 0; \
            const int b_ = cb >> 5, nn_ = cb & 31, r0_ = b_ * SEQ + nn_ * 64; \
            const bf16* ap_ = (isq_ ? QN : KN) + (size_t)(r0_ + 32 * ib_ + n) * 512 + c_ * 128 + 8 * hh; const bf16* bp_ = KN + (size_t)(r0_ + 32 * jb_ + n) * 512 + c_ * 128 + 8 * hh; \
            _Pragma("unroll") for (int ks = 0; ks < 8; ++ks) { FA[ks] = *(const bf16x8*)(ap_ + 16 * ks); FB[ks] = *(const bf16x8*)(bp_ + 16 * ks); } } while (0)
            CH_LOAD(0, fa, fb);
#pragma unroll 1
            for (int q = 0; q < 3; ++q) { const int id = 3 * wave + q, c = id / 6, wq = id % 6, isq = wq >= 3 ? 1 : 0, blk = wq % 3, ib = blk >= 1 ? 1 : 0, jb = blk == 2 ? 1 : 0;
                const int b = cb >> 5, nn = cb & 31, h = c, ci = (b * 4 + h) * 32 + nn;
                if (q + 1 < 3) CH_LOAD(q + 1, na, nb);
                f32x16 acc;
#pragma unroll
                for (int r = 0; r < 16; ++r) acc[r] = 0.f;
#pragma unroll
                for (int ks = 0; ks < 8; ++ks) acc = __builtin_amdgcn_mfma_f32_32x32x16_bf16(fa[ks], fb[ks], acc, 0, 0, 0);
                const int j = 32 * jb + n; const float gj = gcl[c * 64 + j];
#pragma unroll
                for (int r = 0; r < 16; ++r) { const int i = 32 * ib + (r & 3) + 8 * (r >> 2) + 4 * hh; const float dec = __expf(fminf(gcl[c * 64 + i] - gj, 0.f));
                    if (isq) ATT[(size_t)ci * 4096 + i * 64 + j] = (bf16)((j <= i) ? f2bf(acc[r] * dec) : 0u);
                    else Lm[c * 64 * LM_PITCH + i * LM_PITCH + j] = (j < i) ? betal[c * 64 + i] * acc[r] * dec : 0.f; }
#pragma unroll
                for (int ks = 0; ks < 8; ++ks) { fa[ks] = na[ks]; fb[ks] = nb[ks]; } }
#undef CH_LOAD
        }
        __syncthreads();
        if (wave < 4) { LAS float* L = Lm + wave * 64 * LM_PITCH; float T[64];
#pragma unroll
            for (int i = 0; i < 64; ++i) { float a0 = (i == lane) ? 1.f : 0.f, a1 = 0.f, a2 = 0.f, a3 = 0.f;
#pragma unroll
                for (int j4 = 0; j4 + 3 < i; j4 += 4) { const f32x4 lv = *(const LAS f32x4*)(L + i * LM_PITCH + j4);
                    a0 -= lv.x * T[j4]; a1 -= lv.y * T[j4 + 1]; a2 -= lv.z * T[j4 + 2]; a3 -= lv.w * T[j4 + 3]; }
#pragma unroll
                for (int j = (i / 4) * 4; j < i; ++j) a0 -= L[i * LM_PITCH + j] * T[j];
                T[i] = (a0 + a1) + (a2 + a3); }
#pragma unroll
            for (int i = 0; i < 64; ++i) L[i * LM_PITCH + lane] = T[i]; }
        __syncthreads();
        bf16x8 afc[4], afn[4];
#define CH2_LOAD(Q, F) do { const int id_ = wave * 4 + (Q), c_ = id_ >> 3, ten_ = (id_ >> 2) & 1, db_ = id_ & 3; const int ci_ = ((cb >> 5) * 4 + c_) * 32 + (cb & 31); \
            const bf16* ar_ = (ten_ ? KT : VT) + ((size_t)ci_ * 128 + 32 * db_ + n) * 64 + 8 * hh; _Pragma("unroll") for (int ks = 0; ks < 4; ++ks) F[ks] = *(const bf16x8*)(ar_ + 16 * ks); } while (0)
        CH2_LOAD(0, afc);
#pragma unroll 1
        for (int q = 0; q < 4; ++q) { const int id = wave * 4 + q, c = id >> 3, ten = (id >> 2) & 1, db = id & 3;
            if (q + 1 < 4) CH2_LOAD(q + 1, afn);
            const int b = cb >> 5, nn = cb & 31, h = c, ci = (b * 4 + h) * 32 + nn, r0 = b * SEQ + nn * 64;
            const LAS float* scl = (ten ? bkl : betal) + c * 64;
            const LAS float* L = Lm + c * 64 * LM_PITCH;
#pragma unroll
            for (int ib = 0; ib < 2; ++ib) { f32x16 acc;
#pragma unroll
                for (int r = 0; r < 16; ++r) acc[r] = 0.f;
#pragma unroll
                for (int ks = 0; ks < 4; ++ks) { if (ib == 0 && ks >= 2) continue;
                    const LAS float* tp = L + (32 * ib + n) * LM_PITCH + 16 * ks + 8 * hh;
                    const f32x4 t0 = *(const LAS f32x4*)tp, t1 = *(const LAS f32x4*)(tp + 4), s0 = *(const LAS f32x4*)(scl + 16 * ks + 8 * hh), s1 = *(const LAS f32x4*)(scl + 16 * ks + 8 * hh + 4);
                    u32x4 bw; bw.x = pg8::cvt_pk_bf16(t0.x * s0.x, t0.y * s0.y); bw.y = pg8::cvt_pk_bf16(t0.z * s0.z, t0.w * s0.w); bw.z = pg8::cvt_pk_bf16(t1.x * s1.x, t1.y * s1.y); bw.w = pg8::cvt_pk_bf16(t1.z * s1.z, t1.w * s1.w);
                    acc = __builtin_amdgcn_mfma_f32_32x32x16_bf16(afc[ks], __builtin_bit_cast(bf16x8, bw), acc, 0, 0, 0); }
                const size_t ob = (size_t)(r0 + 32 * ib + n) * 512 + h * 128 + 32 * db + 4 * hh;
#pragma unroll
                for (int rq = 0; rq < 4; ++rq) {
                    if (ten) { u32x2 w2; w2.x = pk2(acc[4 * rq], acc[4 * rq + 1]); w2.y = pk2(acc[4 * rq + 2], acc[4 * rq + 3]); *(u32x2*)(W + ob + 8 * rq) = w2; }
                    else *(f32x4*)(U + ob + 8 * rq) = (f32x4){acc[4 * rq], acc[4 * rq + 1], acc[4 * rq + 2], acc[4 * rq + 3]}; } }
#pragma unroll
            for (int ks = 0; ks < 4; ++ks) afc[ks] = afn[ks]; }
#undef CH2_LOAD
        __syncthreads();
    }
}

constexpr int SC_WP = 272, SC_AP = 144;
constexpr int SC_W = 0, SC_Q = 64 * SC_WP, SC_A = 2 * 64 * SC_WP, SC_K = SC_A + 64 * SC_AP, SC_GC = SC_K + 128 * SC_AP, SC_BUF = SC_GC + 1024;
static_assert(2 * SC_BUF <= RING_BYTES, "scan LDS");
struct ScanPf { u32x4 w[4], q[4], at[2], k[4]; float g, gl; };
__device__ __forceinline__ ScanPf scan_load(const bf16* W, const bf16* QN, const bf16* ATT, const bf16* KT, const float* GC, int r0, int h, int ci, int lt) {
    ScanPf p; const int row = lt >> 4, seg = lt & 15;
#pragma unroll
    for (int i = 0; i < 4; ++i) { const size_t go = (size_t)(r0 + row + 16 * i) * 512 + h * 128 + seg * 8; p.w[i] = *(const u32x4*)(W + go); p.q[i] = *(const u32x4*)(QN + go); }
#pragma unroll
    for (int i = 0; i < 2; ++i) p.at[i] = *(const u32x4*)(ATT + (size_t)ci * 4096 + (lt + 256 * i) * 8);
#pragma unroll
    for (int i = 0; i < 4; ++i) p.k[i] = *(const u32x4*)(KT + (size_t)ci * 8192 + (lt + 256 * i) * 8);
    p.g = GC[(size_t)(r0 + (lt & 63)) * 4 + h]; p.gl = GC[(size_t)(r0 + 63) * 4 + h]; return p;
}
__device__ __forceinline__ void scan_store(const ScanPf& p, LAS unsigned char* buf, int lt) {
    const int row = lt >> 4, seg = lt & 15;
#pragma unroll
    for (int i = 0; i < 4; ++i) { *(LAS u32x4*)(buf + SC_W + (row + 16 * i) * SC_WP + seg * 16) = p.w[i]; *(LAS u32x4*)(buf + SC_Q + (row + 16 * i) * SC_WP + seg * 16) = p.q[i]; }
#pragma unroll
    for (int i = 0; i < 2; ++i) *(LAS u32x4*)(buf + SC_A + ((lt >> 3) + 32 * i) * SC_AP + (lt & 7) * 16) = p.at[i];
#pragma unroll
    for (int i = 0; i < 4; ++i) *(LAS u32x4*)(buf + SC_K + ((lt >> 3) + 32 * i) * SC_AP + (lt & 7) * 16) = p.k[i];
    if (lt < 64) { LAS float* gp = (LAS float*)(buf + SC_GC); gp[lt] = __expf(p.g); gp[64 + lt] = __expf(p.gl - p.g); if (lt == 0) gp[128] = __expf(p.gl); }
}
__device__ __forceinline__ bf16x8 frag2(const LAS unsigned char* p) { const u32x2 lo = *(const LAS u32x2*)p, hi = *(const LAS u32x2*)(p + 16); const u32x4 v = {lo.x, lo.y, hi.x, hi.y}; return __builtin_bit_cast(bf16x8, v); }
__device__ __forceinline__ void ph_dn_scan_mfma(const ArgsG& a, LAS unsigned char* lds, int bid, int G, int tid, int wave, int lane) {
    const bf16* QN = (const bf16*)(a.W() + WS_QN); const bf16* KT = (const bf16*)(a.W() + WS_KT); const bf16* W = (const bf16*)(a.W() + WS_W); const bf16* ATT = (const bf16*)(a.W() + WS_ATT);
    const float* GC = (const float*)(a.W() + WS_GC); const float* U = (const float*)(a.W() + WS_U); float* O = (float*)(a.W() + WS_O);
    const int n = lane & 31, hh = lane >> 5;
    for (int u = bid; u < 32; u += G) {
        const int h = u & 3, b = u >> 2;
        f32x16 S[4];
#pragma unroll
        for (int k = 0; k < 4; ++k)
#pragma unroll
            for (int r = 0; r < 16; ++r) S[k][r] = 0.f;
        __syncthreads();
        if (wave >= 4) { const ScanPf p0 = scan_load(W, QN, ATT, KT, GC, b * SEQ, h, (b * 4 + h) * 32, tid - 256); scan_store(p0, lds, tid - 256); }
        __syncthreads();
#pragma unroll 1
        for (int nn = 0; nn < 32; ++nn) {
            const int r0 = b * SEQ + nn * 64; LAS unsigned char* buf = lds + (nn & 1) * SC_BUF; const LAS float* gp = (const LAS float*)(buf + SC_GC);
            if (wave >= 4) { if (nn + 1 < 32) { const ScanPf pf = scan_load(W, QN, ATT, KT, GC, r0 + 64, h, (b * 4 + h) * 32 + nn + 1, tid - 256); scan_store(pf, lds + ((nn + 1) & 1) * SC_BUF, tid - 256); } }
            else {
                const size_t ubase = (size_t)r0 * 512 + h * 128 + 32 * wave + n;
                f32x16 vn[2];
#pragma unroll
                for (int ib = 0; ib < 2; ++ib)
#pragma unroll
                    for (int r = 0; r < 16; ++r) vn[ib][r] = U[ubase + (size_t)(32 * ib + (r & 3) + 8 * (r >> 2) + 4 * hh) * 512];
                bf16x8 Sb[4][2];
#pragma unroll
                for (int k = 0; k < 4; ++k)
#pragma unroll
                    for (int s2 = 0; s2 < 2; ++s2) { u32x4 w4; w4.x = pg8::cvt_pk_bf16(S[k][8 * s2], S[k][8 * s2 + 1]); w4.y = pg8::cvt_pk_bf16(S[k][8 * s2 + 2], S[k][8 * s2 + 3]);
                        w4.z = pg8::cvt_pk_bf16(S[k][8 * s2 + 4], S[k][8 * s2 + 5]); w4.w = pg8::cvt_pk_bf16(S[k][8 * s2 + 6], S[k][8 * s2 + 7]); Sb[k][s2] = __builtin_bit_cast(bf16x8, w4); }
#pragma unroll
                for (int ib = 0; ib < 2; ++ib) { f32x16 acc;
#pragma unroll
                    for (int r = 0; r < 16; ++r) acc[r] = 0.f;
#pragma unroll
                    for (int k = 0; k < 4; ++k)
#pragma unroll
                        for (int s2 = 0; s2 < 2; ++s2) acc = __builtin_amdgcn_mfma_f32_32x32x16_bf16(frag2(buf + SC_W + (32 * ib + n) * SC_WP + (32 * k + 16 * s2 + 4 * hh) * 2), Sb[k][s2], acc, 0, 0, 0);
#pragma unroll
                    for (int r = 0; r < 16; ++r) vn[ib][r] -= acc[r]; }
                bf16x8 vb[2][2], vd[2][2];
#pragma unroll
                for (int jb = 0; jb < 2; ++jb)
#pragma unroll
                    for (int s2 = 0; s2 < 2; ++s2) { const f32x4 d0 = *(const LAS f32x4*)(gp + 64 + 32 * jb + 16 * s2 + 4 * hh), d1 = *(const LAS f32x4*)(gp + 64 + 32 * jb + 16 * s2 + 8 + 4 * hh);
                        const float* v = nullptr; (void)v; u32x4 w4, w5;
                        w4.x = pg8::cvt_pk_bf16(vn[jb][8 * s2], vn[jb][8 * s2 + 1]); w4.y = pg8::cvt_pk_bf16(vn[jb][8 * s2 + 2], vn[jb][8 * s2 + 3]);
                        w4.z = pg8::cvt_pk_bf16(vn[jb][8 * s2 + 4], vn[jb][8 * s2 + 5]); w4.w = pg8::cvt_pk_bf16(vn[jb][8 * s2 + 6], vn[jb][8 * s2 + 7]);
                        w5.x = pg8::cvt_pk_bf16(vn[jb][8 * s2] * d0.x, vn[jb][8 * s2 + 1] * d0.y); w5.y = pg8::cvt_pk_bf16(vn[jb][8 * s2 + 2] * d0.z, vn[jb][8 * s2 + 3] * d0.w);
                        w5.z = pg8::cvt_pk_bf16(vn[jb][8 * s2 + 4] * d1.x, vn[jb][8 * s2 + 5] * d1.y); w5.w = pg8::cvt_pk_bf16(vn[jb][8 * s2 + 6] * d1.z, vn[jb][8 * s2 + 7] * d1.w);
                        vb[jb][s2] = __builtin_bit_cast(bf16x8, w4); vd[jb][s2] = __builtin_bit_cast(bf16x8, w5); }
#pragma unroll
                for (int ib = 0; ib < 2; ++ib) { f32x16 acc;
#pragma unroll
                    for (int r = 0; r < 16; ++r) acc[r] = 0.f;
#pragma unroll
                    for (int k = 0; k < 4; ++k)
#pragma unroll
                        for (int s2 = 0; s2 < 2; ++s2) acc = __builtin_amdgcn_mfma_f32_32x32x16_bf16(frag2(buf + SC_Q + (32 * ib + n) * SC_WP + (32 * k + 16 * s2 + 4 * hh) * 2), Sb[k][s2], acc, 0, 0, 0);
#pragma unroll
                    for (int rq = 0; rq < 4; ++rq) { const f32x4 e4 = *(const LAS f32x4*)(gp + 32 * ib + 8 * rq + 4 * hh);
                        acc[4 * rq] *= e4.x; acc[4 * rq + 1] *= e4.y; acc[4 * rq + 2] *= e4.z; acc[4 * rq + 3] *= e4.w; }
#pragma unroll
                    for (int jb = 0; jb < 2; ++jb) { if (jb > ib) continue;
#pragma unroll
                        for (int s2 = 0; s2 < 2; ++s2) acc = __builtin_amdgcn_mfma_f32_32x32x16_bf16(frag2(buf + SC_A + (32 * ib + n) * SC_AP + (32 * jb + 16 * s2 + 4 * hh) * 2), vb[jb][s2], acc, 0, 0, 0); }
#pragma unroll
                    for (int r = 0; r < 16; ++r) O[ubase + (size_t)(32 * ib + (r & 3) + 8 * (r >> 2) + 4 * hh) * 512] = acc[r]; }
                const float egl = gp[128];
#pragma unroll
                for (int k = 0; k < 4; ++k) {
#pragma unroll
                    for (int r = 0; r < 16; ++r) S[k][r] *= egl;
#pragma unroll
                    for (int jb = 0; jb < 2; ++jb)
#pragma unroll
                        for (int s2 = 0; s2 < 2; ++s2) S[k] = __builtin_amdgcn_mfma_f32_32x32x16_bf16(frag2(buf + SC_K + (32 * k + n) * SC_AP + (32 * jb + 16 * s2 + 4 * hh) * 2), vd[jb][s2], S[k], 0, 0, 0); }
            }
            asm volatile("s_waitcnt lgkmcnt(0)" ::: "memory"); __builtin_amdgcn_s_barrier(); asm volatile("" ::: "memory");
        }
        __syncthreads();
    }
}

__device__ __forceinline__ void ph_dn_out(const ArgsG& a, int l, int gw, int NGW, int lane) {
    const float* O = (const float*)(a.W() + WS_O); const bf16* P = (const bf16*)(a.W() + WS_P); bf16* Y = (bf16*)(a.W() + WS_Y);
    const float* nw = a.I(6) + l * 128; const float n0 = nw[2 * lane], n1 = nw[2 * lane + 1];
    int tok = gw; if (tok >= NT) return;
    float oc[4][2], on[4][2]; unsigned zc[4], zn[4];
#pragma unroll
    for (int h = 0; h < 4; ++h) { oc[h][0] = O[(size_t)tok * 512 + h * 128 + 2 * lane]; oc[h][1] = O[(size_t)tok * 512 + h * 128 + 2 * lane + 1]; zc[h] = *(const unsigned*)(P + (size_t)tok * NP + C_Z + h * 128 + 2 * lane); }
#pragma unroll 1
    for (; tok < NT; tok += NGW) { const int tn = tok + NGW;
        if (tn < NT) {
#pragma unroll
            for (int h = 0; h < 4; ++h) { on[h][0] = O[(size_t)tn * 512 + h * 128 + 2 * lane]; on[h][1] = O[(size_t)tn * 512 + h * 128 + 2 * lane + 1]; zn[h] = *(const unsigned*)(P + (size_t)tn * NP + C_Z + h * 128 + 2 * lane); } }
        float ss[4];
#pragma unroll
        for (int h = 0; h < 4; ++h) ss[h] = oc[h][0] * oc[h][0] + oc[h][1] * oc[h][1];
#pragma unroll
        for (int o_ = 1; o_ < 64; o_ <<= 1) {
#pragma unroll
            for (int h = 0; h < 4; ++h) ss[h] += __shfl_xor(ss[h], o_); }
#pragma unroll
        for (int h = 0; h < 4; ++h) { const float r = rsqrtf(ss[h] * (1.0f / 128.0f) + EPS);
            *(unsigned*)(Y + (size_t)tok * DM + h * 128 + 2 * lane) = pk2(oc[h][0] * r * n0 * siluf_(bf_lo(zc[h])), oc[h][1] * r * n1 * siluf_(bf_hi(zc[h]))); }
#pragma unroll
        for (int h = 0; h < 4; ++h) { oc[h][0] = on[h][0]; oc[h][1] = on[h][1]; zc[h] = zn[h]; } }
}

constexpr int NSA_KT_PITCH = 144, NSA_VT_PITCH = 136;
struct NsaStage { u32x4 kv, vv; };
__device__ __forceinline__ NsaStage nsa_load(const bf16* Kbase, int kpitch, const bf16* Vbase, int vpitch, int tid) {
    const int key = tid >> 3, seg = tid & 7; NsaStage s;
    s.kv = *(const u32x4*)(Kbase + (size_t)key * kpitch + seg * 8); s.vv = *(const u32x4*)(Vbase + (size_t)key * vpitch + seg * 8); return s;
}
__device__ __forceinline__ void nsa_store(const NsaStage& s, LAS unsigned char* Kt, LAS unsigned char* Vt, int tid) {
    const int key = tid >> 3, seg = tid & 7;
    *(LAS u32x4*)(Kt + key * NSA_KT_PITCH + seg * 16) = s.kv;
#pragma unroll
    for (int i = 0; i < 4; ++i) { const unsigned w = s.vv[i];
        *(LAS unsigned short*)(Vt + (seg * 8 + 2 * i) * NSA_VT_PITCH + key * 2) = (unsigned short)(w & 0xffffu);
        *(LAS unsigned short*)(Vt + (seg * 8 + 2 * i + 1) * NSA_VT_PITCH + key * 2) = (unsigned short)(w >> 16); }
}
__device__ __forceinline__ void nsa_st(const LAS unsigned char* Kt, const bf16x8 (&qf)[4], int n, int hh, f32x16 (&s)[2]) {
#pragma unroll
    for (int kb = 0; kb < 2; ++kb) {
#pragma unroll
        for (int r = 0; r < 16; ++r) s[kb][r] = 0.f;
#pragma unroll
        for (int ks = 0; ks < 4; ++ks) { const bf16x8 af = *(const LAS bf16x8*)(Kt + (kb * 32 + n) * NSA_KT_PITCH + (16 * ks + 8 * hh) * 2);
            s[kb] = __builtin_amdgcn_mfma_f32_32x32x16_bf16(af, qf[ks], s[kb], 0, 0, 0); } }
}
__device__ __forceinline__ void nsa_pvm(const LAS unsigned char* Vt, const bf16x8 (&pf)[2][2], int n, int hh, f32x16 (&o)[2]) {
#pragma unroll
    for (int db = 0; db < 2; ++db)
#pragma unroll
        for (int kb = 0; kb < 2; ++kb)
#pragma unroll
            for (int s2 = 0; s2 < 2; ++s2) { const LAS unsigned char* p = Vt + (db * 32 + n) * NSA_VT_PITCH + (kb * 32 + 16 * s2 + 4 * hh) * 2;
                const u32x2 lo = *(const LAS u32x2*)p, hi = *(const LAS u32x2*)(p + 16);
                const u32x4 av = {lo.x, lo.y, hi.x, hi.y};
                o[db] = __builtin_amdgcn_mfma_f32_32x32x16_bf16(__builtin_bit_cast(bf16x8, av), pf[kb][s2], o[db], 0, 0, 0); }
}
__device__ __forceinline__ void nsa_pack(const f32x16 (&p)[2], bf16x8 (&pf)[2][2]) {
#pragma unroll
    for (int kb = 0; kb < 2; ++kb)
#pragma unroll
        for (int s2 = 0; s2 < 2; ++s2) { u32x4 w;
            w.x = pg8::cvt_pk_bf16(p[kb][8 * s2 + 0], p[kb][8 * s2 + 1]); w.y = pg8::cvt_pk_bf16(p[kb][8 * s2 + 2], p[kb][8 * s2 + 3]);
            w.z = pg8::cvt_pk_bf16(p[kb][8 * s2 + 4], p[kb][8 * s2 + 5]); w.w = pg8::cvt_pk_bf16(p[kb][8 * s2 + 6], p[kb][8 * s2 + 7]);
            pf[kb][s2] = __builtin_bit_cast(bf16x8, w); }
}
constexpr int BT2_ROWS = 2048 + 72;
template <bool COLSEL>
__device__ __forceinline__ void nsa_tile_mfma(const LAS unsigned char* Kt, const LAS unsigned char* Vt, const LAS float* btl2h, const bf16x8 (&qf)[4], int n, int hh,
                                              int key0, int tq, bool masked, bool colsel, int maxd, float& m, float& l, f32x16 (&o)[2]) {
    f32x16 s[2]; nsa_st(Kt, qf, n, hh, s);
    const int dbase = tq - key0 - 4 * hh;
    const LAS float* bp = btl2h + (2047 - dbase) * 4;
#pragma unroll
    for (int kb = 0; kb < 2; ++kb)
#pragma unroll
        for (int r = 0; r < 16; ++r) { const int cst = kb * 32 + (r & 3) + 8 * (r >> 2); const float x = s[kb][r] + bp[cst * 4]; s[kb][r] = (!COLSEL || colsel) ? x : -3.0e38f; }
    if (masked) {
#pragma unroll
        for (int kb = 0; kb < 2; ++kb)
#pragma unroll
            for (int r = 0; r < 16; ++r) { const int dist = dbase - (kb * 32 + (r & 3) + 8 * (r >> 2)); s[kb][r] = (dist >= 0 && dist <= maxd) ? s[kb][r] : -3.0e38f; } }
    float tmax = -3.0e38f;
#pragma unroll
    for (int kb = 0; kb < 2; ++kb)
#pragma unroll
        for (int r = 0; r < 16; ++r) tmax = fmaxf(tmax, s[kb][r]);
    tmax = fmaxf(tmax, __shfl_xor(tmax, 32));
    const float mn = fmaxf(m, tmax); float rs = 0.f;
#pragma unroll
    for (int kb = 0; kb < 2; ++kb)
#pragma unroll
        for (int r = 0; r < 16; ++r) { const float p = __builtin_amdgcn_exp2f(s[kb][r] - mn); s[kb][r] = p; rs += p; }
    rs += __shfl_xor(rs, 32);
    if (__any(mn > m)) { const float corr = __builtin_amdgcn_exp2f(m - mn); l *= corr;
#pragma unroll
        for (int db = 0; db < 2; ++db)
#pragma unroll
            for (int r = 0; r < 16; ++r) o[db][r] *= corr; }
    l += rs; m = mn;
    bf16x8 pf[2][2]; nsa_pack(s, pf);
    nsa_pvm(Vt, pf, n, hh, o);
}

__device__ __forceinline__ void ph_nsa_mfma(const ArgsG& a, LAS unsigned char* lds, int ubeg, int ustep, int uend, int tid, int wave, int lane) {
    LAS float* btl2 = (LAS float*)lds;
    constexpr int NSA_L0 = BT2_ROWS * 16;
    LAS unsigned char* Kt = lds + NSA_L0;
    LAS unsigned char* Vt = lds + NSA_L0 + 9216;
    constexpr int NSA_TB = 9216 + 8704;
    LAS float* PS = (LAS float*)(lds + NSA_L0 + 2 * NSA_TB + 256);
    LAS unsigned* MK = (LAS unsigned*)(lds + NSA_L0 + 2 * NSA_TB + 256 + 64 * 129 * 4);
    static_assert(NSA_L0 + 2 * NSA_TB + 256 + 64 * 129 * 4 + 512 <= RING_BYTES, "NSA LDS");
    const float* BT = (const float*)(a.W() + WS_BT);
    for (int i = tid; i < BT2_ROWS * 4; i += NTHR) { const int row = i >> 2, hd = i & 3; btl2[i] = row < 2048 ? BT[hd * 2048 + (2047 - row)] * 1.4426950408889634f : 0.f; }
    const bf16* P = (const bf16*)(a.W() + WS_P); const bf16* NQ = (const bf16*)(a.W() + WS_NQ);
    const bf16* KS = (const bf16*)(a.W() + WS_KS); const bf16* KW = (const bf16*)(a.W() + WS_KW);
    const bf16* KCMP = (const bf16*)(a.W() + WS_KCMP); const bf16* VCMP = (const bf16*)(a.W() + WS_VCMP); bf16* Y = (bf16*)(a.W() + WS_Y);
    const int n = lane & 31, hh = lane >> 5, tl = n >> 2, h = n & 3;
    const LAS float* btl2h = btl2 + h;
    __syncthreads();
    for (int u = ubeg; u < uend; u += ustep) {
        const int b = u & 7, qt = 31 - (u >> 3), t0 = 64 * qt, tq = t0 + 8 * wave + tl, tok = b * SEQ + tq;
        bf16x8 qf[4];
#pragma unroll
        for (int ks = 0; ks < 4; ++ks) qf[ks] = *(const bf16x8*)(NQ + (size_t)tok * 256 + h * 64 + 16 * ks + 8 * hh);
        float gate[3];
#pragma unroll
        for (int br = 0; br < 3; ++br) gate[br] = sigmoidf_(bf2f(P[(size_t)tok * NP + C_G + h * 3 + br]));
        f32x16 yacc[2];
        {
            float mx = -1e30f, rs = 0.f;
#pragma unroll 1
            for (int ct = 0; ct < 2; ++ct) {
                __syncthreads();
                { const NsaStage st = nsa_load(KCMP + (size_t)(b * 128 + ct * 64) * 64, 64, VCMP + (size_t)(b * 128 + ct * 64) * 64, 64, tid); nsa_store(st, Kt, Vt, tid); }
                __syncthreads();
                f32x16 sc[2]; nsa_st(Kt, qf, n, hh, sc);
                float tmax = -1e30f;
#pragma unroll
                for (int kb = 0; kb < 2; ++kb)
#pragma unroll
                    for (int r = 0; r < 16; ++r) { const int j = ct * 64 + kb * 32 + (r & 3) + 8 * (r >> 2) + 4 * hh; const int dist = tq - 16 * j - 31;
                        const float x = sc[kb][r] + btl2h[(2047 - (dist < 0 ? 0 : dist)) * 4]; sc[kb][r] = dist >= 0 ? x : -1e30f; tmax = fmaxf(tmax, sc[kb][r]); }
                tmax = fmaxf(tmax, __shfl_xor(tmax, 32));
                const float mn = fmaxf(mx, tmax); float ts = 0.f;
#pragma unroll
                for (int kb = 0; kb < 2; ++kb)
#pragma unroll
                    for (int r = 0; r < 16; ++r) { const float x = sc[kb][r]; ts += x > -1e29f ? __builtin_amdgcn_exp2f(x - mn) : 0.f; }
                ts += __shfl_xor(ts, 32);
                rs = rs * __builtin_amdgcn_exp2f(mx - mn) + ts; mx = mn;
            }
            const float inv = rs > 0.f ? 1.0f / rs : 0.f;
            f32x16 o[2];
#pragma unroll
            for (int db = 0; db < 2; ++db)
#pragma unroll
                for (int r = 0; r < 16; ++r) o[db][r] = 0.f;
#pragma unroll 1
            for (int cc = 0; cc < 2; ++cc) { const int ct = 1 - cc;
                if (cc == 1) { __syncthreads();
                    { const NsaStage st = nsa_load(KCMP + (size_t)(b * 128) * 64, 64, VCMP + (size_t)(b * 128) * 64, 64, tid); nsa_store(st, Kt, Vt, tid); }
                    __syncthreads(); }
                f32x16 sc[2]; nsa_st(Kt, qf, n, hh, sc);
#pragma unroll
                for (int kb = 0; kb < 2; ++kb)
#pragma unroll
                    for (int r = 0; r < 16; ++r) { const int j = ct * 64 + kb * 32 + (r & 3) + 8 * (r >> 2) + 4 * hh; const int dist = tq - 16 * j - 31;
                        const float x = sc[kb][r] + btl2h[(2047 - (dist < 0 ? 0 : dist)) * 4]; const float p = dist >= 0 ? __builtin_amdgcn_exp2f(x - mx) * inv : 0.f; sc[kb][r] = p;
                        float v = p; v += __shfl_xor(v, 1); v += __shfl_xor(v, 2);
                        if (h == 0) PS[(8 * wave + tl) * 129 + j] = v; }
                bf16x8 pf[2][2]; nsa_pack(sc, pf); nsa_pvm(Vt, pf, n, hh, o);
            }
#pragma unroll
            for (int db = 0; db < 2; ++db)
#pragma unroll
                for (int r = 0; r < 16; ++r) yacc[db][r] = gate[0] * o[db][r];
        }
        LDS_WAIT();
        for (int t2 = 0; t2 < 8; ++t2) {
            const int tqq = t0 + 8 * wave + t2, sb = lane & 31, cur = tqq >> 6; const LAS float* row = PS + (8 * wave + t2) * 129; float imp = 0.f;
#pragma unroll
            for (int dj = -1; dj <= 3; ++dj) { const int j = 4 * sb + dj; if (j >= 0 && j <= 126) imp += row[j]; }
            if (sb > cur) imp = -1.0f; else if (sb == 0 || sb == cur || sb == cur - 1) imp = 1e4f;
            int rank = 0;
            for (int s2 = 0; s2 < 32; ++s2) { const float v2 = __shfl(imp, s2); rank += (v2 > imp || (v2 == imp && s2 < sb)) ? 1 : 0; }
            const unsigned msk = (unsigned)__ballot((lane < 32) && (rank < 16) && (sb <= cur));
            if (lane == 0) MK[8 * wave + t2] = msk;
        }
        __syncthreads();
        unsigned anymask, wmask; const unsigned mymask = MK[8 * wave + tl];
        { unsigned v = MK[lane];
#pragma unroll
            for (int o_ = 1; o_ < 64; o_ <<= 1) v |= (unsigned)__shfl_xor((int)v, o_);
            anymask = (unsigned)__builtin_amdgcn_readfirstlane((int)v);
            unsigned w = MK[8 * wave + (lane & 7)]; w |= (unsigned)__shfl_xor((int)w, 1); w |= (unsigned)__shfl_xor((int)w, 2); w |= (unsigned)__shfl_xor((int)w, 4);
            wmask = (unsigned)__builtin_amdgcn_readfirstlane((int)w); }
        LAS unsigned* stash = (LAS unsigned*)PS + (wave * 16) * 64 + lane;
        __syncthreads();
#pragma unroll
        for (int db = 0; db < 2; ++db)
#pragma unroll
            for (int k = 0; k < 8; ++k) stash[(db * 8 + k) * 64] = pk2(yacc[db][2 * k], yacc[db][2 * k + 1]);
        {
            float m = -1e30f, l = 0.f; f32x16 o[2];
#pragma unroll
            for (int db = 0; db < 2; ++db)
#pragma unroll
                for (int r = 0; r < 16; ++r) o[db][r] = 0.f;
            unsigned mk = anymask; NsaStage s0, s1; bool h1 = false;
            { const int sa = __builtin_ctz(mk); s0 = nsa_load(KS + (size_t)(b * SEQ + 64 * sa) * 64, 64, P + (size_t)(b * SEQ + 64 * sa) * NP + C_KV + 192, NP, tid);
              unsigned m2 = mk & (mk - 1u); if (m2) { const int sb2 = __builtin_ctz(m2); s1 = nsa_load(KS + (size_t)(b * SEQ + 64 * sb2) * 64, 64, P + (size_t)(b * SEQ + 64 * sb2) * NP + C_KV + 192, NP, tid); h1 = true; } }
            __syncthreads();
            nsa_store(s0, Kt, Vt, tid);
            __syncthreads();
            int par = 0;
            while (mk) {
                const int sblk = __builtin_ctz(mk); mk &= mk - 1u;
                if (h1) { nsa_store(s1, Kt + (par ^ 1) * NSA_TB, Vt + (par ^ 1) * NSA_TB, tid);
                    const unsigned m3 = mk & (mk - 1u);
                    if (m3) { const int sc2 = __builtin_ctz(m3); s1 = nsa_load(KS + (size_t)(b * SEQ + 64 * sc2) * 64, 64, P + (size_t)(b * SEQ + 64 * sc2) * NP + C_KV + 192, NP, tid); } else h1 = false; }
                if ((wmask >> sblk) & 1u) nsa_tile_mfma<true>(Kt + par * NSA_TB, Vt + par * NSA_TB, btl2h, qf, n, hh, 64 * sblk, tq, 64 * sblk + 63 > t0 + 8 * wave, ((mymask >> sblk) & 1u) != 0u, 1 << 30, m, l, o);
                asm volatile("s_waitcnt lgkmcnt(0)" ::: "memory"); __builtin_amdgcn_s_barrier(); asm volatile("" ::: "memory");
                par ^= 1;
            }
            const float inv = l > 0.f ? gate[1] / l : 0.f;
#pragma unroll
            for (int db = 0; db < 2; ++db)
#pragma unroll
                for (int k = 0; k < 8; ++k) { const unsigned w = stash[(db * 8 + k) * 64]; stash[(db * 8 + k) * 64] = pk2(bf_lo(w) + inv * o[db][2 * k], bf_hi(w) + inv * o[db][2 * k + 1]); }
        }
        {
            float m = -1e30f, l = 0.f; f32x16 o[2];
#pragma unroll
            for (int db = 0; db < 2; ++db)
#pragma unroll
                for (int r = 0; r < 16; ++r) o[db][r] = 0.f;
            const int kt0 = (t0 - 511 > 0 ? t0 - 511 : 0) >> 6;
            NsaStage s0 = nsa_load(KW + (size_t)(b * SEQ + 64 * kt0) * 64, 64, P + (size_t)(b * SEQ + 64 * kt0) * NP + C_KV + 320, NP, tid), s1;
            if (kt0 < qt) s1 = nsa_load(KW + (size_t)(b * SEQ + 64 * (kt0 + 1)) * 64, 64, P + (size_t)(b * SEQ + 64 * (kt0 + 1)) * NP + C_KV + 320, NP, tid);
            __syncthreads();
            nsa_store(s0, Kt, Vt, tid);
            __syncthreads();
            int par = 0;
            for (int kt = kt0; kt <= qt; ++kt) {
                if (kt < qt) { nsa_store(s1, Kt + (par ^ 1) * NSA_TB, Vt + (par ^ 1) * NSA_TB, tid);
                    if (kt + 2 <= qt) s1 = nsa_load(KW + (size_t)(b * SEQ + 64 * (kt + 2)) * 64, 64, P + (size_t)(b * SEQ + 64 * (kt + 2)) * NP + C_KV + 320, NP, tid); }
                nsa_tile_mfma<false>(Kt + par * NSA_TB, Vt + par * NSA_TB, btl2h, qf, n, hh, 64 * kt, tq, !(64 * kt + 63 <= t0 + 8 * wave && t0 + 8 * wave + 7 - 64 * kt <= 511), true, 511, m, l, o);
                asm volatile("s_waitcnt lgkmcnt(0)" ::: "memory"); __builtin_amdgcn_s_barrier(); asm volatile("" ::: "memory");
                par ^= 1;
            }
            const float inv = l > 0.f ? gate[2] / l : 0.f;
#pragma unroll
            for (int db = 0; db < 2; ++db)
#pragma unroll
                for (int k = 0; k < 8; ++k) { const unsigned w = stash[(db * 8 + k) * 64]; yacc[db][2 * k] = bf_lo(w) + inv * o[db][2 * k]; yacc[db][2 * k + 1] = bf_hi(w) + inv * o[db][2 * k + 1]; }
        }
#pragma unroll
        for (int db = 0; db < 2; ++db)
#pragma unroll
            for (int rq = 0; rq < 4; ++rq) { u32x2 w; w.x = pk2(yacc[db][4 * rq], yacc[db][4 * rq + 1]); w.y = pk2(yacc[db][4 * rq + 2], yacc[db][4 * rq + 3]);
                *(u32x2*)(Y + (size_t)tok * DM + 512 + h * 64 + db * 32 + 8 * rq + 4 * hh) = w; }
        __syncthreads();
    }
}

constexpr int RT_PITCH = 2064;
__device__ __forceinline__ void ph_router(const ArgsG& a, int l, const float* Xin_, const bf16* Dm, LAS unsigned char* lds, int bid, int G, int tid, int wave, int lane) {
    LAS unsigned char* Ht = lds;
    LAS float* LG = (LAS float*)(lds + 32 * RT_PITCH);
    LAS int* lcnt = (LAS int*)(lds + 32 * RT_PITCH + 4 * 64 * 33 * 4); LAS int* asg_e = lcnt + 32; LAS int* asg_p = asg_e + 256; LAS float* asg_w = (LAS float*)(asg_p + 256); LAS int* gbase = (LAS int*)(asg_w + 256);
    bf16* H2 = (bf16*)(a.W() + WS_XN); unsigned* cnt = (unsigned*)(a.W() + WS_CTL) + CW_CNT + 64 * l;
    int* EIDX = (int*)(a.W() + WS_EIDX); int* EPOS = (int*)(a.W() + WS_EPOS); float* EW = (float*)(a.W() + WS_EW); int* POSTOK = (int*)(a.W() + WS_XS);
    const float* fw = a.I(17) + (size_t)l * DM; const float* rb = a.I(19) + l * NE;
    const bf16* RWH = (const bf16*)(a.W() + WS_RWH) + (size_t)l * NE * DM; const bf16* RWL = (const bf16*)(a.W() + WS_RWL) + (size_t)l * NE * DM;
    for (int u = bid; u < NT / 64; u += G) {
        const int tok0 = u * 64;
        if (tid < 32) lcnt[tid] = 0;
#pragma unroll 1
        for (int hf = 0; hf < 2; ++hf) {
            __syncthreads();
#pragma unroll 1
            for (int i = 0; i < 4; ++i) { const int tl = 4 * wave + i, tok = tok0 + 32 * hf + tl;
                f32x4 v[4]; float ss = 0.f;
#pragma unroll
                for (int j = 0; j < 4; ++j) { v[j] = *(const f32x4*)(Xin_ + (size_t)tok * DM + 4 * (64 * j + lane)); const u32x2 dd = *(const u32x2*)(Dm + (size_t)tok * DM + 4 * (64 * j + lane));
                    v[j].x += bf_lo(dd.x); v[j].y += bf_hi(dd.x); v[j].z += bf_lo(dd.y); v[j].w += bf_hi(dd.y); ss += (v[j].x * v[j].x + v[j].y * v[j].y) + (v[j].z * v[j].z + v[j].w * v[j].w); }
                const float r = rsqrtf(wave_sum(ss) * (1.0f / DM) + EPS);
#pragma unroll
                for (int j = 0; j < 4; ++j) { const f32x4 y = v[j] * r * *(const f32x4*)(fw + 4 * (64 * j + lane));
                    u32x2 o; o.x = pk2(y.x, y.y); o.y = pk2(y.z, y.w); *(u32x2*)(H2 + (size_t)tok * DM + 4 * (64 * j + lane)) = o;
                    *(LAS u32x2*)(Ht + tl * RT_PITCH + 8 * (64 * j + lane)) = o; } }
            __syncthreads();
            { const int r = lane & 15, q = lane >> 4, tile = wave & 1, kq = wave >> 1; f32x4 acc0 = {0.f, 0.f, 0.f, 0.f}, acc1 = {0.f, 0.f, 0.f, 0.f};
                const LAS unsigned char* arow = Ht + (16 * tile + r) * RT_PITCH + q * 16;
                const bf16* bh = RWH + (size_t)r * DM + 8 * q; const bf16* bl = RWL + (size_t)r * DM + 8 * q;
#pragma unroll
                for (int s8 = 0; s8 < 8; ++s8) { const int s = 8 * kq + s8; const bf16x8 af = *(const LAS bf16x8*)(arow + s * 64);
                    acc0 = __builtin_amdgcn_mfma_f32_16x16x32_bf16(af, *(const bf16x8*)(bh + 32 * s), acc0, 0, 0, 0); acc0 = __builtin_amdgcn_mfma_f32_16x16x32_bf16(af, *(const bf16x8*)(bl + 32 * s), acc0, 0, 0, 0);
                    acc1 = __builtin_amdgcn_mfma_f32_16x16x32_bf16(af, *(const bf16x8*)(bh + 16 * DM + 32 * s), acc1, 0, 0, 0); acc1 = __builtin_amdgcn_mfma_f32_16x16x32_bf16(af, *(const bf16x8*)(bl + 16 * DM + 32 * s), acc1, 0, 0, 0); }
                const float b0 = kq == 0 ? rb[r] : 0.f, b1 = kq == 0 ? rb[16 + r] : 0.f;
#pragma unroll
                for (int i = 0; i < 4; ++i) { LAS float* lg = LG + kq * (64 * 33) + (32 * hf + 16 * tile + 4 * q + i) * 33; lg[r] = acc0[i] + b0; lg[16 + r] = acc1[i] + b1; } }
        }
        __syncthreads();
        if (tid < 64) { const LAS float* lg = LG + tid * 33; unsigned used = 0u; float tv[4]; int ti[4];
#pragma unroll
            for (int qn = 0; qn < 4; ++qn) { float best = -3.0e38f; int bi = 0;
                for (int e = 0; e < NE; ++e) { const float v = ((lg[e] + lg[64 * 33 + e]) + lg[2 * 64 * 33 + e]) + lg[3 * 64 * 33 + e]; if (!((used >> e) & 1u) && v > best) { best = v; bi = e; } }
                used |= 1u << bi; tv[qn] = best; ti[qn] = bi; }
            float ew[4], es = 0.f;
#pragma unroll
            for (int qn = 0; qn < 4; ++qn) { ew[qn] = __expf(tv[qn] - tv[0]); es += ew[qn]; }
#pragma unroll
            for (int qn = 0; qn < 4; ++qn) { const int p = __hip_atomic_fetch_add(&lcnt[ti[qn]], 1, __ATOMIC_RELAXED, __HIP_MEMORY_SCOPE_WORKGROUP); asg_e[tid * 4 + qn] = ti[qn]; asg_p[tid * 4 + qn] = p; asg_w[tid * 4 + qn] = ew[qn] / es; } }
        __syncthreads();
        if (tid < 32) gbase[tid] = (int)atomicAdd(&cnt[tid], (unsigned)lcnt[tid]);
        __syncthreads();
        if (tid < 256) { const int tok = tok0 + (tid >> 2), k = tid & 3, e = asg_e[tid];
            const int pos = gbase[e] + asg_p[tid];
            EIDX[(size_t)tok * 4 + k] = e; EPOS[(size_t)tok * 4 + k] = pos; EW[(size_t)tok * 4 + k] = asg_w[tid]; POSTOK[(size_t)e * NT + pos] = tok; }
        __syncthreads();
    }
}

__device__ __forceinline__ void build_tiles(const unsigned* cnt, LAS int* TS, LAS int* TE, int tid) {
    if (tid < 64) {
        const int e = tid & 31; const int nt = (int)((cnt[e] + 255u) >> 8); int inc = nt;
#pragma unroll
        for (int off = 1; off < 32; off <<= 1) { const int v = __shfl_up(inc, off, 32); if (e >= off) inc += v; }
        const int start = inc - nt;
        if (tid < 32) { TS[e] = start; if (e == 31) TS[NE] = inc; for (int i = 0; i < nt; ++i) TE[start + i] = e; }
    }
    __syncthreads();
}

__device__ __forceinline__ void ph_gather(const ArgsG& a, int l, LAS unsigned char* lds, int gw, int NGW, int tid, int lane) {
    LAS int* TS = (LAS int*)(lds + TS_OFF); LAS int* TE = (LAS int*)(lds + TE_OFF);
    const unsigned* cnt = (const unsigned*)(a.W() + WS_CTL) + CW_CNT + 64 * l;
    build_tiles(cnt, TS, TE, tid);
    const int* EIDX = (const int*)(a.W() + WS_EIDX); const int* EPOS = (const int*)(a.W() + WS_EPOS); int* SLOT = (int*)(a.W() + WS_SLOT); int* S2T = (int*)(a.W() + WS_XS);
    for (int i = gw * 64 + lane; i < NT * 4; i += NGW * 64) { const int slot = TS[EIDX[i]] * 256 + EPOS[i]; SLOT[i] = slot; S2T[slot] = i >> 2; }
    for (int e = (int)blockIdx.x; e < NE; e += (int)gridDim.x) { const int beg = TS[e] * 256 + (int)cnt[e], end = TS[e + 1] * 256; for (int sidx = beg + tid; sidx < end; sidx += NTHR) S2T[sidx] = 0; }
}

__device__ __forceinline__ void ph_combine(const ArgsG& a, int l, LAS unsigned char* lds, const float* Xin_, const bf16* Dm, float* Xo, const float* next_norm_w, int gw, int NGW, int tid, int lane) {
    LAS int* TS = (LAS int*)(lds + TS_OFF); LAS int* TE = (LAS int*)(lds + TE_OFF);
    build_tiles((const unsigned*)(a.W() + WS_CTL) + CW_CNT + 64 * l, TS, TE, tid);
    const int* EIDX = (const int*)(a.W() + WS_EIDX); const int* EPOS = (const int*)(a.W() + WS_EPOS);
    const bf16* YS = (const bf16*)(a.W() + WS_YS); const float* EW = (const float*)(a.W() + WS_EW); bf16* XN = (bf16*)(a.W() + WS_XN);
    for (int tok = gw; tok < NT; tok += NGW) {
        int slot = 0; float wgt = 0.f;
        if (lane < 4) { slot = TS[EIDX[(size_t)tok * 4 + lane]] * 256 + EPOS[(size_t)tok * 4 + lane]; wgt = EW[(size_t)tok * 4 + lane]; }
        f32x4 v[4];
#pragma unroll
        for (int j = 0; j < 4; ++j) { v[j] = *(const f32x4*)(Xin_ + (size_t)tok * DM + 4 * (64 * j + lane)); const u32x2 dd = *(const u32x2*)(Dm + (size_t)tok * DM + 4 * (64 * j + lane));
            v[j].x += bf_lo(dd.x); v[j].y += bf_hi(dd.x); v[j].z += bf_lo(dd.y); v[j].w += bf_hi(dd.y); }
#pragma unroll
        for (int k = 0; k < 4; ++k) { const int sk = __shfl(slot, k); const float wk = __shfl(wgt, k);
#pragma unroll
            for (int j = 0; j < 4; ++j) { const u32x2 y = *(const u32x2*)(YS + (size_t)sk * DM + 4 * (64 * j + lane));
                v[j].x += wk * bf_lo(y.x); v[j].y += wk * bf_hi(y.x); v[j].z += wk * bf_lo(y.y); v[j].w += wk * bf_hi(y.y); } }
#pragma unroll
        for (int j = 0; j < 4; ++j) *(f32x4*)(Xo + (size_t)tok * DM + 4 * (64 * j + lane)) = v[j];
        if (next_norm_w) rms_row_to_bf16(v, next_norm_w, XN + (size_t)tok * DM, lane);
    }
}

struct Tid { int tid, lane, wave; };
__device__ __forceinline__ Tid fresh_tid() { int t = threadIdx.x; asm volatile("" : "+v"(t)); Tid r; r.tid = t; r.lane = t & 63; r.wave = __builtin_amdgcn_readfirstlane(t >> 6); return r; }
#define FT() ArgsG A_; { unsigned char* w_ = args_k.ws; asm volatile("" : "+s"(w_)); A_.ws = (GAS unsigned char*)w_; _Pragma("unroll") for (int i_ = 0; i_ < 25; ++i_) A_.in[i_] = (const GAS float*)args_k.in[i_]; A_.out = (GAS float*)args_k.out; } const ArgsG& args = A_; const Tid T_ = fresh_tid(); const int tid = T_.tid, lane = T_.lane, wave = T_.wave, gw = bid * NWAVES + wave; (void)tid; (void)lane; (void)wave; (void)gw
constexpr int PH_PER_LAYER = 11, NPH = 2 + NLAYER * PH_PER_LAYER;

#if SINGLE_LAUNCH
#define BARPARM , unsigned* barw, unsigned& bark
#define BARARG , barw, bark
#define GRID_BAR() cnt_barrier(barw, bark)
#else
#define BARPARM
#define BARARG
#define GRID_BAR() do {} while (0)
#endif
#define IN(k) (lo <= (k) && (k) < hi)
#define SEAM(k) do { if (IN(k) && IN((k) + 1)) GRID_BAR(); } while (0)
template <int l>
__device__ __forceinline__ void run_layer(const Args& args_k, LAS unsigned char* lds, int lo, int hi, int G, int bid, int NGW BARPARM) {
        const int pb = 2 + l * PH_PER_LAYER;
#define Xin ((l == 0) ? args.I(0) : (const float*)(args.W() + WS_XB))
#define X1 ((float*)(args.W() + WS_XA))
#define Xout ((l == NLAYER - 1) ? args.O() : (float*)(args.W() + WS_XB))
        if (IN(pb + 0)) {
            FT(); pg8::Gemm g{(const pg8::bf16_t*)(args.W() + WS_XN), (const pg8::bf16_t*)(args.W() + WS_WIN) + (size_t)l * NP * DM, NT, NP, DM};
            pg8::StaticOrder S; S.init(NT, NP, G, bid);
            pg8::EpiBf16Plain E{(pg8::bf16_t*)(args.W() + WS_P), NP};
            pg8::gemm_phase<pg8::EpiBf16Plain, pg8::StaticOrder, true, true>(lds, g, S, E);
        } SEAM(pb + 0);
        if (IN(pb + 1)) { { FT(); ph_compress_mfma(args, l, lds, bid, G, tid, wave, lane); } { FT(); ph_m1(args, l, lds, bid, G, tid, wave, lane); }
            asm volatile("s_waitcnt vmcnt(0)" ::: "memory"); __syncthreads();
            if (G == 256) { FT(); ph_dn_chunk_mfma(args, lds, bid, G, tid, wave, lane); } }
        if (G != 256) { SEAM(pb + 1); if (IN(pb + 1)) { FT(); ph_dn_chunk_mfma(args, lds, bid, G, tid, wave, lane); } } SEAM(pb + 1);
        if (IN(pb + 3)) {
            const bool small = G <= 64;
            if (small || bid < 32) { FT(); ph_dn_scan_mfma(args, lds, bid, small ? G : 32, tid, wave, lane); }
            { int ub, us, ue;
              if (small) { ub = bid; us = G; ue = 256; }
              else if (G == 256) { if (bid >= 32) { ub = bid - 32; us = 32; ue = ub >= 192 ? 256 : ub + 1; } else { ub = 256; us = 256; ue = 256; } }
              else { ub = bid >= 32 ? bid - 32 : 256; us = G - 32; ue = 256; }
              FT(); ph_nsa_mfma(args, lds, ub, us, ue, tid, wave, lane); } } SEAM(pb + 3);
        if (IN(pb + 4)) { FT(); ph_dn_out(args, l, gw, NGW, lane); } SEAM(pb + 4);
        if (IN(pb + 5)) {
            FT(); pg8::Gemm g{(const pg8::bf16_t*)(args.W() + WS_Y), (const pg8::bf16_t*)(args.W() + WS_WOUT) + (size_t)l * DM * DM, NT, DM, DM};
            pg8::StaticOrder S; S.init(NT, DM, G, bid);
            pg8::EpiBf16Plain E{(pg8::bf16_t*)(args.W() + WS_XA), DM};
            pg8::gemm_phase<pg8::EpiBf16Plain, pg8::StaticOrder, true, true>(lds, g, S, E);
        } SEAM(pb + 5);
        if (IN(pb + 6)) { FT(); ph_router(args, l, Xin, (const bf16*)(args.W() + WS_XA), lds, bid, G, tid, wave, lane); } SEAM(pb + 6);
        if (IN(pb + 8)) {
            FT(); LAS int* TS = (LAS int*)(lds + TS_OFF); LAS int* TE = (LAS int*)(lds + TE_OFF);
            build_tiles((const unsigned*)(args.W() + WS_CTL) + CW_CNT + 64 * l, TS, TE, tid);
            const int ntiles = __builtin_amdgcn_readfirstlane(TS[NE]);
            pg8::Gemm g{(const pg8::bf16_t*)(args.W() + WS_XN), (const pg8::bf16_t*)(args.W() + WS_WGU) + (size_t)l * NE * 2048 * DM, ntiles * 256, NE * 2048, DM};
            LAS int* RT = (LAS int*)(lds + LDSCTL_OFF + 2048);
            pg8::MoeOrder<8, true> S{ntiles, G, bid, (const LAS int*)TE, (const LAS int*)RT};
            { const int* POSTOK = (const int*)(args.W() + WS_XS); const unsigned* cntp = (const unsigned*)(args.W() + WS_CTL) + CW_CNT + 64 * l; pg8::Unit uu;
              int rv[10];
#pragma unroll
              for (int i = 0; i < 10; ++i) { rv[i] = -1; if (S.next(i, uu) && tid < 256) { const int e = TE[uu.pm], pos = uu.pm * 256 + tid - TS[e] * 256; rv[i] = pos < (int)cntp[e] ? POSTOK[(size_t)e * NT + pos] : 0; } }
#pragma unroll
              for (int i = 0; i < 10; ++i) if (rv[i] >= 0) RT[i * 256 + tid] = rv[i]; }
            __syncthreads();
            pg8::EpiSwiglu E{(pg8::bf16_t*)(args.W() + WS_ACT), args.I(21) + (size_t)l * NE * 2048};
            pg8::gemm_phase<pg8::EpiSwiglu, pg8::MoeOrder<8, true>, true, true>(lds, g, S, E);
        } SEAM(pb + 8);
        if (IN(pb + 9)) {
            FT(); LAS int* TS = (LAS int*)(lds + TS_OFF); LAS int* TE = (LAS int*)(lds + TE_OFF);
            build_tiles((const unsigned*)(args.W() + WS_CTL) + CW_CNT + 64 * l, TS, TE, tid);
            const int ntiles = __builtin_amdgcn_readfirstlane(TS[NE]);
            pg8::Gemm g{(const pg8::bf16_t*)(args.W() + WS_ACT), (const pg8::bf16_t*)(args.W() + WS_WD) + (size_t)l * NE * DM * DM, ntiles * 256, NE * DM, DM};
            pg8::MoeOrder<4> S{ntiles, G, bid, (const LAS int*)TE};
            pg8::EpiDown64 E{(pg8::bf16_t*)(args.W() + WS_YS), args.I(23) + (size_t)l * NE * DM};
            pg8::gemm_phase<pg8::EpiDown64, pg8::MoeOrder<4>, true, true>(lds, g, S, E);
        } SEAM(pb + 9);
        if (IN(pb + 10)) { FT(); ph_combine(args, l, lds, Xin, (const bf16*)(args.W() + WS_XA), Xout, (l + 1 < NLAYER) ? args.I(1) + (size_t)(l + 1) * DM : nullptr, gw, NGW, tid, lane); }
        if (l + 1 < NLAYER) SEAM(pb + 10);
    }

__global__ void __launch_bounds__(NTHR, 2) fwd_kernel(Args args_k) {
    extern __shared__ __attribute__((aligned(16))) unsigned char lds_raw[];
    LAS unsigned char* lds = (LAS unsigned char*)lds_raw;
    const int G = gridDim.x, bid = blockIdx.x, NGW = G * NWAVES;
    for (int u = threadIdx.x; u < (LDS_BYTES - LDSCTL_OFF) / 4; u += NTHR) ((LAS unsigned*)(lds + LDSCTL_OFF))[u] = 0u;
    __syncthreads();
#if SINGLE_LAUNCH
    unsigned* barw = (unsigned*)(args_k.ws + WS_CTL) + CW_BAR; unsigned bark = 0u;
#endif
    const int lo = args_k.ph_lo, hi = args_k.ph_hi;

    if (IN(0)) { { FT(); ph_norm0(args, gw, NGW, lane); } { FT(); ph_prologue(args, lds, gw, NGW, wave, lane); } } SEAM(0);

    run_layer<0>(args_k, lds, lo, hi, G, bid, NGW BARARG);
    run_layer<1>(args_k, lds, lo, hi, G, bid, NGW BARARG);
#undef IN
#undef SEAM
}

extern "C" void kernel_launch(void* const* d_in, const int* in_sizes, int n_in, void* d_out, int out_size, void* d_ws, size_t ws_size, hipStream_t stream) {
    static int grid = 0;
    if (grid == 0) {
        if (n_in != 25 || in_sizes[0] != NT * DM || out_size != NT * DM || ws_size < WS_END) {
            fprintf(stderr, "kernel_launch: unexpected problem (n_in %d, in0 %d, out %d, ws %zu < %zu); nothing launched\n", n_in, n_in > 0 ? in_sizes[0] : -1, out_size, ws_size, (size_t)WS_END); grid = -1; return; }
        int dev = 0, cus = 0, per_cu = 0;
        if (hipGetDevice(&dev) != hipSuccess || hipDeviceGetAttribute(&cus, hipDeviceAttributeMultiprocessorCount, dev) != hipSuccess) { grid = -1; return; }
        if (hipFuncSetAttribute((const void*)fwd_kernel, hipFuncAttributeMaxDynamicSharedMemorySize, LDS_BYTES) != hipSuccess) { fprintf(stderr, "kernel_launch: hipFuncSetAttribute failed\n"); grid = -1; return; }
        if (hipOccupancyMaxActiveBlocksPerMultiprocessor(&per_cu, (const void*)fwd_kernel, NTHR, LDS_BYTES) != hipSuccess || per_cu < 1)
            fprintf(stderr, "kernel_launch: note: occupancy query reports %d workgroups per CU\n", per_cu);
        (void)hipGetLastError();
        grid = cus;
    }
    if (grid < 0) return;
    if (hipMemsetAsync((char*)d_ws + WS_CTL, 0, CTL_ZERO_BYTES, stream) != hipSuccess) { fprintf(stderr, "kernel_launch: memset failed\n"); return; }
    Args a{};
    for (int i = 0; i < 25; ++i) a.in[i] = (const float*)d_in[i];
    a.out = (float*)d_out; a.ws = (unsigned char*)d_ws;
#if SINGLE_LAUNCH
    a.ph_lo = 0; a.ph_hi = NPH;
    hipLaunchKernelGGL(fwd_kernel, dim3(grid), dim3(NTHR), LDS_BYTES, stream, a);
#else
    for (int ph = 0; ph < NPH; ++ph) { a.ph_lo = ph; a.ph_hi = ph + 1; hipLaunchKernelGGL(fwd_kernel, dim3(grid), dim3(NTHR), LDS_BYTES, stream, a); }
#endif
}
```

```cpp
#include <hip/hip_runtime.h>
#include <cstdio>
#include <cstdint>
#include <cstddef>
namespace pg8 {
#define PG8_LAS __attribute__((address_space(3)))
#define PG8_GAS __attribute__((address_space(1)))
typedef unsigned short bf16_t;
typedef short bf16x8 __attribute__((ext_vector_type(8)));
typedef float f32x4 __attribute__((ext_vector_type(4)));
typedef unsigned u32x4 __attribute__((ext_vector_type(4)));
constexpr int BM = 256, BK = 64, HALF = 128, HTB = HALF * BK * 2  , STAGE_BYTES = 8 * HTB, NXCD = 8, WGM = 8;

__host__ __device__ __forceinline__ int lds_byte(int r, int c) { const int st = (r >> 4) * 2 + (c >> 5), rr = r & 15, cc = c & 31, ob = rr * 64 + cc * 2; return st * 1024 + (ob ^ (((ob >> 9) & 1) << 5)); }
__host__ __device__ __forceinline__ void stage_rc(int b, int& R, int& C) { const int st = b / 1024, sb = b % 1024, swz = sb ^ (((sb >> 9) & 1) << 5); R = (st >> 1) * 16 + swz / 64; C = (st & 1) * 32 + (swz % 64) / 2; }
__host__ __device__ __forceinline__ int perm32(int rho) { const int n = rho >> 4, i = rho & 15; return 8 * (i >> 2) + 4 * n + (i & 3); }

struct Unit { int pm, pn; };
struct Gemm { const bf16_t* A; const bf16_t* Bt; int M, N, K; };

struct StaticOrder {
    static constexpr bool GATHER = false; const PG8_LAS int* rowtab = nullptr;
    int nM, nN, nwg, G, c;
    __host__ __device__ void init(int M, int N, int G_, int c_) { nM = M / BM; nN = N / BM; nwg = nM * nN; G = G_; c = c_; }
    __host__ __device__ bool next(int i, Unit& u) const {
        const long L = (long)i * G + c; if (L >= nwg) return false;
        int wgid = (int)L; { const int q = nwg / NXCD, r = nwg % NXCD, xcd = wgid % NXCD, off = wgid / NXCD; wgid = (xcd < r ? xcd * (q + 1) : r * (q + 1) + (xcd - r) * q) + off; }
        const int nig = WGM * nN, gid = wgid / nig, fm = gid * WGM, gsz = (nM - fm) < WGM ? (nM - fm) : WGM;
        u.pm = fm + ((wgid % nig) % gsz); u.pn = (wgid % nig) / gsz; return true;
    }
    __device__ __forceinline__ void a_ready(const Unit&) const {}
    __device__ __forceinline__ void done(const Unit&) const {}
    __device__ __forceinline__ void flush() const {}
};

__device__ __forceinline__ unsigned cvt_pk_bf16(float lo, float hi) { unsigned r; asm volatile("v_cvt_pk_bf16_f32 %0, %1, %2" : "=v"(r) : "v"(lo), "v"(hi)); return r; }

struct EpiBf16Plain {
    static constexpr bool PERM = true, AFTER_DRAIN = false, B64 = false;
    bf16_t* O; int ldc;
    __device__ __forceinline__ void operator()(const f32x4 (&acc)[2][2][4][2], const Unit& u, int wr, int wc, int fr, int fq) const {
        const int row0 = u.pm * BM + wr * 64 + fr, col0 = u.pn * BM + wc * 32 + 8 * fq;
#pragma unroll
        for (int ai = 0; ai < 2; ++ai)
#pragma unroll
            for (int m = 0; m < 4; ++m) { bf16_t* rowp = O + (size_t)(row0 + ai * HALF + m * 16) * ldc + col0;
#pragma unroll
                for (int bj = 0; bj < 2; ++bj) { const f32x4 v0 = acc[ai][bj][m][0], v1 = acc[ai][bj][m][1];
                    u32x4 w; w.x = cvt_pk_bf16(v0[0], v0[1]); w.y = cvt_pk_bf16(v0[2], v0[3]); w.z = cvt_pk_bf16(v1[0], v1[1]); w.w = cvt_pk_bf16(v1[2], v1[3]);
                    *(PG8_GAS u32x4*)(rowp + bj * HALF) = w; } }
    }
};
struct EpiResF32 {
    static constexpr bool PERM = false, AFTER_DRAIN = false, B64 = false;
    const float* base; float* out; int ldc;
    __device__ __forceinline__ void operator()(const f32x4 (&acc)[2][2][4][2], const Unit& u, int wr, int wc, int fr, int fq) const {
        const int row0 = u.pm * BM + wr * 64 + fr, col0 = u.pn * BM + wc * 32 + 4 * fq;
#pragma unroll
        for (int ai = 0; ai < 2; ++ai)
#pragma unroll
            for (int m = 0; m < 4; ++m) { const size_t off = (size_t)(row0 + ai * HALF + m * 16) * ldc + col0;
#pragma unroll
                for (int bj = 0; bj < 2; ++bj)
#pragma unroll
                    for (int n = 0; n < 2; ++n) { const f32x4 b = *(const f32x4*)(base + off + bj * HALF + n * 16); *(PG8_GAS f32x4*)(out + off + bj * HALF + n * 16) = b + acc[ai][bj][m][n]; } }
    }
};
struct EpiSwiglu {
    static constexpr bool PERM = true, AFTER_DRAIN = false, B64 = false;
    bf16_t* O; const float* bgu;
    __device__ __forceinline__ void operator()(const f32x4 (&acc)[2][2][4][2], const Unit& u, int wr, int wc, int fr, int fq) const {
        const int e = u.pn >> 3, pnl = u.pn & 7;
        const int row0 = u.pm * BM + wr * 64 + fr, gcol = pnl * 128 + wc * 32 + 8 * fq;
        const float* bg = bgu + (size_t)e * 2048 + gcol;
        f32x4 bgv[2], buv[2];
#pragma unroll
        for (int n = 0; n < 2; ++n) { bgv[n] = *(const PG8_GAS f32x4*)(bg + 4 * n); buv[n] = *(const PG8_GAS f32x4*)(bg + 1024 + 4 * n); }
#pragma unroll
        for (int ai = 0; ai < 2; ++ai)
#pragma unroll
            for (int m = 0; m < 4; ++m) { bf16_t* rowp = O + (size_t)(row0 + ai * HALF + m * 16) * 1024 + gcol;
                float r[8];
#pragma unroll
                for (int n = 0; n < 2; ++n) { const f32x4 gv = acc[ai][0][m][n] + bgv[n], uv = acc[ai][1][m][n] + buv[n];
#pragma unroll
                    for (int j = 0; j < 4; ++j) { const float g = fminf(gv[j], 7.0f), up = fminf(fmaxf(uv[j], -7.0f), 7.0f);
                        const float sg = __builtin_amdgcn_rcpf(1.0f + __expf(-1.702f * g)); r[n * 4 + j] = (up + 1.0f) * g * sg; } }
                u32x4 w; w.x = cvt_pk_bf16(r[0], r[1]); w.y = cvt_pk_bf16(r[2], r[3]); w.z = cvt_pk_bf16(r[4], r[5]); w.w = cvt_pk_bf16(r[6], r[7]);
                *(PG8_GAS u32x4*)rowp = w; }
    }
};
struct EpiSwigluWT {
    static constexpr bool PERM = true, AFTER_DRAIN = false, B64 = false;
    bf16_t* O; const float* bgu;
    __device__ __forceinline__ void operator()(const f32x4 (&acc)[2][2][4][2], const Unit& u, int wr, int wc, int fr, int fq) const {
        const int e = u.pn >> 3, pnl = u.pn & 7;
        const int row0 = u.pm * BM + wr * 64 + fr, gcol = pnl * 128 + wc * 32 + 8 * fq;
        const float* bg = bgu + (size_t)e * 2048 + gcol;
        f32x4 bgv[2], buv[2];
#pragma unroll
        for (int n = 0; n < 2; ++n) { bgv[n] = *(const PG8_GAS f32x4*)(bg + 4 * n); buv[n] = *(const PG8_GAS f32x4*)(bg + 1024 + 4 * n); }
#pragma unroll
        for (int ai = 0; ai < 2; ++ai)
#pragma unroll
            for (int m = 0; m < 4; ++m) { bf16_t* rowp = O + (size_t)(row0 + ai * HALF + m * 16) * 1024 + gcol;
                float r[8];
#pragma unroll
                for (int n = 0; n < 2; ++n) { const f32x4 gv = acc[ai][0][m][n] + bgv[n], uv = acc[ai][1][m][n] + buv[n];
#pragma unroll
                    for (int h = 0; h < 2; ++h) { typedef float f32x2_ __attribute__((ext_vector_type(2)));
                        const f32x2_ g2 = {fminf(gv[2 * h], 7.0f), fminf(gv[2 * h + 1], 7.0f)}, up2 = {__builtin_amdgcn_fmed3f(uv[2 * h], -7.0f, 7.0f), __builtin_amdgcn_fmed3f(uv[2 * h + 1], -7.0f, 7.0f)};
                        const f32x2_ t2 = g2 * -2.4554669595930157f; const f32x2_ d2 = (f32x2_){__builtin_amdgcn_exp2f(t2.x), __builtin_amdgcn_exp2f(t2.y)} + 1.0f;
                        const f32x2_ s2 = {__builtin_amdgcn_rcpf(d2.x), __builtin_amdgcn_rcpf(d2.y)}; const f32x2_ r2 = (up2 * g2 + g2) * s2; r[n * 4 + 2 * h] = r2.x; r[n * 4 + 2 * h + 1] = r2.y; } }
                u32x4 w; w.x = cvt_pk_bf16(r[0], r[1]); w.y = cvt_pk_bf16(r[2], r[3]); w.z = cvt_pk_bf16(r[4], r[5]); w.w = cvt_pk_bf16(r[6], r[7]);
                asm volatile("global_store_dwordx4 %0, %1, off sc1\n\ts_nop 1" :: "v"((PG8_GAS u32x4*)rowp), "v"(w) : "memory"); }
    }
};
struct EpiDown {
    static constexpr bool PERM = true, AFTER_DRAIN = false, B64 = false;
    bf16_t* O; const float* bd;
    __device__ __forceinline__ void operator()(const f32x4 (&acc)[2][2][4][2], const Unit& u, int wr, int wc, int fr, int fq) const {
        const int e = u.pn >> 2, pnl = u.pn & 3;
        const int row0 = u.pm * BM + wr * 64 + fr, col0 = pnl * BM + wc * 32 + 8 * fq;
        const float* bp = bd + (size_t)e * 1024 + col0;
        f32x4 bv[2][2];
#pragma unroll
        for (int bj = 0; bj < 2; ++bj)
#pragma unroll
            for (int n = 0; n < 2; ++n) bv[bj][n] = *(const PG8_GAS f32x4*)(bp + bj * HALF + 4 * n);
#pragma unroll
        for (int ai = 0; ai < 2; ++ai)
#pragma unroll
            for (int m = 0; m < 4; ++m) { bf16_t* rowp = O + (size_t)(row0 + ai * HALF + m * 16) * 1024 + col0;
#pragma unroll
                for (int bj = 0; bj < 2; ++bj) { const f32x4 v0 = acc[ai][bj][m][0] + bv[bj][0], v1 = acc[ai][bj][m][1] + bv[bj][1];
                    u32x4 w; w.x = cvt_pk_bf16(v0[0], v0[1]); w.y = cvt_pk_bf16(v0[2], v0[3]); w.z = cvt_pk_bf16(v1[0], v1[1]); w.w = cvt_pk_bf16(v1[2], v1[3]);
                    *(PG8_GAS u32x4*)(rowp + bj * HALF) = w; } }
    }
};
struct EpiDown64 {
    static constexpr bool PERM = true, AFTER_DRAIN = false, B64 = true;
    bf16_t* O; const float* bd;
    __device__ __forceinline__ void operator()(const f32x4 (&acc)[2][2][4][2], const Unit& u, int wr, int wc, int fr, int fq) const {
        const int e = u.pn >> 2, pnl = u.pn & 3;
        const int row0 = u.pm * BM + wr * 64 + fr, col0 = pnl * BM + wc * 64 + 8 * fq;
        const float* bp = bd + (size_t)e * 1024 + col0;
        f32x4 bv[2][2];
#pragma unroll
        for (int bj = 0; bj < 2; ++bj)
#pragma unroll
            for (int n = 0; n < 2; ++n) bv[bj][n] = *(const PG8_GAS f32x4*)(bp + bj * 32 + 4 * n);
#pragma unroll
        for (int ai = 0; ai < 2; ++ai)
#pragma unroll
            for (int m = 0; m < 4; ++m) { bf16_t* rowp = O + (size_t)(row0 + ai * HALF + m * 16) * 1024 + col0;
#pragma unroll
                for (int bj = 0; bj < 2; ++bj) { const f32x4 v0 = acc[ai][bj][m][0] + bv[bj][0], v1 = acc[ai][bj][m][1] + bv[bj][1];
                    u32x4 w; w.x = cvt_pk_bf16(v0[0], v0[1]); w.y = cvt_pk_bf16(v0[2], v0[3]); w.z = cvt_pk_bf16(v1[0], v1[1]); w.w = cvt_pk_bf16(v1[2], v1[3]);
                    *(PG8_GAS u32x4*)(rowp + bj * 32) = w; } }
    }
};
struct EpiDown64L {
    static constexpr bool PERM = true, AFTER_DRAIN = false, B64 = true;
    static constexpr int NSLOT = 8;
    bf16_t* O; const float* bd; const PG8_LAS float* bl; mutable int ui = 0;
    __device__ __forceinline__ void operator()(const f32x4 (&acc)[2][2][4][2], const Unit& u, int wr, int wc, int fr, int fq) const {
        const int e = u.pn >> 2, pnl = u.pn & 3;
        const int row0 = u.pm * BM + wr * 64 + fr, col0 = pnl * BM + wc * 64 + 8 * fq;
        const float* bp = bd + (size_t)e * 1024 + col0;
        f32x4 bv[2][2];
        const int slot = ui; ui = slot + 1;
        if (slot < NSLOT) { const PG8_LAS float* lp = bl + slot * 256 + wc * 64 + 8 * fq;
#pragma unroll
            for (int bj = 0; bj < 2; ++bj)
#pragma unroll
                for (int n = 0; n < 2; ++n) bv[bj][n] = *(const PG8_LAS f32x4*)(lp + bj * 32 + 4 * n); }
        else {
#pragma unroll
            for (int bj = 0; bj < 2; ++bj)
#pragma unroll
                for (int n = 0; n < 2; ++n) bv[bj][n] = *(const PG8_GAS f32x4*)(bp + bj * 32 + 4 * n); }
#pragma unroll
        for (int ai = 0; ai < 2; ++ai)
#pragma unroll
            for (int m = 0; m < 4; ++m) { bf16_t* rowp = O + (size_t)(row0 + ai * HALF + m * 16) * 1024 + col0;
#pragma unroll
                for (int bj = 0; bj < 2; ++bj) { const f32x4 v0 = acc[ai][bj][m][0] + bv[bj][0], v1 = acc[ai][bj][m][1] + bv[bj][1];
                    u32x4 w; w.x = cvt_pk_bf16(v0[0], v0[1]); w.y = cvt_pk_bf16(v0[2], v0[3]); w.z = cvt_pk_bf16(v1[0], v1[1]); w.w = cvt_pk_bf16(v1[2], v1[3]);
                    *(PG8_GAS u32x4*)(rowp + bj * 32) = w; } }
    }
};
struct EpiBf16Plain64 {
    static constexpr bool PERM = true, AFTER_DRAIN = false, B64 = true;
    bf16_t* O; int ldc;
    __device__ __forceinline__ void operator()(const f32x4 (&acc)[2][2][4][2], const Unit& u, int wr, int wc, int fr, int fq) const {
        const int row0 = u.pm * BM + wr * 64 + fr, col0 = u.pn * BM + wc * 64 + 8 * fq;
#pragma unroll
        for (int ai = 0; ai < 2; ++ai)
#pragma unroll
            for (int m = 0; m < 4; ++m) { bf16_t* rowp = O + (size_t)(row0 + ai * HALF + m * 16) * ldc + col0;
#pragma unroll
                for (int bj = 0; bj < 2; ++bj) { const f32x4 v0 = acc[ai][bj][m][0], v1 = acc[ai][bj][m][1];
                    u32x4 w; w.x = cvt_pk_bf16(v0[0], v0[1]); w.y = cvt_pk_bf16(v0[2], v0[3]); w.z = cvt_pk_bf16(v1[0], v1[1]); w.w = cvt_pk_bf16(v1[2], v1[3]);
                    *(PG8_GAS u32x4*)(rowp + bj * 32) = w; } }
    }
};
template <int NPN, bool GATHER_ = false, int MODE = 0> struct MoeOrder {
    static constexpr bool GATHER = GATHER_;
    int ntiles, G, c; const PG8_LAS int* texp; const PG8_LAS int* rowtab = nullptr;
    unsigned* rdy = nullptr; unsigned* tmo = nullptr; int shift = 0; mutable int pend = -1; mutable int nrdy = 0;
    __device__ __forceinline__ bool next(int i, Unit& u) const {
        constexpr int MT = 32 / NPN; int mt, pn;
        if (G == 256) { const int chunk = i * 8 + (((c & 7) - shift) & 7), r = c >> 3; pn = r / MT; mt = chunk * MT + (r % MT); }
        else { const int L = i * G + c; mt = L / NPN; pn = L % NPN; }
        mt = __builtin_amdgcn_readfirstlane(mt); if (mt >= ntiles) return false;
        const int e = __builtin_amdgcn_readfirstlane(texp[mt]);
        u.pm = mt; u.pn = e * NPN + pn; return true;
    }
    __device__ __forceinline__ void publish(int mt) const { if ((threadIdx.x & 63) == 0) (void)__hip_atomic_fetch_add((PG8_GAS unsigned*)rdy + 16 * mt, 1u, __ATOMIC_RELAXED, __HIP_MEMORY_SCOPE_AGENT); }
    __device__ __forceinline__ void wait_tile(int mt) const {
        unsigned sp = 0; PG8_GAS unsigned* w = (PG8_GAS unsigned*)rdy + 16 * mt; PG8_GAS unsigned* t = (PG8_GAS unsigned*)tmo;
        while ((unsigned)__builtin_amdgcn_readfirstlane((int)__hip_atomic_load(w, __ATOMIC_RELAXED, __HIP_MEMORY_SCOPE_AGENT)) < 64u) { __builtin_amdgcn_s_sleep(2);
            if ((++sp & 255u) == 0u) { if (__hip_atomic_load(t, __ATOMIC_RELAXED, __HIP_MEMORY_SCOPE_AGENT)) break; if (sp > (1u << 21)) { __hip_atomic_store(t, 1u, __ATOMIC_RELAXED, __HIP_MEMORY_SCOPE_AGENT); break; } } }
    }
    static constexpr int NUP = 4;
    __device__ __forceinline__ void a_ready(const Unit& u) const {
        if constexpr (MODE == 2) {
            const int k = nrdy; nrdy = k + 1;
            if (k > 0 && k < NUP) return;
            if (threadIdx.x < 64) {
                if (k == 0) { int mt = u.pm; Unit uu;
#pragma unroll
                    for (int i = 1; i < NUP; ++i) { if (next(i, uu) && (int)(threadIdx.x & 63) == i) mt = uu.pm; }
                    unsigned sp = 0; PG8_GAS unsigned* w = (PG8_GAS unsigned*)rdy + 16 * mt; PG8_GAS unsigned* t = (PG8_GAS unsigned*)tmo;
                    while (!__all(__hip_atomic_load(w, __ATOMIC_RELAXED, __HIP_MEMORY_SCOPE_AGENT) >= 64u)) { __builtin_amdgcn_s_sleep(2);
                        if ((++sp & 255u) == 0u) { if (__hip_atomic_load(t, __ATOMIC_RELAXED, __HIP_MEMORY_SCOPE_AGENT)) break; if (sp > (1u << 21)) { __hip_atomic_store(t, 1u, __ATOMIC_RELAXED, __HIP_MEMORY_SCOPE_AGENT); break; } } } }
                else wait_tile(u.pm);
                __builtin_amdgcn_fence(__ATOMIC_ACQUIRE, "agent"); asm volatile("s_waitcnt vmcnt(0)" ::: "memory"); }
            asm volatile("" ::: "memory"); __builtin_amdgcn_s_barrier(); asm volatile("" ::: "memory");
        }
    }
    __device__ __forceinline__ void done(const Unit& u) const { if constexpr (MODE == 1) { if (pend >= 0) publish(pend); pend = u.pm; } }
    __device__ __forceinline__ void flush() const { if constexpr (MODE == 1) { if (pend >= 0) publish(pend); pend = -1; } }
};

template <class Epi, class Sched, bool ALIGN_EPI = false, bool SP2 = false>
__device__ __forceinline__ void gemm_phase(PG8_LAS unsigned char* lds, const Gemm g, const Sched& S, const Epi& E) {
    int tid_ = threadIdx.x; asm volatile("" : "+v"(tid_));
    const int tid = tid_, wid = __builtin_amdgcn_readfirstlane(tid >> 6), lane = tid & 63, wr = wid >> 2, wc = wid & 3, fr = lane & 15, fq = lane >> 4;
    const int K = g.K, nt = K / BK;
    constexpr bool GA = Sched::GATHER;
    static_assert(!GA || SP2, "gathered A rows: SP2 loop only");
    unsigned voffA[2], voffB[2]; int RA[2], CA2[2];
#pragma unroll
    for (int i = 0; i < 2; ++i) { int R, C; stage_rc(tid * 16 + i * 8192, R, C); RA[i] = R; CA2[i] = C * 2; const int Rb = Epi::B64 ? ((R >> 5) * 64 + perm32(R & 31)) : (Epi::PERM ? ((R & ~31) + perm32(R & 31)) : R);
        voffA[i] = (unsigned)(R * K + C) * 2u; voffB[i] = (unsigned)(Rb * K + C) * 2u; }
    const size_t kstep = (size_t)(BK * 2);
    const size_t hstep = (size_t)HALF * K * 2;
    const size_t tstep = 2 * hstep;
    const size_t hstepB = Epi::B64 ? (size_t)32 * K * 2 : hstep;
    const unsigned ldsw = (unsigned)wid * 1024u;
    const int aoff = lds_byte(wr * 64 + fr, fq * 8), boff = lds_byte(wc * 32 + fr, fq * 8);
#define PG8_SA(b, h) (((b) * 2 + (h)) * HTB)
#define PG8_SB(b, h) ((4 + (b) * 2 + (h)) * HTB)
#define PG8_STAGE(bufoff, gbase, voff) do { _Pragma("unroll") for (int _i = 0; _i < 2; ++_i) \
        __builtin_amdgcn_global_load_lds((const unsigned*)((const char*)(gbase) + (voff)[_i]), (PG8_LAS unsigned*)(lds + (bufoff) + ldsw + _i * 8192), 16, 0, 0); } while (0)
#define PG8_STAGE_A(bufoff, ptr, h, V) do { if constexpr (GA) PG8_STAGE(bufoff, ptr, V[h]); else PG8_STAGE(bufoff, (ptr) + (h) * hstep, voffA); } while (0)
#define PG8_ROWOFF(V, uidx) do { _Pragma("unroll") for (int h_ = 0; h_ < 2; ++h_) _Pragma("unroll") for (int i_ = 0; i_ < 2; ++i_) V[h_][i_] = (unsigned)S.rowtab[(uidx) * 256 + h_ * 128 + RA[i_]] * (unsigned)(K * 2) + (unsigned)CA2[i_]; } while (0)
#define PG8_LDA(dst, b, h) do { _Pragma("unroll") for (int m = 0; m < 4; ++m) _Pragma("unroll") for (int k = 0; k < 2; ++k) dst[m][k] = *(const PG8_LAS bf16x8*)(lds + PG8_SA(b, h) + aoff + m * 2048 + k * 1024); } while (0)
#define PG8_LDB(dst, b, h) do { _Pragma("unroll") for (int n = 0; n < 2; ++n) _Pragma("unroll") for (int k = 0; k < 2; ++k) dst[n][k] = *(const PG8_LAS bf16x8*)(lds + PG8_SB(b, h) + boff + n * 2048 + k * 1024); } while (0)
#define PG8_MMA(ai, bj, At, Bt) do { __builtin_amdgcn_s_setprio(1); _Pragma("unroll") for (int m = 0; m < 4; ++m) _Pragma("unroll") for (int n = 0; n < 2; ++n) _Pragma("unroll") for (int k = 0; k < 2; ++k) \
        acc[ai][bj][m][n] = __builtin_amdgcn_mfma_f32_16x16x32_bf16(Bt[n][k], At[m][k], acc[ai][bj][m][n], 0, 0, 0); __builtin_amdgcn_s_setprio(0); } while (0)
#define PG8_WAIT_V(n) asm volatile("s_waitcnt vmcnt(" #n ")" ::: "memory")
#define PG8_WAIT_L(n) asm volatile("s_waitcnt lgkmcnt(" #n ")" ::: "memory")
#define PG8_BAR __builtin_amdgcn_s_barrier()
#define PG8_SCHED __builtin_amdgcn_sched_barrier(0)
    Unit cur, nxt; int ui = 0;
    if (!S.next(0, cur)) return;
    f32x4 acc[2][2][4][2];
#pragma unroll
    for (int a = 0; a < 2; ++a)
#pragma unroll
        for (int b = 0; b < 2; ++b)
#pragma unroll
            for (int m = 0; m < 4; ++m)
#pragma unroll
                for (int n = 0; n < 2; ++n) acc[a][b][m][n] = (f32x4){0.f, 0.f, 0.f, 0.f};
    bf16x8 At[4][2], B0[2][2], B1[2][2];
    const char* cA = (const char*)g.A + (GA ? (size_t)0 : (size_t)cur.pm * tstep); const char* cB = (const char*)g.Bt + (size_t)cur.pn * tstep;
    unsigned vAc[2][2] = {{0u, 0u}, {0u, 0u}}, vAn[2][2] = {{0u, 0u}, {0u, 0u}};
    if constexpr (GA) { PG8_ROWOFF(vAc, 0); }
    S.a_ready(cur);
    if constexpr (SP2) {
        PG8_STAGE(PG8_SB(0, 0), cB, voffB); PG8_STAGE(PG8_SB(0, 1), cB + hstepB, voffB); PG8_STAGE_A(PG8_SA(0, 0), cA, 0, vAc); PG8_STAGE_A(PG8_SA(0, 1), cA, 1, vAc);
        if (wr == 1) PG8_BAR;
        PG8_WAIT_V(2); PG8_BAR;
        PG8_STAGE(PG8_SB(1, 0), cB + kstep, voffB); PG8_STAGE_A(PG8_SA(1, 0), cA + kstep, 0, vAc); PG8_STAGE(PG8_SB(1, 1), cB + hstepB + kstep, voffB);
        PG8_WAIT_V(6); PG8_BAR;
    } else {
        PG8_STAGE(PG8_SB(0, 0), cB, voffB); PG8_STAGE(PG8_SA(0, 0), cA, voffA); PG8_STAGE(PG8_SB(0, 1), cB + hstepB, voffB); PG8_STAGE(PG8_SA(0, 1), cA + hstep, voffA);
        if (wr == 1) PG8_BAR;
        PG8_WAIT_V(4); PG8_BAR;
        PG8_STAGE(PG8_SB(1, 0), cB + kstep, voffB); PG8_STAGE(PG8_SA(1, 0), cA + kstep, voffA); PG8_STAGE(PG8_SB(1, 1), cB + hstepB + kstep, voffB);
        PG8_WAIT_V(6); PG8_BAR;
    }
    for (;;) {
        const bool has_next = S.next(ui + 1, nxt);
        const char* nA = (has_next && !GA) ? (const char*)g.A + (size_t)nxt.pm * tstep : cA; const char* nB = has_next ? (const char*)g.Bt + (size_t)nxt.pn * tstep : cB;
        for (int t = 0; t < nt; t += 2) {
            const bool last = (t == nt - 2);
            const char* a1 = cA + (size_t)(t + 1) * kstep;
            const char* a2 = last ? nA : cA + (size_t)(t + 2) * kstep; const char* b2 = last ? nB : cB + (size_t)(t + 2) * kstep;
            const char* a3 = a2 + kstep; const char* b3 = b2 + kstep;
            if (last && has_next) S.a_ready(nxt);
            unsigned v2[2][2] = {{0u, 0u}, {0u, 0u}};
            if constexpr (GA) { if (last) { if (has_next) { PG8_ROWOFF(vAn, ui + 1); } else {
#pragma unroll
                        for (int h_ = 0; h_ < 2; ++h_) { vAn[h_][0] = vAc[h_][0]; vAn[h_][1] = vAc[h_][1]; } } }
#pragma unroll
                for (int h_ = 0; h_ < 2; ++h_) { v2[h_][0] = last ? vAn[h_][0] : vAc[h_][0]; v2[h_][1] = last ? vAn[h_][1] : vAc[h_][1]; } }
            if constexpr (SP2) {
            PG8_LDB(B0, 0, 0); PG8_LDB(B1, 0, 1); PG8_SCHED; PG8_LDA(At, 0, 0); PG8_STAGE_A(PG8_SA(1, 1), a1, 1, vAc);
            PG8_WAIT_V(8); PG8_WAIT_L(0); PG8_BAR; PG8_MMA(0, 0, At, B0); PG8_MMA(0, 1, At, B1); PG8_BAR; PG8_SCHED;
            PG8_LDA(At, 0, 1); PG8_STAGE(PG8_SB(0, 0), b2, voffB); PG8_STAGE(PG8_SB(0, 1), b2 + hstepB, voffB); PG8_STAGE_A(PG8_SA(0, 0), a2, 0, v2);
            PG8_WAIT_V(8); PG8_WAIT_L(0); PG8_BAR; PG8_MMA(1, 0, At, B0); PG8_MMA(1, 1, At, B1); PG8_BAR; PG8_SCHED;
            PG8_LDB(B0, 1, 0); PG8_LDB(B1, 1, 1); PG8_SCHED; PG8_LDA(At, 1, 0); PG8_STAGE_A(PG8_SA(0, 1), a2, 1, v2);
            PG8_WAIT_V(8); PG8_WAIT_L(0); PG8_BAR; PG8_MMA(0, 0, At, B0); PG8_MMA(0, 1, At, B1); PG8_BAR; PG8_SCHED;
            PG8_LDA(At, 1, 1); PG8_STAGE(PG8_SB(1, 0), b3, voffB); PG8_STAGE(PG8_SB(1, 1), b3 + hstepB, voffB); PG8_STAGE_A(PG8_SA(1, 0), a3, 0, v2);
            PG8_WAIT_V(8); PG8_WAIT_L(0); PG8_BAR; PG8_MMA(1, 0, At, B0); PG8_MMA(1, 1, At, B1); PG8_BAR; PG8_SCHED;
            } else {
            PG8_LDB(B0, 0, 0); PG8_SCHED; PG8_LDA(At, 0, 0); PG8_STAGE(PG8_SA(1, 1), a1 + hstep, voffA);
            PG8_WAIT_L(8); PG8_BAR; PG8_WAIT_L(0); PG8_MMA(0, 0, At, B0); PG8_BAR; PG8_SCHED;
            PG8_LDB(B1, 0, 1); PG8_STAGE(PG8_SB(0, 0), b2, voffB);
            PG8_BAR; PG8_WAIT_L(0); PG8_MMA(0, 1, At, B1); PG8_BAR;
            PG8_LDA(At, 0, 1); PG8_STAGE(PG8_SA(0, 0), a2, voffA);
            PG8_BAR; PG8_WAIT_L(0); PG8_MMA(1, 0, At, B0); PG8_BAR; PG8_SCHED;
            PG8_STAGE(PG8_SB(0, 1), b2 + hstepB, voffB);
            PG8_WAIT_V(6); PG8_BAR; PG8_MMA(1, 1, At, B1); PG8_BAR;
            PG8_LDB(B0, 1, 0); PG8_SCHED; PG8_LDA(At, 1, 0); PG8_STAGE(PG8_SA(0, 1), a2 + hstep, voffA);
            PG8_WAIT_L(8); PG8_BAR; PG8_WAIT_L(0); PG8_MMA(0, 0, At, B0); PG8_BAR; PG8_SCHED;
            PG8_LDB(B1, 1, 1); PG8_STAGE(PG8_SB(1, 0), b3, voffB);
            PG8_BAR; PG8_WAIT_L(0); PG8_MMA(0, 1, At, B1); PG8_BAR;
            PG8_LDA(At, 1, 1); PG8_STAGE(PG8_SA(1, 0), a3, voffA);
            PG8_BAR; PG8_WAIT_L(0); PG8_MMA(1, 0, At, B0); PG8_BAR; PG8_SCHED;
            PG8_STAGE(PG8_SB(1, 1), b3 + hstepB, voffB);
            PG8_WAIT_V(6); PG8_BAR; PG8_MMA(1, 1, At, B1); PG8_BAR;
            }
        }
        if constexpr (ALIGN_EPI) { if (wr == 0) PG8_BAR; }
        if constexpr (!Epi::AFTER_DRAIN) { E(acc, cur, wr, wc, fr, fq); S.done(cur); }
        if (!has_next) break;
#pragma unroll
        for (int a = 0; a < 2; ++a)
#pragma unroll
            for (int b = 0; b < 2; ++b)
#pragma unroll
                for (int m = 0; m < 4; ++m)
#pragma unroll
                    for (int n = 0; n < 2; ++n) acc[a][b][m][n] = (f32x4){0.f, 0.f, 0.f, 0.f};
        cur = nxt; cA = nA; cB = nB; ++ui;
        if constexpr (GA) {
#pragma unroll
            for (int h_ = 0; h_ < 2; ++h_) { vAc[h_][0] = vAn[h_][0]; vAc[h_][1] = vAn[h_][1]; } }
        if constexpr (ALIGN_EPI) { if (wr == 1) PG8_BAR; }
    }
    PG8_WAIT_V(0);
    if constexpr (!ALIGN_EPI) { if (wr == 0) PG8_BAR; }
    PG8_BAR;
    if constexpr (Epi::AFTER_DRAIN) { E.fused(acc, cur, wr, wc, fr, fq, lds, wid, lane); S.done(cur); }
    S.flush();
#undef PG8_SA
#undef PG8_SB
#undef PG8_STAGE
#undef PG8_STAGE_A
#undef PG8_ROWOFF
#undef PG8_LDA
#undef PG8_LDB
#undef PG8_MMA
#undef PG8_WAIT_V
#undef PG8_WAIT_L
#undef PG8_BAR
#undef PG8_SCHED
}
}


#define GAS __attribute__((address_space(1)))
typedef unsigned short bf16;
typedef float f32x4 __attribute__((ext_vector_type(4)));
typedef unsigned u32x4 __attribute__((ext_vector_type(4)));
typedef unsigned u32x2 __attribute__((ext_vector_type(2)));
typedef short bf16x8 __attribute__((ext_vector_type(8)));
typedef float f32x16 __attribute__((ext_vector_type(16)));

#ifndef SINGLE_LAUNCH
#define SINGLE_LAUNCH 1
#endif

constexpr int NB = 8, SEQ = 2048, DM = 1024, NT = NB * SEQ, NLAYER = 2;
constexpr int DIN = 3220, NP = 3328;
constexpr int C_Q = 0, C_K = 512, C_V = 1024, C_Z = 1536, C_NQ = 2048, C_KV = 2304, C_CU = 2688, C_A = 3200, C_B = 3204, C_G = 3208;
constexpr int NE = 32, MAXT = 288;
constexpr int NWAVES = 8, NTHR = 512;
constexpr float EPS = 1e-6f;

constexpr size_t MiB = 1u << 20;
constexpr size_t WS_CTL = 0, CTL_ZERO_BYTES = 65536;
constexpr size_t WS_BT = 1 * MiB;
constexpr size_t WS_KCMP = 1 * MiB + 256 * 1024, WS_VCMP = 1 * MiB + 512 * 1024;
constexpr size_t WS_G = 2 * MiB, WS_BETA = 2 * MiB + 256 * 1024, WS_GC = 2 * MiB + 512 * 1024;
constexpr size_t WS_EIDX = 3 * MiB, WS_EPOS = 3 * MiB + 256 * 1024, WS_EW = 3 * MiB + 512 * 1024, WS_SLOT = 3 * MiB + 768 * 1024;
constexpr size_t WS_WIN = 4 * MiB;
constexpr size_t WS_WOUT = 17 * MiB;
constexpr size_t WS_WGU = 22 * MiB;
constexpr size_t WS_WD = 278 * MiB;
constexpr size_t WS_XA = 406 * MiB, WS_XB = 470 * MiB;
constexpr size_t WS_XN = 534 * MiB;
constexpr size_t WS_P = 566 * MiB;
constexpr size_t WS_QN = 670 * MiB, WS_KN = 686 * MiB, WS_VC = 702 * MiB;
constexpr size_t WS_U = 718 * MiB, WS_W = 750 * MiB;
constexpr size_t WS_ATT = 782 * MiB;
constexpr size_t WS_O = 798 * MiB;
constexpr size_t WS_NQ = 830 * MiB;
constexpr size_t WS_KS = 846 * MiB, WS_KW = 848 * MiB;
constexpr size_t WS_Y = 850 * MiB;
constexpr size_t WS_XS = 882 * MiB, WS_ACT = 1026 * MiB, WS_YS = 1170 * MiB;
constexpr size_t WS_KT = 1314 * MiB, WS_VT = 1330 * MiB;
constexpr size_t WS_W1T = 1346 * MiB;
constexpr size_t WS_POSW = 1349 * MiB;
constexpr size_t WS_RWH = 1350 * MiB, WS_RWL = 1351 * MiB;
constexpr size_t WS_END = 1352 * MiB;

constexpr int CW_TMO = 0, CW_BAR = 64, CW_CNT = 512, CW_RDY = 4096, RDY_STRIDE = MAXT * 16;

constexpr int RING_BYTES = 131072;
constexpr int LDSCTL_OFF = RING_BYTES, MISC_OFF = LDSCTL_OFF, TS_OFF = LDSCTL_OFF + 128, TE_OFF = LDSCTL_OFF + 320;
constexpr int LDS_BYTES = 147456;
static_assert((CW_RDY + NLAYER * RDY_STRIDE) * 4 <= (int)CTL_ZERO_BYTES, "control words inside the memset");
static_assert(TE_OFF + MAXT * 4 + 64 <= LDSCTL_OFF + 2048 && LDSCTL_OFF + 2048 + 10 * 1024 <= LDS_BYTES, "LDS map");

#define XB_TMO      128
#define XB_XCNT(j)  (256  + 64 * (j))
#define XB_XSUB(j)  (1280 + 64 * (j))
#define XB_XGEN(j)  (2304 + 64 * (j))
#define XB_TOP      3328
#define XB_TOPGEN   3392
#define XCD_BAR_WORDS 3456
#define XB_SPIN_CAP (1u << 22)
#define LAS __attribute__((address_space(3)))

__device__ __forceinline__ unsigned xb_ld(unsigned* p)              { return __hip_atomic_load(p, __ATOMIC_RELAXED, __HIP_MEMORY_SCOPE_AGENT); }
__device__ __forceinline__ unsigned xb_add(unsigned* p, unsigned v) { return __hip_atomic_fetch_add(p, v, __ATOMIC_RELAXED, __HIP_MEMORY_SCOPE_AGENT); }
__device__ __forceinline__ unsigned xb_xcc_id() { return (unsigned)__builtin_amdgcn_s_getreg((3 << 11) | 20) & 0xFu; }
#define XB_SPIN(cond, bar) do { unsigned _sp = 0; while (cond) { __builtin_amdgcn_s_sleep(1); \
    if ((++_sp & 255u) == 0u) { if (xb_ld(&(bar)[XB_TMO])) break; if (_sp > XB_SPIN_CAP) { atomicAdd(&(bar)[XB_TMO], 1u); break; } } } } while (0)

struct XcdBarrier {
    unsigned* bar; unsigned x;
    volatile LAS unsigned* st;
};

__device__ __forceinline__ XcdBarrier xcd_barrier_post(unsigned* bar, volatile LAS unsigned* st) {
    XcdBarrier b; b.bar = bar; b.x = xb_xcc_id(); b.st = st;
    if (threadIdx.x == 0) (void)xb_add(&bar[XB_XCNT(b.x)], 1u);
    return b;
}
__device__ __forceinline__ void xcd_barrier_complete(unsigned* bar, unsigned x, unsigned& nloc, unsigned& nx) {
    const unsigned G = gridDim.x * gridDim.y * gridDim.z;
    unsigned sum, cnt, mine, sp = 0u;
    for (;;) {
        sum = 0u; cnt = 0u; mine = 0u;
#pragma unroll
        for (unsigned j = 0; j < 16; ++j) { const unsigned c = xb_ld(&bar[XB_XCNT(j)]); sum += c; cnt += (c > 0u) ? 1u : 0u; mine = (j == x) ? c : mine; }
        if (sum == G) break;
        __builtin_amdgcn_s_sleep(1);
        if ((++sp & 255u) == 0u) { if (xb_ld(&bar[XB_TMO])) break; if (sp > XB_SPIN_CAP) { atomicAdd(&bar[XB_TMO], 1u); break; } }
    }
    nloc = mine > 0u ? mine : 1u; nx = cnt > 0u ? cnt : 1u;
}

__device__ __forceinline__ void xcd_barrier(const XcdBarrier& b) {
    asm volatile("s_waitcnt vmcnt(0)" ::: "memory");
    __syncthreads();
    if (threadIdx.x == 0) {
        unsigned* bar = b.bar;
        __builtin_amdgcn_s_waitcnt(0);
        unsigned nloc = b.st[0], nx = b.st[1];
        if (nloc == 0u) { xcd_barrier_complete(bar, b.x, nloc, nx); b.st[0] = nloc; b.st[1] = nx; }
        const unsigned old = xb_add(&bar[XB_XSUB(b.x)], 1u);
        const unsigned gen = old / nloc;
        if (old + 1u == (gen + 1u) * nloc) {
            __builtin_amdgcn_fence(__ATOMIC_RELEASE, "agent");
            asm volatile("s_waitcnt vmcnt(0)" ::: "memory");
            const unsigned og = xb_add(&bar[XB_TOP], 1u);
            const unsigned tg = og / nx;
            if (og + 1u == (tg + 1u) * nx) xb_add(&bar[XB_TOPGEN], 1u);
            else XB_SPIN(xb_ld(&bar[XB_TOPGEN]) == tg, bar);
            __builtin_amdgcn_fence(__ATOMIC_ACQUIRE, "agent");
            xb_add(&bar[XB_XGEN(b.x)], 1u);
            asm volatile("s_waitcnt vmcnt(0)" ::: "memory");
        } else {
            XB_SPIN(xb_ld(&bar[XB_XGEN(b.x)]) == gen, bar);
            __builtin_amdgcn_fence(__ATOMIC_ACQUIRE, "agent");
            asm volatile("s_waitcnt vmcnt(0)" ::: "memory");
        }
    }
    __syncthreads();
}


__device__ __forceinline__ void cnt_barrier(unsigned* cw, unsigned& k) {
    asm volatile("s_waitcnt vmcnt(0)" ::: "memory");
    __syncthreads();
    if (threadIdx.x == 0) {
        __builtin_amdgcn_fence(__ATOMIC_RELEASE, "agent");
        asm volatile("s_waitcnt vmcnt(0)" ::: "memory");
        const unsigned G = gridDim.x;
        const unsigned old = xb_add(cw, 1u);
        if (old == G * (k + 1u) - 1u) xb_add(cw + 64, 1u);
        else { unsigned sp = 0; while (xb_ld(cw + 64) == k) { __builtin_amdgcn_s_sleep(1);
                if ((++sp & 255u) == 0u) { if (xb_ld(cw + 128)) break; if (sp > XB_SPIN_CAP) { atomicAdd(cw + 128, 1u); break; } } } }
        __builtin_amdgcn_fence(__ATOMIC_ACQUIRE, "agent");
        asm volatile("s_waitcnt vmcnt(0)" ::: "memory");
    }
    ++k;
    __syncthreads();
}
__device__ __forceinline__ float bf_lo(unsigned w) { return __uint_as_float(w << 16); }
__device__ __forceinline__ float bf_hi(unsigned w) { return __uint_as_float(w & 0xffff0000u); }
__device__ __forceinline__ float bf2f(bf16 v) { return __uint_as_float(((unsigned)v) << 16); }
__device__ __forceinline__ unsigned f2bf(float f) { unsigned u = __float_as_uint(f); return (u + 0x7fffu + ((u >> 16) & 1u)) >> 16; }
__device__ __forceinline__ unsigned pk2(float lo, float hi) { unsigned r; asm("v_cvt_pk_bf16_f32 %0, %1, %2" : "=v"(r) : "v"(lo), "v"(hi)); return r; }
__device__ __forceinline__ float wave_sum(float v) {
#pragma unroll
    for (int o = 1; o < 64; o <<= 1) v += __shfl_xor(v, o);
    return v;
}
__device__ __forceinline__ float wave_max(float v) {
#pragma unroll
    for (int o = 1; o < 64; o <<= 1) v = fmaxf(v, __shfl_xor(v, o));
    return v;
}
__device__ __forceinline__ float sigmoidf_(float x) { return __builtin_amdgcn_rcpf(1.0f + __builtin_amdgcn_exp2f(x * -1.4426950408889634f)); }
__device__ __forceinline__ float siluf_(float x) { return x * __builtin_amdgcn_rcpf(1.0f + __builtin_amdgcn_exp2f(x * -1.4426950408889634f)); }
#define LDS_WAIT() asm volatile("s_waitcnt lgkmcnt(0)" ::: "memory")

struct Args { const float* in[25]; float* out; unsigned char* ws; int ph_lo, ph_hi; };
struct ArgsG { const GAS float* in[25]; GAS float* out; GAS unsigned char* ws;
    __device__ __forceinline__ const float* I(int i) const { return (const float*)in[i]; }
    __device__ __forceinline__ unsigned char* W() const { return (unsigned char*)ws; }
    __device__ __forceinline__ float* O() const { return (float*)out; } };

__device__ __forceinline__ int map_win(int n);
__device__ __forceinline__ int map_gu(int n);
template <int MAP>
__device__ __forceinline__ void transpose_item(const float* W, int K, int N, bf16* WT, LAS float* scr, int item, int nblk, int lane) {
    const int kb = item / nblk, nb = item % nblk, k0 = 64 * kb, n0 = 32 * nb;
    const int nd = n0 + (lane & 31); const int src = MAP == 1 ? map_win(nd) : (MAP == 2 ? map_gu(nd) : nd);
    { const float* wp = W + (size_t)(k0 + (lane >> 5)) * N + (src >= 0 ? src : 0); LAS float* sp = scr + (lane >> 5) * 33 + (lane & 31); float v[32];
#pragma unroll
      for (int i = 0; i < 32; ++i) v[i] = __builtin_nontemporal_load(wp + (size_t)(2 * i) * N);
      __builtin_amdgcn_sched_barrier(0);
#pragma unroll
      for (int i = 0; i < 32; ++i) sp[2 * i * 33] = src >= 0 ? v[i] : 0.0f; }
    LDS_WAIT();
    const int c = lane & 7;
#pragma unroll
    for (int j = 0; j < 4; ++j) { const int n = (lane >> 3) + 8 * j; const LAS float* s = scr + (8 * c) * 33 + n;
        u32x4 o; o.x = pk2(s[0 * 33], s[1 * 33]); o.y = pk2(s[2 * 33], s[3 * 33]); o.z = pk2(s[4 * 33], s[5 * 33]); o.w = pk2(s[6 * 33], s[7 * 33]);
        __builtin_nontemporal_store(o, (u32x4*)(WT + (size_t)(n0 + n) * K + k0 + 8 * c)); }
    LDS_WAIT();
}
__device__ __forceinline__ int map_win(int n) {
    if (n < 2048) return n;
    if (n < C_KV) return 2056 + (n - C_NQ);
    if (n < C_CU) return 2312 + (n - C_KV);
    if (n < C_A) return 2708 + (n - C_CU);
    if (n < C_B) return 2048 + (n - C_A);
    if (n < C_G) return 2052 + (n - C_B);
    if (n < C_G + 12) return 2696 + (n - C_G);
    return -1;
}
__device__ __forceinline__ int map_gu(int n) { const int pn = n >> 8, r = n & 255; return (r < 128 ? 0 : 1024) + 128 * pn + (r & 127); }

__device__ __forceinline__ void ph_prologue(const ArgsG& a, LAS unsigned char* lds, int gw, int NGW, int wave, int lane, int part, int q_lo = 0, int q_hi = 1 << 30, int rank = -1, int nranks = 0) {
    LAS float* scr = (LAS float*)(lds + wave * 16384);
    bf16* WinT = (bf16*)(a.W() + WS_WIN); bf16* WoutT = (bf16*)(a.W() + WS_WOUT); bf16* WguT = (bf16*)(a.W() + WS_WGU); bf16* WdT = (bf16*)(a.W() + WS_WD);
    constexpr int I_IN = 16 * (NP / 32), I_OUT = 16 * 32, I_GU = 16 * 64, I_D = 16 * 32;
    constexpr int N_IN = NLAYER * I_IN, N_OUT = NLAYER * I_OUT, N_GU = NLAYER * NE * I_GU, N_D = NLAYER * NE * I_D;
    const int it_end = part == 0 ? N_IN + N_OUT : (N_GU + N_D) / 2, it_hi = q_hi < it_end ? q_hi : it_end;
    if (rank < 0) { rank = gw; nranks = NGW; }
    for (int it = q_lo + rank; it < it_hi; it += nranks) {
        int r = it;
        if (part != 0) r = r < N_GU / 2 ? N_IN + N_OUT + (part - 1) * (N_GU / 2) + r : N_IN + N_OUT + N_GU + (part - 1) * (N_D / 2) + (r - N_GU / 2);
        if (r < N_IN) { const int l = r / I_IN; transpose_item<1>(a.I(2) + (size_t)l * DM * DIN, DM, DIN, WinT + (size_t)l * NP * DM, scr, r % I_IN, NP / 32, lane); continue; } r -= N_IN;
        if (r < N_OUT) { const int l = r / I_OUT; transpose_item<0>(a.I(16) + (size_t)l * DM * DM, DM, DM, WoutT + (size_t)l * DM * DM, scr, r % I_OUT, 32, lane); continue; } r -= N_OUT;
        if (r < N_GU) { const int le = r / I_GU; transpose_item<2>(a.I(20) + (size_t)le * DM * 2048, DM, 2048, WguT + (size_t)le * 2048 * DM, scr, r % I_GU, 64, lane); continue; } r -= N_GU;
        { const int le = r / I_D; transpose_item<0>(a.I(22) + (size_t)le * DM * DM, DM, DM, WdT + (size_t)le * DM * DM, scr, r % I_D, 32, lane); }
    }
    if (part != 0) return;
    { bf16* W1T = (bf16*)(a.W() + WS_W1T);
        for (int it = gw; it < 4 * 128; it += NGW) { const int mtx = it >> 7; transpose_item<0>(a.I(10) + (size_t)mtx * 2048 * 128, 2048, 128, W1T + (size_t)mtx * 128 * 2048, scr, it & 127, 4, lane); }
        float* POSW = (float*)(a.W() + WS_POSW);
        for (int id = gw; id < 512; id += NGW) { const int mtx = id >> 7, nn_ = id & 127; const float* w1 = a.I(10) + (size_t)mtx * 2048 * 128; const float* pos = a.I(9) + (size_t)mtx * 2048; float acc = 0.f;
#pragma unroll 8
            for (int k = lane; k < 2048; k += 64) acc += pos[k] * w1[(size_t)k * 128 + nn_];
            acc = wave_sum(acc);
            if (lane == 0) POSW[id] = acc; } }
    { bf16* RWH = (bf16*)(a.W() + WS_RWH); bf16* RWL = (bf16*)(a.W() + WS_RWL);
        for (int i = gw * 64 + lane; i < NLAYER * NE * DM; i += NGW * 64) { const int d = i & (DM - 1), e = (i >> 10) & (NE - 1), l = i >> 15;
            const float w = a.I(18)[((size_t)l * DM + d) * NE + e]; const unsigned hi = f2bf(w); const float lo = w - __uint_as_float(hi << 16);
            RWH[i] = (bf16)hi; RWL[i] = (bf16)f2bf(lo); } }
    float* BT = (float*)(a.W() + WS_BT);
    for (int i = gw * 64 + lane; i < 4 * 2048; i += NGW * 64) {
        const int h = i >> 11, n = i & 2047; int bk;
        if (n < 16) bk = n; else { const float v = logf((float)n / 16.0f) / 2.0794415416798357f * 16.0f; bk = 16 + (int)v; bk = bk < 31 ? bk : 31; }
        BT[i] = a.I(24)[bk * 4 + h];
    }
}

__device__ __forceinline__ void rms_row_to_bf16(const f32x4 (&v)[4], const float* w, bf16* orow, int lane) {
    float s = 0.f;
#pragma unroll
    for (int j = 0; j < 4; ++j) s += (v[j].x * v[j].x + v[j].y * v[j].y) + (v[j].z * v[j].z + v[j].w * v[j].w);
    const float r = rsqrtf(wave_sum(s) * (1.0f / DM) + EPS);
#pragma unroll
    for (int j = 0; j < 4; ++j) { const f32x4 wv = *(const f32x4*)(w + 4 * (64 * j + lane)); const f32x4 y = v[j] * r * wv;
        u32x2 o; o.x = pk2(y.x, y.y); o.y = pk2(y.z, y.w); *(u32x2*)(orow + 4 * (64 * j + lane)) = o; }
}

__device__ __forceinline__ void ph_norm0(const ArgsG& a, int gw, int NGW, int lane) {
    bf16* XN = (bf16*)(a.W() + WS_XN);
    for (int tok = gw; tok < NT; tok += NGW) {
        f32x4 v[4];
#pragma unroll
        for (int j = 0; j < 4; ++j) v[j] = *(const f32x4*)(a.I(0) + (size_t)tok * DM + 4 * (64 * j + lane));
        rms_row_to_bf16(v, a.I(1), XN + (size_t)tok * DM, lane);
    }
}

__device__ __forceinline__ void ph_compress_mfma(const ArgsG& a, int l, LAS unsigned char* lds, int bid, int G, int tid, int wave, int lane) {
    LAS float* part = (LAS float*)lds;
    LAS float* hid = (LAS float*)(lds + 8 * 16 * 132 * 4);
    const bf16* P = (const bf16*)(a.W() + WS_P); bf16* KCMP = (bf16*)(a.W() + WS_KCMP); bf16* VCMP = (bf16*)(a.W() + WS_VCMP);
    const int r = lane & 15, q = lane >> 4;
    for (int u = bid; u < 128; u += G) {
        const int b = u >> 4, kv = (u >> 3) & 1, j0 = 16 * (u & 7);
        const bf16* arow = P + (size_t)(b * SEQ) * NP + C_KV + kv * 64;
        const bf16* brow = (const bf16*)(a.W() + WS_W1T) + ((size_t)(l * 2 + kv) * 128 + r) * 2048 + 8 * q;
        f32x4 acc[8];
#pragma unroll
        for (int nb = 0; nb < 8; ++nb) acc[nb] = (f32x4){0.f, 0.f, 0.f, 0.f};
#pragma unroll
        for (int s8 = 0; s8 < 8; ++s8) { const int ks = 8 * wave + s8; int tk = 16 * (j0 + r) + (ks >> 1); tk = tk < SEQ ? tk : SEQ - 1;
            const bf16x8 af = *(const bf16x8*)(arow + (size_t)tk * NP + (ks & 1) * 32 + 8 * q);
#pragma unroll
            for (int nb = 0; nb < 8; ++nb) acc[nb] = __builtin_amdgcn_mfma_f32_16x16x32_bf16(af, *(const bf16x8*)(brow + (size_t)(16 * nb) * 2048 + 32 * ks), acc[nb], 0, 0, 0); }
#pragma unroll
        for (int nb = 0; nb < 8; ++nb)
#pragma unroll
            for (int i = 0; i < 4; ++i) part[(wave * 16 + 4 * q + i) * 132 + 16 * nb + r] = acc[nb][i];
        __syncthreads();
        { const float* POSW = (const float*)(a.W() + WS_POSW) + (l * 2 + kv) * 128;
            for (int e = tid; e < 16 * 128; e += NTHR) { const int row = e >> 7, n = e & 127; float sacc = POSW[n];
#pragma unroll
                for (int w = 0; w < 8; ++w) sacc += part[(w * 16 + row) * 132 + n];
                hid[row * 132 + n] = siluf_(sacc); } }
        __syncthreads();
        { const int row = tid >> 5, c2 = tid & 31; const float* w2 = a.I(11) + (size_t)(l * 2 + kv) * 128 * 64; float o0 = 0.f, o1 = 0.f;
            for (int nn = 0; nn < 128; ++nn) { const float hv = hid[row * 132 + nn]; o0 += hv * w2[nn * 64 + 2 * c2]; o1 += hv * w2[nn * 64 + 2 * c2 + 1]; }
            if (kv == 0) { float ss = o0 * o0 + o1 * o1;
#pragma unroll
                for (int o_ = 1; o_ < 32; o_ <<= 1) ss += __shfl_xor(ss, o_);
                const float sc = rsqrtf(ss * (1.0f / 64.0f) + EPS); o0 *= sc * a.I(8)[l * 192 + 2 * c2]; o1 *= sc * a.I(8)[l * 192 + 2 * c2 + 1]; }
            const int j = j0 + row;
            *(unsigned*)((kv ? VCMP : KCMP) + (size_t)(b * 128 + j) * 64 + 2 * c2) = (j < 127) ? pk2(o0, o1) : 0u; }
        __syncthreads();
    }
}

__device__ __forceinline__ void ph_m1(const ArgsG& a, int l, LAS unsigned char* lds, int bid, int G, int tid, int wave, int lane) {
    const bf16* P = (const bf16*)(a.W() + WS_P);
    bf16* QN = (bf16*)(a.W() + WS_QN); bf16* KN = (bf16*)(a.W() + WS_KN); bf16* VC = (bf16*)(a.W() + WS_VC);
    bf16* KT = (bf16*)(a.W() + WS_KT); bf16* VT = (bf16*)(a.W() + WS_VT);
    float* Gb = (float*)(a.W() + WS_G); float* BETA = (float*)(a.W() + WS_BETA);
    bf16* NQ = (bf16*)(a.W() + WS_NQ); bf16* KS = (bf16*)(a.W() + WS_KS); bf16* KW = (bf16*)(a.W() + WS_KW); bf16* Y = (bf16*)(a.W() + WS_Y);
    const float* convw = a.I(3) + (size_t)l * 4 * 1536; const float* a_log = a.I(4) + l * 4; const float* dt_bias = a.I(5) + l * 4;
    const float* qnw = a.I(7) + l * 64; const float* knw = a.I(8) + l * 192;
    const float* dww = a.I(12) + (size_t)l * 31 * 256; const float* dwb = a.I(13) + l * 256; const float* lnw = a.I(14) + l * 256; const float* lnb = a.I(15) + l * 256;
    LAS float* dwl = (LAS float*)(lds + 65536);
    for (int i = tid; i < 31 * 256; i += NTHR) dwl[i] = dww[i];
    __syncthreads();
    for (int u = bid; u < NT / 64; u += G) {
        const int b = u >> 5, nchunk = u & 31, tw = nchunk * 64 + 8 * wave;
        const bf16* pw0 = P + (size_t)(b * SEQ + tw) * NP;
        { unsigned cx[11], nx[11]; float cw0[4], cw1[4], nw0[4], nw1[4];
#define DN_LOAD(idx, X, W0, W1) do { const int cb_ = ((idx) >> 2) * 512 + ((idx) & 3) * 128 + 2 * lane; \
            _Pragma("unroll") for (int j = 0; j < 4; ++j) { W0[j] = convw[j * 1536 + cb_]; W1[j] = convw[j * 1536 + cb_ + 1]; } \
            _Pragma("unroll") for (int j = 0; j < 3; ++j) { X[j] = 0u; if (tw - 3 + j >= 0) X[j] = *(const unsigned*)(pw0 + (ptrdiff_t)(j - 3) * NP + cb_); } \
            _Pragma("unroll") for (int i = 0; i < 8; ++i) X[3 + i] = *(const unsigned*)(pw0 + (size_t)i * NP + cb_); } while (0)
            DN_LOAD(0, cx, cw0, cw1);
#pragma unroll 1
            for (int idx = 0; idx < 12; ++idx) { const int ten = idx >> 2, h = idx & 3;
                if (idx + 1 < 12) DN_LOAD(idx + 1, nx, nw0, nw1);
                float xa[3] = {bf_lo(cx[0]), bf_lo(cx[1]), bf_lo(cx[2])}, xb[3] = {bf_hi(cx[0]), bf_hi(cx[1]), bf_hi(cx[2])};
                float ya[8], yb[8], sq[8];
#pragma unroll
                for (int i = 0; i < 8; ++i) { const unsigned w = cx[3 + i]; const float ca = bf_lo(w), cbv = bf_hi(w);
                    ya[i] = siluf_(cw0[0] * xa[0] + cw0[1] * xa[1] + cw0[2] * xa[2] + cw0[3] * ca); yb[i] = siluf_(cw1[0] * xb[0] + cw1[1] * xb[1] + cw1[2] * xb[2] + cw1[3] * cbv);
                    xa[0] = xa[1]; xa[1] = xa[2]; xa[2] = ca; xb[0] = xb[1]; xb[1] = xb[2]; xb[2] = cbv; sq[i] = ya[i] * ya[i] + yb[i] * yb[i]; }
                if (ten < 2) {
#pragma unroll
                    for (int o_ = 1; o_ < 64; o_ <<= 1) {
#pragma unroll
                        for (int i = 0; i < 8; ++i) sq[i] += __shfl_xor(sq[i], o_); }
                    const float qs_ = ten == 0 ? 0.08838834764831845f : 1.0f;
#pragma unroll
                    for (int i = 0; i < 8; ++i) { const float sc = rsqrtf(sq[i] + EPS) * qs_; ya[i] *= sc; yb[i] *= sc; } }
                unsigned pk[8];
#pragma unroll
                for (int i = 0; i < 8; ++i) pk[i] = pk2(ya[i], yb[i]);
                if (ten < 2) { bf16* dst = ten == 0 ? QN : KN;
#pragma unroll
                    for (int i = 0; i < 8; ++i) *(unsigned*)(dst + (size_t)(b * SEQ + tw + i) * 512 + h * 128 + 2 * lane) = pk[i]; }
                if (ten >= 1) {
                    bf16* tb = (ten == 1 ? KT : VT) + ((size_t)((b * 4 + h) * 32 + nchunk) * 128 + 2 * lane) * 64 + 8 * wave;
                    u32x4 lo, hi;
                    lo.x = (pk[0] & 0xffffu) | (pk[1] << 16); lo.y = (pk[2] & 0xffffu) | (pk[3] << 16); lo.z = (pk[4] & 0xffffu) | (pk[5] << 16); lo.w = (pk[6] & 0xffffu) | (pk[7] << 16);
                    hi.x = (pk[0] >> 16) | (pk[1] & 0xffff0000u); hi.y = (pk[2] >> 16) | (pk[3] & 0xffff0000u); hi.z = (pk[4] >> 16) | (pk[5] & 0xffff0000u); hi.w = (pk[6] >> 16) | (pk[7] & 0xffff0000u);
                    *(u32x4*)tb = lo; *(u32x4*)(tb + 64) = hi; }
#pragma unroll
                for (int j = 0; j < 11; ++j) cx[j] = nx[j];
#pragma unroll
                for (int j = 0; j < 4; ++j) { cw0[j] = nw0[j]; cw1[j] = nw1[j]; } }
#undef DN_LOAD
        }
        if (lane < 32) { const int i = lane >> 2, hd = lane & 3; const size_t tok = (size_t)(b * SEQ + tw + i); const bf16* prow = P + tok * NP;
            const float av = bf2f(prow[C_A + hd]), bv = bf2f(prow[C_B + hd]);
            BETA[tok * 4 + hd] = sigmoidf_(bv);
            const float x = av + dt_bias[hd]; const float sp = x > 20.0f ? x : log1pf(expf(x));
            Gb[tok * 4 + hd] = -expf(a_log[hd]) * sp; }
        { const float qw = qnw[lane] * (0.125f * 1.4426950408889634f), ksw = knw[64 + lane], kww = knw[128 + lane];
#pragma unroll 4
          for (int i = 0; i < 8; ++i) { const size_t tok = (size_t)(b * SEQ + tw + i); const bf16* prow = P + tok * NP;
            float xv[6];
#pragma unroll
            for (int h = 0; h < 4; ++h) xv[h] = bf2f(prow[C_NQ + h * 64 + lane]);
            xv[4] = bf2f(prow[C_KV + 128 + lane]); xv[5] = bf2f(prow[C_KV + 256 + lane]);
            float ss[6];
#pragma unroll
            for (int h = 0; h < 6; ++h) ss[h] = xv[h] * xv[h];
#pragma unroll
            for (int o_ = 1; o_ < 64; o_ <<= 1) {
#pragma unroll
                for (int h = 0; h < 6; ++h) ss[h] += __shfl_xor(ss[h], o_); }
#pragma unroll
            for (int h = 0; h < 4; ++h) NQ[tok * 256 + h * 64 + lane] = (bf16)f2bf(xv[h] * rsqrtf(ss[h] * (1.0f / 64.0f) + EPS) * qw);
            KS[tok * 64 + lane] = (bf16)f2bf(xv[4] * rsqrtf(ss[4] * (1.0f / 64.0f) + EPS) * ksw);
            KW[tok * 64 + lane] = (bf16)f2bf(xv[5] * rsqrtf(ss[5] * (1.0f / 64.0f) + EPS) * kww); } }
        { const int c = 4 * lane; f32x4 acc[8]; const f32x4 bias = *(const f32x4*)(dwb + c);
#pragma unroll
            for (int i = 0; i < 8; ++i) acc[i] = bias;
#pragma unroll 1
            for (int g8 = 0; g8 < 5; ++g8) { u32x2 av[8], gv[8];
#pragma unroll
                for (int rr = 0; rr < 8; ++rr) { const int r = 8 * g8 + rr; av[rr] = (u32x2){0u, 0u}; gv[rr] = (u32x2){0u, 0u};
                    if (r < 38 && tw - 30 + r >= 0) { const bf16* pr = pw0 + (ptrdiff_t)(r - 30) * NP + C_CU + c; av[rr] = *(const u32x2*)pr; gv[rr] = *(const u32x2*)(pr + 256); } }
#pragma unroll
                for (int rr = 0; rr < 8; ++rr) { const int r = 8 * g8 + rr;
                    f32x4 gl; gl.x = bf_lo(av[rr].x) * sigmoidf_(bf_lo(gv[rr].x)); gl.y = bf_hi(av[rr].x) * sigmoidf_(bf_hi(gv[rr].x)); gl.z = bf_lo(av[rr].y) * sigmoidf_(bf_lo(gv[rr].y)); gl.w = bf_hi(av[rr].y) * sigmoidf_(bf_hi(gv[rr].y));
#pragma unroll
                    for (int i = 0; i < 8; ++i) { const int j = r - i; if (j >= 0 && j <= 30) { const f32x4 w = *(const LAS f32x4*)(dwl + j * 256 + c); acc[i] += w * gl; } } } }
            const f32x4 lw = *(const f32x4*)(lnw + c), lb = *(const f32x4*)(lnb + c);
#pragma unroll
            for (int i = 0; i < 8; ++i) { const f32x4 x = acc[i]; const float mean = wave_sum((x.x + x.y) + (x.z + x.w)) * (1.0f / 256.0f);
                const f32x4 d = x - mean; const float var = wave_sum((d.x * d.x + d.y * d.y) + (d.z * d.z + d.w * d.w)) * (1.0f / 256.0f);
                const float rr = rsqrtf(var + EPS); const f32x4 y = d * rr * lw + lb;
                u32x2 o; o.x = pk2(siluf_(y.x), siluf_(y.y)); o.y = pk2(siluf_(y.z), siluf_(y.w));
                *(u32x2*)(Y + (size_t)(b * SEQ + tw + i) * DM + 768 + c) = o; } }
    }
}

constexpr int LM_PITCH = 68;
__device__ __forceinline__ void ph_dn_chunk_mfma(const ArgsG& a, LAS unsigned char* lds, int bid, int G, int tid, int wave, int lane) {
    LAS float* Lm = (LAS float*)lds;
    LAS float* gcl = (LAS float*)(lds + 4 * 64 * LM_PITCH * 4);
    LAS float* betal = gcl + 256; LAS float* bkl = betal + 256;
    const bf16* QN = (const bf16*)(a.W() + WS_QN); const bf16* KN = (const bf16*)(a.W() + WS_KN);
    const bf16* KT = (const bf16*)(a.W() + WS_KT); const bf16* VT = (const bf16*)(a.W() + WS_VT);
    const float* Gb = (const float*)(a.W() + WS_G); const float* BETA = (const float*)(a.W() + WS_BETA); float* GC = (float*)(a.W() + WS_GC);
    float* U = (float*)(a.W() + WS_U); bf16* W = (bf16*)(a.W() + WS_W); bf16* ATT = (bf16*)(a.W() + WS_ATT);
    const int n = lane & 31, hh = lane >> 5;
    for (int cb = bid; cb < 256; cb += G) {
        if (wave < 4) { const int b = cb >> 5, nn = cb & 31, h = wave, ci = (b * 4 + h) * 32 + nn, r0 = b * SEQ + nn * 64; (void)ci;
            float g = Gb[(size_t)(r0 + lane) * 4 + h];
#pragma unroll
            for (int off = 1; off < 64; off <<= 1) { const float v = __shfl_up(g, off); if (lane >= off) g += v; }
            const float be = BETA[(size_t)(r0 + lane) * 4 + h];
            gcl[wave * 64 + lane] = g; GC[(size_t)(r0 + lane) * 4 + h] = g; betal[wave * 64 + lane] = be; bkl[wave * 64 + lane] = be * __expf(g); }
        __syncthreads();
        { bf16x8 fa[8], fb[8], na[8], nb[8];
#define CH_LOAD(Q, FA, FB) do { const int id_ = 3 * wave + (Q), c_ = id_ / 6, wq_ = id_ % 6, isq_ = wq_ >= 3 ? 1 : 0, blk_ = wq_ % 3, ib_ = blk_ >= 1 ? 1 : 0, jb_ = blk_ == 2 ? 1 : 0; \
            const int b_ = cb >> 5, nn_ = cb & 31, r0_ = b_ * SEQ + nn_ * 64; \
            const bf16* ap_ = (isq_ ? QN : KN) + (size_t)(r0_ + 32 * ib_ + n) * 512 + c_ * 128 + 8 * hh; const bf16* bp_ = KN + (size_t)(r0_ + 32 * jb_ + n) * 512 + c_ * 128 + 8 * hh; \
            _Pragma("unroll") for (int ks = 0; ks < 8; ++ks) { FA[ks] = *(const bf16x8*)(ap_ + 16 * ks); FB[ks] = *(const bf16x8*)(bp_ + 16 * ks); } } while (0)
            CH_LOAD(0, fa, fb);
#pragma unroll 1
            for (int q = 0; q < 3; ++q) { const int id = 3 * wave + q, c = id / 6, wq = id % 6, isq = wq >= 3 ? 1 : 0, blk = wq % 3, ib = blk >= 1 ? 1 : 0, jb = blk == 2 ? 1 : 0;
                const int b = cb >> 5, nn = cb & 31, h = c, ci = (b * 4 + h) * 32 + nn;
                if (q + 1 < 3) CH_LOAD(q + 1, na, nb);
                f32x16 acc;
#pragma unroll
                for (int r = 0; r < 16; ++r) acc[r] = 0.f;
#pragma unroll
                for (int ks = 0; ks < 8; ++ks) acc = __builtin_amdgcn_mfma_f32_32x32x16_bf16(fa[ks], fb[ks], acc, 0, 0, 0);
                const int j = 32 * jb + n; const float gj = gcl[c * 64 + j];
#pragma unroll
                for (int r = 0; r < 16; ++r) { const int i = 32 * ib + (r & 3) + 8 * (r >> 2) + 4 * hh; const float dec = __expf(fminf(gcl[c * 64 + i] - gj, 0.f));
                    if (isq) ATT[(size_t)ci * 4096 + i * 64 + j] = (bf16)((j <= i) ? f2bf(acc[r] * dec) : 0u);
                    else Lm[c * 64 * LM_PITCH + i * LM_PITCH + j] = (j < i) ? betal[c * 64 + i] * acc[r] * dec : 0.f; }
#pragma unroll
                for (int ks = 0; ks < 8; ++ks) { fa[ks] = na[ks]; fb[ks] = nb[ks]; } }
#undef CH_LOAD
        }
        __syncthreads();
        if (wave < 4) { LAS float* L = Lm + wave * 64 * LM_PITCH; float T[64];
#pragma unroll
            for (int i = 0; i < 64; ++i) { float a0 = (i == lane) ? 1.f : 0.f, a1 = 0.f, a2 = 0.f, a3 = 0.f;
#pragma unroll
                for (int j4 = 0; j4 + 3 < i; j4 += 4) { const f32x4 lv = *(const LAS f32x4*)(L + i * LM_PITCH + j4);
                    a0 -= lv.x * T[j4]; a1 -= lv.y * T[j4 + 1]; a2 -= lv.z * T[j4 + 2]; a3 -= lv.w * T[j4 + 3]; }
#pragma unroll
                for (int j = (i / 4) * 4; j < i; ++j) a0 -= L[i * LM_PITCH + j] * T[j];
                T[i] = (a0 + a1) + (a2 + a3); }
#pragma unroll
            for (int i = 0; i < 64; ++i) L[i * LM_PITCH + lane] = T[i]; }
        __syncthreads();
        bf16x8 afc[4], afn[4];
#define CH2_LOAD(Q, F) do { const int id_ = wave * 4 + (Q), c_ = id_ >> 3, ten_ = (id_ >> 2) & 1, db_ = id_ & 3; const int ci_ = ((cb >> 5) * 4 + c_) * 32 + (cb & 31); \
            const bf16* ar_ = (ten_ ? KT : VT) + ((size_t)ci_ * 128 + 32 * db_ + n) * 64 + 8 * hh; _Pragma("unroll") for (int ks = 0; ks < 4; ++ks) F[ks] = *(const bf16x8*)(ar_ + 16 * ks); } while (0)
        CH2_LOAD(0, afc);
#pragma unroll 1
        for (int q = 0; q < 4; ++q) { const int id = wave * 4 + q, c = id >> 3, ten = (id >> 2) & 1, db = id & 3;
            if (q + 1 < 4) CH2_LOAD(q + 1, afn);
            const int b = cb >> 5, nn = cb & 31, h = c, ci = (b * 4 + h) * 32 + nn, r0 = b * SEQ + nn * 64;
            const LAS float* scl = (ten ? bkl : betal) + c * 64;
            const LAS float* L = Lm + c * 64 * LM_PITCH;
#pragma unroll
            for (int ib = 0; ib < 2; ++ib) { f32x16 acc;
#pragma unroll
                for (int r = 0; r < 16; ++r) acc[r] = 0.f;
#pragma unroll
                for (int ks = 0; ks < 4; ++ks) { if (ib == 0 && ks >= 2) continue;
                    const LAS float* tp = L + (32 * ib + n) * LM_PITCH + 16 * ks + 8 * hh;
                    const f32x4 t0 = *(const LAS f32x4*)tp, t1 = *(const LAS f32x4*)(tp + 4), s0 = *(const LAS f32x4*)(scl + 16 * ks + 8 * hh), s1 = *(const LAS f32x4*)(scl + 16 * ks + 8 * hh + 4);
                    u32x4 bw; bw.x = pg8::cvt_pk_bf16(t0.x * s0.x, t0.y * s0.y); bw.y = pg8::cvt_pk_bf16(t0.z * s0.z, t0.w * s0.w); bw.z = pg8::cvt_pk_bf16(t1.x * s1.x, t1.y * s1.y); bw.w = pg8::cvt_pk_bf16(t1.z * s1.z, t1.w * s1.w);
                    acc = __builtin_amdgcn_mfma_f32_32x32x16_bf16(afc[ks], __builtin_bit_cast(bf16x8, bw), acc, 0, 0, 0); }
                const size_t ob = (size_t)(r0 + 32 * ib + n) * 512 + h * 128 + 32 * db + 4 * hh;
#pragma unroll
                for (int rq = 0; rq < 4; ++rq) {
                    if (ten) { u32x2 w2; w2.x = pk2(acc[4 * rq], acc[4 * rq + 1]); w2.y = pk2(acc[4 * rq + 2], acc[4 * rq + 3]); *(u32x2*)(W + ob + 8 * rq) = w2; }
                    else *(f32x4*)(U + ob + 8 * rq) = (f32x4){acc[4 * rq], acc[4 * rq + 1], acc[4 * rq + 2], acc[4 * rq + 3]}; } }
#pragma unroll
            for (int ks = 0; ks < 4; ++ks) afc[ks] = afn[ks]; }
#undef CH2_LOAD
        __syncthreads();
    }
}

constexpr int SC_WP = 272, SC_AP = 144;
constexpr int SC_W = 0, SC_Q = 64 * SC_WP, SC_A = 2 * 64 * SC_WP, SC_K = SC_A + 64 * SC_AP, SC_GC = SC_K + 128 * SC_AP, SC_BUF = SC_GC + 1024;
static_assert(2 * SC_BUF <= RING_BYTES, "scan LDS");
struct ScanPf { u32x4 w[4], q[4], at[2], k[4]; float g, gl; };
__device__ __forceinline__ ScanPf scan_load(const bf16* W, const bf16* QN, const bf16* ATT, const bf16* KT, const float* GC, int r0, int h, int ci, int lt) {
    ScanPf p; const int row = lt >> 4, seg = lt & 15;
#pragma unroll
    for (int i = 0; i < 4; ++i) { const size_t go = (size_t)(r0 + row + 16 * i) * 512 + h * 128 + seg * 8; p.w[i] = *(const u32x4*)(W + go); p.q[i] = *(const u32x4*)(QN + go); }
#pragma unroll
    for (int i = 0; i < 2; ++i) p.at[i] = *(const u32x4*)(ATT + (size_t)ci * 4096 + (lt + 256 * i) * 8);
#pragma unroll
    for (int i = 0; i < 4; ++i) p.k[i] = *(const u32x4*)(KT + (size_t)ci * 8192 + (lt + 256 * i) * 8);
    p.g = GC[(size_t)(r0 + (lt & 63)) * 4 + h]; p.gl = GC[(size_t)(r0 + 63) * 4 + h]; return p;
}
__device__ __forceinline__ void scan_store(const ScanPf& p, LAS unsigned char* buf, int lt) {
    const int row = lt >> 4, seg = lt & 15;
#pragma unroll
    for (int i = 0; i < 4; ++i) { *(LAS u32x4*)(buf + SC_W + (row + 16 * i) * SC_WP + seg * 16) = p.w[i]; *(LAS u32x4*)(buf + SC_Q + (row + 16 * i) * SC_WP + seg * 16) = p.q[i]; }
#pragma unroll
    for (int i = 0; i < 2; ++i) *(LAS u32x4*)(buf + SC_A + ((lt >> 3) + 32 * i) * SC_AP + (lt & 7) * 16) = p.at[i];
#pragma unroll
    for (int i = 0; i < 4; ++i) *(LAS u32x4*)(buf + SC_K + ((lt >> 3) + 32 * i) * SC_AP + (lt & 7) * 16) = p.k[i];
    if (lt < 64) { LAS float* gp = (LAS float*)(buf + SC_GC); gp[lt] = __expf(p.g); gp[64 + lt] = __expf(p.gl - p.g); if (lt == 0) gp[128] = __expf(p.gl); }
}
__device__ __forceinline__ bf16x8 frag2(const LAS unsigned char* p) { const u32x2 lo = *(const LAS u32x2*)p, hi = *(const LAS u32x2*)(p + 16); const u32x4 v = {lo.x, lo.y, hi.x, hi.y}; return __builtin_bit_cast(bf16x8, v); }
__device__ __forceinline__ void ph_dn_scan_mfma(const ArgsG& a, LAS unsigned char* lds, int bid, int G, int tid, int wave, int lane) {
    const bf16* QN = (const bf16*)(a.W() + WS_QN); const bf16* KT = (const bf16*)(a.W() + WS_KT); const bf16* W = (const bf16*)(a.W() + WS_W); const bf16* ATT = (const bf16*)(a.W() + WS_ATT);
    const float* GC = (const float*)(a.W() + WS_GC); const float* U = (const float*)(a.W() + WS_U); float* O = (float*)(a.W() + WS_O);
    const int n = lane & 31, hh = lane >> 5;
    for (int u = bid; u < 32; u += G) {
        const int h = u & 3, b = u >> 2;
        f32x16 S[4];
#pragma unroll
        for (int k = 0; k < 4; ++k)
#pragma unroll
            for (int r = 0; r < 16; ++r) S[k][r] = 0.f;
        __syncthreads();
        if (wave >= 4) { const ScanPf p0 = scan_load(W, QN, ATT, KT, GC, b * SEQ, h, (b * 4 + h) * 32, tid - 256); scan_store(p0, lds, tid - 256); }
        __syncthreads();
#pragma unroll 1
        for (int nn = 0; nn < 32; ++nn) {
            const int r0 = b * SEQ + nn * 64; LAS unsigned char* buf = lds + (nn & 1) * SC_BUF; const LAS float* gp = (const LAS float*)(buf + SC_GC);
            if (wave >= 4) { if (nn + 1 < 32) { const ScanPf pf = scan_load(W, QN, ATT, KT, GC, r0 + 64, h, (b * 4 + h) * 32 + nn + 1, tid - 256); scan_store(pf, lds + ((nn + 1) & 1) * SC_BUF, tid - 256); } }
            else {
                const size_t ubase = (size_t)r0 * 512 + h * 128 + 32 * wave + n;
                f32x16 vn[2];
#pragma unroll
                for (int ib = 0; ib < 2; ++ib)
#pragma unroll
                    for (int r = 0; r < 16; ++r) vn[ib][r] = U[ubase + (size_t)(32 * ib + (r & 3) + 8 * (r >> 2) + 4 * hh) * 512];
                bf16x8 Sb[4][2];
#pragma unroll
                for (int k = 0; k < 4; ++k)
#pragma unroll
                    for (int s2 = 0; s2 < 2; ++s2) { u32x4 w4; w4.x = pg8::cvt_pk_bf16(S[k][8 * s2], S[k][8 * s2 + 1]); w4.y = pg8::cvt_pk_bf16(S[k][8 * s2 + 2], S[k][8 * s2 + 3]);
                        w4.z = pg8::cvt_pk_bf16(S[k][8 * s2 + 4], S[k][8 * s2 + 5]); w4.w = pg8::cvt_pk_bf16(S[k][8 * s2 + 6], S[k][8 * s2 + 7]); Sb[k][s2] = __builtin_bit_cast(bf16x8, w4); }
#pragma unroll
                for (int ib = 0; ib < 2; ++ib) { f32x16 acc;
#pragma unroll
                    for (int r = 0; r < 16; ++r) acc[r] = 0.f;
#pragma unroll
                    for (int k = 0; k < 4; ++k)
#pragma unroll
                        for (int s2 = 0; s2 < 2; ++s2) acc = __builtin_amdgcn_mfma_f32_32x32x16_bf16(frag2(buf + SC_W + (32 * ib + n) * SC_WP + (32 * k + 16 * s2 + 4 * hh) * 2), Sb[k][s2], acc, 0, 0, 0);
#pragma unroll
                    for (int r = 0; r < 16; ++r) vn[ib][r] -= acc[r]; }
                bf16x8 vb[2][2], vd[2][2];
#pragma unroll
                for (int jb = 0; jb < 2; ++jb)
#pragma unroll
                    for (int s2 = 0; s2 < 2; ++s2) { const f32x4 d0 = *(const LAS f32x4*)(gp + 64 + 32 * jb + 16 * s2 + 4 * hh), d1 = *(const LAS f32x4*)(gp + 64 + 32 * jb + 16 * s2 + 8 + 4 * hh);
                        const float* v = nullptr; (void)v; u32x4 w4, w5;
                        w4.x = pg8::cvt_pk_bf16(vn[jb][8 * s2], vn[jb][8 * s2 + 1]); w4.y = pg8::cvt_pk_bf16(vn[jb][8 * s2 + 2], vn[jb][8 * s2 + 3]);
                        w4.z = pg8::cvt_pk_bf16(vn[jb][8 * s2 + 4], vn[jb][8 * s2 + 5]); w4.w = pg8::cvt_pk_bf16(vn[jb][8 * s2 + 6], vn[jb][8 * s2 + 7]);
                        w5.x = pg8::cvt_pk_bf16(vn[jb][8 * s2] * d0.x, vn[jb][8 * s2 + 1] * d0.y); w5.y = pg8::cvt_pk_bf16(vn[jb][8 * s2 + 2] * d0.z, vn[jb][8 * s2 + 3] * d0.w);
                        w5.z = pg8::cvt_pk_bf16(vn[jb][8 * s2 + 4] * d1.x, vn[jb][8 * s2 + 5] * d1.y); w5.w = pg8::cvt_pk_bf16(vn[jb][8 * s2 + 6] * d1.z, vn[jb][8 * s2 + 7] * d1.w);
                        vb[jb][s2] = __builtin_bit_cast(bf16x8, w4); vd[jb][s2] = __builtin_bit_cast(bf16x8, w5); }
#pragma unroll
                for (int ib = 0; ib < 2; ++ib) { f32x16 acc;
#pragma unroll
                    for (int r = 0; r < 16; ++r) acc[r] = 0.f;
#pragma unroll
                    for (int k = 0; k < 4; ++k)
#pragma unroll
                        for (int s2 = 0; s2 < 2; ++s2) acc = __builtin_amdgcn_mfma_f32_32x32x16_bf16(frag2(buf + SC_Q + (32 * ib + n) * SC_WP + (32 * k + 16 * s2 + 4 * hh) * 2), Sb[k][s2], acc, 0, 0, 0);
#pragma unroll
                    for (int rq = 0; rq < 4; ++rq) { const f32x4 e4 = *(const LAS f32x4*)(gp + 32 * ib + 8 * rq + 4 * hh);
                        acc[4 * rq] *= e4.x; acc[4 * rq + 1] *= e4.y; acc[4 * rq + 2] *= e4.z; acc[4 * rq + 3] *= e4.w; }
#pragma unroll
                    for (int jb = 0; jb < 2; ++jb) { if (jb > ib) continue;
#pragma unroll
                        for (int s2 = 0; s2 < 2; ++s2) acc = __builtin_amdgcn_mfma_f32_32x32x16_bf16(frag2(buf + SC_A + (32 * ib + n) * SC_AP + (32 * jb + 16 * s2 + 4 * hh) * 2), vb[jb][s2], acc, 0, 0, 0); }
#pragma unroll
                    for (int r = 0; r < 16; ++r) O[ubase + (size_t)(32 * ib + (r & 3) + 8 * (r >> 2) + 4 * hh) * 512] = acc[r]; }
                const float egl = gp[128];
#pragma unroll
                for (int k = 0; k < 4; ++k) {
#pragma unroll
                    for (int r = 0; r < 16; ++r) S[k][r] *= egl;
#pragma unroll
                    for (int jb = 0; jb < 2; ++jb)
#pragma unroll
                        for (int s2 = 0; s2 < 2; ++s2) S[k] = __builtin_amdgcn_mfma_f32_32x32x16_bf16(frag2(buf + SC_K + (32 * k + n) * SC_AP + (32 * jb + 16 * s2 + 4 * hh) * 2), vd[jb][s2], S[k], 0, 0, 0); }
            }
            asm volatile("s_waitcnt lgkmcnt(0)" ::: "memory"); __builtin_amdgcn_s_barrier(); asm volatile("" ::: "memory");
        }
        __syncthreads();
    }
}

__device__ __forceinline__ void ph_dn_out(const ArgsG& a, int l, int gw, int NGW, int lane) {
    const float* O = (const float*)(a.W() + WS_O); const bf16* P = (const bf16*)(a.W() + WS_P); bf16* Y = (bf16*)(a.W() + WS_Y);
    const float* nw = a.I(6) + l * 128; const float n0 = nw[2 * lane], n1 = nw[2 * lane + 1];
    int tok = gw; if (tok >= NT) return;
    float oc[4][2], on[4][2]; unsigned zc[4], zn[4];
#pragma unroll
    for (int h = 0; h < 4; ++h) { oc[h][0] = O[(size_t)tok * 512 + h * 128 + 2 * lane]; oc[h][1] = O[(size_t)tok * 512 + h * 128 + 2 * lane + 1]; zc[h] = *(const unsigned*)(P + (size_t)tok * NP + C_Z + h * 128 + 2 * lane); }
#pragma unroll 1
    for (; tok < NT; tok += NGW) { const int tn = tok + NGW;
        if (tn < NT) {
#pragma unroll
            for (int h = 0; h < 4; ++h) { on[h][0] = O[(size_t)tn * 512 + h * 128 + 2 * lane]; on[h][1] = O[(size_t)tn * 512 + h * 128 + 2 * lane + 1]; zn[h] = *(const unsigned*)(P + (size_t)tn * NP + C_Z + h * 128 + 2 * lane); } }
        float ss[4];
#pragma unroll
        for (int h = 0; h < 4; ++h) ss[h] = oc[h][0] * oc[h][0] + oc[h][1] * oc[h][1];
#pragma unroll
        for (int o_ = 1; o_ < 64; o_ <<= 1) {
#pragma unroll
            for (int h = 0; h < 4; ++h) ss[h] += __shfl_xor(ss[h], o_); }
#pragma unroll
        for (int h = 0; h < 4; ++h) { const float r = rsqrtf(ss[h] * (1.0f / 128.0f) + EPS);
            *(unsigned*)(Y + (size_t)tok * DM + h * 128 + 2 * lane) = pk2(oc[h][0] * r * n0 * siluf_(bf_lo(zc[h])), oc[h][1] * r * n1 * siluf_(bf_hi(zc[h]))); }
#pragma unroll
        for (int h = 0; h < 4; ++h) { oc[h][0] = on[h][0]; oc[h][1] = on[h][1]; zc[h] = zn[h]; } }
}

constexpr int NSA_KT_PITCH = 144, NSA_VT_PITCH = 136;
struct NsaStage { u32x4 kv, vv; };
__device__ __forceinline__ NsaStage nsa_load(const bf16* Kbase, int kpitch, const bf16* Vbase, int vpitch, int tid) {
    const int key = tid >> 3, seg = tid & 7; NsaStage s;
    s.kv = *(const u32x4*)(Kbase + (size_t)key * kpitch + seg * 8); s.vv = *(const u32x4*)(Vbase + (size_t)key * vpitch + seg * 8); return s;
}
__device__ __forceinline__ void nsa_store(const NsaStage& s, LAS unsigned char* Kt, LAS unsigned char* Vt, int tid) {
    const int key = tid >> 3, seg = tid & 7;
    *(LAS u32x4*)(Kt + key * NSA_KT_PITCH + seg * 16) = s.kv;
#pragma unroll
    for (int i = 0; i < 4; ++i) { const unsigned w = s.vv[i];
        *(LAS unsigned short*)(Vt + (seg * 8 + 2 * i) * NSA_VT_PITCH + key * 2) = (unsigned short)(w & 0xffffu);
        *(LAS unsigned short*)(Vt + (seg * 8 + 2 * i + 1) * NSA_VT_PITCH + key * 2) = (unsigned short)(w >> 16); }
}
__device__ __forceinline__ void nsa_st(const LAS unsigned char* Kt, const bf16x8 (&qf)[4], int n, int hh, f32x16 (&s)[2]) {
#pragma unroll
    for (int kb = 0; kb < 2; ++kb) {
#pragma unroll
        for (int r = 0; r < 16; ++r) s[kb][r] = 0.f;
#pragma unroll
        for (int ks = 0; ks < 4; ++ks) { const bf16x8 af = *(const LAS bf16x8*)(Kt + (kb * 32 + n) * NSA_KT_PITCH + (16 * ks + 8 * hh) * 2);
            s[kb] = __builtin_amdgcn_mfma_f32_32x32x16_bf16(af, qf[ks], s[kb], 0, 0, 0); } }
}
__device__ __forceinline__ void nsa_pvm(const LAS unsigned char* Vt, const bf16x8 (&pf)[2][2], int n, int hh, f32x16 (&o)[2]) {
#pragma unroll
    for (int db = 0; db < 2; ++db)
#pragma unroll
        for (int kb = 0; kb < 2; ++kb)
#pragma unroll
            for (int s2 = 0; s2 < 2; ++s2) { const LAS unsigned char* p = Vt + (db * 32 + n) * NSA_VT_PITCH + (kb * 32 + 16 * s2 + 4 * hh) * 2;
                const u32x2 lo = *(const LAS u32x2*)p, hi = *(const LAS u32x2*)(p + 16);
                const u32x4 av = {lo.x, lo.y, hi.x, hi.y};
                o[db] = __builtin_amdgcn_mfma_f32_32x32x16_bf16(__builtin_bit_cast(bf16x8, av), pf[kb][s2], o[db], 0, 0, 0); }
}
__device__ __forceinline__ void nsa_pack(const f32x16 (&p)[2], bf16x8 (&pf)[2][2]) {
#pragma unroll
    for (int kb = 0; kb < 2; ++kb)
#pragma unroll
        for (int s2 = 0; s2 < 2; ++s2) { u32x4 w;
            w.x = pg8::cvt_pk_bf16(p[kb][8 * s2 + 0], p[kb][8 * s2 + 1]); w.y = pg8::cvt_pk_bf16(p[kb][8 * s2 + 2], p[kb][8 * s2 + 3]);
            w.z = pg8::cvt_pk_bf16(p[kb][8 * s2 + 4], p[kb][8 * s2 + 5]); w.w = pg8::cvt_pk_bf16(p[kb][8 * s2 + 6], p[kb][8 * s2 + 7]);
            pf[kb][s2] = __builtin_bit_cast(bf16x8, w); }
}
constexpr int BT2_ROWS = 2048 + 72;
template <bool COLSEL>
__device__ __forceinline__ void nsa_tile_mfma(const LAS unsigned char* Kt, const LAS unsigned char* Vt, const LAS float* btl2h, const bf16x8 (&qf)[4], int n, int hh,
                                              int key0, int tq, bool masked, bool colsel, int maxd, float& m, float& l, f32x16 (&o)[2]) {
    f32x16 s[2]; nsa_st(Kt, qf, n, hh, s);
    const int dbase = tq - key0 - 4 * hh;
    const LAS float* bp = btl2h + (2047 - dbase) * 4;
#pragma unroll
    for (int kb = 0; kb < 2; ++kb)
#pragma unroll
        for (int r = 0; r < 16; ++r) { const int cst = kb * 32 + (r & 3) + 8 * (r >> 2); const float x = s[kb][r] + bp[cst * 4]; s[kb][r] = (!COLSEL || colsel) ? x : -3.0e38f; }
    if (masked) {
#pragma unroll
        for (int kb = 0; kb < 2; ++kb)
#pragma unroll
            for (int r = 0; r < 16; ++r) { const int dist = dbase - (kb * 32 + (r & 3) + 8 * (r >> 2)); s[kb][r] = (dist >= 0 && dist <= maxd) ? s[kb][r] : -3.0e38f; } }
    float tmax = -3.0e38f;
#pragma unroll
    for (int kb = 0; kb < 2; ++kb)
#pragma unroll
        for (int r = 0; r < 16; ++r) tmax = fmaxf(tmax, s[kb][r]);
    tmax = fmaxf(tmax, __shfl_xor(tmax, 32));
    const float mn = fmaxf(m, tmax); float rs = 0.f;
#pragma unroll
    for (int kb = 0; kb < 2; ++kb)
#pragma unroll
        for (int r = 0; r < 16; ++r) { const float p = __builtin_amdgcn_exp2f(s[kb][r] - mn); s[kb][r] = p; rs += p; }
    rs += __shfl_xor(rs, 32);
    if (__any(mn > m)) { const float corr = __builtin_amdgcn_exp2f(m - mn); l *= corr;
#pragma unroll
        for (int db = 0; db < 2; ++db)
#pragma unroll
            for (int r = 0; r < 16; ++r) o[db][r] *= corr; }
    l += rs; m = mn;
    bf16x8 pf[2][2]; nsa_pack(s, pf);
    nsa_pvm(Vt, pf, n, hh, o);
}

__device__ __forceinline__ void ph_nsa_mfma(const ArgsG& a, LAS unsigned char* lds, int ubeg, int ustep, int uend, int tid, int wave, int lane) {
    LAS float* btl2 = (LAS float*)lds;
    constexpr int NSA_L0 = BT2_ROWS * 16;
    LAS unsigned char* Kt = lds + NSA_L0;
    LAS unsigned char* Vt = lds + NSA_L0 + 9216;
    constexpr int NSA_TB = 9216 + 8704;
    LAS float* PS = (LAS float*)(lds + NSA_L0 + 2 * NSA_TB + 256);
    LAS unsigned* MK = (LAS unsigned*)(lds + NSA_L0 + 2 * NSA_TB + 256 + 64 * 129 * 4);
    static_assert(NSA_L0 + 2 * NSA_TB + 256 + 64 * 129 * 4 + 512 <= RING_BYTES, "NSA LDS");
    const float* BT = (const float*)(a.W() + WS_BT);
    for (int i = tid; i < BT2_ROWS * 4; i += NTHR) { const int row = i >> 2, hd = i & 3; btl2[i] = row < 2048 ? BT[hd * 2048 + (2047 - row)] * 1.4426950408889634f : 0.f; }
    const bf16* P = (const bf16*)(a.W() + WS_P); const bf16* NQ = (const bf16*)(a.W() + WS_NQ);
    const bf16* KS = (const bf16*)(a.W() + WS_KS); const bf16* KW = (const bf16*)(a.W() + WS_KW);
    const bf16* KCMP = (const bf16*)(a.W() + WS_KCMP); const bf16* VCMP = (const bf16*)(a.W() + WS_VCMP); bf16* Y = (bf16*)(a.W() + WS_Y);
    const int n = lane & 31, hh = lane >> 5, tl = n >> 2, h = n & 3;
    const LAS float* btl2h = btl2 + h;
    __syncthreads();
    for (int u = ubeg; u < uend; u += ustep) {
        const int b = u & 7, qt = 31 - (u >> 3), t0 = 64 * qt, tq = t0 + 8 * wave + tl, tok = b * SEQ + tq;
        bf16x8 qf[4];
#pragma unroll
        for (int ks = 0; ks < 4; ++ks) qf[ks] = *(const bf16x8*)(NQ + (size_t)tok * 256 + h * 64 + 16 * ks + 8 * hh);
        float gate[3];
#pragma unroll
        for (int br = 0; br < 3; ++br) gate[br] = sigmoidf_(bf2f(P[(size_t)tok * NP + C_G + h * 3 + br]));
        f32x16 yacc[2];
        {
            float mx = -1e30f, rs = 0.f;
#pragma unroll 1
            for (int ct = 0; ct < 2; ++ct) {
                __syncthreads();
                { const NsaStage st = nsa_load(KCMP + (size_t)(b * 128 + ct * 64) * 64, 64, VCMP + (size_t)(b * 128 + ct * 64) * 64, 64, tid); nsa_store(st, Kt, Vt, tid); }
                __syncthreads();
                f32x16 sc[2]; nsa_st(Kt, qf, n, hh, sc);
                float tmax = -1e30f;
#pragma unroll
                for (int kb = 0; kb < 2; ++kb)
#pragma unroll
                    for (int r = 0; r < 16; ++r) { const int j = ct * 64 + kb * 32 + (r & 3) + 8 * (r >> 2) + 4 * hh; const int dist = tq - 16 * j - 31;
                        const float x = sc[kb][r] + btl2h[(2047 - (dist < 0 ? 0 : dist)) * 4]; sc[kb][r] = dist >= 0 ? x : -1e30f; tmax = fmaxf(tmax, sc[kb][r]); }
                tmax = fmaxf(tmax, __shfl_xor(tmax, 32));
                const float mn = fmaxf(mx, tmax); float ts = 0.f;
#pragma unroll
                for (int kb = 0; kb < 2; ++kb)
#pragma unroll
                    for (int r = 0; r < 16; ++r) { const float x = sc[kb][r]; ts += x > -1e29f ? __builtin_amdgcn_exp2f(x - mn) : 0.f; }
                ts += __shfl_xor(ts, 32);
                rs = rs * __builtin_amdgcn_exp2f(mx - mn) + ts; mx = mn;
            }
            const float inv = rs > 0.f ? 1.0f / rs : 0.f;
            f32x16 o[2];
#pragma unroll
            for (int db = 0; db < 2; ++db)
#pragma unroll
                for (int r = 0; r < 16; ++r) o[db][r] = 0.f;
#pragma unroll 1
            for (int cc = 0; cc < 2; ++cc) { const int ct = 1 - cc;
                if (cc == 1) { __syncthreads();
                    { const NsaStage st = nsa_load(KCMP + (size_t)(b * 128) * 64, 64, VCMP + (size_t)(b * 128) * 64, 64, tid); nsa_store(st, Kt, Vt, tid); }
                    __syncthreads(); }
                f32x16 sc[2]; nsa_st(Kt, qf, n, hh, sc);
#pragma unroll
                for (int kb = 0; kb < 2; ++kb)
#pragma unroll
                    for (int r = 0; r < 16; ++r) { const int j = ct * 64 + kb * 32 + (r & 3) + 8 * (r >> 2) + 4 * hh; const int dist = tq - 16 * j - 31;
                        const float x = sc[kb][r] + btl2h[(2047 - (dist < 0 ? 0 : dist)) * 4]; const float p = dist >= 0 ? __builtin_amdgcn_exp2f(x - mx) * inv : 0.f; sc[kb][r] = p;
                        float v = p; v += __uint_as_float(__builtin_amdgcn_update_dpp(0u, __float_as_uint(v), 0xB1, 0xF, 0xF, true)); v += __uint_as_float(__builtin_amdgcn_update_dpp(0u, __float_as_uint(v), 0x4E, 0xF, 0xF, true));
                        if (h == 0) PS[(8 * wave + tl) * 129 + j] = v; }
                bf16x8 pf[2][2]; nsa_pack(sc, pf); nsa_pvm(Vt, pf, n, hh, o);
            }
#pragma unroll
            for (int db = 0; db < 2; ++db)
#pragma unroll
                for (int r = 0; r < 16; ++r) yacc[db][r] = gate[0] * o[db][r];
        }
        LDS_WAIT();
        for (int t2 = 0; t2 < 8; ++t2) {
            const int tqq = t0 + 8 * wave + t2, sb = lane & 31, cur = tqq >> 6; const LAS float* row = PS + (8 * wave + t2) * 129; float imp = 0.f;
#pragma unroll
            for (int dj = -1; dj <= 3; ++dj) { const int j = 4 * sb + dj; if (j >= 0 && j <= 126) imp += row[j]; }
            if (sb > cur) imp = -1.0f; else if (sb == 0 || sb == cur || sb == cur - 1) imp = 1e4f;
            int rank = 0;
#pragma unroll
            for (int s2 = 0; s2 < 32; ++s2) { const float v2 = __uint_as_float(__builtin_amdgcn_readlane(__float_as_uint(imp), s2)); rank += (v2 > imp || (v2 == imp && s2 < sb)) ? 1 : 0; }
            const unsigned msk = (unsigned)__ballot((lane < 32) && (rank < 16) && (sb <= cur));
            if (lane == 0) MK[8 * wave + t2] = msk;
        }
        __syncthreads();
        unsigned anymask, wmask; const unsigned mymask = MK[8 * wave + tl];
        { unsigned v = MK[lane];
#pragma unroll
            for (int o_ = 1; o_ < 64; o_ <<= 1) v |= (unsigned)__shfl_xor((int)v, o_);
            anymask = (unsigned)__builtin_amdgcn_readfirstlane((int)v);
            unsigned w = MK[8 * wave + (lane & 7)]; w |= (unsigned)__shfl_xor((int)w, 1); w |= (unsigned)__shfl_xor((int)w, 2); w |= (unsigned)__shfl_xor((int)w, 4);
            wmask = (unsigned)__builtin_amdgcn_readfirstlane((int)w); }
        LAS unsigned* stash = (LAS unsigned*)PS + (wave * 16) * 64 + lane;
        __syncthreads();
#pragma unroll
        for (int db = 0; db < 2; ++db)
#pragma unroll
            for (int k = 0; k < 8; ++k) stash[(db * 8 + k) * 64] = pk2(yacc[db][2 * k], yacc[db][2 * k + 1]);
        {
            float m = -1e30f, l = 0.f; f32x16 o[2];
#pragma unroll
            for (int db = 0; db < 2; ++db)
#pragma unroll
                for (int r = 0; r < 16; ++r) o[db][r] = 0.f;
            unsigned mk = anymask; NsaStage s0, s1; bool h1 = false;
            { const int sa = __builtin_ctz(mk); s0 = nsa_load(KS + (size_t)(b * SEQ + 64 * sa) * 64, 64, P + (size_t)(b * SEQ + 64 * sa) * NP + C_KV + 192, NP, tid);
              unsigned m2 = mk & (mk - 1u); if (m2) { const int sb2 = __builtin_ctz(m2); s1 = nsa_load(KS + (size_t)(b * SEQ + 64 * sb2) * 64, 64, P + (size_t)(b * SEQ + 64 * sb2) * NP + C_KV + 192, NP, tid); h1 = true; } }
            __syncthreads();
            nsa_store(s0, Kt, Vt, tid);
            __syncthreads();
            int par = 0;
            while (mk) {
                const int sblk = __builtin_ctz(mk); mk &= mk - 1u;
                if (h1) { nsa_store(s1, Kt + (par ^ 1) * NSA_TB, Vt + (par ^ 1) * NSA_TB, tid);
                    const unsigned m3 = mk & (mk - 1u);
                    if (m3) { const int sc2 = __builtin_ctz(m3); s1 = nsa_load(KS + (size_t)(b * SEQ + 64 * sc2) * 64, 64, P + (size_t)(b * SEQ + 64 * sc2) * NP + C_KV + 192, NP, tid); } else h1 = false; }
                if ((wmask >> sblk) & 1u) nsa_tile_mfma<true>(Kt + par * NSA_TB, Vt + par * NSA_TB, btl2h, qf, n, hh, 64 * sblk, tq, 64 * sblk + 63 > t0 + 8 * wave, ((mymask >> sblk) & 1u) != 0u, 1 << 30, m, l, o);
                asm volatile("s_waitcnt lgkmcnt(0)" ::: "memory"); __builtin_amdgcn_s_barrier(); asm volatile("" ::: "memory");
                par ^= 1;
            }
            const float inv = l > 0.f ? gate[1] / l : 0.f;
#pragma unroll
            for (int db = 0; db < 2; ++db)
#pragma unroll
                for (int k = 0; k < 8; ++k) { const unsigned w = stash[(db * 8 + k) * 64]; stash[(db * 8 + k) * 64] = pk2(bf_lo(w) + inv * o[db][2 * k], bf_hi(w) + inv * o[db][2 * k + 1]); }
        }
        {
            float m = -1e30f, l = 0.f; f32x16 o[2];
#pragma unroll
            for (int db = 0; db < 2; ++db)
#pragma unroll
                for (int r = 0; r < 16; ++r) o[db][r] = 0.f;
            const int kt0 = (t0 - 511 > 0 ? t0 - 511 : 0) >> 6;
            NsaStage s0 = nsa_load(KW + (size_t)(b * SEQ + 64 * kt0) * 64, 64, P + (size_t)(b * SEQ + 64 * kt0) * NP + C_KV + 320, NP, tid), s1;
            if (kt0 < qt) s1 = nsa_load(KW + (size_t)(b * SEQ + 64 * (kt0 + 1)) * 64, 64, P + (size_t)(b * SEQ + 64 * (kt0 + 1)) * NP + C_KV + 320, NP, tid);
            __syncthreads();
            nsa_store(s0, Kt, Vt, tid);
            __syncthreads();
            int par = 0;
            for (int kt = kt0; kt <= qt; ++kt) {
                if (kt < qt) { nsa_store(s1, Kt + (par ^ 1) * NSA_TB, Vt + (par ^ 1) * NSA_TB, tid);
                    if (kt + 2 <= qt) s1 = nsa_load(KW + (size_t)(b * SEQ + 64 * (kt + 2)) * 64, 64, P + (size_t)(b * SEQ + 64 * (kt + 2)) * NP + C_KV + 320, NP, tid); }
                nsa_tile_mfma<false>(Kt + par * NSA_TB, Vt + par * NSA_TB, btl2h, qf, n, hh, 64 * kt, tq, !(64 * kt + 63 <= t0 + 8 * wave && t0 + 8 * wave + 7 - 64 * kt <= 511), true, 511, m, l, o);
                asm volatile("s_waitcnt lgkmcnt(0)" ::: "memory"); __builtin_amdgcn_s_barrier(); asm volatile("" ::: "memory");
                par ^= 1;
            }
            const float inv = l > 0.f ? gate[2] / l : 0.f;
#pragma unroll
            for (int db = 0; db < 2; ++db)
#pragma unroll
                for (int k = 0; k < 8; ++k) { const unsigned w = stash[(db * 8 + k) * 64]; yacc[db][2 * k] = bf_lo(w) + inv * o[db][2 * k]; yacc[db][2 * k + 1] = bf_hi(w) + inv * o[db][2 * k + 1]; }
        }
#pragma unroll
        for (int db = 0; db < 2; ++db)
#pragma unroll
            for (int rq = 0; rq < 4; ++rq) { u32x2 w; w.x = pk2(yacc[db][4 * rq], yacc[db][4 * rq + 1]); w.y = pk2(yacc[db][4 * rq + 2], yacc[db][4 * rq + 3]);
                *(u32x2*)(Y + (size_t)tok * DM + 512 + h * 64 + db * 32 + 8 * rq + 4 * hh) = w; }
        __syncthreads();
    }
}

constexpr int RT_PITCH = 2064;
__device__ __forceinline__ void ph_router(const ArgsG& a, int l, const float* Xin_, const bf16* Dm, LAS unsigned char* lds, int bid, int G, int tid, int wave, int lane) {
    LAS unsigned char* Ht = lds;
    LAS float* LG = (LAS float*)(lds + 32 * RT_PITCH);
    LAS int* lcnt = (LAS int*)(lds + 32 * RT_PITCH + 4 * 64 * 33 * 4); LAS int* asg_e = lcnt + 32; LAS int* asg_p = asg_e + 256; LAS float* asg_w = (LAS float*)(asg_p + 256); LAS int* gbase = (LAS int*)(asg_w + 256);
    bf16* H2 = (bf16*)(a.W() + WS_XN); unsigned* cnt = (unsigned*)(a.W() + WS_CTL) + CW_CNT + 64 * l;
    int* EIDX = (int*)(a.W() + WS_EIDX); int* EPOS = (int*)(a.W() + WS_EPOS); float* EW = (float*)(a.W() + WS_EW); int* POSTOK = (int*)(a.W() + WS_XS);
    const float* fw = a.I(17) + (size_t)l * DM; const float* rb = a.I(19) + l * NE;
    const bf16* RWH = (const bf16*)(a.W() + WS_RWH) + (size_t)l * NE * DM; const bf16* RWL = (const bf16*)(a.W() + WS_RWL) + (size_t)l * NE * DM;
    for (int u = bid; u < NT / 64; u += G) {
        const int tok0 = u * 64;
        if (tid < 32) lcnt[tid] = 0;
#pragma unroll 1
        for (int hf = 0; hf < 2; ++hf) {
            __syncthreads();
#pragma unroll 1
            for (int i = 0; i < 4; ++i) { const int tl = 4 * wave + i, tok = tok0 + 32 * hf + tl;
                f32x4 v[4]; float ss = 0.f;
#pragma unroll
                for (int j = 0; j < 4; ++j) { v[j] = *(const f32x4*)(Xin_ + (size_t)tok * DM + 4 * (64 * j + lane)); const u32x2 dd = *(const u32x2*)(Dm + (size_t)tok * DM + 4 * (64 * j + lane));
                    v[j].x += bf_lo(dd.x); v[j].y += bf_hi(dd.x); v[j].z += bf_lo(dd.y); v[j].w += bf_hi(dd.y); ss += (v[j].x * v[j].x + v[j].y * v[j].y) + (v[j].z * v[j].z + v[j].w * v[j].w); }
                const float r = rsqrtf(wave_sum(ss) * (1.0f / DM) + EPS);
#pragma unroll
                for (int j = 0; j < 4; ++j) { const f32x4 y = v[j] * r * *(const f32x4*)(fw + 4 * (64 * j + lane));
                    u32x2 o; o.x = pk2(y.x, y.y); o.y = pk2(y.z, y.w); *(u32x2*)(H2 + (size_t)tok * DM + 4 * (64 * j + lane)) = o;
                    *(LAS u32x2*)(Ht + tl * RT_PITCH + 8 * (64 * j + lane)) = o; } }
            __syncthreads();
            { const int r = lane & 15, q = lane >> 4, tile = wave & 1, kq = wave >> 1; f32x4 acc0 = {0.f, 0.f, 0.f, 0.f}, acc1 = {0.f, 0.f, 0.f, 0.f};
                const LAS unsigned char* arow = Ht + (16 * tile + r) * RT_PITCH + q * 16;
                const bf16* bh = RWH + (size_t)r * DM + 8 * q; const bf16* bl = RWL + (size_t)r * DM + 8 * q;
#pragma unroll
                for (int s8 = 0; s8 < 8; ++s8) { const int s = 8 * kq + s8; const bf16x8 af = *(const LAS bf16x8*)(arow + s * 64);
                    acc0 = __builtin_amdgcn_mfma_f32_16x16x32_bf16(af, *(const bf16x8*)(bh + 32 * s), acc0, 0, 0, 0); acc0 = __builtin_amdgcn_mfma_f32_16x16x32_bf16(af, *(const bf16x8*)(bl + 32 * s), acc0, 0, 0, 0);
                    acc1 = __builtin_amdgcn_mfma_f32_16x16x32_bf16(af, *(const bf16x8*)(bh + 16 * DM + 32 * s), acc1, 0, 0, 0); acc1 = __builtin_amdgcn_mfma_f32_16x16x32_bf16(af, *(const bf16x8*)(bl + 16 * DM + 32 * s), acc1, 0, 0, 0); }
                const float b0 = kq == 0 ? rb[r] : 0.f, b1 = kq == 0 ? rb[16 + r] : 0.f;
#pragma unroll
                for (int i = 0; i < 4; ++i) { LAS float* lg = LG + kq * (64 * 33) + (32 * hf + 16 * tile + 4 * q + i) * 33; lg[r] = acc0[i] + b0; lg[16 + r] = acc1[i] + b1; } }
        }
        __syncthreads();
        if (tid < 64) { const LAS float* lg = LG + tid * 33; unsigned used = 0u; float tv[4]; int ti[4];
#pragma unroll
            for (int qn = 0; qn < 4; ++qn) { float best = -3.0e38f; int bi = 0;
                for (int e = 0; e < NE; ++e) { const float v = ((lg[e] + lg[64 * 33 + e]) + lg[2 * 64 * 33 + e]) + lg[3 * 64 * 33 + e]; if (!((used >> e) & 1u) && v > best) { best = v; bi = e; } }
                used |= 1u << bi; tv[qn] = best; ti[qn] = bi; }
            float ew[4], es = 0.f;
#pragma unroll
            for (int qn = 0; qn < 4; ++qn) { ew[qn] = __expf(tv[qn] - tv[0]); es += ew[qn]; }
#pragma unroll
            for (int qn = 0; qn < 4; ++qn) { const int p = __hip_atomic_fetch_add(&lcnt[ti[qn]], 1, __ATOMIC_RELAXED, __HIP_MEMORY_SCOPE_WORKGROUP); asg_e[tid * 4 + qn] = ti[qn]; asg_p[tid * 4 + qn] = p; asg_w[tid * 4 + qn] = ew[qn] / es; } }
        __syncthreads();
        if (tid < 32) gbase[tid] = (int)atomicAdd(&cnt[tid], (unsigned)lcnt[tid]);
        __syncthreads();
        if (tid < 256) { const int tok = tok0 + (tid >> 2), k = tid & 3, e = asg_e[tid];
            const int pos = gbase[e] + asg_p[tid];
            EIDX[(size_t)tok * 4 + k] = e; EPOS[(size_t)tok * 4 + k] = pos; EW[(size_t)tok * 4 + k] = asg_w[tid]; POSTOK[(size_t)e * NT + pos] = tok; }
        __syncthreads();
    }
}

__device__ __forceinline__ void build_tiles(const unsigned* cnt, LAS int* TS, LAS int* TE, int tid) {
    if (tid < 64) {
        const int e = tid & 31; const int nt = (int)((cnt[e] + 255u) >> 8); int inc = nt;
#pragma unroll
        for (int off = 1; off < 32; off <<= 1) { const int v = __shfl_up(inc, off, 32); if (e >= off) inc += v; }
        const int start = inc - nt;
        if (tid < 32) { TS[e] = start; if (e == 31) TS[NE] = inc; for (int i = 0; i < nt; ++i) TE[start + i] = e; }
    }
    __syncthreads();
}

__device__ __forceinline__ void ph_gather(const ArgsG& a, int l, LAS unsigned char* lds, int gw, int NGW, int tid, int lane) {
    LAS int* TS = (LAS int*)(lds + TS_OFF); LAS int* TE = (LAS int*)(lds + TE_OFF);
    const unsigned* cnt = (const unsigned*)(a.W() + WS_CTL) + CW_CNT + 64 * l;
    build_tiles(cnt, TS, TE, tid);
    const int* EIDX = (const int*)(a.W() + WS_EIDX); const int* EPOS = (const int*)(a.W() + WS_EPOS); int* SLOT = (int*)(a.W() + WS_SLOT); int* S2T = (int*)(a.W() + WS_XS);
    for (int i = gw * 64 + lane; i < NT * 4; i += NGW * 64) { const int slot = TS[EIDX[i]] * 256 + EPOS[i]; SLOT[i] = slot; S2T[slot] = i >> 2; }
    for (int e = (int)blockIdx.x; e < NE; e += (int)gridDim.x) { const int beg = TS[e] * 256 + (int)cnt[e], end = TS[e + 1] * 256; for (int sidx = beg + tid; sidx < end; sidx += NTHR) S2T[sidx] = 0; }
}

__device__ __forceinline__ void ph_combine(const ArgsG& a, int l, LAS unsigned char* lds, const float* Xin_, const bf16* Dm, float* Xo, const float* next_norm_w, bool rebuild, int gw, int NGW, int tid, int lane) {
    LAS int* TS = (LAS int*)(lds + TS_OFF); LAS int* TE = (LAS int*)(lds + TE_OFF);
    if (rebuild) build_tiles((const unsigned*)(a.W() + WS_CTL) + CW_CNT + 64 * l, TS, TE, tid);
    const int* EIDX = (const int*)(a.W() + WS_EIDX); const int* EPOS = (const int*)(a.W() + WS_EPOS);
    const bf16* YS = (const bf16*)(a.W() + WS_YS); const float* EW = (const float*)(a.W() + WS_EW); bf16* XN = (bf16*)(a.W() + WS_XN);
    for (int tok = gw; tok < NT; tok += NGW) {
        int slot = 0; float wgt = 0.f;
        if (lane < 4) { slot = TS[EIDX[(size_t)tok * 4 + lane]] * 256 + EPOS[(size_t)tok * 4 + lane]; wgt = EW[(size_t)tok * 4 + lane]; }
        f32x4 v[4];
#pragma unroll
        for (int j = 0; j < 4; ++j) { v[j] = *(const f32x4*)(Xin_ + (size_t)tok * DM + 4 * (64 * j + lane)); const u32x2 dd = *(const u32x2*)(Dm + (size_t)tok * DM + 4 * (64 * j + lane));
            v[j].x += bf_lo(dd.x); v[j].y += bf_hi(dd.x); v[j].z += bf_lo(dd.y); v[j].w += bf_hi(dd.y); }
#pragma unroll
        for (int k = 0; k < 4; ++k) { const int sk = __shfl(slot, k); const float wk = __shfl(wgt, k);
#pragma unroll
            for (int j = 0; j < 4; ++j) { const u32x2 y = __builtin_nontemporal_load((const u32x2*)(YS + (size_t)sk * DM + 4 * (64 * j + lane)));
                v[j].x += wk * bf_lo(y.x); v[j].y += wk * bf_hi(y.x); v[j].z += wk * bf_lo(y.y); v[j].w += wk * bf_hi(y.y); } }
#pragma unroll
        for (int j = 0; j < 4; ++j) *(f32x4*)(Xo + (size_t)tok * DM + 4 * (64 * j + lane)) = v[j];
        if (next_norm_w) rms_row_to_bf16(v, next_norm_w, XN + (size_t)tok * DM, lane);
    }
}

struct Tid { int tid, lane, wave; };
__device__ __forceinline__ Tid fresh_tid() { int t = threadIdx.x; asm volatile("" : "+v"(t)); Tid r; r.tid = t; r.lane = t & 63; r.wave = __builtin_amdgcn_readfirstlane(t >> 6); return r; }
#define FT() ArgsG A_; { unsigned char* w_ = args_k.ws; asm volatile("" : "+s"(w_)); A_.ws = (GAS unsigned char*)w_; _Pragma("unroll") for (int i_ = 0; i_ < 25; ++i_) A_.in[i_] = (const GAS float*)args_k.in[i_]; A_.out = (GAS float*)args_k.out; } const ArgsG& args = A_; const Tid T_ = fresh_tid(); const int tid = T_.tid, lane = T_.lane, wave = T_.wave, gw = bid * NWAVES + wave; (void)tid; (void)lane; (void)wave; (void)gw
constexpr int CONV_FOUR_ITEMS = 64 * 8 * 20, CONV_L1_TAIL = 192 * 8 * 7, CONV_M3_FILL = 8 * 1216, CONV_PB1_W = 2, CONV_PB1_FILL = 128 * 8 * CONV_PB1_W;
constexpr int PH_PER_LAYER = 11, NPH = 2 + NLAYER * PH_PER_LAYER;

#if SINGLE_LAUNCH
#define BARPARM , unsigned* barw, unsigned& bark
#define BARARG , barw, bark
#define GRID_BAR() cnt_barrier(barw, bark)
#else
#define BARPARM
#define BARARG
#define GRID_BAR() do {} while (0)
#endif
#define IN(k) (lo <= (k) && (k) < hi)
#define SEAM(k) do { if (IN(k) && IN((k) + 1)) GRID_BAR(); } while (0)
template <int l>
__device__ __forceinline__ void run_layer(const Args& args_k, LAS unsigned char* lds, int lo, int hi, int G, int bid, int NGW BARPARM) {
        const int pb = 2 + l * PH_PER_LAYER;
#define Xin ((l == 0) ? args.I(0) : (const float*)(args.W() + WS_XB))
#define X1 ((float*)(args.W() + WS_XA))
#define Xout ((l == NLAYER - 1) ? args.O() : (float*)(args.W() + WS_XB))
        if (IN(pb + 0)) {
            const bool conv_first = ((bid >> 3) & 1) != 0;
            const bool bal = G == 256; const bool four = bid < 64;
            const int c_lo = !bal ? 0 : (four ? 0 : CONV_FOUR_ITEMS), c_hi = !bal ? (1 << 30) : (four ? CONV_FOUR_ITEMS : (1 << 30));
            const int c_rank0 = !bal ? bid * NWAVES : (four ? bid * NWAVES : (bid - 64) * NWAVES), c_nr = !bal ? NGW : (four ? 64 * NWAVES : 192 * NWAVES);
            if constexpr (l == 0) { if (conv_first) { { FT(); ph_prologue(args, lds, gw, NGW, wave, lane, 1, c_lo, c_hi, c_rank0 + wave, c_nr); } __syncthreads(); } }
            { FT(); pg8::Gemm g{(const pg8::bf16_t*)(args.W() + WS_XN), (const pg8::bf16_t*)(args.W() + WS_WIN) + (size_t)l * NP * DM, NT, NP, DM};
            pg8::StaticOrder S; S.init(NT, NP, G, bid);
            pg8::EpiBf16Plain E{(pg8::bf16_t*)(args.W() + WS_P), NP};
            pg8::gemm_phase<pg8::EpiBf16Plain, pg8::StaticOrder, true, true>(lds, g, S, E); }
            if constexpr (l == 0) { if (!conv_first) { __syncthreads(); { FT(); ph_prologue(args, lds, gw, NGW, wave, lane, 1, c_lo, c_hi, c_rank0 + wave, c_nr); } } }
            if constexpr (l == 1) { if (bal && !four) { __syncthreads(); { FT(); ph_prologue(args, lds, gw, NGW, wave, lane, 2, 0, CONV_L1_TAIL, (bid - 64) * NWAVES + wave, 192 * NWAVES); } } }
        } SEAM(pb + 0);
        if (IN(pb + 1)) { { FT(); ph_compress_mfma(args, l, lds, bid, G, tid, wave, lane); }
            if (G == 256 && bid >= 128) { { FT(); const int lo_ = CONV_L1_TAIL + 2 * CONV_M3_FILL + l * CONV_PB1_FILL + (bid - 128) * 8 * CONV_PB1_W; ph_prologue(args, lds, gw, NGW, wave, lane, 2, lo_, lo_ + 8 * CONV_PB1_W, wave, 8); } __syncthreads(); }
            { FT(); ph_m1(args, l, lds, bid, G, tid, wave, lane); }
            asm volatile("s_waitcnt vmcnt(0)" ::: "memory"); __syncthreads();
            if (G == 256) { FT(); ph_dn_chunk_mfma(args, lds, bid, G, tid, wave, lane); } }
        if (G != 256) { SEAM(pb + 1); if (IN(pb + 1)) { FT(); ph_dn_chunk_mfma(args, lds, bid, G, tid, wave, lane); } } SEAM(pb + 1);
        if (IN(pb + 3)) {
            const bool small = G <= 64;
            const bool conv_first3 = (bid & 1) != 0;
            int fw, fo;
            if (bid < 32) { fw = 3; fo = 3 * bid; }
            else { const int ub_ = bid - 32; if (ub_ < 192) { const int q_ = ub_ / 16; fw = q_; fo = 96 + 8 * q_ * (q_ - 1) + q_ * (ub_ - 16 * q_); } else { fw = 2; fo = 96 + 1056 + 2 * (ub_ - 192); } }
            const int fill_lo = CONV_L1_TAIL + l * CONV_M3_FILL + 8 * fo, even_lo = G == 256 ? CONV_L1_TAIL + 2 * CONV_M3_FILL + 2 * CONV_PB1_FILL : 0;
            if constexpr (l == 0) { if (conv_first3) { { FT(); ph_prologue(args, lds, gw, NGW, wave, lane, 2, even_lo); } __syncthreads(); } }
            if (small || bid < 32) { FT(); ph_dn_scan_mfma(args, lds, bid, small ? G : 32, tid, wave, lane); }
            { int ub, us, ue;
              if (small) { ub = bid; us = G; ue = 256; }
              else if (G == 256) { if (bid >= 32) { ub = bid - 32; us = 32; ue = ub >= 192 ? 256 : ub + 1; } else { ub = 256; us = 256; ue = 256; } }
              else { ub = bid >= 32 ? bid - 32 : 256; us = G - 32; ue = 256; }
              FT(); ph_nsa_mfma(args, lds, ub, us, ue, tid, wave, lane); }
            if constexpr (l == 0) { if (!conv_first3) { asm volatile("s_waitcnt vmcnt(0)" ::: "memory"); __syncthreads(); { FT(); ph_prologue(args, lds, gw, NGW, wave, lane, 2, even_lo); } } }
            if (G == 256 && fw > 0) { asm volatile("s_waitcnt vmcnt(0)" ::: "memory"); __syncthreads(); { FT(); ph_prologue(args, lds, gw, NGW, wave, lane, 2, fill_lo, fill_lo + 8 * fw, wave, 8); } } } SEAM(pb + 3);
        if (IN(pb + 4)) { FT(); ph_dn_out(args, l, gw, NGW, lane); } SEAM(pb + 4);
        if (IN(pb + 5)) {
            FT(); pg8::Gemm g{(const pg8::bf16_t*)(args.W() + WS_Y), (const pg8::bf16_t*)(args.W() + WS_WOUT) + (size_t)l * DM * DM, NT, DM, DM};
            pg8::StaticOrder S; S.init(NT, DM, G, bid);
            pg8::EpiBf16Plain E{(pg8::bf16_t*)(args.W() + WS_XA), DM};
            pg8::gemm_phase<pg8::EpiBf16Plain, pg8::StaticOrder, true, true>(lds, g, S, E);
        } SEAM(pb + 5);
        if (IN(pb + 6)) { FT(); ph_router(args, l, Xin, (const bf16*)(args.W() + WS_XA), lds, bid, G, tid, wave, lane); } SEAM(pb + 6);
        if (IN(pb + 8)) {
            { FT(); LAS int* TS = (LAS int*)(lds + TS_OFF); LAS int* TE = (LAS int*)(lds + TE_OFF);
            build_tiles((const unsigned*)(args.W() + WS_CTL) + CW_CNT + 64 * l, TS, TE, tid);
            const int ntiles = __builtin_amdgcn_readfirstlane(TS[NE]);
            pg8::Gemm g{(const pg8::bf16_t*)(args.W() + WS_XN), (const pg8::bf16_t*)(args.W() + WS_WGU) + (size_t)l * NE * 2048 * DM, ntiles * 256, NE * 2048, DM};
            LAS int* RT = (LAS int*)(lds + LDSCTL_OFF + 2048);
            pg8::MoeOrder<8, true, 1> S{ntiles, G, bid, (const LAS int*)TE, (const LAS int*)RT};
            S.rdy = (unsigned*)(args.W() + WS_CTL) + CW_RDY + l * RDY_STRIDE;
            { const int* POSTOK = (const int*)(args.W() + WS_XS); const unsigned* cntp = (const unsigned*)(args.W() + WS_CTL) + CW_CNT + 64 * l; pg8::Unit uu;
              int rv[10];
#pragma unroll
              for (int i = 0; i < 10; ++i) { rv[i] = -1; if (S.next(i, uu) && tid < 256) { const int e = TE[uu.pm], pos = uu.pm * 256 + tid - TS[e] * 256; rv[i] = pos < (int)cntp[e] ? POSTOK[(size_t)e * NT + pos] : 0; } }
#pragma unroll
              for (int i = 0; i < 10; ++i) if (rv[i] >= 0) RT[i * 256 + tid] = rv[i]; }
            __syncthreads();
            pg8::EpiSwigluWT E{(pg8::bf16_t*)(args.W() + WS_ACT), args.I(21) + (size_t)l * NE * 2048};
            pg8::gemm_phase<pg8::EpiSwigluWT, pg8::MoeOrder<8, true, 1>, true, true>(lds, g, S, E); }
            __syncthreads();
            { FT(); LAS int* TS = (LAS int*)(lds + TS_OFF); LAS int* TE = (LAS int*)(lds + TE_OFF);
            const int ntiles = __builtin_amdgcn_readfirstlane(TS[NE]);
            pg8::Gemm g{(const pg8::bf16_t*)(args.W() + WS_ACT), (const pg8::bf16_t*)(args.W() + WS_WD) + (size_t)l * NE * DM * DM, ntiles * 256, NE * DM, DM};
            pg8::MoeOrder<4, false, 2> S{ntiles, G, bid, (const LAS int*)TE};
            S.rdy = (unsigned*)(args.W() + WS_CTL) + CW_RDY + l * RDY_STRIDE; S.tmo = (unsigned*)(args.W() + WS_CTL) + CW_TMO; S.shift = ((ntiles + 3) >> 2) & 7;
            LAS float* BL = (LAS float*)(lds + LDSCTL_OFF + 2048);
            { const float* bdn = args.I(23) + (size_t)l * NE * DM; pg8::Unit uu; float rv[pg8::EpiDown64L::NSLOT]; bool ok[pg8::EpiDown64L::NSLOT];
#pragma unroll
              for (int i = 0; i < pg8::EpiDown64L::NSLOT; ++i) { ok[i] = S.next(i, uu) && tid < 256; rv[i] = ok[i] ? bdn[(size_t)(uu.pn >> 2) * DM + (uu.pn & 3) * 256 + tid] : 0.f; }
#pragma unroll
              for (int i = 0; i < pg8::EpiDown64L::NSLOT; ++i) if (ok[i]) BL[i * 256 + tid] = rv[i]; }
            __syncthreads();
            pg8::EpiDown64L E{(pg8::bf16_t*)(args.W() + WS_YS), args.I(23) + (size_t)l * NE * DM, (const LAS float*)BL};
            pg8::gemm_phase<pg8::EpiDown64L, pg8::MoeOrder<4, false, 2>, true, true>(lds, g, S, E); }
        } SEAM(pb + 8);
        if (IN(pb + 10)) { FT(); ph_combine(args, l, lds, Xin, (const bf16*)(args.W() + WS_XA), Xout, (l + 1 < NLAYER) ? args.I(1) + (size_t)(l + 1) * DM : nullptr, !IN(pb + 8), gw, NGW, tid, lane); }
        if (l + 1 < NLAYER) SEAM(pb + 10);
    }

__global__ void __launch_bounds__(NTHR, 2) fwd_kernel(Args args_k) {
    extern __shared__ __attribute__((aligned(16))) unsigned char lds_raw[];
    LAS unsigned char* lds = (LAS unsigned char*)lds_raw;
    const int G = gridDim.x, bid = blockIdx.x, NGW = G * NWAVES;
    for (int u = threadIdx.x; u < (LDS_BYTES - LDSCTL_OFF) / 4; u += NTHR) ((LAS unsigned*)(lds + LDSCTL_OFF))[u] = 0u;
    __syncthreads();
#if SINGLE_LAUNCH
    unsigned* barw = (unsigned*)(args_k.ws + WS_CTL) + CW_BAR; unsigned bark = 0u;
#endif
    const int lo = args_k.ph_lo, hi = args_k.ph_hi;

    if (IN(0)) { { FT(); ph_norm0(args, gw, NGW, lane); } { FT(); ph_prologue(args, lds, gw, NGW, wave, lane, 0); } } SEAM(0);

    run_layer<0>(args_k, lds, lo, hi, G, bid, NGW BARARG);
    run_layer<1>(args_k, lds, lo, hi, G, bid, NGW BARARG);
#undef IN
#undef SEAM
}

extern "C" void kernel_launch(void* const* d_in, const int* in_sizes, int n_in, void* d_out, int out_size, void* d_ws, size_t ws_size, hipStream_t stream) {
    static int grid = 0;
    if (grid == 0) {
        if (n_in != 25 || in_sizes[0] != NT * DM || out_size != NT * DM || ws_size < WS_END) {
            fprintf(stderr, "kernel_launch: unexpected problem (n_in %d, in0 %d, out %d, ws %zu < %zu); nothing launched\n", n_in, n_in > 0 ? in_sizes[0] : -1, out_size, ws_size, (size_t)WS_END); grid = -1; return; }
        int dev = 0, cus = 0, per_cu = 0;
        if (hipGetDevice(&dev) != hipSuccess || hipDeviceGetAttribute(&cus, hipDeviceAttributeMultiprocessorCount, dev) != hipSuccess) { grid = -1; return; }
        if (hipFuncSetAttribute((const void*)fwd_kernel, hipFuncAttributeMaxDynamicSharedMemorySize, LDS_BYTES) != hipSuccess) { fprintf(stderr, "kernel_launch: hipFuncSetAttribute failed\n"); grid = -1; return; }
        if (hipOccupancyMaxActiveBlocksPerMultiprocessor(&per_cu, (const void*)fwd_kernel, NTHR, LDS_BYTES) != hipSuccess || per_cu < 1)
            fprintf(stderr, "kernel_launch: note: occupancy query reports %d workgroups per CU\n", per_cu);
        (void)hipGetLastError();
        grid = cus;
    }
    if (grid < 0) return;
    if (hipMemsetAsync((char*)d_ws + WS_CTL, 0, CTL_ZERO_BYTES, stream) != hipSuccess) { fprintf(stderr, "kernel_launch: memset failed\n"); return; }
    Args a{};
    for (int i = 0; i < 25; ++i) a.in[i] = (const float*)d_in[i];
    a.out = (float*)d_out; a.ws = (unsigned char*)d_ws;
#if SINGLE_LAUNCH
    a.ph_lo = 0; a.ph_hi = NPH;
    hipLaunchKernelGGL(fwd_kernel, dim3(grid), dim3(NTHR), LDS_BYTES, stream, a);
#else
    for (int ph = 0; ph < NPH; ++ph) { a.ph_lo = ph; a.ph_hi = ph + 1; hipLaunchKernelGGL(fwd_kernel, dim3(grid), dim3(NTHR), LDS_BYTES, stream, a); }
#endif
}
```
